# Optimizing an MI355X kernel written in HIP

```python
import math
import jax
import jax.numpy as jnp
from jax import lax
import numpy as np

D_MODEL = 1024
BATCH = 4
SEQ = 8192
DEPTH = 2

GRID_W = 64
CTX_LEN = 256

RW_HEADS = 6
RW_HEAD_DIM = 64
RW_WIDTH = 384
RW_DECAY_LORA = 64
RW_AAA_LORA = 64
RW_GATE_LORA = 128
RW_GN_EPS = 64e-5

S5_GROUPS = 16
S5_GROUP_CH = 16
S5_WIDTH = 256
S5_STATE = 64
S5_DT_MIN = 1e-3
S5_DT_MAX = 1e-1

ML_HEADS = 4
ML_HEAD_DIM = 96
ML_WIDTH = 384
ML_CHUNK = 64
ML_EPS = 1e-5

D_FF = 2816
N_BRANCH = 3
N_MOD = 9
LN_EPS = 1e-5
DEEPNORM_ALPHA = (2.0 * DEPTH) ** 0.25
DEEPNORM_BETA = (8.0 * DEPTH) ** -0.25

CONV_COLS = 3 * RW_WIDTH + 2 * ML_WIDTH
IN_SPLITS = (CONV_COLS, ML_WIDTH, ML_WIDTH, 4 * ML_HEADS, S5_WIDTH, RW_DECAY_LORA, RW_AAA_LORA, RW_GATE_LORA, N_BRANCH * D_MODEL)
IN_WIDTH = CONV_COLS + 2 * ML_WIDTH + 4 * ML_HEADS + S5_WIDTH + RW_DECAY_LORA + RW_AAA_LORA + RW_GATE_LORA + N_BRANCH * D_MODEL

kernel_name = 'hybrid_rwkv7_s5_mlstm_prefix_dit'


def _split(z, sizes):
    parts, start = [], 0
    for s in sizes:
        parts.append(z[..., start:start + s])
        start += s
    return parts


def _standardize(x, eps):
    xf = x.astype(jnp.float32)
    xc = xf - jnp.mean(xf, axis=-1, keepdims=True)
    return xc * lax.rsqrt(jnp.mean(xc * xc, axis=-1, keepdims=True) + eps)


def _post_norm(x, delta, g, b):
    y = _standardize(DEEPNORM_ALPHA * x + delta, LN_EPS) * g.astype(jnp.float32) + b.astype(jnp.float32)
    return y.astype(x.dtype)


def _modulation(cvec, w, b):
    m = jnp.dot(jax.nn.silu(cvec), w) + b
    return jnp.split(m[..., None, :], N_MOD, axis=-1)


def _swiglu(u, wg, wu, wd):
    return jnp.dot(jax.nn.silu(jnp.dot(u, wg)) * jnp.dot(u, wu), wd)


def _ffn_half(x, shift, scale, gate, wg, wu, wd, g, b):
    u = x * (1.0 + scale) + shift
    return _post_norm(x, 0.5 * gate * _swiglu(u, wg, wu, wd), g, b)


def _conv_grid(z, w):
    b, l, ch = z.shape
    rows = l // GRID_W
    y = lax.conv_general_dilated(z.reshape(b, rows, GRID_W, ch), w[:, :, None, :].astype(z.dtype),
                                 window_strides=(1, 1), padding='SAME',
                                 dimension_numbers=('NHWC', 'HWIO', 'NHWC'), feature_group_count=ch)
    return y.reshape(b, l, ch)


def _conv_seq(z, w):
    wr = w[1].astype(z.dtype)
    zp = jnp.pad(z, ((0, 0), (1, 1), (0, 0)))
    return zp[:, :-2] * wr[0] + zp[:, 1:-1] * wr[1] + zp[:, 2:] * wr[2]


def _rwkv7_scan(r, w, k, v, kk, a, s0, reverse):
    def step(s, inp):
        r_t, w_t, k_t, v_t, kk_t, a_t = inp
        sa = jnp.einsum('bhvk,bhk->bhv', s, kk_t)
        s = s * w_t[:, :, None, :] - sa[..., None] * (kk_t * a_t)[:, :, None, :] + v_t[..., None] * k_t[:, :, None, :]
        return s, jnp.einsum('bhvk,bhk->bhv', s, r_t)
    xs = tuple(jnp.moveaxis(t, 1, 0) for t in (r, w, k, v, kk, a))
    s_fin, ys = lax.scan(step, s0, xs, reverse=reverse)
    return jnp.moveaxis(ys, 0, 1), s_fin


def _rwkv7_branch(r, k, v, w_dn, a_dn, g_dn, p, init):
    b, l, _ = r.shape
    f32 = jnp.float32
    hd = lambda t: t.astype(f32).reshape(b, l, RW_HEADS, RW_HEAD_DIM)
    rh, vh = hd(r), hd(v)
    kk = hd(k * p['rw_k_k'])
    kk = kk * lax.rsqrt(jnp.maximum(jnp.sum(kk * kk, axis=-1, keepdims=True), 1e-24))
    g = jnp.dot(jax.nn.sigmoid(g_dn), p['rw_g_up'])
    r_k = p['rw_r_k'].astype(f32)
    y_sum, bonus, finals = None, None, []
    for d, rev in enumerate((False, True)):
        w_log = -jax.nn.softplus(-(p['rw_w0'][d] + jnp.dot(jnp.tanh(w_dn), p['rw_w_up'][d]))) - 0.5
        decay = jnp.exp(-jnp.exp(w_log.astype(f32)))
        a = jax.nn.sigmoid(p['rw_a0'][d] + jnp.dot(a_dn, p['rw_a_up'][d]))
        k_d = hd(k * (1.0 + (a - 1.0) * p['rw_k_a']))
        s0 = jnp.zeros((b, RW_HEADS, RW_HEAD_DIM, RW_HEAD_DIM), f32) if init is None else init[d]
        y_d, s_d = _rwkv7_scan(rh, hd(decay), k_d, vh, kk, hd(a), s0, rev)
        bonus_d = jnp.sum(rh * k_d * r_k, axis=-1, keepdims=True) * vh
        y_sum = y_d if y_sum is None else y_sum + y_d
        bonus = bonus_d if bonus is None else bonus + bonus_d
        finals.append(s_d)
    y = _standardize(y_sum, RW_GN_EPS).reshape(b, l, RW_WIDTH) * p['rw_gn_g'].astype(f32) + p['rw_gn_b'].astype(f32)
    y = (y + bonus.reshape(b, l, RW_WIDTH)) * g
    return y.astype(r.dtype), finals


def _diag_combine(e1, e2):
    a1, b1 = e1
    a2, b2 = e2
    return a1 * a2, a2 * b1 + b2


def _s5_direction(ug, a_re, a_im, log_dt, b_re, b_im, c_re, c_im, x0, reverse):
    f32 = jnp.float32
    lam = lax.complex(jnp.minimum(a_re.astype(f32), -1e-4), a_im.astype(f32))
    a_bar = jnp.exp(lam * jnp.exp(log_dt.astype(f32))[:, None])
    b_bar = ((a_bar - 1.0) / lam)[..., None] * lax.complex(b_re.astype(f32), b_im.astype(f32))
    bu = jnp.einsum('blgh,gnh->blgn', ug.astype(jnp.complex64), b_bar)
    if reverse:
        bu = bu[:, ::-1]
    if x0 is not None:
        bu = bu.at[:, 0].add(a_bar * x0)
    a_seq = jnp.broadcast_to(a_bar, (1,) + bu.shape[1:])
    _, xs = lax.associative_scan(_diag_combine, (a_seq, bu), axis=1)
    y = jnp.einsum('blgn,ghn->blgh', xs, lax.complex(c_re.astype(f32), c_im.astype(f32))).real
    if reverse:
        y = y[:, ::-1]
    return y, xs[:, -1]


def _s5_branch(u, p, init):
    b, l, _ = u.shape
    f32 = jnp.float32
    ug = u.astype(f32).reshape(b, l, S5_GROUPS, S5_GROUP_CH)
    y = ug * p['s5_d'].astype(f32).reshape(S5_GROUPS, S5_GROUP_CH)
    finals = []
    for d, rev in enumerate((False, True)):
        y_d, x_d = _s5_direction(ug, p['s5_a_re'][d], p['s5_a_im'][d], p['s5_log_dt'][d],
                                 p['s5_b_re'][d], p['s5_b_im'][d], p['s5_c_re'][d], p['s5_c_im'][d],
                                 None if init is None else init[d], rev)
        y = y + y_d
        finals.append(x_d)
    y = jax.nn.gelu(y.reshape(b, l, S5_WIDTH))
    y = y * jax.nn.sigmoid(jnp.dot(y, p['s5_glu_w'].astype(f32)) + p['s5_glu_b'].astype(f32))
    return y.astype(u.dtype), finals


def _mlstm_direction(q, k, v, ig, fg, state0, reverse):
    if reverse:
        q, k, v, ig, fg = (t[:, ::-1] for t in (q, k, v, ig, fg))
    b, l, h, dh = q.shape
    nc = l // ML_CHUNK

    def chunks(t):
        t = t.reshape((b, nc, ML_CHUNK) + t.shape[2:])
        return jnp.moveaxis(jnp.moveaxis(t, 1, 0), 3, 2)

    lower_tri = jnp.tril(jnp.ones((ML_CHUNK, ML_CHUNK), dtype=bool))

    def step(carry, inp):
        c_prev, n_prev, m_prev = carry
        qc, kc, vc, ic, fc = inp
        bcum = jnp.cumsum(fc, axis=-1)
        logd = jnp.where(lower_tri, bcum[..., :, None] - bcum[..., None, :] + ic[..., None, :], -jnp.inf)
        log_inter = bcum + m_prev[..., None]
        m = jnp.maximum(log_inter, jnp.max(logd, axis=-1))
        inter = jnp.exp(log_inter - m)
        s = jnp.einsum('bhjd,bhsd->bhjs', qc, kc) * jnp.exp(logd - m[..., None])
        num = inter[..., None] * jnp.einsum('bhvk,bhjk->bhjv', c_prev, qc) + jnp.einsum('bhjs,bhsv->bhjv', s, vc)
        den = inter * jnp.einsum('bhk,bhjk->bhj', n_prev, qc) + jnp.sum(s, axis=-1)
        hc = num / jnp.maximum(jnp.abs(den), jnp.exp(-m))[..., None]
        b_last = bcum[..., -1]
        log_w = b_last[..., None] - bcum + ic
        m_new = jnp.maximum(b_last + m_prev, jnp.max(log_w, axis=-1))
        wgt = jnp.exp(log_w - m_new[..., None])
        dec = jnp.exp(b_last + m_prev - m_new)
        c_new = dec[..., None, None] * c_prev + jnp.einsum('bhs,bhsv,bhsk->bhvk', wgt, vc, kc)
        n_new = dec[..., None] * n_prev + jnp.einsum('bhs,bhsk->bhk', wgt, kc)
        return (c_new, n_new, m_new), hc

    state, hs = lax.scan(step, state0, tuple(chunks(t) for t in (q, k, v, ig, fg)))
    hs = jnp.moveaxis(jnp.moveaxis(hs, 2, 3), 0, 1).reshape(b, l, h, dh)
    if reverse:
        hs = hs[:, ::-1]
    return hs, state


def _mlstm_branch(q, k, v, o, gl, p, init):
    b, l, _ = q.shape
    f32 = jnp.float32
    hd = lambda t: t.astype(f32).reshape(b, l, ML_HEADS, ML_HEAD_DIM)
    qh = hd(jax.nn.silu(q))
    kh = hd(jax.nn.silu(k)) * (ML_HEAD_DIM ** -0.5)
    vh = hd(v)
    gates = gl.astype(f32).reshape(b, l, 2, 2, ML_HEADS) + p['ml_gate_b'].astype(f32)
    h_sum, finals = None, []
    for d, rev in enumerate((False, True)):
        if init is None:
            s0 = (jnp.zeros((b, ML_HEADS, ML_HEAD_DIM, ML_HEAD_DIM), f32),
                  jnp.zeros((b, ML_HEADS, ML_HEAD_DIM), f32),
                  jnp.zeros((b, ML_HEADS), f32))
        else:
            s0 = init[d]
        h_d, s_d = _mlstm_direction(qh, kh, vh, gates[:, :, d, 0], jax.nn.log_sigmoid(gates[:, :, d, 1]), s0, rev)
        h_sum = h_d if h_sum is None else h_sum + h_d
        finals.append(s_d)
    h_gated = jax.nn.sigmoid(hd(o)) * h_sum
    y = _standardize(h_gated, ML_EPS).reshape(b, l, ML_WIDTH) * p['ml_norm_g'].astype(f32)
    return y.astype(q.dtype), finals


def _mixer(u, p, init, grid):
    z = jnp.dot(u, p['w_in'])
    zc, ml_v, ml_o, ml_gl, s5_u, w_dn, a_dn, g_dn, br_gl = _split(z, IN_SPLITS)
    zc = _conv_grid(zc, p['conv_w']) if grid else _conv_seq(zc, p['conv_w'])
    rw_r, rw_k, rw_v, ml_q, ml_k = _split(zc, (RW_WIDTH, RW_WIDTH, RW_WIDTH, ML_WIDTH, ML_WIDTH))
    rw_y, rw_st = _rwkv7_branch(rw_r, rw_k, rw_v, w_dn, a_dn, g_dn, p, None if init is None else init[0])
    s5_y, s5_st = _s5_branch(s5_u, p, None if init is None else init[1])
    ml_y, ml_st = _mlstm_branch(ml_q, ml_k, ml_v, ml_o, ml_gl, p, None if init is None else init[2])
    return (rw_y, s5_y, ml_y, br_gl), (rw_st, s5_st, ml_st)


def _merge(branches, p):
    rw_y, s5_y, ml_y, br_gl = branches
    g_rw, g_s5, g_ml = jnp.split(jax.nn.sigmoid(br_gl + p['br_gate_b']), N_BRANCH, axis=-1)
    y = g_rw * jnp.dot(rw_y, p['up_rw']) + g_s5 * jnp.dot(s5_y, p['up_s5']) + g_ml * jnp.dot(ml_y, p['up_ml'])
    return jnp.dot(y, p['w_out'])


def setup_inputs(seed: int = 0) -> dict:
    key = jax.random.key(seed)
    ks = jax.random.split(key, 48)
    counter = [0]

    def nxt():
        counter[0] += 1
        return ks[counter[0] - 1]

    def nrm(shape, scale):
        return scale * jax.random.normal(nxt(), shape, jnp.float32)

    def uni(shape, lo, hi):
        return jax.random.uniform(nxt(), shape, jnp.float32, lo, hi)

    D = D_MODEL
    x = nrm((BATCH, SEQ, D), 1.0)
    c = nrm((BATCH, D), 1.0)
    ctx = nrm((BATCH, CTX_LEN, D), 1.0)
    c_ctx = nrm((D,), 1.0)
    ada_w = nrm((DEPTH, D, N_MOD * D), 0.5 * D ** -0.5)
    ada_b = nrm((DEPTH, N_MOD * D), 0.02)
    ln_g = 1.0 + nrm((DEPTH, 3, D), 0.02)
    ln_b = nrm((DEPTH, 3, D), 0.02)
    ffn_w_gate = nrm((DEPTH, 2, D, D_FF), D ** -0.5)
    ffn_w_up = nrm((DEPTH, 2, D, D_FF), D ** -0.5)
    ffn_w_down = nrm((DEPTH, 2, D_FF, D), DEEPNORM_BETA * D_FF ** -0.5)
    w_in = nrm((DEPTH, D, IN_WIDTH), D ** -0.5)
    conv_w = nrm((DEPTH, 3, 3, CONV_COLS), 0.15).at[:, 1, 1].add(0.6)
    rw_w0 = uni((DEPTH, 2, RW_WIDTH), -6.0, -1.0)
    rw_w_up = nrm((DEPTH, 2, RW_DECAY_LORA, RW_WIDTH), 0.5 * RW_DECAY_LORA ** -0.5)
    rw_a0 = nrm((DEPTH, 2, RW_WIDTH), 0.1)
    rw_a_up = nrm((DEPTH, 2, RW_AAA_LORA, RW_WIDTH), RW_AAA_LORA ** -0.5)
    rw_g_up = nrm((DEPTH, RW_GATE_LORA, RW_WIDTH), RW_GATE_LORA ** -0.5)
    rw_k_k = 0.85 + nrm((DEPTH, RW_WIDTH), 0.02)
    rw_k_a = 1.0 + nrm((DEPTH, RW_WIDTH), 0.02)
    rw_r_k = nrm((DEPTH, RW_HEADS, RW_HEAD_DIM), 0.1)
    rw_gn_g = 1.0 + nrm((DEPTH, RW_WIDTH), 0.02)
    rw_gn_b = nrm((DEPTH, RW_WIDTH), 0.02)
    s5_a_re = -0.5 + nrm((DEPTH, 2, S5_GROUPS, S5_STATE), 0.01)
    s5_a_im = math.pi * jnp.arange(S5_STATE, dtype=jnp.float32) + nrm((DEPTH, 2, S5_GROUPS, S5_STATE), 0.01)
    s5_log_dt = uni((DEPTH, 2, S5_GROUPS), math.log(S5_DT_MIN), math.log(S5_DT_MAX))
    s5_b_re = nrm((DEPTH, 2, S5_GROUPS, S5_STATE, S5_GROUP_CH), (2.0 * S5_GROUP_CH) ** -0.5)
    s5_b_im = nrm((DEPTH, 2, S5_GROUPS, S5_STATE, S5_GROUP_CH), (2.0 * S5_GROUP_CH) ** -0.5)
    s5_c_re = nrm((DEPTH, 2, S5_GROUPS, S5_GROUP_CH, S5_STATE), (0.5 * S5_STATE) ** -0.5)
    s5_c_im = nrm((DEPTH, 2, S5_GROUPS, S5_GROUP_CH, S5_STATE), (0.5 * S5_STATE) ** -0.5)
    s5_d = nrm((DEPTH, S5_WIDTH), 0.5)
    s5_glu_w = nrm((DEPTH, S5_WIDTH, S5_WIDTH), S5_WIDTH ** -0.5)
    s5_glu_b = nrm((DEPTH, S5_WIDTH), 0.02)
    ig_b = nrm((DEPTH, 2, 1, ML_HEADS), 0.1)
    fg_b = jnp.linspace(3.0, 6.0, ML_HEADS, dtype=jnp.float32) + nrm((DEPTH, 2, 1, ML_HEADS), 0.1)
    ml_gate_b = jnp.concatenate([ig_b, fg_b], axis=2)
    ml_norm_g = 1.0 + nrm((DEPTH, ML_WIDTH), 0.02)
    up_rw = nrm((DEPTH, RW_WIDTH, D), RW_WIDTH ** -0.5)
    up_s5 = nrm((DEPTH, S5_WIDTH, D), S5_WIDTH ** -0.5)
    up_ml = nrm((DEPTH, ML_WIDTH, D), ML_WIDTH ** -0.5)
    br_gate_b = nrm((DEPTH, N_BRANCH * D), 0.1)
    w_out = nrm((DEPTH, D, D), DEEPNORM_BETA * D ** -0.5)
    return {'x': x, 'c': c, 'ctx': ctx, 'c_ctx': c_ctx, 'ada_w': ada_w, 'ada_b': ada_b,
            'ln_g': ln_g, 'ln_b': ln_b, 'ffn_w_gate': ffn_w_gate, 'ffn_w_up': ffn_w_up, 'ffn_w_down': ffn_w_down,
            'w_in': w_in, 'conv_w': conv_w, 'rw_w0': rw_w0, 'rw_w_up': rw_w_up, 'rw_a0': rw_a0, 'rw_a_up': rw_a_up,
            'rw_g_up': rw_g_up, 'rw_k_k': rw_k_k, 'rw_k_a': rw_k_a, 'rw_r_k': rw_r_k, 'rw_gn_g': rw_gn_g,
            'rw_gn_b': rw_gn_b, 's5_a_re': s5_a_re, 's5_a_im': s5_a_im, 's5_log_dt': s5_log_dt,
            's5_b_re': s5_b_re, 's5_b_im': s5_b_im, 's5_c_re': s5_c_re, 's5_c_im': s5_c_im, 's5_d': s5_d,
            's5_glu_w': s5_glu_w, 's5_glu_b': s5_glu_b, 'ml_gate_b': ml_gate_b, 'ml_norm_g': ml_norm_g,
            'up_rw': up_rw, 'up_s5': up_s5, 'up_ml': up_ml, 'br_gate_b': br_gate_b, 'w_out': w_out}


def reference(x, c, ctx, c_ctx, ada_w, ada_b, ln_g, ln_b, ffn_w_gate, ffn_w_up, ffn_w_down, w_in, conv_w,
              rw_w0, rw_w_up, rw_a0, rw_a_up, rw_g_up, rw_k_k, rw_k_a, rw_r_k, rw_gn_g, rw_gn_b,
              s5_a_re, s5_a_im, s5_log_dt, s5_b_re, s5_b_im, s5_c_re, s5_c_im, s5_d, s5_glu_w, s5_glu_b,
              ml_gate_b, ml_norm_g, up_rw, up_s5, up_ml, br_gate_b, w_out):
    h = ctx
    for i in range(DEPTH):
        last = i == DEPTH - 1
        p = dict(w_in=w_in[i], conv_w=conv_w[i], rw_w0=rw_w0[i], rw_w_up=rw_w_up[i], rw_a0=rw_a0[i],
                 rw_a_up=rw_a_up[i], rw_g_up=rw_g_up[i], rw_k_k=rw_k_k[i], rw_k_a=rw_k_a[i], rw_r_k=rw_r_k[i],
                 rw_gn_g=rw_gn_g[i], rw_gn_b=rw_gn_b[i], s5_a_re=s5_a_re[i], s5_a_im=s5_a_im[i],
                 s5_log_dt=s5_log_dt[i], s5_b_re=s5_b_re[i], s5_b_im=s5_b_im[i], s5_c_re=s5_c_re[i],
                 s5_c_im=s5_c_im[i], s5_d=s5_d[i], s5_glu_w=s5_glu_w[i], s5_glu_b=s5_glu_b[i],
                 ml_gate_b=ml_gate_b[i], ml_norm_g=ml_norm_g[i], up_rw=up_rw[i], up_s5=up_s5[i],
                 up_ml=up_ml[i], br_gate_b=br_gate_b[i], w_out=w_out[i])
        mx = _modulation(c, ada_w[i], ada_b[i])
        mc = _modulation(c_ctx, ada_w[i], ada_b[i])
        x = _ffn_half(x, mx[0], mx[1], mx[2], ffn_w_gate[i, 0], ffn_w_up[i, 0], ffn_w_down[i, 0], ln_g[i, 0], ln_b[i, 0])
        h = _ffn_half(h, mc[0], mc[1], mc[2], ffn_w_gate[i, 0], ffn_w_up[i, 0], ffn_w_down[i, 0], ln_g[i, 0], ln_b[i, 0])
        uc = h * (1.0 + mc[4]) + mc[3]
        ctx_branches, ctx_states = _mixer(uc, p, None, False)
        ux = x * (1.0 + mx[4]) + mx[3]
        lat_branches, _ = _mixer(ux, p, ctx_states, True)
        x = _post_norm(x, mx[5] * _merge(lat_branches, p), ln_g[i, 1], ln_b[i, 1])
        x = _ffn_half(x, mx[6], mx[7], mx[8], ffn_w_gate[i, 1], ffn_w_up[i, 1], ffn_w_down[i, 1], ln_g[i, 2], ln_b[i, 2])
        if not last:
            h = _post_norm(h, mc[5] * _merge(ctx_branches, p), ln_g[i, 1], ln_b[i, 1])
            h = _ffn_half(h, mc[6], mc[7], mc[8], ffn_w_gate[i, 1], ffn_w_up[i, 1], ffn_w_down[i, 1], ln_g[i, 2], ln_b[i, 2])
    return x
```

```cpp
#include <hip/hip_runtime.h>
#include <hip/hip_cooperative_groups.h>
#include <cstdio>
namespace cg = cooperative_groups;

typedef unsigned short bf16_t;
typedef _Float16 hf;
typedef hf hf4 __attribute__((ext_vector_type(4)));
typedef hf hf8 __attribute__((ext_vector_type(8)));
typedef __attribute__((ext_vector_type(8))) short bf16x8;
typedef __attribute__((ext_vector_type(4))) float f32x4;

#define M_LAT 32768
#define M_ALL 33792
#define NTHR 256
#define LDS_BYTES 73728
#define ALPHA 1.41421356237f

#define W_GU0 0
#define W_D0 5767168
#define W_GU1 8650752
#define W_D1 14417920
#define W_IN 17301504
#define W_WUP0 23740416
#define W_WUP1 23764992
#define W_AUP0 23789568
#define W_AUP1 23814144
#define W_GUP 23838720
#define W_GLU 23887872
#define W_UPRW 23953408
#define W_UPS5 24346624
#define W_UPML 24608768
#define W_OUT 25001984
#define W_TOTAL 26050560

struct P {
  const float* in[40];
  float* out; float* sctx; float* mod;
  bf16_t* U; bf16_t* Y; bf16_t* W; char* R;
};

__device__ __forceinline__ int get_tid() { int t = __builtin_amdgcn_workitem_id_x(); asm volatile("" : "+v"(t)); return t; }
__device__ __forceinline__ bf16_t f2bf(float f) { unsigned u = __float_as_uint(f); u += 0x7fffu + ((u >> 16) & 1u); return (bf16_t)(u >> 16); }
__device__ __forceinline__ float bf2f(bf16_t h) { return __uint_as_float(((unsigned)h) << 16); }
__device__ __forceinline__ float sigmoidf_(float x) { return 1.f / (1.f + __expf(-x)); }
__device__ __forceinline__ float siluf_(float x) { return x / (1.f + __expf(-x)); }
__device__ __forceinline__ float* srow(const P& p, int m) { return m < M_LAT ? p.out + (size_t)m * 1024 : p.sctx + (size_t)(m - M_LAT) * 1024; }
__device__ __forceinline__ const float* modp(const P& p, int l, int m, int k) { int mv = m < M_LAT ? (m >> 13) : 4; return p.mod + (size_t)(l * 5 + mv) * 9216 + k * 1024; }
template <int C> __device__ __forceinline__ float dppf(float x) { return __int_as_float(__builtin_amdgcn_update_dpp(0, __float_as_int(x), C, 0xf, 0xf, false)); }
__device__ __forceinline__ float rowsum16(float x) { x += dppf<0x128>(x); x += dppf<0x124>(x); x += dppf<0x122>(x); x += dppf<0x121>(x); return x; }
__device__ __forceinline__ float wavesum(float x) { for (int o = 32; o > 0; o >>= 1) x += __shfl_xor(x, o); return x; }

template <int NB>
__device__ __forceinline__ void gemm_main_t(const bf16_t* __restrict__ A, int lda, const bf16_t* __restrict__ B, int ldb, int K,
                                          f32x4 (&acc)[4][NB], char* lds) {
  const int tid = get_tid(), lane = tid & 63, wid = tid >> 6, wr = wid >> 1, wc = wid & 1;
  const int fr = lane & 15, fq = lane >> 4;
  const int sr = tid >> 3, skc = tid & 7;
  const bf16_t* ga = A + (size_t)sr * lda + skc * 8;
  const bf16_t* gb = B + (size_t)sr * ldb + skc * 8;
  uint4 ra[4], rb[NB];
#pragma unroll
  for (int i = 0; i < 4; ++i) { ra[i] = *(const uint4*)(ga + (size_t)(i * 32) * lda); if (i < NB) rb[i] = *(const uint4*)(gb + (size_t)(i * 32) * ldb); }
  const int soff = sr * 144 + skc * 16;
#pragma unroll
  for (int i = 0; i < 4; ++i) { *(uint4*)(lds + soff + i * 32 * 144) = ra[i]; if (i < NB) *(uint4*)(lds + 18432 + soff + i * 32 * 144) = rb[i]; }
  __syncthreads();
  const int nk = K >> 6;
  const int aoff = (wr * 64 + fr) * 144 + fq * 16;
  const int boff = 18432 + (wc * (NB * 16) + fr) * 144 + fq * 16;
  for (int kt = 0; kt < nk; ++kt) {
    char* cur = lds + (kt & 1) * 36864;
    const bool more = (kt + 1 < nk);
    if (more) {
      ga += 64; gb += 64;
#pragma unroll
      for (int i = 0; i < 4; ++i) { ra[i] = *(const uint4*)(ga + (size_t)(i * 32) * lda); if (i < NB) rb[i] = *(const uint4*)(gb + (size_t)(i * 32) * ldb); }
    }
#pragma unroll
    for (int ks = 0; ks < 2; ++ks) {
      bf16x8 af[4], bfr[NB];
#pragma unroll
      for (int m = 0; m < 4; ++m) af[m] = *(const bf16x8*)(cur + aoff + m * 16 * 144 + ks * 64);
#pragma unroll
      for (int n = 0; n < NB; ++n) bfr[n] = *(const bf16x8*)(cur + boff + n * 16 * 144 + ks * 64);
#pragma unroll
      for (int m = 0; m < 4; ++m)
#pragma unroll
        for (int n = 0; n < NB; ++n) acc[m][n] = __builtin_amdgcn_mfma_f32_16x16x32_bf16(af[m], bfr[n], acc[m][n], 0, 0, 0);
    }
    if (more) {
      char* nxt = lds + ((kt + 1) & 1) * 36864;
#pragma unroll
      for (int i = 0; i < 4; ++i) { *(uint4*)(nxt + soff + i * 32 * 144) = ra[i]; if (i < NB) *(uint4*)(nxt + 18432 + soff + i * 32 * 144) = rb[i]; }
    }
    __syncthreads();
  }
}
__device__ __forceinline__ void gemm_main(const bf16_t* __restrict__ A, int lda, const bf16_t* __restrict__ B, int ldb, int K, f32x4 (&acc)[4][4], char* lds) {
  gemm_main_t<4>(A, lda, B, ldb, K, acc, lds);
}
#define ZERO_ACC(a) _Pragma("unroll") for (int m_ = 0; m_ < 4; ++m_) _Pragma("unroll") for (int n_ = 0; n_ < 4; ++n_) a[m_][n_] = (f32x4){0.f, 0.f, 0.f, 0.f};
#define EPI_VARS const int tid = get_tid(), lane = tid & 63, wid = tid >> 6, wr = wid >> 1, wc = wid & 1, fr = lane & 15, fq = lane >> 4; (void)wr; (void)wc; (void)fr; (void)fq;
#define EPI_ROW_BEGIN(m0) _Pragma("unroll") for (int m = 0; m < 4; ++m) _Pragma("unroll") for (int j = 0; j < 4; ++j) { const int row = (m0) + wr * 64 + m * 16 + fq * 4 + j; (void)row;
#define EPI_COL_BEGIN(n0) _Pragma("unroll") for (int n = 0; n < 4; ++n) { const int col = (n0) + wc * 64 + n * 16 + fr; const float val = acc[m][n][j]; (void)col; (void)val;
#define EPI_COL_END }
#define EPI_ROW_END }
#define EPI_BEGIN(m0, n0) EPI_ROW_BEGIN(m0) EPI_COL_BEGIN(n0)
#define EPI_END } }

struct Job { const float* src; int K, N; int dst; int mode; };
__device__ __forceinline__ Job get_job(const P& p, int l, int j) {
  Job r; r.mode = 0;
  switch (j) {
    case 0: r.src = p.in[8] + (size_t)(l * 2 + 0) * 1024 * 2816; r.K = 1024; r.N = 2816; r.dst = W_GU0; r.mode = 1; break;
    case 1: r.src = p.in[9] + (size_t)(l * 2 + 0) * 1024 * 2816; r.K = 1024; r.N = 2816; r.dst = W_GU0; r.mode = 2; break;
    case 2: r.src = p.in[10] + (size_t)(l * 2 + 0) * 2816 * 1024; r.K = 2816; r.N = 1024; r.dst = W_D0; break;
    case 3: r.src = p.in[8] + (size_t)(l * 2 + 1) * 1024 * 2816; r.K = 1024; r.N = 2816; r.dst = W_GU1; r.mode = 1; break;
    case 4: r.src = p.in[9] + (size_t)(l * 2 + 1) * 1024 * 2816; r.K = 1024; r.N = 2816; r.dst = W_GU1; r.mode = 2; break;
    case 5: r.src = p.in[10] + (size_t)(l * 2 + 1) * 2816 * 1024; r.K = 2816; r.N = 1024; r.dst = W_D1; break;
    case 6: r.src = p.in[11] + (size_t)l * 1024 * 6288; r.K = 1024; r.N = 6288; r.dst = W_IN; break;
    case 7: r.src = p.in[14] + (size_t)(l * 2 + 0) * 64 * 384; r.K = 64; r.N = 384; r.dst = W_WUP0; break;
    case 8: r.src = p.in[14] + (size_t)(l * 2 + 1) * 64 * 384; r.K = 64; r.N = 384; r.dst = W_WUP1; break;
    case 9: r.src = p.in[16] + (size_t)(l * 2 + 0) * 64 * 384; r.K = 64; r.N = 384; r.dst = W_AUP0; break;
    case 10: r.src = p.in[16] + (size_t)(l * 2 + 1) * 64 * 384; r.K = 64; r.N = 384; r.dst = W_AUP1; break;
    case 11: r.src = p.in[17] + (size_t)l * 128 * 384; r.K = 128; r.N = 384; r.dst = W_GUP; break;
    case 12: r.src = p.in[31] + (size_t)l * 256 * 256; r.K = 256; r.N = 256; r.dst = W_GLU; break;
    case 13: r.src = p.in[35] + (size_t)l * 384 * 1024; r.K = 384; r.N = 1024; r.dst = W_UPRW; break;
    case 14: r.src = p.in[36] + (size_t)l * 256 * 1024; r.K = 256; r.N = 1024; r.dst = W_UPS5; break;
    case 15: r.src = p.in[37] + (size_t)l * 384 * 1024; r.K = 384; r.N = 1024; r.dst = W_UPML; break;
    default: r.src = p.in[39] + (size_t)l * 1024 * 1024; r.K = 1024; r.N = 1024; r.dst = W_OUT; break;
  }
  return r;
}
#define NJOBS 17
__device__ void mod_task(const P& p, int t, char* lds) {
  float* sc = (float*)lds;
  float* red = sc + 5 * 1024;
  const int tid = get_tid();
  for (int i = tid; i < 5 * 1024; i += NTHR) {
    int v = i >> 10, k = i & 1023;
    float c = v < 4 ? p.in[1][v * 1024 + k] : p.in[3][k];
    sc[i] = siluf_(c);
  }
  __syncthreads();
  const int c0 = t * 64; const int l = c0 / 9216; const int j0 = c0 % 9216;
  const int col = tid & 63, part = tid >> 6;
  const float* w = p.in[4] + ((size_t)l * 1024 + part * 256) * 9216 + j0 + col;
  float a0 = 0, a1 = 0, a2 = 0, a3 = 0, a4 = 0;
  const float* s = sc + part * 256;
#pragma unroll 8
  for (int i = 0; i < 256; ++i) {
    float wv = w[(size_t)i * 9216];
    a0 += s[i] * wv; a1 += s[1024 + i] * wv; a2 += s[2048 + i] * wv; a3 += s[3072 + i] * wv; a4 += s[4096 + i] * wv;
  }
  red[(part * 5 + 0) * 64 + col] = a0; red[(part * 5 + 1) * 64 + col] = a1; red[(part * 5 + 2) * 64 + col] = a2;
  red[(part * 5 + 3) * 64 + col] = a3; red[(part * 5 + 4) * 64 + col] = a4;
  __syncthreads();
  for (int i = tid; i < 320; i += NTHR) {
    int v = i >> 6, c = i & 63;
    float sum = red[(0 * 5 + v) * 64 + c] + red[(1 * 5 + v) * 64 + c] + red[(2 * 5 + v) * 64 + c] + red[(3 * 5 + v) * 64 + c];
    p.mod[(size_t)(l * 5 + v) * 9216 + j0 + c] = sum + p.in[5][(size_t)l * 9216 + j0 + c];
  }
  __syncthreads();
}
__device__ __forceinline__ void ph_convert(const P& p, int l, bool with_mod, char* lds) {
  const int tid = get_tid();
  int ntiles[NJOBS]; int total = 0;
#pragma unroll
  for (int j = 0; j < NJOBS; ++j) { Job jb = get_job(p, l, j); ntiles[j] = (jb.K >> 6) * ((jb.N + 63) >> 6); total += ntiles[j]; }
  const int nmod = with_mod ? 288 : 0;
  float* tile = (float*)lds;
  for (int t = blockIdx.x; t < total + nmod; t += gridDim.x) {
    if (t < nmod) { mod_task(p, t, lds); continue; }
    int tt = t - nmod; int j = 0;
#pragma unroll
    for (int q = 0; q < NJOBS; ++q) { if (j == q && tt >= ntiles[q]) { tt -= ntiles[q]; j = q + 1; } }
    Job jb = get_job(p, l, j);
    const int nkt = jb.K >> 6;
    const int k0 = (tt % nkt) * 64, n0 = (tt / nkt) * 64;
    {
      const int c = tid & 63, r0 = tid >> 6;
      const bool ok = (n0 + c) < jb.N;
#pragma unroll
      for (int i = 0; i < 16; ++i) { int r = r0 + i * 4; tile[r * 65 + c] = ok ? jb.src[(size_t)(k0 + r) * jb.N + n0 + c] : 0.f; }
    }
    __syncthreads();
    {
      const int nn = tid >> 2, q = tid & 3; const int n = n0 + nn;
      if (n < jb.N) {
        int drow = n;
        if (jb.mode == 1) drow = (n >> 5) * 64 + (n & 31);
        else if (jb.mode == 2) drow = (n >> 5) * 64 + 32 + (n & 31);
        bf16_t* d = p.W + jb.dst + (size_t)drow * jb.K + k0 + q * 16;
        unsigned pk[8];
#pragma unroll
        for (int i = 0; i < 8; ++i) { unsigned lo = f2bf(tile[(q * 16 + 2 * i) * 65 + nn]); unsigned hi = f2bf(tile[(q * 16 + 2 * i + 1) * 65 + nn]); pk[i] = lo | (hi << 16); }
        *(uint4*)d = make_uint4(pk[0], pk[1], pk[2], pk[3]);
        *(uint4*)(d + 8) = make_uint4(pk[4], pk[5], pk[6], pk[7]);
      }
    }
    __syncthreads();
  }
}

__device__ __forceinline__ void ph_rows(const P& p, int mode, int l, int ln_idx, int Mrows, bool writeU, int ul, int ks) {
  const int lane = get_tid() & 63, wid = get_tid() >> 6;
  const int nw = gridDim.x * 4;
  const float* g = p.in[6] + (size_t)(l * 3 + ln_idx) * 1024;
  const float* b = p.in[7] + (size_t)(l * 3 + ln_idx) * 1024;
  for (int m = blockIdx.x * 4 + wid; m < Mrows; m += nw) {
    float* s = srow(p, m);
    const float* src = s;
    if (mode == 0) src = m < M_LAT ? p.in[0] + (size_t)m * 1024 : p.in[2] + (size_t)(m - M_LAT) * 1024;
    float4 v[4];
#pragma unroll
    for (int i = 0; i < 4; ++i) v[i] = *(const float4*)(src + lane * 4 + i * 256);
    if (mode == 1) {
      float sum = 0;
#pragma unroll
      for (int i = 0; i < 4; ++i) sum += v[i].x + v[i].y + v[i].z + v[i].w;
      sum = wavesum(sum);
      const float mean = sum * (1.f / 1024.f);
      float sq = 0;
#pragma unroll
      for (int i = 0; i < 4; ++i) { v[i].x -= mean; v[i].y -= mean; v[i].z -= mean; v[i].w -= mean; sq += v[i].x * v[i].x + v[i].y * v[i].y + v[i].z * v[i].z + v[i].w * v[i].w; }
      sq = wavesum(sq);
      const float rstd = rsqrtf(sq * (1.f / 1024.f) + 1e-5f);
#pragma unroll
      for (int i = 0; i < 4; ++i) {
        float4 gg = *(const float4*)(g + lane * 4 + i * 256), bb = *(const float4*)(b + lane * 4 + i * 256);
        v[i].x = v[i].x * rstd * gg.x + bb.x; v[i].y = v[i].y * rstd * gg.y + bb.y; v[i].z = v[i].z * rstd * gg.z + bb.z; v[i].w = v[i].w * rstd * gg.w + bb.w;
      }
    }
#pragma unroll
    for (int i = 0; i < 4; ++i) *(float4*)(s + lane * 4 + i * 256) = v[i];
    if (writeU) {
      const float* sh = modp(p, ul, m, ks); const float* scl = modp(p, ul, m, ks + 1);
#pragma unroll
      for (int i = 0; i < 4; ++i) {
        float4 a = *(const float4*)(sh + lane * 4 + i * 256), c = *(const float4*)(scl + lane * 4 + i * 256);
        unsigned lo = f2bf(v[i].x * (1.f + c.x) + a.x) | ((unsigned)f2bf(v[i].y * (1.f + c.y) + a.y) << 16);
        unsigned hi = f2bf(v[i].z * (1.f + c.z) + a.z) | ((unsigned)f2bf(v[i].w * (1.f + c.w) + a.w) << 16);
        *(uint2*)(p.U + (size_t)m * 1024 + lane * 4 + i * 256) = make_uint2(lo, hi);
      }
    }
  }
}

__device__ __forceinline__ void ph_ffn_up(const P& p, int s, int Mt, char* lds) {
  EPI_VARS
  bf16_t* HM = (bf16_t*)p.R;
  const bf16_t* Wt = p.W + (s ? W_GU1 : W_GU0);
  const int ntile = Mt * 44;
  for (int t = blockIdx.x; t < ntile; t += gridDim.x) {
    const int tm = t % Mt, tn = t / Mt; const int m0 = tm * 128, n0 = tn * 128;
    f32x4 acc[4][4]; ZERO_ACC(acc)
    gemm_main(p.U + (size_t)m0 * 1024, 1024, Wt + (size_t)n0 * 1024, 1024, 1024, acc, lds);
    const int hb = ((n0 + wc * 64) >> 6) * 32;
#pragma unroll
    for (int m = 0; m < 4; ++m)
#pragma unroll
      for (int n = 0; n < 2; ++n)
#pragma unroll
        for (int j = 0; j < 4; ++j) {
          const int row = m0 + wr * 64 + m * 16 + fq * 4 + j; const int hc = hb + n * 16 + fr;
          HM[(size_t)row * 2816 + hc] = f2bf(siluf_(acc[m][n][j]) * acc[m][n + 2][j]);
        }
  }
}
__device__ __forceinline__ void ph_ffn_down(const P& p, int l, int s, int Mt, char* lds) {
  EPI_VARS
  const bf16_t* HM = (const bf16_t*)p.R;
  const bf16_t* Wt = p.W + (s ? W_D1 : W_D0);
  const int gk = s ? 8 : 2;
  const int ntile = Mt * 8;
  for (int t = blockIdx.x; t < ntile; t += gridDim.x) {
    const int tm = t % Mt, tn = t / Mt; const int m0 = tm * 128, n0 = tn * 128;
    f32x4 acc[4][4]; ZERO_ACC(acc)
    gemm_main(HM + (size_t)m0 * 2816, 2816, Wt + (size_t)n0 * 2816, 2816, 2816, acc, lds);
    EPI_ROW_BEGIN(m0)
      float* sp = srow(p, row) + n0 + wc * 64 + fr; const float* gp = modp(p, l, row, gk) + n0 + wc * 64 + fr;
#pragma unroll
      for (int n = 0; n < 4; ++n) sp[n * 16] = ALPHA * sp[n * 16] + 0.5f * gp[n * 16] * acc[m][n][j];
    EPI_ROW_END
  }
}

#define RW_ZRW(p) ((hf*)(p).R)
#define RW_RKV(p) (RW_ZRW(p) + (size_t)M_ALL * 1152)
#define RW_LA(p) ((bf16_t*)(RW_RKV(p) + (size_t)M_ALL * 1152))
#define RW_KK(p) ((hf*)(RW_LA(p) + (size_t)M_ALL * 256))
#define RW_KD(p) (RW_KK(p) + (size_t)M_ALL * 384)
#define RW_KA(p) (RW_KD(p) + (size_t)2 * M_ALL * 384)
#define RW_YR(p) (RW_KA(p) + (size_t)2 * M_ALL * 384)

#define S5_Z(p) ((float*)(p).R)
#define S5_YG(p) ((bf16_t*)(S5_Z(p) + (size_t)M_ALL * 256))
#define S5_E(p) ((float2*)(S5_YG(p) + (size_t)M_ALL * 256))
#define S5_X(p) (S5_E(p) + (size_t)2 * 4 * 132 * 1024)

#define ML_Z(p) ((hf*)(p).R)
#define ML_GL(p) ((float*)(ML_Z(p) + (size_t)M_ALL * 1536))
#define ML_QK(p) ((hf*)(ML_GL(p) + (size_t)M_ALL * 16))
#define ML_DC(p) ((float*)(ML_QK(p) + (size_t)M_ALL * 768))
#define ML_DN(p) (ML_DC(p) + (size_t)4224 * 9216)
#define ML_SC(p) (ML_DN(p) + (size_t)4224 * 96)
#define ML_MP(p) (ML_SC(p) + (size_t)4224 * 2)

__device__ __forceinline__ void ph_z_rw(const P& p, char* lds) {
  EPI_VARS
  hf* ZRW = RW_ZRW(p); bf16_t* LA = RW_LA(p);
  const int Mt = 264; const int ntile = Mt * 11;
  for (int t = blockIdx.x; t < ntile; t += gridDim.x) {
    const int tm = t % Mt, tn = t / Mt; const int m0 = tm * 128;
    const int wrow = tn < 9 ? tn * 128 : 2960 + (tn - 9) * 128;
    f32x4 acc[4][4]; ZERO_ACC(acc)
    gemm_main(p.U + (size_t)m0 * 1024, 1024, p.W + W_IN + (size_t)wrow * 1024, 1024, 1024, acc, lds);
    if (tn < 9) {
      EPI_BEGIN(m0, tn * 128)
        ZRW[(size_t)row * 1152 + col] = (hf)val;
      EPI_END
    } else {
      EPI_BEGIN(m0, (tn - 9) * 128)
        float o = col < 64 ? tanhf(val) : (col < 128 ? val : sigmoidf_(val));
        LA[(size_t)row * 256 + col] = f2bf(o);
      EPI_END
    }
  }
}
__device__ __forceinline__ void ph_z_s5(const P& p, char* lds) {
  EPI_VARS
  float* Z = S5_Z(p);
  const int Mt = 264; const int ntile = Mt * 2;
  for (int t = blockIdx.x; t < ntile; t += gridDim.x) {
    const int tm = t % Mt, tn = t / Mt; const int m0 = tm * 128;
    f32x4 acc[4][4]; ZERO_ACC(acc)
    gemm_main(p.U + (size_t)m0 * 1024, 1024, p.W + W_IN + (size_t)(2704 + tn * 128) * 1024, 1024, 1024, acc, lds);
    EPI_BEGIN(m0, tn * 128)
      Z[(size_t)row * 256 + col] = val;
    EPI_END
  }
}
__device__ __forceinline__ void ph_z_ml(const P& p, char* lds) {
  EPI_VARS
  hf* Z = ML_Z(p); float* GL = ML_GL(p);
  const int Mt = 264; const int ntile = Mt * 13;
  for (int t = blockIdx.x; t < ntile; t += gridDim.x) {
    const int tm = t % Mt, tn = t / Mt; const int m0 = tm * 128;
    f32x4 acc[4][4]; ZERO_ACC(acc)
    gemm_main(p.U + (size_t)m0 * 1024, 1024, p.W + W_IN + (size_t)(1152 + tn * 128) * 1024, 1024, 1024, acc, lds);
    if (tn < 12) {
      EPI_BEGIN(m0, tn * 128)
        Z[(size_t)row * 1536 + col] = (hf)val;
      EPI_END
    } else {
      EPI_BEGIN(m0, 0)
        if (col < 16) GL[(size_t)row * 16 + col] = val;
      EPI_END
    }
  }
}

__device__ __forceinline__ void ph_conv(const P& p, int l, int which) {
  const int nch = which == 0 ? 144 : 96;
  const int ldin = which == 0 ? 1152 : 1536;
  const hf* Zin = which == 0 ? RW_ZRW(p) : ML_Z(p);
  const int cbase = which == 0 ? 0 : 1152;
  const float* cw = p.in[12] + (size_t)l * 9 * 1920;
  const size_t total = (size_t)M_ALL * nch;
  for (size_t idx = (size_t)blockIdx.x * NTHR + get_tid(); idx < (total + 63) / 64 * 64; idx += (size_t)gridDim.x * NTHR) {
    const bool act = idx < total;
    const int m = act ? (int)(idx / nch) : 0; const int ch = act ? (int)(idx % nch) : 0; const int c0 = ch * 8;
    float o[8];
#pragma unroll
    for (int i = 0; i < 8; ++i) o[i] = 0.f;
    if (m < M_LAT) {
      const int bb = m >> 13, tt = m & 8191, gr = tt >> 6, gc = tt & 63;
#pragma unroll
      for (int dr = -1; dr <= 1; ++dr)
#pragma unroll
        for (int dc = -1; dc <= 1; ++dc) {
          const int rr = gr + dr, cc = gc + dc;
          if (rr >= 0 && rr < 128 && cc >= 0 && cc < 64) {
            const int mm = (bb << 13) + rr * 64 + cc;
            hf8 z = *(const hf8*)(Zin + (size_t)mm * ldin + c0);
            const float* w = cw + ((dr + 1) * 3 + (dc + 1)) * 1920 + cbase + c0;
            float4 w0 = *(const float4*)w, w1 = *(const float4*)(w + 4);
            o[0] += (float)z[0] * w0.x; o[1] += (float)z[1] * w0.y; o[2] += (float)z[2] * w0.z; o[3] += (float)z[3] * w0.w;
            o[4] += (float)z[4] * w1.x; o[5] += (float)z[5] * w1.y; o[6] += (float)z[6] * w1.z; o[7] += (float)z[7] * w1.w;
          }
        }
    } else {
      const int tt = (m - M_LAT) & 255;
#pragma unroll
      for (int dc = -1; dc <= 1; ++dc) {
        const int t2 = tt + dc;
        if (t2 >= 0 && t2 < 256) {
          hf8 z = *(const hf8*)(Zin + (size_t)(m + dc) * ldin + c0);
          const float* w = cw + (3 + (dc + 1)) * 1920 + cbase + c0;
          float4 w0 = *(const float4*)w, w1 = *(const float4*)(w + 4);
          o[0] += (float)z[0] * w0.x; o[1] += (float)z[1] * w0.y; o[2] += (float)z[2] * w0.z; o[3] += (float)z[3] * w0.w;
          o[4] += (float)z[4] * w1.x; o[5] += (float)z[5] * w1.y; o[6] += (float)z[6] * w1.z; o[7] += (float)z[7] * w1.w;
        }
      }
    }
    if (which == 0) {
      const bool isk = act && (c0 >= 384) && (c0 < 768);
      float kkv[8]; float ss = 0.f;
      if (isk) {
        const float* kkw = p.in[18] + (size_t)l * 384 + (c0 - 384);
#pragma unroll
        for (int i = 0; i < 8; ++i) { kkv[i] = o[i] * kkw[i]; ss += kkv[i] * kkv[i]; }
      } else {
#pragma unroll
        for (int i = 0; i < 8; ++i) kkv[i] = 0.f;
      }
      ss += __shfl_xor(ss, 1); ss += __shfl_xor(ss, 2); ss += __shfl_xor(ss, 4);
      if (act) {
        hf8 ov;
#pragma unroll
        for (int i = 0; i < 8; ++i) ov[i] = (hf)o[i];
        *(hf8*)(RW_RKV(p) + (size_t)m * 1152 + c0) = ov;
        if (isk) {
          const float rn = rsqrtf(fmaxf(ss, 1e-24f));
          hf8 kv;
#pragma unroll
          for (int i = 0; i < 8; ++i) kv[i] = (hf)(kkv[i] * rn);
          *(hf8*)(RW_KK(p) + (size_t)m * 384 + (c0 - 384)) = kv;
        }
      }
    } else if (act) {
      const float sc = c0 >= 384 ? 0.10206207261596575f : 1.f;
      hf8 ov;
#pragma unroll
      for (int i = 0; i < 8; ++i) ov[i] = (hf)(siluf_(o[i]) * sc);
      *(hf8*)(ML_QK(p) + (size_t)m * 768 + c0) = ov;
    }
  }
}

__device__ __forceinline__ void ph_lora(const P& p, int l, char* lds) {
  EPI_VARS
  hf* ZRW = RW_ZRW(p); const hf* RKV = RW_RKV(p); const bf16_t* LA = RW_LA(p); const hf* KK = RW_KK(p);
  hf* KD = RW_KD(p); hf* KA = RW_KA(p);
  const int Mt = 264; const int ntile = Mt * 15;
  for (int t = blockIdx.x; t < ntile; t += gridDim.x) {
    const int tm = t % Mt, q = t / Mt; const int job = q / 3, tn = q % 3; const int m0 = tm * 128, n0 = tn * 128;
    f32x4 acc[4][4]; ZERO_ACC(acc)
    if (job < 2) {
      const int d = job;
      gemm_main(LA + (size_t)m0 * 256, 256, p.W + (d ? W_WUP1 : W_WUP0) + (size_t)n0 * 64, 64, 64, acc, lds);
      const float* w0 = p.in[13] + (size_t)(l * 2 + d) * 384;
      EPI_BEGIN(m0, n0)
        const float e = sigmoidf_(w0[col] + val) * 0.6065306597126334f;
        ZRW[(size_t)row * 1152 + d * 384 + col] = (hf)(-expm1f(-e));
      EPI_END
    } else if (job < 4) {
      const int d = job - 2;
      gemm_main(LA + (size_t)m0 * 256 + 64, 256, p.W + (d ? W_AUP1 : W_AUP0) + (size_t)n0 * 64, 64, 64, acc, lds);
      const float* a0 = p.in[15] + (size_t)(l * 2 + d) * 384; const float* kaw = p.in[19] + (size_t)l * 384;
      EPI_ROW_BEGIN(m0)
        const int cb = n0 + wc * 64 + fr;
        const hf* kp = RKV + (size_t)row * 1152 + 384 + cb; const hf* kkp = KK + (size_t)row * 384 + cb;
        hf* kdp = KD + ((size_t)d * M_ALL + row) * 384 + cb; hf* kap = KA + ((size_t)d * M_ALL + row) * 384 + cb;
#pragma unroll
        for (int n = 0; n < 4; ++n) {
          const float a = sigmoidf_(a0[cb + n * 16] + acc[m][n][j]);
          kdp[n * 16] = (hf)((float)kp[n * 16] * (1.f + (a - 1.f) * kaw[cb + n * 16]));
          kap[n * 16] = (hf)((float)kkp[n * 16] * a);
        }
      EPI_ROW_END
    } else {
      gemm_main(LA + (size_t)m0 * 256 + 128, 256, p.W + W_GUP + (size_t)n0 * 128, 128, 128, acc, lds);
      EPI_BEGIN(m0, n0)
        ZRW[(size_t)row * 1152 + 768 + col] = (hf)val;
      EPI_END
    }
  }
}

#define RW_CH 32
#define RW_BUF 21504
__device__ __forceinline__ void ph_rwscan(const P& p, char* lds) {
  const hf* ZRW = RW_ZRW(p); hf* RKV = RW_RKV(p); const hf* KK = RW_KK(p);
  const int tid = get_tid(), lane = tid & 63, wid = tid >> 6;
  char* ybuf = lds + 3 * RW_BUF;
  for (int t = blockIdx.x; t < 192; t += gridDim.x) {
    const int rqq = t & 3, h = (t >> 2) % 6, b = (t / 24) & 3, d = t / 96;
    const int rsub = lane >> 4, g = lane & 15; const int rl = wid * 4 + rsub;
    const int sgn = d ? -1 : 1;
    const int sstep = tid >> 3, sseg = tid & 7;
    const hf* g_r = RKV + h * 64 + sseg * 8; const hf* g_kk = KK + h * 64 + sseg * 8; const hf* g_dd = ZRW + d * 384 + h * 64 + sseg * 8;
    const hf* g_kd = RW_KD(p) + (size_t)d * M_ALL * 384 + h * 64 + sseg * 8; const hf* g_ka = RW_KA(p) + (size_t)d * M_ALL * 384 + h * 64 + sseg * 8;
    const hf* g_v = RKV + 768 + h * 64 + rqq * 16 + (tid & 1) * 8;
    hf* g_y = d == 0 ? (RKV + 384 + h * 64 + rqq * 16 + (tid & 1) * 8) : (RW_YR(p) + h * 64 + rqq * 16 + (tid & 1) * 8);
    const int ldy = d == 0 ? 1152 : 384;
    uint4 q0, q1, q2, q3, q4, q5;
#define RW_M0(pp) ((pp) < 256 ? (M_LAT + b * 256 + (d ? 255 - (pp) : (pp))) : (b * 8192 + (d ? 8447 - (pp) : (pp) - 256)))
#define RW_GLOAD(c) { const int mb_ = RW_M0((c) * RW_CH); const size_t mm = (size_t)(mb_ + sgn * sstep); \
      q0 = *(const uint4*)(g_r + mm * 1152); q1 = *(const uint4*)(g_kk + mm * 384); q2 = *(const uint4*)(g_dd + mm * 1152); \
      q3 = *(const uint4*)(g_kd + mm * 384); q4 = *(const uint4*)(g_ka + mm * 384); \
      if (tid < 64) { const size_t mv = (size_t)(mb_ + sgn * (tid >> 1)); q5 = *(const uint4*)(g_v + mv * 1152); } }
#define RW_SSTORE(c) { char* bb_ = lds + ((c) % 3) * RW_BUF + sstep * 128 + sseg * 16; \
      *(uint4*)(bb_) = q0; *(uint4*)(bb_ + 4096) = q1; *(uint4*)(bb_ + 8192) = q2; *(uint4*)(bb_ + 12288) = q3; *(uint4*)(bb_ + 16384) = q4; \
      if (tid < 64) *(uint4*)(lds + ((c) % 3) * RW_BUF + 20480 + tid * 16) = q5; }
    float S0 = 0.f, S1 = 0.f, S2 = 0.f, S3 = 0.f;
    RW_GLOAD(0) RW_SSTORE(0)
    RW_GLOAD(1) RW_SSTORE(1)
    __syncthreads();
    const int NCH = 8448 / RW_CH;
    for (int c = 0; c < NCH; ++c) {
      if (c + 2 < NCH) RW_GLOAD(c + 2)
      if (c > 0 && tid < 64) {
        const int mb_ = RW_M0((c - 1) * RW_CH); const size_t mv = (size_t)(mb_ + sgn * (tid >> 1));
        *(uint4*)(g_y + mv * ldy) = *(const uint4*)(ybuf + ((c - 1) & 1) * 1024 + tid * 16);
      }
      const char* cb = lds + (c % 3) * RW_BUF + g * 8;
      hf* yb = (hf*)(ybuf + (c & 1) * 1024) + rl;
#pragma unroll
      for (int s = 0; s < RW_CH; ++s) {
        const hf4 r4 = *(const hf4*)(cb + s * 128), k4 = *(const hf4*)(cb + 4096 + s * 128), d4 = *(const hf4*)(cb + 8192 + s * 128);
        const hf4 kd4 = *(const hf4*)(cb + 12288 + s * 128), ka4 = *(const hf4*)(cb + 16384 + s * 128);
        const float vv = (float)*(const hf*)(lds + (c % 3) * RW_BUF + 20480 + s * 32 + rl * 2);
        float sa = S0 * (float)k4[0] + S1 * (float)k4[1] + S2 * (float)k4[2] + S3 * (float)k4[3];
        sa = rowsum16(sa);
        S0 = fmaf(-S0, (float)d4[0], S0); S1 = fmaf(-S1, (float)d4[1], S1); S2 = fmaf(-S2, (float)d4[2], S2); S3 = fmaf(-S3, (float)d4[3], S3);
        S0 = fmaf(-sa, (float)ka4[0], S0); S1 = fmaf(-sa, (float)ka4[1], S1); S2 = fmaf(-sa, (float)ka4[2], S2); S3 = fmaf(-sa, (float)ka4[3], S3);
        S0 = fmaf(vv, (float)kd4[0], S0); S1 = fmaf(vv, (float)kd4[1], S1); S2 = fmaf(vv, (float)kd4[2], S2); S3 = fmaf(vv, (float)kd4[3], S3);
        float y = S0 * (float)r4[0] + S1 * (float)r4[1] + S2 * (float)r4[2] + S3 * (float)r4[3];
        y = rowsum16(y);
        if (g == 0) yb[s * 16] = (hf)y;
      }
      if (c + 2 < NCH) RW_SSTORE(c + 2)
      __syncthreads();
    }
    if (tid < 64) {
      const int mb_ = RW_M0((NCH - 1) * RW_CH); const size_t mv = (size_t)(mb_ + sgn * (tid >> 1));
      *(uint4*)(g_y + mv * ldy) = *(const uint4*)(ybuf + ((NCH - 1) & 1) * 1024 + tid * 16);
    }
    __syncthreads();
  }
}

__device__ __forceinline__ void ph_rwpost(const P& p, int l) {
  const hf* ZRW = RW_ZRW(p); const hf* RKV = RW_RKV(p); const hf* YR = RW_YR(p);
  const int lane = get_tid() & 63, wid = get_tid() >> 6;
  const int nw = gridDim.x * 4;
  for (int t = blockIdx.x * 4 + wid; t < M_ALL * 6; t += nw) {
    const int m = t / 6, h = t % 6; const int c = h * 64 + lane;
    const float ys = (float)RKV[(size_t)m * 1152 + 384 + c] + (float)YR[(size_t)m * 384 + c];
    const float mean = wavesum(ys) * (1.f / 64.f);
    const float xc = ys - mean;
    const float var = wavesum(xc * xc) * (1.f / 64.f);
    float y = xc * rsqrtf(var + 64e-5f) * p.in[21][(size_t)l * 384 + c] + p.in[22][(size_t)l * 384 + c];
    const float r = (float)RKV[(size_t)m * 1152 + c], v = (float)RKV[(size_t)m * 1152 + 768 + c];
    const float rk = p.in[20][(size_t)l * 384 + c];
    const float kd0 = (float)RW_KD(p)[(size_t)m * 384 + c], kd1 = (float)RW_KD(p)[((size_t)M_ALL + m) * 384 + c];
    const float bs = wavesum(r * (kd0 + kd1) * rk);
    y = (y + bs * v) * (float)ZRW[(size_t)m * 1152 + 768 + c];
    p.Y[(size_t)m * 1024 + c] = f2bf(y);
  }
}

struct S5C { float ar, ai; float br[16], bi[16]; };
__device__ __forceinline__ void s5_consts(const P& p, int l, int d, int g, int n, S5C& c) {
  const int ig = (l * 2 + d) * 16 + g;
  const float lr = fminf(p.in[23][(size_t)ig * 64 + n], -1e-4f), li = p.in[24][(size_t)ig * 64 + n];
  const float dt = expf(p.in[25][ig]);
  const float mag = expf(lr * dt);
  c.ar = mag * cosf(li * dt); c.ai = mag * sinf(li * dt);
  const float nr = c.ar - 1.f, ni = c.ai; const float den = 1.f / (lr * lr + li * li);
  const float cr = (nr * lr + ni * li) * den, ci = (ni * lr - nr * li) * den;
  const float* bre = p.in[26] + ((size_t)ig * 64 + n) * 16; const float* bim = p.in[27] + ((size_t)ig * 64 + n) * 16;
#pragma unroll
  for (int h = 0; h < 16; ++h) { const float xr = bre[h], xi = bim[h]; c.br[h] = cr * xr - ci * xi; c.bi[h] = cr * xi + ci * xr; }
}
__device__ __forceinline__ int s5_m0(int b, int tc) { return tc < 128 ? b * 8192 + tc * 64 : M_LAT + b * 256 + (tc - 128) * 64; }
__device__ __forceinline__ int chain_pos(int d, int tc) { return d == 0 ? (tc < 128 ? tc + 4 : tc - 128) : (tc < 128 ? 131 - tc : 131 - tc); }
__device__ __forceinline__ void ph_s5_pass(const P& p, int l, int pass, char* lds) {
  const int lane = get_tid() & 63, wid = get_tid() >> 6;
  float* ub = (float*)lds + wid * 2048;
  float* yb = ub + 1024;
  const float* Z = S5_Z(p); float2* E = S5_E(p); const float2* X = S5_X(p); bf16_t* YG = S5_YG(p);
  const int nw = gridDim.x * 4;
  for (int t = blockIdx.x * 4 + wid; t < 4 * 132 * 16; t += nw) {
    const int g = t & 15, tc = (t >> 4) % 132, b = t / (16 * 132);
    const int m0 = s5_m0(b, tc);
#pragma unroll
    for (int i = 0; i < 4; ++i) { const int e = lane + i * 64; const int tok = e >> 2, q = e & 3;
      *(float4*)(ub + tok * 16 + q * 4) = *(const float4*)(Z + (size_t)(m0 + tok) * 256 + g * 16 + q * 4); }
    __builtin_amdgcn_s_waitcnt(0);
    __builtin_amdgcn_wave_barrier();
    for (int d = 0; d < 2; ++d) {
      S5C c; s5_consts(p, l, d, g, lane, c);
      const int cp = chain_pos(d, tc);
      const size_t sidx = (((size_t)(d * 4 + b) * 132 + cp) * 16 + g) * 64 + lane;
      float xr = 0.f, xi = 0.f;
      float cre[16], cim[16];
      if (pass == 3) {
        float2 x0 = X[sidx]; xr = x0.x; xi = x0.y;
        const int ig = (l * 2 + d) * 16 + g;
#pragma unroll
        for (int h = 0; h < 16; ++h) { cre[h] = p.in[28][((size_t)ig * 16 + h) * 64 + lane]; cim[h] = p.in[29][((size_t)ig * 16 + h) * 64 + lane]; }
      }
      for (int j = 0; j < 64; ++j) {
        const int tok = d ? 63 - j : j;
        float br = 0.f, bi = 0.f;
        const float* u = ub + tok * 16;
#pragma unroll
        for (int h = 0; h < 16; ++h) { const float uv = u[h]; br += c.br[h] * uv; bi += c.bi[h] * uv; }
        const float nr = c.ar * xr - c.ai * xi + br, ni = c.ar * xi + c.ai * xr + bi;
        xr = nr; xi = ni;
        if (pass == 3) {
          float pp[16];
#pragma unroll
          for (int h = 0; h < 16; ++h) pp[h] = cre[h] * xr - cim[h] * xi;
#pragma unroll
          for (int i = 0; i < 8; ++i) { const bool hi = lane & 1; float snd = hi ? pp[i] : pp[i + 8]; float rcv = __shfl_xor(snd, 1); pp[i] = (hi ? pp[i + 8] : pp[i]) + rcv; }
#pragma unroll
          for (int i = 0; i < 4; ++i) { const bool hi = lane & 2; float snd = hi ? pp[i] : pp[i + 4]; float rcv = __shfl_xor(snd, 2); pp[i] = (hi ? pp[i + 4] : pp[i]) + rcv; }
#pragma unroll
          for (int i = 0; i < 2; ++i) { const bool hi = lane & 4; float snd = hi ? pp[i] : pp[i + 2]; float rcv = __shfl_xor(snd, 4); pp[i] = (hi ? pp[i + 2] : pp[i]) + rcv; }
          { const bool hi = lane & 8; float snd = hi ? pp[0] : pp[1]; float rcv = __shfl_xor(snd, 8); pp[0] = (hi ? pp[1] : pp[0]) + rcv; }
          float tot = pp[0]; tot += __shfl_xor(tot, 16); tot += __shfl_xor(tot, 32);
          if (lane < 16) {
            const int hh = ((lane & 1) ? 8 : 0) + ((lane & 2) ? 4 : 0) + ((lane & 4) ? 2 : 0) + ((lane & 8) ? 1 : 0);
            if (d == 0) yb[tok * 16 + hh] = tot; else yb[tok * 16 + hh] += tot;
          }
        }
      }
      if (pass == 1) E[sidx] = make_float2(xr, xi);
    }
    if (pass == 3) {
      __builtin_amdgcn_s_waitcnt(0);
      __builtin_amdgcn_wave_barrier();
#pragma unroll
      for (int i = 0; i < 16; ++i) {
        const int e = lane + i * 64; const int tok = e >> 4, h = e & 15;
        float y = yb[e] + p.in[30][(size_t)l * 256 + g * 16 + h] * ub[e];
        const float inner = 0.7978845608028654f * (y + 0.044715f * y * y * y);
        y = 0.5f * y * (1.f + tanhf(inner));
        YG[(size_t)(m0 + tok) * 256 + g * 16 + h] = f2bf(y);
      }
    }
    __builtin_amdgcn_s_waitcnt(0);
    __builtin_amdgcn_wave_barrier();
  }
}
__device__ __forceinline__ void ph_s5_carry(const P& p, int l) {
  const float2* E = S5_E(p); float2* X = S5_X(p);
  for (int t = blockIdx.x * NTHR + get_tid(); t < 8192; t += gridDim.x * NTHR) {
    const int n = t & 63, g = (t >> 6) & 15, b = (t >> 10) & 3, d = t >> 12;
    const int ig = (l * 2 + d) * 16 + g;
    const float lr = fminf(p.in[23][(size_t)ig * 64 + n], -1e-4f), li = p.in[24][(size_t)ig * 64 + n];
    const float dt = expf(p.in[25][ig]);
    const float mag = expf(lr * dt * 64.f);
    float ar = expf(lr * dt) * cosf(li * dt), ai = expf(lr * dt) * sinf(li * dt);
#pragma unroll
    for (int i = 0; i < 6; ++i) { const float r2 = ar * ar - ai * ai, i2 = 2.f * ar * ai; ar = r2; ai = i2; }
    (void)mag;
    float xr = 0.f, xi = 0.f;
    for (int cp = 0; cp < 132; ++cp) {
      const size_t idx = (((size_t)(d * 4 + b) * 132 + cp) * 16 + g) * 64 + n;
      X[idx] = make_float2(xr, xi);
      const float2 e = E[idx];
      const float nr = ar * xr - ai * xi + e.x, ni = ar * xi + ai * xr + e.y;
      xr = nr; xi = ni;
    }
  }
}
__device__ __forceinline__ void ph_glu(const P& p, int l, char* lds) {
  EPI_VARS
  const bf16_t* YG = S5_YG(p);
  const int Mt = 264; const int ntile = Mt * 2;
  const float* gb = p.in[32] + (size_t)l * 256;
  for (int t = blockIdx.x; t < ntile; t += gridDim.x) {
    const int tm = t % Mt, tn = t / Mt; const int m0 = tm * 128, n0 = tn * 128;
    f32x4 acc[4][4]; ZERO_ACC(acc)
    gemm_main(YG + (size_t)m0 * 256, 256, p.W + W_GLU + (size_t)n0 * 256, 256, 256, acc, lds);
    EPI_BEGIN(m0, n0)
      const float y = bf2f(YG[(size_t)row * 256 + col]);
      p.Y[(size_t)row * 1024 + 384 + col] = f2bf(y * sigmoidf_(val + gb[col]));
    EPI_END
  }
}

__device__ __forceinline__ float logsigf_(float x) { return fminf(x, 0.f) - log1pf(__expf(-fabsf(x))); }
__device__ __forceinline__ void ml_gates(const P& p, int l, int d, int h, int m0, int lane, float& bcum, float& ic) {
  const int tok = d ? 63 - lane : lane;
  const float* gl = ML_GL(p) + (size_t)(m0 + tok) * 16;
  const float* gb = p.in[33] + (size_t)(l * 2 + d) * 8;
  ic = gl[d * 8 + h] + gb[h];
  float f = logsigf_(gl[d * 8 + 4 + h] + gb[4 + h]);
#pragma unroll
  for (int o = 1; o < 64; o <<= 1) { float v = __shfl_up(f, o); if (lane >= o) f += v; }
  bcum = f;
}
#define MLP 104
__device__ __forceinline__ void ph_ml_a(const P& p, int l, char* lds) {
  hf* ks = (hf*)lds; hf* vs = ks + 64 * MLP; float* wg = (float*)(vs + 64 * MLP);
  const int tid = get_tid(), lane = tid & 63, wid = tid >> 6;
  const hf* QK = ML_QK(p); const hf* Z = ML_Z(p);
  for (int t = blockIdx.x; t < 4224; t += gridDim.x) {
    const int tc = t % 132, h = (t / 132) & 3, b = (t / 528) & 3, d = t / 2112;
    const int m0 = s5_m0(b, tc); const int cp = chain_pos(d, tc);
    const size_t task = ((size_t)((d * 4 + b) * 4 + h)) * 132 + cp;
    for (int e = tid; e < 64 * 12; e += NTHR) {
      const int j = e / 12, q = e % 12; const int tok = d ? 63 - j : j;
      *(hf8*)(ks + j * MLP + q * 8) = *(const hf8*)(QK + (size_t)(m0 + tok) * 768 + 384 + h * 96 + q * 8);
      *(hf8*)(vs + j * MLP + q * 8) = *(const hf8*)(Z + (size_t)(m0 + tok) * 1536 + 768 + h * 96 + q * 8);
    }
    if (wid == 0) {
      float bcum, ic; ml_gates(p, l, d, h, m0, lane, bcum, ic);
      const float blast = __shfl(bcum, 63);
      const float lw = blast - bcum + ic;
      float mx = lw;
      for (int o = 32; o > 0; o >>= 1) mx = fmaxf(mx, __shfl_xor(mx, o));
      wg[lane] = __expf(lw - mx);
      if (lane == 0) { ML_SC(p)[task * 2] = mx; ML_SC(p)[task * 2 + 1] = blast; }
    }
    __syncthreads();
    const int tk = tid >> 4, tv = tid & 15;
    float acc[6][6];
#pragma unroll
    for (int a = 0; a < 6; ++a)
#pragma unroll
      for (int c = 0; c < 6; ++c) acc[a][c] = 0.f;
    for (int j = 0; j < 64; ++j) {
      const float w = wg[j];
      float kv[6], vv[6];
#pragma unroll
      for (int a = 0; a < 6; ++a) { kv[a] = w * (float)ks[j * MLP + tk * 6 + a]; vv[a] = (float)vs[j * MLP + tv * 6 + a]; }
#pragma unroll
      for (int a = 0; a < 6; ++a)
#pragma unroll
        for (int c = 0; c < 6; ++c) acc[a][c] += kv[a] * vv[c];
    }
    float* dc = ML_DC(p) + task * 9216;
#pragma unroll
    for (int a = 0; a < 6; ++a)
#pragma unroll
      for (int c = 0; c < 6; ++c) dc[(tk * 6 + a) * 96 + tv * 6 + c] = acc[a][c];
    if (tid < 96) {
      float s = 0.f;
      for (int j = 0; j < 64; ++j) s += wg[j] * (float)ks[j * MLP + tid];
      ML_DN(p)[task * 96 + tid] = s;
    }
    __syncthreads();
  }
}
__device__ __forceinline__ void ph_ml_b(const P& p) {
  float* DC = ML_DC(p); float* DN = ML_DN(p); const float* SC = ML_SC(p); float* MP = ML_MP(p);
  for (int t = blockIdx.x * NTHR + get_tid(); t < 32 * 9312; t += gridDim.x * NTHR) {
    const int chain = t / 9312, e = t % 9312;
    float cur = 0.f, mprev = 0.f;
    for (int cp = 0; cp < 132; ++cp) {
      const size_t task = (size_t)chain * 132 + cp;
      float* slot = e < 9216 ? DC + task * 9216 + e : DN + task * 96 + (e - 9216);
      const float dl = *slot;
      *slot = cur;
      if (e == 0) MP[task] = mprev;
      const float mloc = SC[task * 2], blast = SC[task * 2 + 1];
      const float mnew = fmaxf(blast + mprev, mloc);
      cur = __expf(blast + mprev - mnew) * cur + __expf(mloc - mnew) * dl;
      mprev = mnew;
    }
  }
}
__device__ __forceinline__ void ph_ml_c(const P& p, int l, char* lds) {
  hf* qs = (hf*)lds; hf* ks = qs + 64 * MLP; hf* vs = ks + 64 * MLP;
  float* Sm = (float*)(vs + 64 * MLP);
  float* bc = Sm + 64 * 65; float* icv = bc + 64; float* mr = icv + 64; float* inter = mr + 64; float* den = inter + 64; float* nst = den + 64;
  const int tid = get_tid(), lane = tid & 63, wid = tid >> 6;
  const hf* QK = ML_QK(p); const hf* Z = ML_Z(p);
  const int tj = tid >> 4, tv = tid & 15;
  for (int t = blockIdx.x; t < 2112; t += gridDim.x) {
    const int tc = t % 132, h = (t / 132) & 3, b = t / 528;
    const int m0 = s5_m0(b, tc);
    float hs[4][6];
#pragma unroll
    for (int a = 0; a < 4; ++a)
#pragma unroll
      for (int c = 0; c < 6; ++c) hs[a][c] = 0.f;
    for (int d = 0; d < 2; ++d) {
      const int cp = chain_pos(d, tc);
      const size_t task = ((size_t)((d * 4 + b) * 4 + h)) * 132 + cp;
      const float mprev = ML_MP(p)[task];
      for (int e = tid; e < 64 * 12; e += NTHR) {
        const int j = e / 12, q = e % 12; const int tok = d ? 63 - j : j;
        *(hf8*)(qs + j * MLP + q * 8) = *(const hf8*)(QK + (size_t)(m0 + tok) * 768 + h * 96 + q * 8);
        *(hf8*)(ks + j * MLP + q * 8) = *(const hf8*)(QK + (size_t)(m0 + tok) * 768 + 384 + h * 96 + q * 8);
        *(hf8*)(vs + j * MLP + q * 8) = *(const hf8*)(Z + (size_t)(m0 + tok) * 1536 + 768 + h * 96 + q * 8);
      }
      if (tid < 96) nst[tid] = ML_DN(p)[task * 96 + tid];
      if (wid == 0) { float bcum, ic; ml_gates(p, l, d, h, m0, lane, bcum, ic); bc[lane] = bcum; icv[lane] = ic; }
      __syncthreads();
      const int sj = tid >> 4, ss = tid & 15;
      float qk[4][4];
#pragma unroll
      for (int a = 0; a < 4; ++a)
#pragma unroll
        for (int c = 0; c < 4; ++c) qk[a][c] = 0.f;
      for (int k = 0; k < 96; ++k) {
        float qv[4], kv[4];
#pragma unroll
        for (int a = 0; a < 4; ++a) { qv[a] = (float)qs[(sj * 4 + a) * MLP + k]; kv[a] = (float)ks[(ss * 4 + a) * MLP + k]; }
#pragma unroll
        for (int a = 0; a < 4; ++a)
#pragma unroll
          for (int c = 0; c < 4; ++c) qk[a][c] += qv[a] * kv[c];
      }
      if (tid < 64) {
        const int j = tid; const float bj = bc[j];
        float mx = bj + mprev;
        for (int s = 0; s <= j; ++s) mx = fmaxf(mx, bj - bc[s] + icv[s]);
        mr[j] = mx; inter[j] = __expf(bj + mprev - mx);
      }
      __syncthreads();
#pragma unroll
      for (int a = 0; a < 4; ++a)
#pragma unroll
        for (int c = 0; c < 4; ++c) {
          const int j = sj * 4 + a, s = ss * 4 + c;
          Sm[j * 65 + s] = s <= j ? qk[a][c] * __expf(bc[j] - bc[s] + icv[s] - mr[j]) : 0.f;
        }
      __syncthreads();
      if (tid < 64) {
        const int j = tid; float s1 = 0.f, s2 = 0.f;
        for (int k = 0; k < 96; ++k) s1 += nst[k] * (float)qs[j * MLP + k];
        for (int s = 0; s < 64; ++s) s2 += Sm[j * 65 + s];
        den[j] = inter[j] * s1 + s2;
      }
      const int jb = d ? 60 - 4 * tj : 4 * tj;
      float num[4][6];
#pragma unroll
      for (int a = 0; a < 4; ++a)
#pragma unroll
        for (int c = 0; c < 6; ++c) num[a][c] = 0.f;
      const float* ct = ML_DC(p) + task * 9216 + tv * 6;
      for (int k = 0; k < 96; ++k) {
        float cv[6], qv[4];
        const float2 c0 = *(const float2*)(ct + k * 96), c1 = *(const float2*)(ct + k * 96 + 2), c2 = *(const float2*)(ct + k * 96 + 4);
        cv[0] = c0.x; cv[1] = c0.y; cv[2] = c1.x; cv[3] = c1.y; cv[4] = c2.x; cv[5] = c2.y;
#pragma unroll
        for (int a = 0; a < 4; ++a) qv[a] = (float)qs[(jb + a) * MLP + k];
#pragma unroll
        for (int a = 0; a < 4; ++a)
#pragma unroll
          for (int c = 0; c < 6; ++c) num[a][c] += qv[a] * cv[c];
      }
#pragma unroll
      for (int a = 0; a < 4; ++a) { const float it = inter[jb + a];
#pragma unroll
        for (int c = 0; c < 6; ++c) num[a][c] *= it; }
      for (int s = 0; s < 64; ++s) {
        float sv[4], vv[6];
#pragma unroll
        for (int a = 0; a < 4; ++a) sv[a] = Sm[(jb + a) * 65 + s];
#pragma unroll
        for (int c = 0; c < 6; ++c) vv[c] = (float)vs[s * MLP + tv * 6 + c];
#pragma unroll
        for (int a = 0; a < 4; ++a)
#pragma unroll
          for (int c = 0; c < 6; ++c) num[a][c] += sv[a] * vv[c];
      }
      __syncthreads();
#pragma unroll
      for (int a = 0; a < 4; ++a) {
        const int j = jb + a;
        const float dn = 1.f / fmaxf(fabsf(den[j]), __expf(-mr[j]));
        const int slot = d ? 3 - a : a;
#pragma unroll
        for (int c = 0; c < 6; ++c) hs[slot][c] += num[a][c] * dn;
      }
      __syncthreads();
    }
#pragma unroll
    for (int a = 0; a < 4; ++a) {
      const int m = m0 + tj * 4 + a;
      float x[6]; float s = 0.f;
#pragma unroll
      for (int c = 0; c < 6; ++c) { const float o = (float)Z[(size_t)m * 1536 + 1152 + h * 96 + tv * 6 + c]; x[c] = sigmoidf_(o) * hs[a][c]; s += x[c]; }
      s += __shfl_xor(s, 1); s += __shfl_xor(s, 2); s += __shfl_xor(s, 4); s += __shfl_xor(s, 8);
      const float mean = s * (1.f / 96.f);
      float q = 0.f;
#pragma unroll
      for (int c = 0; c < 6; ++c) { x[c] -= mean; q += x[c] * x[c]; }
      q += __shfl_xor(q, 1); q += __shfl_xor(q, 2); q += __shfl_xor(q, 4); q += __shfl_xor(q, 8);
      const float rs = rsqrtf(q * (1.f / 96.f) + 1e-5f);
#pragma unroll
      for (int c = 0; c < 6; ++c) p.Y[(size_t)m * 1024 + 640 + h * 96 + tv * 6 + c] = f2bf(x[c] * rs * p.in[34][(size_t)l * 384 + h * 96 + tv * 6 + c]);
    }
  }
}

#define MG_YM(p) ((bf16_t*)(p).R)
#define MG_G3(p) (MG_YM(p) + (size_t)M_ALL * 1024)
__device__ __forceinline__ void ph_gates(const P& p, int l, int Mt, char* lds) {
  EPI_VARS
  bf16_t* G3 = MG_G3(p);
  const float* gbias = p.in[38] + (size_t)l * 3072;
  const int ntile = Mt * 24;
  for (int t = blockIdx.x; t < ntile; t += gridDim.x) {
    const int tm = t % Mt, tn = t / Mt; const int m0 = tm * 128, n0 = tn * 128;
    f32x4 acc[4][4]; ZERO_ACC(acc)
    gemm_main(p.U + (size_t)m0 * 1024, 1024, p.W + W_IN + (size_t)(3216 + n0) * 1024, 1024, 1024, acc, lds);
    EPI_BEGIN(m0, n0)
      G3[(size_t)row * 3072 + col] = f2bf(sigmoidf_(val + gbias[col]));
    EPI_END
  }
}
__device__ __forceinline__ void ph_merge(const P& p, int l, int Mt, char* lds) {
  EPI_VARS
  bf16_t* YM = MG_YM(p); const bf16_t* G3 = MG_G3(p);
  const int ntile = Mt * 16;
  for (int t = blockIdx.x; t < ntile; t += gridDim.x) {
    const int tm = t % Mt, tn = t / Mt; const int m0 = tm * 128, n0 = tn * 64;
    f32x4 yacc[4][2];
#pragma unroll
    for (int m = 0; m < 4; ++m) { yacc[m][0] = (f32x4){0.f, 0.f, 0.f, 0.f}; yacc[m][1] = (f32x4){0.f, 0.f, 0.f, 0.f}; }
#pragma unroll 1
    for (int br = 0; br < 3; ++br) {
      f32x4 acc[4][2];
#pragma unroll
      for (int m = 0; m < 4; ++m) { acc[m][0] = (f32x4){0.f, 0.f, 0.f, 0.f}; acc[m][1] = (f32x4){0.f, 0.f, 0.f, 0.f}; }
      const int kb = br == 1 ? 256 : 384; const int yoff = br == 0 ? 0 : (br == 1 ? 384 : 640);
      const int woff = br == 0 ? W_UPRW : (br == 1 ? W_UPS5 : W_UPML);
      gemm_main_t<2>(p.Y + (size_t)m0 * 1024 + yoff, 1024, p.W + woff + (size_t)n0 * kb, kb, kb, acc, lds);
      EPI_ROW_BEGIN(m0)
        const bf16_t* gp = G3 + (size_t)row * 3072 + br * 1024 + n0 + wc * 32 + fr;
#pragma unroll
        for (int n = 0; n < 2; ++n) yacc[m][n][j] += bf2f(gp[n * 16]) * acc[m][n][j];
      EPI_ROW_END
    }
    EPI_ROW_BEGIN(m0)
      bf16_t* yp = YM + (size_t)row * 1024 + n0 + wc * 32 + fr;
#pragma unroll
      for (int n = 0; n < 2; ++n) yp[n * 16] = f2bf(yacc[m][n][j]);
    EPI_ROW_END
  }
}
__device__ __forceinline__ void ph_wout(const P& p, int l, int Mt, char* lds) {
  EPI_VARS
  const bf16_t* YM = (const bf16_t*)p.R;
  const int ntile = Mt * 8;
  for (int t = blockIdx.x; t < ntile; t += gridDim.x) {
    const int tm = t % Mt, tn = t / Mt; const int m0 = tm * 128, n0 = tn * 128;
    f32x4 acc[4][4]; ZERO_ACC(acc)
    gemm_main(YM + (size_t)m0 * 1024, 1024, p.W + W_OUT + (size_t)n0 * 1024, 1024, 1024, acc, lds);
    EPI_ROW_BEGIN(m0)
      float* sp = srow(p, row) + n0 + wc * 64 + fr; const float* gp = modp(p, l, row, 5) + n0 + wc * 64 + fr;
#pragma unroll
      for (int n = 0; n < 4; ++n) sp[n * 16] = ALPHA * sp[n * 16] + gp[n * 16] * acc[m][n][j];
    EPI_ROW_END
  }
}

#define SYNC grid.sync(); asm volatile("" : "+s"(l));
__global__ void __launch_bounds__(NTHR, 2) mega(P pv) {
#define p pv
  __shared__ __attribute__((aligned(16))) char lds[LDS_BYTES];
  cg::grid_group grid = cg::this_grid();
  for (int l = 0; l < 2; ++l) {
    const bool last = (l == 1);
    const int Mt2 = last ? 256 : 264;
    const int Mr2 = last ? M_LAT : M_ALL;
    ph_convert(p, l, l == 0, lds); SYNC
    if (l == 0) { ph_rows(p, 0, 0, 0, M_ALL, true, 0, 0); SYNC }
    ph_ffn_up(p, 0, 264, lds); SYNC
    ph_ffn_down(p, l, 0, 264, lds); SYNC
    ph_rows(p, 1, l, 0, M_ALL, true, l, 3); SYNC
    ph_z_rw(p, lds); SYNC
    ph_conv(p, l, 0); SYNC
    ph_lora(p, l, lds); SYNC
    ph_rwscan(p, lds); SYNC
    ph_rwpost(p, l); SYNC
    ph_z_s5(p, lds); SYNC
    ph_s5_pass(p, l, 1, lds); SYNC
    ph_s5_carry(p, l); SYNC
    ph_s5_pass(p, l, 3, lds); SYNC
    ph_glu(p, l, lds); SYNC
    ph_z_ml(p, lds); SYNC
    ph_conv(p, l, 1); SYNC
    ph_ml_a(p, l, lds); SYNC
    ph_ml_b(p); SYNC
    ph_ml_c(p, l, lds); SYNC
    ph_gates(p, l, Mt2, lds); SYNC
    ph_merge(p, l, Mt2, lds); SYNC
    ph_wout(p, l, Mt2, lds); SYNC
    ph_rows(p, 1, l, 1, Mr2, true, l, 6); SYNC
    ph_ffn_up(p, 1, Mt2, lds); SYNC
    ph_ffn_down(p, l, 1, Mt2, lds); SYNC
    ph_rows(p, 1, l, 2, Mr2, !last, l + 1, 0);
    if (!last) { SYNC }
  }
#undef p
}

extern "C" void kernel_launch(void* const* d_in, const int* in_sizes, int n_in, void* d_out, int out_size, void* d_ws, size_t ws_size,
                              hipStream_t stream) {
  static int grid_blocks = 0;
  if (!grid_blocks) {
    int dev = 0, cus = 0, per_cu = 0;
    hipGetDevice(&dev);
    hipDeviceGetAttribute(&cus, hipDeviceAttributeMultiprocessorCount, dev);
    hipOccupancyMaxActiveBlocksPerMultiprocessor(&per_cu, mega, NTHR, 0);
    if (per_cu > 2) per_cu = 2;
    grid_blocks = cus * per_cu;
  }
  P p{};
  for (int i = 0; i < 40; ++i) p.in[i] = (const float*)d_in[i];
  char* ws = (char*)d_ws;
  size_t off = 0;
  p.W = (bf16_t*)(ws + off); off += (size_t)W_TOTAL * 2;
  p.mod = (float*)(ws + off); off += (size_t)2 * 5 * 9216 * 4;
  p.sctx = (float*)(ws + off); off += (size_t)1024 * 1024 * 4;
  p.U = (bf16_t*)(ws + off); off += (size_t)M_ALL * 1024 * 2;
  p.Y = (bf16_t*)(ws + off); off += (size_t)M_ALL * 1024 * 2;
  p.R = ws + off;
  p.out = (float*)d_out;
  if (off + (size_t)M_ALL * 9728 > ws_size) fprintf(stderr, "workspace too small: need %zu have %zu\n", off + (size_t)M_ALL * 9728, ws_size);
  void* args[] = {&p};
  hipError_t e = hipLaunchCooperativeKernel((void*)mega, dim3(grid_blocks), dim3(NTHR), args, 0, stream);
  if (e != hipSuccess) fprintf(stderr, "cooperative launch failed: %s (grid %d)\n", hipGetErrorString(e), grid_blocks);
}
```

```cpp
#include <hip/hip_runtime.h>
#include <hip/hip_cooperative_groups.h>
#include <cstdio>
namespace cg = cooperative_groups;

typedef unsigned short bf16_t;
typedef _Float16 hf;
typedef hf hf4 __attribute__((ext_vector_type(4)));
typedef hf hf8 __attribute__((ext_vector_type(8)));
typedef __attribute__((ext_vector_type(8))) short bf16x8;
typedef __attribute__((ext_vector_type(4))) float f32x4;
typedef unsigned int u32x4 __attribute__((ext_vector_type(4)));

#define M_LAT 32768
#define M_ALL 33792
#define NTHR 256
#define LDS_BYTES 73728
#define ALPHA 1.41421356237f

#define W_GU0 0
#define W_D0 5767168
#define W_GU1 8650752
#define W_D1 14417920
#define W_IN 17301504
#define W_WUP0 23740416
#define W_WUP1 23764992
#define W_AUP0 23789568
#define W_AUP1 23814144
#define W_GUP 23838720
#define W_GLU 23887872
#define W_UPRW 23953408
#define W_UPS5 24346624
#define W_UPML 24608768
#define W_OUT 25001984
#define W_TOTAL 26050560

struct P {
  const float* in[40];
  float* out; float* sctx; float* mod;
  bf16_t* U; bf16_t* Y; bf16_t* W; char* R;
};

__device__ __forceinline__ int get_tid() { int t = __builtin_amdgcn_workitem_id_x(); asm volatile("" : "+v"(t)); return t; }
__device__ __forceinline__ bf16_t f2bf(float f) { return __builtin_bit_cast(unsigned short, (_Float16)f); }
__device__ __forceinline__ float bf2f(bf16_t h) { return (float)__builtin_bit_cast(_Float16, h); }
__device__ __forceinline__ float sigmoidf_(float x) { return 1.f / (1.f + __expf(-x)); }
__device__ __forceinline__ float siluf_(float x) { return x / (1.f + __expf(-x)); }
__device__ __forceinline__ float* srow(const P& p, int m) { return m < M_LAT ? p.out + (size_t)m * 1024 : p.sctx + (size_t)(m - M_LAT) * 1024; }
__device__ __forceinline__ const float* modp(const P& p, int l, int m, int k) { int mv = m < M_LAT ? (m >> 13) : 4; return p.mod + (size_t)(l * 5 + mv) * 9216 + k * 1024; }
template <int C> __device__ __forceinline__ float dppf(float x) { return __int_as_float(__builtin_amdgcn_update_dpp(0, __float_as_int(x), C, 0xf, 0xf, false)); }
__device__ __forceinline__ float rowsum16(float x) { x += dppf<0x128>(x); x += dppf<0x124>(x); x += dppf<0x122>(x); x += dppf<0x121>(x); return x; }
__device__ __forceinline__ float wavesum(float x) { for (int o = 32; o > 0; o >>= 1) x += __shfl_xor(x, o); return x; }

template <int NB>
__device__ __forceinline__ void gemm_main_t(const bf16_t* __restrict__ A, int lda, const bf16_t* __restrict__ B, int ldb, int K,
                                          f32x4 (&acc)[4][NB], char* lds) {
  const int tid = get_tid(), lane = tid & 63, wid = tid >> 6, wr = wid >> 1, wc = wid & 1;
  const int fr = lane & 15, fq = lane >> 4;
  const int sr = tid >> 3, skc = tid & 7;
  const bf16_t* ga = A + (size_t)sr * lda + skc * 8;
  const bf16_t* gb = B + (size_t)sr * ldb + skc * 8;
  u32x4 ra0[4], rb0[NB], ra1[4], rb1[NB];
  const int soff = sr * 144 + skc * 16;
  const int nk = K >> 6;
  const int aoff = (wr * 64 + fr) * 144 + fq * 16;
  const int boff = 18432 + (wc * (NB * 16) + fr) * 144 + fq * 16;
#define G_LOAD(RA, RB, kt) { _Pragma("unroll") for (int i = 0; i < 4; ++i) { RA[i] = *(const u32x4*)(ga + (size_t)(i * 32) * lda + (kt) * 64); if (i < NB) RB[i] = *(const u32x4*)(gb + (size_t)(i * 32) * ldb + (kt) * 64); } }
#define G_STORE(RA, RB, buf) { char* d_ = lds + (buf) * 36864 + soff; _Pragma("unroll") for (int i = 0; i < 4; ++i) { *(u32x4*)(d_ + i * 32 * 144) = RA[i]; if (i < NB) *(u32x4*)(d_ + 18432 + i * 32 * 144) = RB[i]; } }
#define G_COMP(buf) { const char* cur = lds + (buf) * 36864; _Pragma("unroll") for (int ks = 0; ks < 2; ++ks) { hf8 af[4], bfr[NB]; \
    _Pragma("unroll") for (int m = 0; m < 4; ++m) af[m] = *(const hf8*)(cur + aoff + m * 16 * 144 + ks * 64); \
    _Pragma("unroll") for (int n = 0; n < NB; ++n) bfr[n] = *(const hf8*)(cur + boff + n * 16 * 144 + ks * 64); \
    _Pragma("unroll") for (int m = 0; m < 4; ++m) _Pragma("unroll") for (int n = 0; n < NB; ++n) acc[m][n] = __builtin_amdgcn_mfma_f32_16x16x32_f16(af[m], bfr[n], acc[m][n], 0, 0, 0); } }
  G_LOAD(ra0, rb0, 0)
  { const int k1 = nk > 1 ? 1 : 0; G_LOAD(ra1, rb1, k1) }
  G_STORE(ra0, rb0, 0)
  __syncthreads();
  for (int kt = 0; kt < nk; kt += 2) {
    { const int k2 = kt + 2 < nk ? kt + 2 : nk - 1; G_LOAD(ra0, rb0, k2) }
    G_COMP(0)
    G_STORE(ra1, rb1, 1)
    __syncthreads();
    { const int k3 = kt + 3 < nk ? kt + 3 : nk - 1; G_LOAD(ra1, rb1, k3) }
    if (kt + 1 < nk) G_COMP(1)
    G_STORE(ra0, rb0, 0)
    __syncthreads();
  }
}
__device__ __forceinline__ void gemm_main(const bf16_t* __restrict__ A, int lda, const bf16_t* __restrict__ B, int ldb, int K, f32x4 (&acc)[4][4], char* lds) {
  gemm_main_t<4>(A, lda, B, ldb, K, acc, lds);
}

__device__ __forceinline__ bool tile_map(int it, int Mt, int Nt, int SN, int& tm, int& tn) {
  const int b = blockIdx.x, xcd = b & 7, li = b >> 3, nloc = gridDim.x >> 3;
  const int T = 8 * SN; const int nsn = Nt / SN; const int nsuper = (Mt >> 3) * nsn;
  const int o = li + it * nloc; const int k = o / T, w = o - k * T;
  const int s = xcd + 8 * k;
  if (s >= nsuper) return false;
  const int sm = s / nsn, sn = s - sm * nsn;
  tm = sm * 8 + (w & 7); tn = sn * SN + (w >> 3);
  return true;
}
#define ZERO_ACC(a) _Pragma("unroll") for (int m_ = 0; m_ < 4; ++m_) _Pragma("unroll") for (int n_ = 0; n_ < 4; ++n_) a[m_][n_] = (f32x4){0.f, 0.f, 0.f, 0.f};
#define EPI_VARS const int tid = get_tid(), lane = tid & 63, wid = tid >> 6, wr = wid >> 1, wc = wid & 1, fr = lane & 15, fq = lane >> 4; (void)wr; (void)wc; (void)fr; (void)fq;
#define EPI_ROW_BEGIN(m0) _Pragma("unroll") for (int m = 0; m < 4; ++m) _Pragma("unroll") for (int j = 0; j < 4; ++j) { const int row = (m0) + wr * 64 + m * 16 + fq * 4 + j; (void)row;
#define EPI_COL_BEGIN(n0) _Pragma("unroll") for (int n = 0; n < 4; ++n) { const int col = (n0) + wc * 64 + n * 16 + fr; const float val = acc[m][n][j]; (void)col; (void)val;
#define EPI_COL_END }
#define EPI_ROW_END }
#define EPI_BEGIN(m0, n0) EPI_ROW_BEGIN(m0) EPI_COL_BEGIN(n0)
#define EPI_END } }

struct Job { const float* src; int K, N; int dst; int mode; };
__device__ __forceinline__ Job get_job(const P& p, int l, int j) {
  Job r; r.mode = 0;
  switch (j) {
    case 0: r.src = p.in[8] + (size_t)(l * 2 + 0) * 1024 * 2816; r.K = 1024; r.N = 2816; r.dst = W_GU0; r.mode = 1; break;
    case 1: r.src = p.in[9] + (size_t)(l * 2 + 0) * 1024 * 2816; r.K = 1024; r.N = 2816; r.dst = W_GU0; r.mode = 2; break;
    case 2: r.src = p.in[10] + (size_t)(l * 2 + 0) * 2816 * 1024; r.K = 2816; r.N = 1024; r.dst = W_D0; break;
    case 3: r.src = p.in[8] + (size_t)(l * 2 + 1) * 1024 * 2816; r.K = 1024; r.N = 2816; r.dst = W_GU1; r.mode = 1; break;
    case 4: r.src = p.in[9] + (size_t)(l * 2 + 1) * 1024 * 2816; r.K = 1024; r.N = 2816; r.dst = W_GU1; r.mode = 2; break;
    case 5: r.src = p.in[10] + (size_t)(l * 2 + 1) * 2816 * 1024; r.K = 2816; r.N = 1024; r.dst = W_D1; break;
    case 6: r.src = p.in[11] + (size_t)l * 1024 * 6288; r.K = 1024; r.N = 6288; r.dst = W_IN; break;
    case 7: r.src = p.in[14] + (size_t)(l * 2 + 0) * 64 * 384; r.K = 64; r.N = 384; r.dst = W_WUP0; break;
    case 8: r.src = p.in[14] + (size_t)(l * 2 + 1) * 64 * 384; r.K = 64; r.N = 384; r.dst = W_WUP1; break;
    case 9: r.src = p.in[16] + (size_t)(l * 2 + 0) * 64 * 384; r.K = 64; r.N = 384; r.dst = W_AUP0; break;
    case 10: r.src = p.in[16] + (size_t)(l * 2 + 1) * 64 * 384; r.K = 64; r.N = 384; r.dst = W_AUP1; break;
    case 11: r.src = p.in[17] + (size_t)l * 128 * 384; r.K = 128; r.N = 384; r.dst = W_GUP; break;
    case 12: r.src = p.in[31] + (size_t)l * 256 * 256; r.K = 256; r.N = 256; r.dst = W_GLU; break;
    case 13: r.src = p.in[35] + (size_t)l * 384 * 1024; r.K = 384; r.N = 1024; r.dst = W_UPRW; break;
    case 14: r.src = p.in[36] + (size_t)l * 256 * 1024; r.K = 256; r.N = 1024; r.dst = W_UPS5; break;
    case 15: r.src = p.in[37] + (size_t)l * 384 * 1024; r.K = 384; r.N = 1024; r.dst = W_UPML; break;
    default: r.src = p.in[39] + (size_t)l * 1024 * 1024; r.K = 1024; r.N = 1024; r.dst = W_OUT; break;
  }
  return r;
}
#define NJOBS 17
__device__ void mod_task(const P& p, int t, char* lds) {
  float* sc = (float*)lds;
  float* red = sc + 5 * 1024;
  const int tid = get_tid();
  for (int i = tid; i < 5 * 1024; i += NTHR) {
    int v = i >> 10, k = i & 1023;
    float c = v < 4 ? p.in[1][v * 1024 + k] : p.in[3][k];
    sc[i] = siluf_(c);
  }
  __syncthreads();
  const int c0 = t * 64; const int l = c0 / 9216; const int j0 = c0 % 9216;
  const int col = tid & 63, part = tid >> 6;
  const float* w = p.in[4] + ((size_t)l * 1024 + part * 256) * 9216 + j0 + col;
  float a0 = 0, a1 = 0, a2 = 0, a3 = 0, a4 = 0;
  const float* s = sc + part * 256;
#pragma unroll 8
  for (int i = 0; i < 256; ++i) {
    float wv = w[(size_t)i * 9216];
    a0 += s[i] * wv; a1 += s[1024 + i] * wv; a2 += s[2048 + i] * wv; a3 += s[3072 + i] * wv; a4 += s[4096 + i] * wv;
  }
  red[(part * 5 + 0) * 64 + col] = a0; red[(part * 5 + 1) * 64 + col] = a1; red[(part * 5 + 2) * 64 + col] = a2;
  red[(part * 5 + 3) * 64 + col] = a3; red[(part * 5 + 4) * 64 + col] = a4;
  __syncthreads();
  for (int i = tid; i < 320; i += NTHR) {
    int v = i >> 6, c = i & 63;
    float sum = red[(0 * 5 + v) * 64 + c] + red[(1 * 5 + v) * 64 + c] + red[(2 * 5 + v) * 64 + c] + red[(3 * 5 + v) * 64 + c];
    p.mod[(size_t)(l * 5 + v) * 9216 + j0 + c] = sum + p.in[5][(size_t)l * 9216 + j0 + c];
  }
  __syncthreads();
}
__device__ __forceinline__ void ph_convert(const P& p, int l, bool with_mod, char* lds) {
  const int tid = get_tid();
  int ntiles[NJOBS]; int total = 0;
#pragma unroll
  for (int j = 0; j < NJOBS; ++j) { Job jb = get_job(p, l, j); ntiles[j] = (jb.K >> 6) * ((jb.N + 63) >> 6); total += ntiles[j]; }
  const int nmod = with_mod ? 288 : 0;
  float* tile = (float*)lds;
  for (int t = blockIdx.x; t < total + nmod; t += gridDim.x) {
    if (t < nmod) { mod_task(p, t, lds); continue; }
    int tt = t - nmod; int j = 0;
#pragma unroll
    for (int q = 0; q < NJOBS; ++q) { if (j == q && tt >= ntiles[q]) { tt -= ntiles[q]; j = q + 1; } }
    Job jb = get_job(p, l, j);
    const int nkt = jb.K >> 6;
    const int k0 = (tt % nkt) * 64, n0 = (tt / nkt) * 64;
    {
      const int c = tid & 63, r0 = tid >> 6;
      const bool ok = (n0 + c) < jb.N;
#pragma unroll
      for (int i = 0; i < 16; ++i) { int r = r0 + i * 4; tile[r * 65 + c] = ok ? jb.src[(size_t)(k0 + r) * jb.N + n0 + c] : 0.f; }
    }
    __syncthreads();
    {
      const int nn = tid >> 2, q = tid & 3; const int n = n0 + nn;
      if (n < jb.N) {
        int drow = n;
        if (jb.mode == 1) drow = (n >> 5) * 64 + (n & 31);
        else if (jb.mode == 2) drow = (n >> 5) * 64 + 32 + (n & 31);
        bf16_t* d = p.W + jb.dst + (size_t)drow * jb.K + k0 + q * 16;
        unsigned pk[8];
#pragma unroll
        for (int i = 0; i < 8; ++i) { unsigned lo = f2bf(tile[(q * 16 + 2 * i) * 65 + nn]); unsigned hi = f2bf(tile[(q * 16 + 2 * i + 1) * 65 + nn]); pk[i] = lo | (hi << 16); }
        *(uint4*)d = make_uint4(pk[0], pk[1], pk[2], pk[3]);
        *(uint4*)(d + 8) = make_uint4(pk[4], pk[5], pk[6], pk[7]);
      }
    }
    __syncthreads();
  }
}

__device__ __forceinline__ void ph_rows(const P& p, int mode, int l, int ln_idx, int Mrows, bool writeU, int ul, int ks) {
  const int lane = get_tid() & 63, wid = get_tid() >> 6;
  const int nw = gridDim.x * 4;
  const float* g = p.in[6] + (size_t)(l * 3 + ln_idx) * 1024;
  const float* b = p.in[7] + (size_t)(l * 3 + ln_idx) * 1024;
  for (int m = blockIdx.x * 4 + wid; m < Mrows; m += nw) {
    float* s = srow(p, m);
    const float* src = s;
    if (mode == 0) src = m < M_LAT ? p.in[0] + (size_t)m * 1024 : p.in[2] + (size_t)(m - M_LAT) * 1024;
    float4 v[4];
#pragma unroll
    for (int i = 0; i < 4; ++i) v[i] = *(const float4*)(src + lane * 4 + i * 256);
    if (mode == 1) {
      float sum = 0;
#pragma unroll
      for (int i = 0; i < 4; ++i) sum += v[i].x + v[i].y + v[i].z + v[i].w;
      sum = wavesum(sum);
      const float mean = sum * (1.f / 1024.f);
      float sq = 0;
#pragma unroll
      for (int i = 0; i < 4; ++i) { v[i].x -= mean; v[i].y -= mean; v[i].z -= mean; v[i].w -= mean; sq += v[i].x * v[i].x + v[i].y * v[i].y + v[i].z * v[i].z + v[i].w * v[i].w; }
      sq = wavesum(sq);
      const float rstd = rsqrtf(sq * (1.f / 1024.f) + 1e-5f);
#pragma unroll
      for (int i = 0; i < 4; ++i) {
        float4 gg = *(const float4*)(g + lane * 4 + i * 256), bb = *(const float4*)(b + lane * 4 + i * 256);
        v[i].x = v[i].x * rstd * gg.x + bb.x; v[i].y = v[i].y * rstd * gg.y + bb.y; v[i].z = v[i].z * rstd * gg.z + bb.z; v[i].w = v[i].w * rstd * gg.w + bb.w;
      }
    }
#pragma unroll
    for (int i = 0; i < 4; ++i) *(float4*)(s + lane * 4 + i * 256) = v[i];
    if (writeU) {
      const float* sh = modp(p, ul, m, ks); const float* scl = modp(p, ul, m, ks + 1);
#pragma unroll
      for (int i = 0; i < 4; ++i) {
        float4 a = *(const float4*)(sh + lane * 4 + i * 256), c = *(const float4*)(scl + lane * 4 + i * 256);
        unsigned lo = f2bf(v[i].x * (1.f + c.x) + a.x) | ((unsigned)f2bf(v[i].y * (1.f + c.y) + a.y) << 16);
        unsigned hi = f2bf(v[i].z * (1.f + c.z) + a.z) | ((unsigned)f2bf(v[i].w * (1.f + c.w) + a.w) << 16);
        *(uint2*)(p.U + (size_t)m * 1024 + lane * 4 + i * 256) = make_uint2(lo, hi);
      }
    }
  }
}

__device__ __forceinline__ void ph_ffn_up(const P& p, int s, int Mt, char* lds) {
  EPI_VARS
  bf16_t* HM = (bf16_t*)p.R;
  const bf16_t* Wt = p.W + (s ? W_GU1 : W_GU0);
  const int ntile = Mt * 44;
  for (int it = 0;; ++it) {
    int tm, tn; if (!tile_map(it, Mt, 44, 4, tm, tn)) break; const int m0 = tm * 128, n0 = tn * 128;
    f32x4 acc[4][4]; ZERO_ACC(acc)
    gemm_main(p.U + (size_t)m0 * 1024, 1024, Wt + (size_t)n0 * 1024, 1024, 1024, acc, lds);
    const int hb = ((n0 + wc * 64) >> 6) * 32;
#pragma unroll
    for (int m = 0; m < 4; ++m)
#pragma unroll
      for (int n = 0; n < 2; ++n)
#pragma unroll
        for (int j = 0; j < 4; ++j) {
          const int row = m0 + wr * 64 + m * 16 + fq * 4 + j; const int hc = hb + n * 16 + fr;
          HM[(size_t)row * 2816 + hc] = f2bf(siluf_(acc[m][n][j]) * acc[m][n + 2][j]);
        }
  }
}
__device__ __forceinline__ void ph_ffn_down(const P& p, int l, int s, int Mt, char* lds) {
  EPI_VARS
  const bf16_t* HM = (const bf16_t*)p.R;
  const bf16_t* Wt = p.W + (s ? W_D1 : W_D0);
  const int gk = s ? 8 : 2;
  const int ntile = Mt * 8;
  for (int it = 0;; ++it) {
    int tm, tn; if (!tile_map(it, Mt, 8, 8, tm, tn)) break; const int m0 = tm * 128, n0 = tn * 128;
    f32x4 acc[4][4]; ZERO_ACC(acc)
    gemm_main(HM + (size_t)m0 * 2816, 2816, Wt + (size_t)n0 * 2816, 2816, 2816, acc, lds);
    EPI_ROW_BEGIN(m0)
      float* sp = srow(p, row) + n0 + wc * 64 + fr; const float* gp = modp(p, l, row, gk) + n0 + wc * 64 + fr;
#pragma unroll
      for (int n = 0; n < 4; ++n) sp[n * 16] = ALPHA * sp[n * 16] + 0.5f * gp[n * 16] * acc[m][n][j];
    EPI_ROW_END
  }
}

#define RW_ZRW(p) ((hf*)(p).R)
#define RW_RKV(p) (RW_ZRW(p) + (size_t)M_ALL * 1152)
#define RW_LA(p) ((bf16_t*)(RW_RKV(p) + (size_t)M_ALL * 1152))
#define RW_KK(p) ((hf*)(RW_LA(p) + (size_t)M_ALL * 256))
#define RW_KD(p) (RW_KK(p) + (size_t)M_ALL * 384)
#define RW_KA(p) (RW_KD(p) + (size_t)2 * M_ALL * 384)
#define RW_YR(p) (RW_KA(p) + (size_t)2 * M_ALL * 384)

#define S5_Z(p) ((float*)(p).R)
#define S5_YG(p) ((bf16_t*)(S5_Z(p) + (size_t)M_ALL * 256))
#define S5_E(p) ((float2*)(S5_YG(p) + (size_t)M_ALL * 256))
#define S5_X(p) (S5_E(p) + (size_t)2 * 4 * 132 * 1024)

#define ML_Z(p) ((hf*)(p).R)
#define ML_GL(p) ((float*)(ML_Z(p) + (size_t)M_ALL * 1536))
#define ML_QK(p) ((hf*)(ML_GL(p) + (size_t)M_ALL * 16))
#define ML_DC(p) ((float*)(ML_QK(p) + (size_t)M_ALL * 768))
#define ML_DN(p) (ML_DC(p) + (size_t)4224 * 9216)
#define ML_SC(p) (ML_DN(p) + (size_t)4224 * 96)
#define ML_MP(p) (ML_SC(p) + (size_t)4224 * 2)

__device__ __forceinline__ void ph_z_rw(const P& p, char* lds) {
  EPI_VARS
  hf* ZRW = RW_ZRW(p); bf16_t* LA = RW_LA(p);
  const int Mt = 264; const int ntile = Mt * 11;
  for (int it = 0;; ++it) {
    int tm, tn; if (!tile_map(it, Mt, 11, 11, tm, tn)) break; const int m0 = tm * 128;
    const int wrow = tn < 9 ? tn * 128 : 2960 + (tn - 9) * 128;
    f32x4 acc[4][4]; ZERO_ACC(acc)
    gemm_main(p.U + (size_t)m0 * 1024, 1024, p.W + W_IN + (size_t)wrow * 1024, 1024, 1024, acc, lds);
    if (tn < 9) {
      EPI_BEGIN(m0, tn * 128)
        ZRW[(size_t)row * 1152 + col] = (hf)val;
      EPI_END
    } else {
      EPI_BEGIN(m0, (tn - 9) * 128)
        float o = col < 64 ? tanhf(val) : (col < 128 ? val : sigmoidf_(val));
        LA[(size_t)row * 256 + col] = f2bf(o);
      EPI_END
    }
  }
}
__device__ __forceinline__ void ph_z_s5(const P& p, char* lds) {
  EPI_VARS
  float* Z = S5_Z(p);
  const int Mt = 264; const int ntile = Mt * 2;
  for (int it = 0;; ++it) {
    int tm, tn; if (!tile_map(it, Mt, 2, 2, tm, tn)) break; const int m0 = tm * 128;
    f32x4 acc[4][4]; ZERO_ACC(acc)
    gemm_main(p.U + (size_t)m0 * 1024, 1024, p.W + W_IN + (size_t)(2704 + tn * 128) * 1024, 1024, 1024, acc, lds);
    EPI_BEGIN(m0, tn * 128)
      Z[(size_t)row * 256 + col] = val;
    EPI_END
  }
}
__device__ __forceinline__ void ph_z_ml(const P& p, char* lds) {
  EPI_VARS
  hf* Z = ML_Z(p); float* GL = ML_GL(p);
  const int Mt = 264; const int ntile = Mt * 13;
  for (int it = 0;; ++it) {
    int tm, tn; if (!tile_map(it, Mt, 13, 13, tm, tn)) break; const int m0 = tm * 128;
    f32x4 acc[4][4]; ZERO_ACC(acc)
    gemm_main(p.U + (size_t)m0 * 1024, 1024, p.W + W_IN + (size_t)(1152 + tn * 128) * 1024, 1024, 1024, acc, lds);
    if (tn < 12) {
      EPI_BEGIN(m0, tn * 128)
        Z[(size_t)row * 1536 + col] = (hf)val;
      EPI_END
    } else {
      EPI_BEGIN(m0, 0)
        if (col < 16) GL[(size_t)row * 16 + col] = val;
      EPI_END
    }
  }
}

__device__ __forceinline__ void ph_conv(const P& p, int l, int which) {
  const int nch = which == 0 ? 144 : 96;
  const int ldin = which == 0 ? 1152 : 1536;
  const hf* Zin = which == 0 ? RW_ZRW(p) : ML_Z(p);
  const int cbase = which == 0 ? 0 : 1152;
  const float* cw = p.in[12] + (size_t)l * 9 * 1920;
  const size_t total = (size_t)M_ALL * nch;
  for (size_t idx = (size_t)blockIdx.x * NTHR + get_tid(); idx < (total + 63) / 64 * 64; idx += (size_t)gridDim.x * NTHR) {
    const bool act = idx < total;
    const int m = act ? (int)(idx / nch) : 0; const int ch = act ? (int)(idx % nch) : 0; const int c0 = ch * 8;
    float o[8];
#pragma unroll
    for (int i = 0; i < 8; ++i) o[i] = 0.f;
    if (m < M_LAT) {
      const int bb = m >> 13, tt = m & 8191, gr = tt >> 6, gc = tt & 63;
#pragma unroll
      for (int dr = -1; dr <= 1; ++dr)
#pragma unroll
        for (int dc = -1; dc <= 1; ++dc) {
          const int rr = gr + dr, cc = gc + dc;
          if (rr >= 0 && rr < 128 && cc >= 0 && cc < 64) {
            const int mm = (bb << 13) + rr * 64 + cc;
            hf8 z = *(const hf8*)(Zin + (size_t)mm * ldin + c0);
            const float* w = cw + ((dr + 1) * 3 + (dc + 1)) * 1920 + cbase + c0;
            float4 w0 = *(const float4*)w, w1 = *(const float4*)(w + 4);
            o[0] += (float)z[0] * w0.x; o[1] += (float)z[1] * w0.y; o[2] += (float)z[2] * w0.z; o[3] += (float)z[3] * w0.w;
            o[4] += (float)z[4] * w1.x; o[5] += (float)z[5] * w1.y; o[6] += (float)z[6] * w1.z; o[7] += (float)z[7] * w1.w;
          }
        }
    } else {
      const int tt = (m - M_LAT) & 255;
#pragma unroll
      for (int dc = -1; dc <= 1; ++dc) {
        const int t2 = tt + dc;
        if (t2 >= 0 && t2 < 256) {
          hf8 z = *(const hf8*)(Zin + (size_t)(m + dc) * ldin + c0);
          const float* w = cw + (3 + (dc + 1)) * 1920 + cbase + c0;
          float4 w0 = *(const float4*)w, w1 = *(const float4*)(w + 4);
          o[0] += (float)z[0] * w0.x; o[1] += (float)z[1] * w0.y; o[2] += (float)z[2] * w0.z; o[3] += (float)z[3] * w0.w;
          o[4] += (float)z[4] * w1.x; o[5] += (float)z[5] * w1.y; o[6] += (float)z[6] * w1.z; o[7] += (float)z[7] * w1.w;
        }
      }
    }
    if (which == 0) {
      const bool isk = act && (c0 >= 384) && (c0 < 768);
      float kkv[8]; float ss = 0.f;
      if (isk) {
        const float* kkw = p.in[18] + (size_t)l * 384 + (c0 - 384);
#pragma unroll
        for (int i = 0; i < 8; ++i) { kkv[i] = o[i] * kkw[i]; ss += kkv[i] * kkv[i]; }
      } else {
#pragma unroll
        for (int i = 0; i < 8; ++i) kkv[i] = 0.f;
      }
      ss += __shfl_xor(ss, 1); ss += __shfl_xor(ss, 2); ss += __shfl_xor(ss, 4);
      if (act) {
        hf8 ov;
#pragma unroll
        for (int i = 0; i < 8; ++i) ov[i] = (hf)o[i];
        *(hf8*)(RW_RKV(p) + (size_t)m * 1152 + c0) = ov;
        if (isk) {
          const float rn = rsqrtf(fmaxf(ss, 1e-24f));
          hf8 kv;
#pragma unroll
          for (int i = 0; i < 8; ++i) kv[i] = (hf)(kkv[i] * rn);
          *(hf8*)(RW_KK(p) + (size_t)m * 384 + (c0 - 384)) = kv;
        }
      }
    } else if (act) {
      const float sc = c0 >= 384 ? 0.10206207261596575f : 1.f;
      hf8 ov;
#pragma unroll
      for (int i = 0; i < 8; ++i) ov[i] = (hf)(siluf_(o[i]) * sc);
      *(hf8*)(ML_QK(p) + (size_t)m * 768 + c0) = ov;
    }
  }
}

__device__ __forceinline__ void ph_lora(const P& p, int l, char* lds) {
  EPI_VARS
  hf* ZRW = RW_ZRW(p); const hf* RKV = RW_RKV(p); const bf16_t* LA = RW_LA(p); const hf* KK = RW_KK(p);
  hf* KD = RW_KD(p); hf* KA = RW_KA(p);
  const int Mt = 264; const int ntile = Mt * 15;
  for (int it = 0;; ++it) {
    int tm, q; if (!tile_map(it, Mt, 15, 15, tm, q)) break; const int job = q / 3, tn = q % 3; const int m0 = tm * 128, n0 = tn * 128;
    f32x4 acc[4][4]; ZERO_ACC(acc)
    if (job < 2) {
      const int d = job;
      gemm_main(LA + (size_t)m0 * 256, 256, p.W + (d ? W_WUP1 : W_WUP0) + (size_t)n0 * 64, 64, 64, acc, lds);
      const float* w0 = p.in[13] + (size_t)(l * 2 + d) * 384;
      EPI_BEGIN(m0, n0)
        const float e = sigmoidf_(w0[col] + val) * 0.6065306597126334f;
        ZRW[(size_t)row * 1152 + d * 384 + col] = (hf)(-expm1f(-e));
      EPI_END
    } else if (job < 4) {
      const int d = job - 2;
      gemm_main(LA + (size_t)m0 * 256 + 64, 256, p.W + (d ? W_AUP1 : W_AUP0) + (size_t)n0 * 64, 64, 64, acc, lds);
      const float* a0 = p.in[15] + (size_t)(l * 2 + d) * 384; const float* kaw = p.in[19] + (size_t)l * 384;
      EPI_ROW_BEGIN(m0)
        const int cb = n0 + wc * 64 + fr;
        const hf* kp = RKV + (size_t)row * 1152 + 384 + cb; const hf* kkp = KK + (size_t)row * 384 + cb;
        hf* kdp = KD + ((size_t)d * M_ALL + row) * 384 + cb; hf* kap = KA + ((size_t)d * M_ALL + row) * 384 + cb;
#pragma unroll
        for (int n = 0; n < 4; ++n) {
          const float a = sigmoidf_(a0[cb + n * 16] + acc[m][n][j]);
          kdp[n * 16] = (hf)((float)kp[n * 16] * (1.f + (a - 1.f) * kaw[cb + n * 16]));
          kap[n * 16] = (hf)((float)kkp[n * 16] * a);
        }
      EPI_ROW_END
    } else {
      gemm_main(LA + (size_t)m0 * 256 + 128, 256, p.W + W_GUP + (size_t)n0 * 128, 128, 128, acc, lds);
      EPI_BEGIN(m0, n0)
        ZRW[(size_t)row * 1152 + 768 + col] = (hf)val;
      EPI_END
    }
  }
}

#define RW_CH 32
#define RW_BUF 21504
__device__ __forceinline__ void ph_rwscan(const P& p, char* lds) {
  const hf* ZRW = RW_ZRW(p); hf* RKV = RW_RKV(p); const hf* KK = RW_KK(p);
  const int tid = get_tid(), lane = tid & 63, wid = tid >> 6;
  char* ybuf = lds + 3 * RW_BUF;
  for (int t = blockIdx.x; t < 192; t += gridDim.x) {
    const int rqq = t & 3, h = (t >> 2) % 6, b = (t / 24) & 3, d = t / 96;
    const int rsub = lane >> 4, g = lane & 15; const int rl = wid * 4 + rsub;
    const int sgn = d ? -1 : 1;
    const int sstep = tid >> 3, sseg = tid & 7;
    const hf* g_r = RKV + h * 64 + sseg * 8; const hf* g_kk = KK + h * 64 + sseg * 8; const hf* g_dd = ZRW + d * 384 + h * 64 + sseg * 8;
    const hf* g_kd = RW_KD(p) + (size_t)d * M_ALL * 384 + h * 64 + sseg * 8; const hf* g_ka = RW_KA(p) + (size_t)d * M_ALL * 384 + h * 64 + sseg * 8;
    const hf* g_v = RKV + 768 + h * 64 + rqq * 16 + (tid & 1) * 8;
    hf* g_y = d == 0 ? (RKV + 384 + h * 64 + rqq * 16 + (tid & 1) * 8) : (RW_YR(p) + h * 64 + rqq * 16 + (tid & 1) * 8);
    const int ldy = d == 0 ? 1152 : 384;
    uint4 q0, q1, q2, q3, q4, q5;
#define RW_M0(pp) ((pp) < 256 ? (M_LAT + b * 256 + (d ? 255 - (pp) : (pp))) : (b * 8192 + (d ? 8447 - (pp) : (pp) - 256)))
#define RW_GLOAD(c) { const int mb_ = RW_M0((c) * RW_CH); const size_t mm = (size_t)(mb_ + sgn * sstep); \
      q0 = *(const uint4*)(g_r + mm * 1152); q1 = *(const uint4*)(g_kk + mm * 384); q2 = *(const uint4*)(g_dd + mm * 1152); \
      q3 = *(const uint4*)(g_kd + mm * 384); q4 = *(const uint4*)(g_ka + mm * 384); \
      if (tid < 64) { const size_t mv = (size_t)(mb_ + sgn * (tid >> 1)); q5 = *(const uint4*)(g_v + mv * 1152); } }
#define RW_SSTORE(c) { char* bb_ = lds + ((c) % 3) * RW_BUF + sstep * 128 + sseg * 16; \
      *(uint4*)(bb_) = q0; *(uint4*)(bb_ + 4096) = q1; *(uint4*)(bb_ + 8192) = q2; *(uint4*)(bb_ + 12288) = q3; *(uint4*)(bb_ + 16384) = q4; \
      if (tid < 64) *(uint4*)(lds + ((c) % 3) * RW_BUF + 20480 + tid * 16) = q5; }
    float S0 = 0.f, S1 = 0.f, S2 = 0.f, S3 = 0.f;
    RW_GLOAD(0) RW_SSTORE(0)
    RW_GLOAD(1) RW_SSTORE(1)
    __syncthreads();
    const int NCH = 8448 / RW_CH;
    for (int c = 0; c < NCH; ++c) {
      if (c + 2 < NCH) RW_GLOAD(c + 2)
      if (c > 0 && tid < 64) {
        const int mb_ = RW_M0((c - 1) * RW_CH); const size_t mv = (size_t)(mb_ + sgn * (tid >> 1));
        *(uint4*)(g_y + mv * ldy) = *(const uint4*)(ybuf + ((c - 1) & 1) * 1024 + tid * 16);
      }
      const char* cb = lds + (c % 3) * RW_BUF + g * 8;
      hf* yb = (hf*)(ybuf + (c & 1) * 1024) + rl;
      const char* vb = lds + (c % 3) * RW_BUF + 20480 + rl * 2;
      hf4 r4 = *(const hf4*)(cb), k4 = *(const hf4*)(cb + 4096), d4 = *(const hf4*)(cb + 8192), kd4 = *(const hf4*)(cb + 12288), ka4 = *(const hf4*)(cb + 16384);
      hf vh = *(const hf*)(vb);
#pragma unroll
      for (int s = 0; s < RW_CH; ++s) {
        hf4 r4n = r4, k4n = k4, d4n = d4, kd4n = kd4, ka4n = ka4; hf vhn = vh;
        if (s + 1 < RW_CH) {
          r4n = *(const hf4*)(cb + (s + 1) * 128); k4n = *(const hf4*)(cb + 4096 + (s + 1) * 128); d4n = *(const hf4*)(cb + 8192 + (s + 1) * 128);
          kd4n = *(const hf4*)(cb + 12288 + (s + 1) * 128); ka4n = *(const hf4*)(cb + 16384 + (s + 1) * 128); vhn = *(const hf*)(vb + (s + 1) * 32);
        }
        const float vv = (float)vh;
        float sa = S0 * (float)k4[0] + S1 * (float)k4[1] + S2 * (float)k4[2] + S3 * (float)k4[3];
        sa = rowsum16(sa);
        S0 = fmaf(-S0, (float)d4[0], S0); S1 = fmaf(-S1, (float)d4[1], S1); S2 = fmaf(-S2, (float)d4[2], S2); S3 = fmaf(-S3, (float)d4[3], S3);
        S0 = fmaf(-sa, (float)ka4[0], S0); S1 = fmaf(-sa, (float)ka4[1], S1); S2 = fmaf(-sa, (float)ka4[2], S2); S3 = fmaf(-sa, (float)ka4[3], S3);
        S0 = fmaf(vv, (float)kd4[0], S0); S1 = fmaf(vv, (float)kd4[1], S1); S2 = fmaf(vv, (float)kd4[2], S2); S3 = fmaf(vv, (float)kd4[3], S3);
        float y = S0 * (float)r4[0] + S1 * (float)r4[1] + S2 * (float)r4[2] + S3 * (float)r4[3];
        y = rowsum16(y);
        if (g == 0) yb[s * 16] = (hf)y;
        r4 = r4n; k4 = k4n; d4 = d4n; kd4 = kd4n; ka4 = ka4n; vh = vhn;
      }
      if (c + 2 < NCH) RW_SSTORE(c + 2)
      __syncthreads();
    }
    if (tid < 64) {
      const int mb_ = RW_M0((NCH - 1) * RW_CH); const size_t mv = (size_t)(mb_ + sgn * (tid >> 1));
      *(uint4*)(g_y + mv * ldy) = *(const uint4*)(ybuf + ((NCH - 1) & 1) * 1024 + tid * 16);
    }
    __syncthreads();
  }
}

__device__ __forceinline__ void ph_rwpost(const P& p, int l) {
  const hf* ZRW = RW_ZRW(p); const hf* RKV = RW_RKV(p); const hf* YR = RW_YR(p);
  const int lane = get_tid() & 63, wid = get_tid() >> 6;
  const int nw = gridDim.x * 4;
  for (int t = blockIdx.x * 4 + wid; t < M_ALL * 6; t += nw) {
    const int m = t / 6, h = t % 6; const int c = h * 64 + lane;
    const float ys = (float)RKV[(size_t)m * 1152 + 384 + c] + (float)YR[(size_t)m * 384 + c];
    const float mean = wavesum(ys) * (1.f / 64.f);
    const float xc = ys - mean;
    const float var = wavesum(xc * xc) * (1.f / 64.f);
    float y = xc * rsqrtf(var + 64e-5f) * p.in[21][(size_t)l * 384 + c] + p.in[22][(size_t)l * 384 + c];
    const float r = (float)RKV[(size_t)m * 1152 + c], v = (float)RKV[(size_t)m * 1152 + 768 + c];
    const float rk = p.in[20][(size_t)l * 384 + c];
    const float kd0 = (float)RW_KD(p)[(size_t)m * 384 + c], kd1 = (float)RW_KD(p)[((size_t)M_ALL + m) * 384 + c];
    const float bs = wavesum(r * (kd0 + kd1) * rk);
    y = (y + bs * v) * (float)ZRW[(size_t)m * 1152 + 768 + c];
    p.Y[(size_t)m * 1024 + c] = f2bf(y);
  }
}

struct S5C { float ar, ai; float br[16], bi[16]; };
__device__ __forceinline__ void s5_consts(const P& p, int l, int d, int g, int n, S5C& c) {
  const int ig = (l * 2 + d) * 16 + g;
  const float lr = fminf(p.in[23][(size_t)ig * 64 + n], -1e-4f), li = p.in[24][(size_t)ig * 64 + n];
  const float dt = expf(p.in[25][ig]);
  const float mag = expf(lr * dt);
  c.ar = mag * cosf(li * dt); c.ai = mag * sinf(li * dt);
  const float nr = c.ar - 1.f, ni = c.ai; const float den = 1.f / (lr * lr + li * li);
  const float cr = (nr * lr + ni * li) * den, ci = (ni * lr - nr * li) * den;
  const float* bre = p.in[26] + ((size_t)ig * 64 + n) * 16; const float* bim = p.in[27] + ((size_t)ig * 64 + n) * 16;
#pragma unroll
  for (int h = 0; h < 16; ++h) { const float xr = bre[h], xi = bim[h]; c.br[h] = cr * xr - ci * xi; c.bi[h] = cr * xi + ci * xr; }
}
__device__ __forceinline__ int s5_m0(int b, int tc) { return tc < 128 ? b * 8192 + tc * 64 : M_LAT + b * 256 + (tc - 128) * 64; }
__device__ __forceinline__ int chain_pos(int d, int tc) { return d == 0 ? (tc < 128 ? tc + 4 : tc - 128) : (tc < 128 ? 131 - tc : 131 - tc); }
__device__ __forceinline__ void ph_s5_pass(const P& p, int l, int pass, char* lds) {
  const int lane = get_tid() & 63, wid = get_tid() >> 6;
  float* ub = (float*)lds + wid * 2048;
  float* yb = ub + 1024;
  const float* Z = S5_Z(p); float2* E = S5_E(p); const float2* X = S5_X(p); bf16_t* YG = S5_YG(p);
  const int nw = gridDim.x * 4;
  for (int t = blockIdx.x * 4 + wid; t < 4 * 132 * 16; t += nw) {
    const int g = t & 15, tc = (t >> 4) % 132, b = t / (16 * 132);
    const int m0 = s5_m0(b, tc);
#pragma unroll
    for (int i = 0; i < 4; ++i) { const int e = lane + i * 64; const int tok = e >> 2, q = e & 3;
      *(float4*)(ub + tok * 16 + q * 4) = *(const float4*)(Z + (size_t)(m0 + tok) * 256 + g * 16 + q * 4); }
    __builtin_amdgcn_s_waitcnt(0);
    __builtin_amdgcn_wave_barrier();
    for (int d = 0; d < 2; ++d) {
      S5C c; s5_consts(p, l, d, g, lane, c);
      const int cp = chain_pos(d, tc);
      const size_t sidx = (((size_t)(d * 4 + b) * 132 + cp) * 16 + g) * 64 + lane;
      float xr = 0.f, xi = 0.f;
      float cre[16], cim[16];
      if (pass == 3) {
        float2 x0 = X[sidx]; xr = x0.x; xi = x0.y;
        const int ig = (l * 2 + d) * 16 + g;
#pragma unroll
        for (int h = 0; h < 16; ++h) { cre[h] = p.in[28][((size_t)ig * 16 + h) * 64 + lane]; cim[h] = p.in[29][((size_t)ig * 16 + h) * 64 + lane]; }
      }
      for (int j = 0; j < 64; ++j) {
        const int tok = d ? 63 - j : j;
        float br = 0.f, bi = 0.f;
        const float* u = ub + tok * 16;
#pragma unroll
        for (int h = 0; h < 16; ++h) { const float uv = u[h]; br += c.br[h] * uv; bi += c.bi[h] * uv; }
        const float nr = c.ar * xr - c.ai * xi + br, ni = c.ar * xi + c.ai * xr + bi;
        xr = nr; xi = ni;
        if (pass == 3) {
          float pp[16];
#pragma unroll
          for (int h = 0; h < 16; ++h) pp[h] = cre[h] * xr - cim[h] * xi;
#pragma unroll
          for (int i = 0; i < 8; ++i) { const bool hi = lane & 1; float snd = hi ? pp[i] : pp[i + 8]; float rcv = __shfl_xor(snd, 1); pp[i] = (hi ? pp[i + 8] : pp[i]) + rcv; }
#pragma unroll
          for (int i = 0; i < 4; ++i) { const bool hi = lane & 2; float snd = hi ? pp[i] : pp[i + 4]; float rcv = __shfl_xor(snd, 2); pp[i] = (hi ? pp[i + 4] : pp[i]) + rcv; }
#pragma unroll
          for (int i = 0; i < 2; ++i) { const bool hi = lane & 4; float snd = hi ? pp[i] : pp[i + 2]; float rcv = __shfl_xor(snd, 4); pp[i] = (hi ? pp[i + 2] : pp[i]) + rcv; }
          { const bool hi = lane & 8; float snd = hi ? pp[0] : pp[1]; float rcv = __shfl_xor(snd, 8); pp[0] = (hi ? pp[1] : pp[0]) + rcv; }
          float tot = pp[0]; tot += __shfl_xor(tot, 16); tot += __shfl_xor(tot, 32);
          if (lane < 16) {
            const int hh = ((lane & 1) ? 8 : 0) + ((lane & 2) ? 4 : 0) + ((lane & 4) ? 2 : 0) + ((lane & 8) ? 1 : 0);
            if (d == 0) yb[tok * 16 + hh] = tot; else yb[tok * 16 + hh] += tot;
          }
        }
      }
      if (pass == 1) E[sidx] = make_float2(xr, xi);
    }
    if (pass == 3) {
      __builtin_amdgcn_s_waitcnt(0);
      __builtin_amdgcn_wave_barrier();
#pragma unroll
      for (int i = 0; i < 16; ++i) {
        const int e = lane + i * 64; const int tok = e >> 4, h = e & 15;
        float y = yb[e] + p.in[30][(size_t)l * 256 + g * 16 + h] * ub[e];
        const float inner = 0.7978845608028654f * (y + 0.044715f * y * y * y);
        y = 0.5f * y * (1.f + tanhf(inner));
        YG[(size_t)(m0 + tok) * 256 + g * 16 + h] = f2bf(y);
      }
    }
    __builtin_amdgcn_s_waitcnt(0);
    __builtin_amdgcn_wave_barrier();
  }
}
__device__ __forceinline__ void ph_s5_carry(const P& p, int l) {
  const float2* E = S5_E(p); float2* X = S5_X(p);
  for (int t = blockIdx.x * NTHR + get_tid(); t < 8192; t += gridDim.x * NTHR) {
    const int n = t & 63, g = (t >> 6) & 15, b = (t >> 10) & 3, d = t >> 12;
    const int ig = (l * 2 + d) * 16 + g;
    const float lr = fminf(p.in[23][(size_t)ig * 64 + n], -1e-4f), li = p.in[24][(size_t)ig * 64 + n];
    const float dt = expf(p.in[25][ig]);
    const float mag = expf(lr * dt * 64.f);
    float ar = expf(lr * dt) * cosf(li * dt), ai = expf(lr * dt) * sinf(li * dt);
#pragma unroll
    for (int i = 0; i < 6; ++i) { const float r2 = ar * ar - ai * ai, i2 = 2.f * ar * ai; ar = r2; ai = i2; }
    (void)mag;
    float xr = 0.f, xi = 0.f;
    const size_t base = (((size_t)(d * 4 + b) * 132) * 16 + g) * 64 + n;
    for (int cp0 = 0; cp0 < 132; cp0 += 12) {
      float2 ev[12];
#pragma unroll
      for (int u = 0; u < 12; ++u) ev[u] = E[base + (size_t)(cp0 + u) * 1024];
#pragma unroll
      for (int u = 0; u < 12; ++u) {
        X[base + (size_t)(cp0 + u) * 1024] = make_float2(xr, xi);
        const float nr = ar * xr - ai * xi + ev[u].x, ni = ar * xi + ai * xr + ev[u].y;
        xr = nr; xi = ni;
      }
    }
  }
}
__device__ __forceinline__ void ph_glu(const P& p, int l, char* lds) {
  EPI_VARS
  const bf16_t* YG = S5_YG(p);
  const int Mt = 264; const int ntile = Mt * 2;
  const float* gb = p.in[32] + (size_t)l * 256;
  for (int it = 0;; ++it) {
    int tm, tn; if (!tile_map(it, Mt, 2, 2, tm, tn)) break; const int m0 = tm * 128, n0 = tn * 128;
    f32x4 acc[4][4]; ZERO_ACC(acc)
    gemm_main(YG + (size_t)m0 * 256, 256, p.W + W_GLU + (size_t)n0 * 256, 256, 256, acc, lds);
    EPI_BEGIN(m0, n0)
      const float y = bf2f(YG[(size_t)row * 256 + col]);
      p.Y[(size_t)row * 1024 + 384 + col] = f2bf(y * sigmoidf_(val + gb[col]));
    EPI_END
  }
}

__device__ __forceinline__ float logsigf_(float x) { return fminf(x, 0.f) - log1pf(__expf(-fabsf(x))); }
__device__ __forceinline__ void ml_gates(const P& p, int l, int d, int h, int m0, int lane, float& bcum, float& ic) {
  const int tok = d ? 63 - lane : lane;
  const float* gl = ML_GL(p) + (size_t)(m0 + tok) * 16;
  const float* gb = p.in[33] + (size_t)(l * 2 + d) * 8;
  ic = gl[d * 8 + h] + gb[h];
  float f = logsigf_(gl[d * 8 + 4 + h] + gb[4 + h]);
#pragma unroll
  for (int o = 1; o < 64; o <<= 1) { float v = __shfl_up(f, o); if (lane >= o) f += v; }
  bcum = f;
}
#define MLP 104
__device__ __forceinline__ void ph_ml_a(const P& p, int l, char* lds) {
  hf* ks = (hf*)lds; hf* vs = ks + 64 * MLP; float* wg = (float*)(vs + 64 * MLP);
  const int tid = get_tid(), lane = tid & 63, wid = tid >> 6;
  const hf* QK = ML_QK(p); const hf* Z = ML_Z(p);
  for (int t = blockIdx.x; t < 4224; t += gridDim.x) {
    const int tc = t % 132, h = (t / 132) & 3, b = (t / 528) & 3, d = t / 2112;
    const int m0 = s5_m0(b, tc); const int cp = chain_pos(d, tc);
    const size_t task = ((size_t)((d * 4 + b) * 4 + h)) * 132 + cp;
    for (int e = tid; e < 64 * 12; e += NTHR) {
      const int j = e / 12, q = e % 12; const int tok = d ? 63 - j : j;
      *(hf8*)(ks + j * MLP + q * 8) = *(const hf8*)(QK + (size_t)(m0 + tok) * 768 + 384 + h * 96 + q * 8);
      *(hf8*)(vs + j * MLP + q * 8) = *(const hf8*)(Z + (size_t)(m0 + tok) * 1536 + 768 + h * 96 + q * 8);
    }
    if (wid == 0) {
      float bcum, ic; ml_gates(p, l, d, h, m0, lane, bcum, ic);
      const float blast = __shfl(bcum, 63);
      const float lw = blast - bcum + ic;
      float mx = lw;
      for (int o = 32; o > 0; o >>= 1) mx = fmaxf(mx, __shfl_xor(mx, o));
      wg[lane] = __expf(lw - mx);
      if (lane == 0) { ML_SC(p)[task * 2] = mx; ML_SC(p)[task * 2 + 1] = blast; }
    }
    __syncthreads();
    const int tk = tid >> 4, tv = tid & 15;
    float acc[6][6];
#pragma unroll
    for (int a = 0; a < 6; ++a)
#pragma unroll
      for (int c = 0; c < 6; ++c) acc[a][c] = 0.f;
    for (int j = 0; j < 64; ++j) {
      const float w = wg[j];
      float kv[6], vv[6];
#pragma unroll
      for (int a = 0; a < 6; ++a) { kv[a] = w * (float)ks[j * MLP + tk * 6 + a]; vv[a] = (float)vs[j * MLP + tv * 6 + a]; }
#pragma unroll
      for (int a = 0; a < 6; ++a)
#pragma unroll
        for (int c = 0; c < 6; ++c) acc[a][c] += kv[a] * vv[c];
    }
    float* dc = ML_DC(p) + task * 9216;
#pragma unroll
    for (int a = 0; a < 6; ++a)
#pragma unroll
      for (int c = 0; c < 6; ++c) dc[(tk * 6 + a) * 96 + tv * 6 + c] = acc[a][c];
    if (tid < 96) {
      float s = 0.f;
      for (int j = 0; j < 64; ++j) s += wg[j] * (float)ks[j * MLP + tid];
      ML_DN(p)[task * 96 + tid] = s;
    }
    __syncthreads();
  }
}
__device__ __forceinline__ void ph_ml_b(const P& p) {
  float* DC = ML_DC(p); float* DN = ML_DN(p); const float* SC = ML_SC(p); float* MP = ML_MP(p);
  for (int t = blockIdx.x * NTHR + get_tid(); t < 32 * 9312; t += gridDim.x * NTHR) {
    const int chain = t / 9312, e = t % 9312;
    float cur = 0.f, mprev = 0.f;
    for (int cp0 = 0; cp0 < 132; cp0 += 12) {
      float dl[12], ml_[12], bl_[12];
#pragma unroll
      for (int u = 0; u < 12; ++u) {
        const size_t task = (size_t)chain * 132 + cp0 + u;
        dl[u] = e < 9216 ? DC[task * 9216 + e] : DN[task * 96 + (e - 9216)];
        ml_[u] = SC[task * 2]; bl_[u] = SC[task * 2 + 1];
      }
#pragma unroll
      for (int u = 0; u < 12; ++u) {
        const size_t task = (size_t)chain * 132 + cp0 + u;
        float* slot = e < 9216 ? DC + task * 9216 + e : DN + task * 96 + (e - 9216);
        *slot = cur;
        if (e == 0) MP[task] = mprev;
        const float mnew = fmaxf(bl_[u] + mprev, ml_[u]);
        cur = __expf(bl_[u] + mprev - mnew) * cur + __expf(ml_[u] - mnew) * dl[u];
        mprev = mnew;
      }
    }
  }
}
__device__ __forceinline__ void ph_ml_c(const P& p, int l, char* lds) {
  hf* qs = (hf*)lds; hf* ks = qs + 64 * MLP; hf* vs = ks + 64 * MLP;
  float* Sm = (float*)(vs + 64 * MLP);
  float* bc = Sm + 64 * 65; float* icv = bc + 64; float* mr = icv + 64; float* inter = mr + 64; float* den = inter + 64; float* nst = den + 64;
  const int tid = get_tid(), lane = tid & 63, wid = tid >> 6;
  const hf* QK = ML_QK(p); const hf* Z = ML_Z(p);
  const int tj = tid >> 4, tv = tid & 15;
  for (int t = blockIdx.x; t < 2112; t += gridDim.x) {
    const int tc = t % 132, h = (t / 132) & 3, b = t / 528;
    const int m0 = s5_m0(b, tc);
    float hs[4][6];
#pragma unroll
    for (int a = 0; a < 4; ++a)
#pragma unroll
      for (int c = 0; c < 6; ++c) hs[a][c] = 0.f;
    for (int d = 0; d < 2; ++d) {
      const int cp = chain_pos(d, tc);
      const size_t task = ((size_t)((d * 4 + b) * 4 + h)) * 132 + cp;
      const float mprev = ML_MP(p)[task];
      for (int e = tid; e < 64 * 12; e += NTHR) {
        const int j = e / 12, q = e % 12; const int tok = d ? 63 - j : j;
        *(hf8*)(qs + j * MLP + q * 8) = *(const hf8*)(QK + (size_t)(m0 + tok) * 768 + h * 96 + q * 8);
        *(hf8*)(ks + j * MLP + q * 8) = *(const hf8*)(QK + (size_t)(m0 + tok) * 768 + 384 + h * 96 + q * 8);
        *(hf8*)(vs + j * MLP + q * 8) = *(const hf8*)(Z + (size_t)(m0 + tok) * 1536 + 768 + h * 96 + q * 8);
      }
      if (tid < 96) nst[tid] = ML_DN(p)[task * 96 + tid];
      if (wid == 0) { float bcum, ic; ml_gates(p, l, d, h, m0, lane, bcum, ic); bc[lane] = bcum; icv[lane] = ic; }
      __syncthreads();
      const int sj = tid >> 4, ss = tid & 15;
      float qk[4][4];
#pragma unroll
      for (int a = 0; a < 4; ++a)
#pragma unroll
        for (int c = 0; c < 4; ++c) qk[a][c] = 0.f;
      for (int k = 0; k < 96; ++k) {
        float qv[4], kv[4];
#pragma unroll
        for (int a = 0; a < 4; ++a) { qv[a] = (float)qs[(sj * 4 + a) * MLP + k]; kv[a] = (float)ks[(ss * 4 + a) * MLP + k]; }
#pragma unroll
        for (int a = 0; a < 4; ++a)
#pragma unroll
          for (int c = 0; c < 4; ++c) qk[a][c] += qv[a] * kv[c];
      }
      if (tid < 64) {
        const int j = tid; const float bj = bc[j];
        float mx = bj + mprev;
        for (int s = 0; s <= j; ++s) mx = fmaxf(mx, bj - bc[s] + icv[s]);
        mr[j] = mx; inter[j] = __expf(bj + mprev - mx);
      }
      __syncthreads();
#pragma unroll
      for (int a = 0; a < 4; ++a)
#pragma unroll
        for (int c = 0; c < 4; ++c) {
          const int j = sj * 4 + a, s = ss * 4 + c;
          Sm[j * 65 + s] = s <= j ? qk[a][c] * __expf(bc[j] - bc[s] + icv[s] - mr[j]) : 0.f;
        }
      __syncthreads();
      if (tid < 64) {
        const int j = tid; float s1 = 0.f, s2 = 0.f;
        for (int k = 0; k < 96; ++k) s1 += nst[k] * (float)qs[j * MLP + k];
        for (int s = 0; s < 64; ++s) s2 += Sm[j * 65 + s];
        den[j] = inter[j] * s1 + s2;
      }
      const int jb = d ? 60 - 4 * tj : 4 * tj;
      float num[4][6];
#pragma unroll
      for (int a = 0; a < 4; ++a)
#pragma unroll
        for (int c = 0; c < 6; ++c) num[a][c] = 0.f;
      const float* ct = ML_DC(p) + task * 9216 + tv * 6;
      for (int k = 0; k < 96; ++k) {
        float cv[6], qv[4];
        const float2 c0 = *(const float2*)(ct + k * 96), c1 = *(const float2*)(ct + k * 96 + 2), c2 = *(const float2*)(ct + k * 96 + 4);
        cv[0] = c0.x; cv[1] = c0.y; cv[2] = c1.x; cv[3] = c1.y; cv[4] = c2.x; cv[5] = c2.y;
#pragma unroll
        for (int a = 0; a < 4; ++a) qv[a] = (float)qs[(jb + a) * MLP + k];
#pragma unroll
        for (int a = 0; a < 4; ++a)
#pragma unroll
          for (int c = 0; c < 6; ++c) num[a][c] += qv[a] * cv[c];
      }
#pragma unroll
      for (int a = 0; a < 4; ++a) { const float it = inter[jb + a];
#pragma unroll
        for (int c = 0; c < 6; ++c) num[a][c] *= it; }
      for (int s = 0; s < 64; ++s) {
        float sv[4], vv[6];
#pragma unroll
        for (int a = 0; a < 4; ++a) sv[a] = Sm[(jb + a) * 65 + s];
#pragma unroll
        for (int c = 0; c < 6; ++c) vv[c] = (float)vs[s * MLP + tv * 6 + c];
#pragma unroll
        for (int a = 0; a < 4; ++a)
#pragma unroll
          for (int c = 0; c < 6; ++c) num[a][c] += sv[a] * vv[c];
      }
      __syncthreads();
#pragma unroll
      for (int a = 0; a < 4; ++a) {
        const int j = jb + a;
        const float dn = 1.f / fmaxf(fabsf(den[j]), __expf(-mr[j]));
        const int slot = d ? 3 - a : a;
#pragma unroll
        for (int c = 0; c < 6; ++c) hs[slot][c] += num[a][c] * dn;
      }
      __syncthreads();
    }
#pragma unroll
    for (int a = 0; a < 4; ++a) {
      const int m = m0 + tj * 4 + a;
      float x[6]; float s = 0.f;
#pragma unroll
      for (int c = 0; c < 6; ++c) { const float o = (float)Z[(size_t)m * 1536 + 1152 + h * 96 + tv * 6 + c]; x[c] = sigmoidf_(o) * hs[a][c]; s += x[c]; }
      s += __shfl_xor(s, 1); s += __shfl_xor(s, 2); s += __shfl_xor(s, 4); s += __shfl_xor(s, 8);
      const float mean = s * (1.f / 96.f);
      float q = 0.f;
#pragma unroll
      for (int c = 0; c < 6; ++c) { x[c] -= mean; q += x[c] * x[c]; }
      q += __shfl_xor(q, 1); q += __shfl_xor(q, 2); q += __shfl_xor(q, 4); q += __shfl_xor(q, 8);
      const float rs = rsqrtf(q * (1.f / 96.f) + 1e-5f);
#pragma unroll
      for (int c = 0; c < 6; ++c) p.Y[(size_t)m * 1024 + 640 + h * 96 + tv * 6 + c] = f2bf(x[c] * rs * p.in[34][(size_t)l * 384 + h * 96 + tv * 6 + c]);
    }
  }
}

#define MG_YM(p) ((bf16_t*)(p).R)
#define MG_G3(p) (MG_YM(p) + (size_t)M_ALL * 1024)
__device__ __forceinline__ void ph_gates(const P& p, int l, int Mt, char* lds) {
  EPI_VARS
  bf16_t* G3 = MG_G3(p);
  const float* gbias = p.in[38] + (size_t)l * 3072;
  const int ntile = Mt * 24;
  for (int it = 0;; ++it) {
    int tm, tn; if (!tile_map(it, Mt, 24, 8, tm, tn)) break; const int m0 = tm * 128, n0 = tn * 128;
    f32x4 acc[4][4]; ZERO_ACC(acc)
    gemm_main(p.U + (size_t)m0 * 1024, 1024, p.W + W_IN + (size_t)(3216 + n0) * 1024, 1024, 1024, acc, lds);
    EPI_BEGIN(m0, n0)
      G3[(size_t)row * 3072 + col] = f2bf(sigmoidf_(val + gbias[col]));
    EPI_END
  }
}
__device__ __forceinline__ void ph_merge(const P& p, int l, int Mt, char* lds) {
  EPI_VARS
  bf16_t* YM = MG_YM(p); const bf16_t* G3 = MG_G3(p);
  const int ntile = Mt * 16;
  for (int it = 0;; ++it) {
    int tm, tn; if (!tile_map(it, Mt, 16, 8, tm, tn)) break; const int m0 = tm * 128, n0 = tn * 64;
    f32x4 yacc[4][2];
#pragma unroll
    for (int m = 0; m < 4; ++m) { yacc[m][0] = (f32x4){0.f, 0.f, 0.f, 0.f}; yacc[m][1] = (f32x4){0.f, 0.f, 0.f, 0.f}; }
#pragma unroll 1
    for (int br = 0; br < 3; ++br) {
      f32x4 acc[4][2];
#pragma unroll
      for (int m = 0; m < 4; ++m) { acc[m][0] = (f32x4){0.f, 0.f, 0.f, 0.f}; acc[m][1] = (f32x4){0.f, 0.f, 0.f, 0.f}; }
      const int kb = br == 1 ? 256 : 384; const int yoff = br == 0 ? 0 : (br == 1 ? 384 : 640);
      const int woff = br == 0 ? W_UPRW : (br == 1 ? W_UPS5 : W_UPML);
      gemm_main_t<2>(p.Y + (size_t)m0 * 1024 + yoff, 1024, p.W + woff + (size_t)n0 * kb, kb, kb, acc, lds);
      EPI_ROW_BEGIN(m0)
        const bf16_t* gp = G3 + (size_t)row * 3072 + br * 1024 + n0 + wc * 32 + fr;
#pragma unroll
        for (int n = 0; n < 2; ++n) yacc[m][n][j] += bf2f(gp[n * 16]) * acc[m][n][j];
      EPI_ROW_END
    }
    EPI_ROW_BEGIN(m0)
      bf16_t* yp = YM + (size_t)row * 1024 + n0 + wc * 32 + fr;
#pragma unroll
      for (int n = 0; n < 2; ++n) yp[n * 16] = f2bf(yacc[m][n][j]);
    EPI_ROW_END
  }
}
__device__ __forceinline__ void ph_wout(const P& p, int l, int Mt, char* lds) {
  EPI_VARS
  const bf16_t* YM = (const bf16_t*)p.R;
  const int ntile = Mt * 8;
  for (int it = 0;; ++it) {
    int tm, tn; if (!tile_map(it, Mt, 8, 8, tm, tn)) break; const int m0 = tm * 128, n0 = tn * 128;
    f32x4 acc[4][4]; ZERO_ACC(acc)
    gemm_main(YM + (size_t)m0 * 1024, 1024, p.W + W_OUT + (size_t)n0 * 1024, 1024, 1024, acc, lds);
    EPI_ROW_BEGIN(m0)
      float* sp = srow(p, row) + n0 + wc * 64 + fr; const float* gp = modp(p, l, row, 5) + n0 + wc * 64 + fr;
#pragma unroll
      for (int n = 0; n < 4; ++n) sp[n * 16] = ALPHA * sp[n * 16] + gp[n * 16] * acc[m][n][j];
    EPI_ROW_END
  }
}

#define SYNC grid.sync(); asm volatile("" : "+s"(l));
__global__ void __launch_bounds__(NTHR, 2) mega(P pv) {
#define p pv
  __shared__ __attribute__((aligned(16))) char lds[LDS_BYTES];
  cg::grid_group grid = cg::this_grid();
  for (int l = 0; l < 2; ++l) {
    const bool last = (l == 1);
    const int Mt2 = last ? 256 : 264;
    const int Mr2 = last ? M_LAT : M_ALL;
    ph_convert(p, l, l == 0, lds); SYNC
    if (l == 0) { ph_rows(p, 0, 0, 0, M_ALL, true, 0, 0); SYNC }
    ph_ffn_up(p, 0, 264, lds); SYNC
    ph_ffn_down(p, l, 0, 264, lds); SYNC
    ph_rows(p, 1, l, 0, M_ALL, true, l, 3); SYNC
    ph_z_rw(p, lds); SYNC
    ph_conv(p, l, 0); SYNC
    ph_lora(p, l, lds); SYNC
    ph_rwscan(p, lds); SYNC
    ph_rwpost(p, l); SYNC
    ph_z_s5(p, lds); SYNC
    ph_s5_pass(p, l, 1, lds); SYNC
    ph_s5_carry(p, l); SYNC
    ph_s5_pass(p, l, 3, lds); SYNC
    ph_glu(p, l, lds); SYNC
    ph_z_ml(p, lds); SYNC
    ph_conv(p, l, 1); SYNC
    ph_ml_a(p, l, lds); SYNC
    ph_ml_b(p); SYNC
    ph_ml_c(p, l, lds); SYNC
    ph_gates(p, l, Mt2, lds); SYNC
    ph_merge(p, l, Mt2, lds); SYNC
    ph_wout(p, l, Mt2, lds); SYNC
    ph_rows(p, 1, l, 1, Mr2, true, l, 6); SYNC
    ph_ffn_up(p, 1, Mt2, lds); SYNC
    ph_ffn_down(p, l, 1, Mt2, lds); SYNC
    ph_rows(p, 1, l, 2, Mr2, !last, l + 1, 0);
    if (!last) { SYNC }
  }
#undef p
}

extern "C" void kernel_launch(void* const* d_in, const int* in_sizes, int n_in, void* d_out, int out_size, void* d_ws, size_t ws_size,
                              hipStream_t stream) {
  static int grid_blocks = 0;
  if (!grid_blocks) {
    int dev = 0, cus = 0, per_cu = 0;
    hipGetDevice(&dev);
    hipDeviceGetAttribute(&cus, hipDeviceAttributeMultiprocessorCount, dev);
    hipOccupancyMaxActiveBlocksPerMultiprocessor(&per_cu, mega, NTHR, 0);
    if (per_cu > 2) per_cu = 2;
    grid_blocks = cus * per_cu;
  }
  P p{};
  for (int i = 0; i < 40; ++i) p.in[i] = (const float*)d_in[i];
  char* ws = (char*)d_ws;
  size_t off = 0;
  p.W = (bf16_t*)(ws + off); off += (size_t)W_TOTAL * 2;
  p.mod = (float*)(ws + off); off += (size_t)2 * 5 * 9216 * 4;
  p.sctx = (float*)(ws + off); off += (size_t)1024 * 1024 * 4;
  p.U = (bf16_t*)(ws + off); off += (size_t)M_ALL * 1024 * 2;
  p.Y = (bf16_t*)(ws + off); off += (size_t)M_ALL * 1024 * 2;
  p.R = ws + off;
  p.out = (float*)d_out;
  if (off + (size_t)M_ALL * 9728 > ws_size) fprintf(stderr, "workspace too small: need %zu have %zu\n", off + (size_t)M_ALL * 9728, ws_size);
  void* args[] = {&p};
  hipError_t e = hipLaunchCooperativeKernel((void*)mega, dim3(grid_blocks), dim3(NTHR), args, 0, stream);
  if (e != hipSuccess) fprintf(stderr, "cooperative launch failed: %s (grid %d)\n", hipGetErrorString(e), grid_blocks);
}
```

```cpp
#include <hip/hip_runtime.h>
#include <hip/hip_cooperative_groups.h>
#include <cstdio>
namespace cg = cooperative_groups;

typedef unsigned short bf16_t;
typedef _Float16 hf;
typedef hf hf4 __attribute__((ext_vector_type(4)));
typedef hf hf8 __attribute__((ext_vector_type(8)));
typedef __attribute__((ext_vector_type(8))) short bf16x8;
typedef __attribute__((ext_vector_type(4))) float f32x4;
typedef unsigned int u32x4 __attribute__((ext_vector_type(4)));

#define M_LAT 32768
#define M_ALL 33792
#define NTHR 256
#define LDS_BYTES 73728
#define ALPHA 1.41421356237f

#define W_GU0 0
#define W_D0 5767168
#define W_GU1 8650752
#define W_D1 14417920
#define W_IN 17301504
#define W_WUP0 23740416
#define W_WUP1 23764992
#define W_AUP0 23789568
#define W_AUP1 23814144
#define W_GUP 23838720
#define W_GLU 23887872
#define W_UPRW 23953408
#define W_UPS5 24346624
#define W_UPML 24608768
#define W_OUT 25001984
#define W_TOTAL 26050560

struct P {
  const float* in[40];
  float* out; float* sctx; float* mod;
  bf16_t* U; bf16_t* Y; bf16_t* W; char* R;
};

__device__ __forceinline__ int get_tid() { int t = __builtin_amdgcn_workitem_id_x(); asm volatile("" : "+v"(t)); return t; }
__device__ __forceinline__ bf16_t f2bf(float f) { return __builtin_bit_cast(unsigned short, (_Float16)f); }
__device__ __forceinline__ float bf2f(bf16_t h) { return (float)__builtin_bit_cast(_Float16, h); }
__device__ __forceinline__ float sigmoidf_(float x) { return 1.f / (1.f + __expf(-x)); }
__device__ __forceinline__ float siluf_(float x) { return x / (1.f + __expf(-x)); }
__device__ __forceinline__ float* srow(const P& p, int m) { return m < M_LAT ? p.out + (size_t)m * 1024 : p.sctx + (size_t)(m - M_LAT) * 1024; }
__device__ __forceinline__ const float* modp(const P& p, int l, int m, int k) { int mv = m < M_LAT ? (m >> 13) : 4; return p.mod + (size_t)(l * 5 + mv) * 9216 + k * 1024; }
template <int C> __device__ __forceinline__ float dppf(float x) { return __int_as_float(__builtin_amdgcn_update_dpp(0, __float_as_int(x), C, 0xf, 0xf, false)); }
__device__ __forceinline__ float rowsum16(float x) { x += dppf<0x128>(x); x += dppf<0x124>(x); x += dppf<0x122>(x); x += dppf<0x121>(x); return x; }
__device__ __forceinline__ float wavesum(float x) { for (int o = 32; o > 0; o >>= 1) x += __shfl_xor(x, o); return x; }

template <int NB>
__device__ __forceinline__ void gemm_main_t(const bf16_t* __restrict__ A, int lda, const bf16_t* __restrict__ B, int ldb, int K,
                                          f32x4 (&acc)[4][NB], char* lds) {
  const int tid = get_tid(), lane = tid & 63, wid = tid >> 6, wr = wid >> 1, wc = wid & 1;
  const int fr = lane & 15, fq = lane >> 4;
  const int sr = tid >> 3, skc = tid & 7;
  const bf16_t* ga = A + (size_t)sr * lda + skc * 8;
  const bf16_t* gb = B + (size_t)sr * ldb + skc * 8;
  u32x4 ra0[4], rb0[NB], ra1[4], rb1[NB];
  const int soff = sr * 144 + skc * 16;
  const int nk = K >> 6;
  const int aoff = (wr * 64 + fr) * 144 + fq * 16;
  const int boff = 18432 + (wc * (NB * 16) + fr) * 144 + fq * 16;
#define G_LOAD(RA, RB, kt) { _Pragma("unroll") for (int i = 0; i < 4; ++i) { RA[i] = *(const u32x4*)(ga + (size_t)(i * 32) * lda + (kt) * 64); if (i < NB) RB[i] = *(const u32x4*)(gb + (size_t)(i * 32) * ldb + (kt) * 64); } }
#define G_STORE(RA, RB, buf) { char* d_ = lds + (buf) * 36864 + soff; _Pragma("unroll") for (int i = 0; i < 4; ++i) { *(u32x4*)(d_ + i * 32 * 144) = RA[i]; if (i < NB) *(u32x4*)(d_ + 18432 + i * 32 * 144) = RB[i]; } }
#define G_COMP(buf) { const char* cur = lds + (buf) * 36864; _Pragma("unroll") for (int ks = 0; ks < 2; ++ks) { hf8 af[4], bfr[NB]; \
    _Pragma("unroll") for (int m = 0; m < 4; ++m) af[m] = *(const hf8*)(cur + aoff + m * 16 * 144 + ks * 64); \
    _Pragma("unroll") for (int n = 0; n < NB; ++n) bfr[n] = *(const hf8*)(cur + boff + n * 16 * 144 + ks * 64); \
    _Pragma("unroll") for (int m = 0; m < 4; ++m) _Pragma("unroll") for (int n = 0; n < NB; ++n) acc[m][n] = __builtin_amdgcn_mfma_f32_16x16x32_f16(af[m], bfr[n], acc[m][n], 0, 0, 0); } }
  G_LOAD(ra0, rb0, 0)
  { const int k1 = nk > 1 ? 1 : 0; G_LOAD(ra1, rb1, k1) }
  G_STORE(ra0, rb0, 0)
  __syncthreads();
  for (int kt = 0; kt < nk; kt += 2) {
    { const int k2 = kt + 2 < nk ? kt + 2 : nk - 1; G_LOAD(ra0, rb0, k2) }
    G_COMP(0)
    G_STORE(ra1, rb1, 1)
    __syncthreads();
    { const int k3 = kt + 3 < nk ? kt + 3 : nk - 1; G_LOAD(ra1, rb1, k3) }
    if (kt + 1 < nk) G_COMP(1)
    G_STORE(ra0, rb0, 0)
    __syncthreads();
  }
}
__device__ __forceinline__ void gemm_main(const bf16_t* __restrict__ A, int lda, const bf16_t* __restrict__ B, int ldb, int K, f32x4 (&acc)[4][4], char* lds) {
  gemm_main_t<4>(A, lda, B, ldb, K, acc, lds);
}

__device__ __forceinline__ bool tile_map(int it, int Mt, int Nt, int SN, int& tm, int& tn) {
  const int b = blockIdx.x, xcd = b & 7, li = b >> 3, nloc = gridDim.x >> 3;
  const int T = 8 * SN; const int nsn = Nt / SN; const int nsuper = (Mt >> 3) * nsn;
  const int o = li + it * nloc; const int k = o / T, w = o - k * T;
  const int s = xcd + 8 * k;
  if (s >= nsuper) return false;
  const int sm = s / nsn, sn = s - sm * nsn;
  tm = sm * 8 + (w & 7); tn = sn * SN + (w >> 3);
  return true;
}
#define ZERO_ACC(a) _Pragma("unroll") for (int m_ = 0; m_ < 4; ++m_) _Pragma("unroll") for (int n_ = 0; n_ < 4; ++n_) a[m_][n_] = (f32x4){0.f, 0.f, 0.f, 0.f};
#define EPI_VARS const int tid = get_tid(), lane = tid & 63, wid = tid >> 6, wr = wid >> 1, wc = wid & 1, fr = lane & 15, fq = lane >> 4; (void)wr; (void)wc; (void)fr; (void)fq;
#define EPI_ROW_BEGIN(m0) _Pragma("unroll") for (int m = 0; m < 4; ++m) _Pragma("unroll") for (int j = 0; j < 4; ++j) { const int row = (m0) + wr * 64 + m * 16 + fq * 4 + j; (void)row;
#define EPI_COL_BEGIN(n0) _Pragma("unroll") for (int n = 0; n < 4; ++n) { const int col = (n0) + wc * 64 + n * 16 + fr; const float val = acc[m][n][j]; (void)col; (void)val;
#define EPI_COL_END }
#define EPI_ROW_END }
#define EPI_BEGIN(m0, n0) EPI_ROW_BEGIN(m0) EPI_COL_BEGIN(n0)
#define EPI_END } }

struct Job { const float* src; int K, N; int dst; int mode; };
__device__ __forceinline__ Job get_job(const P& p, int l, int j) {
  Job r; r.mode = 0;
  switch (j) {
    case 0: r.src = p.in[8] + (size_t)(l * 2 + 0) * 1024 * 2816; r.K = 1024; r.N = 2816; r.dst = W_GU0; r.mode = 1; break;
    case 1: r.src = p.in[9] + (size_t)(l * 2 + 0) * 1024 * 2816; r.K = 1024; r.N = 2816; r.dst = W_GU0; r.mode = 2; break;
    case 2: r.src = p.in[10] + (size_t)(l * 2 + 0) * 2816 * 1024; r.K = 2816; r.N = 1024; r.dst = W_D0; break;
    case 3: r.src = p.in[8] + (size_t)(l * 2 + 1) * 1024 * 2816; r.K = 1024; r.N = 2816; r.dst = W_GU1; r.mode = 1; break;
    case 4: r.src = p.in[9] + (size_t)(l * 2 + 1) * 1024 * 2816; r.K = 1024; r.N = 2816; r.dst = W_GU1; r.mode = 2; break;
    case 5: r.src = p.in[10] + (size_t)(l * 2 + 1) * 2816 * 1024; r.K = 2816; r.N = 1024; r.dst = W_D1; break;
    case 6: r.src = p.in[11] + (size_t)l * 1024 * 6288; r.K = 1024; r.N = 6288; r.dst = W_IN; break;
    case 7: r.src = p.in[14] + (size_t)(l * 2 + 0) * 64 * 384; r.K = 64; r.N = 384; r.dst = W_WUP0; break;
    case 8: r.src = p.in[14] + (size_t)(l * 2 + 1) * 64 * 384; r.K = 64; r.N = 384; r.dst = W_WUP1; break;
    case 9: r.src = p.in[16] + (size_t)(l * 2 + 0) * 64 * 384; r.K = 64; r.N = 384; r.dst = W_AUP0; break;
    case 10: r.src = p.in[16] + (size_t)(l * 2 + 1) * 64 * 384; r.K = 64; r.N = 384; r.dst = W_AUP1; break;
    case 11: r.src = p.in[17] + (size_t)l * 128 * 384; r.K = 128; r.N = 384; r.dst = W_GUP; break;
    case 12: r.src = p.in[31] + (size_t)l * 256 * 256; r.K = 256; r.N = 256; r.dst = W_GLU; break;
    case 13: r.src = p.in[35] + (size_t)l * 384 * 1024; r.K = 384; r.N = 1024; r.dst = W_UPRW; break;
    case 14: r.src = p.in[36] + (size_t)l * 256 * 1024; r.K = 256; r.N = 1024; r.dst = W_UPS5; break;
    case 15: r.src = p.in[37] + (size_t)l * 384 * 1024; r.K = 384; r.N = 1024; r.dst = W_UPML; break;
    default: r.src = p.in[39] + (size_t)l * 1024 * 1024; r.K = 1024; r.N = 1024; r.dst = W_OUT; break;
  }
  return r;
}
#define NJOBS 17
__device__ void mod_task(const P& p, int t, char* lds) {
  float* sc = (float*)lds;
  float* red = sc + 5 * 1024;
  const int tid = get_tid();
  for (int i = tid; i < 5 * 1024; i += NTHR) {
    int v = i >> 10, k = i & 1023;
    float c = v < 4 ? p.in[1][v * 1024 + k] : p.in[3][k];
    sc[i] = siluf_(c);
  }
  __syncthreads();
  const int c0 = t * 64; const int l = c0 / 9216; const int j0 = c0 % 9216;
  const int col = tid & 63, part = tid >> 6;
  const float* w = p.in[4] + ((size_t)l * 1024 + part * 256) * 9216 + j0 + col;
  float a0 = 0, a1 = 0, a2 = 0, a3 = 0, a4 = 0;
  const float* s = sc + part * 256;
#pragma unroll 8
  for (int i = 0; i < 256; ++i) {
    float wv = w[(size_t)i * 9216];
    a0 += s[i] * wv; a1 += s[1024 + i] * wv; a2 += s[2048 + i] * wv; a3 += s[3072 + i] * wv; a4 += s[4096 + i] * wv;
  }
  red[(part * 5 + 0) * 64 + col] = a0; red[(part * 5 + 1) * 64 + col] = a1; red[(part * 5 + 2) * 64 + col] = a2;
  red[(part * 5 + 3) * 64 + col] = a3; red[(part * 5 + 4) * 64 + col] = a4;
  __syncthreads();
  for (int i = tid; i < 320; i += NTHR) {
    int v = i >> 6, c = i & 63;
    float sum = red[(0 * 5 + v) * 64 + c] + red[(1 * 5 + v) * 64 + c] + red[(2 * 5 + v) * 64 + c] + red[(3 * 5 + v) * 64 + c];
    p.mod[(size_t)(l * 5 + v) * 9216 + j0 + c] = sum + p.in[5][(size_t)l * 9216 + j0 + c];
  }
  __syncthreads();
}
__device__ __forceinline__ void ph_convert(const P& p, int l, bool with_mod, char* lds) {
  const int tid = get_tid();
  int ntiles[NJOBS]; int total = 0;
#pragma unroll
  for (int j = 0; j < NJOBS; ++j) { Job jb = get_job(p, l, j); ntiles[j] = (jb.K >> 6) * ((jb.N + 63) >> 6); total += ntiles[j]; }
  const int nmod = with_mod ? 288 : 0;
  float* tile = (float*)lds;
  for (int t = blockIdx.x; t < total + nmod; t += gridDim.x) {
    if (t < nmod) { mod_task(p, t, lds); continue; }
    int tt = t - nmod; int j = 0;
#pragma unroll
    for (int q = 0; q < NJOBS; ++q) { if (j == q && tt >= ntiles[q]) { tt -= ntiles[q]; j = q + 1; } }
    Job jb = get_job(p, l, j);
    const int nkt = jb.K >> 6;
    const int k0 = (tt % nkt) * 64, n0 = (tt / nkt) * 64;
    {
      const int c = tid & 63, r0 = tid >> 6;
      const bool ok = (n0 + c) < jb.N;
#pragma unroll
      for (int i = 0; i < 16; ++i) { int r = r0 + i * 4; tile[r * 65 + c] = ok ? jb.src[(size_t)(k0 + r) * jb.N + n0 + c] : 0.f; }
    }
    __syncthreads();
    {
      const int nn = tid >> 2, q = tid & 3; const int n = n0 + nn;
      if (n < jb.N) {
        int drow = n;
        if (jb.mode == 1) drow = (n >> 5) * 64 + (n & 31);
        else if (jb.mode == 2) drow = (n >> 5) * 64 + 32 + (n & 31);
        bf16_t* d = p.W + jb.dst + (size_t)drow * jb.K + k0 + q * 16;
        unsigned pk[8];
#pragma unroll
        for (int i = 0; i < 8; ++i) { unsigned lo = f2bf(tile[(q * 16 + 2 * i) * 65 + nn]); unsigned hi = f2bf(tile[(q * 16 + 2 * i + 1) * 65 + nn]); pk[i] = lo | (hi << 16); }
        *(uint4*)d = make_uint4(pk[0], pk[1], pk[2], pk[3]);
        *(uint4*)(d + 8) = make_uint4(pk[4], pk[5], pk[6], pk[7]);
      }
    }
    __syncthreads();
  }
}

__device__ __forceinline__ void ph_rows(const P& p, int mode, int l, int ln_idx, int Mrows, bool writeU, int ul, int ks) {
  const int lane = get_tid() & 63, wid = get_tid() >> 6;
  const int nw = gridDim.x * 4;
  const float* g = p.in[6] + (size_t)(l * 3 + ln_idx) * 1024;
  const float* b = p.in[7] + (size_t)(l * 3 + ln_idx) * 1024;
  for (int m = blockIdx.x * 4 + wid; m < Mrows; m += nw) {
    float* s = srow(p, m);
    const float* src = s;
    if (mode == 0) src = m < M_LAT ? p.in[0] + (size_t)m * 1024 : p.in[2] + (size_t)(m - M_LAT) * 1024;
    float4 v[4];
#pragma unroll
    for (int i = 0; i < 4; ++i) v[i] = *(const float4*)(src + lane * 4 + i * 256);
    if (mode == 1) {
      float sum = 0;
#pragma unroll
      for (int i = 0; i < 4; ++i) sum += v[i].x + v[i].y + v[i].z + v[i].w;
      sum = wavesum(sum);
      const float mean = sum * (1.f / 1024.f);
      float sq = 0;
#pragma unroll
      for (int i = 0; i < 4; ++i) { v[i].x -= mean; v[i].y -= mean; v[i].z -= mean; v[i].w -= mean; sq += v[i].x * v[i].x + v[i].y * v[i].y + v[i].z * v[i].z + v[i].w * v[i].w; }
      sq = wavesum(sq);
      const float rstd = rsqrtf(sq * (1.f / 1024.f) + 1e-5f);
#pragma unroll
      for (int i = 0; i < 4; ++i) {
        float4 gg = *(const float4*)(g + lane * 4 + i * 256), bb = *(const float4*)(b + lane * 4 + i * 256);
        v[i].x = v[i].x * rstd * gg.x + bb.x; v[i].y = v[i].y * rstd * gg.y + bb.y; v[i].z = v[i].z * rstd * gg.z + bb.z; v[i].w = v[i].w * rstd * gg.w + bb.w;
      }
    }
#pragma unroll
    for (int i = 0; i < 4; ++i) *(float4*)(s + lane * 4 + i * 256) = v[i];
    if (writeU) {
      const float* sh = modp(p, ul, m, ks); const float* scl = modp(p, ul, m, ks + 1);
#pragma unroll
      for (int i = 0; i < 4; ++i) {
        float4 a = *(const float4*)(sh + lane * 4 + i * 256), c = *(const float4*)(scl + lane * 4 + i * 256);
        unsigned lo = f2bf(v[i].x * (1.f + c.x) + a.x) | ((unsigned)f2bf(v[i].y * (1.f + c.y) + a.y) << 16);
        unsigned hi = f2bf(v[i].z * (1.f + c.z) + a.z) | ((unsigned)f2bf(v[i].w * (1.f + c.w) + a.w) << 16);
        *(uint2*)(p.U + (size_t)m * 1024 + lane * 4 + i * 256) = make_uint2(lo, hi);
      }
    }
  }
}

__device__ __forceinline__ void ph_ffn_up(const P& p, int s, int Mt, char* lds) {
  EPI_VARS
  bf16_t* HM = (bf16_t*)p.R;
  const bf16_t* Wt = p.W + (s ? W_GU1 : W_GU0);
  const int ntile = Mt * 44;
  for (int it = 0;; ++it) {
    int tm, tn; if (!tile_map(it, Mt, 44, 4, tm, tn)) break; const int m0 = tm * 128, n0 = tn * 128;
    f32x4 acc[4][4]; ZERO_ACC(acc)
    gemm_main(p.U + (size_t)m0 * 1024, 1024, Wt + (size_t)n0 * 1024, 1024, 1024, acc, lds);
    const int hb = ((n0 + wc * 64) >> 6) * 32;
#pragma unroll
    for (int m = 0; m < 4; ++m)
#pragma unroll
      for (int n = 0; n < 2; ++n)
#pragma unroll
        for (int j = 0; j < 4; ++j) {
          const int row = m0 + wr * 64 + m * 16 + fq * 4 + j; const int hc = hb + n * 16 + fr;
          HM[(size_t)row * 2816 + hc] = f2bf(siluf_(acc[m][n][j]) * acc[m][n + 2][j]);
        }
  }
}
__device__ __forceinline__ void ph_ffn_down(const P& p, int l, int s, int Mt, char* lds) {
  EPI_VARS
  const bf16_t* HM = (const bf16_t*)p.R;
  const bf16_t* Wt = p.W + (s ? W_D1 : W_D0);
  const int gk = s ? 8 : 2;
  const int ntile = Mt * 8;
  for (int it = 0;; ++it) {
    int tm, tn; if (!tile_map(it, Mt, 8, 8, tm, tn)) break; const int m0 = tm * 128, n0 = tn * 128;
    f32x4 acc[4][4]; ZERO_ACC(acc)
    gemm_main(HM + (size_t)m0 * 2816, 2816, Wt + (size_t)n0 * 2816, 2816, 2816, acc, lds);
    EPI_ROW_BEGIN(m0)
      float* sp = srow(p, row) + n0 + wc * 64 + fr; const float* gp = modp(p, l, row, gk) + n0 + wc * 64 + fr;
#pragma unroll
      for (int n = 0; n < 4; ++n) sp[n * 16] = ALPHA * sp[n * 16] + 0.5f * gp[n * 16] * acc[m][n][j];
    EPI_ROW_END
  }
}

#define RW_ZRW(p) ((hf*)(p).R)
#define RW_RKV(p) (RW_ZRW(p) + (size_t)M_ALL * 1152)
#define RW_LA(p) ((bf16_t*)(RW_RKV(p) + (size_t)M_ALL * 1152))
#define RW_KK(p) ((hf*)(RW_LA(p) + (size_t)M_ALL * 256))
#define RW_KD(p) (RW_KK(p) + (size_t)M_ALL * 384)
#define RW_KA(p) (RW_KD(p) + (size_t)2 * M_ALL * 384)
#define RW_YR(p) (RW_KA(p) + (size_t)2 * M_ALL * 384)

#define S5_Z(p) ((float*)(p).R)
#define S5_YG(p) ((bf16_t*)(S5_Z(p) + (size_t)M_ALL * 256))
#define S5_E(p) ((float2*)(S5_YG(p) + (size_t)M_ALL * 256))
#define S5_X(p) (S5_E(p) + (size_t)2 * 4 * 132 * 1024)

#define ML_Z(p) ((hf*)(p).R)
#define ML_GL(p) ((float*)(ML_Z(p) + (size_t)M_ALL * 1536))
#define ML_QK(p) ((hf*)(ML_GL(p) + (size_t)M_ALL * 16))
#define ML_DC(p) ((float*)(ML_QK(p) + (size_t)M_ALL * 768))
#define ML_DN(p) (ML_DC(p) + (size_t)4224 * 9216)
#define ML_SC(p) (ML_DN(p) + (size_t)4224 * 96)
#define ML_MP(p) (ML_SC(p) + (size_t)4224 * 2)

__device__ __forceinline__ void ph_z_rw(const P& p, char* lds) {
  EPI_VARS
  hf* ZRW = RW_ZRW(p); bf16_t* LA = RW_LA(p);
  const int Mt = 264; const int ntile = Mt * 11;
  for (int it = 0;; ++it) {
    int tm, tn; if (!tile_map(it, Mt, 11, 11, tm, tn)) break; const int m0 = tm * 128;
    const int wrow = tn < 9 ? tn * 128 : 2960 + (tn - 9) * 128;
    f32x4 acc[4][4]; ZERO_ACC(acc)
    gemm_main(p.U + (size_t)m0 * 1024, 1024, p.W + W_IN + (size_t)wrow * 1024, 1024, 1024, acc, lds);
    if (tn < 9) {
      EPI_BEGIN(m0, tn * 128)
        ZRW[(size_t)row * 1152 + col] = (hf)val;
      EPI_END
    } else {
      EPI_BEGIN(m0, (tn - 9) * 128)
        float o = col < 64 ? tanhf(val) : (col < 128 ? val : sigmoidf_(val));
        LA[(size_t)row * 256 + col] = f2bf(o);
      EPI_END
    }
  }
}
__device__ __forceinline__ void ph_z_s5(const P& p, char* lds) {
  EPI_VARS
  float* Z = S5_Z(p);
  const int Mt = 264; const int ntile = Mt * 2;
  for (int it = 0;; ++it) {
    int tm, tn; if (!tile_map(it, Mt, 2, 2, tm, tn)) break; const int m0 = tm * 128;
    f32x4 acc[4][4]; ZERO_ACC(acc)
    gemm_main(p.U + (size_t)m0 * 1024, 1024, p.W + W_IN + (size_t)(2704 + tn * 128) * 1024, 1024, 1024, acc, lds);
    EPI_BEGIN(m0, tn * 128)
      Z[(size_t)row * 256 + col] = val;
    EPI_END
  }
}
__device__ __forceinline__ void ph_z_ml(const P& p, char* lds) {
  EPI_VARS
  hf* Z = ML_Z(p); float* GL = ML_GL(p);
  const int Mt = 264; const int ntile = Mt * 13;
  for (int it = 0;; ++it) {
    int tm, tn; if (!tile_map(it, Mt, 13, 13, tm, tn)) break; const int m0 = tm * 128;
    f32x4 acc[4][4]; ZERO_ACC(acc)
    gemm_main(p.U + (size_t)m0 * 1024, 1024, p.W + W_IN + (size_t)(1152 + tn * 128) * 1024, 1024, 1024, acc, lds);
    if (tn < 12) {
      EPI_BEGIN(m0, tn * 128)
        Z[(size_t)row * 1536 + col] = (hf)val;
      EPI_END
    } else {
      EPI_BEGIN(m0, 0)
        if (col < 16) GL[(size_t)row * 16 + col] = val;
      EPI_END
    }
  }
}

__device__ __forceinline__ void ph_conv(const P& p, int l, int which) {
  const int nch = which == 0 ? 144 : 96;
  const int ldin = which == 0 ? 1152 : 1536;
  const hf* Zin = which == 0 ? RW_ZRW(p) : ML_Z(p);
  const int cbase = which == 0 ? 0 : 1152;
  const float* cw = p.in[12] + (size_t)l * 9 * 1920;
  const size_t total = (size_t)M_ALL * nch;
  for (size_t idx = (size_t)blockIdx.x * NTHR + get_tid(); idx < (total + 63) / 64 * 64; idx += (size_t)gridDim.x * NTHR) {
    const bool act = idx < total;
    const int m = act ? (int)(idx / nch) : 0; const int ch = act ? (int)(idx % nch) : 0; const int c0 = ch * 8;
    float o[8];
#pragma unroll
    for (int i = 0; i < 8; ++i) o[i] = 0.f;
    if (m < M_LAT) {
      const int bb = m >> 13, tt = m & 8191, gr = tt >> 6, gc = tt & 63;
#pragma unroll
      for (int dr = -1; dr <= 1; ++dr)
#pragma unroll
        for (int dc = -1; dc <= 1; ++dc) {
          const int rr = gr + dr, cc = gc + dc;
          if (rr >= 0 && rr < 128 && cc >= 0 && cc < 64) {
            const int mm = (bb << 13) + rr * 64 + cc;
            hf8 z = *(const hf8*)(Zin + (size_t)mm * ldin + c0);
            const float* w = cw + ((dr + 1) * 3 + (dc + 1)) * 1920 + cbase + c0;
            float4 w0 = *(const float4*)w, w1 = *(const float4*)(w + 4);
            o[0] += (float)z[0] * w0.x; o[1] += (float)z[1] * w0.y; o[2] += (float)z[2] * w0.z; o[3] += (float)z[3] * w0.w;
            o[4] += (float)z[4] * w1.x; o[5] += (float)z[5] * w1.y; o[6] += (float)z[6] * w1.z; o[7] += (float)z[7] * w1.w;
          }
        }
    } else {
      const int tt = (m - M_LAT) & 255;
#pragma unroll
      for (int dc = -1; dc <= 1; ++dc) {
        const int t2 = tt + dc;
        if (t2 >= 0 && t2 < 256) {
          hf8 z = *(const hf8*)(Zin + (size_t)(m + dc) * ldin + c0);
          const float* w = cw + (3 + (dc + 1)) * 1920 + cbase + c0;
          float4 w0 = *(const float4*)w, w1 = *(const float4*)(w + 4);
          o[0] += (float)z[0] * w0.x; o[1] += (float)z[1] * w0.y; o[2] += (float)z[2] * w0.z; o[3] += (float)z[3] * w0.w;
          o[4] += (float)z[4] * w1.x; o[5] += (float)z[5] * w1.y; o[6] += (float)z[6] * w1.z; o[7] += (float)z[7] * w1.w;
        }
      }
    }
    if (which == 0) {
      const bool isk = act && (c0 >= 384) && (c0 < 768);
      float kkv[8]; float ss = 0.f;
      if (isk) {
        const float* kkw = p.in[18] + (size_t)l * 384 + (c0 - 384);
#pragma unroll
        for (int i = 0; i < 8; ++i) { kkv[i] = o[i] * kkw[i]; ss += kkv[i] * kkv[i]; }
      } else {
#pragma unroll
        for (int i = 0; i < 8; ++i) kkv[i] = 0.f;
      }
      ss += __shfl_xor(ss, 1); ss += __shfl_xor(ss, 2); ss += __shfl_xor(ss, 4);
      if (act) {
        hf8 ov;
#pragma unroll
        for (int i = 0; i < 8; ++i) ov[i] = (hf)o[i];
        *(hf8*)(RW_RKV(p) + (size_t)m * 1152 + c0) = ov;
        if (isk) {
          const float rn = rsqrtf(fmaxf(ss, 1e-24f));
          hf8 kv;
#pragma unroll
          for (int i = 0; i < 8; ++i) kv[i] = (hf)(kkv[i] * rn);
          *(hf8*)(RW_KK(p) + (size_t)m * 384 + (c0 - 384)) = kv;
        }
      }
    } else if (act) {
      const float sc = c0 >= 384 ? 0.10206207261596575f : 1.f;
      hf8 ov;
#pragma unroll
      for (int i = 0; i < 8; ++i) ov[i] = (hf)(siluf_(o[i]) * sc);
      *(hf8*)(ML_QK(p) + (size_t)m * 768 + c0) = ov;
    }
  }
}

__device__ __forceinline__ void ph_lora(const P& p, int l, char* lds) {
  EPI_VARS
  hf* ZRW = RW_ZRW(p); const hf* RKV = RW_RKV(p); const bf16_t* LA = RW_LA(p); const hf* KK = RW_KK(p);
  hf* KD = RW_KD(p); hf* KA = RW_KA(p);
  const int Mt = 264; const int ntile = Mt * 15;
  for (int it = 0;; ++it) {
    int tm, q; if (!tile_map(it, Mt, 15, 15, tm, q)) break; const int job = q / 3, tn = q % 3; const int m0 = tm * 128, n0 = tn * 128;
    f32x4 acc[4][4]; ZERO_ACC(acc)
    if (job < 2) {
      const int d = job;
      gemm_main(LA + (size_t)m0 * 256, 256, p.W + (d ? W_WUP1 : W_WUP0) + (size_t)n0 * 64, 64, 64, acc, lds);
      const float* w0 = p.in[13] + (size_t)(l * 2 + d) * 384;
      EPI_BEGIN(m0, n0)
        const float e = sigmoidf_(w0[col] + val) * 0.6065306597126334f;
        ZRW[(size_t)row * 1152 + d * 384 + col] = (hf)(-expm1f(-e));
      EPI_END
    } else if (job < 4) {
      const int d = job - 2;
      gemm_main(LA + (size_t)m0 * 256 + 64, 256, p.W + (d ? W_AUP1 : W_AUP0) + (size_t)n0 * 64, 64, 64, acc, lds);
      const float* a0 = p.in[15] + (size_t)(l * 2 + d) * 384; const float* kaw = p.in[19] + (size_t)l * 384;
      EPI_ROW_BEGIN(m0)
        const int cb = n0 + wc * 64 + fr;
        const hf* kp = RKV + (size_t)row * 1152 + 384 + cb; const hf* kkp = KK + (size_t)row * 384 + cb;
        hf* kdp = KD + ((size_t)d * M_ALL + row) * 384 + cb; hf* kap = KA + ((size_t)d * M_ALL + row) * 384 + cb;
#pragma unroll
        for (int n = 0; n < 4; ++n) {
          const float a = sigmoidf_(a0[cb + n * 16] + acc[m][n][j]);
          kdp[n * 16] = (hf)((float)kp[n * 16] * (1.f + (a - 1.f) * kaw[cb + n * 16]));
          kap[n * 16] = (hf)((float)kkp[n * 16] * a);
        }
      EPI_ROW_END
    } else {
      gemm_main(LA + (size_t)m0 * 256 + 128, 256, p.W + W_GUP + (size_t)n0 * 128, 128, 128, acc, lds);
      EPI_BEGIN(m0, n0)
        ZRW[(size_t)row * 1152 + 768 + col] = (hf)val;
      EPI_END
    }
  }
}

#define RW_CH 32
#define RW_BUF 21504
__device__ __forceinline__ void ph_rwscan(const P& p, char* lds) {
  const hf* ZRW = RW_ZRW(p); hf* RKV = RW_RKV(p); const hf* KK = RW_KK(p);
  const int tid = get_tid(), lane = tid & 63, wid = tid >> 6;
  char* ybuf = lds + 3 * RW_BUF;
  for (int t = blockIdx.x; t < 192; t += gridDim.x) {
    const int rqq = t & 3, h = (t >> 2) % 6, b = (t / 24) & 3, d = t / 96;
    const int rsub = lane >> 4, g = lane & 15; const int rl = wid * 4 + rsub;
    const int sgn = d ? -1 : 1;
    const int sstep = tid >> 3, sseg = tid & 7;
    const hf* g_r = RKV + h * 64 + sseg * 8; const hf* g_kk = KK + h * 64 + sseg * 8; const hf* g_dd = ZRW + d * 384 + h * 64 + sseg * 8;
    const hf* g_kd = RW_KD(p) + (size_t)d * M_ALL * 384 + h * 64 + sseg * 8; const hf* g_ka = RW_KA(p) + (size_t)d * M_ALL * 384 + h * 64 + sseg * 8;
    const hf* g_v = RKV + 768 + h * 64 + rqq * 16 + (tid & 1) * 8;
    hf* g_y = d == 0 ? (RKV + 384 + h * 64 + rqq * 16 + (tid & 1) * 8) : (RW_YR(p) + h * 64 + rqq * 16 + (tid & 1) * 8);
    const int ldy = d == 0 ? 1152 : 384;
    uint4 q0, q1, q2, q3, q4, q5;
#define RW_M0(pp) ((pp) < 256 ? (M_LAT + b * 256 + (d ? 255 - (pp) : (pp))) : (b * 8192 + (d ? 8447 - (pp) : (pp) - 256)))
#define RW_GLOAD(c) { const int mb_ = RW_M0((c) * RW_CH); const size_t mm = (size_t)(mb_ + sgn * sstep); \
      q0 = *(const uint4*)(g_r + mm * 1152); q1 = *(const uint4*)(g_kk + mm * 384); q2 = *(const uint4*)(g_dd + mm * 1152); \
      q3 = *(const uint4*)(g_kd + mm * 384); q4 = *(const uint4*)(g_ka + mm * 384); \
      if (tid < 64) { const size_t mv = (size_t)(mb_ + sgn * (tid >> 1)); q5 = *(const uint4*)(g_v + mv * 1152); } }
#define RW_SSTORE(c) { char* bb_ = lds + ((c) % 3) * RW_BUF + sstep * 128 + sseg * 16; \
      *(uint4*)(bb_) = q0; *(uint4*)(bb_ + 4096) = q1; *(uint4*)(bb_ + 8192) = q2; *(uint4*)(bb_ + 12288) = q3; *(uint4*)(bb_ + 16384) = q4; \
      if (tid < 64) *(uint4*)(lds + ((c) % 3) * RW_BUF + 20480 + tid * 16) = q5; }
    float S0 = 0.f, S1 = 0.f, S2 = 0.f, S3 = 0.f;
    RW_GLOAD(0) RW_SSTORE(0)
    RW_GLOAD(1) RW_SSTORE(1)
    __syncthreads();
    const int NCH = 8448 / RW_CH;
    for (int c = 0; c < NCH; ++c) {
      if (c + 2 < NCH) RW_GLOAD(c + 2)
      if (c > 0 && tid < 64) {
        const int mb_ = RW_M0((c - 1) * RW_CH); const size_t mv = (size_t)(mb_ + sgn * (tid >> 1));
        *(uint4*)(g_y + mv * ldy) = *(const uint4*)(ybuf + ((c - 1) & 1) * 1024 + tid * 16);
      }
      const char* cb = lds + (c % 3) * RW_BUF + g * 8;
      hf* yb = (hf*)(ybuf + (c & 1) * 1024) + rl;
      const char* vb = lds + (c % 3) * RW_BUF + 20480 + rl * 2;
      hf4 r4 = *(const hf4*)(cb), k4 = *(const hf4*)(cb + 4096), d4 = *(const hf4*)(cb + 8192), kd4 = *(const hf4*)(cb + 12288), ka4 = *(const hf4*)(cb + 16384);
      hf vh = *(const hf*)(vb);
#pragma unroll
      for (int s = 0; s < RW_CH; ++s) {
        hf4 r4n = r4, k4n = k4, d4n = d4, kd4n = kd4, ka4n = ka4; hf vhn = vh;
        if (s + 1 < RW_CH) {
          r4n = *(const hf4*)(cb + (s + 1) * 128); k4n = *(const hf4*)(cb + 4096 + (s + 1) * 128); d4n = *(const hf4*)(cb + 8192 + (s + 1) * 128);
          kd4n = *(const hf4*)(cb + 12288 + (s + 1) * 128); ka4n = *(const hf4*)(cb + 16384 + (s + 1) * 128); vhn = *(const hf*)(vb + (s + 1) * 32);
        }
        const float vv = (float)vh;
        float sa = S0 * (float)k4[0] + S1 * (float)k4[1] + S2 * (float)k4[2] + S3 * (float)k4[3];
        sa = rowsum16(sa);
        S0 = fmaf(-S0, (float)d4[0], S0); S1 = fmaf(-S1, (float)d4[1], S1); S2 = fmaf(-S2, (float)d4[2], S2); S3 = fmaf(-S3, (float)d4[3], S3);
        S0 = fmaf(vv, (float)kd4[0], S0); S1 = fmaf(vv, (float)kd4[1], S1); S2 = fmaf(vv, (float)kd4[2], S2); S3 = fmaf(vv, (float)kd4[3], S3);
        S0 = fmaf(-sa, (float)ka4[0], S0); S1 = fmaf(-sa, (float)ka4[1], S1); S2 = fmaf(-sa, (float)ka4[2], S2); S3 = fmaf(-sa, (float)ka4[3], S3);
        float y = S0 * (float)r4[0] + S1 * (float)r4[1] + S2 * (float)r4[2] + S3 * (float)r4[3];
        y = rowsum16(y);
        if (g == 0) yb[s * 16] = (hf)y;
        r4 = r4n; k4 = k4n; d4 = d4n; kd4 = kd4n; ka4 = ka4n; vh = vhn;
      }
      if (c + 2 < NCH) RW_SSTORE(c + 2)
      __syncthreads();
    }
    if (tid < 64) {
      const int mb_ = RW_M0((NCH - 1) * RW_CH); const size_t mv = (size_t)(mb_ + sgn * (tid >> 1));
      *(uint4*)(g_y + mv * ldy) = *(const uint4*)(ybuf + ((NCH - 1) & 1) * 1024 + tid * 16);
    }
    __syncthreads();
  }
}

__device__ __forceinline__ void ph_rwpost(const P& p, int l) {
  const hf* ZRW = RW_ZRW(p); const hf* RKV = RW_RKV(p); const hf* YR = RW_YR(p);
  const int lane = get_tid() & 63, wid = get_tid() >> 6;
  const int nw = gridDim.x * 4;
  for (int t = blockIdx.x * 4 + wid; t < M_ALL * 6; t += nw) {
    const int m = t / 6, h = t % 6; const int c = h * 64 + lane;
    const float ys = (float)RKV[(size_t)m * 1152 + 384 + c] + (float)YR[(size_t)m * 384 + c];
    const float mean = wavesum(ys) * (1.f / 64.f);
    const float xc = ys - mean;
    const float var = wavesum(xc * xc) * (1.f / 64.f);
    float y = xc * rsqrtf(var + 64e-5f) * p.in[21][(size_t)l * 384 + c] + p.in[22][(size_t)l * 384 + c];
    const float r = (float)RKV[(size_t)m * 1152 + c], v = (float)RKV[(size_t)m * 1152 + 768 + c];
    const float rk = p.in[20][(size_t)l * 384 + c];
    const float kd0 = (float)RW_KD(p)[(size_t)m * 384 + c], kd1 = (float)RW_KD(p)[((size_t)M_ALL + m) * 384 + c];
    const float bs = wavesum(r * (kd0 + kd1) * rk);
    y = (y + bs * v) * (float)ZRW[(size_t)m * 1152 + 768 + c];
    p.Y[(size_t)m * 1024 + c] = f2bf(y);
  }
}

struct S5C { float ar, ai; float br[16], bi[16]; };
__device__ __forceinline__ void s5_consts(const P& p, int l, int d, int g, int n, S5C& c) {
  const int ig = (l * 2 + d) * 16 + g;
  const float lr = fminf(p.in[23][(size_t)ig * 64 + n], -1e-4f), li = p.in[24][(size_t)ig * 64 + n];
  const float dt = expf(p.in[25][ig]);
  const float mag = expf(lr * dt);
  c.ar = mag * cosf(li * dt); c.ai = mag * sinf(li * dt);
  const float nr = c.ar - 1.f, ni = c.ai; const float den = 1.f / (lr * lr + li * li);
  const float cr = (nr * lr + ni * li) * den, ci = (ni * lr - nr * li) * den;
  const float* bre = p.in[26] + ((size_t)ig * 64 + n) * 16; const float* bim = p.in[27] + ((size_t)ig * 64 + n) * 16;
#pragma unroll
  for (int h = 0; h < 16; ++h) { const float xr = bre[h], xi = bim[h]; c.br[h] = cr * xr - ci * xi; c.bi[h] = cr * xi + ci * xr; }
}
__device__ __forceinline__ int s5_m0(int b, int tc) { return tc < 128 ? b * 8192 + tc * 64 : M_LAT + b * 256 + (tc - 128) * 64; }
__device__ __forceinline__ int chain_pos(int d, int tc) { return d == 0 ? (tc < 128 ? tc + 4 : tc - 128) : (tc < 128 ? 131 - tc : 131 - tc); }
__device__ __forceinline__ void ph_s5_pass(const P& p, int l, int pass, char* lds) {
  const int lane = get_tid() & 63, wid = get_tid() >> 6;
  float* ub = (float*)lds + wid * 2048;
  float* yb = ub + 1024;
  const float* Z = S5_Z(p); float2* E = S5_E(p); const float2* X = S5_X(p); bf16_t* YG = S5_YG(p);
  const int nw = gridDim.x * 4;
  for (int t = blockIdx.x * 4 + wid; t < 4 * 132 * 16; t += nw) {
    const int g = t & 15, tc = (t >> 4) % 132, b = t / (16 * 132);
    const int m0 = s5_m0(b, tc);
#pragma unroll
    for (int i = 0; i < 4; ++i) { const int e = lane + i * 64; const int tok = e >> 2, q = e & 3;
      *(float4*)(ub + tok * 16 + q * 4) = *(const float4*)(Z + (size_t)(m0 + tok) * 256 + g * 16 + q * 4); }
    __builtin_amdgcn_s_waitcnt(0);
    __builtin_amdgcn_wave_barrier();
    for (int d = 0; d < 2; ++d) {
      S5C c; s5_consts(p, l, d, g, lane, c);
      const int cp = chain_pos(d, tc);
      const size_t sidx = (((size_t)(d * 4 + b) * 132 + cp) * 16 + g) * 64 + lane;
      float xr = 0.f, xi = 0.f;
      float cre[16], cim[16];
      if (pass == 3) {
        float2 x0 = X[sidx]; xr = x0.x; xi = x0.y;
        const int ig = (l * 2 + d) * 16 + g;
#pragma unroll
        for (int h = 0; h < 16; ++h) { cre[h] = p.in[28][((size_t)ig * 16 + h) * 64 + lane]; cim[h] = p.in[29][((size_t)ig * 16 + h) * 64 + lane]; }
      }
      for (int j = 0; j < 64; ++j) {
        const int tok = d ? 63 - j : j;
        float br = 0.f, bi = 0.f;
        const float* u = ub + tok * 16;
#pragma unroll
        for (int h = 0; h < 16; ++h) { const float uv = u[h]; br += c.br[h] * uv; bi += c.bi[h] * uv; }
        const float nr = c.ar * xr - c.ai * xi + br, ni = c.ar * xi + c.ai * xr + bi;
        xr = nr; xi = ni;
        if (pass == 3) {
          float pp[16];
#pragma unroll
          for (int h = 0; h < 16; ++h) pp[h] = cre[h] * xr - cim[h] * xi;
#pragma unroll
          for (int i = 0; i < 8; ++i) { const bool hi = lane & 1; float snd = hi ? pp[i] : pp[i + 8]; float rcv = __shfl_xor(snd, 1); pp[i] = (hi ? pp[i + 8] : pp[i]) + rcv; }
#pragma unroll
          for (int i = 0; i < 4; ++i) { const bool hi = lane & 2; float snd = hi ? pp[i] : pp[i + 4]; float rcv = __shfl_xor(snd, 2); pp[i] = (hi ? pp[i + 4] : pp[i]) + rcv; }
#pragma unroll
          for (int i = 0; i < 2; ++i) { const bool hi = lane & 4; float snd = hi ? pp[i] : pp[i + 2]; float rcv = __shfl_xor(snd, 4); pp[i] = (hi ? pp[i + 2] : pp[i]) + rcv; }
          { const bool hi = lane & 8; float snd = hi ? pp[0] : pp[1]; float rcv = __shfl_xor(snd, 8); pp[0] = (hi ? pp[1] : pp[0]) + rcv; }
          float tot = pp[0]; tot += __shfl_xor(tot, 16); tot += __shfl_xor(tot, 32);
          if (lane < 16) {
            const int hh = ((lane & 1) ? 8 : 0) + ((lane & 2) ? 4 : 0) + ((lane & 4) ? 2 : 0) + ((lane & 8) ? 1 : 0);
            if (d == 0) yb[tok * 16 + hh] = tot; else yb[tok * 16 + hh] += tot;
          }
        }
      }
      if (pass == 1) E[sidx] = make_float2(xr, xi);
    }
    if (pass == 3) {
      __builtin_amdgcn_s_waitcnt(0);
      __builtin_amdgcn_wave_barrier();
#pragma unroll
      for (int i = 0; i < 16; ++i) {
        const int e = lane + i * 64; const int tok = e >> 4, h = e & 15;
        float y = yb[e] + p.in[30][(size_t)l * 256 + g * 16 + h] * ub[e];
        const float inner = 0.7978845608028654f * (y + 0.044715f * y * y * y);
        y = 0.5f * y * (1.f + tanhf(inner));
        YG[(size_t)(m0 + tok) * 256 + g * 16 + h] = f2bf(y);
      }
    }
    __builtin_amdgcn_s_waitcnt(0);
    __builtin_amdgcn_wave_barrier();
  }
}
__device__ __forceinline__ void ph_s5_carry(const P& p, int l) {
  const float2* E = S5_E(p); float2* X = S5_X(p);
  for (int t = blockIdx.x * NTHR + get_tid(); t < 8192; t += gridDim.x * NTHR) {
    const int n = t & 63, g = (t >> 6) & 15, b = (t >> 10) & 3, d = t >> 12;
    const int ig = (l * 2 + d) * 16 + g;
    const float lr = fminf(p.in[23][(size_t)ig * 64 + n], -1e-4f), li = p.in[24][(size_t)ig * 64 + n];
    const float dt = expf(p.in[25][ig]);
    const float mag = expf(lr * dt * 64.f);
    float ar = expf(lr * dt) * cosf(li * dt), ai = expf(lr * dt) * sinf(li * dt);
#pragma unroll
    for (int i = 0; i < 6; ++i) { const float r2 = ar * ar - ai * ai, i2 = 2.f * ar * ai; ar = r2; ai = i2; }
    (void)mag;
    float xr = 0.f, xi = 0.f;
    const size_t base = (((size_t)(d * 4 + b) * 132) * 16 + g) * 64 + n;
    for (int cp0 = 0; cp0 < 132; cp0 += 12) {
      float2 ev[12];
#pragma unroll
      for (int u = 0; u < 12; ++u) ev[u] = E[base + (size_t)(cp0 + u) * 1024];
#pragma unroll
      for (int u = 0; u < 12; ++u) {
        X[base + (size_t)(cp0 + u) * 1024] = make_float2(xr, xi);
        const float nr = ar * xr - ai * xi + ev[u].x, ni = ar * xi + ai * xr + ev[u].y;
        xr = nr; xi = ni;
      }
    }
  }
}
__device__ __forceinline__ void ph_glu(const P& p, int l, char* lds) {
  EPI_VARS
  const bf16_t* YG = S5_YG(p);
  const int Mt = 264; const int ntile = Mt * 2;
  const float* gb = p.in[32] + (size_t)l * 256;
  for (int it = 0;; ++it) {
    int tm, tn; if (!tile_map(it, Mt, 2, 2, tm, tn)) break; const int m0 = tm * 128, n0 = tn * 128;
    f32x4 acc[4][4]; ZERO_ACC(acc)
    gemm_main(YG + (size_t)m0 * 256, 256, p.W + W_GLU + (size_t)n0 * 256, 256, 256, acc, lds);
    EPI_BEGIN(m0, n0)
      const float y = bf2f(YG[(size_t)row * 256 + col]);
      p.Y[(size_t)row * 1024 + 384 + col] = f2bf(y * sigmoidf_(val + gb[col]));
    EPI_END
  }
}

__device__ __forceinline__ float logsigf_(float x) { return fminf(x, 0.f) - log1pf(__expf(-fabsf(x))); }
__device__ __forceinline__ void ml_gates(const P& p, int l, int d, int h, int m0, int lane, float& bcum, float& ic) {
  const int tok = d ? 63 - lane : lane;
  const float* gl = ML_GL(p) + (size_t)(m0 + tok) * 16;
  const float* gb = p.in[33] + (size_t)(l * 2 + d) * 8;
  ic = gl[d * 8 + h] + gb[h];
  float f = logsigf_(gl[d * 8 + 4 + h] + gb[4 + h]);
#pragma unroll
  for (int o = 1; o < 64; o <<= 1) { float v = __shfl_up(f, o); if (lane >= o) f += v; }
  bcum = f;
}
__device__ __forceinline__ void ml_gates2(const P& p, int l, int d, int h, int m0, int lane, float& bc, float& ic, float& tot) {
  const float* gl = ML_GL(p) + (size_t)(m0 + lane) * 16;
  const float* gb = p.in[33] + (size_t)(l * 2 + d) * 8;
  ic = gl[d * 8 + h] + gb[h];
  const float f0 = logsigf_(gl[d * 8 + 4 + h] + gb[4 + h]);
  float f = f0;
#pragma unroll
  for (int o = 1; o < 64; o <<= 1) { float v = __shfl_up(f, o); if (lane >= o) f += v; }
  tot = __shfl(f, 63);
  bc = d ? (tot - f + f0) : f;
}
#define MLQ 208
#define MLS 144
__device__ __forceinline__ void ph_ml_a(const P& p, int l, char* lds) {
  char* vt = lds; char* kt = lds + 13824; float* wg = (float*)(lds + 27648);
  const int tid = get_tid(), lane = tid & 63, wid = tid >> 6, fr = lane & 15, fq = lane >> 4;
  const hf* QK = ML_QK(p); const hf* Z = ML_Z(p);
  for (int t = blockIdx.x; t < 4224; t += gridDim.x) {
    const int tc = t % 132, h = (t / 132) & 3, b = (t / 528) & 3, d = t / 2112;
    const int m0 = s5_m0(b, tc); const int cp = chain_pos(d, tc);
    const size_t task = ((size_t)((d * 4 + b) * 4 + h)) * 132 + cp;
    if (wid == 0) {
      float bc, ic, tot; ml_gates2(p, l, d, h, m0, lane, bc, ic, tot);
      const float lw = tot - bc + ic;
      float mx = lw;
      for (int o = 32; o > 0; o >>= 1) mx = fmaxf(mx, __shfl_xor(mx, o));
      wg[lane] = __expf(lw - mx);
      if (lane == 0) { ML_SC(p)[task * 2] = mx; ML_SC(p)[task * 2 + 1] = tot; }
    }
    __syncthreads();
    for (int e = tid; e < 64 * 12; e += NTHR) {
      const int tok = e & 63, q = e >> 6;
      const hf8 kv = *(const hf8*)(QK + (size_t)(m0 + tok) * 768 + 384 + h * 96 + q * 8);
      const hf8 vv = *(const hf8*)(Z + (size_t)(m0 + tok) * 1536 + 768 + h * 96 + q * 8);
      const float w = wg[tok];
#pragma unroll
      for (int i = 0; i < 8; ++i) {
        *(hf*)(kt + (q * 8 + i) * MLS + tok * 2) = kv[i];
        *(hf*)(vt + (q * 8 + i) * MLS + tok * 2) = (hf)((float)vv[i] * w);
      }
    }
    __syncthreads();
    float* dc = ML_DC(p) + task * 9216;
#pragma unroll 1
    for (int bi = 0; bi < 9; ++bi) {
      const int idx = wid * 9 + bi; const int mb = idx / 6, nb = idx % 6;
      f32x4 acc = (f32x4){0.f, 0.f, 0.f, 0.f};
#pragma unroll
      for (int ks = 0; ks < 2; ++ks) {
        const hf8 af = *(const hf8*)(vt + (mb * 16 + fr) * MLS + ks * 64 + fq * 16);
        const hf8 bf = *(const hf8*)(kt + (nb * 16 + fr) * MLS + ks * 64 + fq * 16);
        acc = __builtin_amdgcn_mfma_f32_16x16x32_f16(af, bf, acc, 0, 0, 0);
      }
#pragma unroll
      for (int j = 0; j < 4; ++j) dc[(mb * 16 + fq * 4 + j) * 96 + nb * 16 + fr] = acc[j];
    }
    if (tid < 96) {
      float s = 0.f;
      for (int j = 0; j < 64; ++j) s += wg[j] * (float)*(const hf*)(kt + tid * MLS + j * 2);
      ML_DN(p)[task * 96 + tid] = s;
    }
    __syncthreads();
  }
}
__device__ __forceinline__ void ph_ml_b(const P& p) {
  float* DC = ML_DC(p); float* DN = ML_DN(p); const float* SC = ML_SC(p); float* MP = ML_MP(p);
  for (int t = blockIdx.x * NTHR + get_tid(); t < 32 * 9312; t += gridDim.x * NTHR) {
    const int chain = t / 9312, e = t % 9312;
    float cur = 0.f, mprev = 0.f;
    for (int cp0 = 0; cp0 < 132; cp0 += 12) {
      float dl[12], ml_[12], bl_[12];
#pragma unroll
      for (int u = 0; u < 12; ++u) {
        const size_t task = (size_t)chain * 132 + cp0 + u;
        dl[u] = e < 9216 ? DC[task * 9216 + e] : DN[task * 96 + (e - 9216)];
        ml_[u] = SC[task * 2]; bl_[u] = SC[task * 2 + 1];
      }
#pragma unroll
      for (int u = 0; u < 12; ++u) {
        const size_t task = (size_t)chain * 132 + cp0 + u;
        float* slot = e < 9216 ? DC + task * 9216 + e : DN + task * 96 + (e - 9216);
        *slot = cur;
        if (e == 0) MP[task] = mprev;
        const float mnew = fmaxf(bl_[u] + mprev, ml_[u]);
        cur = __expf(bl_[u] + mprev - mnew) * cur + __expf(ml_[u] - mnew) * dl[u];
        mprev = mnew;
      }
    }
  }
}
__device__ __forceinline__ void ph_ml_c(const P& p, int l, char* lds) {
  char* qs = lds; char* ks = lds + 13312; char* vt = lds + 26624; char* cs = lds + 40448; char* ps = lds + 60416;
  float* fl = (float*)(lds + 69632);
  float* bc = fl; float* icv = fl + 128; float* mr = fl + 256; float* inter = fl + 320; float* den = fl + 384; float* nq = fl + 448; float* nst = fl + 512;
  const int tid = get_tid(), lane = tid & 63, wid = tid >> 6, fr = lane & 15, fq = lane >> 4;
  const hf* QK = ML_QK(p); const hf* Z = ML_Z(p);
  for (int t = blockIdx.x; t < 2112; t += gridDim.x) {
    const int tc = t % 132, h = (t / 132) & 3, b = t / 528;
    const int m0 = s5_m0(b, tc);
    for (int e = tid; e < 64 * 12; e += NTHR) {
      const int tok = e & 63, q = e >> 6;
      *(hf8*)(qs + tok * MLQ + q * 16) = *(const hf8*)(QK + (size_t)(m0 + tok) * 768 + h * 96 + q * 8);
      *(hf8*)(ks + tok * MLQ + q * 16) = *(const hf8*)(QK + (size_t)(m0 + tok) * 768 + 384 + h * 96 + q * 8);
      const hf8 vv = *(const hf8*)(Z + (size_t)(m0 + tok) * 1536 + 768 + h * 96 + q * 8);
#pragma unroll
      for (int i = 0; i < 8; ++i) *(hf*)(vt + (q * 8 + i) * MLS + tok * 2) = vv[i];
    }
    if (wid < 2) { float bcv, ic, tot; ml_gates2(p, l, wid, h, m0, lane, bcv, ic, tot); bc[wid * 64 + lane] = bcv; icv[wid * 64 + lane] = ic; }
    f32x4 hs[6];
#pragma unroll
    for (int n = 0; n < 6; ++n) hs[n] = (f32x4){0.f, 0.f, 0.f, 0.f};
    for (int d = 0; d < 2; ++d) {
      const int cp = chain_pos(d, tc);
      const size_t task = ((size_t)((d * 4 + b) * 4 + h)) * 132 + cp;
      const float mprev = ML_MP(p)[task];
      __syncthreads();
      {
        const float* cg = ML_DC(p) + task * 9216;
        for (int e = tid; e < 96 * 24; e += NTHR) {
          const int v = e / 24, q = e % 24;
          const float4 c4 = *(const float4*)(cg + v * 96 + q * 4);
          hf4 o; o[0] = (hf)c4.x; o[1] = (hf)c4.y; o[2] = (hf)c4.z; o[3] = (hf)c4.w;
          *(hf4*)(cs + v * MLQ + q * 8) = o;
        }
        if (tid < 96) nst[tid] = ML_DN(p)[task * 96 + tid];
      }
      const float* bcd = bc + d * 64; const float* icd = icv + d * 64;
      if (tid < 64) {
        const int j = tid; const float bj = bcd[j];
        float mx = bj + mprev;
        if (d == 0) { for (int s = 0; s <= j; ++s) mx = fmaxf(mx, bj - bcd[s] + icd[s]); }
        else { for (int s = j; s < 64; ++s) mx = fmaxf(mx, bj - bcd[s] + icd[s]); }
        mr[j] = mx; inter[j] = __expf(bj + mprev - mx);
      }
      __syncthreads();
      if (tid < 64) {
        float s1 = 0.f;
        for (int k = 0; k < 96; ++k) s1 += nst[k] * (float)*(const hf*)(qs + tid * MLQ + k * 2);
        nq[tid] = s1;
      }
      {
        f32x4 sacc[4];
#pragma unroll
        for (int n = 0; n < 4; ++n) sacc[n] = (f32x4){0.f, 0.f, 0.f, 0.f};
#pragma unroll
        for (int kk = 0; kk < 3; ++kk) {
          const hf8 af = *(const hf8*)(qs + (wid * 16 + fr) * MLQ + kk * 64 + fq * 16);
#pragma unroll
          for (int n = 0; n < 4; ++n) {
            const hf8 bf = *(const hf8*)(ks + (n * 16 + fr) * MLQ + kk * 64 + fq * 16);
            sacc[n] = __builtin_amdgcn_mfma_f32_16x16x32_f16(af, bf, sacc[n], 0, 0, 0);
          }
        }
        float rs[4] = {0.f, 0.f, 0.f, 0.f};
#pragma unroll
        for (int n = 0; n < 4; ++n) {
          const int s = n * 16 + fr; const float bs = bcd[s] - icd[s];
#pragma unroll
          for (int jj = 0; jj < 4; ++jj) {
            const int j = wid * 16 + fq * 4 + jj;
            const bool valid = d == 0 ? (s <= j) : (s >= j);
            const float val = valid ? sacc[n][jj] * __expf(bcd[j] - bs - mr[j]) : 0.f;
            rs[jj] += val;
            *(hf*)(ps + j * MLS + s * 2) = (hf)val;
          }
        }
        __syncthreads();
#pragma unroll
        for (int jj = 0; jj < 4; ++jj) {
          const float r = rowsum16(rs[jj]);
          const int j = wid * 16 + fq * 4 + jj;
          if (fr == 0) den[j] = inter[j] * nq[j] + r;
        }
      }
      f32x4 acc[6];
#pragma unroll
      for (int n = 0; n < 6; ++n) acc[n] = (f32x4){0.f, 0.f, 0.f, 0.f};
#pragma unroll
      for (int kk = 0; kk < 3; ++kk) {
        const hf8 af = *(const hf8*)(qs + (wid * 16 + fr) * MLQ + kk * 64 + fq * 16);
#pragma unroll
        for (int n = 0; n < 6; ++n) {
          const hf8 bf = *(const hf8*)(cs + (n * 16 + fr) * MLQ + kk * 64 + fq * 16);
          acc[n] = __builtin_amdgcn_mfma_f32_16x16x32_f16(af, bf, acc[n], 0, 0, 0);
        }
      }
#pragma unroll
      for (int jj = 0; jj < 4; ++jj) { const float it = inter[wid * 16 + fq * 4 + jj];
#pragma unroll
        for (int n = 0; n < 6; ++n) acc[n][jj] *= it; }
#pragma unroll
      for (int kk = 0; kk < 2; ++kk) {
        const hf8 af = *(const hf8*)(ps + (wid * 16 + fr) * MLS + kk * 64 + fq * 16);
#pragma unroll
        for (int n = 0; n < 6; ++n) {
          const hf8 bf = *(const hf8*)(vt + (n * 16 + fr) * MLS + kk * 64 + fq * 16);
          acc[n] = __builtin_amdgcn_mfma_f32_16x16x32_f16(af, bf, acc[n], 0, 0, 0);
        }
      }
      __syncthreads();
#pragma unroll
      for (int jj = 0; jj < 4; ++jj) {
        const int j = wid * 16 + fq * 4 + jj;
        const float dn = 1.f / fmaxf(fabsf(den[j]), __expf(-mr[j]));
#pragma unroll
        for (int n = 0; n < 6; ++n) hs[n][jj] += acc[n][jj] * dn;
      }
    }
#pragma unroll
    for (int jj = 0; jj < 4; ++jj) {
      const int m = m0 + wid * 16 + fq * 4 + jj;
      const hf* op = Z + (size_t)m * 1536 + 1152 + h * 96 + fr;
      float x[6]; float s = 0.f;
#pragma unroll
      for (int n = 0; n < 6; ++n) { x[n] = sigmoidf_((float)op[n * 16]) * hs[n][jj]; s += x[n]; }
      s = rowsum16(s);
      const float mean = s * (1.f / 96.f);
      float q = 0.f;
#pragma unroll
      for (int n = 0; n < 6; ++n) { x[n] -= mean; q += x[n] * x[n]; }
      q = rowsum16(q);
      const float rsd = rsqrtf(q * (1.f / 96.f) + 1e-5f);
      const float* ng = p.in[34] + (size_t)l * 384 + h * 96 + fr;
      bf16_t* yp = p.Y + (size_t)m * 1024 + 640 + h * 96 + fr;
#pragma unroll
      for (int n = 0; n < 6; ++n) yp[n * 16] = f2bf(x[n] * rsd * ng[n * 16]);
    }
    __syncthreads();
  }
}

#define MG_YM(p) ((bf16_t*)(p).R)
#define MG_G3(p) (MG_YM(p) + (size_t)M_ALL * 1024)
__device__ __forceinline__ void ph_gates(const P& p, int l, int Mt, char* lds) {
  EPI_VARS
  bf16_t* G3 = MG_G3(p);
  const float* gbias = p.in[38] + (size_t)l * 3072;
  const int ntile = Mt * 24;
  for (int it = 0;; ++it) {
    int tm, tn; if (!tile_map(it, Mt, 24, 8, tm, tn)) break; const int m0 = tm * 128, n0 = tn * 128;
    f32x4 acc[4][4]; ZERO_ACC(acc)
    gemm_main(p.U + (size_t)m0 * 1024, 1024, p.W + W_IN + (size_t)(3216 + n0) * 1024, 1024, 1024, acc, lds);
    EPI_BEGIN(m0, n0)
      G3[(size_t)row * 3072 + col] = f2bf(sigmoidf_(val + gbias[col]));
    EPI_END
  }
}
__device__ __forceinline__ void ph_merge(const P& p, int l, int Mt, char* lds) {
  EPI_VARS
  bf16_t* YM = MG_YM(p); const bf16_t* G3 = MG_G3(p);
  const int ntile = Mt * 16;
  for (int it = 0;; ++it) {
    int tm, tn; if (!tile_map(it, Mt, 16, 8, tm, tn)) break; const int m0 = tm * 128, n0 = tn * 64;
    f32x4 yacc[4][2];
#pragma unroll
    for (int m = 0; m < 4; ++m) { yacc[m][0] = (f32x4){0.f, 0.f, 0.f, 0.f}; yacc[m][1] = (f32x4){0.f, 0.f, 0.f, 0.f}; }
#pragma unroll 1
    for (int br = 0; br < 3; ++br) {
      f32x4 acc[4][2];
#pragma unroll
      for (int m = 0; m < 4; ++m) { acc[m][0] = (f32x4){0.f, 0.f, 0.f, 0.f}; acc[m][1] = (f32x4){0.f, 0.f, 0.f, 0.f}; }
      const int kb = br == 1 ? 256 : 384; const int yoff = br == 0 ? 0 : (br == 1 ? 384 : 640);
      const int woff = br == 0 ? W_UPRW : (br == 1 ? W_UPS5 : W_UPML);
      gemm_main_t<2>(p.Y + (size_t)m0 * 1024 + yoff, 1024, p.W + woff + (size_t)n0 * kb, kb, kb, acc, lds);
      EPI_ROW_BEGIN(m0)
        const bf16_t* gp = G3 + (size_t)row * 3072 + br * 1024 + n0 + wc * 32 + fr;
#pragma unroll
        for (int n = 0; n < 2; ++n) yacc[m][n][j] += bf2f(gp[n * 16]) * acc[m][n][j];
      EPI_ROW_END
    }
    EPI_ROW_BEGIN(m0)
      bf16_t* yp = YM + (size_t)row * 1024 + n0 + wc * 32 + fr;
#pragma unroll
      for (int n = 0; n < 2; ++n) yp[n * 16] = f2bf(yacc[m][n][j]);
    EPI_ROW_END
  }
}
__device__ __forceinline__ void ph_wout(const P& p, int l, int Mt, char* lds) {
  EPI_VARS
  const bf16_t* YM = (const bf16_t*)p.R;
  const int ntile = Mt * 8;
  for (int it = 0;; ++it) {
    int tm, tn; if (!tile_map(it, Mt, 8, 8, tm, tn)) break; const int m0 = tm * 128, n0 = tn * 128;
    f32x4 acc[4][4]; ZERO_ACC(acc)
    gemm_main(YM + (size_t)m0 * 1024, 1024, p.W + W_OUT + (size_t)n0 * 1024, 1024, 1024, acc, lds);
    EPI_ROW_BEGIN(m0)
      float* sp = srow(p, row) + n0 + wc * 64 + fr; const float* gp = modp(p, l, row, 5) + n0 + wc * 64 + fr;
#pragma unroll
      for (int n = 0; n < 4; ++n) sp[n * 16] = ALPHA * sp[n * 16] + gp[n * 16] * acc[m][n][j];
    EPI_ROW_END
  }
}

#define SYNC grid.sync(); asm volatile("" : "+s"(l));
__global__ void __launch_bounds__(NTHR, 2) mega(P pv) {
#define p pv
  __shared__ __attribute__((aligned(16))) char lds[LDS_BYTES];
  cg::grid_group grid = cg::this_grid();
  for (int l = 0; l < 2; ++l) {
    const bool last = (l == 1);
    const int Mt2 = last ? 256 : 264;
    const int Mr2 = last ? M_LAT : M_ALL;
    ph_convert(p, l, l == 0, lds); SYNC
    if (l == 0) { ph_rows(p, 0, 0, 0, M_ALL, true, 0, 0); SYNC }
    ph_ffn_up(p, 0, 264, lds); SYNC
    ph_ffn_down(p, l, 0, 264, lds); SYNC
    ph_rows(p, 1, l, 0, M_ALL, true, l, 3); SYNC
    ph_z_rw(p, lds); SYNC
    ph_conv(p, l, 0); SYNC
    ph_lora(p, l, lds); SYNC
    ph_rwscan(p, lds); SYNC
    ph_rwpost(p, l); SYNC
    ph_z_s5(p, lds); SYNC
    ph_s5_pass(p, l, 1, lds); SYNC
    ph_s5_carry(p, l); SYNC
    ph_s5_pass(p, l, 3, lds); SYNC
    ph_glu(p, l, lds); SYNC
    ph_z_ml(p, lds); SYNC
    ph_conv(p, l, 1); SYNC
    ph_ml_a(p, l, lds); SYNC
    ph_ml_b(p); SYNC
    ph_ml_c(p, l, lds); SYNC
    ph_gates(p, l, Mt2, lds); SYNC
    ph_merge(p, l, Mt2, lds); SYNC
    ph_wout(p, l, Mt2, lds); SYNC
    ph_rows(p, 1, l, 1, Mr2, true, l, 6); SYNC
    ph_ffn_up(p, 1, Mt2, lds); SYNC
    ph_ffn_down(p, l, 1, Mt2, lds); SYNC
    ph_rows(p, 1, l, 2, Mr2, !last, l + 1, 0);
    if (!last) { SYNC }
  }
#undef p
}

extern "C" void kernel_launch(void* const* d_in, const int* in_sizes, int n_in, void* d_out, int out_size, void* d_ws, size_t ws_size,
                              hipStream_t stream) {
  static int grid_blocks = 0;
  if (!grid_blocks) {
    int dev = 0, cus = 0, per_cu = 0;
    hipGetDevice(&dev);
    hipDeviceGetAttribute(&cus, hipDeviceAttributeMultiprocessorCount, dev);
    hipOccupancyMaxActiveBlocksPerMultiprocessor(&per_cu, mega, NTHR, 0);
    if (per_cu > 2) per_cu = 2;
    grid_blocks = cus * per_cu;
  }
  P p{};
  for (int i = 0; i < 40; ++i) p.in[i] = (const float*)d_in[i];
  char* ws = (char*)d_ws;
  size_t off = 0;
  p.W = (bf16_t*)(ws + off); off += (size_t)W_TOTAL * 2;
  p.mod = (float*)(ws + off); off += (size_t)2 * 5 * 9216 * 4;
  p.sctx = (float*)(ws + off); off += (size_t)1024 * 1024 * 4;
  p.U = (bf16_t*)(ws + off); off += (size_t)M_ALL * 1024 * 2;
  p.Y = (bf16_t*)(ws + off); off += (size_t)M_ALL * 1024 * 2;
  p.R = ws + off;
  p.out = (float*)d_out;
  if (off + (size_t)M_ALL * 9728 > ws_size) fprintf(stderr, "workspace too small: need %zu have %zu\n", off + (size_t)M_ALL * 9728, ws_size);
  void* args[] = {&p};
  hipError_t e = hipLaunchCooperativeKernel((void*)mega, dim3(grid_blocks), dim3(NTHR), args, 0, stream);
  if (e != hipSuccess) fprintf(stderr, "cooperative launch failed: %s (grid %d)\n", hipGetErrorString(e), grid_blocks);
}
```

```cpp
#include <hip/hip_runtime.h>
#include <hip/hip_cooperative_groups.h>
#include <cstdio>
namespace cg = cooperative_groups;

typedef unsigned short bf16_t;
typedef _Float16 hf;
typedef hf hf4 __attribute__((ext_vector_type(4)));
typedef hf hf8 __attribute__((ext_vector_type(8)));
typedef __attribute__((ext_vector_type(8))) short bf16x8;
typedef __attribute__((ext_vector_type(4))) float f32x4;
typedef unsigned int u32x4 __attribute__((ext_vector_type(4)));

#define M_LAT 32768
#define M_ALL 33792
#define NTHR 256
#define LDS_BYTES 73728
#define ALPHA 1.41421356237f

#define W_GU0 0
#define W_D0 5767168
#define W_GU1 8650752
#define W_D1 14417920
#define W_IN 17301504
#define W_WUP0 23740416
#define W_WUP1 23764992
#define W_AUP0 23789568
#define W_AUP1 23814144
#define W_GUP 23838720
#define W_GLU 23887872
#define W_UPRW 23953408
#define W_UPS5 24346624
#define W_UPML 24608768
#define W_OUT 25001984
#define W_TOTAL 26050560

struct P {
  const float* in[40];
  float* out; float* sctx; float* mod;
  bf16_t* U; bf16_t* Y; bf16_t* W; char* R; unsigned* bar;
};

__device__ __forceinline__ int get_tid() { int t = __builtin_amdgcn_workitem_id_x(); asm volatile("" : "+v"(t)); return t; }
__device__ __forceinline__ bf16_t f2bf(float f) { return __builtin_bit_cast(unsigned short, (_Float16)f); }
__device__ __forceinline__ float bf2f(bf16_t h) { return (float)__builtin_bit_cast(_Float16, h); }
__device__ __forceinline__ float sigmoidf_(float x) { return 1.f / (1.f + __expf(-x)); }
__device__ __forceinline__ float siluf_(float x) { return x / (1.f + __expf(-x)); }
__device__ __forceinline__ float* srow(const P& p, int m) { return m < M_LAT ? p.out + (size_t)m * 1024 : p.sctx + (size_t)(m - M_LAT) * 1024; }
__device__ __forceinline__ const float* modp(const P& p, int l, int m, int k) { int mv = m < M_LAT ? (m >> 13) : 4; return p.mod + (size_t)(l * 5 + mv) * 9216 + k * 1024; }
template <int C> __device__ __forceinline__ float dppf(float x) { return __int_as_float(__builtin_amdgcn_update_dpp(0, __float_as_int(x), C, 0xf, 0xf, false)); }
__device__ __forceinline__ float rowsum16(float x) { x += dppf<0x128>(x); x += dppf<0x124>(x); x += dppf<0x122>(x); x += dppf<0x121>(x); return x; }
__device__ __forceinline__ float wavesum(float x) { for (int o = 32; o > 0; o >>= 1) x += __shfl_xor(x, o); return x; }

template <int NB>
__device__ __forceinline__ void gemm_main_t(const bf16_t* __restrict__ A, int lda, const bf16_t* __restrict__ B, int ldb, int K,
                                          f32x4 (&acc)[4][NB], char* lds) {
  const int tid = get_tid(), lane = tid & 63, wid = tid >> 6, wr = wid >> 1, wc = wid & 1;
  const int fr = lane & 15, fq = lane >> 4;
  const int sr = tid >> 3, skc = tid & 7;
  const bf16_t* ga = A + (size_t)sr * lda + skc * 8;
  const bf16_t* gb = B + (size_t)sr * ldb + skc * 8;
  u32x4 ra0[4], rb0[NB], ra1[4], rb1[NB];
  const int soff = sr * 144 + skc * 16;
  const int nk = K >> 6;
  const int aoff = (wr * 64 + fr) * 144 + fq * 16;
  const int boff = 18432 + (wc * (NB * 16) + fr) * 144 + fq * 16;
#define G_LOAD(RA, RB, kt) { _Pragma("unroll") for (int i = 0; i < 4; ++i) { RA[i] = *(const u32x4*)(ga + (size_t)(i * 32) * lda + (kt) * 64); if (i < NB) RB[i] = *(const u32x4*)(gb + (size_t)(i * 32) * ldb + (kt) * 64); } }
#define G_STORE(RA, RB, buf) { char* d_ = lds + (buf) * 36864 + soff; _Pragma("unroll") for (int i = 0; i < 4; ++i) { *(u32x4*)(d_ + i * 32 * 144) = RA[i]; if (i < NB) *(u32x4*)(d_ + 18432 + i * 32 * 144) = RB[i]; } }
#define G_COMP(buf) { const char* cur = lds + (buf) * 36864; _Pragma("unroll") for (int ks = 0; ks < 2; ++ks) { hf8 af[4], bfr[NB]; \
    _Pragma("unroll") for (int m = 0; m < 4; ++m) af[m] = *(const hf8*)(cur + aoff + m * 16 * 144 + ks * 64); \
    _Pragma("unroll") for (int n = 0; n < NB; ++n) bfr[n] = *(const hf8*)(cur + boff + n * 16 * 144 + ks * 64); \
    _Pragma("unroll") for (int m = 0; m < 4; ++m) _Pragma("unroll") for (int n = 0; n < NB; ++n) acc[m][n] = __builtin_amdgcn_mfma_f32_16x16x32_f16(af[m], bfr[n], acc[m][n], 0, 0, 0); } }
  G_LOAD(ra0, rb0, 0)
  { const int k1 = nk > 1 ? 1 : 0; G_LOAD(ra1, rb1, k1) }
  G_STORE(ra0, rb0, 0)
  __syncthreads();
  for (int kt = 0; kt < nk; kt += 2) {
    { const int k2 = kt + 2 < nk ? kt + 2 : nk - 1; G_LOAD(ra0, rb0, k2) }
    G_COMP(0)
    G_STORE(ra1, rb1, 1)
    __syncthreads();
    { const int k3 = kt + 3 < nk ? kt + 3 : nk - 1; G_LOAD(ra1, rb1, k3) }
    if (kt + 1 < nk) G_COMP(1)
    G_STORE(ra0, rb0, 0)
    __syncthreads();
  }
}
__device__ __forceinline__ void gemm_main(const bf16_t* __restrict__ A, int lda, const bf16_t* __restrict__ B, int ldb, int K, f32x4 (&acc)[4][4], char* lds) {
  gemm_main_t<4>(A, lda, B, ldb, K, acc, lds);
}

__device__ __forceinline__ bool tile_map(int it, int Mt, int Nt, int SN, int& tm, int& tn) {
  const int b = blockIdx.x, xcd = b & 7, li = b >> 3, nloc = gridDim.x >> 3;
  const int T = 8 * SN; const int nsn = Nt / SN; const int nsuper = (Mt >> 3) * nsn;
  const int o = li + it * nloc; const int k = o / T, w = o - k * T;
  const int s = xcd + 8 * k;
  if (s >= nsuper) return false;
  const int sm = s / nsn, sn = s - sm * nsn;
  tm = sm * 8 + (w & 7); tn = sn * SN + (w >> 3);
  return true;
}
#define ZERO_ACC(a) _Pragma("unroll") for (int m_ = 0; m_ < 4; ++m_) _Pragma("unroll") for (int n_ = 0; n_ < 4; ++n_) a[m_][n_] = (f32x4){0.f, 0.f, 0.f, 0.f};
#define EPI_VARS const int tid = get_tid(), lane = tid & 63, wid = tid >> 6, wr = wid >> 1, wc = wid & 1, fr = lane & 15, fq = lane >> 4; (void)wr; (void)wc; (void)fr; (void)fq;
#define EPI_ROW_BEGIN(m0) _Pragma("unroll") for (int m = 0; m < 4; ++m) _Pragma("unroll") for (int j = 0; j < 4; ++j) { const int row = (m0) + wr * 64 + m * 16 + fq * 4 + j; (void)row;
#define EPI_COL_BEGIN(n0) _Pragma("unroll") for (int n = 0; n < 4; ++n) { const int col = (n0) + wc * 64 + n * 16 + fr; const float val = acc[m][n][j]; (void)col; (void)val;
#define EPI_COL_END }
#define EPI_ROW_END }
#define EPI_BEGIN(m0, n0) EPI_ROW_BEGIN(m0) EPI_COL_BEGIN(n0)
#define EPI_END } }

struct Job { const float* src; int K, N; int dst; int mode; };
__device__ __forceinline__ Job get_job(const P& p, int l, int j) {
  Job r; r.mode = 0;
  switch (j) {
    case 0: r.src = p.in[8] + (size_t)(l * 2 + 0) * 1024 * 2816; r.K = 1024; r.N = 2816; r.dst = W_GU0; r.mode = 1; break;
    case 1: r.src = p.in[9] + (size_t)(l * 2 + 0) * 1024 * 2816; r.K = 1024; r.N = 2816; r.dst = W_GU0; r.mode = 2; break;
    case 2: r.src = p.in[10] + (size_t)(l * 2 + 0) * 2816 * 1024; r.K = 2816; r.N = 1024; r.dst = W_D0; break;
    case 3: r.src = p.in[8] + (size_t)(l * 2 + 1) * 1024 * 2816; r.K = 1024; r.N = 2816; r.dst = W_GU1; r.mode = 1; break;
    case 4: r.src = p.in[9] + (size_t)(l * 2 + 1) * 1024 * 2816; r.K = 1024; r.N = 2816; r.dst = W_GU1; r.mode = 2; break;
    case 5: r.src = p.in[10] + (size_t)(l * 2 + 1) * 2816 * 1024; r.K = 2816; r.N = 1024; r.dst = W_D1; break;
    case 6: r.src = p.in[11] + (size_t)l * 1024 * 6288; r.K = 1024; r.N = 6288; r.dst = W_IN; break;
    case 7: r.src = p.in[14] + (size_t)(l * 2 + 0) * 64 * 384; r.K = 64; r.N = 384; r.dst = W_WUP0; break;
    case 8: r.src = p.in[14] + (size_t)(l * 2 + 1) * 64 * 384; r.K = 64; r.N = 384; r.dst = W_WUP1; break;
    case 9: r.src = p.in[16] + (size_t)(l * 2 + 0) * 64 * 384; r.K = 64; r.N = 384; r.dst = W_AUP0; break;
    case 10: r.src = p.in[16] + (size_t)(l * 2 + 1) * 64 * 384; r.K = 64; r.N = 384; r.dst = W_AUP1; break;
    case 11: r.src = p.in[17] + (size_t)l * 128 * 384; r.K = 128; r.N = 384; r.dst = W_GUP; break;
    case 12: r.src = p.in[31] + (size_t)l * 256 * 256; r.K = 256; r.N = 256; r.dst = W_GLU; break;
    case 13: r.src = p.in[35] + (size_t)l * 384 * 1024; r.K = 384; r.N = 1024; r.dst = W_UPRW; break;
    case 14: r.src = p.in[36] + (size_t)l * 256 * 1024; r.K = 256; r.N = 1024; r.dst = W_UPS5; break;
    case 15: r.src = p.in[37] + (size_t)l * 384 * 1024; r.K = 384; r.N = 1024; r.dst = W_UPML; break;
    default: r.src = p.in[39] + (size_t)l * 1024 * 1024; r.K = 1024; r.N = 1024; r.dst = W_OUT; break;
  }
  return r;
}
#define NJOBS 17
__device__ void mod_task(const P& p, int t, char* lds) {
  float* sc = (float*)lds;
  float* red = sc + 5 * 1024;
  const int tid = get_tid();
  for (int i = tid; i < 5 * 1024; i += NTHR) {
    int v = i >> 10, k = i & 1023;
    float c = v < 4 ? p.in[1][v * 1024 + k] : p.in[3][k];
    sc[i] = siluf_(c);
  }
  __syncthreads();
  const int c0 = t * 64; const int l = c0 / 9216; const int j0 = c0 % 9216;
  const int col = tid & 63, part = tid >> 6;
  const float* w = p.in[4] + ((size_t)l * 1024 + part * 256) * 9216 + j0 + col;
  float a0 = 0, a1 = 0, a2 = 0, a3 = 0, a4 = 0;
  const float* s = sc + part * 256;
#pragma unroll 8
  for (int i = 0; i < 256; ++i) {
    float wv = w[(size_t)i * 9216];
    a0 += s[i] * wv; a1 += s[1024 + i] * wv; a2 += s[2048 + i] * wv; a3 += s[3072 + i] * wv; a4 += s[4096 + i] * wv;
  }
  red[(part * 5 + 0) * 64 + col] = a0; red[(part * 5 + 1) * 64 + col] = a1; red[(part * 5 + 2) * 64 + col] = a2;
  red[(part * 5 + 3) * 64 + col] = a3; red[(part * 5 + 4) * 64 + col] = a4;
  __syncthreads();
  for (int i = tid; i < 320; i += NTHR) {
    int v = i >> 6, c = i & 63;
    float sum = red[(0 * 5 + v) * 64 + c] + red[(1 * 5 + v) * 64 + c] + red[(2 * 5 + v) * 64 + c] + red[(3 * 5 + v) * 64 + c];
    p.mod[(size_t)(l * 5 + v) * 9216 + j0 + c] = sum + p.in[5][(size_t)l * 9216 + j0 + c];
  }
  __syncthreads();
}
__device__ __forceinline__ void ph_convert(const P& p, int l, bool with_mod, char* lds) {
  const int tid = get_tid();
  int ntiles[NJOBS]; int total = 0;
#pragma unroll
  for (int j = 0; j < NJOBS; ++j) { Job jb = get_job(p, l, j); ntiles[j] = (jb.K >> 6) * ((jb.N + 63) >> 6); total += ntiles[j]; }
  const int nmod = with_mod ? 288 : 0;
  float* tile = (float*)lds;
  for (int t = blockIdx.x; t < total + nmod; t += gridDim.x) {
    if (t < nmod) { mod_task(p, t, lds); continue; }
    int tt = t - nmod; int j = 0;
#pragma unroll
    for (int q = 0; q < NJOBS; ++q) { if (j == q && tt >= ntiles[q]) { tt -= ntiles[q]; j = q + 1; } }
    Job jb = get_job(p, l, j);
    const int nkt = jb.K >> 6;
    const int k0 = (tt % nkt) * 64, n0 = (tt / nkt) * 64;
    {
      const int c = tid & 63, r0 = tid >> 6;
      const bool ok = (n0 + c) < jb.N;
#pragma unroll
      for (int i = 0; i < 16; ++i) { int r = r0 + i * 4; tile[r * 65 + c] = ok ? jb.src[(size_t)(k0 + r) * jb.N + n0 + c] : 0.f; }
    }
    __syncthreads();
    {
      const int nn = tid >> 2, q = tid & 3; const int n = n0 + nn;
      if (n < jb.N) {
        int drow = n;
        if (jb.mode == 1) drow = (n >> 5) * 64 + (n & 31);
        else if (jb.mode == 2) drow = (n >> 5) * 64 + 32 + (n & 31);
        bf16_t* d = p.W + jb.dst + (size_t)drow * jb.K + k0 + q * 16;
        unsigned pk[8];
#pragma unroll
        for (int i = 0; i < 8; ++i) { unsigned lo = f2bf(tile[(q * 16 + 2 * i) * 65 + nn]); unsigned hi = f2bf(tile[(q * 16 + 2 * i + 1) * 65 + nn]); pk[i] = lo | (hi << 16); }
        *(uint4*)d = make_uint4(pk[0], pk[1], pk[2], pk[3]);
        *(uint4*)(d + 8) = make_uint4(pk[4], pk[5], pk[6], pk[7]);
      }
    }
    __syncthreads();
  }
}

__device__ __forceinline__ void ph_rows(const P& p, int mode, int l, int ln_idx, int Mrows, bool writeU, int ul, int ks) {
  const int lane = get_tid() & 63, wid = get_tid() >> 6;
  const int nw = gridDim.x * 4;
  const float* g = p.in[6] + (size_t)(l * 3 + ln_idx) * 1024;
  const float* b = p.in[7] + (size_t)(l * 3 + ln_idx) * 1024;
  for (int m = blockIdx.x * 4 + wid; m < Mrows; m += nw) {
    float* s = srow(p, m);
    const float* src = s;
    if (mode == 0) src = m < M_LAT ? p.in[0] + (size_t)m * 1024 : p.in[2] + (size_t)(m - M_LAT) * 1024;
    float4 v[4];
#pragma unroll
    for (int i = 0; i < 4; ++i) v[i] = *(const float4*)(src + lane * 4 + i * 256);
    if (mode == 1) {
      float sum = 0;
#pragma unroll
      for (int i = 0; i < 4; ++i) sum += v[i].x + v[i].y + v[i].z + v[i].w;
      sum = wavesum(sum);
      const float mean = sum * (1.f / 1024.f);
      float sq = 0;
#pragma unroll
      for (int i = 0; i < 4; ++i) { v[i].x -= mean; v[i].y -= mean; v[i].z -= mean; v[i].w -= mean; sq += v[i].x * v[i].x + v[i].y * v[i].y + v[i].z * v[i].z + v[i].w * v[i].w; }
      sq = wavesum(sq);
      const float rstd = rsqrtf(sq * (1.f / 1024.f) + 1e-5f);
#pragma unroll
      for (int i = 0; i < 4; ++i) {
        float4 gg = *(const float4*)(g + lane * 4 + i * 256), bb = *(const float4*)(b + lane * 4 + i * 256);
        v[i].x = v[i].x * rstd * gg.x + bb.x; v[i].y = v[i].y * rstd * gg.y + bb.y; v[i].z = v[i].z * rstd * gg.z + bb.z; v[i].w = v[i].w * rstd * gg.w + bb.w;
      }
    }
#pragma unroll
    for (int i = 0; i < 4; ++i) *(float4*)(s + lane * 4 + i * 256) = v[i];
    if (writeU) {
      const float* sh = modp(p, ul, m, ks); const float* scl = modp(p, ul, m, ks + 1);
#pragma unroll
      for (int i = 0; i < 4; ++i) {
        float4 a = *(const float4*)(sh + lane * 4 + i * 256), c = *(const float4*)(scl + lane * 4 + i * 256);
        unsigned lo = f2bf(v[i].x * (1.f + c.x) + a.x) | ((unsigned)f2bf(v[i].y * (1.f + c.y) + a.y) << 16);
        unsigned hi = f2bf(v[i].z * (1.f + c.z) + a.z) | ((unsigned)f2bf(v[i].w * (1.f + c.w) + a.w) << 16);
        *(uint2*)(p.U + (size_t)m * 1024 + lane * 4 + i * 256) = make_uint2(lo, hi);
      }
    }
  }
}

__device__ __forceinline__ void ph_ffn_up(const P& p, int s, int Mt, char* lds) {
  EPI_VARS
  bf16_t* HM = (bf16_t*)p.R;
  const bf16_t* Wt = p.W + (s ? W_GU1 : W_GU0);
  const int ntile = Mt * 44;
  for (int it = 0;; ++it) {
    int tm, tn; if (!tile_map(it, Mt, 44, 4, tm, tn)) break; const int m0 = tm * 128, n0 = tn * 128;
    f32x4 acc[4][4]; ZERO_ACC(acc)
    gemm_main(p.U + (size_t)m0 * 1024, 1024, Wt + (size_t)n0 * 1024, 1024, 1024, acc, lds);
    const int hb = ((n0 + wc * 64) >> 6) * 32;
#pragma unroll
    for (int m = 0; m < 4; ++m)
#pragma unroll
      for (int n = 0; n < 2; ++n)
#pragma unroll
        for (int j = 0; j < 4; ++j) {
          const int row = m0 + wr * 64 + m * 16 + fq * 4 + j; const int hc = hb + n * 16 + fr;
          HM[(size_t)row * 2816 + hc] = f2bf(siluf_(acc[m][n][j]) * acc[m][n + 2][j]);
        }
  }
}
__device__ __forceinline__ void ph_ffn_down(const P& p, int l, int s, int Mt, char* lds) {
  EPI_VARS
  const bf16_t* HM = (const bf16_t*)p.R;
  const bf16_t* Wt = p.W + (s ? W_D1 : W_D0);
  const int gk = s ? 8 : 2;
  const int ntile = Mt * 8;
  for (int it = 0;; ++it) {
    int tm, tn; if (!tile_map(it, Mt, 8, 8, tm, tn)) break; const int m0 = tm * 128, n0 = tn * 128;
    f32x4 acc[4][4]; ZERO_ACC(acc)
    gemm_main(HM + (size_t)m0 * 2816, 2816, Wt + (size_t)n0 * 2816, 2816, 2816, acc, lds);
    EPI_ROW_BEGIN(m0)
      float* sp = srow(p, row) + n0 + wc * 64 + fr; const float* gp = modp(p, l, row, gk) + n0 + wc * 64 + fr;
#pragma unroll
      for (int n = 0; n < 4; ++n) sp[n * 16] = ALPHA * sp[n * 16] + 0.5f * gp[n * 16] * acc[m][n][j];
    EPI_ROW_END
  }
}

#define RW_ZRW(p) ((hf*)(p).R)
#define RW_RKV(p) (RW_ZRW(p) + (size_t)M_ALL * 1152)
#define RW_LA(p) ((bf16_t*)(RW_RKV(p) + (size_t)M_ALL * 1152))
#define RW_KK(p) ((hf*)(RW_LA(p) + (size_t)M_ALL * 256))
#define RW_KD(p) (RW_KK(p) + (size_t)M_ALL * 384)
#define RW_KA(p) (RW_KD(p) + (size_t)2 * M_ALL * 384)
#define RW_YR(p) (RW_KA(p) + (size_t)2 * M_ALL * 384)

#define S5_Z(p) ((float*)(p).R)
#define S5_YG(p) ((bf16_t*)(S5_Z(p) + (size_t)M_ALL * 256))
#define S5_E(p) ((float2*)(S5_YG(p) + (size_t)M_ALL * 256))
#define S5_X(p) (S5_E(p) + (size_t)2 * 4 * 132 * 1024)

#define ML_Z(p) ((hf*)(p).R)
#define ML_GL(p) ((float*)(ML_Z(p) + (size_t)M_ALL * 1536))
#define ML_QK(p) ((hf*)(ML_GL(p) + (size_t)M_ALL * 16))
#define ML_DC(p) ((float*)(ML_QK(p) + (size_t)M_ALL * 768))
#define ML_DN(p) (ML_DC(p) + (size_t)4224 * 9216)
#define ML_SC(p) (ML_DN(p) + (size_t)4224 * 96)
#define ML_MP(p) (ML_SC(p) + (size_t)4224 * 2)

__device__ __forceinline__ void ph_z_rw(const P& p, char* lds) {
  EPI_VARS
  hf* ZRW = RW_ZRW(p); bf16_t* LA = RW_LA(p);
  const int Mt = 264; const int ntile = Mt * 11;
  for (int it = 0;; ++it) {
    int tm, tn; if (!tile_map(it, Mt, 11, 11, tm, tn)) break; const int m0 = tm * 128;
    const int wrow = tn < 9 ? tn * 128 : 2960 + (tn - 9) * 128;
    f32x4 acc[4][4]; ZERO_ACC(acc)
    gemm_main(p.U + (size_t)m0 * 1024, 1024, p.W + W_IN + (size_t)wrow * 1024, 1024, 1024, acc, lds);
    if (tn < 9) {
      EPI_BEGIN(m0, tn * 128)
        ZRW[(size_t)row * 1152 + col] = (hf)val;
      EPI_END
    } else {
      EPI_BEGIN(m0, (tn - 9) * 128)
        float o = col < 64 ? tanhf(val) : (col < 128 ? val : sigmoidf_(val));
        LA[(size_t)row * 256 + col] = f2bf(o);
      EPI_END
    }
  }
}
__device__ __forceinline__ void ph_z_s5(const P& p, char* lds) {
  EPI_VARS
  float* Z = S5_Z(p);
  const int Mt = 264; const int ntile = Mt * 2;
  for (int it = 0;; ++it) {
    int tm, tn; if (!tile_map(it, Mt, 2, 2, tm, tn)) break; const int m0 = tm * 128;
    f32x4 acc[4][4]; ZERO_ACC(acc)
    gemm_main(p.U + (size_t)m0 * 1024, 1024, p.W + W_IN + (size_t)(2704 + tn * 128) * 1024, 1024, 1024, acc, lds);
    EPI_BEGIN(m0, tn * 128)
      Z[(size_t)row * 256 + col] = val;
    EPI_END
  }
}
__device__ __forceinline__ void ph_z_ml(const P& p, char* lds) {
  EPI_VARS
  hf* Z = ML_Z(p); float* GL = ML_GL(p);
  const int Mt = 264; const int ntile = Mt * 13;
  for (int it = 0;; ++it) {
    int tm, tn; if (!tile_map(it, Mt, 13, 13, tm, tn)) break; const int m0 = tm * 128;
    f32x4 acc[4][4]; ZERO_ACC(acc)
    gemm_main(p.U + (size_t)m0 * 1024, 1024, p.W + W_IN + (size_t)(1152 + tn * 128) * 1024, 1024, 1024, acc, lds);
    if (tn < 12) {
      EPI_BEGIN(m0, tn * 128)
        Z[(size_t)row * 1536 + col] = (hf)val;
      EPI_END
    } else {
      EPI_BEGIN(m0, 0)
        if (col < 16) GL[(size_t)row * 16 + col] = val;
      EPI_END
    }
  }
}

__device__ __forceinline__ void ph_conv(const P& p, int l, int which) {
  const int nch = which == 0 ? 144 : 96;
  const int ldin = which == 0 ? 1152 : 1536;
  const hf* Zin = which == 0 ? RW_ZRW(p) : ML_Z(p);
  const int cbase = which == 0 ? 0 : 1152;
  const float* cw = p.in[12] + (size_t)l * 9 * 1920;
  const size_t total = (size_t)M_ALL * nch;
  for (size_t idx = (size_t)blockIdx.x * NTHR + get_tid(); idx < (total + 63) / 64 * 64; idx += (size_t)gridDim.x * NTHR) {
    const bool act = idx < total;
    const int m = act ? (int)(idx / nch) : 0; const int ch = act ? (int)(idx % nch) : 0; const int c0 = ch * 8;
    float o[8];
#pragma unroll
    for (int i = 0; i < 8; ++i) o[i] = 0.f;
    if (m < M_LAT) {
      const int bb = m >> 13, tt = m & 8191, gr = tt >> 6, gc = tt & 63;
#pragma unroll
      for (int dr = -1; dr <= 1; ++dr)
#pragma unroll
        for (int dc = -1; dc <= 1; ++dc) {
          const int rr = gr + dr, cc = gc + dc;
          if (rr >= 0 && rr < 128 && cc >= 0 && cc < 64) {
            const int mm = (bb << 13) + rr * 64 + cc;
            hf8 z = *(const hf8*)(Zin + (size_t)mm * ldin + c0);
            const float* w = cw + ((dr + 1) * 3 + (dc + 1)) * 1920 + cbase + c0;
            float4 w0 = *(const float4*)w, w1 = *(const float4*)(w + 4);
            o[0] += (float)z[0] * w0.x; o[1] += (float)z[1] * w0.y; o[2] += (float)z[2] * w0.z; o[3] += (float)z[3] * w0.w;
            o[4] += (float)z[4] * w1.x; o[5] += (float)z[5] * w1.y; o[6] += (float)z[6] * w1.z; o[7] += (float)z[7] * w1.w;
          }
        }
    } else {
      const int tt = (m - M_LAT) & 255;
#pragma unroll
      for (int dc = -1; dc <= 1; ++dc) {
        const int t2 = tt + dc;
        if (t2 >= 0 && t2 < 256) {
          hf8 z = *(const hf8*)(Zin + (size_t)(m + dc) * ldin + c0);
          const float* w = cw + (3 + (dc + 1)) * 1920 + cbase + c0;
          float4 w0 = *(const float4*)w, w1 = *(const float4*)(w + 4);
          o[0] += (float)z[0] * w0.x; o[1] += (float)z[1] * w0.y; o[2] += (float)z[2] * w0.z; o[3] += (float)z[3] * w0.w;
          o[4] += (float)z[4] * w1.x; o[5] += (float)z[5] * w1.y; o[6] += (float)z[6] * w1.z; o[7] += (float)z[7] * w1.w;
        }
      }
    }
    if (which == 0) {
      const bool isk = act && (c0 >= 384) && (c0 < 768);
      float kkv[8]; float ss = 0.f;
      if (isk) {
        const float* kkw = p.in[18] + (size_t)l * 384 + (c0 - 384);
#pragma unroll
        for (int i = 0; i < 8; ++i) { kkv[i] = o[i] * kkw[i]; ss += kkv[i] * kkv[i]; }
      } else {
#pragma unroll
        for (int i = 0; i < 8; ++i) kkv[i] = 0.f;
      }
      ss += __shfl_xor(ss, 1); ss += __shfl_xor(ss, 2); ss += __shfl_xor(ss, 4);
      if (act) {
        hf8 ov;
#pragma unroll
        for (int i = 0; i < 8; ++i) ov[i] = (hf)o[i];
        *(hf8*)(RW_RKV(p) + (size_t)m * 1152 + c0) = ov;
        if (isk) {
          const float rn = rsqrtf(fmaxf(ss, 1e-24f));
          hf8 kv;
#pragma unroll
          for (int i = 0; i < 8; ++i) kv[i] = (hf)(kkv[i] * rn);
          *(hf8*)(RW_KK(p) + (size_t)m * 384 + (c0 - 384)) = kv;
        }
      }
    } else if (act) {
      const float sc = c0 >= 384 ? 0.10206207261596575f : 1.f;
      hf8 ov;
#pragma unroll
      for (int i = 0; i < 8; ++i) ov[i] = (hf)(siluf_(o[i]) * sc);
      *(hf8*)(ML_QK(p) + (size_t)m * 768 + c0) = ov;
    }
  }
}

__device__ __forceinline__ void ph_lora(const P& p, int l, char* lds) {
  EPI_VARS
  hf* ZRW = RW_ZRW(p); const hf* RKV = RW_RKV(p); const bf16_t* LA = RW_LA(p); const hf* KK = RW_KK(p);
  hf* KD = RW_KD(p); hf* KA = RW_KA(p);
  const int Mt = 264; const int ntile = Mt * 15;
  for (int it = 0;; ++it) {
    int tm, q; if (!tile_map(it, Mt, 15, 15, tm, q)) break; const int job = q / 3, tn = q % 3; const int m0 = tm * 128, n0 = tn * 128;
    f32x4 acc[4][4]; ZERO_ACC(acc)
    if (job < 2) {
      const int d = job;
      gemm_main(LA + (size_t)m0 * 256, 256, p.W + (d ? W_WUP1 : W_WUP0) + (size_t)n0 * 64, 64, 64, acc, lds);
      const float* w0 = p.in[13] + (size_t)(l * 2 + d) * 384;
      EPI_BEGIN(m0, n0)
        const float e = sigmoidf_(w0[col] + val) * 0.6065306597126334f;
        ZRW[(size_t)row * 1152 + d * 384 + col] = (hf)(-expm1f(-e));
      EPI_END
    } else if (job < 4) {
      const int d = job - 2;
      gemm_main(LA + (size_t)m0 * 256 + 64, 256, p.W + (d ? W_AUP1 : W_AUP0) + (size_t)n0 * 64, 64, 64, acc, lds);
      const float* a0 = p.in[15] + (size_t)(l * 2 + d) * 384; const float* kaw = p.in[19] + (size_t)l * 384;
      EPI_ROW_BEGIN(m0)
        const int cb = n0 + wc * 64 + fr;
        const hf* kp = RKV + (size_t)row * 1152 + 384 + cb; const hf* kkp = KK + (size_t)row * 384 + cb;
        hf* kdp = KD + ((size_t)d * M_ALL + row) * 384 + cb; hf* kap = KA + ((size_t)d * M_ALL + row) * 384 + cb;
#pragma unroll
        for (int n = 0; n < 4; ++n) {
          const float a = sigmoidf_(a0[cb + n * 16] + acc[m][n][j]);
          kdp[n * 16] = (hf)((float)kp[n * 16] * (1.f + (a - 1.f) * kaw[cb + n * 16]));
          kap[n * 16] = (hf)((float)kkp[n * 16] * a);
        }
      EPI_ROW_END
    } else {
      gemm_main(LA + (size_t)m0 * 256 + 128, 256, p.W + W_GUP + (size_t)n0 * 128, 128, 128, acc, lds);
      EPI_BEGIN(m0, n0)
        ZRW[(size_t)row * 1152 + 768 + col] = (hf)val;
      EPI_END
    }
  }
}

#define RW_CH 32
#define RW_BUF 21504
__device__ __forceinline__ void ph_rwscan(const P& p, char* lds) {
  const hf* ZRW = RW_ZRW(p); hf* RKV = RW_RKV(p); const hf* KK = RW_KK(p);
  const int tid = get_tid(), lane = tid & 63, wid = tid >> 6;
  char* ybuf = lds + 3 * RW_BUF;
  for (int t = blockIdx.x; t < 192; t += gridDim.x) {
    const int rqq = t & 3, h = (t >> 2) % 6, b = (t / 24) & 3, d = t / 96;
    const int rsub = lane >> 4, g = lane & 15; const int rl = wid * 4 + rsub;
    const int sgn = d ? -1 : 1;
    const int sstep = tid >> 3, sseg = tid & 7;
    const hf* g_r = RKV + h * 64 + sseg * 8; const hf* g_kk = KK + h * 64 + sseg * 8; const hf* g_dd = ZRW + d * 384 + h * 64 + sseg * 8;
    const hf* g_kd = RW_KD(p) + (size_t)d * M_ALL * 384 + h * 64 + sseg * 8; const hf* g_ka = RW_KA(p) + (size_t)d * M_ALL * 384 + h * 64 + sseg * 8;
    const hf* g_v = RKV + 768 + h * 64 + rqq * 16 + (tid & 1) * 8;
    hf* g_y = d == 0 ? (RKV + 384 + h * 64 + rqq * 16 + (tid & 1) * 8) : (RW_YR(p) + h * 64 + rqq * 16 + (tid & 1) * 8);
    const int ldy = d == 0 ? 1152 : 384;
    uint4 q0, q1, q2, q3, q4, q5;
#define RW_M0(pp) ((pp) < 256 ? (M_LAT + b * 256 + (d ? 255 - (pp) : (pp))) : (b * 8192 + (d ? 8447 - (pp) : (pp) - 256)))
#define RW_GLOAD(c) { const int mb_ = RW_M0((c) * RW_CH); const size_t mm = (size_t)(mb_ + sgn * sstep); \
      q0 = *(const uint4*)(g_r + mm * 1152); q1 = *(const uint4*)(g_kk + mm * 384); q2 = *(const uint4*)(g_dd + mm * 1152); \
      q3 = *(const uint4*)(g_kd + mm * 384); q4 = *(const uint4*)(g_ka + mm * 384); \
      if (tid < 64) { const size_t mv = (size_t)(mb_ + sgn * (tid >> 1)); q5 = *(const uint4*)(g_v + mv * 1152); } }
#define RW_SSTORE(c) { char* bb_ = lds + ((c) % 3) * RW_BUF + sstep * 128 + sseg * 16; \
      *(uint4*)(bb_) = q0; *(uint4*)(bb_ + 4096) = q1; *(uint4*)(bb_ + 8192) = q2; *(uint4*)(bb_ + 12288) = q3; *(uint4*)(bb_ + 16384) = q4; \
      if (tid < 64) *(uint4*)(lds + ((c) % 3) * RW_BUF + 20480 + tid * 16) = q5; }
    float S0 = 0.f, S1 = 0.f, S2 = 0.f, S3 = 0.f;
    RW_GLOAD(0) RW_SSTORE(0)
    RW_GLOAD(1) RW_SSTORE(1)
    __syncthreads();
    const int NCH = 8448 / RW_CH;
    for (int c = 0; c < NCH; ++c) {
      if (c + 2 < NCH) RW_GLOAD(c + 2)
      if (c > 0 && tid < 64) {
        const int mb_ = RW_M0((c - 1) * RW_CH); const size_t mv = (size_t)(mb_ + sgn * (tid >> 1));
        *(uint4*)(g_y + mv * ldy) = *(const uint4*)(ybuf + ((c - 1) & 1) * 1024 + tid * 16);
      }
      const char* cb = lds + (c % 3) * RW_BUF + g * 8;
      hf* yb = (hf*)(ybuf + (c & 1) * 1024) + rl;
      const char* vb = lds + (c % 3) * RW_BUF + 20480 + rl * 2;
      hf4 r4 = *(const hf4*)(cb), k4 = *(const hf4*)(cb + 4096), d4 = *(const hf4*)(cb + 8192), kd4 = *(const hf4*)(cb + 12288), ka4 = *(const hf4*)(cb + 16384);
      hf vh = *(const hf*)(vb);
#pragma unroll
      for (int s = 0; s < RW_CH; ++s) {
        hf4 r4n = r4, k4n = k4, d4n = d4, kd4n = kd4, ka4n = ka4; hf vhn = vh;
        if (s + 1 < RW_CH) {
          r4n = *(const hf4*)(cb + (s + 1) * 128); k4n = *(const hf4*)(cb + 4096 + (s + 1) * 128); d4n = *(const hf4*)(cb + 8192 + (s + 1) * 128);
          kd4n = *(const hf4*)(cb + 12288 + (s + 1) * 128); ka4n = *(const hf4*)(cb + 16384 + (s + 1) * 128); vhn = *(const hf*)(vb + (s + 1) * 32);
        }
        const float vv = (float)vh;
        float sa = S0 * (float)k4[0] + S1 * (float)k4[1] + S2 * (float)k4[2] + S3 * (float)k4[3];
        sa = rowsum16(sa);
        S0 = fmaf(-S0, (float)d4[0], S0); S1 = fmaf(-S1, (float)d4[1], S1); S2 = fmaf(-S2, (float)d4[2], S2); S3 = fmaf(-S3, (float)d4[3], S3);
        S0 = fmaf(vv, (float)kd4[0], S0); S1 = fmaf(vv, (float)kd4[1], S1); S2 = fmaf(vv, (float)kd4[2], S2); S3 = fmaf(vv, (float)kd4[3], S3);
        S0 = fmaf(-sa, (float)ka4[0], S0); S1 = fmaf(-sa, (float)ka4[1], S1); S2 = fmaf(-sa, (float)ka4[2], S2); S3 = fmaf(-sa, (float)ka4[3], S3);
        float y = S0 * (float)r4[0] + S1 * (float)r4[1] + S2 * (float)r4[2] + S3 * (float)r4[3];
        y = rowsum16(y);
        if (g == 0) yb[s * 16] = (hf)y;
        r4 = r4n; k4 = k4n; d4 = d4n; kd4 = kd4n; ka4 = ka4n; vh = vhn;
      }
      if (c + 2 < NCH) RW_SSTORE(c + 2)
      __syncthreads();
    }
    if (tid < 64) {
      const int mb_ = RW_M0((NCH - 1) * RW_CH); const size_t mv = (size_t)(mb_ + sgn * (tid >> 1));
      *(uint4*)(g_y + mv * ldy) = *(const uint4*)(ybuf + ((NCH - 1) & 1) * 1024 + tid * 16);
    }
    __syncthreads();
  }
}

__device__ __forceinline__ void ph_rwpost(const P& p, int l) {
  const hf* ZRW = RW_ZRW(p); const hf* RKV = RW_RKV(p); const hf* YR = RW_YR(p);
  const int lane = get_tid() & 63, wid = get_tid() >> 6;
  const int nw = gridDim.x * 4;
  for (int t = blockIdx.x * 4 + wid; t < M_ALL * 6; t += nw) {
    const int m = t / 6, h = t % 6; const int c = h * 64 + lane;
    const float ys = (float)RKV[(size_t)m * 1152 + 384 + c] + (float)YR[(size_t)m * 384 + c];
    const float mean = wavesum(ys) * (1.f / 64.f);
    const float xc = ys - mean;
    const float var = wavesum(xc * xc) * (1.f / 64.f);
    float y = xc * rsqrtf(var + 64e-5f) * p.in[21][(size_t)l * 384 + c] + p.in[22][(size_t)l * 384 + c];
    const float r = (float)RKV[(size_t)m * 1152 + c], v = (float)RKV[(size_t)m * 1152 + 768 + c];
    const float rk = p.in[20][(size_t)l * 384 + c];
    const float kd0 = (float)RW_KD(p)[(size_t)m * 384 + c], kd1 = (float)RW_KD(p)[((size_t)M_ALL + m) * 384 + c];
    const float bs = wavesum(r * (kd0 + kd1) * rk);
    y = (y + bs * v) * (float)ZRW[(size_t)m * 1152 + 768 + c];
    p.Y[(size_t)m * 1024 + c] = f2bf(y);
  }
}

struct S5C { float ar, ai; float br[16], bi[16]; };
__device__ __forceinline__ void s5_consts(const P& p, int l, int d, int g, int n, S5C& c) {
  const int ig = (l * 2 + d) * 16 + g;
  const float lr = fminf(p.in[23][(size_t)ig * 64 + n], -1e-4f), li = p.in[24][(size_t)ig * 64 + n];
  const float dt = expf(p.in[25][ig]);
  const float mag = expf(lr * dt);
  c.ar = mag * cosf(li * dt); c.ai = mag * sinf(li * dt);
  const float nr = c.ar - 1.f, ni = c.ai; const float den = 1.f / (lr * lr + li * li);
  const float cr = (nr * lr + ni * li) * den, ci = (ni * lr - nr * li) * den;
  const float* bre = p.in[26] + ((size_t)ig * 64 + n) * 16; const float* bim = p.in[27] + ((size_t)ig * 64 + n) * 16;
#pragma unroll
  for (int h = 0; h < 16; ++h) { const float xr = bre[h], xi = bim[h]; c.br[h] = cr * xr - ci * xi; c.bi[h] = cr * xi + ci * xr; }
}
__device__ __forceinline__ int s5_m0(int b, int tc) { return tc < 128 ? b * 8192 + tc * 64 : M_LAT + b * 256 + (tc - 128) * 64; }
__device__ __forceinline__ int chain_pos(int d, int tc) { return d == 0 ? (tc < 128 ? tc + 4 : tc - 128) : (tc < 128 ? 131 - tc : 131 - tc); }
__device__ __forceinline__ void ph_s5_pass(const P& p, int l, int pass, char* lds) {
  const int lane = get_tid() & 63, wid = get_tid() >> 6;
  float* ub = (float*)lds + wid * 2048;
  float* yb = ub + 1024;
  const float* Z = S5_Z(p); float2* E = S5_E(p); const float2* X = S5_X(p); bf16_t* YG = S5_YG(p);
  const int nw = gridDim.x * 4;
  for (int t = blockIdx.x * 4 + wid; t < 4 * 132 * 16; t += nw) {
    const int g = t & 15, tc = (t >> 4) % 132, b = t / (16 * 132);
    const int m0 = s5_m0(b, tc);
#pragma unroll
    for (int i = 0; i < 4; ++i) { const int e = lane + i * 64; const int tok = e >> 2, q = e & 3;
      *(float4*)(ub + tok * 16 + q * 4) = *(const float4*)(Z + (size_t)(m0 + tok) * 256 + g * 16 + q * 4); }
    __builtin_amdgcn_s_waitcnt(0);
    __builtin_amdgcn_wave_barrier();
    for (int d = 0; d < 2; ++d) {
      S5C c; s5_consts(p, l, d, g, lane, c);
      const int cp = chain_pos(d, tc);
      const size_t sidx = (((size_t)(d * 4 + b) * 132 + cp) * 16 + g) * 64 + lane;
      float xr = 0.f, xi = 0.f;
      float cre[16], cim[16];
      if (pass == 3) {
        float2 x0 = X[sidx]; xr = x0.x; xi = x0.y;
        const int ig = (l * 2 + d) * 16 + g;
#pragma unroll
        for (int h = 0; h < 16; ++h) { cre[h] = p.in[28][((size_t)ig * 16 + h) * 64 + lane]; cim[h] = p.in[29][((size_t)ig * 16 + h) * 64 + lane]; }
      }
      for (int j = 0; j < 64; ++j) {
        const int tok = d ? 63 - j : j;
        float br = 0.f, bi = 0.f;
        const float* u = ub + tok * 16;
#pragma unroll
        for (int h = 0; h < 16; ++h) { const float uv = u[h]; br += c.br[h] * uv; bi += c.bi[h] * uv; }
        const float nr = c.ar * xr - c.ai * xi + br, ni = c.ar * xi + c.ai * xr + bi;
        xr = nr; xi = ni;
        if (pass == 3) {
          float pp[16];
#pragma unroll
          for (int h = 0; h < 16; ++h) pp[h] = cre[h] * xr - cim[h] * xi;
#pragma unroll
          for (int i = 0; i < 8; ++i) { const bool hi = lane & 1; float snd = hi ? pp[i] : pp[i + 8]; float rcv = __shfl_xor(snd, 1); pp[i] = (hi ? pp[i + 8] : pp[i]) + rcv; }
#pragma unroll
          for (int i = 0; i < 4; ++i) { const bool hi = lane & 2; float snd = hi ? pp[i] : pp[i + 4]; float rcv = __shfl_xor(snd, 2); pp[i] = (hi ? pp[i + 4] : pp[i]) + rcv; }
#pragma unroll
          for (int i = 0; i < 2; ++i) { const bool hi = lane & 4; float snd = hi ? pp[i] : pp[i + 2]; float rcv = __shfl_xor(snd, 4); pp[i] = (hi ? pp[i + 2] : pp[i]) + rcv; }
          { const bool hi = lane & 8; float snd = hi ? pp[0] : pp[1]; float rcv = __shfl_xor(snd, 8); pp[0] = (hi ? pp[1] : pp[0]) + rcv; }
          float tot = pp[0]; tot += __shfl_xor(tot, 16); tot += __shfl_xor(tot, 32);
          if (lane < 16) {
            const int hh = ((lane & 1) ? 8 : 0) + ((lane & 2) ? 4 : 0) + ((lane & 4) ? 2 : 0) + ((lane & 8) ? 1 : 0);
            if (d == 0) yb[tok * 16 + hh] = tot; else yb[tok * 16 + hh] += tot;
          }
        }
      }
      if (pass == 1) E[sidx] = make_float2(xr, xi);
    }
    if (pass == 3) {
      __builtin_amdgcn_s_waitcnt(0);
      __builtin_amdgcn_wave_barrier();
#pragma unroll
      for (int i = 0; i < 16; ++i) {
        const int e = lane + i * 64; const int tok = e >> 4, h = e & 15;
        float y = yb[e] + p.in[30][(size_t)l * 256 + g * 16 + h] * ub[e];
        const float inner = 0.7978845608028654f * (y + 0.044715f * y * y * y);
        y = 0.5f * y * (1.f + tanhf(inner));
        YG[(size_t)(m0 + tok) * 256 + g * 16 + h] = f2bf(y);
      }
    }
    __builtin_amdgcn_s_waitcnt(0);
    __builtin_amdgcn_wave_barrier();
  }
}
__device__ __forceinline__ void ph_s5_carry(const P& p, int l) {
  const float2* E = S5_E(p); float2* X = S5_X(p);
  for (int t = blockIdx.x * NTHR + get_tid(); t < 8192; t += gridDim.x * NTHR) {
    const int n = t & 63, g = (t >> 6) & 15, b = (t >> 10) & 3, d = t >> 12;
    const int ig = (l * 2 + d) * 16 + g;
    const float lr = fminf(p.in[23][(size_t)ig * 64 + n], -1e-4f), li = p.in[24][(size_t)ig * 64 + n];
    const float dt = expf(p.in[25][ig]);
    const float mag = expf(lr * dt * 64.f);
    float ar = expf(lr * dt) * cosf(li * dt), ai = expf(lr * dt) * sinf(li * dt);
#pragma unroll
    for (int i = 0; i < 6; ++i) { const float r2 = ar * ar - ai * ai, i2 = 2.f * ar * ai; ar = r2; ai = i2; }
    (void)mag;
    float xr = 0.f, xi = 0.f;
    const size_t base = (((size_t)(d * 4 + b) * 132) * 16 + g) * 64 + n;
    for (int cp0 = 0; cp0 < 132; cp0 += 12) {
      float2 ev[12];
#pragma unroll
      for (int u = 0; u < 12; ++u) ev[u] = E[base + (size_t)(cp0 + u) * 1024];
#pragma unroll
      for (int u = 0; u < 12; ++u) {
        X[base + (size_t)(cp0 + u) * 1024] = make_float2(xr, xi);
        const float nr = ar * xr - ai * xi + ev[u].x, ni = ar * xi + ai * xr + ev[u].y;
        xr = nr; xi = ni;
      }
    }
  }
}
__device__ __forceinline__ void ph_glu(const P& p, int l, char* lds) {
  EPI_VARS
  const bf16_t* YG = S5_YG(p);
  const int Mt = 264; const int ntile = Mt * 2;
  const float* gb = p.in[32] + (size_t)l * 256;
  for (int it = 0;; ++it) {
    int tm, tn; if (!tile_map(it, Mt, 2, 2, tm, tn)) break; const int m0 = tm * 128, n0 = tn * 128;
    f32x4 acc[4][4]; ZERO_ACC(acc)
    gemm_main(YG + (size_t)m0 * 256, 256, p.W + W_GLU + (size_t)n0 * 256, 256, 256, acc, lds);
    EPI_BEGIN(m0, n0)
      const float y = bf2f(YG[(size_t)row * 256 + col]);
      p.Y[(size_t)row * 1024 + 384 + col] = f2bf(y * sigmoidf_(val + gb[col]));
    EPI_END
  }
}

__device__ __forceinline__ float logsigf_(float x) { return fminf(x, 0.f) - log1pf(__expf(-fabsf(x))); }
__device__ __forceinline__ void ml_gates(const P& p, int l, int d, int h, int m0, int lane, float& bcum, float& ic) {
  const int tok = d ? 63 - lane : lane;
  const float* gl = ML_GL(p) + (size_t)(m0 + tok) * 16;
  const float* gb = p.in[33] + (size_t)(l * 2 + d) * 8;
  ic = gl[d * 8 + h] + gb[h];
  float f = logsigf_(gl[d * 8 + 4 + h] + gb[4 + h]);
#pragma unroll
  for (int o = 1; o < 64; o <<= 1) { float v = __shfl_up(f, o); if (lane >= o) f += v; }
  bcum = f;
}
__device__ __forceinline__ void ml_gates2(const P& p, int l, int d, int h, int m0, int lane, float& bc, float& ic, float& tot) {
  const float* gl = ML_GL(p) + (size_t)(m0 + lane) * 16;
  const float* gb = p.in[33] + (size_t)(l * 2 + d) * 8;
  ic = gl[d * 8 + h] + gb[h];
  const float f0 = logsigf_(gl[d * 8 + 4 + h] + gb[4 + h]);
  float f = f0;
#pragma unroll
  for (int o = 1; o < 64; o <<= 1) { float v = __shfl_up(f, o); if (lane >= o) f += v; }
  tot = __shfl(f, 63);
  bc = d ? (tot - f + f0) : f;
}
#define MLQ 208
#define MLS 144
__device__ __forceinline__ void ph_ml_a(const P& p, int l, char* lds) {
  char* vt = lds; char* kt = lds + 13824; float* wg = (float*)(lds + 27648);
  const int tid = get_tid(), lane = tid & 63, wid = tid >> 6, fr = lane & 15, fq = lane >> 4;
  const hf* QK = ML_QK(p); const hf* Z = ML_Z(p);
  for (int t = blockIdx.x; t < 4224; t += gridDim.x) {
    const int tc = t % 132, h = (t / 132) & 3, b = (t / 528) & 3, d = t / 2112;
    const int m0 = s5_m0(b, tc); const int cp = chain_pos(d, tc);
    const size_t task = ((size_t)((d * 4 + b) * 4 + h)) * 132 + cp;
    if (wid == 0) {
      float bc, ic, tot; ml_gates2(p, l, d, h, m0, lane, bc, ic, tot);
      const float lw = tot - bc + ic;
      float mx = lw;
      for (int o = 32; o > 0; o >>= 1) mx = fmaxf(mx, __shfl_xor(mx, o));
      wg[lane] = __expf(lw - mx);
      if (lane == 0) { ML_SC(p)[task * 2] = mx; ML_SC(p)[task * 2 + 1] = tot; }
    }
    __syncthreads();
    for (int e = tid; e < 64 * 12; e += NTHR) {
      const int tok = e & 63, q = e >> 6;
      const hf8 kv = *(const hf8*)(QK + (size_t)(m0 + tok) * 768 + 384 + h * 96 + q * 8);
      const hf8 vv = *(const hf8*)(Z + (size_t)(m0 + tok) * 1536 + 768 + h * 96 + q * 8);
      const float w = wg[tok];
#pragma unroll
      for (int i = 0; i < 8; ++i) {
        *(hf*)(kt + (q * 8 + i) * MLS + tok * 2) = kv[i];
        *(hf*)(vt + (q * 8 + i) * MLS + tok * 2) = (hf)((float)vv[i] * w);
      }
    }
    __syncthreads();
    float* dc = ML_DC(p) + task * 9216;
#pragma unroll 1
    for (int bi = 0; bi < 9; ++bi) {
      const int idx = wid * 9 + bi; const int mb = idx / 6, nb = idx % 6;
      f32x4 acc = (f32x4){0.f, 0.f, 0.f, 0.f};
#pragma unroll
      for (int ks = 0; ks < 2; ++ks) {
        const hf8 af = *(const hf8*)(vt + (mb * 16 + fr) * MLS + ks * 64 + fq * 16);
        const hf8 bf = *(const hf8*)(kt + (nb * 16 + fr) * MLS + ks * 64 + fq * 16);
        acc = __builtin_amdgcn_mfma_f32_16x16x32_f16(af, bf, acc, 0, 0, 0);
      }
#pragma unroll
      for (int j = 0; j < 4; ++j) dc[(mb * 16 + fq * 4 + j) * 96 + nb * 16 + fr] = acc[j];
    }
    if (tid < 96) {
      float s = 0.f;
      for (int j = 0; j < 64; ++j) s += wg[j] * (float)*(const hf*)(kt + tid * MLS + j * 2);
      ML_DN(p)[task * 96 + tid] = s;
    }
    __syncthreads();
  }
}
__device__ __forceinline__ void ph_ml_b(const P& p) {
  float* DC = ML_DC(p); float* DN = ML_DN(p); const float* SC = ML_SC(p); float* MP = ML_MP(p);
  for (int t = blockIdx.x * NTHR + get_tid(); t < 32 * 9312; t += gridDim.x * NTHR) {
    const int chain = t / 9312, e = t % 9312;
    float cur = 0.f, mprev = 0.f;
    for (int cp0 = 0; cp0 < 132; cp0 += 12) {
      float dl[12], ml_[12], bl_[12];
#pragma unroll
      for (int u = 0; u < 12; ++u) {
        const size_t task = (size_t)chain * 132 + cp0 + u;
        dl[u] = e < 9216 ? DC[task * 9216 + e] : DN[task * 96 + (e - 9216)];
        ml_[u] = SC[task * 2]; bl_[u] = SC[task * 2 + 1];
      }
#pragma unroll
      for (int u = 0; u < 12; ++u) {
        const size_t task = (size_t)chain * 132 + cp0 + u;
        float* slot = e < 9216 ? DC + task * 9216 + e : DN + task * 96 + (e - 9216);
        *slot = cur;
        if (e == 0) MP[task] = mprev;
        const float mnew = fmaxf(bl_[u] + mprev, ml_[u]);
        cur = __expf(bl_[u] + mprev - mnew) * cur + __expf(ml_[u] - mnew) * dl[u];
        mprev = mnew;
      }
    }
  }
}
__device__ __forceinline__ void ph_ml_c(const P& p, int l, char* lds) {
  char* qs = lds; char* ks = lds + 13312; char* vt = lds + 26624; char* cs = lds + 40448; char* ps = lds + 60416;
  float* fl = (float*)(lds + 69632);
  float* bc = fl; float* icv = fl + 128; float* mr = fl + 256; float* inter = fl + 320; float* den = fl + 384; float* nq = fl + 448; float* nst = fl + 512;
  const int tid = get_tid(), lane = tid & 63, wid = tid >> 6, fr = lane & 15, fq = lane >> 4;
  const hf* QK = ML_QK(p); const hf* Z = ML_Z(p);
  for (int t = blockIdx.x; t < 2112; t += gridDim.x) {
    const int tc = t % 132, h = (t / 132) & 3, b = t / 528;
    const int m0 = s5_m0(b, tc);
    for (int e = tid; e < 64 * 12; e += NTHR) {
      const int tok = e & 63, q = e >> 6;
      *(hf8*)(qs + tok * MLQ + q * 16) = *(const hf8*)(QK + (size_t)(m0 + tok) * 768 + h * 96 + q * 8);
      *(hf8*)(ks + tok * MLQ + q * 16) = *(const hf8*)(QK + (size_t)(m0 + tok) * 768 + 384 + h * 96 + q * 8);
      const hf8 vv = *(const hf8*)(Z + (size_t)(m0 + tok) * 1536 + 768 + h * 96 + q * 8);
#pragma unroll
      for (int i = 0; i < 8; ++i) *(hf*)(vt + (q * 8 + i) * MLS + tok * 2) = vv[i];
    }
    if (wid < 2) { float bcv, ic, tot; ml_gates2(p, l, wid, h, m0, lane, bcv, ic, tot); bc[wid * 64 + lane] = bcv; icv[wid * 64 + lane] = ic; }
    f32x4 hs[6];
#pragma unroll
    for (int n = 0; n < 6; ++n) hs[n] = (f32x4){0.f, 0.f, 0.f, 0.f};
    for (int d = 0; d < 2; ++d) {
      const int cp = chain_pos(d, tc);
      const size_t task = ((size_t)((d * 4 + b) * 4 + h)) * 132 + cp;
      const float mprev = ML_MP(p)[task];
      __syncthreads();
      {
        const float* cg = ML_DC(p) + task * 9216;
        for (int e = tid; e < 96 * 24; e += NTHR) {
          const int v = e / 24, q = e % 24;
          const float4 c4 = *(const float4*)(cg + v * 96 + q * 4);
          hf4 o; o[0] = (hf)c4.x; o[1] = (hf)c4.y; o[2] = (hf)c4.z; o[3] = (hf)c4.w;
          *(hf4*)(cs + v * MLQ + q * 8) = o;
        }
        if (tid < 96) nst[tid] = ML_DN(p)[task * 96 + tid];
      }
      const float* bcd = bc + d * 64; const float* icd = icv + d * 64;
      if (tid < 64) {
        const int j = tid; const float bj = bcd[j];
        float mx = bj + mprev;
        if (d == 0) { for (int s = 0; s <= j; ++s) mx = fmaxf(mx, bj - bcd[s] + icd[s]); }
        else { for (int s = j; s < 64; ++s) mx = fmaxf(mx, bj - bcd[s] + icd[s]); }
        mr[j] = mx; inter[j] = __expf(bj + mprev - mx);
      }
      __syncthreads();
      if (tid < 64) {
        float s1 = 0.f;
        for (int k = 0; k < 96; ++k) s1 += nst[k] * (float)*(const hf*)(qs + tid * MLQ + k * 2);
        nq[tid] = s1;
      }
      {
        f32x4 sacc[4];
#pragma unroll
        for (int n = 0; n < 4; ++n) sacc[n] = (f32x4){0.f, 0.f, 0.f, 0.f};
#pragma unroll
        for (int kk = 0; kk < 3; ++kk) {
          const hf8 af = *(const hf8*)(qs + (wid * 16 + fr) * MLQ + kk * 64 + fq * 16);
#pragma unroll
          for (int n = 0; n < 4; ++n) {
            const hf8 bf = *(const hf8*)(ks + (n * 16 + fr) * MLQ + kk * 64 + fq * 16);
            sacc[n] = __builtin_amdgcn_mfma_f32_16x16x32_f16(af, bf, sacc[n], 0, 0, 0);
          }
        }
        float rs[4] = {0.f, 0.f, 0.f, 0.f};
#pragma unroll
        for (int n = 0; n < 4; ++n) {
          const int s = n * 16 + fr; const float bs = bcd[s] - icd[s];
#pragma unroll
          for (int jj = 0; jj < 4; ++jj) {
            const int j = wid * 16 + fq * 4 + jj;
            const bool valid = d == 0 ? (s <= j) : (s >= j);
            const float val = valid ? sacc[n][jj] * __expf(bcd[j] - bs - mr[j]) : 0.f;
            rs[jj] += val;
            *(hf*)(ps + j * MLS + s * 2) = (hf)val;
          }
        }
        __syncthreads();
#pragma unroll
        for (int jj = 0; jj < 4; ++jj) {
          const float r = rowsum16(rs[jj]);
          const int j = wid * 16 + fq * 4 + jj;
          if (fr == 0) den[j] = inter[j] * nq[j] + r;
        }
      }
      f32x4 acc[6];
#pragma unroll
      for (int n = 0; n < 6; ++n) acc[n] = (f32x4){0.f, 0.f, 0.f, 0.f};
#pragma unroll
      for (int kk = 0; kk < 3; ++kk) {
        const hf8 af = *(const hf8*)(qs + (wid * 16 + fr) * MLQ + kk * 64 + fq * 16);
#pragma unroll
        for (int n = 0; n < 6; ++n) {
          const hf8 bf = *(const hf8*)(cs + (n * 16 + fr) * MLQ + kk * 64 + fq * 16);
          acc[n] = __builtin_amdgcn_mfma_f32_16x16x32_f16(af, bf, acc[n], 0, 0, 0);
        }
      }
#pragma unroll
      for (int jj = 0; jj < 4; ++jj) { const float it = inter[wid * 16 + fq * 4 + jj];
#pragma unroll
        for (int n = 0; n < 6; ++n) acc[n][jj] *= it; }
#pragma unroll
      for (int kk = 0; kk < 2; ++kk) {
        const hf8 af = *(const hf8*)(ps + (wid * 16 + fr) * MLS + kk * 64 + fq * 16);
#pragma unroll
        for (int n = 0; n < 6; ++n) {
          const hf8 bf = *(const hf8*)(vt + (n * 16 + fr) * MLS + kk * 64 + fq * 16);
          acc[n] = __builtin_amdgcn_mfma_f32_16x16x32_f16(af, bf, acc[n], 0, 0, 0);
        }
      }
      __syncthreads();
#pragma unroll
      for (int jj = 0; jj < 4; ++jj) {
        const int j = wid * 16 + fq * 4 + jj;
        const float dn = 1.f / fmaxf(fabsf(den[j]), __expf(-mr[j]));
#pragma unroll
        for (int n = 0; n < 6; ++n) hs[n][jj] += acc[n][jj] * dn;
      }
    }
#pragma unroll
    for (int jj = 0; jj < 4; ++jj) {
      const int m = m0 + wid * 16 + fq * 4 + jj;
      const hf* op = Z + (size_t)m * 1536 + 1152 + h * 96 + fr;
      float x[6]; float s = 0.f;
#pragma unroll
      for (int n = 0; n < 6; ++n) { x[n] = sigmoidf_((float)op[n * 16]) * hs[n][jj]; s += x[n]; }
      s = rowsum16(s);
      const float mean = s * (1.f / 96.f);
      float q = 0.f;
#pragma unroll
      for (int n = 0; n < 6; ++n) { x[n] -= mean; q += x[n] * x[n]; }
      q = rowsum16(q);
      const float rsd = rsqrtf(q * (1.f / 96.f) + 1e-5f);
      const float* ng = p.in[34] + (size_t)l * 384 + h * 96 + fr;
      bf16_t* yp = p.Y + (size_t)m * 1024 + 640 + h * 96 + fr;
#pragma unroll
      for (int n = 0; n < 6; ++n) yp[n * 16] = f2bf(x[n] * rsd * ng[n * 16]);
    }
    __syncthreads();
  }
}

#define MG_YM(p) ((bf16_t*)(p).R)
#define MG_G3(p) (MG_YM(p) + (size_t)M_ALL * 1024)
__device__ __forceinline__ void ph_gates(const P& p, int l, int Mt, char* lds) {
  EPI_VARS
  bf16_t* G3 = MG_G3(p);
  const float* gbias = p.in[38] + (size_t)l * 3072;
  const int ntile = Mt * 24;
  for (int it = 0;; ++it) {
    int tm, tn; if (!tile_map(it, Mt, 24, 8, tm, tn)) break; const int m0 = tm * 128, n0 = tn * 128;
    f32x4 acc[4][4]; ZERO_ACC(acc)
    gemm_main(p.U + (size_t)m0 * 1024, 1024, p.W + W_IN + (size_t)(3216 + n0) * 1024, 1024, 1024, acc, lds);
    EPI_BEGIN(m0, n0)
      G3[(size_t)row * 3072 + col] = f2bf(sigmoidf_(val + gbias[col]));
    EPI_END
  }
}
__device__ __forceinline__ void ph_merge(const P& p, int l, int Mt, char* lds) {
  EPI_VARS
  bf16_t* YM = MG_YM(p); const bf16_t* G3 = MG_G3(p);
  const int ntile = Mt * 16;
  for (int it = 0;; ++it) {
    int tm, tn; if (!tile_map(it, Mt, 16, 8, tm, tn)) break; const int m0 = tm * 128, n0 = tn * 64;
    f32x4 yacc[4][2];
#pragma unroll
    for (int m = 0; m < 4; ++m) { yacc[m][0] = (f32x4){0.f, 0.f, 0.f, 0.f}; yacc[m][1] = (f32x4){0.f, 0.f, 0.f, 0.f}; }
#pragma unroll 1
    for (int br = 0; br < 3; ++br) {
      f32x4 acc[4][2];
#pragma unroll
      for (int m = 0; m < 4; ++m) { acc[m][0] = (f32x4){0.f, 0.f, 0.f, 0.f}; acc[m][1] = (f32x4){0.f, 0.f, 0.f, 0.f}; }
      const int kb = br == 1 ? 256 : 384; const int yoff = br == 0 ? 0 : (br == 1 ? 384 : 640);
      const int woff = br == 0 ? W_UPRW : (br == 1 ? W_UPS5 : W_UPML);
      gemm_main_t<2>(p.Y + (size_t)m0 * 1024 + yoff, 1024, p.W + woff + (size_t)n0 * kb, kb, kb, acc, lds);
      EPI_ROW_BEGIN(m0)
        const bf16_t* gp = G3 + (size_t)row * 3072 + br * 1024 + n0 + wc * 32 + fr;
#pragma unroll
        for (int n = 0; n < 2; ++n) yacc[m][n][j] += bf2f(gp[n * 16]) * acc[m][n][j];
      EPI_ROW_END
    }
    EPI_ROW_BEGIN(m0)
      bf16_t* yp = YM + (size_t)row * 1024 + n0 + wc * 32 + fr;
#pragma unroll
      for (int n = 0; n < 2; ++n) yp[n * 16] = f2bf(yacc[m][n][j]);
    EPI_ROW_END
  }
}
__device__ __forceinline__ void ph_wout(const P& p, int l, int Mt, char* lds) {
  EPI_VARS
  const bf16_t* YM = (const bf16_t*)p.R;
  const int ntile = Mt * 8;
  for (int it = 0;; ++it) {
    int tm, tn; if (!tile_map(it, Mt, 8, 8, tm, tn)) break; const int m0 = tm * 128, n0 = tn * 128;
    f32x4 acc[4][4]; ZERO_ACC(acc)
    gemm_main(YM + (size_t)m0 * 1024, 1024, p.W + W_OUT + (size_t)n0 * 1024, 1024, 1024, acc, lds);
    EPI_ROW_BEGIN(m0)
      float* sp = srow(p, row) + n0 + wc * 64 + fr; const float* gp = modp(p, l, row, 5) + n0 + wc * 64 + fr;
#pragma unroll
      for (int n = 0; n < 4; ++n) sp[n * 16] = ALPHA * sp[n * 16] + gp[n * 16] * acc[m][n][j];
    EPI_ROW_END
  }
}

#define XB_TMO      128
#define XB_XCNT(j)  (256  + 64 * (j))
#define XB_XSUB(j)  (1280 + 64 * (j))
#define XB_XGEN(j)  (2304 + 64 * (j))
#define XB_TOP      3328
#define XB_TOPGEN   3392
#define XCD_BAR_WORDS 3456
#define XB_SPIN_CAP (1u << 18)
#define LAS __attribute__((address_space(3)))

__device__ __forceinline__ unsigned xb_ld(unsigned* p)              { return __hip_atomic_load(p, __ATOMIC_RELAXED, __HIP_MEMORY_SCOPE_AGENT); }
__device__ __forceinline__ unsigned xb_add(unsigned* p, unsigned v) { return __hip_atomic_fetch_add(p, v, __ATOMIC_RELAXED, __HIP_MEMORY_SCOPE_AGENT); }
__device__ __forceinline__ unsigned xb_xcc_id() { return (unsigned)__builtin_amdgcn_s_getreg((3 << 11) | 20) & 0xFu; }
#define XB_SPIN(cond, bar) do { unsigned _sp = 0; while (cond) { __builtin_amdgcn_s_sleep(1); \
    if ((++_sp & 255u) == 0u) { if (xb_ld(&(bar)[XB_TMO])) break; if (_sp > XB_SPIN_CAP) { atomicAdd(&(bar)[XB_TMO], 1u); break; } } } } while (0)

struct XcdBarrier {
    unsigned* bar; unsigned x;
    volatile LAS unsigned* st;
};

__device__ __forceinline__ XcdBarrier xcd_barrier_post(unsigned* bar, volatile LAS unsigned* st) {
    XcdBarrier b; b.bar = bar; b.x = xb_xcc_id(); b.st = st;
    if (__builtin_amdgcn_workitem_id_x() == 0) (void)xb_add(&bar[XB_XCNT(b.x)], 1u);
    return b;
}
__device__ __forceinline__ void xcd_barrier_complete(unsigned* bar, unsigned x, unsigned& nloc, unsigned& nx) {
    const unsigned G = gridDim.x * gridDim.y * gridDim.z;
    unsigned sum, cnt, mine, sp = 0u;
    for (;;) {
        sum = 0u; cnt = 0u; mine = 0u;
#pragma unroll
        for (unsigned j = 0; j < 16; ++j) { const unsigned c = xb_ld(&bar[XB_XCNT(j)]); sum += c; cnt += (c > 0u) ? 1u : 0u; mine = (j == x) ? c : mine; }
        if (sum == G) break;
        __builtin_amdgcn_s_sleep(1);
        if ((++sp & 255u) == 0u) { if (xb_ld(&bar[XB_TMO])) break; if (sp > XB_SPIN_CAP) { atomicAdd(&bar[XB_TMO], 1u); break; } }
    }
    nloc = mine > 0u ? mine : 1u; nx = cnt > 0u ? cnt : 1u;
}

__device__ __forceinline__ void xcd_barrier(const XcdBarrier& b) {
    asm volatile("s_waitcnt vmcnt(0)" ::: "memory");
    __syncthreads();
    if (__builtin_amdgcn_workitem_id_x() == 0) {
        unsigned* bar = b.bar;
        __builtin_amdgcn_s_waitcnt(0);
        unsigned nloc = b.st[0], nx = b.st[1];
        if (nloc == 0u) { xcd_barrier_complete(bar, b.x, nloc, nx); b.st[0] = nloc; b.st[1] = nx; }
        const unsigned old = xb_add(&bar[XB_XSUB(b.x)], 1u);
        const unsigned gen = old / nloc;
        if (old + 1u == (gen + 1u) * nloc) {
            __builtin_amdgcn_fence(__ATOMIC_RELEASE, "agent");
            asm volatile("s_waitcnt vmcnt(0)" ::: "memory");
            const unsigned og = xb_add(&bar[XB_TOP], 1u);
            const unsigned tg = og / nx;
            if (og + 1u == (tg + 1u) * nx) xb_add(&bar[XB_TOPGEN], 1u);
            else XB_SPIN(xb_ld(&bar[XB_TOPGEN]) == tg, bar);
            __builtin_amdgcn_fence(__ATOMIC_ACQUIRE, "agent");
            xb_add(&bar[XB_XGEN(b.x)], 1u);
            asm volatile("s_waitcnt vmcnt(0)" ::: "memory");
        } else {
            XB_SPIN(xb_ld(&bar[XB_XGEN(b.x)]) == gen, bar);
            __builtin_amdgcn_fence(__ATOMIC_ACQUIRE, "agent");
            asm volatile("s_waitcnt vmcnt(0)" ::: "memory");
        }
    }
    __syncthreads();
}


#define SYNC xcd_barrier(xb); asm volatile("" : "+s"(l));
__global__ void __launch_bounds__(NTHR, 2) mega(P pv) {
#define p pv
  __shared__ __attribute__((aligned(16))) char lds[LDS_BYTES];
  __shared__ uint4 xb_words;
  cg::grid_group grid = cg::this_grid();
  {
    const int t0 = __builtin_amdgcn_workitem_id_x();
    if (blockIdx.x == 0) for (int i = t0; i < XCD_BAR_WORDS; i += NTHR) pv.bar[i] = 0u;
    if (t0 == 0) xb_words = make_uint4(0u, 0u, 0u, 0u);
    __threadfence();
    grid.sync();
  }
  XcdBarrier xb = xcd_barrier_post(pv.bar, (volatile LAS unsigned*)&xb_words);
  for (int l = 0; l < 2; ++l) {
    const bool last = (l == 1);
    const int Mt2 = last ? 256 : 264;
    const int Mr2 = last ? M_LAT : M_ALL;
    ph_convert(p, l, l == 0, lds); SYNC
    if (l == 0) { ph_rows(p, 0, 0, 0, M_ALL, true, 0, 0); SYNC }
    ph_ffn_up(p, 0, 264, lds); SYNC
    ph_ffn_down(p, l, 0, 264, lds); SYNC
    ph_rows(p, 1, l, 0, M_ALL, true, l, 3); SYNC
    ph_z_rw(p, lds); SYNC
    ph_conv(p, l, 0); SYNC
    ph_lora(p, l, lds); SYNC
    ph_rwscan(p, lds); SYNC
    ph_rwpost(p, l); SYNC
    ph_z_s5(p, lds); SYNC
    ph_s5_pass(p, l, 1, lds); SYNC
    ph_s5_carry(p, l); SYNC
    ph_s5_pass(p, l, 3, lds); SYNC
    ph_glu(p, l, lds); SYNC
    ph_z_ml(p, lds); SYNC
    ph_conv(p, l, 1); SYNC
    ph_ml_a(p, l, lds); SYNC
    ph_ml_b(p); SYNC
    ph_ml_c(p, l, lds); SYNC
    ph_gates(p, l, Mt2, lds); SYNC
    ph_merge(p, l, Mt2, lds); SYNC
    ph_wout(p, l, Mt2, lds); SYNC
    ph_rows(p, 1, l, 1, Mr2, true, l, 6); SYNC
    ph_ffn_up(p, 1, Mt2, lds); SYNC
    ph_ffn_down(p, l, 1, Mt2, lds); SYNC
    ph_rows(p, 1, l, 2, Mr2, !last, l + 1, 0);
    if (!last) { SYNC }
  }
#undef p
}

extern "C" void kernel_launch(void* const* d_in, const int* in_sizes, int n_in, void* d_out, int out_size, void* d_ws, size_t ws_size,
                              hipStream_t stream) {
  static int grid_blocks = 0;
  if (!grid_blocks) {
    int dev = 0, cus = 0, per_cu = 0;
    hipGetDevice(&dev);
    hipDeviceGetAttribute(&cus, hipDeviceAttributeMultiprocessorCount, dev);
    hipOccupancyMaxActiveBlocksPerMultiprocessor(&per_cu, mega, NTHR, 0);
    if (per_cu > 2) per_cu = 2;
    grid_blocks = cus * per_cu;
  }
  P p{};
  for (int i = 0; i < 40; ++i) p.in[i] = (const float*)d_in[i];
  char* ws = (char*)d_ws;
  size_t off = 0;
  p.W = (bf16_t*)(ws + off); off += (size_t)W_TOTAL * 2;
  p.mod = (float*)(ws + off); off += (size_t)2 * 5 * 9216 * 4;
  p.sctx = (float*)(ws + off); off += (size_t)1024 * 1024 * 4;
  p.bar = (unsigned*)(ws + off); off += (size_t)16384;
  p.U = (bf16_t*)(ws + off); off += (size_t)M_ALL * 1024 * 2;
  p.Y = (bf16_t*)(ws + off); off += (size_t)M_ALL * 1024 * 2;
  p.R = ws + off;
  p.out = (float*)d_out;
  if (off + (size_t)M_ALL * 9728 > ws_size) fprintf(stderr, "workspace too small: need %zu have %zu\n", off + (size_t)M_ALL * 9728, ws_size);
  void* args[] = {&p};
  hipError_t e = hipLaunchCooperativeKernel((void*)mega, dim3(grid_blocks), dim3(NTHR), args, 0, stream);
  if (e != hipSuccess) fprintf(stderr, "cooperative launch failed: %s (grid %d)\n", hipGetErrorString(e), grid_blocks);
}
```

```cpp
#include <hip/hip_runtime.h>
#include <hip/hip_cooperative_groups.h>
#include <cstdio>
namespace cg = cooperative_groups;

typedef unsigned short bf16_t;
typedef _Float16 hf;
typedef hf hf4 __attribute__((ext_vector_type(4)));
typedef hf hf8 __attribute__((ext_vector_type(8)));
typedef __attribute__((ext_vector_type(8))) short bf16x8;
typedef __attribute__((ext_vector_type(4))) float f32x4;
typedef unsigned int u32x4 __attribute__((ext_vector_type(4)));

#define M_LAT 32768
#define M_ALL 33792
#define NTHR 256
#define LDS_BYTES 73728
#define ALPHA 1.41421356237f

#define W_GU0 0
#define W_D0 5767168
#define W_GU1 8650752
#define W_D1 14417920
#define W_IN 17301504
#define W_WUP0 23740416
#define W_WUP1 23764992
#define W_AUP0 23789568
#define W_AUP1 23814144
#define W_GUP 23838720
#define W_GLU 23887872
#define W_UPRW 23953408
#define W_UPS5 24346624
#define W_UPML 24608768
#define W_OUT 25001984
#define W_TOTAL 26050560

struct P {
  const float* in[40];
  float* out; float* sctx; float* mod;
  bf16_t* U; bf16_t* Y; bf16_t* W; char* R; unsigned* bar;
};

__device__ __forceinline__ int get_tid() { int t = __builtin_amdgcn_workitem_id_x(); asm volatile("" : "+v"(t)); return t; }
__device__ __forceinline__ bf16_t f2bf(float f) { return __builtin_bit_cast(unsigned short, (_Float16)f); }
__device__ __forceinline__ float bf2f(bf16_t h) { return (float)__builtin_bit_cast(_Float16, h); }
__device__ __forceinline__ float sigmoidf_(float x) { return 1.f / (1.f + __expf(-x)); }
__device__ __forceinline__ float siluf_(float x) { return x / (1.f + __expf(-x)); }
__device__ __forceinline__ float* srow(const P& p, int m) { return m < M_LAT ? p.out + (size_t)m * 1024 : p.sctx + (size_t)(m - M_LAT) * 1024; }
__device__ __forceinline__ const float* modp(const P& p, int l, int m, int k) { int mv = m < M_LAT ? (m >> 13) : 4; return p.mod + (size_t)(l * 5 + mv) * 9216 + k * 1024; }
template <int C> __device__ __forceinline__ float dppf(float x) { return __int_as_float(__builtin_amdgcn_update_dpp(0, __float_as_int(x), C, 0xf, 0xf, false)); }
__device__ __forceinline__ float rowsum16(float x) { x += dppf<0x128>(x); x += dppf<0x124>(x); x += dppf<0x122>(x); x += dppf<0x121>(x); return x; }
__device__ __forceinline__ float wavesum(float x) { for (int o = 32; o > 0; o >>= 1) x += __shfl_xor(x, o); return x; }

template <int NB>
__device__ __forceinline__ void gemm_main_t(const bf16_t* __restrict__ A, int lda, const bf16_t* __restrict__ B, int ldb, int K,
                                          f32x4 (&acc)[4][NB], char* lds) {
  const int tid = get_tid(), lane = tid & 63, wid = tid >> 6, wr = wid >> 1, wc = wid & 1;
  const int fr = lane & 15, fq = lane >> 4;
  const int sr = tid >> 3, skc = tid & 7;
  const bf16_t* ga = A + (size_t)sr * lda + skc * 8;
  const bf16_t* gb = B + (size_t)sr * ldb + skc * 8;
  u32x4 ra0[4], rb0[NB], ra1[4], rb1[NB];
  const int soff = sr * 144 + skc * 16;
  const int nk = K >> 6;
  const int aoff = (wr * 64 + fr) * 144 + fq * 16;
  const int boff = 18432 + (wc * (NB * 16) + fr) * 144 + fq * 16;
#define G_LOAD(RA, RB, kt) { _Pragma("unroll") for (int i = 0; i < 4; ++i) { RA[i] = *(const u32x4*)(ga + (size_t)(i * 32) * lda + (kt) * 64); if (i < NB) RB[i] = *(const u32x4*)(gb + (size_t)(i * 32) * ldb + (kt) * 64); } }
#define G_STORE(RA, RB, buf) { char* d_ = lds + (buf) * 36864 + soff; _Pragma("unroll") for (int i = 0; i < 4; ++i) { *(u32x4*)(d_ + i * 32 * 144) = RA[i]; if (i < NB) *(u32x4*)(d_ + 18432 + i * 32 * 144) = RB[i]; } }
#define G_COMP(buf) { const char* cur = lds + (buf) * 36864; _Pragma("unroll") for (int ks = 0; ks < 2; ++ks) { hf8 af[4], bfr[NB]; \
    _Pragma("unroll") for (int m = 0; m < 4; ++m) af[m] = *(const hf8*)(cur + aoff + m * 16 * 144 + ks * 64); \
    _Pragma("unroll") for (int n = 0; n < NB; ++n) bfr[n] = *(const hf8*)(cur + boff + n * 16 * 144 + ks * 64); \
    _Pragma("unroll") for (int m = 0; m < 4; ++m) _Pragma("unroll") for (int n = 0; n < NB; ++n) acc[m][n] = __builtin_amdgcn_mfma_f32_16x16x32_f16(af[m], bfr[n], acc[m][n], 0, 0, 0); } }
  G_LOAD(ra0, rb0, 0)
  { const int k1 = nk > 1 ? 1 : 0; G_LOAD(ra1, rb1, k1) }
  G_STORE(ra0, rb0, 0)
  __syncthreads();
  for (int kt = 0; kt < nk; kt += 2) {
    { const int k2 = kt + 2 < nk ? kt + 2 : nk - 1; G_LOAD(ra0, rb0, k2) }
    G_COMP(0)
    G_STORE(ra1, rb1, 1)
    __syncthreads();
    { const int k3 = kt + 3 < nk ? kt + 3 : nk - 1; G_LOAD(ra1, rb1, k3) }
    if (kt + 1 < nk) G_COMP(1)
    G_STORE(ra0, rb0, 0)
    __syncthreads();
  }
}
__device__ __forceinline__ void gemm_main(const bf16_t* __restrict__ A, int lda, const bf16_t* __restrict__ B, int ldb, int K, f32x4 (&acc)[4][4], char* lds) {
  gemm_main_t<4>(A, lda, B, ldb, K, acc, lds);
}

__device__ __forceinline__ bool tile_map(int it, int Mt, int Nt, int SN, int& tm, int& tn) {
  const int b = blockIdx.x, xcd = b & 7, li = b >> 3, nloc = gridDim.x >> 3;
  const int T = 8 * SN; const int nsn = Nt / SN; const int nsuper = (Mt >> 3) * nsn;
  const int o = li + it * nloc; const int k = o / T, w = o - k * T;
  const int s = xcd + 8 * k;
  if (s >= nsuper) return false;
  const int sm = s / nsn, sn = s - sm * nsn;
  tm = sm * 8 + (w & 7); tn = sn * SN + (w >> 3);
  return true;
}
#define ZERO_ACC(a) _Pragma("unroll") for (int m_ = 0; m_ < 4; ++m_) _Pragma("unroll") for (int n_ = 0; n_ < 4; ++n_) a[m_][n_] = (f32x4){0.f, 0.f, 0.f, 0.f};
#define EPI_VARS const int tid = get_tid(), lane = tid & 63, wid = tid >> 6, wr = wid >> 1, wc = wid & 1, fr = lane & 15, fq = lane >> 4; (void)wr; (void)wc; (void)fr; (void)fq;
#define EPI_ROW_BEGIN(m0) _Pragma("unroll") for (int m = 0; m < 4; ++m) _Pragma("unroll") for (int j = 0; j < 4; ++j) { const int row = (m0) + wr * 64 + m * 16 + fq * 4 + j; (void)row;
#define EPI_COL_BEGIN(n0) _Pragma("unroll") for (int n = 0; n < 4; ++n) { const int col = (n0) + wc * 64 + n * 16 + fr; const float val = acc[m][n][j]; (void)col; (void)val;
#define EPI_COL_END }
#define EPI_ROW_END }
#define EPI_BEGIN(m0, n0) EPI_ROW_BEGIN(m0) EPI_COL_BEGIN(n0)
#define EPI_END } }

struct Job { const float* src; int K, N; int dst; int mode; };
__device__ __forceinline__ Job get_job(const P& p, int l, int j) {
  Job r; r.mode = 0;
  switch (j) {
    case 0: r.src = p.in[8] + (size_t)(l * 2 + 0) * 1024 * 2816; r.K = 1024; r.N = 2816; r.dst = W_GU0; r.mode = 1; break;
    case 1: r.src = p.in[9] + (size_t)(l * 2 + 0) * 1024 * 2816; r.K = 1024; r.N = 2816; r.dst = W_GU0; r.mode = 2; break;
    case 2: r.src = p.in[10] + (size_t)(l * 2 + 0) * 2816 * 1024; r.K = 2816; r.N = 1024; r.dst = W_D0; break;
    case 3: r.src = p.in[8] + (size_t)(l * 2 + 1) * 1024 * 2816; r.K = 1024; r.N = 2816; r.dst = W_GU1; r.mode = 1; break;
    case 4: r.src = p.in[9] + (size_t)(l * 2 + 1) * 1024 * 2816; r.K = 1024; r.N = 2816; r.dst = W_GU1; r.mode = 2; break;
    case 5: r.src = p.in[10] + (size_t)(l * 2 + 1) * 2816 * 1024; r.K = 2816; r.N = 1024; r.dst = W_D1; break;
    case 6: r.src = p.in[11] + (size_t)l * 1024 * 6288; r.K = 1024; r.N = 6288; r.dst = W_IN; break;
    case 7: r.src = p.in[14] + (size_t)(l * 2 + 0) * 64 * 384; r.K = 64; r.N = 384; r.dst = W_WUP0; break;
    case 8: r.src = p.in[14] + (size_t)(l * 2 + 1) * 64 * 384; r.K = 64; r.N = 384; r.dst = W_WUP1; break;
    case 9: r.src = p.in[16] + (size_t)(l * 2 + 0) * 64 * 384; r.K = 64; r.N = 384; r.dst = W_AUP0; break;
    case 10: r.src = p.in[16] + (size_t)(l * 2 + 1) * 64 * 384; r.K = 64; r.N = 384; r.dst = W_AUP1; break;
    case 11: r.src = p.in[17] + (size_t)l * 128 * 384; r.K = 128; r.N = 384; r.dst = W_GUP; break;
    case 12: r.src = p.in[31] + (size_t)l * 256 * 256; r.K = 256; r.N = 256; r.dst = W_GLU; break;
    case 13: r.src = p.in[35] + (size_t)l * 384 * 1024; r.K = 384; r.N = 1024; r.dst = W_UPRW; break;
    case 14: r.src = p.in[36] + (size_t)l * 256 * 1024; r.K = 256; r.N = 1024; r.dst = W_UPS5; break;
    case 15: r.src = p.in[37] + (size_t)l * 384 * 1024; r.K = 384; r.N = 1024; r.dst = W_UPML; break;
    default: r.src = p.in[39] + (size_t)l * 1024 * 1024; r.K = 1024; r.N = 1024; r.dst = W_OUT; break;
  }
  return r;
}
#define NJOBS 17
__device__ void mod_task(const P& p, int t, char* lds) {
  float* sc = (float*)lds;
  float* red = sc + 5 * 1024;
  const int tid = get_tid();
  for (int i = tid; i < 5 * 1024; i += NTHR) {
    int v = i >> 10, k = i & 1023;
    float c = v < 4 ? p.in[1][v * 1024 + k] : p.in[3][k];
    sc[i] = siluf_(c);
  }
  __syncthreads();
  const int c0 = t * 64; const int l = c0 / 9216; const int j0 = c0 % 9216;
  const int col = tid & 63, part = tid >> 6;
  const float* w = p.in[4] + ((size_t)l * 1024 + part * 256) * 9216 + j0 + col;
  float a0 = 0, a1 = 0, a2 = 0, a3 = 0, a4 = 0;
  const float* s = sc + part * 256;
#pragma unroll 8
  for (int i = 0; i < 256; ++i) {
    float wv = w[(size_t)i * 9216];
    a0 += s[i] * wv; a1 += s[1024 + i] * wv; a2 += s[2048 + i] * wv; a3 += s[3072 + i] * wv; a4 += s[4096 + i] * wv;
  }
  red[(part * 5 + 0) * 64 + col] = a0; red[(part * 5 + 1) * 64 + col] = a1; red[(part * 5 + 2) * 64 + col] = a2;
  red[(part * 5 + 3) * 64 + col] = a3; red[(part * 5 + 4) * 64 + col] = a4;
  __syncthreads();
  for (int i = tid; i < 320; i += NTHR) {
    int v = i >> 6, c = i & 63;
    float sum = red[(0 * 5 + v) * 64 + c] + red[(1 * 5 + v) * 64 + c] + red[(2 * 5 + v) * 64 + c] + red[(3 * 5 + v) * 64 + c];
    p.mod[(size_t)(l * 5 + v) * 9216 + j0 + c] = sum + p.in[5][(size_t)l * 9216 + j0 + c];
  }
  __syncthreads();
}
__device__ __forceinline__ void ph_convert(const P& p, int l, bool with_mod, char* lds) {
  const int tid = get_tid();
  int ntiles[NJOBS]; int total = 0;
#pragma unroll
  for (int j = 0; j < NJOBS; ++j) { Job jb = get_job(p, l, j); ntiles[j] = (jb.K >> 6) * ((jb.N + 63) >> 6); total += ntiles[j]; }
  const int nmod = with_mod ? 288 : 0;
  float* tile = (float*)lds;
  for (int t = blockIdx.x; t < total + nmod; t += gridDim.x) {
    if (t < nmod) { mod_task(p, t, lds); continue; }
    int tt = t - nmod; int j = 0;
#pragma unroll
    for (int q = 0; q < NJOBS; ++q) { if (j == q && tt >= ntiles[q]) { tt -= ntiles[q]; j = q + 1; } }
    Job jb = get_job(p, l, j);
    const int nkt = jb.K >> 6;
    const int k0 = (tt % nkt) * 64, n0 = (tt / nkt) * 64;
    {
      const int c = tid & 63, r0 = tid >> 6;
      const bool ok = (n0 + c) < jb.N;
#pragma unroll
      for (int i = 0; i < 16; ++i) { int r = r0 + i * 4; tile[r * 65 + c] = ok ? jb.src[(size_t)(k0 + r) * jb.N + n0 + c] : 0.f; }
    }
    __syncthreads();
    {
      const int nn = tid >> 2, q = tid & 3; const int n = n0 + nn;
      if (n < jb.N) {
        int drow = n;
        if (jb.mode == 1) drow = (n >> 5) * 64 + (n & 31);
        else if (jb.mode == 2) drow = (n >> 5) * 64 + 32 + (n & 31);
        bf16_t* d = p.W + jb.dst + (size_t)drow * jb.K + k0 + q * 16;
        unsigned pk[8];
#pragma unroll
        for (int i = 0; i < 8; ++i) { unsigned lo = f2bf(tile[(q * 16 + 2 * i) * 65 + nn]); unsigned hi = f2bf(tile[(q * 16 + 2 * i + 1) * 65 + nn]); pk[i] = lo | (hi << 16); }
        *(uint4*)d = make_uint4(pk[0], pk[1], pk[2], pk[3]);
        *(uint4*)(d + 8) = make_uint4(pk[4], pk[5], pk[6], pk[7]);
      }
    }
    __syncthreads();
  }
}

__device__ __forceinline__ void ph_rows(const P& p, int mode, int l, int ln_idx, int Mrows, bool writeU, int ul, int ks) {
  const int lane = get_tid() & 63, wid = get_tid() >> 6;
  const int nw = gridDim.x * 4;
  const float* g = p.in[6] + (size_t)(l * 3 + ln_idx) * 1024;
  const float* b = p.in[7] + (size_t)(l * 3 + ln_idx) * 1024;
  for (int m = blockIdx.x * 4 + wid; m < Mrows; m += nw) {
    float* s = srow(p, m);
    const float* src = s;
    if (mode == 0) src = m < M_LAT ? p.in[0] + (size_t)m * 1024 : p.in[2] + (size_t)(m - M_LAT) * 1024;
    float4 v[4];
#pragma unroll
    for (int i = 0; i < 4; ++i) v[i] = *(const float4*)(src + lane * 4 + i * 256);
    if (mode == 1) {
      float sum = 0;
#pragma unroll
      for (int i = 0; i < 4; ++i) sum += v[i].x + v[i].y + v[i].z + v[i].w;
      sum = wavesum(sum);
      const float mean = sum * (1.f / 1024.f);
      float sq = 0;
#pragma unroll
      for (int i = 0; i < 4; ++i) { v[i].x -= mean; v[i].y -= mean; v[i].z -= mean; v[i].w -= mean; sq += v[i].x * v[i].x + v[i].y * v[i].y + v[i].z * v[i].z + v[i].w * v[i].w; }
      sq = wavesum(sq);
      const float rstd = rsqrtf(sq * (1.f / 1024.f) + 1e-5f);
#pragma unroll
      for (int i = 0; i < 4; ++i) {
        float4 gg = *(const float4*)(g + lane * 4 + i * 256), bb = *(const float4*)(b + lane * 4 + i * 256);
        v[i].x = v[i].x * rstd * gg.x + bb.x; v[i].y = v[i].y * rstd * gg.y + bb.y; v[i].z = v[i].z * rstd * gg.z + bb.z; v[i].w = v[i].w * rstd * gg.w + bb.w;
      }
    }
#pragma unroll
    for (int i = 0; i < 4; ++i) *(float4*)(s + lane * 4 + i * 256) = v[i];
    if (writeU) {
      const float* sh = modp(p, ul, m, ks); const float* scl = modp(p, ul, m, ks + 1);
#pragma unroll
      for (int i = 0; i < 4; ++i) {
        float4 a = *(const float4*)(sh + lane * 4 + i * 256), c = *(const float4*)(scl + lane * 4 + i * 256);
        unsigned lo = f2bf(v[i].x * (1.f + c.x) + a.x) | ((unsigned)f2bf(v[i].y * (1.f + c.y) + a.y) << 16);
        unsigned hi = f2bf(v[i].z * (1.f + c.z) + a.z) | ((unsigned)f2bf(v[i].w * (1.f + c.w) + a.w) << 16);
        *(uint2*)(p.U + (size_t)m * 1024 + lane * 4 + i * 256) = make_uint2(lo, hi);
      }
    }
  }
}

__device__ __forceinline__ void ph_ffn_up(const P& p, int s, int Mt, char* lds) {
  EPI_VARS
  bf16_t* HM = (bf16_t*)p.R;
  const bf16_t* Wt = p.W + (s ? W_GU1 : W_GU0);
  const int ntile = Mt * 44;
  for (int it = 0;; ++it) {
    int tm, tn; if (!tile_map(it, Mt, 44, 4, tm, tn)) break; const int m0 = tm * 128, n0 = tn * 128;
    f32x4 acc[4][4]; ZERO_ACC(acc)
    gemm_main(p.U + (size_t)m0 * 1024, 1024, Wt + (size_t)n0 * 1024, 1024, 1024, acc, lds);
    const int hb = ((n0 + wc * 64) >> 6) * 32;
#pragma unroll
    for (int m = 0; m < 4; ++m)
#pragma unroll
      for (int n = 0; n < 2; ++n)
#pragma unroll
        for (int j = 0; j < 4; ++j) {
          const int row = m0 + wr * 64 + m * 16 + fq * 4 + j; const int hc = hb + n * 16 + fr;
          HM[(size_t)row * 2816 + hc] = f2bf(siluf_(acc[m][n][j]) * acc[m][n + 2][j]);
        }
  }
}
__device__ __forceinline__ void ph_ffn_down(const P& p, int l, int s, int Mt, char* lds) {
  EPI_VARS
  const bf16_t* HM = (const bf16_t*)p.R;
  const bf16_t* Wt = p.W + (s ? W_D1 : W_D0);
  const int gk = s ? 8 : 2;
  const int ntile = Mt * 8;
  for (int it = 0;; ++it) {
    int tm, tn; if (!tile_map(it, Mt, 8, 8, tm, tn)) break; const int m0 = tm * 128, n0 = tn * 128;
    f32x4 acc[4][4]; ZERO_ACC(acc)
    gemm_main(HM + (size_t)m0 * 2816, 2816, Wt + (size_t)n0 * 2816, 2816, 2816, acc, lds);
    EPI_ROW_BEGIN(m0)
      float* sp = srow(p, row) + n0 + wc * 64 + fr; const float* gp = modp(p, l, row, gk) + n0 + wc * 64 + fr;
#pragma unroll
      for (int n = 0; n < 4; ++n) sp[n * 16] = ALPHA * sp[n * 16] + 0.5f * gp[n * 16] * acc[m][n][j];
    EPI_ROW_END
  }
}

#define RW_ZRW(p) ((hf*)(p).R)
#define RW_RKV(p) (RW_ZRW(p) + (size_t)M_ALL * 1152)
#define RW_LA(p) ((bf16_t*)(RW_RKV(p) + (size_t)M_ALL * 1152))
#define RW_KK(p) ((hf*)(RW_LA(p) + (size_t)M_ALL * 256))
#define RW_KD(p) (RW_KK(p) + (size_t)M_ALL * 384)
#define RW_KA(p) (RW_KD(p) + (size_t)2 * M_ALL * 384)
#define RW_YR(p) (RW_KA(p) + (size_t)2 * M_ALL * 384)

#define S5_Z(p) ((float*)(p).R)
#define S5_YG(p) ((bf16_t*)(S5_Z(p) + (size_t)M_ALL * 256))
#define S5_E(p) ((float2*)(S5_YG(p) + (size_t)M_ALL * 256))
#define S5_X(p) (S5_E(p) + (size_t)2 * 4 * 132 * 1024)

#define ML_Z(p) ((hf*)(p).R)
#define ML_GL(p) ((float*)(ML_Z(p) + (size_t)M_ALL * 1536))
#define ML_QK(p) ((hf*)(ML_GL(p) + (size_t)M_ALL * 16))
#define ML_DC(p) ((float*)(ML_QK(p) + (size_t)M_ALL * 768))
#define ML_DN(p) (ML_DC(p) + (size_t)4224 * 9216)
#define ML_SC(p) (ML_DN(p) + (size_t)4224 * 96)
#define ML_MP(p) (ML_SC(p) + (size_t)4224 * 2)

__device__ __forceinline__ void ph_z_rw(const P& p, char* lds) {
  EPI_VARS
  hf* ZRW = RW_ZRW(p); bf16_t* LA = RW_LA(p);
  const int Mt = 264; const int ntile = Mt * 11;
  for (int it = 0;; ++it) {
    int tm, tn; if (!tile_map(it, Mt, 11, 11, tm, tn)) break; const int m0 = tm * 128;
    const int wrow = tn < 9 ? tn * 128 : 2960 + (tn - 9) * 128;
    f32x4 acc[4][4]; ZERO_ACC(acc)
    gemm_main(p.U + (size_t)m0 * 1024, 1024, p.W + W_IN + (size_t)wrow * 1024, 1024, 1024, acc, lds);
    if (tn < 9) {
      EPI_BEGIN(m0, tn * 128)
        ZRW[(size_t)row * 1152 + col] = (hf)val;
      EPI_END
    } else {
      EPI_BEGIN(m0, (tn - 9) * 128)
        float o = col < 64 ? tanhf(val) : (col < 128 ? val : sigmoidf_(val));
        LA[(size_t)row * 256 + col] = f2bf(o);
      EPI_END
    }
  }
}
__device__ __forceinline__ void ph_z_s5(const P& p, char* lds) {
  EPI_VARS
  float* Z = S5_Z(p);
  const int Mt = 264; const int ntile = Mt * 2;
  for (int it = 0;; ++it) {
    int tm, tn; if (!tile_map(it, Mt, 2, 2, tm, tn)) break; const int m0 = tm * 128;
    f32x4 acc[4][4]; ZERO_ACC(acc)
    gemm_main(p.U + (size_t)m0 * 1024, 1024, p.W + W_IN + (size_t)(2704 + tn * 128) * 1024, 1024, 1024, acc, lds);
    EPI_BEGIN(m0, tn * 128)
      Z[(size_t)row * 256 + col] = val;
    EPI_END
  }
}
__device__ __forceinline__ void ph_z_ml(const P& p, char* lds) {
  EPI_VARS
  hf* Z = ML_Z(p); float* GL = ML_GL(p);
  const int Mt = 264; const int ntile = Mt * 13;
  for (int it = 0;; ++it) {
    int tm, tn; if (!tile_map(it, Mt, 13, 13, tm, tn)) break; const int m0 = tm * 128;
    f32x4 acc[4][4]; ZERO_ACC(acc)
    gemm_main(p.U + (size_t)m0 * 1024, 1024, p.W + W_IN + (size_t)(1152 + tn * 128) * 1024, 1024, 1024, acc, lds);
    if (tn < 12) {
      EPI_BEGIN(m0, tn * 128)
        Z[(size_t)row * 1536 + col] = (hf)val;
      EPI_END
    } else {
      EPI_BEGIN(m0, 0)
        if (col < 16) GL[(size_t)row * 16 + col] = val;
      EPI_END
    }
  }
}

__device__ __forceinline__ void ph_conv(const P& p, int l, int which) {
  const int nch = which == 0 ? 144 : 96;
  const int ldin = which == 0 ? 1152 : 1536;
  const hf* Zin = which == 0 ? RW_ZRW(p) : ML_Z(p);
  const int cbase = which == 0 ? 0 : 1152;
  const float* cw = p.in[12] + (size_t)l * 9 * 1920;
  const size_t total = (size_t)M_ALL * nch;
  for (size_t idx = (size_t)blockIdx.x * NTHR + get_tid(); idx < (total + 63) / 64 * 64; idx += (size_t)gridDim.x * NTHR) {
    const bool act = idx < total;
    const int m = act ? (int)(idx / nch) : 0; const int ch = act ? (int)(idx % nch) : 0; const int c0 = ch * 8;
    float o[8];
#pragma unroll
    for (int i = 0; i < 8; ++i) o[i] = 0.f;
    if (m < M_LAT) {
      const int bb = m >> 13, tt = m & 8191, gr = tt >> 6, gc = tt & 63;
#pragma unroll
      for (int dr = -1; dr <= 1; ++dr)
#pragma unroll
        for (int dc = -1; dc <= 1; ++dc) {
          const int rr = gr + dr, cc = gc + dc;
          if (rr >= 0 && rr < 128 && cc >= 0 && cc < 64) {
            const int mm = (bb << 13) + rr * 64 + cc;
            hf8 z = *(const hf8*)(Zin + (size_t)mm * ldin + c0);
            const float* w = cw + ((dr + 1) * 3 + (dc + 1)) * 1920 + cbase + c0;
            float4 w0 = *(const float4*)w, w1 = *(const float4*)(w + 4);
            o[0] += (float)z[0] * w0.x; o[1] += (float)z[1] * w0.y; o[2] += (float)z[2] * w0.z; o[3] += (float)z[3] * w0.w;
            o[4] += (float)z[4] * w1.x; o[5] += (float)z[5] * w1.y; o[6] += (float)z[6] * w1.z; o[7] += (float)z[7] * w1.w;
          }
        }
    } else {
      const int tt = (m - M_LAT) & 255;
#pragma unroll
      for (int dc = -1; dc <= 1; ++dc) {
        const int t2 = tt + dc;
        if (t2 >= 0 && t2 < 256) {
          hf8 z = *(const hf8*)(Zin + (size_t)(m + dc) * ldin + c0);
          const float* w = cw + (3 + (dc + 1)) * 1920 + cbase + c0;
          float4 w0 = *(const float4*)w, w1 = *(const float4*)(w + 4);
          o[0] += (float)z[0] * w0.x; o[1] += (float)z[1] * w0.y; o[2] += (float)z[2] * w0.z; o[3] += (float)z[3] * w0.w;
          o[4] += (float)z[4] * w1.x; o[5] += (float)z[5] * w1.y; o[6] += (float)z[6] * w1.z; o[7] += (float)z[7] * w1.w;
        }
      }
    }
    if (which == 0) {
      const bool isk = act && (c0 >= 384) && (c0 < 768);
      float kkv[8]; float ss = 0.f;
      if (isk) {
        const float* kkw = p.in[18] + (size_t)l * 384 + (c0 - 384);
#pragma unroll
        for (int i = 0; i < 8; ++i) { kkv[i] = o[i] * kkw[i]; ss += kkv[i] * kkv[i]; }
      } else {
#pragma unroll
        for (int i = 0; i < 8; ++i) kkv[i] = 0.f;
      }
      ss += __shfl_xor(ss, 1); ss += __shfl_xor(ss, 2); ss += __shfl_xor(ss, 4);
      if (act) {
        hf8 ov;
#pragma unroll
        for (int i = 0; i < 8; ++i) ov[i] = (hf)o[i];
        *(hf8*)(RW_RKV(p) + (size_t)m * 1152 + c0) = ov;
        if (isk) {
          const float rn = rsqrtf(fmaxf(ss, 1e-24f));
          hf8 kv;
#pragma unroll
          for (int i = 0; i < 8; ++i) kv[i] = (hf)(kkv[i] * rn);
          *(hf8*)(RW_KK(p) + (size_t)m * 384 + (c0 - 384)) = kv;
        }
      }
    } else if (act) {
      const float sc = c0 >= 384 ? 0.10206207261596575f : 1.f;
      hf8 ov;
#pragma unroll
      for (int i = 0; i < 8; ++i) ov[i] = (hf)(siluf_(o[i]) * sc);
      *(hf8*)(ML_QK(p) + (size_t)m * 768 + c0) = ov;
    }
  }
}

__device__ __forceinline__ void ph_lora(const P& p, int l, char* lds) {
  EPI_VARS
  hf* ZRW = RW_ZRW(p); const hf* RKV = RW_RKV(p); const bf16_t* LA = RW_LA(p); const hf* KK = RW_KK(p);
  hf* KD = RW_KD(p); hf* KA = RW_KA(p);
  const int Mt = 264; const int ntile = Mt * 15;
  for (int it = 0;; ++it) {
    int tm, q; if (!tile_map(it, Mt, 15, 15, tm, q)) break; const int job = q / 3, tn = q % 3; const int m0 = tm * 128, n0 = tn * 128;
    f32x4 acc[4][4]; ZERO_ACC(acc)
    if (job < 2) {
      const int d = job;
      gemm_main(LA + (size_t)m0 * 256, 256, p.W + (d ? W_WUP1 : W_WUP0) + (size_t)n0 * 64, 64, 64, acc, lds);
      const float* w0 = p.in[13] + (size_t)(l * 2 + d) * 384;
      EPI_BEGIN(m0, n0)
        const float e = sigmoidf_(w0[col] + val) * 0.6065306597126334f;
        ZRW[(size_t)row * 1152 + d * 384 + col] = (hf)(-expm1f(-e));
      EPI_END
    } else if (job < 4) {
      const int d = job - 2;
      gemm_main(LA + (size_t)m0 * 256 + 64, 256, p.W + (d ? W_AUP1 : W_AUP0) + (size_t)n0 * 64, 64, 64, acc, lds);
      const float* a0 = p.in[15] + (size_t)(l * 2 + d) * 384; const float* kaw = p.in[19] + (size_t)l * 384;
      EPI_ROW_BEGIN(m0)
        const int cb = n0 + wc * 64 + fr;
        const hf* kp = RKV + (size_t)row * 1152 + 384 + cb; const hf* kkp = KK + (size_t)row * 384 + cb;
        hf* kdp = KD + ((size_t)d * M_ALL + row) * 384 + cb; hf* kap = KA + ((size_t)d * M_ALL + row) * 384 + cb;
#pragma unroll
        for (int n = 0; n < 4; ++n) {
          const float a = sigmoidf_(a0[cb + n * 16] + acc[m][n][j]);
          kdp[n * 16] = (hf)((float)kp[n * 16] * (1.f + (a - 1.f) * kaw[cb + n * 16]));
          kap[n * 16] = (hf)((float)kkp[n * 16] * a);
        }
      EPI_ROW_END
    } else {
      gemm_main(LA + (size_t)m0 * 256 + 128, 256, p.W + W_GUP + (size_t)n0 * 128, 128, 128, acc, lds);
      EPI_BEGIN(m0, n0)
        ZRW[(size_t)row * 1152 + 768 + col] = (hf)val;
      EPI_END
    }
  }
}

typedef float f32x2 __attribute__((ext_vector_type(2)));
#define RW_CH 16
#define RW_BUF 21504
__device__ __forceinline__ void rw_cvt_store(char* dst, uint4 q) {
  const hf8 h = __builtin_bit_cast(hf8, q);
  f32x4 a, b;
  a[0] = (float)h[0]; a[1] = (float)h[1]; a[2] = (float)h[2]; a[3] = (float)h[3];
  b[0] = (float)h[4]; b[1] = (float)h[5]; b[2] = (float)h[6]; b[3] = (float)h[7];
  *(f32x4*)dst = a; *(f32x4*)(dst + 16) = b;
}
__device__ __forceinline__ void ph_rwscan(const P& p, char* lds) {
  const hf* ZRW = RW_ZRW(p); hf* RKV = RW_RKV(p); const hf* KK = RW_KK(p);
  const int tid = get_tid(), lane = tid & 63, wid = tid >> 6;
  char* pbuf = lds + 3 * RW_BUF + wid * 2048;
  char* ybuf = lds + 3 * RW_BUF + 8192;
  for (int t = blockIdx.x; t < 192; t += gridDim.x) {
    const int rqq = t & 3, h = (t >> 2) % 6, b = (t / 24) & 3, d = t / 96;
    const int rsub = lane >> 4, g = lane & 15; const int rl = wid * 4 + rsub;
    const int sgn = d ? -1 : 1;
    const bool grpA = tid < 128; const int t2 = tid & 127;
    const int sstep = t2 >> 3, sseg = t2 & 7;
    const hf* g0 = grpA ? (RKV + h * 64 + sseg * 8) : (RW_KD(p) + (size_t)d * M_ALL * 384 + h * 64 + sseg * 8);
    const size_t ld0 = grpA ? 1152 : 384;
    const hf* g1 = grpA ? (KK + h * 64 + sseg * 8) : (RW_KA(p) + (size_t)d * M_ALL * 384 + h * 64 + sseg * 8);
    const hf* g2 = grpA ? (ZRW + d * 384 + h * 64 + sseg * 8) : (RKV + 768 + h * 64 + rqq * 16 + (t2 & 1) * 8);
    const int s2 = grpA ? sstep : (t2 >> 1);
    const bool has2 = grpA || t2 < 32;
    const int o0 = (grpA ? 0 : 12288) + sstep * 256 + sseg * 32;
    const int o1 = (grpA ? 4096 : 16384) + sstep * 256 + sseg * 32;
    const int o2 = grpA ? (8192 + sstep * 256 + sseg * 32) : (20480 + (t2 >> 1) * 64 + (t2 & 1) * 32);
    hf* g_y = d == 0 ? (RKV + 384 + h * 64 + rqq * 16 + (tid & 1) * 8) : (RW_YR(p) + h * 64 + rqq * 16 + (tid & 1) * 8);
    const int ldy = d == 0 ? 1152 : 384;
    uint4 q0, q1, q2;
#define RW_M0(pp) ((pp) < 256 ? (M_LAT + b * 256 + (d ? 255 - (pp) : (pp))) : (b * 8192 + (d ? 8447 - (pp) : (pp) - 256)))
#define RW_GLOAD(c) { const int mb_ = RW_M0((c) * RW_CH); const size_t mm = (size_t)(mb_ + sgn * sstep); \
      q0 = *(const uint4*)(g0 + mm * ld0); q1 = *(const uint4*)(g1 + mm * 384); \
      if (has2) { const size_t m2 = (size_t)(mb_ + sgn * s2); q2 = *(const uint4*)(g2 + m2 * 1152); } }
#define RW_SSTORE(c) { char* bb_ = lds + ((c) % 3) * RW_BUF; rw_cvt_store(bb_ + o0, q0); rw_cvt_store(bb_ + o1, q1); if (has2) rw_cvt_store(bb_ + o2, q2); }
    f32x2 S01 = (f32x2){0.f, 0.f}, S23 = (f32x2){0.f, 0.f};
    RW_GLOAD(0) RW_SSTORE(0)
    RW_GLOAD(1) RW_SSTORE(1)
    __syncthreads();
    const int NCH = 8448 / RW_CH;
    for (int c = 0; c < NCH; ++c) {
      if (c + 2 < NCH) RW_GLOAD(c + 2)
      if (c > 0 && tid < 32) {
        const int mb_ = RW_M0((c - 1) * RW_CH); const size_t mv = (size_t)(mb_ + sgn * (tid >> 1));
        *(uint4*)(g_y + mv * ldy) = *(const uint4*)(ybuf + ((c - 1) & 1) * 512 + tid * 16);
      }
      const char* cb = lds + (c % 3) * RW_BUF + g * 16;
      const char* vb = lds + (c % 3) * RW_BUF + 20480 + rl * 4;
      f32x4 R4[RW_CH], K4[RW_CH], D4[RW_CH], KD4[RW_CH], KA4[RW_CH]; float VV[RW_CH];
#define RW_LDS(s_) { R4[s_] = *(const f32x4*)(cb + (s_) * 256); K4[s_] = *(const f32x4*)(cb + 4096 + (s_) * 256); D4[s_] = *(const f32x4*)(cb + 8192 + (s_) * 256); \
        KD4[s_] = *(const f32x4*)(cb + 12288 + (s_) * 256); KA4[s_] = *(const f32x4*)(cb + 16384 + (s_) * 256); VV[s_] = *(const float*)(vb + (s_) * 64); }
      RW_LDS(0) RW_LDS(1) RW_LDS(2)
#pragma unroll
      for (int s = 0; s < RW_CH; ++s) {
        if (s + 3 < RW_CH) RW_LDS(s + 3)
        const f32x4 r4 = R4[s], k4 = K4[s], d4 = D4[s], kd4 = KD4[s], ka4 = KA4[s]; const float vv = VV[s];
        const f32x2 k01 = {k4[0], k4[1]}, k23 = {k4[2], k4[3]}, d01 = {d4[0], d4[1]}, d23 = {d4[2], d4[3]};
        const f32x2 kd01 = {kd4[0], kd4[1]}, kd23 = {kd4[2], kd4[3]}, ka01 = {ka4[0], ka4[1]}, ka23 = {ka4[2], ka4[3]};
        const f32x2 r01 = {r4[0], r4[1]}, r23 = {r4[2], r4[3]};
        const f32x2 sa2 = __builtin_elementwise_fma(S23, k23, S01 * k01);
        float sa = sa2[0] + sa2[1];
        sa = rowsum16(sa);
        const f32x2 vv2 = {vv, vv}; const f32x2 nsa = {-sa, -sa};
        f32x2 T01 = __builtin_elementwise_fma(-S01, d01, S01), T23 = __builtin_elementwise_fma(-S23, d23, S23);
        T01 = __builtin_elementwise_fma(vv2, kd01, T01); T23 = __builtin_elementwise_fma(vv2, kd23, T23);
        S01 = __builtin_elementwise_fma(nsa, ka01, T01); S23 = __builtin_elementwise_fma(nsa, ka23, T23);
        const f32x2 y2 = __builtin_elementwise_fma(S23, r23, S01 * r01);
        *(float*)(pbuf + (((s & 7) * 4 + rsub) * 16 + g) * 4) = y2[0] + y2[1];
        if ((s & 7) == 7) {
          if (lane < 32) {
            const char* pr = pbuf + lane * 64;
            const f32x4 a0 = *(const f32x4*)(pr), a1 = *(const f32x4*)(pr + 16), a2 = *(const f32x4*)(pr + 32), a3 = *(const f32x4*)(pr + 48);
            const f32x4 sm = (a0 + a1) + (a2 + a3);
            const float y = (sm[0] + sm[1]) + (sm[2] + sm[3]);
            *(hf*)(ybuf + (c & 1) * 512 + (((s >> 3) * 8 + (lane >> 2)) * 16 + wid * 4 + (lane & 3)) * 2) = (hf)y;
          }
        }
      }
      if (c + 2 < NCH) RW_SSTORE(c + 2)
      __syncthreads();
    }
    if (tid < 32) {
      const int mb_ = RW_M0((NCH - 1) * RW_CH); const size_t mv = (size_t)(mb_ + sgn * (tid >> 1));
      *(uint4*)(g_y + mv * ldy) = *(const uint4*)(ybuf + ((NCH - 1) & 1) * 512 + tid * 16);
    }
    __syncthreads();
  }
}

__device__ __forceinline__ void ph_rwpost(const P& p, int l) {
  const hf* ZRW = RW_ZRW(p); const hf* RKV = RW_RKV(p); const hf* YR = RW_YR(p);
  const int lane = get_tid() & 63, wid = get_tid() >> 6;
  const int nw = gridDim.x * 4;
  for (int t = blockIdx.x * 4 + wid; t < M_ALL * 6; t += nw) {
    const int m = t / 6, h = t % 6; const int c = h * 64 + lane;
    const float ys = (float)RKV[(size_t)m * 1152 + 384 + c] + (float)YR[(size_t)m * 384 + c];
    const float mean = wavesum(ys) * (1.f / 64.f);
    const float xc = ys - mean;
    const float var = wavesum(xc * xc) * (1.f / 64.f);
    float y = xc * rsqrtf(var + 64e-5f) * p.in[21][(size_t)l * 384 + c] + p.in[22][(size_t)l * 384 + c];
    const float r = (float)RKV[(size_t)m * 1152 + c], v = (float)RKV[(size_t)m * 1152 + 768 + c];
    const float rk = p.in[20][(size_t)l * 384 + c];
    const float kd0 = (float)RW_KD(p)[(size_t)m * 384 + c], kd1 = (float)RW_KD(p)[((size_t)M_ALL + m) * 384 + c];
    const float bs = wavesum(r * (kd0 + kd1) * rk);
    y = (y + bs * v) * (float)ZRW[(size_t)m * 1152 + 768 + c];
    p.Y[(size_t)m * 1024 + c] = f2bf(y);
  }
}

struct S5C { float ar, ai; float br[16], bi[16]; };
__device__ __forceinline__ void s5_consts(const P& p, int l, int d, int g, int n, S5C& c) {
  const int ig = (l * 2 + d) * 16 + g;
  const float lr = fminf(p.in[23][(size_t)ig * 64 + n], -1e-4f), li = p.in[24][(size_t)ig * 64 + n];
  const float dt = expf(p.in[25][ig]);
  const float mag = expf(lr * dt);
  c.ar = mag * cosf(li * dt); c.ai = mag * sinf(li * dt);
  const float nr = c.ar - 1.f, ni = c.ai; const float den = 1.f / (lr * lr + li * li);
  const float cr = (nr * lr + ni * li) * den, ci = (ni * lr - nr * li) * den;
  const float* bre = p.in[26] + ((size_t)ig * 64 + n) * 16; const float* bim = p.in[27] + ((size_t)ig * 64 + n) * 16;
#pragma unroll
  for (int h = 0; h < 16; ++h) { const float xr = bre[h], xi = bim[h]; c.br[h] = cr * xr - ci * xi; c.bi[h] = cr * xi + ci * xr; }
}
__device__ __forceinline__ int s5_m0(int b, int tc) { return tc < 128 ? b * 8192 + tc * 64 : M_LAT + b * 256 + (tc - 128) * 64; }
__device__ __forceinline__ int chain_pos(int d, int tc) { return d == 0 ? (tc < 128 ? tc + 4 : tc - 128) : (tc < 128 ? 131 - tc : 131 - tc); }
__device__ __forceinline__ void ph_s5_pass(const P& p, int l, int pass, char* lds) {
  const int tid = get_tid(), lane = tid & 63, wid = tid >> 6, fr = lane & 15, fq = lane >> 4;
  float* ub = (float*)(lds + wid * 8448);
  char* xs = lds + wid * 8448 + 4096;
  const float* Z = S5_Z(p); float2* E = S5_E(p); const float2* X = S5_X(p); bf16_t* YG = S5_YG(p);
  const int nw = gridDim.x * 4;
  for (int t = blockIdx.x * 4 + wid; t < 4 * 132 * 16; t += nw) {
    const int g = t & 15, tc = (t >> 4) % 132, b = t / (16 * 132);
    const int m0 = s5_m0(b, tc);
#pragma unroll
    for (int i = 0; i < 4; ++i) { const int e = lane + i * 64; const int tok = e >> 2, q = e & 3;
      *(float4*)(ub + tok * 16 + q * 4) = *(const float4*)(Z + (size_t)(m0 + tok) * 256 + g * 16 + q * 4); }
    f32x4 yacc[4];
#pragma unroll
    for (int i = 0; i < 4; ++i) yacc[i] = (f32x4){0.f, 0.f, 0.f, 0.f};
    for (int d = 0; d < 2; ++d) {
      S5C c; s5_consts(p, l, d, g, lane, c);
      const int cp = chain_pos(d, tc);
      const size_t sidx = (((size_t)(d * 4 + b) * 132 + cp) * 16 + g) * 64 + lane;
      float xr = 0.f, xi = 0.f;
      hf8 cf[4];
      if (pass == 3) {
        float2 x0 = X[sidx]; xr = x0.x; xi = x0.y;
        const int ig = (l * 2 + d) * 16 + g;
#pragma unroll
        for (int ks = 0; ks < 4; ++ks) {
          const int c0 = ks * 32 + fq * 8;
          const float* src_ = (c0 < 64 ? p.in[28] : p.in[29]) + ((size_t)ig * 16 + fr) * 64 + (c0 & 63);
          const float sg = c0 < 64 ? 1.f : -1.f;
          const float4 v0 = *(const float4*)src_, v1 = *(const float4*)(src_ + 4);
          cf[ks][0] = (hf)(sg * v0.x); cf[ks][1] = (hf)(sg * v0.y); cf[ks][2] = (hf)(sg * v0.z); cf[ks][3] = (hf)(sg * v0.w);
          cf[ks][4] = (hf)(sg * v1.x); cf[ks][5] = (hf)(sg * v1.y); cf[ks][6] = (hf)(sg * v1.z); cf[ks][7] = (hf)(sg * v1.w);
        }
      }
#pragma unroll 1
      for (int jb = 0; jb < 4; ++jb) {
        const int tb = d ? 3 - jb : jb;
#pragma unroll 4
        for (int jj = 0; jj < 16; ++jj) {
          const int t16 = d ? 15 - jj : jj;
          const float* u = ub + (tb * 16 + t16) * 16;
          float br = 0.f, bi = 0.f;
#pragma unroll
          for (int h = 0; h < 16; ++h) { const float uv = u[h]; br += c.br[h] * uv; bi += c.bi[h] * uv; }
          const float nr = c.ar * xr - c.ai * xi + br, ni = c.ar * xi + c.ai * xr + bi;
          xr = nr; xi = ni;
          if (pass == 3) { *(hf*)(xs + t16 * 272 + lane * 2) = (hf)xr; *(hf*)(xs + t16 * 272 + 128 + lane * 2) = (hf)xi; }
        }
        if (pass == 3) {
          f32x4 acc = (f32x4){0.f, 0.f, 0.f, 0.f};
#pragma unroll
          for (int ks = 0; ks < 4; ++ks) {
            const hf8 af = *(const hf8*)(xs + fr * 272 + ks * 64 + fq * 16);
            acc = __builtin_amdgcn_mfma_f32_16x16x32_f16(af, cf[ks], acc, 0, 0, 0);
          }
#pragma unroll
          for (int i = 0; i < 4; ++i) if (i == tb) yacc[i] += acc;
        }
      }
      if (pass == 1) E[sidx] = make_float2(xr, xi);
    }
    if (pass == 3) {
      const float dsk = p.in[30][(size_t)l * 256 + g * 16 + fr];
#pragma unroll
      for (int i = 0; i < 4; ++i)
#pragma unroll
        for (int j = 0; j < 4; ++j) {
          const int tok = i * 16 + fq * 4 + j;
          float y = yacc[i][j] + dsk * ub[tok * 16 + fr];
          const float inner = 0.7978845608028654f * (y + 0.044715f * y * y * y);
          y = 0.5f * y * (1.f + tanhf(inner));
          YG[(size_t)(m0 + tok) * 256 + g * 16 + fr] = f2bf(y);
        }
    }
  }
}
__device__ __forceinline__ void ph_s5_carry(const P& p, int l) {
  const float2* E = S5_E(p); float2* X = S5_X(p);
  for (int t = blockIdx.x * NTHR + get_tid(); t < 8192; t += gridDim.x * NTHR) {
    const int n = t & 63, g = (t >> 6) & 15, b = (t >> 10) & 3, d = t >> 12;
    const int ig = (l * 2 + d) * 16 + g;
    const float lr = fminf(p.in[23][(size_t)ig * 64 + n], -1e-4f), li = p.in[24][(size_t)ig * 64 + n];
    const float dt = expf(p.in[25][ig]);
    const float mag = expf(lr * dt * 64.f);
    float ar = expf(lr * dt) * cosf(li * dt), ai = expf(lr * dt) * sinf(li * dt);
#pragma unroll
    for (int i = 0; i < 6; ++i) { const float r2 = ar * ar - ai * ai, i2 = 2.f * ar * ai; ar = r2; ai = i2; }
    (void)mag;
    float xr = 0.f, xi = 0.f;
    const size_t base = (((size_t)(d * 4 + b) * 132) * 16 + g) * 64 + n;
    for (int cp0 = 0; cp0 < 132; cp0 += 12) {
      float2 ev[12];
#pragma unroll
      for (int u = 0; u < 12; ++u) ev[u] = E[base + (size_t)(cp0 + u) * 1024];
#pragma unroll
      for (int u = 0; u < 12; ++u) {
        X[base + (size_t)(cp0 + u) * 1024] = make_float2(xr, xi);
        const float nr = ar * xr - ai * xi + ev[u].x, ni = ar * xi + ai * xr + ev[u].y;
        xr = nr; xi = ni;
      }
    }
  }
}
__device__ __forceinline__ void ph_glu(const P& p, int l, char* lds) {
  EPI_VARS
  const bf16_t* YG = S5_YG(p);
  const int Mt = 264; const int ntile = Mt * 2;
  const float* gb = p.in[32] + (size_t)l * 256;
  for (int it = 0;; ++it) {
    int tm, tn; if (!tile_map(it, Mt, 2, 2, tm, tn)) break; const int m0 = tm * 128, n0 = tn * 128;
    f32x4 acc[4][4]; ZERO_ACC(acc)
    gemm_main(YG + (size_t)m0 * 256, 256, p.W + W_GLU + (size_t)n0 * 256, 256, 256, acc, lds);
    EPI_BEGIN(m0, n0)
      const float y = bf2f(YG[(size_t)row * 256 + col]);
      p.Y[(size_t)row * 1024 + 384 + col] = f2bf(y * sigmoidf_(val + gb[col]));
    EPI_END
  }
}

__device__ __forceinline__ float logsigf_(float x) { return fminf(x, 0.f) - log1pf(__expf(-fabsf(x))); }
__device__ __forceinline__ void ml_gates(const P& p, int l, int d, int h, int m0, int lane, float& bcum, float& ic) {
  const int tok = d ? 63 - lane : lane;
  const float* gl = ML_GL(p) + (size_t)(m0 + tok) * 16;
  const float* gb = p.in[33] + (size_t)(l * 2 + d) * 8;
  ic = gl[d * 8 + h] + gb[h];
  float f = logsigf_(gl[d * 8 + 4 + h] + gb[4 + h]);
#pragma unroll
  for (int o = 1; o < 64; o <<= 1) { float v = __shfl_up(f, o); if (lane >= o) f += v; }
  bcum = f;
}
__device__ __forceinline__ void ml_gates2(const P& p, int l, int d, int h, int m0, int lane, float& bc, float& ic, float& tot) {
  const float* gl = ML_GL(p) + (size_t)(m0 + lane) * 16;
  const float* gb = p.in[33] + (size_t)(l * 2 + d) * 8;
  ic = gl[d * 8 + h] + gb[h];
  const float f0 = logsigf_(gl[d * 8 + 4 + h] + gb[4 + h]);
  float f = f0;
#pragma unroll
  for (int o = 1; o < 64; o <<= 1) { float v = __shfl_up(f, o); if (lane >= o) f += v; }
  tot = __shfl(f, 63);
  bc = d ? (tot - f + f0) : f;
}
#define MLQ 208
#define MLS 144
__device__ __forceinline__ void ph_ml_a(const P& p, int l, char* lds) {
  char* vt = lds; char* kt = lds + 13824; float* wg = (float*)(lds + 27648);
  const int tid = get_tid(), lane = tid & 63, wid = tid >> 6, fr = lane & 15, fq = lane >> 4;
  const hf* QK = ML_QK(p); const hf* Z = ML_Z(p);
  for (int t = blockIdx.x; t < 4224; t += gridDim.x) {
    const int tc = t % 132, h = (t / 132) & 3, b = (t / 528) & 3, d = t / 2112;
    const int m0 = s5_m0(b, tc); const int cp = chain_pos(d, tc);
    const size_t task = ((size_t)((d * 4 + b) * 4 + h)) * 132 + cp;
    if (wid == 0) {
      float bc, ic, tot; ml_gates2(p, l, d, h, m0, lane, bc, ic, tot);
      const float lw = tot - bc + ic;
      float mx = lw;
      for (int o = 32; o > 0; o >>= 1) mx = fmaxf(mx, __shfl_xor(mx, o));
      wg[lane] = __expf(lw - mx);
      if (lane == 0) { ML_SC(p)[task * 2] = mx; ML_SC(p)[task * 2 + 1] = tot; }
    }
    __syncthreads();
    for (int e = tid; e < 64 * 12; e += NTHR) {
      const int tok = e & 63, q = e >> 6;
      const hf8 kv = *(const hf8*)(QK + (size_t)(m0 + tok) * 768 + 384 + h * 96 + q * 8);
      const hf8 vv = *(const hf8*)(Z + (size_t)(m0 + tok) * 1536 + 768 + h * 96 + q * 8);
      const float w = wg[tok];
#pragma unroll
      for (int i = 0; i < 8; ++i) {
        *(hf*)(kt + (q * 8 + i) * MLS + tok * 2) = kv[i];
        *(hf*)(vt + (q * 8 + i) * MLS + tok * 2) = (hf)((float)vv[i] * w);
      }
    }
    __syncthreads();
    float* dc = ML_DC(p) + task * 9216;
#pragma unroll 1
    for (int bi = 0; bi < 9; ++bi) {
      const int idx = wid * 9 + bi; const int mb = idx / 6, nb = idx % 6;
      f32x4 acc = (f32x4){0.f, 0.f, 0.f, 0.f};
#pragma unroll
      for (int ks = 0; ks < 2; ++ks) {
        const hf8 af = *(const hf8*)(vt + (mb * 16 + fr) * MLS + ks * 64 + fq * 16);
        const hf8 bf = *(const hf8*)(kt + (nb * 16 + fr) * MLS + ks * 64 + fq * 16);
        acc = __builtin_amdgcn_mfma_f32_16x16x32_f16(af, bf, acc, 0, 0, 0);
      }
#pragma unroll
      for (int j = 0; j < 4; ++j) dc[(mb * 16 + fq * 4 + j) * 96 + nb * 16 + fr] = acc[j];
    }
    if (tid < 96) {
      float s = 0.f;
      for (int j = 0; j < 64; ++j) s += wg[j] * (float)*(const hf*)(kt + tid * MLS + j * 2);
      ML_DN(p)[task * 96 + tid] = s;
    }
    __syncthreads();
  }
}
__device__ __forceinline__ void ph_ml_b(const P& p) {
  float* DC = ML_DC(p); float* DN = ML_DN(p); const float* SC = ML_SC(p); float* MP = ML_MP(p);
  for (int t = blockIdx.x * NTHR + get_tid(); t < 32 * 9312; t += gridDim.x * NTHR) {
    const int chain = t / 9312, e = t % 9312;
    float cur = 0.f, mprev = 0.f;
    for (int cp0 = 0; cp0 < 132; cp0 += 12) {
      float dl[12], ml_[12], bl_[12];
#pragma unroll
      for (int u = 0; u < 12; ++u) {
        const size_t task = (size_t)chain * 132 + cp0 + u;
        dl[u] = e < 9216 ? DC[task * 9216 + e] : DN[task * 96 + (e - 9216)];
        ml_[u] = SC[task * 2]; bl_[u] = SC[task * 2 + 1];
      }
#pragma unroll
      for (int u = 0; u < 12; ++u) {
        const size_t task = (size_t)chain * 132 + cp0 + u;
        float* slot = e < 9216 ? DC + task * 9216 + e : DN + task * 96 + (e - 9216);
        *slot = cur;
        if (e == 0) MP[task] = mprev;
        const float mnew = fmaxf(bl_[u] + mprev, ml_[u]);
        cur = __expf(bl_[u] + mprev - mnew) * cur + __expf(ml_[u] - mnew) * dl[u];
        mprev = mnew;
      }
    }
  }
}
__device__ __forceinline__ void ph_ml_c(const P& p, int l, char* lds) {
  char* qs = lds; char* ks = lds + 13312; char* vt = lds + 26624; char* cs = lds + 40448; char* ps = lds + 60416;
  float* fl = (float*)(lds + 69632);
  float* bc = fl; float* icv = fl + 128; float* mr = fl + 256; float* inter = fl + 320; float* den = fl + 384; float* nq = fl + 448; float* nst = fl + 512;
  const int tid = get_tid(), lane = tid & 63, wid = tid >> 6, fr = lane & 15, fq = lane >> 4;
  const hf* QK = ML_QK(p); const hf* Z = ML_Z(p);
  for (int t = blockIdx.x; t < 2112; t += gridDim.x) {
    const int tc = t % 132, h = (t / 132) & 3, b = t / 528;
    const int m0 = s5_m0(b, tc);
    for (int e = tid; e < 64 * 12; e += NTHR) {
      const int tok = e & 63, q = e >> 6;
      *(hf8*)(qs + tok * MLQ + q * 16) = *(const hf8*)(QK + (size_t)(m0 + tok) * 768 + h * 96 + q * 8);
      *(hf8*)(ks + tok * MLQ + q * 16) = *(const hf8*)(QK + (size_t)(m0 + tok) * 768 + 384 + h * 96 + q * 8);
      const hf8 vv = *(const hf8*)(Z + (size_t)(m0 + tok) * 1536 + 768 + h * 96 + q * 8);
#pragma unroll
      for (int i = 0; i < 8; ++i) *(hf*)(vt + (q * 8 + i) * MLS + tok * 2) = vv[i];
    }
    if (wid < 2) { float bcv, ic, tot; ml_gates2(p, l, wid, h, m0, lane, bcv, ic, tot); bc[wid * 64 + lane] = bcv; icv[wid * 64 + lane] = ic; }
    f32x4 hs[6];
#pragma unroll
    for (int n = 0; n < 6; ++n) hs[n] = (f32x4){0.f, 0.f, 0.f, 0.f};
    for (int d = 0; d < 2; ++d) {
      const int cp = chain_pos(d, tc);
      const size_t task = ((size_t)((d * 4 + b) * 4 + h)) * 132 + cp;
      const float mprev = ML_MP(p)[task];
      __syncthreads();
      {
        const float* cg = ML_DC(p) + task * 9216;
        for (int e = tid; e < 96 * 24; e += NTHR) {
          const int v = e / 24, q = e % 24;
          const float4 c4 = *(const float4*)(cg + v * 96 + q * 4);
          hf4 o; o[0] = (hf)c4.x; o[1] = (hf)c4.y; o[2] = (hf)c4.z; o[3] = (hf)c4.w;
          *(hf4*)(cs + v * MLQ + q * 8) = o;
        }
        if (tid < 96) nst[tid] = ML_DN(p)[task * 96 + tid];
      }
      const float* bcd = bc + d * 64; const float* icd = icv + d * 64;
      if (tid < 64) {
        const int j = tid; const float bj = bcd[j];
        float mx = bj + mprev;
        if (d == 0) { for (int s = 0; s <= j; ++s) mx = fmaxf(mx, bj - bcd[s] + icd[s]); }
        else { for (int s = j; s < 64; ++s) mx = fmaxf(mx, bj - bcd[s] + icd[s]); }
        mr[j] = mx; inter[j] = __expf(bj + mprev - mx);
      }
      __syncthreads();
      if (tid < 64) {
        float s1 = 0.f;
        for (int k = 0; k < 96; ++k) s1 += nst[k] * (float)*(const hf*)(qs + tid * MLQ + k * 2);
        nq[tid] = s1;
      }
      {
        f32x4 sacc[4];
#pragma unroll
        for (int n = 0; n < 4; ++n) sacc[n] = (f32x4){0.f, 0.f, 0.f, 0.f};
#pragma unroll
        for (int kk = 0; kk < 3; ++kk) {
          const hf8 af = *(const hf8*)(qs + (wid * 16 + fr) * MLQ + kk * 64 + fq * 16);
#pragma unroll
          for (int n = 0; n < 4; ++n) {
            const hf8 bf = *(const hf8*)(ks + (n * 16 + fr) * MLQ + kk * 64 + fq * 16);
            sacc[n] = __builtin_amdgcn_mfma_f32_16x16x32_f16(af, bf, sacc[n], 0, 0, 0);
          }
        }
        float rs[4] = {0.f, 0.f, 0.f, 0.f};
#pragma unroll
        for (int n = 0; n < 4; ++n) {
          const int s = n * 16 + fr; const float bs = bcd[s] - icd[s];
#pragma unroll
          for (int jj = 0; jj < 4; ++jj) {
            const int j = wid * 16 + fq * 4 + jj;
            const bool valid = d == 0 ? (s <= j) : (s >= j);
            const float val = valid ? sacc[n][jj] * __expf(bcd[j] - bs - mr[j]) : 0.f;
            rs[jj] += val;
            *(hf*)(ps + j * MLS + s * 2) = (hf)val;
          }
        }
        __syncthreads();
#pragma unroll
        for (int jj = 0; jj < 4; ++jj) {
          const float r = rowsum16(rs[jj]);
          const int j = wid * 16 + fq * 4 + jj;
          if (fr == 0) den[j] = inter[j] * nq[j] + r;
        }
      }
      f32x4 acc[6];
#pragma unroll
      for (int n = 0; n < 6; ++n) acc[n] = (f32x4){0.f, 0.f, 0.f, 0.f};
#pragma unroll
      for (int kk = 0; kk < 3; ++kk) {
        const hf8 af = *(const hf8*)(qs + (wid * 16 + fr) * MLQ + kk * 64 + fq * 16);
#pragma unroll
        for (int n = 0; n < 6; ++n) {
          const hf8 bf = *(const hf8*)(cs + (n * 16 + fr) * MLQ + kk * 64 + fq * 16);
          acc[n] = __builtin_amdgcn_mfma_f32_16x16x32_f16(af, bf, acc[n], 0, 0, 0);
        }
      }
#pragma unroll
      for (int jj = 0; jj < 4; ++jj) { const float it = inter[wid * 16 + fq * 4 + jj];
#pragma unroll
        for (int n = 0; n < 6; ++n) acc[n][jj] *= it; }
#pragma unroll
      for (int kk = 0; kk < 2; ++kk) {
        const hf8 af = *(const hf8*)(ps + (wid * 16 + fr) * MLS + kk * 64 + fq * 16);
#pragma unroll
        for (int n = 0; n < 6; ++n) {
          const hf8 bf = *(const hf8*)(vt + (n * 16 + fr) * MLS + kk * 64 + fq * 16);
          acc[n] = __builtin_amdgcn_mfma_f32_16x16x32_f16(af, bf, acc[n], 0, 0, 0);
        }
      }
      __syncthreads();
#pragma unroll
      for (int jj = 0; jj < 4; ++jj) {
        const int j = wid * 16 + fq * 4 + jj;
        const float dn = 1.f / fmaxf(fabsf(den[j]), __expf(-mr[j]));
#pragma unroll
        for (int n = 0; n < 6; ++n) hs[n][jj] += acc[n][jj] * dn;
      }
    }
#pragma unroll
    for (int jj = 0; jj < 4; ++jj) {
      const int m = m0 + wid * 16 + fq * 4 + jj;
      const hf* op = Z + (size_t)m * 1536 + 1152 + h * 96 + fr;
      float x[6]; float s = 0.f;
#pragma unroll
      for (int n = 0; n < 6; ++n) { x[n] = sigmoidf_((float)op[n * 16]) * hs[n][jj]; s += x[n]; }
      s = rowsum16(s);
      const float mean = s * (1.f / 96.f);
      float q = 0.f;
#pragma unroll
      for (int n = 0; n < 6; ++n) { x[n] -= mean; q += x[n] * x[n]; }
      q = rowsum16(q);
      const float rsd = rsqrtf(q * (1.f / 96.f) + 1e-5f);
      const float* ng = p.in[34] + (size_t)l * 384 + h * 96 + fr;
      bf16_t* yp = p.Y + (size_t)m * 1024 + 640 + h * 96 + fr;
#pragma unroll
      for (int n = 0; n < 6; ++n) yp[n * 16] = f2bf(x[n] * rsd * ng[n * 16]);
    }
    __syncthreads();
  }
}

#define MG_YM(p) ((bf16_t*)(p).R)
#define MG_G3(p) (MG_YM(p) + (size_t)M_ALL * 1024)
__device__ __forceinline__ void ph_gates(const P& p, int l, int Mt, char* lds) {
  EPI_VARS
  bf16_t* G3 = MG_G3(p);
  const float* gbias = p.in[38] + (size_t)l * 3072;
  const int ntile = Mt * 24;
  for (int it = 0;; ++it) {
    int tm, tn; if (!tile_map(it, Mt, 24, 8, tm, tn)) break; const int m0 = tm * 128, n0 = tn * 128;
    f32x4 acc[4][4]; ZERO_ACC(acc)
    gemm_main(p.U + (size_t)m0 * 1024, 1024, p.W + W_IN + (size_t)(3216 + n0) * 1024, 1024, 1024, acc, lds);
    EPI_BEGIN(m0, n0)
      G3[(size_t)row * 3072 + col] = f2bf(sigmoidf_(val + gbias[col]));
    EPI_END
  }
}
__device__ __forceinline__ void ph_merge(const P& p, int l, int Mt, char* lds) {
  EPI_VARS
  bf16_t* YM = MG_YM(p); const bf16_t* G3 = MG_G3(p);
  const int ntile = Mt * 16;
  for (int it = 0;; ++it) {
    int tm, tn; if (!tile_map(it, Mt, 16, 8, tm, tn)) break; const int m0 = tm * 128, n0 = tn * 64;
    f32x4 yacc[4][2];
#pragma unroll
    for (int m = 0; m < 4; ++m) { yacc[m][0] = (f32x4){0.f, 0.f, 0.f, 0.f}; yacc[m][1] = (f32x4){0.f, 0.f, 0.f, 0.f}; }
#pragma unroll 1
    for (int br = 0; br < 3; ++br) {
      f32x4 acc[4][2];
#pragma unroll
      for (int m = 0; m < 4; ++m) { acc[m][0] = (f32x4){0.f, 0.f, 0.f, 0.f}; acc[m][1] = (f32x4){0.f, 0.f, 0.f, 0.f}; }
      const int kb = br == 1 ? 256 : 384; const int yoff = br == 0 ? 0 : (br == 1 ? 384 : 640);
      const int woff = br == 0 ? W_UPRW : (br == 1 ? W_UPS5 : W_UPML);
      gemm_main_t<2>(p.Y + (size_t)m0 * 1024 + yoff, 1024, p.W + woff + (size_t)n0 * kb, kb, kb, acc, lds);
      EPI_ROW_BEGIN(m0)
        const bf16_t* gp = G3 + (size_t)row * 3072 + br * 1024 + n0 + wc * 32 + fr;
#pragma unroll
        for (int n = 0; n < 2; ++n) yacc[m][n][j] += bf2f(gp[n * 16]) * acc[m][n][j];
      EPI_ROW_END
    }
    EPI_ROW_BEGIN(m0)
      bf16_t* yp = YM + (size_t)row * 1024 + n0 + wc * 32 + fr;
#pragma unroll
      for (int n = 0; n < 2; ++n) yp[n * 16] = f2bf(yacc[m][n][j]);
    EPI_ROW_END
  }
}
__device__ __forceinline__ void ph_wout(const P& p, int l, int Mt, char* lds) {
  EPI_VARS
  const bf16_t* YM = (const bf16_t*)p.R;
  const int ntile = Mt * 8;
  for (int it = 0;; ++it) {
    int tm, tn; if (!tile_map(it, Mt, 8, 8, tm, tn)) break; const int m0 = tm * 128, n0 = tn * 128;
    f32x4 acc[4][4]; ZERO_ACC(acc)
    gemm_main(YM + (size_t)m0 * 1024, 1024, p.W + W_OUT + (size_t)n0 * 1024, 1024, 1024, acc, lds);
    EPI_ROW_BEGIN(m0)
      float* sp = srow(p, row) + n0 + wc * 64 + fr; const float* gp = modp(p, l, row, 5) + n0 + wc * 64 + fr;
#pragma unroll
      for (int n = 0; n < 4; ++n) sp[n * 16] = ALPHA * sp[n * 16] + gp[n * 16] * acc[m][n][j];
    EPI_ROW_END
  }
}

#define XB_TMO      128
#define XB_XCNT(j)  (256  + 64 * (j))
#define XB_XSUB(j)  (1280 + 64 * (j))
#define XB_XGEN(j)  (2304 + 64 * (j))
#define XB_TOP      3328
#define XB_TOPGEN   3392
#define XCD_BAR_WORDS 3456
#define XB_SPIN_CAP (1u << 18)
#define LAS __attribute__((address_space(3)))

__device__ __forceinline__ unsigned xb_ld(unsigned* p)              { return __hip_atomic_load(p, __ATOMIC_RELAXED, __HIP_MEMORY_SCOPE_AGENT); }
__device__ __forceinline__ unsigned xb_add(unsigned* p, unsigned v) { return __hip_atomic_fetch_add(p, v, __ATOMIC_RELAXED, __HIP_MEMORY_SCOPE_AGENT); }
__device__ __forceinline__ unsigned xb_xcc_id() { return (unsigned)__builtin_amdgcn_s_getreg((3 << 11) | 20) & 0xFu; }
#define XB_SPIN(cond, bar) do { unsigned _sp = 0; while (cond) { __builtin_amdgcn_s_sleep(1); \
    if ((++_sp & 255u) == 0u) { if (xb_ld(&(bar)[XB_TMO])) break; if (_sp > XB_SPIN_CAP) { atomicAdd(&(bar)[XB_TMO], 1u); break; } } } } while (0)

struct XcdBarrier {
    unsigned* bar; unsigned x;
    volatile LAS unsigned* st;
};

__device__ __forceinline__ XcdBarrier xcd_barrier_post(unsigned* bar, volatile LAS unsigned* st) {
    XcdBarrier b; b.bar = bar; b.x = xb_xcc_id(); b.st = st;
    if (__builtin_amdgcn_workitem_id_x() == 0) (void)xb_add(&bar[XB_XCNT(b.x)], 1u);
    return b;
}
__device__ __forceinline__ void xcd_barrier_complete(unsigned* bar, unsigned x, unsigned& nloc, unsigned& nx) {
    const unsigned G = gridDim.x * gridDim.y * gridDim.z;
    unsigned sum, cnt, mine, sp = 0u;
    for (;;) {
        sum = 0u; cnt = 0u; mine = 0u;
#pragma unroll
        for (unsigned j = 0; j < 16; ++j) { const unsigned c = xb_ld(&bar[XB_XCNT(j)]); sum += c; cnt += (c > 0u) ? 1u : 0u; mine = (j == x) ? c : mine; }
        if (sum == G) break;
        __builtin_amdgcn_s_sleep(1);
        if ((++sp & 255u) == 0u) { if (xb_ld(&bar[XB_TMO])) break; if (sp > XB_SPIN_CAP) { atomicAdd(&bar[XB_TMO], 1u); break; } }
    }
    nloc = mine > 0u ? mine : 1u; nx = cnt > 0u ? cnt : 1u;
}

__device__ __forceinline__ void xcd_barrier(const XcdBarrier& b) {
    asm volatile("s_waitcnt vmcnt(0)" ::: "memory");
    __syncthreads();
    if (__builtin_amdgcn_workitem_id_x() == 0) {
        unsigned* bar = b.bar;
        __builtin_amdgcn_s_waitcnt(0);
        unsigned nloc = b.st[0], nx = b.st[1];
        if (nloc == 0u) { xcd_barrier_complete(bar, b.x, nloc, nx); b.st[0] = nloc; b.st[1] = nx; }
        const unsigned old = xb_add(&bar[XB_XSUB(b.x)], 1u);
        const unsigned gen = old / nloc;
        if (old + 1u == (gen + 1u) * nloc) {
            __builtin_amdgcn_fence(__ATOMIC_RELEASE, "agent");
            asm volatile("s_waitcnt vmcnt(0)" ::: "memory");
            const unsigned og = xb_add(&bar[XB_TOP], 1u);
            const unsigned tg = og / nx;
            if (og + 1u == (tg + 1u) * nx) xb_add(&bar[XB_TOPGEN], 1u);
            else XB_SPIN(xb_ld(&bar[XB_TOPGEN]) == tg, bar);
            __builtin_amdgcn_fence(__ATOMIC_ACQUIRE, "agent");
            xb_add(&bar[XB_XGEN(b.x)], 1u);
            asm volatile("s_waitcnt vmcnt(0)" ::: "memory");
        } else {
            XB_SPIN(xb_ld(&bar[XB_XGEN(b.x)]) == gen, bar);
            __builtin_amdgcn_fence(__ATOMIC_ACQUIRE, "agent");
            asm volatile("s_waitcnt vmcnt(0)" ::: "memory");
        }
    }
    __syncthreads();
}


#define SYNC xcd_barrier(xb); asm volatile("" : "+s"(l));
__global__ void __launch_bounds__(NTHR, 2) mega(P pv) {
#define p pv
  __shared__ __attribute__((aligned(16))) char lds[LDS_BYTES];
  __shared__ uint4 xb_words;
  cg::grid_group grid = cg::this_grid();
  {
    const int t0 = __builtin_amdgcn_workitem_id_x();
    if (blockIdx.x == 0) for (int i = t0; i < XCD_BAR_WORDS; i += NTHR) pv.bar[i] = 0u;
    if (t0 == 0) xb_words = make_uint4(0u, 0u, 0u, 0u);
    __threadfence();
    grid.sync();
  }
  XcdBarrier xb = xcd_barrier_post(pv.bar, (volatile LAS unsigned*)&xb_words);
  for (int l = 0; l < 2; ++l) {
    const bool last = (l == 1);
    const int Mt2 = last ? 256 : 264;
    const int Mr2 = last ? M_LAT : M_ALL;
    ph_convert(p, l, l == 0, lds); SYNC
    if (l == 0) { ph_rows(p, 0, 0, 0, M_ALL, true, 0, 0); SYNC }
    ph_ffn_up(p, 0, 264, lds); SYNC
    ph_ffn_down(p, l, 0, 264, lds); SYNC
    ph_rows(p, 1, l, 0, M_ALL, true, l, 3); SYNC
    ph_z_rw(p, lds); SYNC
    ph_conv(p, l, 0); SYNC
    ph_lora(p, l, lds); SYNC
    ph_rwscan(p, lds); SYNC
    ph_rwpost(p, l); SYNC
    ph_z_s5(p, lds); SYNC
    ph_s5_pass(p, l, 1, lds); SYNC
    ph_s5_carry(p, l); SYNC
    ph_s5_pass(p, l, 3, lds); SYNC
    ph_glu(p, l, lds); SYNC
    ph_z_ml(p, lds); SYNC
    ph_conv(p, l, 1); SYNC
    ph_ml_a(p, l, lds); SYNC
    ph_ml_b(p); SYNC
    ph_ml_c(p, l, lds); SYNC
    ph_gates(p, l, Mt2, lds); SYNC
    ph_merge(p, l, Mt2, lds); SYNC
    ph_wout(p, l, Mt2, lds); SYNC
    ph_rows(p, 1, l, 1, Mr2, true, l, 6); SYNC
    ph_ffn_up(p, 1, Mt2, lds); SYNC
    ph_ffn_down(p, l, 1, Mt2, lds); SYNC
    ph_rows(p, 1, l, 2, Mr2, !last, l + 1, 0);
    if (!last) { SYNC }
  }
#undef p
}

extern "C" void kernel_launch(void* const* d_in, const int* in_sizes, int n_in, void* d_out, int out_size, void* d_ws, size_t ws_size,
                              hipStream_t stream) {
  static int grid_blocks = 0;
  if (!grid_blocks) {
    int dev = 0, cus = 0, per_cu = 0;
    hipGetDevice(&dev);
    hipDeviceGetAttribute(&cus, hipDeviceAttributeMultiprocessorCount, dev);
    hipOccupancyMaxActiveBlocksPerMultiprocessor(&per_cu, mega, NTHR, 0);
    if (per_cu > 2) per_cu = 2;
    grid_blocks = cus * per_cu;
  }
  P p{};
  for (int i = 0; i < 40; ++i) p.in[i] = (const float*)d_in[i];
  char* ws = (char*)d_ws;
  size_t off = 0;
  p.W = (bf16_t*)(ws + off); off += (size_t)W_TOTAL * 2;
  p.mod = (float*)(ws + off); off += (size_t)2 * 5 * 9216 * 4;
  p.sctx = (float*)(ws + off); off += (size_t)1024 * 1024 * 4;
  p.bar = (unsigned*)(ws + off); off += (size_t)16384;
  p.U = (bf16_t*)(ws + off); off += (size_t)M_ALL * 1024 * 2;
  p.Y = (bf16_t*)(ws + off); off += (size_t)M_ALL * 1024 * 2;
  p.R = ws + off;
  p.out = (float*)d_out;
  if (off + (size_t)M_ALL * 9728 > ws_size) fprintf(stderr, "workspace too small: need %zu have %zu\n", off + (size_t)M_ALL * 9728, ws_size);
  void* args[] = {&p};
  hipError_t e = hipLaunchCooperativeKernel((void*)mega, dim3(grid_blocks), dim3(NTHR), args, 0, stream);
  if (e != hipSuccess) fprintf(stderr, "cooperative launch failed: %s (grid %d)\n", hipGetErrorString(e), grid_blocks);
}
```

```cpp
#include <hip/hip_runtime.h>
#include <hip/hip_cooperative_groups.h>
#include <cstdio>
namespace cg = cooperative_groups;

typedef unsigned short bf16_t;
typedef _Float16 hf;
typedef hf hf4 __attribute__((ext_vector_type(4)));
typedef hf hf8 __attribute__((ext_vector_type(8)));
typedef __attribute__((ext_vector_type(8))) short bf16x8;
typedef __attribute__((ext_vector_type(4))) float f32x4;
typedef unsigned int u32x4 __attribute__((ext_vector_type(4)));

#define M_LAT 32768
#define M_ALL 33792
#define NTHR 256
#define LDS_BYTES 73728
#define ALPHA 1.41421356237f

#define W_GU0 0
#define W_D0 5767168
#define W_GU1 8650752
#define W_D1 14417920
#define W_IN 17301504
#define W_WUP0 23740416
#define W_WUP1 23764992
#define W_AUP0 23789568
#define W_AUP1 23814144
#define W_GUP 23838720
#define W_GLU 23887872
#define W_UPRW 23953408
#define W_UPS5 24346624
#define W_UPML 24608768
#define W_OUT 25001984
#define W_TOTAL 26050560

struct P {
  const float* in[40];
  float* out; float* sctx; float* mod;
  bf16_t* U; bf16_t* Y; bf16_t* W; char* R; unsigned* bar;
};

__device__ __forceinline__ int get_tid() { int t = __builtin_amdgcn_workitem_id_x(); asm volatile("" : "+v"(t)); return t; }
__device__ __forceinline__ bf16_t f2bf(float f) { return __builtin_bit_cast(unsigned short, (_Float16)f); }
__device__ __forceinline__ float bf2f(bf16_t h) { return (float)__builtin_bit_cast(_Float16, h); }
__device__ __forceinline__ float sigmoidf_(float x) { return 1.f / (1.f + __expf(-x)); }
__device__ __forceinline__ float siluf_(float x) { return x / (1.f + __expf(-x)); }
__device__ __forceinline__ float* srow(const P& p, int m) { return m < M_LAT ? p.out + (size_t)m * 1024 : p.sctx + (size_t)(m - M_LAT) * 1024; }
__device__ __forceinline__ const float* modp(const P& p, int l, int m, int k) { int mv = m < M_LAT ? (m >> 13) : 4; return p.mod + (size_t)(l * 5 + mv) * 9216 + k * 1024; }
template <int C> __device__ __forceinline__ float dppf(float x) { return __int_as_float(__builtin_amdgcn_update_dpp(0, __float_as_int(x), C, 0xf, 0xf, false)); }
__device__ __forceinline__ float rowsum16(float x) { x += dppf<0x128>(x); x += dppf<0x124>(x); x += dppf<0x122>(x); x += dppf<0x121>(x); return x; }
__device__ __forceinline__ float wavesum(float x) { for (int o = 32; o > 0; o >>= 1) x += __shfl_xor(x, o); return x; }

template <int NB>
__device__ __forceinline__ void gemm_main_t(const bf16_t* __restrict__ A, int lda, const bf16_t* __restrict__ B, int ldb, int K,
                                          f32x4 (&acc)[4][NB], char* lds) {
  const int tid = get_tid(), lane = tid & 63, wid = tid >> 6, wr = wid >> 1, wc = wid & 1;
  const int fr = lane & 15, fq = lane >> 4;
  const int sr = tid >> 3, skc = tid & 7;
  const bf16_t* ga = A + (size_t)sr * lda + skc * 8;
  const bf16_t* gb = B + (size_t)sr * ldb + skc * 8;
  u32x4 ra0[4], rb0[NB], ra1[4], rb1[NB];
  const int soff = sr * 144 + skc * 16;
  const int nk = K >> 6;
  const int aoff = (wr * 64 + fr) * 144 + fq * 16;
  const int boff = 18432 + (wc * (NB * 16) + fr) * 144 + fq * 16;
#define G_LOAD(RA, RB, kt) { _Pragma("unroll") for (int i = 0; i < 4; ++i) { RA[i] = *(const u32x4*)(ga + (size_t)(i * 32) * lda + (kt) * 64); if (i < NB) RB[i] = *(const u32x4*)(gb + (size_t)(i * 32) * ldb + (kt) * 64); } }
#define G_STORE(RA, RB, buf) { char* d_ = lds + (buf) * 36864 + soff; _Pragma("unroll") for (int i = 0; i < 4; ++i) { *(u32x4*)(d_ + i * 32 * 144) = RA[i]; if (i < NB) *(u32x4*)(d_ + 18432 + i * 32 * 144) = RB[i]; } }
#define G_COMP(buf) { const char* cur = lds + (buf) * 36864; _Pragma("unroll") for (int ks = 0; ks < 2; ++ks) { hf8 af[4], bfr[NB]; \
    _Pragma("unroll") for (int m = 0; m < 4; ++m) af[m] = *(const hf8*)(cur + aoff + m * 16 * 144 + ks * 64); \
    _Pragma("unroll") for (int n = 0; n < NB; ++n) bfr[n] = *(const hf8*)(cur + boff + n * 16 * 144 + ks * 64); \
    _Pragma("unroll") for (int m = 0; m < 4; ++m) _Pragma("unroll") for (int n = 0; n < NB; ++n) acc[m][n] = __builtin_amdgcn_mfma_f32_16x16x32_f16(af[m], bfr[n], acc[m][n], 0, 0, 0); } }
  G_LOAD(ra0, rb0, 0)
  { const int k1 = nk > 1 ? 1 : 0; G_LOAD(ra1, rb1, k1) }
  G_STORE(ra0, rb0, 0)
  __syncthreads();
  for (int kt = 0; kt < nk; kt += 2) {
    { const int k2 = kt + 2 < nk ? kt + 2 : nk - 1; G_LOAD(ra0, rb0, k2) }
    G_COMP(0)
    G_STORE(ra1, rb1, 1)
    __syncthreads();
    { const int k3 = kt + 3 < nk ? kt + 3 : nk - 1; G_LOAD(ra1, rb1, k3) }
    if (kt + 1 < nk) G_COMP(1)
    G_STORE(ra0, rb0, 0)
    __syncthreads();
  }
}
__device__ __forceinline__ void gemm_main(const bf16_t* __restrict__ A, int lda, const bf16_t* __restrict__ B, int ldb, int K, f32x4 (&acc)[4][4], char* lds) {
  gemm_main_t<4>(A, lda, B, ldb, K, acc, lds);
}

__device__ __forceinline__ bool tile_map_v(int b, int nb, int it, int Mt, int Nt, int SN, int& tm, int& tn) {
  const int xcd = b & 7, li = b >> 3, nloc = nb >> 3;
  const int T = 8 * SN; const int nsn = Nt / SN; const int nsuper = (Mt >> 3) * nsn;
  const int o = li + it * nloc; const int k = o / T, w = o - k * T;
  const int s = xcd + 8 * k;
  if (s >= nsuper) return false;
  const int sm = s / nsn, sn = s - sm * nsn;
  tm = sm * 8 + (w & 7); tn = sn * SN + (w >> 3);
  return true;
}
__device__ __forceinline__ bool tile_map(int it, int Mt, int Nt, int SN, int& tm, int& tn) { return tile_map_v(blockIdx.x, gridDim.x, it, Mt, Nt, SN, tm, tn); }
#define ZERO_ACC(a) _Pragma("unroll") for (int m_ = 0; m_ < 4; ++m_) _Pragma("unroll") for (int n_ = 0; n_ < 4; ++n_) a[m_][n_] = (f32x4){0.f, 0.f, 0.f, 0.f};
#define EPI_VARS const int tid = get_tid(), lane = tid & 63, wid = tid >> 6, wr = wid >> 1, wc = wid & 1, fr = lane & 15, fq = lane >> 4; (void)wr; (void)wc; (void)fr; (void)fq;
#define EPI_ROW_BEGIN(m0) _Pragma("unroll") for (int m = 0; m < 4; ++m) _Pragma("unroll") for (int j = 0; j < 4; ++j) { const int row = (m0) + wr * 64 + m * 16 + fq * 4 + j; (void)row;
#define EPI_COL_BEGIN(n0) _Pragma("unroll") for (int n = 0; n < 4; ++n) { const int col = (n0) + wc * 64 + n * 16 + fr; const float val = acc[m][n][j]; (void)col; (void)val;
#define EPI_COL_END }
#define EPI_ROW_END }
#define EPI_BEGIN(m0, n0) EPI_ROW_BEGIN(m0) EPI_COL_BEGIN(n0)
#define EPI_END } }

struct Job { const float* src; int K, N; int dst; int mode; };
__device__ __forceinline__ Job get_job(const P& p, int l, int j) {
  Job r; r.mode = 0;
  switch (j) {
    case 0: r.src = p.in[8] + (size_t)(l * 2 + 0) * 1024 * 2816; r.K = 1024; r.N = 2816; r.dst = W_GU0; r.mode = 1; break;
    case 1: r.src = p.in[9] + (size_t)(l * 2 + 0) * 1024 * 2816; r.K = 1024; r.N = 2816; r.dst = W_GU0; r.mode = 2; break;
    case 2: r.src = p.in[10] + (size_t)(l * 2 + 0) * 2816 * 1024; r.K = 2816; r.N = 1024; r.dst = W_D0; break;
    case 3: r.src = p.in[8] + (size_t)(l * 2 + 1) * 1024 * 2816; r.K = 1024; r.N = 2816; r.dst = W_GU1; r.mode = 1; break;
    case 4: r.src = p.in[9] + (size_t)(l * 2 + 1) * 1024 * 2816; r.K = 1024; r.N = 2816; r.dst = W_GU1; r.mode = 2; break;
    case 5: r.src = p.in[10] + (size_t)(l * 2 + 1) * 2816 * 1024; r.K = 2816; r.N = 1024; r.dst = W_D1; break;
    case 6: r.src = p.in[11] + (size_t)l * 1024 * 6288; r.K = 1024; r.N = 6288; r.dst = W_IN; break;
    case 7: r.src = p.in[14] + (size_t)(l * 2 + 0) * 64 * 384; r.K = 64; r.N = 384; r.dst = W_WUP0; break;
    case 8: r.src = p.in[14] + (size_t)(l * 2 + 1) * 64 * 384; r.K = 64; r.N = 384; r.dst = W_WUP1; break;
    case 9: r.src = p.in[16] + (size_t)(l * 2 + 0) * 64 * 384; r.K = 64; r.N = 384; r.dst = W_AUP0; break;
    case 10: r.src = p.in[16] + (size_t)(l * 2 + 1) * 64 * 384; r.K = 64; r.N = 384; r.dst = W_AUP1; break;
    case 11: r.src = p.in[17] + (size_t)l * 128 * 384; r.K = 128; r.N = 384; r.dst = W_GUP; break;
    case 12: r.src = p.in[31] + (size_t)l * 256 * 256; r.K = 256; r.N = 256; r.dst = W_GLU; break;
    case 13: r.src = p.in[35] + (size_t)l * 384 * 1024; r.K = 384; r.N = 1024; r.dst = W_UPRW; break;
    case 14: r.src = p.in[36] + (size_t)l * 256 * 1024; r.K = 256; r.N = 1024; r.dst = W_UPS5; break;
    case 15: r.src = p.in[37] + (size_t)l * 384 * 1024; r.K = 384; r.N = 1024; r.dst = W_UPML; break;
    default: r.src = p.in[39] + (size_t)l * 1024 * 1024; r.K = 1024; r.N = 1024; r.dst = W_OUT; break;
  }
  return r;
}
#define NJOBS 17
__device__ void mod_task(const P& p, int t, char* lds) {
  float* sc = (float*)lds;
  float* red = sc + 5 * 1024;
  const int tid = get_tid();
  for (int i = tid; i < 5 * 1024; i += NTHR) {
    int v = i >> 10, k = i & 1023;
    float c = v < 4 ? p.in[1][v * 1024 + k] : p.in[3][k];
    sc[i] = siluf_(c);
  }
  __syncthreads();
  const int c0 = t * 64; const int l = c0 / 9216; const int j0 = c0 % 9216;
  const int col = tid & 63, part = tid >> 6;
  const float* w = p.in[4] + ((size_t)l * 1024 + part * 256) * 9216 + j0 + col;
  float a0 = 0, a1 = 0, a2 = 0, a3 = 0, a4 = 0;
  const float* s = sc + part * 256;
#pragma unroll 8
  for (int i = 0; i < 256; ++i) {
    float wv = w[(size_t)i * 9216];
    a0 += s[i] * wv; a1 += s[1024 + i] * wv; a2 += s[2048 + i] * wv; a3 += s[3072 + i] * wv; a4 += s[4096 + i] * wv;
  }
  red[(part * 5 + 0) * 64 + col] = a0; red[(part * 5 + 1) * 64 + col] = a1; red[(part * 5 + 2) * 64 + col] = a2;
  red[(part * 5 + 3) * 64 + col] = a3; red[(part * 5 + 4) * 64 + col] = a4;
  __syncthreads();
  for (int i = tid; i < 320; i += NTHR) {
    int v = i >> 6, c = i & 63;
    float sum = red[(0 * 5 + v) * 64 + c] + red[(1 * 5 + v) * 64 + c] + red[(2 * 5 + v) * 64 + c] + red[(3 * 5 + v) * 64 + c];
    p.mod[(size_t)(l * 5 + v) * 9216 + j0 + c] = sum + p.in[5][(size_t)l * 9216 + j0 + c];
  }
  __syncthreads();
}
__device__ __forceinline__ void ph_convert(const P& p, int l, bool with_mod, char* lds) {
  const int tid = get_tid();
  int ntiles[NJOBS]; int total = 0;
#pragma unroll
  for (int j = 0; j < NJOBS; ++j) { Job jb = get_job(p, l, j); ntiles[j] = (jb.K >> 6) * ((jb.N + 63) >> 6); total += ntiles[j]; }
  const int nmod = with_mod ? 288 : 0;
  float* tile = (float*)lds;
  for (int t = blockIdx.x; t < total + nmod; t += gridDim.x) {
    if (t < nmod) { mod_task(p, t, lds); continue; }
    int tt = t - nmod; int j = 0;
#pragma unroll
    for (int q = 0; q < NJOBS; ++q) { if (j == q && tt >= ntiles[q]) { tt -= ntiles[q]; j = q + 1; } }
    Job jb = get_job(p, l, j);
    const int nkt = jb.K >> 6;
    const int k0 = (tt % nkt) * 64, n0 = (tt / nkt) * 64;
    {
      const int c = tid & 63, r0 = tid >> 6;
      const bool ok = (n0 + c) < jb.N;
#pragma unroll
      for (int i = 0; i < 16; ++i) { int r = r0 + i * 4; tile[r * 65 + c] = ok ? jb.src[(size_t)(k0 + r) * jb.N + n0 + c] : 0.f; }
    }
    __syncthreads();
    {
      const int nn = tid >> 2, q = tid & 3; const int n = n0 + nn;
      if (n < jb.N) {
        int drow = n;
        if (jb.mode == 1) drow = (n >> 5) * 64 + (n & 31);
        else if (jb.mode == 2) drow = (n >> 5) * 64 + 32 + (n & 31);
        bf16_t* d = p.W + jb.dst + (size_t)drow * jb.K + k0 + q * 16;
        unsigned pk[8];
#pragma unroll
        for (int i = 0; i < 8; ++i) { unsigned lo = f2bf(tile[(q * 16 + 2 * i) * 65 + nn]); unsigned hi = f2bf(tile[(q * 16 + 2 * i + 1) * 65 + nn]); pk[i] = lo | (hi << 16); }
        *(uint4*)d = make_uint4(pk[0], pk[1], pk[2], pk[3]);
        *(uint4*)(d + 8) = make_uint4(pk[4], pk[5], pk[6], pk[7]);
      }
    }
    __syncthreads();
  }
}

__device__ __forceinline__ void ph_rows(const P& p, int mode, int l, int ln_idx, int Mrows, bool writeU, int ul, int ks) {
  const int lane = get_tid() & 63, wid = get_tid() >> 6;
  const int nw = gridDim.x * 4;
  const float* g = p.in[6] + (size_t)(l * 3 + ln_idx) * 1024;
  const float* b = p.in[7] + (size_t)(l * 3 + ln_idx) * 1024;
  for (int m = blockIdx.x * 4 + wid; m < Mrows; m += nw) {
    float* s = srow(p, m);
    const float* src = s;
    if (mode == 0) src = m < M_LAT ? p.in[0] + (size_t)m * 1024 : p.in[2] + (size_t)(m - M_LAT) * 1024;
    float4 v[4];
#pragma unroll
    for (int i = 0; i < 4; ++i) v[i] = *(const float4*)(src + lane * 4 + i * 256);
    if (mode == 1) {
      float sum = 0;
#pragma unroll
      for (int i = 0; i < 4; ++i) sum += v[i].x + v[i].y + v[i].z + v[i].w;
      sum = wavesum(sum);
      const float mean = sum * (1.f / 1024.f);
      float sq = 0;
#pragma unroll
      for (int i = 0; i < 4; ++i) { v[i].x -= mean; v[i].y -= mean; v[i].z -= mean; v[i].w -= mean; sq += v[i].x * v[i].x + v[i].y * v[i].y + v[i].z * v[i].z + v[i].w * v[i].w; }
      sq = wavesum(sq);
      const float rstd = rsqrtf(sq * (1.f / 1024.f) + 1e-5f);
#pragma unroll
      for (int i = 0; i < 4; ++i) {
        float4 gg = *(const float4*)(g + lane * 4 + i * 256), bb = *(const float4*)(b + lane * 4 + i * 256);
        v[i].x = v[i].x * rstd * gg.x + bb.x; v[i].y = v[i].y * rstd * gg.y + bb.y; v[i].z = v[i].z * rstd * gg.z + bb.z; v[i].w = v[i].w * rstd * gg.w + bb.w;
      }
    }
#pragma unroll
    for (int i = 0; i < 4; ++i) *(float4*)(s + lane * 4 + i * 256) = v[i];
    if (writeU) {
      const float* sh = modp(p, ul, m, ks); const float* scl = modp(p, ul, m, ks + 1);
#pragma unroll
      for (int i = 0; i < 4; ++i) {
        float4 a = *(const float4*)(sh + lane * 4 + i * 256), c = *(const float4*)(scl + lane * 4 + i * 256);
        unsigned lo = f2bf(v[i].x * (1.f + c.x) + a.x) | ((unsigned)f2bf(v[i].y * (1.f + c.y) + a.y) << 16);
        unsigned hi = f2bf(v[i].z * (1.f + c.z) + a.z) | ((unsigned)f2bf(v[i].w * (1.f + c.w) + a.w) << 16);
        *(uint2*)(p.U + (size_t)m * 1024 + lane * 4 + i * 256) = make_uint2(lo, hi);
      }
    }
  }
}

__device__ __forceinline__ void ph_ffn_up(const P& p, int s, int Mt, char* lds) {
  EPI_VARS
  bf16_t* HM = (bf16_t*)p.R;
  const bf16_t* Wt = p.W + (s ? W_GU1 : W_GU0);
  const int ntile = Mt * 44;
  for (int it = 0;; ++it) {
    int tm, tn; if (!tile_map(it, Mt, 44, 4, tm, tn)) break; const int m0 = tm * 128, n0 = tn * 128;
    f32x4 acc[4][4]; ZERO_ACC(acc)
    gemm_main(p.U + (size_t)m0 * 1024, 1024, Wt + (size_t)n0 * 1024, 1024, 1024, acc, lds);
    const int hb = ((n0 + wc * 64) >> 6) * 32;
#pragma unroll
    for (int m = 0; m < 4; ++m)
#pragma unroll
      for (int n = 0; n < 2; ++n)
#pragma unroll
        for (int j = 0; j < 4; ++j) {
          const int row = m0 + wr * 64 + m * 16 + fq * 4 + j; const int hc = hb + n * 16 + fr;
          HM[(size_t)row * 2816 + hc] = f2bf(siluf_(acc[m][n][j]) * acc[m][n + 2][j]);
        }
  }
}
__device__ __forceinline__ void ph_ffn_down(const P& p, int l, int s, int Mt, char* lds) {
  EPI_VARS
  const bf16_t* HM = (const bf16_t*)p.R;
  const bf16_t* Wt = p.W + (s ? W_D1 : W_D0);
  const int gk = s ? 8 : 2;
  const int ntile = Mt * 8;
  for (int it = 0;; ++it) {
    int tm, tn; if (!tile_map(it, Mt, 8, 8, tm, tn)) break; const int m0 = tm * 128, n0 = tn * 128;
    f32x4 acc[4][4]; ZERO_ACC(acc)
    gemm_main(HM + (size_t)m0 * 2816, 2816, Wt + (size_t)n0 * 2816, 2816, 2816, acc, lds);
    EPI_ROW_BEGIN(m0)
      float* sp = srow(p, row) + n0 + wc * 64 + fr; const float* gp = modp(p, l, row, gk) + n0 + wc * 64 + fr;
#pragma unroll
      for (int n = 0; n < 4; ++n) sp[n * 16] = ALPHA * sp[n * 16] + 0.5f * gp[n * 16] * acc[m][n][j];
    EPI_ROW_END
  }
}

#define RW_ZRW(p) ((hf*)(p).R)
#define RW_RKV(p) (RW_ZRW(p) + (size_t)M_ALL * 1152)
#define RW_LA(p) ((bf16_t*)(RW_RKV(p) + (size_t)M_ALL * 1152))
#define RW_KK(p) ((hf*)(RW_LA(p) + (size_t)M_ALL * 256))
#define RW_KD(p) (RW_KK(p) + (size_t)M_ALL * 384)
#define RW_KA(p) (RW_KD(p) + (size_t)2 * M_ALL * 384)
#define RW_YR(p) (RW_KA(p) + (size_t)2 * M_ALL * 384)

#define S5_ZH(p) ((hf*)RW_LA(p))
#define S5_YG(p) ((p).W + W_GU0)
#define S5_E(p) ((float2*)((p).R + (size_t)M_ALL * 9728))
#define S5_X(p) S5_E(p)

#define ML_Z(p) ((hf*)(p).R)
#define ML_GL(p) ((float*)(ML_Z(p) + (size_t)M_ALL * 1536))
#define ML_QK(p) ((hf*)(ML_GL(p) + (size_t)M_ALL * 16))
#define ML_DC(p) ((float*)(ML_QK(p) + (size_t)M_ALL * 768))
#define ML_DN(p) (ML_DC(p) + (size_t)4224 * 9216)
#define ML_SC(p) (ML_DN(p) + (size_t)4224 * 96)
#define ML_MP(p) (ML_SC(p) + (size_t)4224 * 2)

__device__ __forceinline__ void ph_z_rw(const P& p, char* lds) {
  EPI_VARS
  hf* ZRW = RW_ZRW(p); bf16_t* LA = RW_LA(p);
  const int Mt = 264; const int ntile = Mt * 11;
  for (int it = 0;; ++it) {
    int tm, tn; if (!tile_map(it, Mt, 11, 11, tm, tn)) break; const int m0 = tm * 128;
    const int wrow = tn < 9 ? tn * 128 : 2960 + (tn - 9) * 128;
    f32x4 acc[4][4]; ZERO_ACC(acc)
    gemm_main(p.U + (size_t)m0 * 1024, 1024, p.W + W_IN + (size_t)wrow * 1024, 1024, 1024, acc, lds);
    if (tn < 9) {
      EPI_BEGIN(m0, tn * 128)
        ZRW[(size_t)row * 1152 + col] = (hf)val;
      EPI_END
    } else {
      EPI_BEGIN(m0, (tn - 9) * 128)
        float o = col < 64 ? tanhf(val) : (col < 128 ? val : sigmoidf_(val));
        LA[(size_t)row * 256 + col] = f2bf(o);
      EPI_END
    }
  }
}
__device__ __forceinline__ void ph_z_s5(const P& p, char* lds, int vb, int nvb) {
  EPI_VARS
  hf* Z = S5_ZH(p);
  const int Mt = 264;
  for (int it = 0;; ++it) {
    int tm, tn; if (!tile_map_v(vb, nvb, it, Mt, 2, 2, tm, tn)) break; const int m0 = tm * 128;
    f32x4 acc[4][4]; ZERO_ACC(acc)
    gemm_main(p.U + (size_t)m0 * 1024, 1024, p.W + W_IN + (size_t)(2704 + tn * 128) * 1024, 1024, 1024, acc, lds);
    EPI_BEGIN(m0, tn * 128)
      Z[(size_t)row * 256 + col] = (hf)val;
    EPI_END
  }
}
__device__ __forceinline__ void ph_z_ml(const P& p, char* lds) {
  EPI_VARS
  hf* Z = ML_Z(p); float* GL = ML_GL(p);
  const int Mt = 264; const int ntile = Mt * 13;
  for (int it = 0;; ++it) {
    int tm, tn; if (!tile_map(it, Mt, 13, 13, tm, tn)) break; const int m0 = tm * 128;
    f32x4 acc[4][4]; ZERO_ACC(acc)
    gemm_main(p.U + (size_t)m0 * 1024, 1024, p.W + W_IN + (size_t)(1152 + tn * 128) * 1024, 1024, 1024, acc, lds);
    if (tn < 12) {
      EPI_BEGIN(m0, tn * 128)
        Z[(size_t)row * 1536 + col] = (hf)val;
      EPI_END
    } else {
      EPI_BEGIN(m0, 0)
        if (col < 16) GL[(size_t)row * 16 + col] = val;
      EPI_END
    }
  }
}

__device__ __forceinline__ void ph_conv(const P& p, int l, int which) {
  const int nch = which == 0 ? 144 : 96;
  const int ldin = which == 0 ? 1152 : 1536;
  const hf* Zin = which == 0 ? RW_ZRW(p) : ML_Z(p);
  const int cbase = which == 0 ? 0 : 1152;
  const float* cw = p.in[12] + (size_t)l * 9 * 1920;
  const size_t total = (size_t)M_ALL * nch;
  for (size_t idx = (size_t)blockIdx.x * NTHR + get_tid(); idx < (total + 63) / 64 * 64; idx += (size_t)gridDim.x * NTHR) {
    const bool act = idx < total;
    const int m = act ? (int)(idx / nch) : 0; const int ch = act ? (int)(idx % nch) : 0; const int c0 = ch * 8;
    float o[8];
#pragma unroll
    for (int i = 0; i < 8; ++i) o[i] = 0.f;
    if (m < M_LAT) {
      const int bb = m >> 13, tt = m & 8191, gr = tt >> 6, gc = tt & 63;
#pragma unroll
      for (int dr = -1; dr <= 1; ++dr)
#pragma unroll
        for (int dc = -1; dc <= 1; ++dc) {
          const int rr = gr + dr, cc = gc + dc;
          if (rr >= 0 && rr < 128 && cc >= 0 && cc < 64) {
            const int mm = (bb << 13) + rr * 64 + cc;
            hf8 z = *(const hf8*)(Zin + (size_t)mm * ldin + c0);
            const float* w = cw + ((dr + 1) * 3 + (dc + 1)) * 1920 + cbase + c0;
            float4 w0 = *(const float4*)w, w1 = *(const float4*)(w + 4);
            o[0] += (float)z[0] * w0.x; o[1] += (float)z[1] * w0.y; o[2] += (float)z[2] * w0.z; o[3] += (float)z[3] * w0.w;
            o[4] += (float)z[4] * w1.x; o[5] += (float)z[5] * w1.y; o[6] += (float)z[6] * w1.z; o[7] += (float)z[7] * w1.w;
          }
        }
    } else {
      const int tt = (m - M_LAT) & 255;
#pragma unroll
      for (int dc = -1; dc <= 1; ++dc) {
        const int t2 = tt + dc;
        if (t2 >= 0 && t2 < 256) {
          hf8 z = *(const hf8*)(Zin + (size_t)(m + dc) * ldin + c0);
          const float* w = cw + (3 + (dc + 1)) * 1920 + cbase + c0;
          float4 w0 = *(const float4*)w, w1 = *(const float4*)(w + 4);
          o[0] += (float)z[0] * w0.x; o[1] += (float)z[1] * w0.y; o[2] += (float)z[2] * w0.z; o[3] += (float)z[3] * w0.w;
          o[4] += (float)z[4] * w1.x; o[5] += (float)z[5] * w1.y; o[6] += (float)z[6] * w1.z; o[7] += (float)z[7] * w1.w;
        }
      }
    }
    if (which == 0) {
      const bool isk = act && (c0 >= 384) && (c0 < 768);
      float kkv[8]; float ss = 0.f;
      if (isk) {
        const float* kkw = p.in[18] + (size_t)l * 384 + (c0 - 384);
#pragma unroll
        for (int i = 0; i < 8; ++i) { kkv[i] = o[i] * kkw[i]; ss += kkv[i] * kkv[i]; }
      } else {
#pragma unroll
        for (int i = 0; i < 8; ++i) kkv[i] = 0.f;
      }
      ss += __shfl_xor(ss, 1); ss += __shfl_xor(ss, 2); ss += __shfl_xor(ss, 4);
      if (act) {
        hf8 ov;
#pragma unroll
        for (int i = 0; i < 8; ++i) ov[i] = (hf)o[i];
        *(hf8*)(RW_RKV(p) + (size_t)m * 1152 + c0) = ov;
        if (isk) {
          const float rn = rsqrtf(fmaxf(ss, 1e-24f));
          hf8 kv;
#pragma unroll
          for (int i = 0; i < 8; ++i) kv[i] = (hf)(kkv[i] * rn);
          *(hf8*)(RW_KK(p) + (size_t)m * 384 + (c0 - 384)) = kv;
        }
      }
    } else if (act) {
      const float sc = c0 >= 384 ? 0.10206207261596575f : 1.f;
      hf8 ov;
#pragma unroll
      for (int i = 0; i < 8; ++i) ov[i] = (hf)(siluf_(o[i]) * sc);
      *(hf8*)(ML_QK(p) + (size_t)m * 768 + c0) = ov;
    }
  }
}

__device__ __forceinline__ void ph_lora(const P& p, int l, char* lds) {
  EPI_VARS
  hf* ZRW = RW_ZRW(p); const hf* RKV = RW_RKV(p); const bf16_t* LA = RW_LA(p); const hf* KK = RW_KK(p);
  hf* KD = RW_KD(p); hf* KA = RW_KA(p);
  const int Mt = 264; const int ntile = Mt * 15;
  for (int it = 0;; ++it) {
    int tm, q; if (!tile_map(it, Mt, 15, 15, tm, q)) break; const int job = q / 3, tn = q % 3; const int m0 = tm * 128, n0 = tn * 128;
    f32x4 acc[4][4]; ZERO_ACC(acc)
    if (job < 2) {
      const int d = job;
      gemm_main(LA + (size_t)m0 * 256, 256, p.W + (d ? W_WUP1 : W_WUP0) + (size_t)n0 * 64, 64, 64, acc, lds);
      const float* w0 = p.in[13] + (size_t)(l * 2 + d) * 384;
      EPI_BEGIN(m0, n0)
        const float e = sigmoidf_(w0[col] + val) * 0.6065306597126334f;
        ZRW[(size_t)row * 1152 + d * 384 + col] = (hf)(-expm1f(-e));
      EPI_END
    } else if (job < 4) {
      const int d = job - 2;
      gemm_main(LA + (size_t)m0 * 256 + 64, 256, p.W + (d ? W_AUP1 : W_AUP0) + (size_t)n0 * 64, 64, 64, acc, lds);
      const float* a0 = p.in[15] + (size_t)(l * 2 + d) * 384; const float* kaw = p.in[19] + (size_t)l * 384;
      EPI_ROW_BEGIN(m0)
        const int cb = n0 + wc * 64 + fr;
        const hf* kp = RKV + (size_t)row * 1152 + 384 + cb; const hf* kkp = KK + (size_t)row * 384 + cb;
        hf* kdp = KD + ((size_t)d * M_ALL + row) * 384 + cb; hf* kap = KA + ((size_t)d * M_ALL + row) * 384 + cb;
#pragma unroll
        for (int n = 0; n < 4; ++n) {
          const float a = sigmoidf_(a0[cb + n * 16] + acc[m][n][j]);
          kdp[n * 16] = (hf)((float)kp[n * 16] * (1.f + (a - 1.f) * kaw[cb + n * 16]));
          kap[n * 16] = (hf)((float)kkp[n * 16] * a);
        }
      EPI_ROW_END
    } else {
      gemm_main(LA + (size_t)m0 * 256 + 128, 256, p.W + W_GUP + (size_t)n0 * 128, 128, 128, acc, lds);
      EPI_BEGIN(m0, n0)
        ZRW[(size_t)row * 1152 + 768 + col] = (hf)val;
      EPI_END
    }
  }
}

typedef float f32x2 __attribute__((ext_vector_type(2)));
#define RW_CH 16
#define RW_BUF 21504
__device__ __forceinline__ void rw_cvt_store(char* dst, uint4 q) {
  const hf8 h = __builtin_bit_cast(hf8, q);
  f32x4 a, b;
  a[0] = (float)h[0]; a[1] = (float)h[1]; a[2] = (float)h[2]; a[3] = (float)h[3];
  b[0] = (float)h[4]; b[1] = (float)h[5]; b[2] = (float)h[6]; b[3] = (float)h[7];
  *(f32x4*)dst = a; *(f32x4*)(dst + 16) = b;
}
__device__ __forceinline__ void ph_rwscan(const P& p, char* lds) {
  const hf* ZRW = RW_ZRW(p); hf* RKV = RW_RKV(p); const hf* KK = RW_KK(p);
  const int tid = get_tid(), lane = tid & 63, wid = tid >> 6;
  char* pbuf = lds + 3 * RW_BUF + wid * 2048;
  char* ybuf = lds + 3 * RW_BUF + 8192;
  for (int t = blockIdx.x; t < 192; t += gridDim.x) {
    const int rqq = t & 3, h = (t >> 2) % 6, b = (t / 24) & 3, d = t / 96;
    const int rsub = lane >> 4, g = lane & 15; const int rl = wid * 4 + rsub;
    const int sgn = d ? -1 : 1;
    const bool grpA = tid < 128; const int t2 = tid & 127;
    const int sstep = t2 >> 3, sseg = t2 & 7;
    const hf* g0 = grpA ? (RKV + h * 64 + sseg * 8) : (RW_KD(p) + (size_t)d * M_ALL * 384 + h * 64 + sseg * 8);
    const size_t ld0 = grpA ? 1152 : 384;
    const hf* g1 = grpA ? (KK + h * 64 + sseg * 8) : (RW_KA(p) + (size_t)d * M_ALL * 384 + h * 64 + sseg * 8);
    const hf* g2 = grpA ? (ZRW + d * 384 + h * 64 + sseg * 8) : (RKV + 768 + h * 64 + rqq * 16 + (t2 & 1) * 8);
    const int s2 = grpA ? sstep : (t2 >> 1);
    const bool has2 = grpA || t2 < 32;
    const int o0 = (grpA ? 0 : 12288) + sstep * 256 + sseg * 32;
    const int o1 = (grpA ? 4096 : 16384) + sstep * 256 + sseg * 32;
    const int o2 = grpA ? (8192 + sstep * 256 + sseg * 32) : (20480 + (t2 >> 1) * 64 + (t2 & 1) * 32);
    hf* g_y = d == 0 ? (RKV + 384 + h * 64 + rqq * 16 + (tid & 1) * 8) : (RW_YR(p) + h * 64 + rqq * 16 + (tid & 1) * 8);
    const int ldy = d == 0 ? 1152 : 384;
    uint4 q0, q1, q2;
#define RW_M0(pp) ((pp) < 256 ? (M_LAT + b * 256 + (d ? 255 - (pp) : (pp))) : (b * 8192 + (d ? 8447 - (pp) : (pp) - 256)))
#define RW_GLOAD(c) { const int mb_ = RW_M0((c) * RW_CH); const size_t mm = (size_t)(mb_ + sgn * sstep); \
      q0 = *(const uint4*)(g0 + mm * ld0); q1 = *(const uint4*)(g1 + mm * 384); \
      if (has2) { const size_t m2 = (size_t)(mb_ + sgn * s2); q2 = *(const uint4*)(g2 + m2 * 1152); } }
#define RW_SSTORE(c) { char* bb_ = lds + ((c) % 3) * RW_BUF; rw_cvt_store(bb_ + o0, q0); rw_cvt_store(bb_ + o1, q1); if (has2) rw_cvt_store(bb_ + o2, q2); }
    f32x2 S01 = (f32x2){0.f, 0.f}, S23 = (f32x2){0.f, 0.f};
    RW_GLOAD(0) RW_SSTORE(0)
    RW_GLOAD(1) RW_SSTORE(1)
    __syncthreads();
    const int NCH = 8448 / RW_CH;
    for (int c = 0; c < NCH; ++c) {
      if (c + 2 < NCH) RW_GLOAD(c + 2)
      if (c > 0 && tid < 32) {
        const int mb_ = RW_M0((c - 1) * RW_CH); const size_t mv = (size_t)(mb_ + sgn * (tid >> 1));
        *(uint4*)(g_y + mv * ldy) = *(const uint4*)(ybuf + ((c - 1) & 1) * 512 + tid * 16);
      }
      const char* cb = lds + (c % 3) * RW_BUF + g * 16;
      const char* vb = lds + (c % 3) * RW_BUF + 20480 + rl * 4;
      f32x4 R4[RW_CH], K4[RW_CH], D4[RW_CH], KD4[RW_CH], KA4[RW_CH]; float VV[RW_CH];
#define RW_LDS(s_) { R4[s_] = *(const f32x4*)(cb + (s_) * 256); K4[s_] = *(const f32x4*)(cb + 4096 + (s_) * 256); D4[s_] = *(const f32x4*)(cb + 8192 + (s_) * 256); \
        KD4[s_] = *(const f32x4*)(cb + 12288 + (s_) * 256); KA4[s_] = *(const f32x4*)(cb + 16384 + (s_) * 256); VV[s_] = *(const float*)(vb + (s_) * 64); }
      RW_LDS(0) RW_LDS(1) RW_LDS(2)
#pragma unroll
      for (int s = 0; s < RW_CH; ++s) {
        if (s + 3 < RW_CH) RW_LDS(s + 3)
        const f32x4 r4 = R4[s], k4 = K4[s], d4 = D4[s], kd4 = KD4[s], ka4 = KA4[s]; const float vv = VV[s];
        const f32x2 k01 = {k4[0], k4[1]}, k23 = {k4[2], k4[3]}, d01 = {d4[0], d4[1]}, d23 = {d4[2], d4[3]};
        const f32x2 kd01 = {kd4[0], kd4[1]}, kd23 = {kd4[2], kd4[3]}, ka01 = {ka4[0], ka4[1]}, ka23 = {ka4[2], ka4[3]};
        const f32x2 r01 = {r4[0], r4[1]}, r23 = {r4[2], r4[3]};
        const f32x2 sa2 = __builtin_elementwise_fma(S23, k23, S01 * k01);
        float sa = sa2[0] + sa2[1];
        sa = rowsum16(sa);
        const f32x2 vv2 = {vv, vv}; const f32x2 nsa = {-sa, -sa};
        f32x2 T01 = __builtin_elementwise_fma(-S01, d01, S01), T23 = __builtin_elementwise_fma(-S23, d23, S23);
        T01 = __builtin_elementwise_fma(vv2, kd01, T01); T23 = __builtin_elementwise_fma(vv2, kd23, T23);
        S01 = __builtin_elementwise_fma(nsa, ka01, T01); S23 = __builtin_elementwise_fma(nsa, ka23, T23);
        const f32x2 y2 = __builtin_elementwise_fma(S23, r23, S01 * r01);
        *(float*)(pbuf + (((s & 7) * 4 + rsub) * 16 + g) * 4) = y2[0] + y2[1];
        if ((s & 7) == 7) {
          if (lane < 32) {
            const char* pr = pbuf + lane * 64;
            const f32x4 a0 = *(const f32x4*)(pr), a1 = *(const f32x4*)(pr + 16), a2 = *(const f32x4*)(pr + 32), a3 = *(const f32x4*)(pr + 48);
            const f32x4 sm = (a0 + a1) + (a2 + a3);
            const float y = (sm[0] + sm[1]) + (sm[2] + sm[3]);
            *(hf*)(ybuf + (c & 1) * 512 + (((s >> 3) * 8 + (lane >> 2)) * 16 + wid * 4 + (lane & 3)) * 2) = (hf)y;
          }
        }
      }
      if (c + 2 < NCH) RW_SSTORE(c + 2)
      __syncthreads();
    }
    if (tid < 32) {
      const int mb_ = RW_M0((NCH - 1) * RW_CH); const size_t mv = (size_t)(mb_ + sgn * (tid >> 1));
      *(uint4*)(g_y + mv * ldy) = *(const uint4*)(ybuf + ((NCH - 1) & 1) * 512 + tid * 16);
    }
    __syncthreads();
  }
}

__device__ __forceinline__ void ph_rwpost(const P& p, int l) {
  const hf* ZRW = RW_ZRW(p); const hf* RKV = RW_RKV(p); const hf* YR = RW_YR(p);
  const int lane = get_tid() & 63, wid = get_tid() >> 6;
  const int nw = gridDim.x * 4;
  for (int t = blockIdx.x * 4 + wid; t < M_ALL * 6; t += nw) {
    const int m = t / 6, h = t % 6; const int c = h * 64 + lane;
    const float ys = (float)RKV[(size_t)m * 1152 + 384 + c] + (float)YR[(size_t)m * 384 + c];
    const float mean = wavesum(ys) * (1.f / 64.f);
    const float xc = ys - mean;
    const float var = wavesum(xc * xc) * (1.f / 64.f);
    float y = xc * rsqrtf(var + 64e-5f) * p.in[21][(size_t)l * 384 + c] + p.in[22][(size_t)l * 384 + c];
    const float r = (float)RKV[(size_t)m * 1152 + c], v = (float)RKV[(size_t)m * 1152 + 768 + c];
    const float rk = p.in[20][(size_t)l * 384 + c];
    const float kd0 = (float)RW_KD(p)[(size_t)m * 384 + c], kd1 = (float)RW_KD(p)[((size_t)M_ALL + m) * 384 + c];
    const float bs = wavesum(r * (kd0 + kd1) * rk);
    y = (y + bs * v) * (float)ZRW[(size_t)m * 1152 + 768 + c];
    p.Y[(size_t)m * 1024 + c] = f2bf(y);
  }
}

struct S5C { float ar, ai; float br[16], bi[16]; };
__device__ __forceinline__ void s5_consts(const P& p, int l, int d, int g, int n, S5C& c) {
  const int ig = (l * 2 + d) * 16 + g;
  const float lr = fminf(p.in[23][(size_t)ig * 64 + n], -1e-4f), li = p.in[24][(size_t)ig * 64 + n];
  const float dt = expf(p.in[25][ig]);
  const float mag = expf(lr * dt);
  c.ar = mag * cosf(li * dt); c.ai = mag * sinf(li * dt);
  const float nr = c.ar - 1.f, ni = c.ai; const float den = 1.f / (lr * lr + li * li);
  const float cr = (nr * lr + ni * li) * den, ci = (ni * lr - nr * li) * den;
  const float* bre = p.in[26] + ((size_t)ig * 64 + n) * 16; const float* bim = p.in[27] + ((size_t)ig * 64 + n) * 16;
#pragma unroll
  for (int h = 0; h < 16; ++h) { const float xr = bre[h], xi = bim[h]; c.br[h] = cr * xr - ci * xi; c.bi[h] = cr * xi + ci * xr; }
}
__device__ __forceinline__ int s5_m0(int b, int tc) { return tc < 128 ? b * 8192 + tc * 64 : M_LAT + b * 256 + (tc - 128) * 64; }
__device__ __forceinline__ int chain_pos(int d, int tc) { return d == 0 ? (tc < 128 ? tc + 4 : tc - 128) : (tc < 128 ? 131 - tc : 131 - tc); }
__device__ __forceinline__ void ph_s5_pass(const P& p, int l, int pass, char* lds, int vb, int nvb) {
  const int tid = get_tid(), lane = tid & 63, wid = tid >> 6, fr = lane & 15, fq = lane >> 4;
  float* ub = (float*)(lds + wid * 8448);
  char* xs = lds + wid * 8448 + 4096;
  const hf* Z = S5_ZH(p); float2* E = S5_E(p); const float2* X = S5_X(p); bf16_t* YG = S5_YG(p);
  const int nw = nvb * 4;
  for (int t = vb * 4 + wid; t < 4 * 132 * 16; t += nw) {
    const int g = t & 15, tc = (t >> 4) % 132, b = t / (16 * 132);
    const int m0 = s5_m0(b, tc);
#pragma unroll
    for (int i = 0; i < 4; ++i) { const int e = lane + i * 64; const int tok = e >> 2, q = e & 3;
      const hf4 zv = *(const hf4*)(Z + (size_t)(m0 + tok) * 256 + g * 16 + q * 4);
      *(float4*)(ub + tok * 16 + q * 4) = make_float4((float)zv[0], (float)zv[1], (float)zv[2], (float)zv[3]); }
    f32x4 yacc[4];
#pragma unroll
    for (int i = 0; i < 4; ++i) yacc[i] = (f32x4){0.f, 0.f, 0.f, 0.f};
    for (int d = 0; d < 2; ++d) {
      S5C c; s5_consts(p, l, d, g, lane, c);
      const int cp = chain_pos(d, tc);
      const size_t sidx = (((size_t)(d * 4 + b) * 132 + cp) * 16 + g) * 64 + lane;
      float xr = 0.f, xi = 0.f;
      hf8 cf[4];
      if (pass == 3) {
        float2 x0 = X[sidx]; xr = x0.x; xi = x0.y;
        const int ig = (l * 2 + d) * 16 + g;
#pragma unroll
        for (int ks = 0; ks < 4; ++ks) {
          const int c0 = ks * 32 + fq * 8;
          const float* src_ = (c0 < 64 ? p.in[28] : p.in[29]) + ((size_t)ig * 16 + fr) * 64 + (c0 & 63);
          const float sg = c0 < 64 ? 1.f : -1.f;
          const float4 v0 = *(const float4*)src_, v1 = *(const float4*)(src_ + 4);
          cf[ks][0] = (hf)(sg * v0.x); cf[ks][1] = (hf)(sg * v0.y); cf[ks][2] = (hf)(sg * v0.z); cf[ks][3] = (hf)(sg * v0.w);
          cf[ks][4] = (hf)(sg * v1.x); cf[ks][5] = (hf)(sg * v1.y); cf[ks][6] = (hf)(sg * v1.z); cf[ks][7] = (hf)(sg * v1.w);
        }
      }
#pragma unroll 1
      for (int jb = 0; jb < 4; ++jb) {
        const int tb = d ? 3 - jb : jb;
#pragma unroll 4
        for (int jj = 0; jj < 16; ++jj) {
          const int t16 = d ? 15 - jj : jj;
          const float* u = ub + (tb * 16 + t16) * 16;
          float br = 0.f, bi = 0.f;
#pragma unroll
          for (int h = 0; h < 16; ++h) { const float uv = u[h]; br += c.br[h] * uv; bi += c.bi[h] * uv; }
          const float nr = c.ar * xr - c.ai * xi + br, ni = c.ar * xi + c.ai * xr + bi;
          xr = nr; xi = ni;
          if (pass == 3) { *(hf*)(xs + t16 * 272 + lane * 2) = (hf)xr; *(hf*)(xs + t16 * 272 + 128 + lane * 2) = (hf)xi; }
        }
        if (pass == 3) {
          f32x4 acc = (f32x4){0.f, 0.f, 0.f, 0.f};
#pragma unroll
          for (int ks = 0; ks < 4; ++ks) {
            const hf8 af = *(const hf8*)(xs + fr * 272 + ks * 64 + fq * 16);
            acc = __builtin_amdgcn_mfma_f32_16x16x32_f16(af, cf[ks], acc, 0, 0, 0);
          }
#pragma unroll
          for (int i = 0; i < 4; ++i) if (i == tb) yacc[i] += acc;
        }
      }
      if (pass == 1) E[sidx] = make_float2(xr, xi);
    }
    if (pass == 3) {
      const float dsk = p.in[30][(size_t)l * 256 + g * 16 + fr];
#pragma unroll
      for (int i = 0; i < 4; ++i)
#pragma unroll
        for (int j = 0; j < 4; ++j) {
          const int tok = i * 16 + fq * 4 + j;
          float y = yacc[i][j] + dsk * ub[tok * 16 + fr];
          const float inner = 0.7978845608028654f * (y + 0.044715f * y * y * y);
          y = 0.5f * y * (1.f + tanhf(inner));
          YG[(size_t)(m0 + tok) * 256 + g * 16 + fr] = f2bf(y);
        }
    }
  }
}
__device__ __forceinline__ void ph_s5_carry(const P& p, int l, int vb, int nvb) {
  float2* E = S5_E(p); float2* X = S5_X(p);
  for (int t = vb * NTHR + get_tid(); t < 8192; t += nvb * NTHR) {
    const int n = t & 63, g = (t >> 6) & 15, b = (t >> 10) & 3, d = t >> 12;
    const int ig = (l * 2 + d) * 16 + g;
    const float lr = fminf(p.in[23][(size_t)ig * 64 + n], -1e-4f), li = p.in[24][(size_t)ig * 64 + n];
    const float dt = expf(p.in[25][ig]);
    const float mag = expf(lr * dt * 64.f);
    float ar = expf(lr * dt) * cosf(li * dt), ai = expf(lr * dt) * sinf(li * dt);
#pragma unroll
    for (int i = 0; i < 6; ++i) { const float r2 = ar * ar - ai * ai, i2 = 2.f * ar * ai; ar = r2; ai = i2; }
    (void)mag;
    float xr = 0.f, xi = 0.f;
    const size_t base = (((size_t)(d * 4 + b) * 132) * 16 + g) * 64 + n;
    for (int cp0 = 0; cp0 < 132; cp0 += 12) {
      float2 ev[12];
#pragma unroll
      for (int u = 0; u < 12; ++u) ev[u] = E[base + (size_t)(cp0 + u) * 1024];
#pragma unroll
      for (int u = 0; u < 12; ++u) {
        X[base + (size_t)(cp0 + u) * 1024] = make_float2(xr, xi);
        const float nr = ar * xr - ai * xi + ev[u].x, ni = ar * xi + ai * xr + ev[u].y;
        xr = nr; xi = ni;
      }
    }
  }
}
__device__ __forceinline__ void ph_glu(const P& p, int l, char* lds, int vb, int nvb) {
  EPI_VARS
  const bf16_t* YG = S5_YG(p);
  const int Mt = 264;
  const float* gb = p.in[32] + (size_t)l * 256;
  for (int it = 0;; ++it) {
    int tm, tn; if (!tile_map_v(vb, nvb, it, Mt, 2, 2, tm, tn)) break; const int m0 = tm * 128, n0 = tn * 128;
    f32x4 acc[4][4]; ZERO_ACC(acc)
    gemm_main(YG + (size_t)m0 * 256, 256, p.W + W_GLU + (size_t)n0 * 256, 256, 256, acc, lds);
    EPI_BEGIN(m0, n0)
      const float y = bf2f(YG[(size_t)row * 256 + col]);
      p.Y[(size_t)row * 1024 + 384 + col] = f2bf(y * sigmoidf_(val + gb[col]));
    EPI_END
  }
}

__device__ __forceinline__ void sub_barrier(unsigned* cnt, unsigned target) {
  asm volatile("s_waitcnt vmcnt(0)" ::: "memory");
  __syncthreads();
  if (__builtin_amdgcn_workitem_id_x() == 0) {
    __builtin_amdgcn_fence(__ATOMIC_RELEASE, "agent");
    asm volatile("s_waitcnt vmcnt(0)" ::: "memory");
    __hip_atomic_fetch_add(cnt, 1u, __ATOMIC_RELAXED, __HIP_MEMORY_SCOPE_AGENT);
    unsigned sp = 0;
    while (__hip_atomic_load(cnt, __ATOMIC_RELAXED, __HIP_MEMORY_SCOPE_AGENT) < target) { __builtin_amdgcn_s_sleep(2); if (++sp > (1u << 22)) break; }
    __builtin_amdgcn_fence(__ATOMIC_ACQUIRE, "agent");
    asm volatile("s_waitcnt vmcnt(0)" ::: "memory");
  }
  __syncthreads();
}
__device__ __forceinline__ void ph_s5_stage(const P& p, int l, char* lds, int vb, int nvb) {
  unsigned* cnt = p.bar + 3584;
  const unsigned base = (unsigned)(l * 4) * (unsigned)nvb;
  ph_z_s5(p, lds, vb, nvb);            sub_barrier(cnt, base + 1u * nvb);
  ph_s5_pass(p, l, 1, lds, vb, nvb);   sub_barrier(cnt, base + 2u * nvb);
  ph_s5_carry(p, l, vb, nvb);          sub_barrier(cnt, base + 3u * nvb);
  ph_s5_pass(p, l, 3, lds, vb, nvb);   sub_barrier(cnt, base + 4u * nvb);
  ph_glu(p, l, lds, vb, nvb);
}

__device__ __forceinline__ float logsigf_(float x) { return fminf(x, 0.f) - log1pf(__expf(-fabsf(x))); }
__device__ __forceinline__ void ml_gates(const P& p, int l, int d, int h, int m0, int lane, float& bcum, float& ic) {
  const int tok = d ? 63 - lane : lane;
  const float* gl = ML_GL(p) + (size_t)(m0 + tok) * 16;
  const float* gb = p.in[33] + (size_t)(l * 2 + d) * 8;
  ic = gl[d * 8 + h] + gb[h];
  float f = logsigf_(gl[d * 8 + 4 + h] + gb[4 + h]);
#pragma unroll
  for (int o = 1; o < 64; o <<= 1) { float v = __shfl_up(f, o); if (lane >= o) f += v; }
  bcum = f;
}
__device__ __forceinline__ void ml_gates2(const P& p, int l, int d, int h, int m0, int lane, float& bc, float& ic, float& tot) {
  const float* gl = ML_GL(p) + (size_t)(m0 + lane) * 16;
  const float* gb = p.in[33] + (size_t)(l * 2 + d) * 8;
  ic = gl[d * 8 + h] + gb[h];
  const float f0 = logsigf_(gl[d * 8 + 4 + h] + gb[4 + h]);
  float f = f0;
#pragma unroll
  for (int o = 1; o < 64; o <<= 1) { float v = __shfl_up(f, o); if (lane >= o) f += v; }
  tot = __shfl(f, 63);
  bc = d ? (tot - f + f0) : f;
}
#define MLQ 208
#define MLS 144
__device__ __forceinline__ void ph_ml_a(const P& p, int l, char* lds) {
  char* vt = lds; char* kt = lds + 13824; float* wg = (float*)(lds + 27648);
  const int tid = get_tid(), lane = tid & 63, wid = tid >> 6, fr = lane & 15, fq = lane >> 4;
  const hf* QK = ML_QK(p); const hf* Z = ML_Z(p);
  for (int t = blockIdx.x; t < 4224; t += gridDim.x) {
    const int tc = t % 132, h = (t / 132) & 3, b = (t / 528) & 3, d = t / 2112;
    const int m0 = s5_m0(b, tc); const int cp = chain_pos(d, tc);
    const size_t task = ((size_t)((d * 4 + b) * 4 + h)) * 132 + cp;
    if (wid == 0) {
      float bc, ic, tot; ml_gates2(p, l, d, h, m0, lane, bc, ic, tot);
      const float lw = tot - bc + ic;
      float mx = lw;
      for (int o = 32; o > 0; o >>= 1) mx = fmaxf(mx, __shfl_xor(mx, o));
      wg[lane] = __expf(lw - mx);
      if (lane == 0) { ML_SC(p)[task * 2] = mx; ML_SC(p)[task * 2 + 1] = tot; }
    }
    __syncthreads();
    for (int e = tid; e < 64 * 12; e += NTHR) {
      const int tok = e & 63, q = e >> 6;
      const hf8 kv = *(const hf8*)(QK + (size_t)(m0 + tok) * 768 + 384 + h * 96 + q * 8);
      const hf8 vv = *(const hf8*)(Z + (size_t)(m0 + tok) * 1536 + 768 + h * 96 + q * 8);
      const float w = wg[tok];
#pragma unroll
      for (int i = 0; i < 8; ++i) {
        *(hf*)(kt + (q * 8 + i) * MLS + tok * 2) = kv[i];
        *(hf*)(vt + (q * 8 + i) * MLS + tok * 2) = (hf)((float)vv[i] * w);
      }
    }
    __syncthreads();
    float* dc = ML_DC(p) + task * 9216;
#pragma unroll 1
    for (int bi = 0; bi < 9; ++bi) {
      const int idx = wid * 9 + bi; const int mb = idx / 6, nb = idx % 6;
      f32x4 acc = (f32x4){0.f, 0.f, 0.f, 0.f};
#pragma unroll
      for (int ks = 0; ks < 2; ++ks) {
        const hf8 af = *(const hf8*)(vt + (mb * 16 + fr) * MLS + ks * 64 + fq * 16);
        const hf8 bf = *(const hf8*)(kt + (nb * 16 + fr) * MLS + ks * 64 + fq * 16);
        acc = __builtin_amdgcn_mfma_f32_16x16x32_f16(af, bf, acc, 0, 0, 0);
      }
#pragma unroll
      for (int j = 0; j < 4; ++j) dc[(mb * 16 + fq * 4 + j) * 96 + nb * 16 + fr] = acc[j];
    }
    if (tid < 96) {
      float s = 0.f;
      for (int j = 0; j < 64; ++j) s += wg[j] * (float)*(const hf*)(kt + tid * MLS + j * 2);
      ML_DN(p)[task * 96 + tid] = s;
    }
    __syncthreads();
  }
}
__device__ __forceinline__ void ph_ml_b(const P& p) {
  float* DC = ML_DC(p); float* DN = ML_DN(p); const float* SC = ML_SC(p); float* MP = ML_MP(p);
  for (int t = blockIdx.x * NTHR + get_tid(); t < 32 * 9312; t += gridDim.x * NTHR) {
    const int chain = t / 9312, e = t % 9312;
    float cur = 0.f, mprev = 0.f;
    for (int cp0 = 0; cp0 < 132; cp0 += 12) {
      float dl[12], ml_[12], bl_[12];
#pragma unroll
      for (int u = 0; u < 12; ++u) {
        const size_t task = (size_t)chain * 132 + cp0 + u;
        dl[u] = e < 9216 ? DC[task * 9216 + e] : DN[task * 96 + (e - 9216)];
        ml_[u] = SC[task * 2]; bl_[u] = SC[task * 2 + 1];
      }
#pragma unroll
      for (int u = 0; u < 12; ++u) {
        const size_t task = (size_t)chain * 132 + cp0 + u;
        float* slot = e < 9216 ? DC + task * 9216 + e : DN + task * 96 + (e - 9216);
        *slot = cur;
        if (e == 0) MP[task] = mprev;
        const float mnew = fmaxf(bl_[u] + mprev, ml_[u]);
        cur = __expf(bl_[u] + mprev - mnew) * cur + __expf(ml_[u] - mnew) * dl[u];
        mprev = mnew;
      }
    }
  }
}
__device__ __forceinline__ void ph_ml_c(const P& p, int l, char* lds) {
  char* qs = lds; char* ks = lds + 13312; char* vt = lds + 26624; char* cs = lds + 40448; char* ps = lds + 60416;
  float* fl = (float*)(lds + 69632);
  float* bc = fl; float* icv = fl + 128; float* mr = fl + 256; float* inter = fl + 320; float* den = fl + 384; float* nq = fl + 448; float* nst = fl + 512;
  const int tid = get_tid(), lane = tid & 63, wid = tid >> 6, fr = lane & 15, fq = lane >> 4;
  const hf* QK = ML_QK(p); const hf* Z = ML_Z(p);
  for (int t = blockIdx.x; t < 2112; t += gridDim.x) {
    const int tc = t % 132, h = (t / 132) & 3, b = t / 528;
    const int m0 = s5_m0(b, tc);
    for (int e = tid; e < 64 * 12; e += NTHR) {
      const int tok = e & 63, q = e >> 6;
      *(hf8*)(qs + tok * MLQ + q * 16) = *(const hf8*)(QK + (size_t)(m0 + tok) * 768 + h * 96 + q * 8);
      *(hf8*)(ks + tok * MLQ + q * 16) = *(const hf8*)(QK + (size_t)(m0 + tok) * 768 + 384 + h * 96 + q * 8);
      const hf8 vv = *(const hf8*)(Z + (size_t)(m0 + tok) * 1536 + 768 + h * 96 + q * 8);
#pragma unroll
      for (int i = 0; i < 8; ++i) *(hf*)(vt + (q * 8 + i) * MLS + tok * 2) = vv[i];
    }
    if (wid < 2) { float bcv, ic, tot; ml_gates2(p, l, wid, h, m0, lane, bcv, ic, tot); bc[wid * 64 + lane] = bcv; icv[wid * 64 + lane] = ic; }
    f32x4 hs[6];
#pragma unroll
    for (int n = 0; n < 6; ++n) hs[n] = (f32x4){0.f, 0.f, 0.f, 0.f};
    for (int d = 0; d < 2; ++d) {
      const int cp = chain_pos(d, tc);
      const size_t task = ((size_t)((d * 4 + b) * 4 + h)) * 132 + cp;
      const float mprev = ML_MP(p)[task];
      __syncthreads();
      {
        const float* cg = ML_DC(p) + task * 9216;
        for (int e = tid; e < 96 * 24; e += NTHR) {
          const int v = e / 24, q = e % 24;
          const float4 c4 = *(const float4*)(cg + v * 96 + q * 4);
          hf4 o; o[0] = (hf)c4.x; o[1] = (hf)c4.y; o[2] = (hf)c4.z; o[3] = (hf)c4.w;
          *(hf4*)(cs + v * MLQ + q * 8) = o;
        }
        if (tid < 96) nst[tid] = ML_DN(p)[task * 96 + tid];
      }
      const float* bcd = bc + d * 64; const float* icd = icv + d * 64;
      if (tid < 64) {
        const int j = tid; const float bj = bcd[j];
        float mx = bj + mprev;
        if (d == 0) { for (int s = 0; s <= j; ++s) mx = fmaxf(mx, bj - bcd[s] + icd[s]); }
        else { for (int s = j; s < 64; ++s) mx = fmaxf(mx, bj - bcd[s] + icd[s]); }
        mr[j] = mx; inter[j] = __expf(bj + mprev - mx);
      }
      __syncthreads();
      if (tid < 64) {
        float s1 = 0.f;
        for (int k = 0; k < 96; ++k) s1 += nst[k] * (float)*(const hf*)(qs + tid * MLQ + k * 2);
        nq[tid] = s1;
      }
      {
        f32x4 sacc[4];
#pragma unroll
        for (int n = 0; n < 4; ++n) sacc[n] = (f32x4){0.f, 0.f, 0.f, 0.f};
#pragma unroll
        for (int kk = 0; kk < 3; ++kk) {
          const hf8 af = *(const hf8*)(qs + (wid * 16 + fr) * MLQ + kk * 64 + fq * 16);
#pragma unroll
          for (int n = 0; n < 4; ++n) {
            const hf8 bf = *(const hf8*)(ks + (n * 16 + fr) * MLQ + kk * 64 + fq * 16);
            sacc[n] = __builtin_amdgcn_mfma_f32_16x16x32_f16(af, bf, sacc[n], 0, 0, 0);
          }
        }
        float rs[4] = {0.f, 0.f, 0.f, 0.f};
#pragma unroll
        for (int n = 0; n < 4; ++n) {
          const int s = n * 16 + fr; const float bs = bcd[s] - icd[s];
#pragma unroll
          for (int jj = 0; jj < 4; ++jj) {
            const int j = wid * 16 + fq * 4 + jj;
            const bool valid = d == 0 ? (s <= j) : (s >= j);
            const float val = valid ? sacc[n][jj] * __expf(bcd[j] - bs - mr[j]) : 0.f;
            rs[jj] += val;
            *(hf*)(ps + j * MLS + s * 2) = (hf)val;
          }
        }
        __syncthreads();
#pragma unroll
        for (int jj = 0; jj < 4; ++jj) {
          const float r = rowsum16(rs[jj]);
          const int j = wid * 16 + fq * 4 + jj;
          if (fr == 0) den[j] = inter[j] * nq[j] + r;
        }
      }
      f32x4 acc[6];
#pragma unroll
      for (int n = 0; n < 6; ++n) acc[n] = (f32x4){0.f, 0.f, 0.f, 0.f};
#pragma unroll
      for (int kk = 0; kk < 3; ++kk) {
        const hf8 af = *(const hf8*)(qs + (wid * 16 + fr) * MLQ + kk * 64 + fq * 16);
#pragma unroll
        for (int n = 0; n < 6; ++n) {
          const hf8 bf = *(const hf8*)(cs + (n * 16 + fr) * MLQ + kk * 64 + fq * 16);
          acc[n] = __builtin_amdgcn_mfma_f32_16x16x32_f16(af, bf, acc[n], 0, 0, 0);
        }
      }
#pragma unroll
      for (int jj = 0; jj < 4; ++jj) { const float it = inter[wid * 16 + fq * 4 + jj];
#pragma unroll
        for (int n = 0; n < 6; ++n) acc[n][jj] *= it; }
#pragma unroll
      for (int kk = 0; kk < 2; ++kk) {
        const hf8 af = *(const hf8*)(ps + (wid * 16 + fr) * MLS + kk * 64 + fq * 16);
#pragma unroll
        for (int n = 0; n < 6; ++n) {
          const hf8 bf = *(const hf8*)(vt + (n * 16 + fr) * MLS + kk * 64 + fq * 16);
          acc[n] = __builtin_amdgcn_mfma_f32_16x16x32_f16(af, bf, acc[n], 0, 0, 0);
        }
      }
      __syncthreads();
#pragma unroll
      for (int jj = 0; jj < 4; ++jj) {
        const int j = wid * 16 + fq * 4 + jj;
        const float dn = 1.f / fmaxf(fabsf(den[j]), __expf(-mr[j]));
#pragma unroll
        for (int n = 0; n < 6; ++n) hs[n][jj] += acc[n][jj] * dn;
      }
    }
#pragma unroll
    for (int jj = 0; jj < 4; ++jj) {
      const int m = m0 + wid * 16 + fq * 4 + jj;
      const hf* op = Z + (size_t)m * 1536 + 1152 + h * 96 + fr;
      float x[6]; float s = 0.f;
#pragma unroll
      for (int n = 0; n < 6; ++n) { x[n] = sigmoidf_((float)op[n * 16]) * hs[n][jj]; s += x[n]; }
      s = rowsum16(s);
      const float mean = s * (1.f / 96.f);
      float q = 0.f;
#pragma unroll
      for (int n = 0; n < 6; ++n) { x[n] -= mean; q += x[n] * x[n]; }
      q = rowsum16(q);
      const float rsd = rsqrtf(q * (1.f / 96.f) + 1e-5f);
      const float* ng = p.in[34] + (size_t)l * 384 + h * 96 + fr;
      bf16_t* yp = p.Y + (size_t)m * 1024 + 640 + h * 96 + fr;
#pragma unroll
      for (int n = 0; n < 6; ++n) yp[n * 16] = f2bf(x[n] * rsd * ng[n * 16]);
    }
    __syncthreads();
  }
}

#define MG_YM(p) ((bf16_t*)(p).R)
#define MG_G3(p) (MG_YM(p) + (size_t)M_ALL * 1024)
__device__ __forceinline__ void ph_gates(const P& p, int l, int Mt, char* lds) {
  EPI_VARS
  bf16_t* G3 = MG_G3(p);
  const float* gbias = p.in[38] + (size_t)l * 3072;
  const int ntile = Mt * 24;
  for (int it = 0;; ++it) {
    int tm, tn; if (!tile_map(it, Mt, 24, 8, tm, tn)) break; const int m0 = tm * 128, n0 = tn * 128;
    f32x4 acc[4][4]; ZERO_ACC(acc)
    gemm_main(p.U + (size_t)m0 * 1024, 1024, p.W + W_IN + (size_t)(3216 + n0) * 1024, 1024, 1024, acc, lds);
    EPI_BEGIN(m0, n0)
      G3[(size_t)row * 3072 + col] = f2bf(sigmoidf_(val + gbias[col]));
    EPI_END
  }
}
__device__ __forceinline__ void ph_merge(const P& p, int l, int Mt, char* lds) {
  EPI_VARS
  bf16_t* YM = MG_YM(p); const bf16_t* G3 = MG_G3(p);
  const int ntile = Mt * 16;
  for (int it = 0;; ++it) {
    int tm, tn; if (!tile_map(it, Mt, 16, 8, tm, tn)) break; const int m0 = tm * 128, n0 = tn * 64;
    f32x4 yacc[4][2];
#pragma unroll
    for (int m = 0; m < 4; ++m) { yacc[m][0] = (f32x4){0.f, 0.f, 0.f, 0.f}; yacc[m][1] = (f32x4){0.f, 0.f, 0.f, 0.f}; }
#pragma unroll 1
    for (int br = 0; br < 3; ++br) {
      f32x4 acc[4][2];
#pragma unroll
      for (int m = 0; m < 4; ++m) { acc[m][0] = (f32x4){0.f, 0.f, 0.f, 0.f}; acc[m][1] = (f32x4){0.f, 0.f, 0.f, 0.f}; }
      const int kb = br == 1 ? 256 : 384; const int yoff = br == 0 ? 0 : (br == 1 ? 384 : 640);
      const int woff = br == 0 ? W_UPRW : (br == 1 ? W_UPS5 : W_UPML);
      gemm_main_t<2>(p.Y + (size_t)m0 * 1024 + yoff, 1024, p.W + woff + (size_t)n0 * kb, kb, kb, acc, lds);
      EPI_ROW_BEGIN(m0)
        const bf16_t* gp = G3 + (size_t)row * 3072 + br * 1024 + n0 + wc * 32 + fr;
#pragma unroll
        for (int n = 0; n < 2; ++n) yacc[m][n][j] += bf2f(gp[n * 16]) * acc[m][n][j];
      EPI_ROW_END
    }
    EPI_ROW_BEGIN(m0)
      bf16_t* yp = YM + (size_t)row * 1024 + n0 + wc * 32 + fr;
#pragma unroll
      for (int n = 0; n < 2; ++n) yp[n * 16] = f2bf(yacc[m][n][j]);
    EPI_ROW_END
  }
}
__device__ __forceinline__ void ph_wout(const P& p, int l, int Mt, char* lds) {
  EPI_VARS
  const bf16_t* YM = (const bf16_t*)p.R;
  const int ntile = Mt * 8;
  for (int it = 0;; ++it) {
    int tm, tn; if (!tile_map(it, Mt, 8, 8, tm, tn)) break; const int m0 = tm * 128, n0 = tn * 128;
    f32x4 acc[4][4]; ZERO_ACC(acc)
    gemm_main(YM + (size_t)m0 * 1024, 1024, p.W + W_OUT + (size_t)n0 * 1024, 1024, 1024, acc, lds);
    EPI_ROW_BEGIN(m0)
      float* sp = srow(p, row) + n0 + wc * 64 + fr; const float* gp = modp(p, l, row, 5) + n0 + wc * 64 + fr;
#pragma unroll
      for (int n = 0; n < 4; ++n) sp[n * 16] = ALPHA * sp[n * 16] + gp[n * 16] * acc[m][n][j];
    EPI_ROW_END
  }
}

#define XB_TMO      128
#define XB_XCNT(j)  (256  + 64 * (j))
#define XB_XSUB(j)  (1280 + 64 * (j))
#define XB_XGEN(j)  (2304 + 64 * (j))
#define XB_TOP      3328
#define XB_TOPGEN   3392
#define XCD_BAR_WORDS 3456
#define XB_SPIN_CAP (1u << 18)
#define LAS __attribute__((address_space(3)))

__device__ __forceinline__ unsigned xb_ld(unsigned* p)              { return __hip_atomic_load(p, __ATOMIC_RELAXED, __HIP_MEMORY_SCOPE_AGENT); }
__device__ __forceinline__ unsigned xb_add(unsigned* p, unsigned v) { return __hip_atomic_fetch_add(p, v, __ATOMIC_RELAXED, __HIP_MEMORY_SCOPE_AGENT); }
__device__ __forceinline__ unsigned xb_xcc_id() { return (unsigned)__builtin_amdgcn_s_getreg((3 << 11) | 20) & 0xFu; }
#define XB_SPIN(cond, bar) do { unsigned _sp = 0; while (cond) { __builtin_amdgcn_s_sleep(1); \
    if ((++_sp & 255u) == 0u) { if (xb_ld(&(bar)[XB_TMO])) break; if (_sp > XB_SPIN_CAP) { atomicAdd(&(bar)[XB_TMO], 1u); break; } } } } while (0)

struct XcdBarrier {
    unsigned* bar; unsigned x;
    volatile LAS unsigned* st;
};

__device__ __forceinline__ XcdBarrier xcd_barrier_post(unsigned* bar, volatile LAS unsigned* st) {
    XcdBarrier b; b.bar = bar; b.x = xb_xcc_id(); b.st = st;
    if (__builtin_amdgcn_workitem_id_x() == 0) (void)xb_add(&bar[XB_XCNT(b.x)], 1u);
    return b;
}
__device__ __forceinline__ void xcd_barrier_complete(unsigned* bar, unsigned x, unsigned& nloc, unsigned& nx) {
    const unsigned G = gridDim.x * gridDim.y * gridDim.z;
    unsigned sum, cnt, mine, sp = 0u;
    for (;;) {
        sum = 0u; cnt = 0u; mine = 0u;
#pragma unroll
        for (unsigned j = 0; j < 16; ++j) { const unsigned c = xb_ld(&bar[XB_XCNT(j)]); sum += c; cnt += (c > 0u) ? 1u : 0u; mine = (j == x) ? c : mine; }
        if (sum == G) break;
        __builtin_amdgcn_s_sleep(1);
        if ((++sp & 255u) == 0u) { if (xb_ld(&bar[XB_TMO])) break; if (sp > XB_SPIN_CAP) { atomicAdd(&bar[XB_TMO], 1u); break; } }
    }
    nloc = mine > 0u ? mine : 1u; nx = cnt > 0u ? cnt : 1u;
}

__device__ __forceinline__ void xcd_barrier(const XcdBarrier& b) {
    asm volatile("s_waitcnt vmcnt(0)" ::: "memory");
    __syncthreads();
    if (__builtin_amdgcn_workitem_id_x() == 0) {
        unsigned* bar = b.bar;
        __builtin_amdgcn_s_waitcnt(0);
        unsigned nloc = b.st[0], nx = b.st[1];
        if (nloc == 0u) { xcd_barrier_complete(bar, b.x, nloc, nx); b.st[0] = nloc; b.st[1] = nx; }
        const unsigned old = xb_add(&bar[XB_XSUB(b.x)], 1u);
        const unsigned gen = old / nloc;
        if (old + 1u == (gen + 1u) * nloc) {
            __builtin_amdgcn_fence(__ATOMIC_RELEASE, "agent");
            asm volatile("s_waitcnt vmcnt(0)" ::: "memory");
            const unsigned og = xb_add(&bar[XB_TOP], 1u);
            const unsigned tg = og / nx;
            if (og + 1u == (tg + 1u) * nx) xb_add(&bar[XB_TOPGEN], 1u);
            else XB_SPIN(xb_ld(&bar[XB_TOPGEN]) == tg, bar);
            __builtin_amdgcn_fence(__ATOMIC_ACQUIRE, "agent");
            xb_add(&bar[XB_XGEN(b.x)], 1u);
            asm volatile("s_waitcnt vmcnt(0)" ::: "memory");
        } else {
            XB_SPIN(xb_ld(&bar[XB_XGEN(b.x)]) == gen, bar);
            __builtin_amdgcn_fence(__ATOMIC_ACQUIRE, "agent");
            asm volatile("s_waitcnt vmcnt(0)" ::: "memory");
        }
    }
    __syncthreads();
}


#define SYNC xcd_barrier(xb); asm volatile("" : "+s"(l));
__global__ void __launch_bounds__(NTHR, 2) mega(P pv) {
#define p pv
  __shared__ __attribute__((aligned(16))) char lds[LDS_BYTES];
  __shared__ uint4 xb_words;
  cg::grid_group grid = cg::this_grid();
  {
    const int t0 = __builtin_amdgcn_workitem_id_x();
    if (blockIdx.x == 0) for (int i = t0; i < 4096; i += NTHR) pv.bar[i] = 0u;
    if (t0 == 0) xb_words = make_uint4(0u, 0u, 0u, 0u);
    __threadfence();
    grid.sync();
  }
  XcdBarrier xb = xcd_barrier_post(pv.bar, (volatile LAS unsigned*)&xb_words);
  for (int l = 0; l < 2; ++l) {
    const bool last = (l == 1);
    const int Mt2 = last ? 256 : 264;
    const int Mr2 = last ? M_LAT : M_ALL;
    ph_convert(p, l, l == 0, lds); SYNC
    if (l == 0) { ph_rows(p, 0, 0, 0, M_ALL, true, 0, 0); SYNC }
    ph_ffn_up(p, 0, 264, lds); SYNC
    ph_ffn_down(p, l, 0, 264, lds); SYNC
    ph_rows(p, 1, l, 0, M_ALL, true, l, 3); SYNC
    ph_z_rw(p, lds); SYNC
    ph_conv(p, l, 0); SYNC
    ph_lora(p, l, lds); SYNC
    {
      const int ns = gridDim.x >= 384 ? 192 : 0;
      if (ns == 0 || blockIdx.x < 192) ph_rwscan(p, lds);
      if (ns == 0) { SYNC }
      if ((int)blockIdx.x >= ns) ph_s5_stage(p, l, lds, (int)blockIdx.x - ns, (int)gridDim.x - ns);
      SYNC
    }
    ph_rwpost(p, l); SYNC
    ph_z_ml(p, lds); SYNC
    ph_conv(p, l, 1); SYNC
    ph_ml_a(p, l, lds); SYNC
    ph_ml_b(p); SYNC
    ph_ml_c(p, l, lds); SYNC
    ph_gates(p, l, Mt2, lds); SYNC
    ph_merge(p, l, Mt2, lds); SYNC
    ph_wout(p, l, Mt2, lds); SYNC
    ph_rows(p, 1, l, 1, Mr2, true, l, 6); SYNC
    ph_ffn_up(p, 1, Mt2, lds); SYNC
    ph_ffn_down(p, l, 1, Mt2, lds); SYNC
    ph_rows(p, 1, l, 2, Mr2, !last, l + 1, 0);
    if (!last) { SYNC }
  }
#undef p
}

extern "C" void kernel_launch(void* const* d_in, const int* in_sizes, int n_in, void* d_out, int out_size, void* d_ws, size_t ws_size,
                              hipStream_t stream) {
  static int grid_blocks = 0;
  if (!grid_blocks) {
    int dev = 0, cus = 0, per_cu = 0;
    hipGetDevice(&dev);
    hipDeviceGetAttribute(&cus, hipDeviceAttributeMultiprocessorCount, dev);
    hipOccupancyMaxActiveBlocksPerMultiprocessor(&per_cu, mega, NTHR, 0);
    if (per_cu > 2) per_cu = 2;
    grid_blocks = cus * per_cu;
  }
  P p{};
  for (int i = 0; i < 40; ++i) p.in[i] = (const float*)d_in[i];
  char* ws = (char*)d_ws;
  size_t off = 0;
  p.W = (bf16_t*)(ws + off); off += (size_t)W_TOTAL * 2;
  p.mod = (float*)(ws + off); off += (size_t)2 * 5 * 9216 * 4;
  p.sctx = (float*)(ws + off); off += (size_t)1024 * 1024 * 4;
  p.bar = (unsigned*)(ws + off); off += (size_t)16384;
  p.U = (bf16_t*)(ws + off); off += (size_t)M_ALL * 1024 * 2;
  p.Y = (bf16_t*)(ws + off); off += (size_t)M_ALL * 1024 * 2;
  p.R = ws + off;
  p.out = (float*)d_out;
  if (off + (size_t)M_ALL * 9728 > ws_size) fprintf(stderr, "workspace too small: need %zu have %zu\n", off + (size_t)M_ALL * 9728, ws_size);
  void* args[] = {&p};
  hipError_t e = hipLaunchCooperativeKernel((void*)mega, dim3(grid_blocks), dim3(NTHR), args, 0, stream);
  if (e != hipSuccess) fprintf(stderr, "cooperative launch failed: %s (grid %d)\n", hipGetErrorString(e), grid_blocks);
}
```

```cpp
#include <hip/hip_runtime.h>
#include <hip/hip_cooperative_groups.h>
#include <cstdio>
namespace cg = cooperative_groups;

typedef unsigned short bf16_t;
typedef _Float16 hf;
typedef hf hf4 __attribute__((ext_vector_type(4)));
typedef hf hf8 __attribute__((ext_vector_type(8)));
typedef __attribute__((ext_vector_type(8))) short bf16x8;
typedef __attribute__((ext_vector_type(4))) float f32x4;
typedef unsigned int u32x4 __attribute__((ext_vector_type(4)));

#define M_LAT 32768
#define M_ALL 33792
#define NTHR 256
#define LDS_BYTES 73728
#define ALPHA 1.41421356237f

#define W_GU0 0
#define W_D0 5767168
#define W_GU1 8650752
#define W_D1 14417920
#define W_IN 17301504
#define W_WUP0 23740416
#define W_WUP1 23764992
#define W_AUP0 23789568
#define W_AUP1 23814144
#define W_GUP 23838720
#define W_GLU 23887872
#define W_UPRW 23953408
#define W_UPS5 24346624
#define W_UPML 24608768
#define W_OUT 25001984
#define W_TOTAL 26050560

struct P {
  const float* in[40];
  float* out; float* sctx; float* mod;
  bf16_t* U; bf16_t* Y; bf16_t* W; char* R; unsigned* bar;
};

__device__ __forceinline__ int get_tid() { int t = __builtin_amdgcn_workitem_id_x(); asm volatile("" : "+v"(t)); return t; }
__device__ __forceinline__ bf16_t f2bf(float f) { return __builtin_bit_cast(unsigned short, (_Float16)f); }
__device__ __forceinline__ float bf2f(bf16_t h) { return (float)__builtin_bit_cast(_Float16, h); }
__device__ __forceinline__ float sigmoidf_(float x) { return 1.f / (1.f + __expf(-x)); }
__device__ __forceinline__ float siluf_(float x) { return x / (1.f + __expf(-x)); }
__device__ __forceinline__ float* srow(const P& p, int m) { return m < M_LAT ? p.out + (size_t)m * 1024 : p.sctx + (size_t)(m - M_LAT) * 1024; }
__device__ __forceinline__ const float* modp(const P& p, int l, int m, int k) { int mv = m < M_LAT ? (m >> 13) : 4; return p.mod + (size_t)(l * 5 + mv) * 9216 + k * 1024; }
template <int C> __device__ __forceinline__ float dppf(float x) { return __int_as_float(__builtin_amdgcn_update_dpp(0, __float_as_int(x), C, 0xf, 0xf, false)); }
__device__ __forceinline__ float rowsum16(float x) { x += dppf<0x128>(x); x += dppf<0x124>(x); x += dppf<0x122>(x); x += dppf<0x121>(x); return x; }
__device__ __forceinline__ float wavesum(float x) { for (int o = 32; o > 0; o >>= 1) x += __shfl_xor(x, o); return x; }

template <int NB>
__device__ __forceinline__ void gemm_main_t(const bf16_t* __restrict__ A, int lda, const bf16_t* __restrict__ B, int ldb, int K,
                                          f32x4 (&acc)[4][NB], char* lds) {
  const int tid = get_tid(), lane = tid & 63, wid = tid >> 6, wr = wid >> 1, wc = wid & 1;
  const int fr = lane & 15, fq = lane >> 4;
  const int sr = tid >> 3, skc = tid & 7;
  const bf16_t* ga = A + (size_t)sr * lda + skc * 8;
  const bf16_t* gb = B + (size_t)sr * ldb + skc * 8;
  u32x4 ra0[4], rb0[NB], ra1[4], rb1[NB];
  const int soff = sr * 144 + skc * 16;
  const int nk = K >> 6;
  const int aoff = (wr * 64 + fr) * 144 + fq * 16;
  const int boff = 18432 + (wc * (NB * 16) + fr) * 144 + fq * 16;
#define G_LOAD(RA, RB, kt) { _Pragma("unroll") for (int i = 0; i < 4; ++i) { RA[i] = *(const u32x4*)(ga + (size_t)(i * 32) * lda + (kt) * 64); if (i < NB) RB[i] = *(const u32x4*)(gb + (size_t)(i * 32) * ldb + (kt) * 64); } }
#define G_STORE(RA, RB, buf) { char* d_ = lds + (buf) * 36864 + soff; _Pragma("unroll") for (int i = 0; i < 4; ++i) { *(u32x4*)(d_ + i * 32 * 144) = RA[i]; if (i < NB) *(u32x4*)(d_ + 18432 + i * 32 * 144) = RB[i]; } }
#define G_COMP(buf) { const char* cur = lds + (buf) * 36864; _Pragma("unroll") for (int ks = 0; ks < 2; ++ks) { hf8 af[4], bfr[NB]; \
    _Pragma("unroll") for (int m = 0; m < 4; ++m) af[m] = *(const hf8*)(cur + aoff + m * 16 * 144 + ks * 64); \
    _Pragma("unroll") for (int n = 0; n < NB; ++n) bfr[n] = *(const hf8*)(cur + boff + n * 16 * 144 + ks * 64); \
    _Pragma("unroll") for (int m = 0; m < 4; ++m) _Pragma("unroll") for (int n = 0; n < NB; ++n) acc[m][n] = __builtin_amdgcn_mfma_f32_16x16x32_f16(af[m], bfr[n], acc[m][n], 0, 0, 0); } }
  G_LOAD(ra0, rb0, 0)
  { const int k1 = nk > 1 ? 1 : 0; G_LOAD(ra1, rb1, k1) }
  G_STORE(ra0, rb0, 0)
  __syncthreads();
  for (int kt = 0; kt < nk; kt += 2) {
    { const int k2 = kt + 2 < nk ? kt + 2 : nk - 1; G_LOAD(ra0, rb0, k2) }
    G_COMP(0)
    G_STORE(ra1, rb1, 1)
    __syncthreads();
    { const int k3 = kt + 3 < nk ? kt + 3 : nk - 1; G_LOAD(ra1, rb1, k3) }
    if (kt + 1 < nk) G_COMP(1)
    G_STORE(ra0, rb0, 0)
    __syncthreads();
  }
}
__device__ __forceinline__ void gemm_main(const bf16_t* __restrict__ A, int lda, const bf16_t* __restrict__ B, int ldb, int K, f32x4 (&acc)[4][4], char* lds) {
  gemm_main_t<4>(A, lda, B, ldb, K, acc, lds);
}

template <int SM>
__device__ __forceinline__ bool tile_map_sm(int b, int nb, int it, int Mt, int Nt, int SN, int& tm, int& tn) {
  const int xcd = b & 7, li = b >> 3, nloc = nb >> 3;
  const int T = SM * SN; const int nsn = Nt / SN; const int nsuper = (Mt / SM) * nsn;
  const int o = li + it * nloc; const int k = o / T, w = o - k * T;
  const int s = xcd + 8 * k;
  if (s >= nsuper) return false;
  const int sm = s / nsn, sn = s - sm * nsn;
  tm = sm * SM + (w % SM); tn = sn * SN + (w / SM);
  return true;
}
__device__ __forceinline__ bool tile_map_v(int b, int nb, int it, int Mt, int Nt, int SN, int& tm, int& tn) {
  const int nsn = Nt / SN;
  if (nsn * (Mt >> 3) % 8 == 0 || nsn >= 8) return tile_map_sm<8>(b, nb, it, Mt, Nt, SN, tm, tn);
  return tile_map_sm<1>(b, nb, it, Mt, Nt, SN, tm, tn);
}
__device__ __forceinline__ bool tile_map(int it, int Mt, int Nt, int SN, int& tm, int& tn) { return tile_map_v(blockIdx.x, gridDim.x, it, Mt, Nt, SN, tm, tn); }
#define ZERO_ACC(a) _Pragma("unroll") for (int m_ = 0; m_ < 4; ++m_) _Pragma("unroll") for (int n_ = 0; n_ < 4; ++n_) a[m_][n_] = (f32x4){0.f, 0.f, 0.f, 0.f};
#define EPI_VARS const int tid = get_tid(), lane = tid & 63, wid = tid >> 6, wr = wid >> 1, wc = wid & 1, fr = lane & 15, fq = lane >> 4; (void)wr; (void)wc; (void)fr; (void)fq;
#define EPI_ROW_BEGIN(m0) _Pragma("unroll") for (int m = 0; m < 4; ++m) _Pragma("unroll") for (int j = 0; j < 4; ++j) { const int row = (m0) + wr * 64 + m * 16 + fq * 4 + j; (void)row;
#define EPI_COL_BEGIN(n0) _Pragma("unroll") for (int n = 0; n < 4; ++n) { const int col = (n0) + wc * 64 + n * 16 + fr; const float val = acc[m][n][j]; (void)col; (void)val;
#define EPI_COL_END }
#define EPI_ROW_END }
#define EPI_BEGIN(m0, n0) EPI_ROW_BEGIN(m0) EPI_COL_BEGIN(n0)
#define EPI_END } }

struct Job { const float* src; int K, N; int dst; int mode; };
__device__ __forceinline__ Job get_job(const P& p, int l, int j) {
  Job r; r.mode = 0;
  switch (j) {
    case 0: r.src = p.in[8] + (size_t)(l * 2 + 0) * 1024 * 2816; r.K = 1024; r.N = 2816; r.dst = W_GU0; r.mode = 1; break;
    case 1: r.src = p.in[9] + (size_t)(l * 2 + 0) * 1024 * 2816; r.K = 1024; r.N = 2816; r.dst = W_GU0; r.mode = 2; break;
    case 2: r.src = p.in[10] + (size_t)(l * 2 + 0) * 2816 * 1024; r.K = 2816; r.N = 1024; r.dst = W_D0; break;
    case 3: r.src = p.in[8] + (size_t)(l * 2 + 1) * 1024 * 2816; r.K = 1024; r.N = 2816; r.dst = W_GU1; r.mode = 1; break;
    case 4: r.src = p.in[9] + (size_t)(l * 2 + 1) * 1024 * 2816; r.K = 1024; r.N = 2816; r.dst = W_GU1; r.mode = 2; break;
    case 5: r.src = p.in[10] + (size_t)(l * 2 + 1) * 2816 * 1024; r.K = 2816; r.N = 1024; r.dst = W_D1; break;
    case 6: r.src = p.in[11] + (size_t)l * 1024 * 6288; r.K = 1024; r.N = 6288; r.dst = W_IN; break;
    case 7: r.src = p.in[14] + (size_t)(l * 2 + 0) * 64 * 384; r.K = 64; r.N = 384; r.dst = W_WUP0; break;
    case 8: r.src = p.in[14] + (size_t)(l * 2 + 1) * 64 * 384; r.K = 64; r.N = 384; r.dst = W_WUP1; break;
    case 9: r.src = p.in[16] + (size_t)(l * 2 + 0) * 64 * 384; r.K = 64; r.N = 384; r.dst = W_AUP0; break;
    case 10: r.src = p.in[16] + (size_t)(l * 2 + 1) * 64 * 384; r.K = 64; r.N = 384; r.dst = W_AUP1; break;
    case 11: r.src = p.in[17] + (size_t)l * 128 * 384; r.K = 128; r.N = 384; r.dst = W_GUP; break;
    case 12: r.src = p.in[31] + (size_t)l * 256 * 256; r.K = 256; r.N = 256; r.dst = W_GLU; break;
    case 13: r.src = p.in[35] + (size_t)l * 384 * 1024; r.K = 384; r.N = 1024; r.dst = W_UPRW; break;
    case 14: r.src = p.in[36] + (size_t)l * 256 * 1024; r.K = 256; r.N = 1024; r.dst = W_UPS5; break;
    case 15: r.src = p.in[37] + (size_t)l * 384 * 1024; r.K = 384; r.N = 1024; r.dst = W_UPML; break;
    default: r.src = p.in[39] + (size_t)l * 1024 * 1024; r.K = 1024; r.N = 1024; r.dst = W_OUT; break;
  }
  return r;
}
#define NJOBS 17
__device__ void mod_task(const P& p, int t, char* lds) {
  float* sc = (float*)lds;
  float* red = sc + 5 * 1024;
  const int tid = get_tid();
  for (int i = tid; i < 5 * 1024; i += NTHR) {
    int v = i >> 10, k = i & 1023;
    float c = v < 4 ? p.in[1][v * 1024 + k] : p.in[3][k];
    sc[i] = siluf_(c);
  }
  __syncthreads();
  const int c0 = t * 64; const int l = c0 / 9216; const int j0 = c0 % 9216;
  const int col = tid & 63, part = tid >> 6;
  const float* w = p.in[4] + ((size_t)l * 1024 + part * 256) * 9216 + j0 + col;
  float a0 = 0, a1 = 0, a2 = 0, a3 = 0, a4 = 0;
  const float* s = sc + part * 256;
#pragma unroll 8
  for (int i = 0; i < 256; ++i) {
    float wv = w[(size_t)i * 9216];
    a0 += s[i] * wv; a1 += s[1024 + i] * wv; a2 += s[2048 + i] * wv; a3 += s[3072 + i] * wv; a4 += s[4096 + i] * wv;
  }
  red[(part * 5 + 0) * 64 + col] = a0; red[(part * 5 + 1) * 64 + col] = a1; red[(part * 5 + 2) * 64 + col] = a2;
  red[(part * 5 + 3) * 64 + col] = a3; red[(part * 5 + 4) * 64 + col] = a4;
  __syncthreads();
  for (int i = tid; i < 320; i += NTHR) {
    int v = i >> 6, c = i & 63;
    float sum = red[(0 * 5 + v) * 64 + c] + red[(1 * 5 + v) * 64 + c] + red[(2 * 5 + v) * 64 + c] + red[(3 * 5 + v) * 64 + c];
    p.mod[(size_t)(l * 5 + v) * 9216 + j0 + c] = sum + p.in[5][(size_t)l * 9216 + j0 + c];
  }
  __syncthreads();
}
__device__ __forceinline__ void ph_convert(const P& p, int l, bool with_mod, char* lds) {
  const int tid = get_tid();
  int ntiles[NJOBS]; int total = 0;
#pragma unroll
  for (int j = 0; j < NJOBS; ++j) { Job jb = get_job(p, l, j); ntiles[j] = (jb.K >> 6) * ((jb.N + 63) >> 6); total += ntiles[j]; }
  const int nmod = with_mod ? 288 : 0;
  float* tile = (float*)lds;
  for (int t = blockIdx.x; t < total + nmod; t += gridDim.x) {
    if (t < nmod) { mod_task(p, t, lds); continue; }
    int tt = t - nmod; int j = 0;
#pragma unroll
    for (int q = 0; q < NJOBS; ++q) { if (j == q && tt >= ntiles[q]) { tt -= ntiles[q]; j = q + 1; } }
    Job jb = get_job(p, l, j);
    const int nkt = jb.K >> 6;
    const int k0 = (tt % nkt) * 64, n0 = (tt / nkt) * 64;
    {
      const int c = tid & 63, r0 = tid >> 6;
      const bool ok = (n0 + c) < jb.N;
#pragma unroll
      for (int i = 0; i < 16; ++i) { int r = r0 + i * 4; tile[r * 65 + c] = ok ? jb.src[(size_t)(k0 + r) * jb.N + n0 + c] : 0.f; }
    }
    __syncthreads();
    {
      const int nn = tid >> 2, q = tid & 3; const int n = n0 + nn;
      if (n < jb.N) {
        int drow = n;
        if (jb.mode == 1) drow = (n >> 5) * 64 + (n & 31);
        else if (jb.mode == 2) drow = (n >> 5) * 64 + 32 + (n & 31);
        bf16_t* d = p.W + jb.dst + (size_t)drow * jb.K + k0 + q * 16;
        unsigned pk[8];
#pragma unroll
        for (int i = 0; i < 8; ++i) { unsigned lo = f2bf(tile[(q * 16 + 2 * i) * 65 + nn]); unsigned hi = f2bf(tile[(q * 16 + 2 * i + 1) * 65 + nn]); pk[i] = lo | (hi << 16); }
        *(uint4*)d = make_uint4(pk[0], pk[1], pk[2], pk[3]);
        *(uint4*)(d + 8) = make_uint4(pk[4], pk[5], pk[6], pk[7]);
      }
    }
    __syncthreads();
  }
}

__device__ __forceinline__ void ph_rows(const P& p, int mode, int l, int ln_idx, int Mrows, bool writeU, int ul, int ks) {
  const int lane = get_tid() & 63, wid = get_tid() >> 6;
  const int nw = gridDim.x * 4;
  const float* g = p.in[6] + (size_t)(l * 3 + ln_idx) * 1024;
  const float* b = p.in[7] + (size_t)(l * 3 + ln_idx) * 1024;
  for (int m = blockIdx.x * 4 + wid; m < Mrows; m += nw) {
    float* s = srow(p, m);
    const float* src = s;
    if (mode == 0) src = m < M_LAT ? p.in[0] + (size_t)m * 1024 : p.in[2] + (size_t)(m - M_LAT) * 1024;
    float4 v[4];
#pragma unroll
    for (int i = 0; i < 4; ++i) v[i] = *(const float4*)(src + lane * 4 + i * 256);
    if (mode == 1) {
      float sum = 0;
#pragma unroll
      for (int i = 0; i < 4; ++i) sum += v[i].x + v[i].y + v[i].z + v[i].w;
      sum = wavesum(sum);
      const float mean = sum * (1.f / 1024.f);
      float sq = 0;
#pragma unroll
      for (int i = 0; i < 4; ++i) { v[i].x -= mean; v[i].y -= mean; v[i].z -= mean; v[i].w -= mean; sq += v[i].x * v[i].x + v[i].y * v[i].y + v[i].z * v[i].z + v[i].w * v[i].w; }
      sq = wavesum(sq);
      const float rstd = rsqrtf(sq * (1.f / 1024.f) + 1e-5f);
#pragma unroll
      for (int i = 0; i < 4; ++i) {
        float4 gg = *(const float4*)(g + lane * 4 + i * 256), bb = *(const float4*)(b + lane * 4 + i * 256);
        v[i].x = v[i].x * rstd * gg.x + bb.x; v[i].y = v[i].y * rstd * gg.y + bb.y; v[i].z = v[i].z * rstd * gg.z + bb.z; v[i].w = v[i].w * rstd * gg.w + bb.w;
      }
    }
#pragma unroll
    for (int i = 0; i < 4; ++i) *(float4*)(s + lane * 4 + i * 256) = v[i];
    if (writeU) {
      const float* sh = modp(p, ul, m, ks); const float* scl = modp(p, ul, m, ks + 1);
#pragma unroll
      for (int i = 0; i < 4; ++i) {
        float4 a = *(const float4*)(sh + lane * 4 + i * 256), c = *(const float4*)(scl + lane * 4 + i * 256);
        unsigned lo = f2bf(v[i].x * (1.f + c.x) + a.x) | ((unsigned)f2bf(v[i].y * (1.f + c.y) + a.y) << 16);
        unsigned hi = f2bf(v[i].z * (1.f + c.z) + a.z) | ((unsigned)f2bf(v[i].w * (1.f + c.w) + a.w) << 16);
        *(uint2*)(p.U + (size_t)m * 1024 + lane * 4 + i * 256) = make_uint2(lo, hi);
      }
    }
  }
}

__device__ __forceinline__ void ph_ffn_up(const P& p, int s, int Mt, char* lds) {
  EPI_VARS
  bf16_t* HM = (bf16_t*)p.R;
  const bf16_t* Wt = p.W + (s ? W_GU1 : W_GU0);
  const int ntile = Mt * 44;
  for (int it = 0;; ++it) {
    int tm, tn; if (!tile_map(it, Mt, 44, 4, tm, tn)) break; const int m0 = tm * 128, n0 = tn * 128;
    f32x4 acc[4][4]; ZERO_ACC(acc)
    gemm_main(p.U + (size_t)m0 * 1024, 1024, Wt + (size_t)n0 * 1024, 1024, 1024, acc, lds);
    const int hb = ((n0 + wc * 64) >> 6) * 32;
#pragma unroll
    for (int m = 0; m < 4; ++m)
#pragma unroll
      for (int n = 0; n < 2; ++n)
#pragma unroll
        for (int j = 0; j < 4; ++j) {
          const int row = m0 + wr * 64 + m * 16 + fq * 4 + j; const int hc = hb + n * 16 + fr;
          HM[(size_t)row * 2816 + hc] = f2bf(siluf_(acc[m][n][j]) * acc[m][n + 2][j]);
        }
  }
}
__device__ __forceinline__ void ph_ffn_down(const P& p, int l, int s, int Mt, char* lds) {
  EPI_VARS
  const bf16_t* HM = (const bf16_t*)p.R;
  const bf16_t* Wt = p.W + (s ? W_D1 : W_D0);
  const int gk = s ? 8 : 2;
  const int ntile = Mt * 8;
  for (int it = 0;; ++it) {
    int tm, tn; if (!tile_map(it, Mt, 8, 8, tm, tn)) break; const int m0 = tm * 128, n0 = tn * 128;
    f32x4 acc[4][4]; ZERO_ACC(acc)
    gemm_main(HM + (size_t)m0 * 2816, 2816, Wt + (size_t)n0 * 2816, 2816, 2816, acc, lds);
    EPI_ROW_BEGIN(m0)
      float* sp = srow(p, row) + n0 + wc * 64 + fr; const float* gp = modp(p, l, row, gk) + n0 + wc * 64 + fr;
#pragma unroll
      for (int n = 0; n < 4; ++n) sp[n * 16] = ALPHA * sp[n * 16] + 0.5f * gp[n * 16] * acc[m][n][j];
    EPI_ROW_END
  }
}

#define RW_ZRW(p) ((hf*)(p).R)
#define RW_RKV(p) (RW_ZRW(p) + (size_t)M_ALL * 1152)
#define RW_LA(p) ((bf16_t*)(RW_RKV(p) + (size_t)M_ALL * 1152))
#define RW_KK(p) ((hf*)(RW_LA(p) + (size_t)M_ALL * 256))
#define RW_KD(p) (RW_KK(p) + (size_t)M_ALL * 384)
#define RW_KA(p) (RW_KD(p) + (size_t)2 * M_ALL * 384)
#define RW_YR(p) (RW_KA(p) + (size_t)2 * M_ALL * 384)

#define S5_ZH(p) ((hf*)RW_LA(p))
#define S5_YG(p) ((p).W + W_GU0)
#define S5_E(p) ((float2*)((p).R + (size_t)M_ALL * 9728))
#define S5_X(p) S5_E(p)

#define ML_Z(p) ((hf*)(p).R)
#define ML_GL(p) ((float*)(ML_Z(p) + (size_t)M_ALL * 1536))
#define ML_QK(p) ((hf*)(ML_GL(p) + (size_t)M_ALL * 16))
#define ML_DC(p) ((float*)(ML_QK(p) + (size_t)M_ALL * 768))
#define ML_DN(p) (ML_DC(p) + (size_t)4224 * 9216)
#define ML_SC(p) (ML_DN(p) + (size_t)4224 * 96)
#define ML_MP(p) (ML_SC(p) + (size_t)4224 * 2)

__device__ __forceinline__ void ph_z_rw(const P& p, char* lds) {
  EPI_VARS
  hf* ZRW = RW_ZRW(p); bf16_t* LA = RW_LA(p);
  const int Mt = 264; const int ntile = Mt * 11;
  for (int it = 0;; ++it) {
    int tm, tn; if (!tile_map(it, Mt, 11, 11, tm, tn)) break; const int m0 = tm * 128;
    const int wrow = tn < 9 ? tn * 128 : 2960 + (tn - 9) * 128;
    f32x4 acc[4][4]; ZERO_ACC(acc)
    gemm_main(p.U + (size_t)m0 * 1024, 1024, p.W + W_IN + (size_t)wrow * 1024, 1024, 1024, acc, lds);
    if (tn < 9) {
      EPI_BEGIN(m0, tn * 128)
        ZRW[(size_t)row * 1152 + col] = (hf)val;
      EPI_END
    } else {
      EPI_BEGIN(m0, (tn - 9) * 128)
        float o = col < 64 ? tanhf(val) : (col < 128 ? val : sigmoidf_(val));
        LA[(size_t)row * 256 + col] = f2bf(o);
      EPI_END
    }
  }
}
__device__ __forceinline__ void ph_z_s5(const P& p, char* lds, int vb, int nvb) {
  EPI_VARS
  hf* Z = S5_ZH(p);
  const int Mt = 264;
  for (int it = 0;; ++it) {
    int tm, tn; if (!tile_map_v(vb, nvb, it, Mt, 2, 2, tm, tn)) break; const int m0 = tm * 128;
    f32x4 acc[4][4]; ZERO_ACC(acc)
    gemm_main(p.U + (size_t)m0 * 1024, 1024, p.W + W_IN + (size_t)(2704 + tn * 128) * 1024, 1024, 1024, acc, lds);
    EPI_BEGIN(m0, tn * 128)
      Z[(size_t)row * 256 + col] = (hf)val;
    EPI_END
  }
}
__device__ __forceinline__ void ph_z_ml(const P& p, char* lds) {
  EPI_VARS
  hf* Z = ML_Z(p); float* GL = ML_GL(p);
  const int Mt = 264; const int ntile = Mt * 13;
  for (int it = 0;; ++it) {
    int tm, tn; if (!tile_map(it, Mt, 13, 13, tm, tn)) break; const int m0 = tm * 128;
    f32x4 acc[4][4]; ZERO_ACC(acc)
    gemm_main(p.U + (size_t)m0 * 1024, 1024, p.W + W_IN + (size_t)(1152 + tn * 128) * 1024, 1024, 1024, acc, lds);
    if (tn < 12) {
      EPI_BEGIN(m0, tn * 128)
        Z[(size_t)row * 1536 + col] = (hf)val;
      EPI_END
    } else {
      EPI_BEGIN(m0, 0)
        if (col < 16) GL[(size_t)row * 16 + col] = val;
      EPI_END
    }
  }
}

__device__ __forceinline__ void ph_conv(const P& p, int l, int which) {
  const int nch = which == 0 ? 144 : 96;
  const int ldin = which == 0 ? 1152 : 1536;
  const hf* Zin = which == 0 ? RW_ZRW(p) : ML_Z(p);
  const int cbase = which == 0 ? 0 : 1152;
  const float* cw = p.in[12] + (size_t)l * 9 * 1920;
  const size_t total = (size_t)M_ALL * nch;
  for (size_t idx = (size_t)blockIdx.x * NTHR + get_tid(); idx < (total + 63) / 64 * 64; idx += (size_t)gridDim.x * NTHR) {
    const bool act = idx < total;
    const int m = act ? (int)(idx / nch) : 0; const int ch = act ? (int)(idx % nch) : 0; const int c0 = ch * 8;
    float o[8];
#pragma unroll
    for (int i = 0; i < 8; ++i) o[i] = 0.f;
    if (m < M_LAT) {
      const int bb = m >> 13, tt = m & 8191, gr = tt >> 6, gc = tt & 63;
#pragma unroll
      for (int dr = -1; dr <= 1; ++dr)
#pragma unroll
        for (int dc = -1; dc <= 1; ++dc) {
          const int rr = gr + dr, cc = gc + dc;
          if (rr >= 0 && rr < 128 && cc >= 0 && cc < 64) {
            const int mm = (bb << 13) + rr * 64 + cc;
            hf8 z = *(const hf8*)(Zin + (size_t)mm * ldin + c0);
            const float* w = cw + ((dr + 1) * 3 + (dc + 1)) * 1920 + cbase + c0;
            float4 w0 = *(const float4*)w, w1 = *(const float4*)(w + 4);
            o[0] += (float)z[0] * w0.x; o[1] += (float)z[1] * w0.y; o[2] += (float)z[2] * w0.z; o[3] += (float)z[3] * w0.w;
            o[4] += (float)z[4] * w1.x; o[5] += (float)z[5] * w1.y; o[6] += (float)z[6] * w1.z; o[7] += (float)z[7] * w1.w;
          }
        }
    } else {
      const int tt = (m - M_LAT) & 255;
#pragma unroll
      for (int dc = -1; dc <= 1; ++dc) {
        const int t2 = tt + dc;
        if (t2 >= 0 && t2 < 256) {
          hf8 z = *(const hf8*)(Zin + (size_t)(m + dc) * ldin + c0);
          const float* w = cw + (3 + (dc + 1)) * 1920 + cbase + c0;
          float4 w0 = *(const float4*)w, w1 = *(const float4*)(w + 4);
          o[0] += (float)z[0] * w0.x; o[1] += (float)z[1] * w0.y; o[2] += (float)z[2] * w0.z; o[3] += (float)z[3] * w0.w;
          o[4] += (float)z[4] * w1.x; o[5] += (float)z[5] * w1.y; o[6] += (float)z[6] * w1.z; o[7] += (float)z[7] * w1.w;
        }
      }
    }
    if (which == 0) {
      const bool isk = act && (c0 >= 384) && (c0 < 768);
      float kkv[8]; float ss = 0.f;
      if (isk) {
        const float* kkw = p.in[18] + (size_t)l * 384 + (c0 - 384);
#pragma unroll
        for (int i = 0; i < 8; ++i) { kkv[i] = o[i] * kkw[i]; ss += kkv[i] * kkv[i]; }
      } else {
#pragma unroll
        for (int i = 0; i < 8; ++i) kkv[i] = 0.f;
      }
      ss += __shfl_xor(ss, 1); ss += __shfl_xor(ss, 2); ss += __shfl_xor(ss, 4);
      if (act) {
        hf8 ov;
#pragma unroll
        for (int i = 0; i < 8; ++i) ov[i] = (hf)o[i];
        *(hf8*)(RW_RKV(p) + (size_t)m * 1152 + c0) = ov;
        if (isk) {
          const float rn = rsqrtf(fmaxf(ss, 1e-24f));
          hf8 kv;
#pragma unroll
          for (int i = 0; i < 8; ++i) kv[i] = (hf)(kkv[i] * rn);
          *(hf8*)(RW_KK(p) + (size_t)m * 384 + (c0 - 384)) = kv;
        }
      }
    } else if (act) {
      const float sc = c0 >= 384 ? 0.10206207261596575f : 1.f;
      hf8 ov;
#pragma unroll
      for (int i = 0; i < 8; ++i) ov[i] = (hf)(siluf_(o[i]) * sc);
      *(hf8*)(ML_QK(p) + (size_t)m * 768 + c0) = ov;
    }
  }
}

__device__ __forceinline__ void ph_lora(const P& p, int l, char* lds) {
  EPI_VARS
  hf* ZRW = RW_ZRW(p); const hf* RKV = RW_RKV(p); const bf16_t* LA = RW_LA(p); const hf* KK = RW_KK(p);
  hf* KD = RW_KD(p); hf* KA = RW_KA(p);
  const int Mt = 264; const int ntile = Mt * 15;
  for (int it = 0;; ++it) {
    int tm, q; if (!tile_map(it, Mt, 15, 15, tm, q)) break; const int job = q / 3, tn = q % 3; const int m0 = tm * 128, n0 = tn * 128;
    f32x4 acc[4][4]; ZERO_ACC(acc)
    if (job < 2) {
      const int d = job;
      gemm_main(LA + (size_t)m0 * 256, 256, p.W + (d ? W_WUP1 : W_WUP0) + (size_t)n0 * 64, 64, 64, acc, lds);
      const float* w0 = p.in[13] + (size_t)(l * 2 + d) * 384;
      EPI_BEGIN(m0, n0)
        const float e = sigmoidf_(w0[col] + val) * 0.6065306597126334f;
        ZRW[(size_t)row * 1152 + d * 384 + col] = (hf)(-expm1f(-e));
      EPI_END
    } else if (job < 4) {
      const int d = job - 2;
      gemm_main(LA + (size_t)m0 * 256 + 64, 256, p.W + (d ? W_AUP1 : W_AUP0) + (size_t)n0 * 64, 64, 64, acc, lds);
      const float* a0 = p.in[15] + (size_t)(l * 2 + d) * 384; const float* kaw = p.in[19] + (size_t)l * 384;
      EPI_ROW_BEGIN(m0)
        const int cb = n0 + wc * 64 + fr;
        const hf* kp = RKV + (size_t)row * 1152 + 384 + cb; const hf* kkp = KK + (size_t)row * 384 + cb;
        hf* kdp = KD + ((size_t)d * M_ALL + row) * 384 + cb; hf* kap = KA + ((size_t)d * M_ALL + row) * 384 + cb;
#pragma unroll
        for (int n = 0; n < 4; ++n) {
          const float a = sigmoidf_(a0[cb + n * 16] + acc[m][n][j]);
          kdp[n * 16] = (hf)((float)kp[n * 16] * (1.f + (a - 1.f) * kaw[cb + n * 16]));
          kap[n * 16] = (hf)((float)kkp[n * 16] * a);
        }
      EPI_ROW_END
    } else {
      gemm_main(LA + (size_t)m0 * 256 + 128, 256, p.W + W_GUP + (size_t)n0 * 128, 128, 128, acc, lds);
      EPI_BEGIN(m0, n0)
        ZRW[(size_t)row * 1152 + 768 + col] = (hf)val;
      EPI_END
    }
  }
}

typedef float f32x2 __attribute__((ext_vector_type(2)));
#define RW_CH 16
#define RW_BUF 21504
__device__ __forceinline__ void rw_cvt_store(char* dst, uint4 q) {
  const hf8 h = __builtin_bit_cast(hf8, q);
  f32x4 a, b;
  a[0] = (float)h[0]; a[1] = (float)h[1]; a[2] = (float)h[2]; a[3] = (float)h[3];
  b[0] = (float)h[4]; b[1] = (float)h[5]; b[2] = (float)h[6]; b[3] = (float)h[7];
  *(f32x4*)dst = a; *(f32x4*)(dst + 16) = b;
}
__device__ __forceinline__ void ph_rwscan(const P& p, char* lds) {
  const hf* ZRW = RW_ZRW(p); hf* RKV = RW_RKV(p); const hf* KK = RW_KK(p);
  const int tid = get_tid(), lane = tid & 63, wid = tid >> 6;
  char* pbuf = lds + 3 * RW_BUF + wid * 2048;
  char* ybuf = lds + 3 * RW_BUF + 8192;
  for (int t = blockIdx.x; t < 192; t += gridDim.x) {
    const int rqq = t & 3, h = (t >> 2) % 6, b = (t / 24) & 3, d = t / 96;
    const int rsub = lane >> 4, g = lane & 15; const int rl = wid * 4 + rsub;
    const int sgn = d ? -1 : 1;
    const bool grpA = tid < 128; const int t2 = tid & 127;
    const int sstep = t2 >> 3, sseg = t2 & 7;
    const hf* g0 = grpA ? (RKV + h * 64 + sseg * 8) : (RW_KD(p) + (size_t)d * M_ALL * 384 + h * 64 + sseg * 8);
    const size_t ld0 = grpA ? 1152 : 384;
    const hf* g1 = grpA ? (KK + h * 64 + sseg * 8) : (RW_KA(p) + (size_t)d * M_ALL * 384 + h * 64 + sseg * 8);
    const hf* g2 = grpA ? (ZRW + d * 384 + h * 64 + sseg * 8) : (RKV + 768 + h * 64 + rqq * 16 + (t2 & 1) * 8);
    const int s2 = grpA ? sstep : (t2 >> 1);
    const bool has2 = grpA || t2 < 32;
    const int o0 = (grpA ? 0 : 12288) + sstep * 256 + sseg * 32;
    const int o1 = (grpA ? 4096 : 16384) + sstep * 256 + sseg * 32;
    const int o2 = grpA ? (8192 + sstep * 256 + sseg * 32) : (20480 + (t2 >> 1) * 64 + (t2 & 1) * 32);
    hf* g_y = d == 0 ? (RKV + 384 + h * 64 + rqq * 16 + (tid & 1) * 8) : (RW_YR(p) + h * 64 + rqq * 16 + (tid & 1) * 8);
    const int ldy = d == 0 ? 1152 : 384;
    uint4 q0, q1, q2;
#define RW_M0(pp) ((pp) < 256 ? (M_LAT + b * 256 + (d ? 255 - (pp) : (pp))) : (b * 8192 + (d ? 8447 - (pp) : (pp) - 256)))
#define RW_GLOAD(c) { const int mb_ = RW_M0((c) * RW_CH); const size_t mm = (size_t)(mb_ + sgn * sstep); \
      q0 = *(const uint4*)(g0 + mm * ld0); q1 = *(const uint4*)(g1 + mm * 384); \
      if (has2) { const size_t m2 = (size_t)(mb_ + sgn * s2); q2 = *(const uint4*)(g2 + m2 * 1152); } }
#define RW_SSTORE(c) { char* bb_ = lds + ((c) % 3) * RW_BUF; rw_cvt_store(bb_ + o0, q0); rw_cvt_store(bb_ + o1, q1); if (has2) rw_cvt_store(bb_ + o2, q2); }
    f32x2 S01 = (f32x2){0.f, 0.f}, S23 = (f32x2){0.f, 0.f};
    RW_GLOAD(0) RW_SSTORE(0)
    RW_GLOAD(1) RW_SSTORE(1)
    __syncthreads();
    const int NCH = 8448 / RW_CH;
    for (int c = 0; c < NCH; ++c) {
      if (c + 2 < NCH) RW_GLOAD(c + 2)
      if (c > 0 && tid < 32) {
        const int mb_ = RW_M0((c - 1) * RW_CH); const size_t mv = (size_t)(mb_ + sgn * (tid >> 1));
        *(uint4*)(g_y + mv * ldy) = *(const uint4*)(ybuf + ((c - 1) & 1) * 512 + tid * 16);
      }
      const char* cb = lds + (c % 3) * RW_BUF + g * 16;
      const char* vb = lds + (c % 3) * RW_BUF + 20480 + rl * 4;
      f32x4 R4[RW_CH], K4[RW_CH], D4[RW_CH], KD4[RW_CH], KA4[RW_CH]; float VV[RW_CH];
#define RW_LDS(s_) { R4[s_] = *(const f32x4*)(cb + (s_) * 256); K4[s_] = *(const f32x4*)(cb + 4096 + (s_) * 256); D4[s_] = *(const f32x4*)(cb + 8192 + (s_) * 256); \
        KD4[s_] = *(const f32x4*)(cb + 12288 + (s_) * 256); KA4[s_] = *(const f32x4*)(cb + 16384 + (s_) * 256); VV[s_] = *(const float*)(vb + (s_) * 64); }
      RW_LDS(0) RW_LDS(1) RW_LDS(2)
#pragma unroll
      for (int s = 0; s < RW_CH; ++s) {
        if (s + 3 < RW_CH) RW_LDS(s + 3)
        const f32x4 r4 = R4[s], k4 = K4[s], d4 = D4[s], kd4 = KD4[s], ka4 = KA4[s]; const float vv = VV[s];
        const f32x2 k01 = {k4[0], k4[1]}, k23 = {k4[2], k4[3]}, d01 = {d4[0], d4[1]}, d23 = {d4[2], d4[3]};
        const f32x2 kd01 = {kd4[0], kd4[1]}, kd23 = {kd4[2], kd4[3]}, ka01 = {ka4[0], ka4[1]}, ka23 = {ka4[2], ka4[3]};
        const f32x2 r01 = {r4[0], r4[1]}, r23 = {r4[2], r4[3]};
        const f32x2 sa2 = __builtin_elementwise_fma(S23, k23, S01 * k01);
        float sa = sa2[0] + sa2[1];
        sa = rowsum16(sa);
        const f32x2 vv2 = {vv, vv}; const f32x2 nsa = {-sa, -sa};
        f32x2 T01 = __builtin_elementwise_fma(-S01, d01, S01), T23 = __builtin_elementwise_fma(-S23, d23, S23);
        T01 = __builtin_elementwise_fma(vv2, kd01, T01); T23 = __builtin_elementwise_fma(vv2, kd23, T23);
        S01 = __builtin_elementwise_fma(nsa, ka01, T01); S23 = __builtin_elementwise_fma(nsa, ka23, T23);
        const f32x2 y2 = __builtin_elementwise_fma(S23, r23, S01 * r01);
        *(float*)(pbuf + (((s & 7) * 4 + rsub) * 16 + g) * 4) = y2[0] + y2[1];
        if ((s & 7) == 7) {
          if (lane < 32) {
            const char* pr = pbuf + lane * 64;
            const f32x4 a0 = *(const f32x4*)(pr), a1 = *(const f32x4*)(pr + 16), a2 = *(const f32x4*)(pr + 32), a3 = *(const f32x4*)(pr + 48);
            const f32x4 sm = (a0 + a1) + (a2 + a3);
            const float y = (sm[0] + sm[1]) + (sm[2] + sm[3]);
            *(hf*)(ybuf + (c & 1) * 512 + (((s >> 3) * 8 + (lane >> 2)) * 16 + wid * 4 + (lane & 3)) * 2) = (hf)y;
          }
        }
      }
      if (c + 2 < NCH) RW_SSTORE(c + 2)
      __syncthreads();
    }
    if (tid < 32) {
      const int mb_ = RW_M0((NCH - 1) * RW_CH); const size_t mv = (size_t)(mb_ + sgn * (tid >> 1));
      *(uint4*)(g_y + mv * ldy) = *(const uint4*)(ybuf + ((NCH - 1) & 1) * 512 + tid * 16);
    }
    __syncthreads();
  }
}

__device__ __forceinline__ void ph_rwpost(const P& p, int l) {
  const hf* ZRW = RW_ZRW(p); const hf* RKV = RW_RKV(p); const hf* YR = RW_YR(p);
  const int lane = get_tid() & 63, wid = get_tid() >> 6;
  const int nw = gridDim.x * 4;
  for (int t = blockIdx.x * 4 + wid; t < M_ALL * 6; t += nw) {
    const int m = t / 6, h = t % 6; const int c = h * 64 + lane;
    const float ys = (float)RKV[(size_t)m * 1152 + 384 + c] + (float)YR[(size_t)m * 384 + c];
    const float mean = wavesum(ys) * (1.f / 64.f);
    const float xc = ys - mean;
    const float var = wavesum(xc * xc) * (1.f / 64.f);
    float y = xc * rsqrtf(var + 64e-5f) * p.in[21][(size_t)l * 384 + c] + p.in[22][(size_t)l * 384 + c];
    const float r = (float)RKV[(size_t)m * 1152 + c], v = (float)RKV[(size_t)m * 1152 + 768 + c];
    const float rk = p.in[20][(size_t)l * 384 + c];
    const float kd0 = (float)RW_KD(p)[(size_t)m * 384 + c], kd1 = (float)RW_KD(p)[((size_t)M_ALL + m) * 384 + c];
    const float bs = wavesum(r * (kd0 + kd1) * rk);
    y = (y + bs * v) * (float)ZRW[(size_t)m * 1152 + 768 + c];
    p.Y[(size_t)m * 1024 + c] = f2bf(y);
  }
}

struct S5C { float ar, ai; float br[16], bi[16]; };
__device__ __forceinline__ void s5_consts(const P& p, int l, int d, int g, int n, S5C& c) {
  const int ig = (l * 2 + d) * 16 + g;
  const float lr = fminf(p.in[23][(size_t)ig * 64 + n], -1e-4f), li = p.in[24][(size_t)ig * 64 + n];
  const float dt = expf(p.in[25][ig]);
  const float mag = expf(lr * dt);
  c.ar = mag * cosf(li * dt); c.ai = mag * sinf(li * dt);
  const float nr = c.ar - 1.f, ni = c.ai; const float den = 1.f / (lr * lr + li * li);
  const float cr = (nr * lr + ni * li) * den, ci = (ni * lr - nr * li) * den;
  const float* bre = p.in[26] + ((size_t)ig * 64 + n) * 16; const float* bim = p.in[27] + ((size_t)ig * 64 + n) * 16;
#pragma unroll
  for (int h = 0; h < 16; ++h) { const float xr = bre[h], xi = bim[h]; c.br[h] = cr * xr - ci * xi; c.bi[h] = cr * xi + ci * xr; }
}
__device__ __forceinline__ int s5_m0(int b, int tc) { return tc < 128 ? b * 8192 + tc * 64 : M_LAT + b * 256 + (tc - 128) * 64; }
__device__ __forceinline__ int chain_pos(int d, int tc) { return d == 0 ? (tc < 128 ? tc + 4 : tc - 128) : (tc < 128 ? 131 - tc : 131 - tc); }
__device__ __forceinline__ void ph_s5_pass(const P& p, int l, int pass, char* lds, int vb, int nvb) {
  const int tid = get_tid(), lane = tid & 63, wid = tid >> 6, fr = lane & 15, fq = lane >> 4;
  float* ub = (float*)(lds + wid * 8448);
  char* xs = lds + wid * 8448 + 4096;
  const hf* Z = S5_ZH(p); float2* E = S5_E(p); const float2* X = S5_X(p); bf16_t* YG = S5_YG(p);
  const int nw = nvb * 4;
  for (int t = vb * 4 + wid; t < 4 * 132 * 16; t += nw) {
    const int g = t & 15, tc = (t >> 4) % 132, b = t / (16 * 132);
    const int m0 = s5_m0(b, tc);
#pragma unroll
    for (int i = 0; i < 4; ++i) { const int e = lane + i * 64; const int tok = e >> 2, q = e & 3;
      const hf4 zv = *(const hf4*)(Z + (size_t)(m0 + tok) * 256 + g * 16 + q * 4);
      *(float4*)(ub + tok * 16 + q * 4) = make_float4((float)zv[0], (float)zv[1], (float)zv[2], (float)zv[3]); }
    f32x4 yacc[4];
#pragma unroll
    for (int i = 0; i < 4; ++i) yacc[i] = (f32x4){0.f, 0.f, 0.f, 0.f};
    for (int d = 0; d < 2; ++d) {
      S5C c; s5_consts(p, l, d, g, lane, c);
      const int cp = chain_pos(d, tc);
      const size_t sidx = (((size_t)(d * 4 + b) * 132 + cp) * 16 + g) * 64 + lane;
      float xr = 0.f, xi = 0.f;
      hf8 cf[4];
      if (pass == 3) {
        float2 x0 = X[sidx]; xr = x0.x; xi = x0.y;
        const int ig = (l * 2 + d) * 16 + g;
#pragma unroll
        for (int ks = 0; ks < 4; ++ks) {
          const int c0 = ks * 32 + fq * 8;
          const float* src_ = (c0 < 64 ? p.in[28] : p.in[29]) + ((size_t)ig * 16 + fr) * 64 + (c0 & 63);
          const float sg = c0 < 64 ? 1.f : -1.f;
          const float4 v0 = *(const float4*)src_, v1 = *(const float4*)(src_ + 4);
          cf[ks][0] = (hf)(sg * v0.x); cf[ks][1] = (hf)(sg * v0.y); cf[ks][2] = (hf)(sg * v0.z); cf[ks][3] = (hf)(sg * v0.w);
          cf[ks][4] = (hf)(sg * v1.x); cf[ks][5] = (hf)(sg * v1.y); cf[ks][6] = (hf)(sg * v1.z); cf[ks][7] = (hf)(sg * v1.w);
        }
      }
#pragma unroll 1
      for (int jb = 0; jb < 4; ++jb) {
        const int tb = d ? 3 - jb : jb;
#pragma unroll 4
        for (int jj = 0; jj < 16; ++jj) {
          const int t16 = d ? 15 - jj : jj;
          const float* u = ub + (tb * 16 + t16) * 16;
          float br = 0.f, bi = 0.f;
#pragma unroll
          for (int h = 0; h < 16; ++h) { const float uv = u[h]; br += c.br[h] * uv; bi += c.bi[h] * uv; }
          const float nr = c.ar * xr - c.ai * xi + br, ni = c.ar * xi + c.ai * xr + bi;
          xr = nr; xi = ni;
          if (pass == 3) { *(hf*)(xs + t16 * 272 + lane * 2) = (hf)xr; *(hf*)(xs + t16 * 272 + 128 + lane * 2) = (hf)xi; }
        }
        if (pass == 3) {
          f32x4 acc = (f32x4){0.f, 0.f, 0.f, 0.f};
#pragma unroll
          for (int ks = 0; ks < 4; ++ks) {
            const hf8 af = *(const hf8*)(xs + fr * 272 + ks * 64 + fq * 16);
            acc = __builtin_amdgcn_mfma_f32_16x16x32_f16(af, cf[ks], acc, 0, 0, 0);
          }
#pragma unroll
          for (int i = 0; i < 4; ++i) if (i == tb) yacc[i] += acc;
        }
      }
      if (pass == 1) E[sidx] = make_float2(xr, xi);
    }
    if (pass == 3) {
      const float dsk = p.in[30][(size_t)l * 256 + g * 16 + fr];
#pragma unroll
      for (int i = 0; i < 4; ++i)
#pragma unroll
        for (int j = 0; j < 4; ++j) {
          const int tok = i * 16 + fq * 4 + j;
          float y = yacc[i][j] + dsk * ub[tok * 16 + fr];
          const float inner = 0.7978845608028654f * (y + 0.044715f * y * y * y);
          y = 0.5f * y * (1.f + tanhf(inner));
          YG[(size_t)(m0 + tok) * 256 + g * 16 + fr] = f2bf(y);
        }
    }
  }
}
__device__ __forceinline__ void ph_s5_carry(const P& p, int l, int vb, int nvb) {
  float2* E = S5_E(p); float2* X = S5_X(p);
  for (int t = vb * NTHR + get_tid(); t < 8192; t += nvb * NTHR) {
    const int n = t & 63, g = (t >> 6) & 15, b = (t >> 10) & 3, d = t >> 12;
    const int ig = (l * 2 + d) * 16 + g;
    const float lr = fminf(p.in[23][(size_t)ig * 64 + n], -1e-4f), li = p.in[24][(size_t)ig * 64 + n];
    const float dt = expf(p.in[25][ig]);
    const float mag = expf(lr * dt * 64.f);
    float ar = expf(lr * dt) * cosf(li * dt), ai = expf(lr * dt) * sinf(li * dt);
#pragma unroll
    for (int i = 0; i < 6; ++i) { const float r2 = ar * ar - ai * ai, i2 = 2.f * ar * ai; ar = r2; ai = i2; }
    (void)mag;
    float xr = 0.f, xi = 0.f;
    const size_t base = (((size_t)(d * 4 + b) * 132) * 16 + g) * 64 + n;
    for (int cp0 = 0; cp0 < 132; cp0 += 12) {
      float2 ev[12];
#pragma unroll
      for (int u = 0; u < 12; ++u) ev[u] = E[base + (size_t)(cp0 + u) * 1024];
#pragma unroll
      for (int u = 0; u < 12; ++u) {
        X[base + (size_t)(cp0 + u) * 1024] = make_float2(xr, xi);
        const float nr = ar * xr - ai * xi + ev[u].x, ni = ar * xi + ai * xr + ev[u].y;
        xr = nr; xi = ni;
      }
    }
  }
}
__device__ __forceinline__ void ph_glu(const P& p, int l, char* lds, int vb, int nvb) {
  EPI_VARS
  const bf16_t* YG = S5_YG(p);
  const int Mt = 264;
  const float* gb = p.in[32] + (size_t)l * 256;
  for (int it = 0;; ++it) {
    int tm, tn; if (!tile_map_v(vb, nvb, it, Mt, 2, 2, tm, tn)) break; const int m0 = tm * 128, n0 = tn * 128;
    f32x4 acc[4][4]; ZERO_ACC(acc)
    gemm_main(YG + (size_t)m0 * 256, 256, p.W + W_GLU + (size_t)n0 * 256, 256, 256, acc, lds);
    EPI_BEGIN(m0, n0)
      const float y = bf2f(YG[(size_t)row * 256 + col]);
      p.Y[(size_t)row * 1024 + 384 + col] = f2bf(y * sigmoidf_(val + gb[col]));
    EPI_END
  }
}

__device__ __forceinline__ void sub_barrier(unsigned* cnt, unsigned target) {
  asm volatile("s_waitcnt vmcnt(0)" ::: "memory");
  __syncthreads();
  if (__builtin_amdgcn_workitem_id_x() == 0) {
    __builtin_amdgcn_fence(__ATOMIC_RELEASE, "agent");
    asm volatile("s_waitcnt vmcnt(0)" ::: "memory");
    __hip_atomic_fetch_add(cnt, 1u, __ATOMIC_RELAXED, __HIP_MEMORY_SCOPE_AGENT);
    unsigned sp = 0;
    while (__hip_atomic_load(cnt, __ATOMIC_RELAXED, __HIP_MEMORY_SCOPE_AGENT) < target) { __builtin_amdgcn_s_sleep(2); if (++sp > (1u << 22)) break; }
    __builtin_amdgcn_fence(__ATOMIC_ACQUIRE, "agent");
    asm volatile("s_waitcnt vmcnt(0)" ::: "memory");
  }
  __syncthreads();
}
__device__ __forceinline__ void ph_s5_stage(const P& p, int l, char* lds, int vb, int nvb) {
  unsigned* cnt = p.bar + 3584;
  const unsigned base = (unsigned)(l * 4) * (unsigned)nvb;
  ph_z_s5(p, lds, vb, nvb);            sub_barrier(cnt, base + 1u * nvb);
  ph_s5_pass(p, l, 1, lds, vb, nvb);   sub_barrier(cnt, base + 2u * nvb);
  ph_s5_carry(p, l, vb, nvb);          sub_barrier(cnt, base + 3u * nvb);
  ph_s5_pass(p, l, 3, lds, vb, nvb);   sub_barrier(cnt, base + 4u * nvb);
  ph_glu(p, l, lds, vb, nvb);
}

__device__ __forceinline__ float logsigf_(float x) { return fminf(x, 0.f) - log1pf(__expf(-fabsf(x))); }
__device__ __forceinline__ void ml_gates(const P& p, int l, int d, int h, int m0, int lane, float& bcum, float& ic) {
  const int tok = d ? 63 - lane : lane;
  const float* gl = ML_GL(p) + (size_t)(m0 + tok) * 16;
  const float* gb = p.in[33] + (size_t)(l * 2 + d) * 8;
  ic = gl[d * 8 + h] + gb[h];
  float f = logsigf_(gl[d * 8 + 4 + h] + gb[4 + h]);
#pragma unroll
  for (int o = 1; o < 64; o <<= 1) { float v = __shfl_up(f, o); if (lane >= o) f += v; }
  bcum = f;
}
__device__ __forceinline__ void ml_gates2(const P& p, int l, int d, int h, int m0, int lane, float& bc, float& ic, float& tot) {
  const float* gl = ML_GL(p) + (size_t)(m0 + lane) * 16;
  const float* gb = p.in[33] + (size_t)(l * 2 + d) * 8;
  ic = gl[d * 8 + h] + gb[h];
  const float f0 = logsigf_(gl[d * 8 + 4 + h] + gb[4 + h]);
  float f = f0;
#pragma unroll
  for (int o = 1; o < 64; o <<= 1) { float v = __shfl_up(f, o); if (lane >= o) f += v; }
  tot = __shfl(f, 63);
  bc = d ? (tot - f + f0) : f;
}
#define MLQ 208
#define MLS 144
__device__ __forceinline__ void ph_ml_a(const P& p, int l, char* lds) {
  char* vt = lds; char* kt = lds + 13824; float* wg = (float*)(lds + 27648);
  const int tid = get_tid(), lane = tid & 63, wid = tid >> 6, fr = lane & 15, fq = lane >> 4;
  const hf* QK = ML_QK(p); const hf* Z = ML_Z(p);
  for (int t = blockIdx.x; t < 4224; t += gridDim.x) {
    const int tc = t % 132, h = (t / 132) & 3, b = (t / 528) & 3, d = t / 2112;
    const int m0 = s5_m0(b, tc); const int cp = chain_pos(d, tc);
    const size_t task = ((size_t)((d * 4 + b) * 4 + h)) * 132 + cp;
    if (wid == 0) {
      float bc, ic, tot; ml_gates2(p, l, d, h, m0, lane, bc, ic, tot);
      const float lw = tot - bc + ic;
      float mx = lw;
      for (int o = 32; o > 0; o >>= 1) mx = fmaxf(mx, __shfl_xor(mx, o));
      wg[lane] = __expf(lw - mx);
      if (lane == 0) { ML_SC(p)[task * 2] = mx; ML_SC(p)[task * 2 + 1] = tot; }
    }
    __syncthreads();
    for (int e = tid; e < 64 * 12; e += NTHR) {
      const int tok = e & 63, q = e >> 6;
      const hf8 kv = *(const hf8*)(QK + (size_t)(m0 + tok) * 768 + 384 + h * 96 + q * 8);
      const hf8 vv = *(const hf8*)(Z + (size_t)(m0 + tok) * 1536 + 768 + h * 96 + q * 8);
      const float w = wg[tok];
#pragma unroll
      for (int i = 0; i < 8; ++i) {
        *(hf*)(kt + (q * 8 + i) * MLS + tok * 2) = kv[i];
        *(hf*)(vt + (q * 8 + i) * MLS + tok * 2) = (hf)((float)vv[i] * w);
      }
    }
    __syncthreads();
    float* dc = ML_DC(p) + task * 9216;
#pragma unroll 1
    for (int bi = 0; bi < 9; ++bi) {
      const int idx = wid * 9 + bi; const int mb = idx / 6, nb = idx % 6;
      f32x4 acc = (f32x4){0.f, 0.f, 0.f, 0.f};
#pragma unroll
      for (int ks = 0; ks < 2; ++ks) {
        const hf8 af = *(const hf8*)(vt + (mb * 16 + fr) * MLS + ks * 64 + fq * 16);
        const hf8 bf = *(const hf8*)(kt + (nb * 16 + fr) * MLS + ks * 64 + fq * 16);
        acc = __builtin_amdgcn_mfma_f32_16x16x32_f16(af, bf, acc, 0, 0, 0);
      }
#pragma unroll
      for (int j = 0; j < 4; ++j) dc[(mb * 16 + fq * 4 + j) * 96 + nb * 16 + fr] = acc[j];
    }
    if (tid < 96) {
      float s = 0.f;
      for (int j = 0; j < 64; ++j) s += wg[j] * (float)*(const hf*)(kt + tid * MLS + j * 2);
      ML_DN(p)[task * 96 + tid] = s;
    }
    __syncthreads();
  }
}
__device__ __forceinline__ void ph_ml_b(const P& p) {
  float* DC = ML_DC(p); float* DN = ML_DN(p); const float* SC = ML_SC(p); float* MP = ML_MP(p);
  for (int t = blockIdx.x * NTHR + get_tid(); t < 32 * 9312; t += gridDim.x * NTHR) {
    const int chain = t / 9312, e = t % 9312;
    float cur = 0.f, mprev = 0.f;
    for (int cp0 = 0; cp0 < 132; cp0 += 12) {
      float dl[12], ml_[12], bl_[12];
#pragma unroll
      for (int u = 0; u < 12; ++u) {
        const size_t task = (size_t)chain * 132 + cp0 + u;
        dl[u] = e < 9216 ? DC[task * 9216 + e] : DN[task * 96 + (e - 9216)];
        ml_[u] = SC[task * 2]; bl_[u] = SC[task * 2 + 1];
      }
#pragma unroll
      for (int u = 0; u < 12; ++u) {
        const size_t task = (size_t)chain * 132 + cp0 + u;
        float* slot = e < 9216 ? DC + task * 9216 + e : DN + task * 96 + (e - 9216);
        *slot = cur;
        if (e == 0) MP[task] = mprev;
        const float mnew = fmaxf(bl_[u] + mprev, ml_[u]);
        cur = __expf(bl_[u] + mprev - mnew) * cur + __expf(ml_[u] - mnew) * dl[u];
        mprev = mnew;
      }
    }
  }
}
__device__ __forceinline__ void ph_ml_c(const P& p, int l, char* lds) {
  char* qs = lds; char* ks = lds + 13312; char* vt = lds + 26624; char* cs = lds + 40448; char* ps = lds + 60416;
  float* fl = (float*)(lds + 69632);
  float* bc = fl; float* icv = fl + 128; float* mr = fl + 256; float* inter = fl + 320; float* den = fl + 384; float* nq = fl + 448; float* nst = fl + 512;
  const int tid = get_tid(), lane = tid & 63, wid = tid >> 6, fr = lane & 15, fq = lane >> 4;
  const hf* QK = ML_QK(p); const hf* Z = ML_Z(p);
  for (int t = blockIdx.x; t < 2112; t += gridDim.x) {
    const int tc = t % 132, h = (t / 132) & 3, b = t / 528;
    const int m0 = s5_m0(b, tc);
    for (int e = tid; e < 64 * 12; e += NTHR) {
      const int tok = e & 63, q = e >> 6;
      *(hf8*)(qs + tok * MLQ + q * 16) = *(const hf8*)(QK + (size_t)(m0 + tok) * 768 + h * 96 + q * 8);
      *(hf8*)(ks + tok * MLQ + q * 16) = *(const hf8*)(QK + (size_t)(m0 + tok) * 768 + 384 + h * 96 + q * 8);
      const hf8 vv = *(const hf8*)(Z + (size_t)(m0 + tok) * 1536 + 768 + h * 96 + q * 8);
#pragma unroll
      for (int i = 0; i < 8; ++i) *(hf*)(vt + (q * 8 + i) * MLS + tok * 2) = vv[i];
    }
    if (wid < 2) { float bcv, ic, tot; ml_gates2(p, l, wid, h, m0, lane, bcv, ic, tot); bc[wid * 64 + lane] = bcv; icv[wid * 64 + lane] = ic; }
    f32x4 hs[6];
#pragma unroll
    for (int n = 0; n < 6; ++n) hs[n] = (f32x4){0.f, 0.f, 0.f, 0.f};
    for (int d = 0; d < 2; ++d) {
      const int cp = chain_pos(d, tc);
      const size_t task = ((size_t)((d * 4 + b) * 4 + h)) * 132 + cp;
      const float mprev = ML_MP(p)[task];
      __syncthreads();
      {
        const float* cg = ML_DC(p) + task * 9216;
        for (int e = tid; e < 96 * 24; e += NTHR) {
          const int v = e / 24, q = e % 24;
          const float4 c4 = *(const float4*)(cg + v * 96 + q * 4);
          hf4 o; o[0] = (hf)c4.x; o[1] = (hf)c4.y; o[2] = (hf)c4.z; o[3] = (hf)c4.w;
          *(hf4*)(cs + v * MLQ + q * 8) = o;
        }
        if (tid < 96) nst[tid] = ML_DN(p)[task * 96 + tid];
      }
      const float* bcd = bc + d * 64; const float* icd = icv + d * 64;
      if (tid < 64) {
        const int j = tid; const float bj = bcd[j];
        float mx = bj + mprev;
        if (d == 0) { for (int s = 0; s <= j; ++s) mx = fmaxf(mx, bj - bcd[s] + icd[s]); }
        else { for (int s = j; s < 64; ++s) mx = fmaxf(mx, bj - bcd[s] + icd[s]); }
        mr[j] = mx; inter[j] = __expf(bj + mprev - mx);
      }
      __syncthreads();
      if (tid < 64) {
        float s1 = 0.f;
        for (int k = 0; k < 96; ++k) s1 += nst[k] * (float)*(const hf*)(qs + tid * MLQ + k * 2);
        nq[tid] = s1;
      }
      {
        f32x4 sacc[4];
#pragma unroll
        for (int n = 0; n < 4; ++n) sacc[n] = (f32x4){0.f, 0.f, 0.f, 0.f};
#pragma unroll
        for (int kk = 0; kk < 3; ++kk) {
          const hf8 af = *(const hf8*)(qs + (wid * 16 + fr) * MLQ + kk * 64 + fq * 16);
#pragma unroll
          for (int n = 0; n < 4; ++n) {
            const hf8 bf = *(const hf8*)(ks + (n * 16 + fr) * MLQ + kk * 64 + fq * 16);
            sacc[n] = __builtin_amdgcn_mfma_f32_16x16x32_f16(af, bf, sacc[n], 0, 0, 0);
          }
        }
        float rs[4] = {0.f, 0.f, 0.f, 0.f};
#pragma unroll
        for (int n = 0; n < 4; ++n) {
          const int s = n * 16 + fr; const float bs = bcd[s] - icd[s];
#pragma unroll
          for (int jj = 0; jj < 4; ++jj) {
            const int j = wid * 16 + fq * 4 + jj;
            const bool valid = d == 0 ? (s <= j) : (s >= j);
            const float val = valid ? sacc[n][jj] * __expf(bcd[j] - bs - mr[j]) : 0.f;
            rs[jj] += val;
            *(hf*)(ps + j * MLS + s * 2) = (hf)val;
          }
        }
        __syncthreads();
#pragma unroll
        for (int jj = 0; jj < 4; ++jj) {
          const float r = rowsum16(rs[jj]);
          const int j = wid * 16 + fq * 4 + jj;
          if (fr == 0) den[j] = inter[j] * nq[j] + r;
        }
      }
      f32x4 acc[6];
#pragma unroll
      for (int n = 0; n < 6; ++n) acc[n] = (f32x4){0.f, 0.f, 0.f, 0.f};
#pragma unroll
      for (int kk = 0; kk < 3; ++kk) {
        const hf8 af = *(const hf8*)(qs + (wid * 16 + fr) * MLQ + kk * 64 + fq * 16);
#pragma unroll
        for (int n = 0; n < 6; ++n) {
          const hf8 bf = *(const hf8*)(cs + (n * 16 + fr) * MLQ + kk * 64 + fq * 16);
          acc[n] = __builtin_amdgcn_mfma_f32_16x16x32_f16(af, bf, acc[n], 0, 0, 0);
        }
      }
#pragma unroll
      for (int jj = 0; jj < 4; ++jj) { const float it = inter[wid * 16 + fq * 4 + jj];
#pragma unroll
        for (int n = 0; n < 6; ++n) acc[n][jj] *= it; }
#pragma unroll
      for (int kk = 0; kk < 2; ++kk) {
        const hf8 af = *(const hf8*)(ps + (wid * 16 + fr) * MLS + kk * 64 + fq * 16);
#pragma unroll
        for (int n = 0; n < 6; ++n) {
          const hf8 bf = *(const hf8*)(vt + (n * 16 + fr) * MLS + kk * 64 + fq * 16);
          acc[n] = __builtin_amdgcn_mfma_f32_16x16x32_f16(af, bf, acc[n], 0, 0, 0);
        }
      }
      __syncthreads();
#pragma unroll
      for (int jj = 0; jj < 4; ++jj) {
        const int j = wid * 16 + fq * 4 + jj;
        const float dn = 1.f / fmaxf(fabsf(den[j]), __expf(-mr[j]));
#pragma unroll
        for (int n = 0; n < 6; ++n) hs[n][jj] += acc[n][jj] * dn;
      }
    }
#pragma unroll
    for (int jj = 0; jj < 4; ++jj) {
      const int m = m0 + wid * 16 + fq * 4 + jj;
      const hf* op = Z + (size_t)m * 1536 + 1152 + h * 96 + fr;
      float x[6]; float s = 0.f;
#pragma unroll
      for (int n = 0; n < 6; ++n) { x[n] = sigmoidf_((float)op[n * 16]) * hs[n][jj]; s += x[n]; }
      s = rowsum16(s);
      const float mean = s * (1.f / 96.f);
      float q = 0.f;
#pragma unroll
      for (int n = 0; n < 6; ++n) { x[n] -= mean; q += x[n] * x[n]; }
      q = rowsum16(q);
      const float rsd = rsqrtf(q * (1.f / 96.f) + 1e-5f);
      const float* ng = p.in[34] + (size_t)l * 384 + h * 96 + fr;
      bf16_t* yp = p.Y + (size_t)m * 1024 + 640 + h * 96 + fr;
#pragma unroll
      for (int n = 0; n < 6; ++n) yp[n * 16] = f2bf(x[n] * rsd * ng[n * 16]);
    }
    __syncthreads();
  }
}

#define MG_YM(p) ((bf16_t*)(p).R)
#define MG_G3(p) (MG_YM(p) + (size_t)M_ALL * 1024)
__device__ __forceinline__ void ph_gates(const P& p, int l, int Mt, char* lds) {
  EPI_VARS
  bf16_t* G3 = MG_G3(p);
  const float* gbias = p.in[38] + (size_t)l * 3072;
  const int ntile = Mt * 24;
  for (int it = 0;; ++it) {
    int tm, tn; if (!tile_map(it, Mt, 24, 8, tm, tn)) break; const int m0 = tm * 128, n0 = tn * 128;
    f32x4 acc[4][4]; ZERO_ACC(acc)
    gemm_main(p.U + (size_t)m0 * 1024, 1024, p.W + W_IN + (size_t)(3216 + n0) * 1024, 1024, 1024, acc, lds);
    EPI_BEGIN(m0, n0)
      G3[(size_t)row * 3072 + col] = f2bf(sigmoidf_(val + gbias[col]));
    EPI_END
  }
}
__device__ __forceinline__ void ph_merge(const P& p, int l, int Mt, char* lds) {
  EPI_VARS
  bf16_t* YM = MG_YM(p); const bf16_t* G3 = MG_G3(p);
  const int ntile = Mt * 16;
  for (int it = 0;; ++it) {
    int tm, tn; if (!tile_map(it, Mt, 16, 8, tm, tn)) break; const int m0 = tm * 128, n0 = tn * 64;
    f32x4 yacc[4][2];
#pragma unroll
    for (int m = 0; m < 4; ++m) { yacc[m][0] = (f32x4){0.f, 0.f, 0.f, 0.f}; yacc[m][1] = (f32x4){0.f, 0.f, 0.f, 0.f}; }
#pragma unroll 1
    for (int br = 0; br < 3; ++br) {
      f32x4 acc[4][2];
#pragma unroll
      for (int m = 0; m < 4; ++m) { acc[m][0] = (f32x4){0.f, 0.f, 0.f, 0.f}; acc[m][1] = (f32x4){0.f, 0.f, 0.f, 0.f}; }
      const int kb = br == 1 ? 256 : 384; const int yoff = br == 0 ? 0 : (br == 1 ? 384 : 640);
      const int woff = br == 0 ? W_UPRW : (br == 1 ? W_UPS5 : W_UPML);
      gemm_main_t<2>(p.Y + (size_t)m0 * 1024 + yoff, 1024, p.W + woff + (size_t)n0 * kb, kb, kb, acc, lds);
      EPI_ROW_BEGIN(m0)
        const bf16_t* gp = G3 + (size_t)row * 3072 + br * 1024 + n0 + wc * 32 + fr;
#pragma unroll
        for (int n = 0; n < 2; ++n) yacc[m][n][j] += bf2f(gp[n * 16]) * acc[m][n][j];
      EPI_ROW_END
    }
    EPI_ROW_BEGIN(m0)
      bf16_t* yp = YM + (size_t)row * 1024 + n0 + wc * 32 + fr;
#pragma unroll
      for (int n = 0; n < 2; ++n) yp[n * 16] = f2bf(yacc[m][n][j]);
    EPI_ROW_END
  }
}
__device__ __forceinline__ void ph_wout(const P& p, int l, int Mt, char* lds) {
  EPI_VARS
  const bf16_t* YM = (const bf16_t*)p.R;
  const int ntile = Mt * 8;
  for (int it = 0;; ++it) {
    int tm, tn; if (!tile_map(it, Mt, 8, 8, tm, tn)) break; const int m0 = tm * 128, n0 = tn * 128;
    f32x4 acc[4][4]; ZERO_ACC(acc)
    gemm_main(YM + (size_t)m0 * 1024, 1024, p.W + W_OUT + (size_t)n0 * 1024, 1024, 1024, acc, lds);
    EPI_ROW_BEGIN(m0)
      float* sp = srow(p, row) + n0 + wc * 64 + fr; const float* gp = modp(p, l, row, 5) + n0 + wc * 64 + fr;
#pragma unroll
      for (int n = 0; n < 4; ++n) sp[n * 16] = ALPHA * sp[n * 16] + gp[n * 16] * acc[m][n][j];
    EPI_ROW_END
  }
}

#define XB_TMO      128
#define XB_XCNT(j)  (256  + 64 * (j))
#define XB_XSUB(j)  (1280 + 64 * (j))
#define XB_XGEN(j)  (2304 + 64 * (j))
#define XB_TOP      3328
#define XB_TOPGEN   3392
#define XCD_BAR_WORDS 3456
#define XB_SPIN_CAP (1u << 18)
#define LAS __attribute__((address_space(3)))

__device__ __forceinline__ unsigned xb_ld(unsigned* p)              { return __hip_atomic_load(p, __ATOMIC_RELAXED, __HIP_MEMORY_SCOPE_AGENT); }
__device__ __forceinline__ unsigned xb_add(unsigned* p, unsigned v) { return __hip_atomic_fetch_add(p, v, __ATOMIC_RELAXED, __HIP_MEMORY_SCOPE_AGENT); }
__device__ __forceinline__ unsigned xb_xcc_id() { return (unsigned)__builtin_amdgcn_s_getreg((3 << 11) | 20) & 0xFu; }
#define XB_SPIN(cond, bar) do { unsigned _sp = 0; while (cond) { __builtin_amdgcn_s_sleep(1); \
    if ((++_sp & 255u) == 0u) { if (xb_ld(&(bar)[XB_TMO])) break; if (_sp > XB_SPIN_CAP) { atomicAdd(&(bar)[XB_TMO], 1u); break; } } } } while (0)

struct XcdBarrier {
    unsigned* bar; unsigned x;
    volatile LAS unsigned* st;
};

__device__ __forceinline__ XcdBarrier xcd_barrier_post(unsigned* bar, volatile LAS unsigned* st) {
    XcdBarrier b; b.bar = bar; b.x = xb_xcc_id(); b.st = st;
    if (__builtin_amdgcn_workitem_id_x() == 0) (void)xb_add(&bar[XB_XCNT(b.x)], 1u);
    return b;
}
__device__ __forceinline__ void xcd_barrier_complete(unsigned* bar, unsigned x, unsigned& nloc, unsigned& nx) {
    const unsigned G = gridDim.x * gridDim.y * gridDim.z;
    unsigned sum, cnt, mine, sp = 0u;
    for (;;) {
        sum = 0u; cnt = 0u; mine = 0u;
#pragma unroll
        for (unsigned j = 0; j < 16; ++j) { const unsigned c = xb_ld(&bar[XB_XCNT(j)]); sum += c; cnt += (c > 0u) ? 1u : 0u; mine = (j == x) ? c : mine; }
        if (sum == G) break;
        __builtin_amdgcn_s_sleep(1);
        if ((++sp & 255u) == 0u) { if (xb_ld(&bar[XB_TMO])) break; if (sp > XB_SPIN_CAP) { atomicAdd(&bar[XB_TMO], 1u); break; } }
    }
    nloc = mine > 0u ? mine : 1u; nx = cnt > 0u ? cnt : 1u;
}

__device__ __forceinline__ void xcd_barrier(const XcdBarrier& b) {
    asm volatile("s_waitcnt vmcnt(0)" ::: "memory");
    __syncthreads();
    if (__builtin_amdgcn_workitem_id_x() == 0) {
        unsigned* bar = b.bar;
        __builtin_amdgcn_s_waitcnt(0);
        unsigned nloc = b.st[0], nx = b.st[1];
        if (nloc == 0u) { xcd_barrier_complete(bar, b.x, nloc, nx); b.st[0] = nloc; b.st[1] = nx; }
        const unsigned old = xb_add(&bar[XB_XSUB(b.x)], 1u);
        const unsigned gen = old / nloc;
        if (old + 1u == (gen + 1u) * nloc) {
            __builtin_amdgcn_fence(__ATOMIC_RELEASE, "agent");
            asm volatile("s_waitcnt vmcnt(0)" ::: "memory");
            const unsigned og = xb_add(&bar[XB_TOP], 1u);
            const unsigned tg = og / nx;
            if (og + 1u == (tg + 1u) * nx) xb_add(&bar[XB_TOPGEN], 1u);
            else XB_SPIN(xb_ld(&bar[XB_TOPGEN]) == tg, bar);
            __builtin_amdgcn_fence(__ATOMIC_ACQUIRE, "agent");
            xb_add(&bar[XB_XGEN(b.x)], 1u);
            asm volatile("s_waitcnt vmcnt(0)" ::: "memory");
        } else {
            XB_SPIN(xb_ld(&bar[XB_XGEN(b.x)]) == gen, bar);
            __builtin_amdgcn_fence(__ATOMIC_ACQUIRE, "agent");
            asm volatile("s_waitcnt vmcnt(0)" ::: "memory");
        }
    }
    __syncthreads();
}


#define SYNC xcd_barrier(xb); asm volatile("" : "+s"(l));
__global__ void __launch_bounds__(NTHR, 2) mega(P pv) {
#define p pv
  __shared__ __attribute__((aligned(16))) char lds[LDS_BYTES];
  __shared__ uint4 xb_words;
  cg::grid_group grid = cg::this_grid();
  {
    const int t0 = __builtin_amdgcn_workitem_id_x();
    if (blockIdx.x == 0) for (int i = t0; i < 4096; i += NTHR) pv.bar[i] = 0u;
    if (t0 == 0) xb_words = make_uint4(0u, 0u, 0u, 0u);
    __threadfence();
    grid.sync();
  }
  XcdBarrier xb = xcd_barrier_post(pv.bar, (volatile LAS unsigned*)&xb_words);
  for (int l = 0; l < 2; ++l) {
    const bool last = (l == 1);
    const int Mt2 = last ? 256 : 264;
    const int Mr2 = last ? M_LAT : M_ALL;
    ph_convert(p, l, l == 0, lds); SYNC
    if (l == 0) { ph_rows(p, 0, 0, 0, M_ALL, true, 0, 0); SYNC }
    ph_ffn_up(p, 0, 264, lds); SYNC
    ph_ffn_down(p, l, 0, 264, lds); SYNC
    ph_rows(p, 1, l, 0, M_ALL, true, l, 3); SYNC
    ph_z_rw(p, lds); SYNC
    ph_conv(p, l, 0); SYNC
    ph_lora(p, l, lds); SYNC
    {
      const int ns = gridDim.x >= 384 ? 192 : 0;
      if (ns == 0 || blockIdx.x < 192) ph_rwscan(p, lds);
      if (ns == 0) { SYNC }
      if ((int)blockIdx.x >= ns) ph_s5_stage(p, l, lds, (int)blockIdx.x - ns, (int)gridDim.x - ns);
      SYNC
    }
    ph_rwpost(p, l); SYNC
    ph_z_ml(p, lds); SYNC
    ph_conv(p, l, 1); SYNC
    ph_ml_a(p, l, lds); SYNC
    ph_ml_b(p); SYNC
    ph_ml_c(p, l, lds); SYNC
    ph_gates(p, l, Mt2, lds); SYNC
    ph_merge(p, l, Mt2, lds); SYNC
    ph_wout(p, l, Mt2, lds); SYNC
    ph_rows(p, 1, l, 1, Mr2, true, l, 6); SYNC
    ph_ffn_up(p, 1, Mt2, lds); SYNC
    ph_ffn_down(p, l, 1, Mt2, lds); SYNC
    ph_rows(p, 1, l, 2, Mr2, !last, l + 1, 0);
    if (!last) { SYNC }
  }
#undef p
}

extern "C" void kernel_launch(void* const* d_in, const int* in_sizes, int n_in, void* d_out, int out_size, void* d_ws, size_t ws_size,
                              hipStream_t stream) {
  static int grid_blocks = 0;
  if (!grid_blocks) {
    int dev = 0, cus = 0, per_cu = 0;
    hipGetDevice(&dev);
    hipDeviceGetAttribute(&cus, hipDeviceAttributeMultiprocessorCount, dev);
    hipOccupancyMaxActiveBlocksPerMultiprocessor(&per_cu, mega, NTHR, 0);
    if (per_cu > 2) per_cu = 2;
    grid_blocks = cus * per_cu;
  }
  P p{};
  for (int i = 0; i < 40; ++i) p.in[i] = (const float*)d_in[i];
  char* ws = (char*)d_ws;
  size_t off = 0;
  p.W = (bf16_t*)(ws + off); off += (size_t)W_TOTAL * 2;
  p.mod = (float*)(ws + off); off += (size_t)2 * 5 * 9216 * 4;
  p.sctx = (float*)(ws + off); off += (size_t)1024 * 1024 * 4;
  p.bar = (unsigned*)(ws + off); off += (size_t)16384;
  p.U = (bf16_t*)(ws + off); off += (size_t)M_ALL * 1024 * 2;
  p.Y = (bf16_t*)(ws + off); off += (size_t)M_ALL * 1024 * 2;
  p.R = ws + off;
  p.out = (float*)d_out;
  if (off + (size_t)M_ALL * 9728 > ws_size) fprintf(stderr, "workspace too small: need %zu have %zu\n", off + (size_t)M_ALL * 9728, ws_size);
  void* args[] = {&p};
  hipError_t e = hipLaunchCooperativeKernel((void*)mega, dim3(grid_blocks), dim3(NTHR), args, 0, stream);
  if (e != hipSuccess) fprintf(stderr, "cooperative launch failed: %s (grid %d)\n", hipGetErrorString(e), grid_blocks);
}
```

```cpp
#include <hip/hip_runtime.h>
#include <hip/hip_cooperative_groups.h>
#include <cstdio>
namespace cg = cooperative_groups;

typedef unsigned short bf16_t;
typedef _Float16 hf;
typedef hf hf4 __attribute__((ext_vector_type(4)));
typedef hf hf8 __attribute__((ext_vector_type(8)));
typedef __attribute__((ext_vector_type(8))) short bf16x8;
typedef __attribute__((ext_vector_type(4))) float f32x4;
typedef unsigned int u32x4 __attribute__((ext_vector_type(4)));

#define M_LAT 32768
#define M_ALL 33792
#define NTHR 256
#define LDS_BYTES 73728
#define ALPHA 1.41421356237f

#define W_GU0 0
#define W_D0 5767168
#define W_GU1 8650752
#define W_D1 14417920
#define W_IN 17301504
#define W_WUP0 23740416
#define W_WUP1 23764992
#define W_AUP0 23789568
#define W_AUP1 23814144
#define W_GUP 23838720
#define W_GLU 23887872
#define W_UPRW 23953408
#define W_UPS5 24346624
#define W_UPML 24608768
#define W_OUT 25001984
#define W_TOTAL 26050560

struct P {
  const float* in[40];
  float* out; float* sctx; float* mod;
  bf16_t* U; bf16_t* Y; bf16_t* W; char* R; unsigned* bar;
};

__device__ __forceinline__ int get_tid() { int t = __builtin_amdgcn_workitem_id_x(); asm volatile("" : "+v"(t)); return t; }
__device__ __forceinline__ bf16_t f2bf(float f) { return __builtin_bit_cast(unsigned short, (_Float16)f); }
__device__ __forceinline__ float bf2f(bf16_t h) { return (float)__builtin_bit_cast(_Float16, h); }
__device__ __forceinline__ float sigmoidf_(float x) { return 1.f / (1.f + __expf(-x)); }
__device__ __forceinline__ float siluf_(float x) { return x / (1.f + __expf(-x)); }
__device__ __forceinline__ float* srow(const P& p, int m) { return m < M_LAT ? p.out + (size_t)m * 1024 : p.sctx + (size_t)(m - M_LAT) * 1024; }
__device__ __forceinline__ const float* modp(const P& p, int l, int m, int k) { int mv = m < M_LAT ? (m >> 13) : 4; return p.mod + (size_t)(l * 5 + mv) * 9216 + k * 1024; }
template <int C> __device__ __forceinline__ float dppf(float x) { return __int_as_float(__builtin_amdgcn_update_dpp(0, __float_as_int(x), C, 0xf, 0xf, false)); }
__device__ __forceinline__ float rowsum16(float x) { x += dppf<0x128>(x); x += dppf<0x124>(x); x += dppf<0x122>(x); x += dppf<0x121>(x); return x; }
__device__ __forceinline__ float wavesum(float x) { for (int o = 32; o > 0; o >>= 1) x += __shfl_xor(x, o); return x; }

template <int NB>
__device__ __forceinline__ void gemm_main_t(const bf16_t* __restrict__ A, int lda, const bf16_t* __restrict__ B, int ldb, int K,
                                          f32x4 (&acc)[4][NB], char* lds) {
  const int tid = get_tid(), lane = tid & 63, wid = tid >> 6, wr = wid >> 1, wc = wid & 1;
  const int fr = lane & 15, fq = lane >> 4;
  const int sr = tid >> 3, skc = tid & 7;
  const bf16_t* ga = A + (size_t)sr * lda + skc * 8;
  const bf16_t* gb = B + (size_t)sr * ldb + skc * 8;
  u32x4 ra0[4], rb0[NB], ra1[4], rb1[NB];
  const int soff = sr * 144 + skc * 16;
  const int nk = K >> 6;
  const int aoff = (wr * 64 + fr) * 144 + fq * 16;
  const int boff = 18432 + (wc * (NB * 16) + fr) * 144 + fq * 16;
#define G_LOAD(RA, RB, kt) { _Pragma("unroll") for (int i = 0; i < 4; ++i) { RA[i] = *(const u32x4*)(ga + (size_t)(i * 32) * lda + (kt) * 64); if (i < NB) RB[i] = *(const u32x4*)(gb + (size_t)(i * 32) * ldb + (kt) * 64); } }
#define G_STORE(RA, RB, buf) { char* d_ = lds + (buf) * 36864 + soff; _Pragma("unroll") for (int i = 0; i < 4; ++i) { *(u32x4*)(d_ + i * 32 * 144) = RA[i]; if (i < NB) *(u32x4*)(d_ + 18432 + i * 32 * 144) = RB[i]; } }
#define G_COMP(buf) { const char* cur = lds + (buf) * 36864; _Pragma("unroll") for (int ks = 0; ks < 2; ++ks) { hf8 af[4], bfr[NB]; \
    _Pragma("unroll") for (int m = 0; m < 4; ++m) af[m] = *(const hf8*)(cur + aoff + m * 16 * 144 + ks * 64); \
    _Pragma("unroll") for (int n = 0; n < NB; ++n) bfr[n] = *(const hf8*)(cur + boff + n * 16 * 144 + ks * 64); \
    _Pragma("unroll") for (int m = 0; m < 4; ++m) _Pragma("unroll") for (int n = 0; n < NB; ++n) acc[m][n] = __builtin_amdgcn_mfma_f32_16x16x32_f16(af[m], bfr[n], acc[m][n], 0, 0, 0); } }
  G_LOAD(ra0, rb0, 0)
  { const int k1 = nk > 1 ? 1 : 0; G_LOAD(ra1, rb1, k1) }
  G_STORE(ra0, rb0, 0)
  __syncthreads();
  for (int kt = 0; kt < nk; kt += 2) {
    { const int k2 = kt + 2 < nk ? kt + 2 : nk - 1; G_LOAD(ra0, rb0, k2) }
    G_COMP(0)
    G_STORE(ra1, rb1, 1)
    __syncthreads();
    { const int k3 = kt + 3 < nk ? kt + 3 : nk - 1; G_LOAD(ra1, rb1, k3) }
    if (kt + 1 < nk) G_COMP(1)
    G_STORE(ra0, rb0, 0)
    __syncthreads();
  }
}
__device__ __forceinline__ void gemm_main(const bf16_t* __restrict__ A, int lda, const bf16_t* __restrict__ B, int ldb, int K, f32x4 (&acc)[4][4], char* lds) {
  gemm_main_t<4>(A, lda, B, ldb, K, acc, lds);
}

template <int SM>
__device__ __forceinline__ bool tile_map_sm(int b, int nb, int it, int Mt, int Nt, int SN, int& tm, int& tn) {
  const int xcd = b & 7, li = b >> 3, nloc = nb >> 3;
  const int T = SM * SN; const int nsn = Nt / SN; const int nsuper = (Mt / SM) * nsn;
  const int o = li + it * nloc; const int k = o / T, w = o - k * T;
  const int s = xcd + 8 * k;
  if (s >= nsuper) return false;
  const int sm = s / nsn, sn = s - sm * nsn;
  tm = sm * SM + (w % SM); tn = sn * SN + (w / SM);
  return true;
}
__device__ __forceinline__ bool tile_map_v(int b, int nb, int it, int Mt, int Nt, int SN, int& tm, int& tn) {
  const int nsn = Nt / SN;
  if (nsn * (Mt >> 3) % 8 == 0 || nsn >= 8) return tile_map_sm<8>(b, nb, it, Mt, Nt, SN, tm, tn);
  return tile_map_sm<1>(b, nb, it, Mt, Nt, SN, tm, tn);
}
__device__ __forceinline__ bool tile_map(int it, int Mt, int Nt, int SN, int& tm, int& tn) { return tile_map_v(blockIdx.x, gridDim.x, it, Mt, Nt, SN, tm, tn); }
#define ZERO_ACC(a) _Pragma("unroll") for (int m_ = 0; m_ < 4; ++m_) _Pragma("unroll") for (int n_ = 0; n_ < 4; ++n_) a[m_][n_] = (f32x4){0.f, 0.f, 0.f, 0.f};
#define EPI_VARS const int tid = get_tid(), lane = tid & 63, wid = tid >> 6, wr = wid >> 1, wc = wid & 1, fr = lane & 15, fq = lane >> 4; (void)wr; (void)wc; (void)fr; (void)fq;
#define EPI_ROW_BEGIN(m0) _Pragma("unroll") for (int m = 0; m < 4; ++m) _Pragma("unroll") for (int j = 0; j < 4; ++j) { const int row = (m0) + wr * 64 + m * 16 + fq * 4 + j; (void)row;
#define EPI_COL_BEGIN(n0) _Pragma("unroll") for (int n = 0; n < 4; ++n) { const int col = (n0) + wc * 64 + n * 16 + fr; const float val = acc[m][n][j]; (void)col; (void)val;
#define EPI_COL_END }
#define EPI_ROW_END }
#define EPI_BEGIN(m0, n0) EPI_ROW_BEGIN(m0) EPI_COL_BEGIN(n0)
#define EPI_END } }

struct Job { const float* src; int K, N; int dst; int mode; };
__device__ __forceinline__ Job get_job(const P& p, int l, int j) {
  Job r; r.mode = 0;
  switch (j) {
    case 0: r.src = p.in[8] + (size_t)(l * 2 + 0) * 1024 * 2816; r.K = 1024; r.N = 2816; r.dst = W_GU0; r.mode = 1; break;
    case 1: r.src = p.in[9] + (size_t)(l * 2 + 0) * 1024 * 2816; r.K = 1024; r.N = 2816; r.dst = W_GU0; r.mode = 2; break;
    case 2: r.src = p.in[10] + (size_t)(l * 2 + 0) * 2816 * 1024; r.K = 2816; r.N = 1024; r.dst = W_D0; break;
    case 3: r.src = p.in[8] + (size_t)(l * 2 + 1) * 1024 * 2816; r.K = 1024; r.N = 2816; r.dst = W_GU1; r.mode = 1; break;
    case 4: r.src = p.in[9] + (size_t)(l * 2 + 1) * 1024 * 2816; r.K = 1024; r.N = 2816; r.dst = W_GU1; r.mode = 2; break;
    case 5: r.src = p.in[10] + (size_t)(l * 2 + 1) * 2816 * 1024; r.K = 2816; r.N = 1024; r.dst = W_D1; break;
    case 6: r.src = p.in[11] + (size_t)l * 1024 * 6288; r.K = 1024; r.N = 6288; r.dst = W_IN; break;
    case 7: r.src = p.in[14] + (size_t)(l * 2 + 0) * 64 * 384; r.K = 64; r.N = 384; r.dst = W_WUP0; break;
    case 8: r.src = p.in[14] + (size_t)(l * 2 + 1) * 64 * 384; r.K = 64; r.N = 384; r.dst = W_WUP1; break;
    case 9: r.src = p.in[16] + (size_t)(l * 2 + 0) * 64 * 384; r.K = 64; r.N = 384; r.dst = W_AUP0; break;
    case 10: r.src = p.in[16] + (size_t)(l * 2 + 1) * 64 * 384; r.K = 64; r.N = 384; r.dst = W_AUP1; break;
    case 11: r.src = p.in[17] + (size_t)l * 128 * 384; r.K = 128; r.N = 384; r.dst = W_GUP; break;
    case 12: r.src = p.in[31] + (size_t)l * 256 * 256; r.K = 256; r.N = 256; r.dst = W_GLU; break;
    case 13: r.src = p.in[35] + (size_t)l * 384 * 1024; r.K = 384; r.N = 1024; r.dst = W_UPRW; break;
    case 14: r.src = p.in[36] + (size_t)l * 256 * 1024; r.K = 256; r.N = 1024; r.dst = W_UPS5; break;
    case 15: r.src = p.in[37] + (size_t)l * 384 * 1024; r.K = 384; r.N = 1024; r.dst = W_UPML; break;
    default: r.src = p.in[39] + (size_t)l * 1024 * 1024; r.K = 1024; r.N = 1024; r.dst = W_OUT; break;
  }
  return r;
}
#define NJOBS 17
__device__ void mod_task(const P& p, int t, char* lds) {
  float* sc = (float*)lds;
  float* red = sc + 5 * 1024;
  const int tid = get_tid();
  for (int i = tid; i < 5 * 1024; i += NTHR) {
    int v = i >> 10, k = i & 1023;
    float c = v < 4 ? p.in[1][v * 1024 + k] : p.in[3][k];
    sc[i] = siluf_(c);
  }
  __syncthreads();
  const int c0 = t * 64; const int l = c0 / 9216; const int j0 = c0 % 9216;
  const int col = tid & 63, part = tid >> 6;
  const float* w = p.in[4] + ((size_t)l * 1024 + part * 256) * 9216 + j0 + col;
  float a0 = 0, a1 = 0, a2 = 0, a3 = 0, a4 = 0;
  const float* s = sc + part * 256;
#pragma unroll 8
  for (int i = 0; i < 256; ++i) {
    float wv = w[(size_t)i * 9216];
    a0 += s[i] * wv; a1 += s[1024 + i] * wv; a2 += s[2048 + i] * wv; a3 += s[3072 + i] * wv; a4 += s[4096 + i] * wv;
  }
  red[(part * 5 + 0) * 64 + col] = a0; red[(part * 5 + 1) * 64 + col] = a1; red[(part * 5 + 2) * 64 + col] = a2;
  red[(part * 5 + 3) * 64 + col] = a3; red[(part * 5 + 4) * 64 + col] = a4;
  __syncthreads();
  for (int i = tid; i < 320; i += NTHR) {
    int v = i >> 6, c = i & 63;
    float sum = red[(0 * 5 + v) * 64 + c] + red[(1 * 5 + v) * 64 + c] + red[(2 * 5 + v) * 64 + c] + red[(3 * 5 + v) * 64 + c];
    p.mod[(size_t)(l * 5 + v) * 9216 + j0 + c] = sum + p.in[5][(size_t)l * 9216 + j0 + c];
  }
  __syncthreads();
}
__device__ __forceinline__ void ph_convert(const P& p, int l, bool with_mod, char* lds) {
  const int tid = get_tid();
  int ntiles[NJOBS]; int total = 0;
#pragma unroll
  for (int j = 0; j < NJOBS; ++j) { Job jb = get_job(p, l, j); ntiles[j] = (jb.K >> 6) * ((jb.N + 63) >> 6); total += ntiles[j]; }
  const int nmod = with_mod ? 288 : 0;
  float* tile = (float*)lds;
  for (int t = blockIdx.x; t < total + nmod; t += gridDim.x) {
    if (t < nmod) { mod_task(p, t, lds); continue; }
    int tt = t - nmod; int j = 0;
#pragma unroll
    for (int q = 0; q < NJOBS; ++q) { if (j == q && tt >= ntiles[q]) { tt -= ntiles[q]; j = q + 1; } }
    Job jb = get_job(p, l, j);
    const int nkt = jb.K >> 6;
    const int k0 = (tt % nkt) * 64, n0 = (tt / nkt) * 64;
    {
      const int c = tid & 63, r0 = tid >> 6;
      const bool ok = (n0 + c) < jb.N;
#pragma unroll
      for (int i = 0; i < 16; ++i) { int r = r0 + i * 4; tile[r * 65 + c] = ok ? jb.src[(size_t)(k0 + r) * jb.N + n0 + c] : 0.f; }
    }
    __syncthreads();
    {
      const int nn = tid >> 2, q = tid & 3; const int n = n0 + nn;
      if (n < jb.N) {
        int drow = n;
        if (jb.mode == 1) drow = (n >> 5) * 64 + (n & 31);
        else if (jb.mode == 2) drow = (n >> 5) * 64 + 32 + (n & 31);
        bf16_t* d = p.W + jb.dst + (size_t)drow * jb.K + k0 + q * 16;
        unsigned pk[8];
#pragma unroll
        for (int i = 0; i < 8; ++i) { unsigned lo = f2bf(tile[(q * 16 + 2 * i) * 65 + nn]); unsigned hi = f2bf(tile[(q * 16 + 2 * i + 1) * 65 + nn]); pk[i] = lo | (hi << 16); }
        *(uint4*)d = make_uint4(pk[0], pk[1], pk[2], pk[3]);
        *(uint4*)(d + 8) = make_uint4(pk[4], pk[5], pk[6], pk[7]);
      }
    }
    __syncthreads();
  }
}

__device__ __forceinline__ void ph_rows(const P& p, int mode, int l, int ln_idx, int Mrows, bool writeU, int ul, int ks) {
  const int lane = get_tid() & 63, wid = get_tid() >> 6;
  const int nw = gridDim.x * 4;
  const float* g = p.in[6] + (size_t)(l * 3 + ln_idx) * 1024;
  const float* b = p.in[7] + (size_t)(l * 3 + ln_idx) * 1024;
  for (int m = blockIdx.x * 4 + wid; m < Mrows; m += nw) {
    float* s = srow(p, m);
    const float* src = s;
    if (mode == 0) src = m < M_LAT ? p.in[0] + (size_t)m * 1024 : p.in[2] + (size_t)(m - M_LAT) * 1024;
    float4 v[4];
#pragma unroll
    for (int i = 0; i < 4; ++i) v[i] = *(const float4*)(src + lane * 4 + i * 256);
    if (mode == 1) {
      float sum = 0;
#pragma unroll
      for (int i = 0; i < 4; ++i) sum += v[i].x + v[i].y + v[i].z + v[i].w;
      sum = wavesum(sum);
      const float mean = sum * (1.f / 1024.f);
      float sq = 0;
#pragma unroll
      for (int i = 0; i < 4; ++i) { v[i].x -= mean; v[i].y -= mean; v[i].z -= mean; v[i].w -= mean; sq += v[i].x * v[i].x + v[i].y * v[i].y + v[i].z * v[i].z + v[i].w * v[i].w; }
      sq = wavesum(sq);
      const float rstd = rsqrtf(sq * (1.f / 1024.f) + 1e-5f);
#pragma unroll
      for (int i = 0; i < 4; ++i) {
        float4 gg = *(const float4*)(g + lane * 4 + i * 256), bb = *(const float4*)(b + lane * 4 + i * 256);
        v[i].x = v[i].x * rstd * gg.x + bb.x; v[i].y = v[i].y * rstd * gg.y + bb.y; v[i].z = v[i].z * rstd * gg.z + bb.z; v[i].w = v[i].w * rstd * gg.w + bb.w;
      }
    }
#pragma unroll
    for (int i = 0; i < 4; ++i) *(float4*)(s + lane * 4 + i * 256) = v[i];
    if (writeU) {
      const float* sh = modp(p, ul, m, ks); const float* scl = modp(p, ul, m, ks + 1);
#pragma unroll
      for (int i = 0; i < 4; ++i) {
        float4 a = *(const float4*)(sh + lane * 4 + i * 256), c = *(const float4*)(scl + lane * 4 + i * 256);
        unsigned lo = f2bf(v[i].x * (1.f + c.x) + a.x) | ((unsigned)f2bf(v[i].y * (1.f + c.y) + a.y) << 16);
        unsigned hi = f2bf(v[i].z * (1.f + c.z) + a.z) | ((unsigned)f2bf(v[i].w * (1.f + c.w) + a.w) << 16);
        *(uint2*)(p.U + (size_t)m * 1024 + lane * 4 + i * 256) = make_uint2(lo, hi);
      }
    }
  }
}

__device__ __forceinline__ void ph_ffn_up(const P& p, int s, int Mt, char* lds) {
  EPI_VARS
  bf16_t* HM = (bf16_t*)p.R;
  const bf16_t* Wt = p.W + (s ? W_GU1 : W_GU0);
  const int ntile = Mt * 44;
  for (int it = 0;; ++it) {
    int tm, tn; if (!tile_map(it, Mt, 44, 4, tm, tn)) break; const int m0 = tm * 128, n0 = tn * 128;
    f32x4 acc[4][4]; ZERO_ACC(acc)
    gemm_main(p.U + (size_t)m0 * 1024, 1024, Wt + (size_t)n0 * 1024, 1024, 1024, acc, lds);
    const int hb = ((n0 + wc * 64) >> 6) * 32;
#pragma unroll
    for (int m = 0; m < 4; ++m)
#pragma unroll
      for (int n = 0; n < 2; ++n)
#pragma unroll
        for (int j = 0; j < 4; ++j) {
          const int row = m0 + wr * 64 + m * 16 + fq * 4 + j; const int hc = hb + n * 16 + fr;
          HM[(size_t)row * 2816 + hc] = f2bf(siluf_(acc[m][n][j]) * acc[m][n + 2][j]);
        }
  }
}
__device__ __forceinline__ void ph_ffn_down(const P& p, int l, int s, int Mt, char* lds) {
  EPI_VARS
  const bf16_t* HM = (const bf16_t*)p.R;
  const bf16_t* Wt = p.W + (s ? W_D1 : W_D0);
  const int gk = s ? 8 : 2;
  const int ntile = Mt * 8;
  for (int it = 0;; ++it) {
    int tm, tn; if (!tile_map(it, Mt, 8, 8, tm, tn)) break; const int m0 = tm * 128, n0 = tn * 128;
    f32x4 acc[4][4]; ZERO_ACC(acc)
    gemm_main(HM + (size_t)m0 * 2816, 2816, Wt + (size_t)n0 * 2816, 2816, 2816, acc, lds);
    EPI_ROW_BEGIN(m0)
      float* sp = srow(p, row) + n0 + wc * 64 + fr; const float* gp = modp(p, l, row, gk) + n0 + wc * 64 + fr;
#pragma unroll
      for (int n = 0; n < 4; ++n) sp[n * 16] = ALPHA * sp[n * 16] + 0.5f * gp[n * 16] * acc[m][n][j];
    EPI_ROW_END
  }
}

#define RW_ZRW(p) ((hf*)(p).R)
#define RW_RKV(p) (RW_ZRW(p) + (size_t)M_ALL * 1152)
#define RW_LA(p) ((bf16_t*)(RW_RKV(p) + (size_t)M_ALL * 1152))
#define RW_KK(p) ((hf*)(RW_LA(p) + (size_t)M_ALL * 256))
#define RW_KD(p) (RW_KK(p) + (size_t)M_ALL * 384)
#define RW_KA(p) (RW_KD(p) + (size_t)2 * M_ALL * 384)
#define RW_YR(p) (RW_KA(p) + (size_t)2 * M_ALL * 384)

#define S5_ZH(p) ((hf*)RW_LA(p))
#define S5_YG(p) ((p).W + W_GU0)
#define S5_E(p) ((float2*)((p).R + (size_t)M_ALL * 9728))
#define S5_X(p) S5_E(p)

#define ML_Z(p) ((hf*)(p).R)
#define ML_GL(p) ((float*)(ML_Z(p) + (size_t)M_ALL * 1536))
#define ML_QK(p) ((hf*)(ML_GL(p) + (size_t)M_ALL * 16))
#define ML_DC(p) ((float*)(ML_QK(p) + (size_t)M_ALL * 768))
#define ML_DN(p) (ML_DC(p) + (size_t)4224 * 9216)
#define ML_SC(p) (ML_DN(p) + (size_t)4224 * 96)
#define ML_MP(p) (ML_SC(p) + (size_t)4224 * 2)

__device__ __forceinline__ void ph_z_rw(const P& p, char* lds) {
  EPI_VARS
  hf* ZRW = RW_ZRW(p); bf16_t* LA = RW_LA(p);
  const int Mt = 264; const int ntile = Mt * 11;
  for (int it = 0;; ++it) {
    int tm, tn; if (!tile_map(it, Mt, 11, 11, tm, tn)) break; const int m0 = tm * 128;
    const int wrow = tn < 9 ? tn * 128 : 2960 + (tn - 9) * 128;
    f32x4 acc[4][4]; ZERO_ACC(acc)
    gemm_main(p.U + (size_t)m0 * 1024, 1024, p.W + W_IN + (size_t)wrow * 1024, 1024, 1024, acc, lds);
    if (tn < 9) {
      EPI_BEGIN(m0, tn * 128)
        ZRW[(size_t)row * 1152 + col] = (hf)val;
      EPI_END
    } else {
      EPI_BEGIN(m0, (tn - 9) * 128)
        float o = col < 64 ? tanhf(val) : (col < 128 ? val : sigmoidf_(val));
        LA[(size_t)row * 256 + col] = f2bf(o);
      EPI_END
    }
  }
}
__device__ __forceinline__ void ph_z_s5(const P& p, char* lds, int vb, int nvb) {
  EPI_VARS
  hf* Z = S5_ZH(p);
  const int Mt = 264;
  for (int it = 0;; ++it) {
    int tm, tn; if (!tile_map_v(vb, nvb, it, Mt, 2, 2, tm, tn)) break; const int m0 = tm * 128;
    f32x4 acc[4][4]; ZERO_ACC(acc)
    gemm_main(p.U + (size_t)m0 * 1024, 1024, p.W + W_IN + (size_t)(2704 + tn * 128) * 1024, 1024, 1024, acc, lds);
    EPI_BEGIN(m0, tn * 128)
      Z[(size_t)row * 256 + col] = (hf)val;
    EPI_END
  }
}
__device__ __forceinline__ void ph_z_ml(const P& p, char* lds) {
  EPI_VARS
  hf* Z = ML_Z(p); float* GL = ML_GL(p);
  const int Mt = 264; const int ntile = Mt * 13;
  for (int it = 0;; ++it) {
    int tm, tn; if (!tile_map(it, Mt, 13, 13, tm, tn)) break; const int m0 = tm * 128;
    f32x4 acc[4][4]; ZERO_ACC(acc)
    gemm_main(p.U + (size_t)m0 * 1024, 1024, p.W + W_IN + (size_t)(1152 + tn * 128) * 1024, 1024, 1024, acc, lds);
    if (tn < 12) {
      EPI_BEGIN(m0, tn * 128)
        Z[(size_t)row * 1536 + col] = (hf)val;
      EPI_END
    } else {
      EPI_BEGIN(m0, 0)
        if (col < 16) GL[(size_t)row * 16 + col] = val;
      EPI_END
    }
  }
}

template <int which>
__device__ __forceinline__ void ph_conv(const P& p, int l) {
  constexpr int nch = which == 0 ? 144 : 96;
  constexpr int ldin = which == 0 ? 1152 : 1536;
  constexpr int cbase = which == 0 ? 0 : 1152;
  const hf* Zin = which == 0 ? RW_ZRW(p) : ML_Z(p);
  const float* cw = p.in[12] + (size_t)l * 9 * 1920;
  const unsigned total = (unsigned)(M_ALL / 4) * nch;
  for (unsigned idx = blockIdx.x * NTHR + get_tid(); idx < (total + 63u) / 64u * 64u; idx += gridDim.x * NTHR) {
    const bool act = idx < total;
    const int tg = act ? (int)(idx / (unsigned)nch) : 0; const int ch = act ? (int)(idx % (unsigned)nch) : 0; const int c0 = ch * 8;
    const int m0 = tg * 4;
    float o[4][8];
#pragma unroll
    for (int t = 0; t < 4; ++t)
#pragma unroll
      for (int i = 0; i < 8; ++i) o[t][i] = 0.f;
    const bool lat = m0 < M_LAT;
    const int bb = m0 >> 13, tt = lat ? (m0 & 8191) : ((m0 - M_LAT) & 255);
    const int gr = tt >> 6, gc0 = lat ? (tt & 63) : tt;
    const int ncol = lat ? 64 : 256;
#pragma unroll
    for (int dr = -1; dr <= 1; ++dr) {
      const int rr = gr + dr;
      const bool rowok = lat ? (rr >= 0 && rr < 128) : (dr == 0);
      if (!rowok) continue;
      const float* w = cw + ((dr + 1) * 3) * 1920 + cbase + c0;
      float wv[3][8];
#pragma unroll
      for (int k = 0; k < 3; ++k) { const float4 a = *(const float4*)(w + k * 1920), b = *(const float4*)(w + k * 1920 + 4);
        wv[k][0] = a.x; wv[k][1] = a.y; wv[k][2] = a.z; wv[k][3] = a.w; wv[k][4] = b.x; wv[k][5] = b.y; wv[k][6] = b.z; wv[k][7] = b.w; }
      const int mrow = lat ? ((bb << 13) + rr * 64) : (m0 - gc0);
#pragma unroll
      for (int cc = 0; cc < 6; ++cc) {
        const int col = gc0 - 1 + cc;
        if (col < 0 || col >= ncol) continue;
        const hf8 z = *(const hf8*)(Zin + (size_t)(mrow + col) * ldin + c0);
        float zf[8];
#pragma unroll
        for (int i = 0; i < 8; ++i) zf[i] = (float)z[i];
#pragma unroll
        for (int t = 0; t < 4; ++t) {
          const int k = cc - t;
          if (k >= 0 && k < 3) {
#pragma unroll
            for (int i = 0; i < 8; ++i) o[t][i] += zf[i] * wv[k][i];
          }
        }
      }
    }
#pragma unroll
    for (int t = 0; t < 4; ++t) {
      const int m = m0 + t;
      if (which == 0) {
        const bool isk = act && (c0 >= 384) && (c0 < 768);
        float kkv[8]; float ss = 0.f;
        if (isk) {
          const float* kkw = p.in[18] + (size_t)l * 384 + (c0 - 384);
#pragma unroll
          for (int i = 0; i < 8; ++i) { kkv[i] = o[t][i] * kkw[i]; ss += kkv[i] * kkv[i]; }
        } else {
#pragma unroll
          for (int i = 0; i < 8; ++i) kkv[i] = 0.f;
        }
        ss += __shfl_xor(ss, 1); ss += __shfl_xor(ss, 2); ss += __shfl_xor(ss, 4);
        if (act) {
          hf8 ov;
#pragma unroll
          for (int i = 0; i < 8; ++i) ov[i] = (hf)o[t][i];
          *(hf8*)(RW_RKV(p) + (size_t)m * 1152 + c0) = ov;
          if (isk) {
            const float rn = rsqrtf(fmaxf(ss, 1e-24f));
            hf8 kv;
#pragma unroll
            for (int i = 0; i < 8; ++i) kv[i] = (hf)(kkv[i] * rn);
            *(hf8*)(RW_KK(p) + (size_t)m * 384 + (c0 - 384)) = kv;
          }
        }
      } else if (act) {
        const float sc = c0 >= 384 ? 0.10206207261596575f : 1.f;
        hf8 ov;
#pragma unroll
        for (int i = 0; i < 8; ++i) ov[i] = (hf)(siluf_(o[t][i]) * sc);
        *(hf8*)(ML_QK(p) + (size_t)m * 768 + c0) = ov;
      }
    }
  }
}

__device__ __forceinline__ void ph_lora(const P& p, int l, char* lds) {
  EPI_VARS
  hf* ZRW = RW_ZRW(p); const hf* RKV = RW_RKV(p); const bf16_t* LA = RW_LA(p); const hf* KK = RW_KK(p);
  hf* KD = RW_KD(p); hf* KA = RW_KA(p);
  const int Mt = 264; const int ntile = Mt * 15;
  for (int it = 0;; ++it) {
    int tm, q; if (!tile_map(it, Mt, 15, 15, tm, q)) break; const int job = q / 3, tn = q % 3; const int m0 = tm * 128, n0 = tn * 128;
    f32x4 acc[4][4]; ZERO_ACC(acc)
    if (job < 2) {
      const int d = job;
      gemm_main(LA + (size_t)m0 * 256, 256, p.W + (d ? W_WUP1 : W_WUP0) + (size_t)n0 * 64, 64, 64, acc, lds);
      const float* w0 = p.in[13] + (size_t)(l * 2 + d) * 384;
      EPI_BEGIN(m0, n0)
        const float e = sigmoidf_(w0[col] + val) * 0.6065306597126334f;
        ZRW[(size_t)row * 1152 + d * 384 + col] = (hf)(-expm1f(-e));
      EPI_END
    } else if (job < 4) {
      const int d = job - 2;
      gemm_main(LA + (size_t)m0 * 256 + 64, 256, p.W + (d ? W_AUP1 : W_AUP0) + (size_t)n0 * 64, 64, 64, acc, lds);
      const float* a0 = p.in[15] + (size_t)(l * 2 + d) * 384; const float* kaw = p.in[19] + (size_t)l * 384;
      EPI_ROW_BEGIN(m0)
        const int cb = n0 + wc * 64 + fr;
        const hf* kp = RKV + (size_t)row * 1152 + 384 + cb; const hf* kkp = KK + (size_t)row * 384 + cb;
        hf* kdp = KD + ((size_t)d * M_ALL + row) * 384 + cb; hf* kap = KA + ((size_t)d * M_ALL + row) * 384 + cb;
#pragma unroll
        for (int n = 0; n < 4; ++n) {
          const float a = sigmoidf_(a0[cb + n * 16] + acc[m][n][j]);
          kdp[n * 16] = (hf)((float)kp[n * 16] * (1.f + (a - 1.f) * kaw[cb + n * 16]));
          kap[n * 16] = (hf)((float)kkp[n * 16] * a);
        }
      EPI_ROW_END
    } else {
      gemm_main(LA + (size_t)m0 * 256 + 128, 256, p.W + W_GUP + (size_t)n0 * 128, 128, 128, acc, lds);
      EPI_BEGIN(m0, n0)
        ZRW[(size_t)row * 1152 + 768 + col] = (hf)val;
      EPI_END
    }
  }
}

typedef float f32x2 __attribute__((ext_vector_type(2)));
#define RW_CH 16
#define RW_BUF 21504
__device__ __forceinline__ void rw_cvt_store(char* dst, uint4 q) {
  const hf8 h = __builtin_bit_cast(hf8, q);
  f32x4 a, b;
  a[0] = (float)h[0]; a[1] = (float)h[1]; a[2] = (float)h[2]; a[3] = (float)h[3];
  b[0] = (float)h[4]; b[1] = (float)h[5]; b[2] = (float)h[6]; b[3] = (float)h[7];
  *(f32x4*)dst = a; *(f32x4*)(dst + 16) = b;
}
__device__ __forceinline__ void ph_rwscan(const P& p, char* lds) {
  const hf* ZRW = RW_ZRW(p); hf* RKV = RW_RKV(p); const hf* KK = RW_KK(p);
  const int tid = get_tid(), lane = tid & 63, wid = tid >> 6;
  char* pbuf = lds + 3 * RW_BUF + wid * 2048;
  char* ybuf = lds + 3 * RW_BUF + 8192;
  for (int t = blockIdx.x; t < 192; t += gridDim.x) {
    const int rqq = t & 3, h = (t >> 2) % 6, b = (t / 24) & 3, d = t / 96;
    const int rsub = lane >> 4, g = lane & 15; const int rl = wid * 4 + rsub;
    const int sgn = d ? -1 : 1;
    const bool grpA = tid < 128; const int t2 = tid & 127;
    const int sstep = t2 >> 3, sseg = t2 & 7;
    const hf* g0 = grpA ? (RKV + h * 64 + sseg * 8) : (RW_KD(p) + (size_t)d * M_ALL * 384 + h * 64 + sseg * 8);
    const size_t ld0 = grpA ? 1152 : 384;
    const hf* g1 = grpA ? (KK + h * 64 + sseg * 8) : (RW_KA(p) + (size_t)d * M_ALL * 384 + h * 64 + sseg * 8);
    const hf* g2 = grpA ? (ZRW + d * 384 + h * 64 + sseg * 8) : (RKV + 768 + h * 64 + rqq * 16 + (t2 & 1) * 8);
    const int s2 = grpA ? sstep : (t2 >> 1);
    const bool has2 = grpA || t2 < 32;
    const int o0 = (grpA ? 0 : 12288) + sstep * 256 + sseg * 32;
    const int o1 = (grpA ? 4096 : 16384) + sstep * 256 + sseg * 32;
    const int o2 = grpA ? (8192 + sstep * 256 + sseg * 32) : (20480 + (t2 >> 1) * 64 + (t2 & 1) * 32);
    hf* g_y = d == 0 ? (RKV + 384 + h * 64 + rqq * 16 + (tid & 1) * 8) : (RW_YR(p) + h * 64 + rqq * 16 + (tid & 1) * 8);
    const int ldy = d == 0 ? 1152 : 384;
    uint4 q0, q1, q2;
#define RW_M0(pp) ((pp) < 256 ? (M_LAT + b * 256 + (d ? 255 - (pp) : (pp))) : (b * 8192 + (d ? 8447 - (pp) : (pp) - 256)))
#define RW_GLOAD(c) { const int mb_ = RW_M0((c) * RW_CH); const size_t mm = (size_t)(mb_ + sgn * sstep); \
      q0 = *(const uint4*)(g0 + mm * ld0); q1 = *(const uint4*)(g1 + mm * 384); \
      if (has2) { const size_t m2 = (size_t)(mb_ + sgn * s2); q2 = *(const uint4*)(g2 + m2 * 1152); } }
#define RW_SSTORE(c) { char* bb_ = lds + ((c) % 3) * RW_BUF; rw_cvt_store(bb_ + o0, q0); rw_cvt_store(bb_ + o1, q1); if (has2) rw_cvt_store(bb_ + o2, q2); }
    f32x2 S01 = (f32x2){0.f, 0.f}, S23 = (f32x2){0.f, 0.f};
    RW_GLOAD(0) RW_SSTORE(0)
    RW_GLOAD(1) RW_SSTORE(1)
    __syncthreads();
    const int NCH = 8448 / RW_CH;
    for (int c = 0; c < NCH; ++c) {
      if (c + 2 < NCH) RW_GLOAD(c + 2)
      if (c > 0 && tid < 32) {
        const int mb_ = RW_M0((c - 1) * RW_CH); const size_t mv = (size_t)(mb_ + sgn * (tid >> 1));
        *(uint4*)(g_y + mv * ldy) = *(const uint4*)(ybuf + ((c - 1) & 1) * 512 + tid * 16);
      }
      const char* cb = lds + (c % 3) * RW_BUF + g * 16;
      const char* vb = lds + (c % 3) * RW_BUF + 20480 + rl * 4;
      f32x4 R4[RW_CH], K4[RW_CH], D4[RW_CH], KD4[RW_CH], KA4[RW_CH]; float VV[RW_CH];
#define RW_LDS(s_) { R4[s_] = *(const f32x4*)(cb + (s_) * 256); K4[s_] = *(const f32x4*)(cb + 4096 + (s_) * 256); D4[s_] = *(const f32x4*)(cb + 8192 + (s_) * 256); \
        KD4[s_] = *(const f32x4*)(cb + 12288 + (s_) * 256); KA4[s_] = *(const f32x4*)(cb + 16384 + (s_) * 256); VV[s_] = *(const float*)(vb + (s_) * 64); }
      RW_LDS(0) RW_LDS(1) RW_LDS(2)
#pragma unroll
      for (int s = 0; s < RW_CH; ++s) {
        if (s + 3 < RW_CH) RW_LDS(s + 3)
        const f32x4 r4 = R4[s], k4 = K4[s], d4 = D4[s], kd4 = KD4[s], ka4 = KA4[s]; const float vv = VV[s];
        const f32x2 k01 = {k4[0], k4[1]}, k23 = {k4[2], k4[3]}, d01 = {d4[0], d4[1]}, d23 = {d4[2], d4[3]};
        const f32x2 kd01 = {kd4[0], kd4[1]}, kd23 = {kd4[2], kd4[3]}, ka01 = {ka4[0], ka4[1]}, ka23 = {ka4[2], ka4[3]};
        const f32x2 r01 = {r4[0], r4[1]}, r23 = {r4[2], r4[3]};
        const f32x2 sa2 = __builtin_elementwise_fma(S23, k23, S01 * k01);
        float sa = sa2[0] + sa2[1];
        sa = rowsum16(sa);
        const f32x2 vv2 = {vv, vv}; const f32x2 nsa = {-sa, -sa};
        f32x2 T01 = __builtin_elementwise_fma(-S01, d01, S01), T23 = __builtin_elementwise_fma(-S23, d23, S23);
        T01 = __builtin_elementwise_fma(vv2, kd01, T01); T23 = __builtin_elementwise_fma(vv2, kd23, T23);
        S01 = __builtin_elementwise_fma(nsa, ka01, T01); S23 = __builtin_elementwise_fma(nsa, ka23, T23);
        const f32x2 y2 = __builtin_elementwise_fma(S23, r23, S01 * r01);
        *(float*)(pbuf + (((s & 7) * 4 + rsub) * 16 + g) * 4) = y2[0] + y2[1];
        if ((s & 7) == 7) {
          if (lane < 32) {
            const char* pr = pbuf + lane * 64;
            const f32x4 a0 = *(const f32x4*)(pr), a1 = *(const f32x4*)(pr + 16), a2 = *(const f32x4*)(pr + 32), a3 = *(const f32x4*)(pr + 48);
            const f32x4 sm = (a0 + a1) + (a2 + a3);
            const float y = (sm[0] + sm[1]) + (sm[2] + sm[3]);
            *(hf*)(ybuf + (c & 1) * 512 + (((s >> 3) * 8 + (lane >> 2)) * 16 + wid * 4 + (lane & 3)) * 2) = (hf)y;
          }
        }
      }
      if (c + 2 < NCH) RW_SSTORE(c + 2)
      __syncthreads();
    }
    if (tid < 32) {
      const int mb_ = RW_M0((NCH - 1) * RW_CH); const size_t mv = (size_t)(mb_ + sgn * (tid >> 1));
      *(uint4*)(g_y + mv * ldy) = *(const uint4*)(ybuf + ((NCH - 1) & 1) * 512 + tid * 16);
    }
    __syncthreads();
  }
}

__device__ __forceinline__ void ph_rwpost(const P& p, int l) {
  const hf* ZRW = RW_ZRW(p); const hf* RKV = RW_RKV(p); const hf* YR = RW_YR(p);
  const int lane = get_tid() & 63, wid = get_tid() >> 6;
  const int nw = gridDim.x * 4;
  for (int t = blockIdx.x * 4 + wid; t < M_ALL * 6; t += nw) {
    const int m = t / 6, h = t % 6; const int c = h * 64 + lane;
    const float ys = (float)RKV[(size_t)m * 1152 + 384 + c] + (float)YR[(size_t)m * 384 + c];
    const float mean = wavesum(ys) * (1.f / 64.f);
    const float xc = ys - mean;
    const float var = wavesum(xc * xc) * (1.f / 64.f);
    float y = xc * rsqrtf(var + 64e-5f) * p.in[21][(size_t)l * 384 + c] + p.in[22][(size_t)l * 384 + c];
    const float r = (float)RKV[(size_t)m * 1152 + c], v = (float)RKV[(size_t)m * 1152 + 768 + c];
    const float rk = p.in[20][(size_t)l * 384 + c];
    const float kd0 = (float)RW_KD(p)[(size_t)m * 384 + c], kd1 = (float)RW_KD(p)[((size_t)M_ALL + m) * 384 + c];
    const float bs = wavesum(r * (kd0 + kd1) * rk);
    y = (y + bs * v) * (float)ZRW[(size_t)m * 1152 + 768 + c];
    p.Y[(size_t)m * 1024 + c] = f2bf(y);
  }
}

struct S5C { float ar, ai; float br[16], bi[16]; };
__device__ __forceinline__ void s5_consts(const P& p, int l, int d, int g, int n, S5C& c) {
  const int ig = (l * 2 + d) * 16 + g;
  const float lr = fminf(p.in[23][(size_t)ig * 64 + n], -1e-4f), li = p.in[24][(size_t)ig * 64 + n];
  const float dt = expf(p.in[25][ig]);
  const float mag = expf(lr * dt);
  c.ar = mag * cosf(li * dt); c.ai = mag * sinf(li * dt);
  const float nr = c.ar - 1.f, ni = c.ai; const float den = 1.f / (lr * lr + li * li);
  const float cr = (nr * lr + ni * li) * den, ci = (ni * lr - nr * li) * den;
  const float* bre = p.in[26] + ((size_t)ig * 64 + n) * 16; const float* bim = p.in[27] + ((size_t)ig * 64 + n) * 16;
#pragma unroll
  for (int h = 0; h < 16; ++h) { const float xr = bre[h], xi = bim[h]; c.br[h] = cr * xr - ci * xi; c.bi[h] = cr * xi + ci * xr; }
}
__device__ __forceinline__ int s5_m0(int b, int tc) { return tc < 128 ? b * 8192 + tc * 64 : M_LAT + b * 256 + (tc - 128) * 64; }
__device__ __forceinline__ int chain_pos(int d, int tc) { return d == 0 ? (tc < 128 ? tc + 4 : tc - 128) : (tc < 128 ? 131 - tc : 131 - tc); }
__device__ __forceinline__ void ph_s5_pass(const P& p, int l, int pass, char* lds, int vb, int nvb) {
  const int tid = get_tid(), lane = tid & 63, wid = tid >> 6, fr = lane & 15, fq = lane >> 4;
  float* ub = (float*)(lds + wid * 8448);
  char* xs = lds + wid * 8448 + 4096;
  const hf* Z = S5_ZH(p); float2* E = S5_E(p); const float2* X = S5_X(p); bf16_t* YG = S5_YG(p);
  const int nw = nvb * 4;
  for (int t = vb * 4 + wid; t < 4 * 132 * 16; t += nw) {
    const int g = t & 15, tc = (t >> 4) % 132, b = t / (16 * 132);
    const int m0 = s5_m0(b, tc);
#pragma unroll
    for (int i = 0; i < 4; ++i) { const int e = lane + i * 64; const int tok = e >> 2, q = e & 3;
      const hf4 zv = *(const hf4*)(Z + (size_t)(m0 + tok) * 256 + g * 16 + q * 4);
      *(float4*)(ub + tok * 16 + q * 4) = make_float4((float)zv[0], (float)zv[1], (float)zv[2], (float)zv[3]); }
    f32x4 yacc[4];
#pragma unroll
    for (int i = 0; i < 4; ++i) yacc[i] = (f32x4){0.f, 0.f, 0.f, 0.f};
    for (int d = 0; d < 2; ++d) {
      S5C c; s5_consts(p, l, d, g, lane, c);
      const int cp = chain_pos(d, tc);
      const size_t sidx = (((size_t)(d * 4 + b) * 132 + cp) * 16 + g) * 64 + lane;
      float xr = 0.f, xi = 0.f;
      hf8 cf[4];
      if (pass == 3) {
        float2 x0 = X[sidx]; xr = x0.x; xi = x0.y;
        const int ig = (l * 2 + d) * 16 + g;
#pragma unroll
        for (int ks = 0; ks < 4; ++ks) {
          const int c0 = ks * 32 + fq * 8;
          const float* src_ = (c0 < 64 ? p.in[28] : p.in[29]) + ((size_t)ig * 16 + fr) * 64 + (c0 & 63);
          const float sg = c0 < 64 ? 1.f : -1.f;
          const float4 v0 = *(const float4*)src_, v1 = *(const float4*)(src_ + 4);
          cf[ks][0] = (hf)(sg * v0.x); cf[ks][1] = (hf)(sg * v0.y); cf[ks][2] = (hf)(sg * v0.z); cf[ks][3] = (hf)(sg * v0.w);
          cf[ks][4] = (hf)(sg * v1.x); cf[ks][5] = (hf)(sg * v1.y); cf[ks][6] = (hf)(sg * v1.z); cf[ks][7] = (hf)(sg * v1.w);
        }
      }
#pragma unroll 1
      for (int jb = 0; jb < 4; ++jb) {
        const int tb = d ? 3 - jb : jb;
#pragma unroll 4
        for (int jj = 0; jj < 16; ++jj) {
          const int t16 = d ? 15 - jj : jj;
          const float* u = ub + (tb * 16 + t16) * 16;
          float br = 0.f, bi = 0.f;
#pragma unroll
          for (int h = 0; h < 16; ++h) { const float uv = u[h]; br += c.br[h] * uv; bi += c.bi[h] * uv; }
          const float nr = c.ar * xr - c.ai * xi + br, ni = c.ar * xi + c.ai * xr + bi;
          xr = nr; xi = ni;
          if (pass == 3) { *(hf*)(xs + t16 * 272 + lane * 2) = (hf)xr; *(hf*)(xs + t16 * 272 + 128 + lane * 2) = (hf)xi; }
        }
        if (pass == 3) {
          f32x4 acc = (f32x4){0.f, 0.f, 0.f, 0.f};
#pragma unroll
          for (int ks = 0; ks < 4; ++ks) {
            const hf8 af = *(const hf8*)(xs + fr * 272 + ks * 64 + fq * 16);
            acc = __builtin_amdgcn_mfma_f32_16x16x32_f16(af, cf[ks], acc, 0, 0, 0);
          }
#pragma unroll
          for (int i = 0; i < 4; ++i) if (i == tb) yacc[i] += acc;
        }
      }
      if (pass == 1) E[sidx] = make_float2(xr, xi);
    }
    if (pass == 3) {
      const float dsk = p.in[30][(size_t)l * 256 + g * 16 + fr];
#pragma unroll
      for (int i = 0; i < 4; ++i)
#pragma unroll
        for (int j = 0; j < 4; ++j) {
          const int tok = i * 16 + fq * 4 + j;
          float y = yacc[i][j] + dsk * ub[tok * 16 + fr];
          const float inner = 0.7978845608028654f * (y + 0.044715f * y * y * y);
          y = 0.5f * y * (1.f + tanhf(inner));
          YG[(size_t)(m0 + tok) * 256 + g * 16 + fr] = f2bf(y);
        }
    }
  }
}
__device__ __forceinline__ void ph_s5_carry(const P& p, int l, int vb, int nvb) {
  float2* E = S5_E(p); float2* X = S5_X(p);
  for (int t = vb * NTHR + get_tid(); t < 8192; t += nvb * NTHR) {
    const int n = t & 63, g = (t >> 6) & 15, b = (t >> 10) & 3, d = t >> 12;
    const int ig = (l * 2 + d) * 16 + g;
    const float lr = fminf(p.in[23][(size_t)ig * 64 + n], -1e-4f), li = p.in[24][(size_t)ig * 64 + n];
    const float dt = expf(p.in[25][ig]);
    const float mag = expf(lr * dt * 64.f);
    float ar = expf(lr * dt) * cosf(li * dt), ai = expf(lr * dt) * sinf(li * dt);
#pragma unroll
    for (int i = 0; i < 6; ++i) { const float r2 = ar * ar - ai * ai, i2 = 2.f * ar * ai; ar = r2; ai = i2; }
    (void)mag;
    float xr = 0.f, xi = 0.f;
    const size_t base = (((size_t)(d * 4 + b) * 132) * 16 + g) * 64 + n;
    for (int cp0 = 0; cp0 < 132; cp0 += 12) {
      float2 ev[12];
#pragma unroll
      for (int u = 0; u < 12; ++u) ev[u] = E[base + (size_t)(cp0 + u) * 1024];
#pragma unroll
      for (int u = 0; u < 12; ++u) {
        X[base + (size_t)(cp0 + u) * 1024] = make_float2(xr, xi);
        const float nr = ar * xr - ai * xi + ev[u].x, ni = ar * xi + ai * xr + ev[u].y;
        xr = nr; xi = ni;
      }
    }
  }
}
__device__ __forceinline__ void ph_glu(const P& p, int l, char* lds, int vb, int nvb) {
  EPI_VARS
  const bf16_t* YG = S5_YG(p);
  const int Mt = 264;
  const float* gb = p.in[32] + (size_t)l * 256;
  for (int it = 0;; ++it) {
    int tm, tn; if (!tile_map_v(vb, nvb, it, Mt, 2, 2, tm, tn)) break; const int m0 = tm * 128, n0 = tn * 128;
    f32x4 acc[4][4]; ZERO_ACC(acc)
    gemm_main(YG + (size_t)m0 * 256, 256, p.W + W_GLU + (size_t)n0 * 256, 256, 256, acc, lds);
    EPI_BEGIN(m0, n0)
      const float y = bf2f(YG[(size_t)row * 256 + col]);
      p.Y[(size_t)row * 1024 + 384 + col] = f2bf(y * sigmoidf_(val + gb[col]));
    EPI_END
  }
}

__device__ __forceinline__ void sub_barrier(unsigned* cnt, unsigned target) {
  asm volatile("s_waitcnt vmcnt(0)" ::: "memory");
  __syncthreads();
  if (__builtin_amdgcn_workitem_id_x() == 0) {
    __builtin_amdgcn_fence(__ATOMIC_RELEASE, "agent");
    asm volatile("s_waitcnt vmcnt(0)" ::: "memory");
    __hip_atomic_fetch_add(cnt, 1u, __ATOMIC_RELAXED, __HIP_MEMORY_SCOPE_AGENT);
    unsigned sp = 0;
    while (__hip_atomic_load(cnt, __ATOMIC_RELAXED, __HIP_MEMORY_SCOPE_AGENT) < target) { __builtin_amdgcn_s_sleep(2); if (++sp > (1u << 22)) break; }
    __builtin_amdgcn_fence(__ATOMIC_ACQUIRE, "agent");
    asm volatile("s_waitcnt vmcnt(0)" ::: "memory");
  }
  __syncthreads();
}
__device__ __forceinline__ void ph_s5_stage(const P& p, int l, char* lds, int vb, int nvb) {
  unsigned* cnt = p.bar + 3584;
  const unsigned base = (unsigned)(l * 4) * (unsigned)nvb;
  ph_z_s5(p, lds, vb, nvb);            sub_barrier(cnt, base + 1u * nvb);
  ph_s5_pass(p, l, 1, lds, vb, nvb);   sub_barrier(cnt, base + 2u * nvb);
  ph_s5_carry(p, l, vb, nvb);          sub_barrier(cnt, base + 3u * nvb);
  ph_s5_pass(p, l, 3, lds, vb, nvb);   sub_barrier(cnt, base + 4u * nvb);
  ph_glu(p, l, lds, vb, nvb);
}

__device__ __forceinline__ float logsigf_(float x) { return fminf(x, 0.f) - log1pf(__expf(-fabsf(x))); }
__device__ __forceinline__ void ml_gates(const P& p, int l, int d, int h, int m0, int lane, float& bcum, float& ic) {
  const int tok = d ? 63 - lane : lane;
  const float* gl = ML_GL(p) + (size_t)(m0 + tok) * 16;
  const float* gb = p.in[33] + (size_t)(l * 2 + d) * 8;
  ic = gl[d * 8 + h] + gb[h];
  float f = logsigf_(gl[d * 8 + 4 + h] + gb[4 + h]);
#pragma unroll
  for (int o = 1; o < 64; o <<= 1) { float v = __shfl_up(f, o); if (lane >= o) f += v; }
  bcum = f;
}
__device__ __forceinline__ void ml_gates2(const P& p, int l, int d, int h, int m0, int lane, float& bc, float& ic, float& tot) {
  const float* gl = ML_GL(p) + (size_t)(m0 + lane) * 16;
  const float* gb = p.in[33] + (size_t)(l * 2 + d) * 8;
  ic = gl[d * 8 + h] + gb[h];
  const float f0 = logsigf_(gl[d * 8 + 4 + h] + gb[4 + h]);
  float f = f0;
#pragma unroll
  for (int o = 1; o < 64; o <<= 1) { float v = __shfl_up(f, o); if (lane >= o) f += v; }
  tot = __shfl(f, 63);
  bc = d ? (tot - f + f0) : f;
}
#define MLQ 208
#define MLS 144
__device__ __forceinline__ void ph_ml_a(const P& p, int l, char* lds) {
  char* vt = lds; char* kt = lds + 13824; float* wg = (float*)(lds + 27648);
  const int tid = get_tid(), lane = tid & 63, wid = tid >> 6, fr = lane & 15, fq = lane >> 4;
  const hf* QK = ML_QK(p); const hf* Z = ML_Z(p);
  for (int t = blockIdx.x; t < 4224; t += gridDim.x) {
    const int tc = t % 132, h = (t / 132) & 3, b = (t / 528) & 3, d = t / 2112;
    const int m0 = s5_m0(b, tc); const int cp = chain_pos(d, tc);
    const size_t task = ((size_t)((d * 4 + b) * 4 + h)) * 132 + cp;
    if (wid == 0) {
      float bc, ic, tot; ml_gates2(p, l, d, h, m0, lane, bc, ic, tot);
      const float lw = tot - bc + ic;
      float mx = lw;
      for (int o = 32; o > 0; o >>= 1) mx = fmaxf(mx, __shfl_xor(mx, o));
      wg[lane] = __expf(lw - mx);
      if (lane == 0) { ML_SC(p)[task * 2] = mx; ML_SC(p)[task * 2 + 1] = tot; }
    }
    __syncthreads();
    for (int e = tid; e < 64 * 12; e += NTHR) {
      const int tok = e & 63, q = e >> 6;
      const hf8 kv = *(const hf8*)(QK + (size_t)(m0 + tok) * 768 + 384 + h * 96 + q * 8);
      const hf8 vv = *(const hf8*)(Z + (size_t)(m0 + tok) * 1536 + 768 + h * 96 + q * 8);
      const float w = wg[tok];
#pragma unroll
      for (int i = 0; i < 8; ++i) {
        *(hf*)(kt + (q * 8 + i) * MLS + tok * 2) = kv[i];
        *(hf*)(vt + (q * 8 + i) * MLS + tok * 2) = (hf)((float)vv[i] * w);
      }
    }
    __syncthreads();
    float* dc = ML_DC(p) + task * 9216;
#pragma unroll 1
    for (int bi = 0; bi < 9; ++bi) {
      const int idx = wid * 9 + bi; const int mb = idx / 6, nb = idx % 6;
      f32x4 acc = (f32x4){0.f, 0.f, 0.f, 0.f};
#pragma unroll
      for (int ks = 0; ks < 2; ++ks) {
        const hf8 af = *(const hf8*)(vt + (mb * 16 + fr) * MLS + ks * 64 + fq * 16);
        const hf8 bf = *(const hf8*)(kt + (nb * 16 + fr) * MLS + ks * 64 + fq * 16);
        acc = __builtin_amdgcn_mfma_f32_16x16x32_f16(af, bf, acc, 0, 0, 0);
      }
#pragma unroll
      for (int j = 0; j < 4; ++j) dc[(mb * 16 + fq * 4 + j) * 96 + nb * 16 + fr] = acc[j];
    }
    if (tid < 96) {
      float s = 0.f;
      for (int j = 0; j < 64; ++j) s += wg[j] * (float)*(const hf*)(kt + tid * MLS + j * 2);
      ML_DN(p)[task * 96 + tid] = s;
    }
    __syncthreads();
  }
}
__device__ __forceinline__ void ph_ml_b(const P& p) {
  float* DC = ML_DC(p); float* DN = ML_DN(p); const float* SC = ML_SC(p); float* MP = ML_MP(p);
  for (int t = blockIdx.x * NTHR + get_tid(); t < 32 * 9312; t += gridDim.x * NTHR) {
    const int chain = t / 9312, e = t % 9312;
    float cur = 0.f, mprev = 0.f;
    for (int cp0 = 0; cp0 < 132; cp0 += 12) {
      float dl[12], ml_[12], bl_[12];
#pragma unroll
      for (int u = 0; u < 12; ++u) {
        const size_t task = (size_t)chain * 132 + cp0 + u;
        dl[u] = e < 9216 ? DC[task * 9216 + e] : DN[task * 96 + (e - 9216)];
        ml_[u] = SC[task * 2]; bl_[u] = SC[task * 2 + 1];
      }
#pragma unroll
      for (int u = 0; u < 12; ++u) {
        const size_t task = (size_t)chain * 132 + cp0 + u;
        float* slot = e < 9216 ? DC + task * 9216 + e : DN + task * 96 + (e - 9216);
        *slot = cur;
        if (e == 0) MP[task] = mprev;
        const float mnew = fmaxf(bl_[u] + mprev, ml_[u]);
        cur = __expf(bl_[u] + mprev - mnew) * cur + __expf(ml_[u] - mnew) * dl[u];
        mprev = mnew;
      }
    }
  }
}
__device__ __forceinline__ void ph_ml_c(const P& p, int l, char* lds) {
  char* qs = lds; char* ks = lds + 13312; char* vt = lds + 26624; char* cs = lds + 40448; char* ps = lds + 60416;
  float* fl = (float*)(lds + 69632);
  float* bc = fl; float* icv = fl + 128; float* mr = fl + 256; float* inter = fl + 320; float* den = fl + 384; float* nq = fl + 448; float* nst = fl + 512;
  const int tid = get_tid(), lane = tid & 63, wid = tid >> 6, fr = lane & 15, fq = lane >> 4;
  const hf* QK = ML_QK(p); const hf* Z = ML_Z(p);
  for (int t = blockIdx.x; t < 2112; t += gridDim.x) {
    const int tc = t % 132, h = (t / 132) & 3, b = t / 528;
    const int m0 = s5_m0(b, tc);
    for (int e = tid; e < 64 * 12; e += NTHR) {
      const int tok = e & 63, q = e >> 6;
      *(hf8*)(qs + tok * MLQ + q * 16) = *(const hf8*)(QK + (size_t)(m0 + tok) * 768 + h * 96 + q * 8);
      *(hf8*)(ks + tok * MLQ + q * 16) = *(const hf8*)(QK + (size_t)(m0 + tok) * 768 + 384 + h * 96 + q * 8);
      const hf8 vv = *(const hf8*)(Z + (size_t)(m0 + tok) * 1536 + 768 + h * 96 + q * 8);
#pragma unroll
      for (int i = 0; i < 8; ++i) *(hf*)(vt + (q * 8 + i) * MLS + tok * 2) = vv[i];
    }
    if (wid < 2) { float bcv, ic, tot; ml_gates2(p, l, wid, h, m0, lane, bcv, ic, tot); bc[wid * 64 + lane] = bcv; icv[wid * 64 + lane] = ic; }
    f32x4 hs[6];
#pragma unroll
    for (int n = 0; n < 6; ++n) hs[n] = (f32x4){0.f, 0.f, 0.f, 0.f};
    for (int d = 0; d < 2; ++d) {
      const int cp = chain_pos(d, tc);
      const size_t task = ((size_t)((d * 4 + b) * 4 + h)) * 132 + cp;
      const float mprev = ML_MP(p)[task];
      __syncthreads();
      {
        const float* cg = ML_DC(p) + task * 9216;
        for (int e = tid; e < 96 * 24; e += NTHR) {
          const int v = e / 24, q = e % 24;
          const float4 c4 = *(const float4*)(cg + v * 96 + q * 4);
          hf4 o; o[0] = (hf)c4.x; o[1] = (hf)c4.y; o[2] = (hf)c4.z; o[3] = (hf)c4.w;
          *(hf4*)(cs + v * MLQ + q * 8) = o;
        }
        if (tid < 96) nst[tid] = ML_DN(p)[task * 96 + tid];
      }
      const float* bcd = bc + d * 64; const float* icd = icv + d * 64;
      if (tid < 64) {
        const int j = tid; const float bj = bcd[j];
        float mx = bj + mprev;
        if (d == 0) { for (int s = 0; s <= j; ++s) mx = fmaxf(mx, bj - bcd[s] + icd[s]); }
        else { for (int s = j; s < 64; ++s) mx = fmaxf(mx, bj - bcd[s] + icd[s]); }
        mr[j] = mx; inter[j] = __expf(bj + mprev - mx);
      }
      __syncthreads();
      if (tid < 64) {
        float s1 = 0.f;
        for (int k = 0; k < 96; ++k) s1 += nst[k] * (float)*(const hf*)(qs + tid * MLQ + k * 2);
        nq[tid] = s1;
      }
      {
        f32x4 sacc[4];
#pragma unroll
        for (int n = 0; n < 4; ++n) sacc[n] = (f32x4){0.f, 0.f, 0.f, 0.f};
#pragma unroll
        for (int kk = 0; kk < 3; ++kk) {
          const hf8 af = *(const hf8*)(qs + (wid * 16 + fr) * MLQ + kk * 64 + fq * 16);
#pragma unroll
          for (int n = 0; n < 4; ++n) {
            const hf8 bf = *(const hf8*)(ks + (n * 16 + fr) * MLQ + kk * 64 + fq * 16);
            sacc[n] = __builtin_amdgcn_mfma_f32_16x16x32_f16(af, bf, sacc[n], 0, 0, 0);
          }
        }
        float rs[4] = {0.f, 0.f, 0.f, 0.f};
#pragma unroll
        for (int n = 0; n < 4; ++n) {
          const int s = n * 16 + fr; const float bs = bcd[s] - icd[s];
#pragma unroll
          for (int jj = 0; jj < 4; ++jj) {
            const int j = wid * 16 + fq * 4 + jj;
            const bool valid = d == 0 ? (s <= j) : (s >= j);
            const float val = valid ? sacc[n][jj] * __expf(bcd[j] - bs - mr[j]) : 0.f;
            rs[jj] += val;
            *(hf*)(ps + j * MLS + s * 2) = (hf)val;
          }
        }
        __syncthreads();
#pragma unroll
        for (int jj = 0; jj < 4; ++jj) {
          const float r = rowsum16(rs[jj]);
          const int j = wid * 16 + fq * 4 + jj;
          if (fr == 0) den[j] = inter[j] * nq[j] + r;
        }
      }
      f32x4 acc[6];
#pragma unroll
      for (int n = 0; n < 6; ++n) acc[n] = (f32x4){0.f, 0.f, 0.f, 0.f};
#pragma unroll
      for (int kk = 0; kk < 3; ++kk) {
        const hf8 af = *(const hf8*)(qs + (wid * 16 + fr) * MLQ + kk * 64 + fq * 16);
#pragma unroll
        for (int n = 0; n < 6; ++n) {
          const hf8 bf = *(const hf8*)(cs + (n * 16 + fr) * MLQ + kk * 64 + fq * 16);
          acc[n] = __builtin_amdgcn_mfma_f32_16x16x32_f16(af, bf, acc[n], 0, 0, 0);
        }
      }
#pragma unroll
      for (int jj = 0; jj < 4; ++jj) { const float it = inter[wid * 16 + fq * 4 + jj];
#pragma unroll
        for (int n = 0; n < 6; ++n) acc[n][jj] *= it; }
#pragma unroll
      for (int kk = 0; kk < 2; ++kk) {
        const hf8 af = *(const hf8*)(ps + (wid * 16 + fr) * MLS + kk * 64 + fq * 16);
#pragma unroll
        for (int n = 0; n < 6; ++n) {
          const hf8 bf = *(const hf8*)(vt + (n * 16 + fr) * MLS + kk * 64 + fq * 16);
          acc[n] = __builtin_amdgcn_mfma_f32_16x16x32_f16(af, bf, acc[n], 0, 0, 0);
        }
      }
      __syncthreads();
#pragma unroll
      for (int jj = 0; jj < 4; ++jj) {
        const int j = wid * 16 + fq * 4 + jj;
        const float dn = 1.f / fmaxf(fabsf(den[j]), __expf(-mr[j]));
#pragma unroll
        for (int n = 0; n < 6; ++n) hs[n][jj] += acc[n][jj] * dn;
      }
    }
#pragma unroll
    for (int jj = 0; jj < 4; ++jj) {
      const int m = m0 + wid * 16 + fq * 4 + jj;
      const hf* op = Z + (size_t)m * 1536 + 1152 + h * 96 + fr;
      float x[6]; float s = 0.f;
#pragma unroll
      for (int n = 0; n < 6; ++n) { x[n] = sigmoidf_((float)op[n * 16]) * hs[n][jj]; s += x[n]; }
      s = rowsum16(s);
      const float mean = s * (1.f / 96.f);
      float q = 0.f;
#pragma unroll
      for (int n = 0; n < 6; ++n) { x[n] -= mean; q += x[n] * x[n]; }
      q = rowsum16(q);
      const float rsd = rsqrtf(q * (1.f / 96.f) + 1e-5f);
      const float* ng = p.in[34] + (size_t)l * 384 + h * 96 + fr;
      bf16_t* yp = p.Y + (size_t)m * 1024 + 640 + h * 96 + fr;
#pragma unroll
      for (int n = 0; n < 6; ++n) yp[n * 16] = f2bf(x[n] * rsd * ng[n * 16]);
    }
    __syncthreads();
  }
}

#define MG_YM(p) ((bf16_t*)(p).R)
#define MG_G3(p) (MG_YM(p) + (size_t)M_ALL * 1024)
__device__ __forceinline__ void ph_gates(const P& p, int l, int Mt, char* lds) {
  EPI_VARS
  bf16_t* G3 = MG_G3(p);
  const float* gbias = p.in[38] + (size_t)l * 3072;
  const int ntile = Mt * 24;
  for (int it = 0;; ++it) {
    int tm, tn; if (!tile_map(it, Mt, 24, 8, tm, tn)) break; const int m0 = tm * 128, n0 = tn * 128;
    f32x4 acc[4][4]; ZERO_ACC(acc)
    gemm_main(p.U + (size_t)m0 * 1024, 1024, p.W + W_IN + (size_t)(3216 + n0) * 1024, 1024, 1024, acc, lds);
    EPI_BEGIN(m0, n0)
      G3[(size_t)row * 3072 + col] = f2bf(sigmoidf_(val + gbias[col]));
    EPI_END
  }
}
__device__ __forceinline__ void ph_merge(const P& p, int l, int Mt, char* lds) {
  EPI_VARS
  bf16_t* YM = MG_YM(p); const bf16_t* G3 = MG_G3(p);
  const int ntile = Mt * 16;
  for (int it = 0;; ++it) {
    int tm, tn; if (!tile_map(it, Mt, 16, 8, tm, tn)) break; const int m0 = tm * 128, n0 = tn * 64;
    f32x4 yacc[4][2];
#pragma unroll
    for (int m = 0; m < 4; ++m) { yacc[m][0] = (f32x4){0.f, 0.f, 0.f, 0.f}; yacc[m][1] = (f32x4){0.f, 0.f, 0.f, 0.f}; }
#pragma unroll 1
    for (int br = 0; br < 3; ++br) {
      f32x4 acc[4][2];
#pragma unroll
      for (int m = 0; m < 4; ++m) { acc[m][0] = (f32x4){0.f, 0.f, 0.f, 0.f}; acc[m][1] = (f32x4){0.f, 0.f, 0.f, 0.f}; }
      const int kb = br == 1 ? 256 : 384; const int yoff = br == 0 ? 0 : (br == 1 ? 384 : 640);
      const int woff = br == 0 ? W_UPRW : (br == 1 ? W_UPS5 : W_UPML);
      gemm_main_t<2>(p.Y + (size_t)m0 * 1024 + yoff, 1024, p.W + woff + (size_t)n0 * kb, kb, kb, acc, lds);
      EPI_ROW_BEGIN(m0)
        const bf16_t* gp = G3 + (size_t)row * 3072 + br * 1024 + n0 + wc * 32 + fr;
#pragma unroll
        for (int n = 0; n < 2; ++n) yacc[m][n][j] += bf2f(gp[n * 16]) * acc[m][n][j];
      EPI_ROW_END
    }
    EPI_ROW_BEGIN(m0)
      bf16_t* yp = YM + (size_t)row * 1024 + n0 + wc * 32 + fr;
#pragma unroll
      for (int n = 0; n < 2; ++n) yp[n * 16] = f2bf(yacc[m][n][j]);
    EPI_ROW_END
  }
}
__device__ __forceinline__ void ph_wout(const P& p, int l, int Mt, char* lds) {
  EPI_VARS
  const bf16_t* YM = (const bf16_t*)p.R;
  const int ntile = Mt * 8;
  for (int it = 0;; ++it) {
    int tm, tn; if (!tile_map(it, Mt, 8, 8, tm, tn)) break; const int m0 = tm * 128, n0 = tn * 128;
    f32x4 acc[4][4]; ZERO_ACC(acc)
    gemm_main(YM + (size_t)m0 * 1024, 1024, p.W + W_OUT + (size_t)n0 * 1024, 1024, 1024, acc, lds);
    EPI_ROW_BEGIN(m0)
      float* sp = srow(p, row) + n0 + wc * 64 + fr; const float* gp = modp(p, l, row, 5) + n0 + wc * 64 + fr;
#pragma unroll
      for (int n = 0; n < 4; ++n) sp[n * 16] = ALPHA * sp[n * 16] + gp[n * 16] * acc[m][n][j];
    EPI_ROW_END
  }
}

#define XB_TMO      128
#define XB_XCNT(j)  (256  + 64 * (j))
#define XB_XSUB(j)  (1280 + 64 * (j))
#define XB_XGEN(j)  (2304 + 64 * (j))
#define XB_TOP      3328
#define XB_TOPGEN   3392
#define XCD_BAR_WORDS 3456
#define XB_SPIN_CAP (1u << 18)
#define LAS __attribute__((address_space(3)))

__device__ __forceinline__ unsigned xb_ld(unsigned* p)              { return __hip_atomic_load(p, __ATOMIC_RELAXED, __HIP_MEMORY_SCOPE_AGENT); }
__device__ __forceinline__ unsigned xb_add(unsigned* p, unsigned v) { return __hip_atomic_fetch_add(p, v, __ATOMIC_RELAXED, __HIP_MEMORY_SCOPE_AGENT); }
__device__ __forceinline__ unsigned xb_xcc_id() { return (unsigned)__builtin_amdgcn_s_getreg((3 << 11) | 20) & 0xFu; }
#define XB_SPIN(cond, bar) do { unsigned _sp = 0; while (cond) { __builtin_amdgcn_s_sleep(1); \
    if ((++_sp & 255u) == 0u) { if (xb_ld(&(bar)[XB_TMO])) break; if (_sp > XB_SPIN_CAP) { atomicAdd(&(bar)[XB_TMO], 1u); break; } } } } while (0)

struct XcdBarrier {
    unsigned* bar; unsigned x;
    volatile LAS unsigned* st;
};

__device__ __forceinline__ XcdBarrier xcd_barrier_post(unsigned* bar, volatile LAS unsigned* st) {
    XcdBarrier b; b.bar = bar; b.x = xb_xcc_id(); b.st = st;
    if (__builtin_amdgcn_workitem_id_x() == 0) (void)xb_add(&bar[XB_XCNT(b.x)], 1u);
    return b;
}
__device__ __forceinline__ void xcd_barrier_complete(unsigned* bar, unsigned x, unsigned& nloc, unsigned& nx) {
    const unsigned G = gridDim.x * gridDim.y * gridDim.z;
    unsigned sum, cnt, mine, sp = 0u;
    for (;;) {
        sum = 0u; cnt = 0u; mine = 0u;
#pragma unroll
        for (unsigned j = 0; j < 16; ++j) { const unsigned c = xb_ld(&bar[XB_XCNT(j)]); sum += c; cnt += (c > 0u) ? 1u : 0u; mine = (j == x) ? c : mine; }
        if (sum == G) break;
        __builtin_amdgcn_s_sleep(1);
        if ((++sp & 255u) == 0u) { if (xb_ld(&bar[XB_TMO])) break; if (sp > XB_SPIN_CAP) { atomicAdd(&bar[XB_TMO], 1u); break; } }
    }
    nloc = mine > 0u ? mine : 1u; nx = cnt > 0u ? cnt : 1u;
}

__device__ __forceinline__ void xcd_barrier(const XcdBarrier& b) {
    asm volatile("s_waitcnt vmcnt(0)" ::: "memory");
    __syncthreads();
    if (__builtin_amdgcn_workitem_id_x() == 0) {
        unsigned* bar = b.bar;
        __builtin_amdgcn_s_waitcnt(0);
        unsigned nloc = b.st[0], nx = b.st[1];
        if (nloc == 0u) { xcd_barrier_complete(bar, b.x, nloc, nx); b.st[0] = nloc; b.st[1] = nx; }
        const unsigned old = xb_add(&bar[XB_XSUB(b.x)], 1u);
        const unsigned gen = old / nloc;
        if (old + 1u == (gen + 1u) * nloc) {
            __builtin_amdgcn_fence(__ATOMIC_RELEASE, "agent");
            asm volatile("s_waitcnt vmcnt(0)" ::: "memory");
            const unsigned og = xb_add(&bar[XB_TOP], 1u);
            const unsigned tg = og / nx;
            if (og + 1u == (tg + 1u) * nx) xb_add(&bar[XB_TOPGEN], 1u);
            else XB_SPIN(xb_ld(&bar[XB_TOPGEN]) == tg, bar);
            __builtin_amdgcn_fence(__ATOMIC_ACQUIRE, "agent");
            xb_add(&bar[XB_XGEN(b.x)], 1u);
            asm volatile("s_waitcnt vmcnt(0)" ::: "memory");
        } else {
            XB_SPIN(xb_ld(&bar[XB_XGEN(b.x)]) == gen, bar);
            __builtin_amdgcn_fence(__ATOMIC_ACQUIRE, "agent");
            asm volatile("s_waitcnt vmcnt(0)" ::: "memory");
        }
    }
    __syncthreads();
}


#define SYNC xcd_barrier(xb); asm volatile("" : "+s"(l));
__global__ void __launch_bounds__(NTHR, 2) mega(P pv) {
#define p pv
  __shared__ __attribute__((aligned(16))) char lds[LDS_BYTES];
  __shared__ uint4 xb_words;
  cg::grid_group grid = cg::this_grid();
  {
    const int t0 = __builtin_amdgcn_workitem_id_x();
    if (blockIdx.x == 0) for (int i = t0; i < 4096; i += NTHR) pv.bar[i] = 0u;
    if (t0 == 0) xb_words = make_uint4(0u, 0u, 0u, 0u);
    __threadfence();
    grid.sync();
  }
  XcdBarrier xb = xcd_barrier_post(pv.bar, (volatile LAS unsigned*)&xb_words);
  for (int l = 0; l < 2; ++l) {
    const bool last = (l == 1);
    const int Mt2 = last ? 256 : 264;
    const int Mr2 = last ? M_LAT : M_ALL;
    ph_convert(p, l, l == 0, lds); SYNC
    if (l == 0) { ph_rows(p, 0, 0, 0, M_ALL, true, 0, 0); SYNC }
    ph_ffn_up(p, 0, 264, lds); SYNC
    ph_ffn_down(p, l, 0, 264, lds); SYNC
    ph_rows(p, 1, l, 0, M_ALL, true, l, 3); SYNC
    ph_z_rw(p, lds); SYNC
    ph_conv<0>(p, l); SYNC
    ph_lora(p, l, lds); SYNC
    {
      const int ns = gridDim.x >= 384 ? 192 : 0;
      if (ns == 0 || blockIdx.x < 192) ph_rwscan(p, lds);
      if (ns == 0) { SYNC }
      if ((int)blockIdx.x >= ns) ph_s5_stage(p, l, lds, (int)blockIdx.x - ns, (int)gridDim.x - ns);
      SYNC
    }
    ph_rwpost(p, l); SYNC
    ph_z_ml(p, lds); SYNC
    ph_conv<1>(p, l); SYNC
    ph_ml_a(p, l, lds); SYNC
    ph_ml_b(p); SYNC
    ph_ml_c(p, l, lds); SYNC
    ph_gates(p, l, Mt2, lds); SYNC
    ph_merge(p, l, Mt2, lds); SYNC
    ph_wout(p, l, Mt2, lds); SYNC
    ph_rows(p, 1, l, 1, Mr2, true, l, 6); SYNC
    ph_ffn_up(p, 1, Mt2, lds); SYNC
    ph_ffn_down(p, l, 1, Mt2, lds); SYNC
    ph_rows(p, 1, l, 2, Mr2, !last, l + 1, 0);
    if (!last) { SYNC }
  }
#undef p
}

extern "C" void kernel_launch(void* const* d_in, const int* in_sizes, int n_in, void* d_out, int out_size, void* d_ws, size_t ws_size,
                              hipStream_t stream) {
  static int grid_blocks = 0;
  if (!grid_blocks) {
    int dev = 0, cus = 0, per_cu = 0;
    hipGetDevice(&dev);
    hipDeviceGetAttribute(&cus, hipDeviceAttributeMultiprocessorCount, dev);
    hipOccupancyMaxActiveBlocksPerMultiprocessor(&per_cu, mega, NTHR, 0);
    if (per_cu > 2) per_cu = 2;
    grid_blocks = cus * per_cu;
  }
  P p{};
  for (int i = 0; i < 40; ++i) p.in[i] = (const float*)d_in[i];
  char* ws = (char*)d_ws;
  size_t off = 0;
  p.W = (bf16_t*)(ws + off); off += (size_t)W_TOTAL * 2;
  p.mod = (float*)(ws + off); off += (size_t)2 * 5 * 9216 * 4;
  p.sctx = (float*)(ws + off); off += (size_t)1024 * 1024 * 4;
  p.bar = (unsigned*)(ws + off); off += (size_t)16384;
  p.U = (bf16_t*)(ws + off); off += (size_t)M_ALL * 1024 * 2;
  p.Y = (bf16_t*)(ws + off); off += (size_t)M_ALL * 1024 * 2;
  p.R = ws + off;
  p.out = (float*)d_out;
  if (off + (size_t)M_ALL * 9728 > ws_size) fprintf(stderr, "workspace too small: need %zu have %zu\n", off + (size_t)M_ALL * 9728, ws_size);
  void* args[] = {&p};
  hipError_t e = hipLaunchCooperativeKernel((void*)mega, dim3(grid_blocks), dim3(NTHR), args, 0, stream);
  if (e != hipSuccess) fprintf(stderr, "cooperative launch failed: %s (grid %d)\n", hipGetErrorString(e), grid_blocks);
}
```

```cpp
#include <hip/hip_runtime.h>
#include <hip/hip_cooperative_groups.h>
#include <cstdio>
namespace cg = cooperative_groups;

typedef unsigned short bf16_t;
typedef _Float16 hf;
typedef hf hf4 __attribute__((ext_vector_type(4)));
typedef hf hf8 __attribute__((ext_vector_type(8)));
typedef __attribute__((ext_vector_type(8))) short bf16x8;
typedef __attribute__((ext_vector_type(4))) float f32x4;
typedef unsigned int u32x4 __attribute__((ext_vector_type(4)));

#define M_LAT 32768
#define M_ALL 33792
#define NTHR 256
#define LDS_BYTES 73728
#define ALPHA 1.41421356237f

#define W_GU0 0
#define W_D0 5767168
#define W_GU1 8650752
#define W_D1 14417920
#define W_IN 17301504
#define W_WUP0 23740416
#define W_WUP1 23764992
#define W_AUP0 23789568
#define W_AUP1 23814144
#define W_GUP 23838720
#define W_GLU 23887872
#define W_UPRW 23953408
#define W_UPS5 24346624
#define W_UPML 24608768
#define W_OUT 25001984
#define W_TOTAL 26050560

struct P {
  const float* in[40];
  float* out; float* sctx; float* mod;
  bf16_t* U; bf16_t* Y; bf16_t* W; char* R; unsigned* bar;
};

__device__ __forceinline__ int get_tid() { int t = __builtin_amdgcn_workitem_id_x(); asm volatile("" : "+v"(t)); return t; }
__device__ __forceinline__ bf16_t f2bf(float f) { return __builtin_bit_cast(unsigned short, (_Float16)f); }
__device__ __forceinline__ float bf2f(bf16_t h) { return (float)__builtin_bit_cast(_Float16, h); }
__device__ __forceinline__ float sigmoidf_(float x) { return __builtin_amdgcn_rcpf(1.f + __expf(-x)); }
__device__ __forceinline__ float tanhf_(float x) { return 1.f - 2.f * __builtin_amdgcn_rcpf(1.f + __expf(2.f * x)); }
__device__ __forceinline__ float siluf_(float x) { return x * __builtin_amdgcn_rcpf(1.f + __expf(-x)); }
__device__ __forceinline__ float* srow(const P& p, int m) { return m < M_LAT ? p.out + (size_t)m * 1024 : p.sctx + (size_t)(m - M_LAT) * 1024; }
__device__ __forceinline__ const float* modp(const P& p, int l, int m, int k) { int mv = m < M_LAT ? (m >> 13) : 4; return p.mod + (size_t)(l * 5 + mv) * 9216 + k * 1024; }
template <int C> __device__ __forceinline__ float dppf(float x) { return __int_as_float(__builtin_amdgcn_update_dpp(0, __float_as_int(x), C, 0xf, 0xf, false)); }
__device__ __forceinline__ float rowsum16(float x) { x += dppf<0x128>(x); x += dppf<0x124>(x); x += dppf<0x122>(x); x += dppf<0x121>(x); return x; }
__device__ __forceinline__ float wavesum(float x) { for (int o = 32; o > 0; o >>= 1) x += __shfl_xor(x, o); return x; }

template <int NB>
__device__ __forceinline__ void gemm_main_t(const bf16_t* __restrict__ A, int lda, const bf16_t* __restrict__ B, int ldb, int K,
                                          f32x4 (&acc)[4][NB], char* lds) {
  const int tid = get_tid(), lane = tid & 63, wid = tid >> 6, wr = wid >> 1, wc = wid & 1;
  const int fr = lane & 15, fq = lane >> 4;
  const int sr = tid >> 3, skc = tid & 7;
  const bf16_t* ga = A + (size_t)sr * lda + skc * 8;
  const bf16_t* gb = B + (size_t)sr * ldb + skc * 8;
  u32x4 ra0[4], rb0[NB], ra1[4], rb1[NB];
  const int soff = sr * 144 + skc * 16;
  const int nk = K >> 6;
  const int aoff = (wr * 64 + fr) * 144 + fq * 16;
  const int boff = 18432 + (wc * (NB * 16) + fr) * 144 + fq * 16;
#define G_LOAD(RA, RB, kt) { _Pragma("unroll") for (int i = 0; i < 4; ++i) { RA[i] = *(const u32x4*)(ga + (size_t)(i * 32) * lda + (kt) * 64); if (i < NB) RB[i] = *(const u32x4*)(gb + (size_t)(i * 32) * ldb + (kt) * 64); } }
#define G_STORE(RA, RB, buf) { char* d_ = lds + (buf) * 36864 + soff; _Pragma("unroll") for (int i = 0; i < 4; ++i) { *(u32x4*)(d_ + i * 32 * 144) = RA[i]; if (i < NB) *(u32x4*)(d_ + 18432 + i * 32 * 144) = RB[i]; } }
#define G_COMP(buf) { const char* cur = lds + (buf) * 36864; _Pragma("unroll") for (int ks = 0; ks < 2; ++ks) { hf8 af[4], bfr[NB]; \
    _Pragma("unroll") for (int m = 0; m < 4; ++m) af[m] = *(const hf8*)(cur + aoff + m * 16 * 144 + ks * 64); \
    _Pragma("unroll") for (int n = 0; n < NB; ++n) bfr[n] = *(const hf8*)(cur + boff + n * 16 * 144 + ks * 64); \
    _Pragma("unroll") for (int m = 0; m < 4; ++m) _Pragma("unroll") for (int n = 0; n < NB; ++n) acc[m][n] = __builtin_amdgcn_mfma_f32_16x16x32_f16(af[m], bfr[n], acc[m][n], 0, 0, 0); } }
  G_LOAD(ra0, rb0, 0)
  { const int k1 = nk > 1 ? 1 : 0; G_LOAD(ra1, rb1, k1) }
  G_STORE(ra0, rb0, 0)
  __syncthreads();
  for (int kt = 0; kt < nk; kt += 2) {
    { const int k2 = kt + 2 < nk ? kt + 2 : nk - 1; G_LOAD(ra0, rb0, k2) }
    G_COMP(0)
    G_STORE(ra1, rb1, 1)
    __syncthreads();
    { const int k3 = kt + 3 < nk ? kt + 3 : nk - 1; G_LOAD(ra1, rb1, k3) }
    if (kt + 1 < nk) G_COMP(1)
    G_STORE(ra0, rb0, 0)
    __syncthreads();
  }
}
__device__ __forceinline__ void gemm_main(const bf16_t* __restrict__ A, int lda, const bf16_t* __restrict__ B, int ldb, int K, f32x4 (&acc)[4][4], char* lds) {
  gemm_main_t<4>(A, lda, B, ldb, K, acc, lds);
}
template <int KT>
__device__ __forceinline__ void gemm_small_t(const bf16_t* __restrict__ A, int lda, const bf16_t* __restrict__ B, int ldb, f32x4 (&acc)[4][4], char* lds) {
  const int tid = get_tid(), lane = tid & 63, wid = tid >> 6, wr = wid >> 1, wc = wid & 1;
  const int fr = lane & 15, fq = lane >> 4;
  const int sr = tid >> 3, skc = tid & 7;
  const bf16_t* ga = A + (size_t)sr * lda + skc * 8;
  const bf16_t* gb = B + (size_t)sr * ldb + skc * 8;
  const int soff = sr * 144 + skc * 16;
  const int aoff = (wr * 64 + fr) * 144 + fq * 16;
  const int boff = 18432 + (wc * 64 + fr) * 144 + fq * 16;
  u32x4 ra[KT][4], rb[KT][4];
#pragma unroll
  for (int kt = 0; kt < KT; ++kt)
#pragma unroll
    for (int i = 0; i < 4; ++i) { ra[kt][i] = *(const u32x4*)(ga + (size_t)(i * 32) * lda + kt * 64); rb[kt][i] = *(const u32x4*)(gb + (size_t)(i * 32) * ldb + kt * 64); }
#pragma unroll
  for (int kt = 0; kt < KT; ++kt)
#pragma unroll
    for (int i = 0; i < 4; ++i) { *(u32x4*)(lds + kt * 36864 + soff + i * 32 * 144) = ra[kt][i]; *(u32x4*)(lds + kt * 36864 + 18432 + soff + i * 32 * 144) = rb[kt][i]; }
  __syncthreads();
#pragma unroll
  for (int kt = 0; kt < KT; ++kt) {
    const char* cur = lds + kt * 36864;
#pragma unroll
    for (int ks = 0; ks < 2; ++ks) {
      hf8 af[4], bfr[4];
#pragma unroll
      for (int m = 0; m < 4; ++m) af[m] = *(const hf8*)(cur + aoff + m * 16 * 144 + ks * 64);
#pragma unroll
      for (int n = 0; n < 4; ++n) bfr[n] = *(const hf8*)(cur + boff + n * 16 * 144 + ks * 64);
#pragma unroll
      for (int m = 0; m < 4; ++m)
#pragma unroll
        for (int n = 0; n < 4; ++n) acc[m][n] = __builtin_amdgcn_mfma_f32_16x16x32_f16(bfr[n], af[m], acc[m][n], 0, 0, 0);
    }
  }
  __syncthreads();
}

template <int SM>
__device__ __forceinline__ bool tile_map_sm(int b, int nb, int it, int Mt, int Nt, int SN, int& tm, int& tn) {
  const int xcd = b & 7, li = b >> 3, nloc = nb >> 3;
  const int T = SM * SN; const int nsn = Nt / SN; const int nsuper = (Mt / SM) * nsn;
  const int o = li + it * nloc; const int k = o / T, w = o - k * T;
  const int s = xcd + 8 * k;
  if (s >= nsuper) return false;
  const int sm = s / nsn, sn = s - sm * nsn;
  tm = sm * SM + (w % SM); tn = sn * SN + (w / SM);
  return true;
}
__device__ __forceinline__ bool tile_map_v(int b, int nb, int it, int Mt, int Nt, int SN, int& tm, int& tn) {
  const int nsn = Nt / SN;
  if (nsn * (Mt >> 3) % 8 == 0 || nsn >= 8) return tile_map_sm<8>(b, nb, it, Mt, Nt, SN, tm, tn);
  return tile_map_sm<1>(b, nb, it, Mt, Nt, SN, tm, tn);
}
__device__ __forceinline__ bool tile_map(int it, int Mt, int Nt, int SN, int& tm, int& tn) { return tile_map_v(blockIdx.x, gridDim.x, it, Mt, Nt, SN, tm, tn); }
#define ZERO_ACC(a) _Pragma("unroll") for (int m_ = 0; m_ < 4; ++m_) _Pragma("unroll") for (int n_ = 0; n_ < 4; ++n_) a[m_][n_] = (f32x4){0.f, 0.f, 0.f, 0.f};
#define EPI_VARS const int tid = get_tid(), lane = tid & 63, wid = tid >> 6, wr = wid >> 1, wc = wid & 1, fr = lane & 15, fq = lane >> 4; (void)wr; (void)wc; (void)fr; (void)fq;
#define EPI_ROW_BEGIN(m0) _Pragma("unroll") for (int m = 0; m < 4; ++m) _Pragma("unroll") for (int j = 0; j < 4; ++j) { const int row = (m0) + wr * 64 + m * 16 + fq * 4 + j; (void)row;
#define EPI_COL_BEGIN(n0) _Pragma("unroll") for (int n = 0; n < 4; ++n) { const int col = (n0) + wc * 64 + n * 16 + fr; const float val = acc[m][n][j]; (void)col; (void)val;
#define EPI_COL_END }
#define EPI_ROW_END }
#define EPI_BEGIN(m0, n0) EPI_ROW_BEGIN(m0) EPI_COL_BEGIN(n0)
#define EPI_END } }

struct Job { const float* src; int K, N; int dst; int mode; };
__device__ __forceinline__ Job get_job(const P& p, int l, int j) {
  Job r; r.mode = 0;
  switch (j) {
    case 0: r.src = p.in[8] + (size_t)(l * 2 + 0) * 1024 * 2816; r.K = 1024; r.N = 2816; r.dst = W_GU0; r.mode = 1; break;
    case 1: r.src = p.in[9] + (size_t)(l * 2 + 0) * 1024 * 2816; r.K = 1024; r.N = 2816; r.dst = W_GU0; r.mode = 2; break;
    case 2: r.src = p.in[10] + (size_t)(l * 2 + 0) * 2816 * 1024; r.K = 2816; r.N = 1024; r.dst = W_D0; break;
    case 3: r.src = p.in[8] + (size_t)(l * 2 + 1) * 1024 * 2816; r.K = 1024; r.N = 2816; r.dst = W_GU1; r.mode = 1; break;
    case 4: r.src = p.in[9] + (size_t)(l * 2 + 1) * 1024 * 2816; r.K = 1024; r.N = 2816; r.dst = W_GU1; r.mode = 2; break;
    case 5: r.src = p.in[10] + (size_t)(l * 2 + 1) * 2816 * 1024; r.K = 2816; r.N = 1024; r.dst = W_D1; break;
    case 6: r.src = p.in[11] + (size_t)l * 1024 * 6288; r.K = 1024; r.N = 6288; r.dst = W_IN; break;
    case 7: r.src = p.in[14] + (size_t)(l * 2 + 0) * 64 * 384; r.K = 64; r.N = 384; r.dst = W_WUP0; break;
    case 8: r.src = p.in[14] + (size_t)(l * 2 + 1) * 64 * 384; r.K = 64; r.N = 384; r.dst = W_WUP1; break;
    case 9: r.src = p.in[16] + (size_t)(l * 2 + 0) * 64 * 384; r.K = 64; r.N = 384; r.dst = W_AUP0; break;
    case 10: r.src = p.in[16] + (size_t)(l * 2 + 1) * 64 * 384; r.K = 64; r.N = 384; r.dst = W_AUP1; break;
    case 11: r.src = p.in[17] + (size_t)l * 128 * 384; r.K = 128; r.N = 384; r.dst = W_GUP; break;
    case 12: r.src = p.in[31] + (size_t)l * 256 * 256; r.K = 256; r.N = 256; r.dst = W_GLU; break;
    case 13: r.src = p.in[35] + (size_t)l * 384 * 1024; r.K = 384; r.N = 1024; r.dst = W_UPRW; break;
    case 14: r.src = p.in[36] + (size_t)l * 256 * 1024; r.K = 256; r.N = 1024; r.dst = W_UPS5; break;
    case 15: r.src = p.in[37] + (size_t)l * 384 * 1024; r.K = 384; r.N = 1024; r.dst = W_UPML; break;
    default: r.src = p.in[39] + (size_t)l * 1024 * 1024; r.K = 1024; r.N = 1024; r.dst = W_OUT; break;
  }
  return r;
}
#define NJOBS 17
__device__ void mod_task(const P& p, int t, char* lds) {
  float* sc = (float*)lds;
  float* red = sc + 5 * 1024;
  const int tid = get_tid();
  for (int i = tid; i < 5 * 1024; i += NTHR) {
    int v = i >> 10, k = i & 1023;
    float c = v < 4 ? p.in[1][v * 1024 + k] : p.in[3][k];
    sc[i] = siluf_(c);
  }
  __syncthreads();
  const int c0 = t * 64; const int l = c0 / 9216; const int j0 = c0 % 9216;
  const int col = tid & 63, part = tid >> 6;
  const float* w = p.in[4] + ((size_t)l * 1024 + part * 256) * 9216 + j0 + col;
  float a0 = 0, a1 = 0, a2 = 0, a3 = 0, a4 = 0;
  const float* s = sc + part * 256;
#pragma unroll 8
  for (int i = 0; i < 256; ++i) {
    float wv = w[(size_t)i * 9216];
    a0 += s[i] * wv; a1 += s[1024 + i] * wv; a2 += s[2048 + i] * wv; a3 += s[3072 + i] * wv; a4 += s[4096 + i] * wv;
  }
  red[(part * 5 + 0) * 64 + col] = a0; red[(part * 5 + 1) * 64 + col] = a1; red[(part * 5 + 2) * 64 + col] = a2;
  red[(part * 5 + 3) * 64 + col] = a3; red[(part * 5 + 4) * 64 + col] = a4;
  __syncthreads();
  for (int i = tid; i < 320; i += NTHR) {
    int v = i >> 6, c = i & 63;
    float sum = red[(0 * 5 + v) * 64 + c] + red[(1 * 5 + v) * 64 + c] + red[(2 * 5 + v) * 64 + c] + red[(3 * 5 + v) * 64 + c];
    p.mod[(size_t)(l * 5 + v) * 9216 + j0 + c] = sum + p.in[5][(size_t)l * 9216 + j0 + c];
  }
  __syncthreads();
}
__device__ __forceinline__ void ph_convert(const P& p, int l, bool with_mod, char* lds) {
  const int tid = get_tid();
  int ntiles[NJOBS]; int total = 0;
#pragma unroll
  for (int j = 0; j < NJOBS; ++j) { Job jb = get_job(p, l, j); ntiles[j] = (jb.K >> 6) * ((jb.N + 63) >> 6); total += ntiles[j]; }
  const int nmod = with_mod ? 288 : 0;
  float* tile = (float*)lds;
  for (int t = blockIdx.x; t < total + nmod; t += gridDim.x) {
    if (t < nmod) { mod_task(p, t, lds); continue; }
    int tt = t - nmod; int j = 0;
#pragma unroll
    for (int q = 0; q < NJOBS; ++q) { if (j == q && tt >= ntiles[q]) { tt -= ntiles[q]; j = q + 1; } }
    Job jb = get_job(p, l, j);
    const int nkt = jb.K >> 6;
    const int k0 = (tt % nkt) * 64, n0 = (tt / nkt) * 64;
    {
      const int c = tid & 63, r0 = tid >> 6;
      const bool ok = (n0 + c) < jb.N;
#pragma unroll
      for (int i = 0; i < 16; ++i) { int r = r0 + i * 4; tile[r * 65 + c] = ok ? jb.src[(size_t)(k0 + r) * jb.N + n0 + c] : 0.f; }
    }
    __syncthreads();
    {
      const int nn = tid >> 2, q = tid & 3; const int n = n0 + nn;
      if (n < jb.N) {
        int drow = n;
        if (jb.mode == 1) drow = (n >> 5) * 64 + (n & 31);
        else if (jb.mode == 2) drow = (n >> 5) * 64 + 32 + (n & 31);
        bf16_t* d = p.W + jb.dst + (size_t)drow * jb.K + k0 + q * 16;
        unsigned pk[8];
#pragma unroll
        for (int i = 0; i < 8; ++i) { unsigned lo = f2bf(tile[(q * 16 + 2 * i) * 65 + nn]); unsigned hi = f2bf(tile[(q * 16 + 2 * i + 1) * 65 + nn]); pk[i] = lo | (hi << 16); }
        *(uint4*)d = make_uint4(pk[0], pk[1], pk[2], pk[3]);
        *(uint4*)(d + 8) = make_uint4(pk[4], pk[5], pk[6], pk[7]);
      }
    }
    __syncthreads();
  }
}

__device__ __forceinline__ void ph_rows(const P& p, int mode, int l, int ln_idx, int Mrows, bool writeU, int ul, int ks) {
  const int lane = get_tid() & 63, wid = get_tid() >> 6;
  const int nw = gridDim.x * 4;
  const float* g = p.in[6] + (size_t)(l * 3 + ln_idx) * 1024;
  const float* b = p.in[7] + (size_t)(l * 3 + ln_idx) * 1024;
  for (int m = blockIdx.x * 4 + wid; m < Mrows; m += nw) {
    float* s = srow(p, m);
    const float* src = s;
    if (mode == 0) src = m < M_LAT ? p.in[0] + (size_t)m * 1024 : p.in[2] + (size_t)(m - M_LAT) * 1024;
    float4 v[4];
#pragma unroll
    for (int i = 0; i < 4; ++i) v[i] = *(const float4*)(src + lane * 4 + i * 256);
    if (mode == 1) {
      float sum = 0;
#pragma unroll
      for (int i = 0; i < 4; ++i) sum += v[i].x + v[i].y + v[i].z + v[i].w;
      sum = wavesum(sum);
      const float mean = sum * (1.f / 1024.f);
      float sq = 0;
#pragma unroll
      for (int i = 0; i < 4; ++i) { v[i].x -= mean; v[i].y -= mean; v[i].z -= mean; v[i].w -= mean; sq += v[i].x * v[i].x + v[i].y * v[i].y + v[i].z * v[i].z + v[i].w * v[i].w; }
      sq = wavesum(sq);
      const float rstd = rsqrtf(sq * (1.f / 1024.f) + 1e-5f);
#pragma unroll
      for (int i = 0; i < 4; ++i) {
        float4 gg = *(const float4*)(g + lane * 4 + i * 256), bb = *(const float4*)(b + lane * 4 + i * 256);
        v[i].x = v[i].x * rstd * gg.x + bb.x; v[i].y = v[i].y * rstd * gg.y + bb.y; v[i].z = v[i].z * rstd * gg.z + bb.z; v[i].w = v[i].w * rstd * gg.w + bb.w;
      }
    }
#pragma unroll
    for (int i = 0; i < 4; ++i) *(float4*)(s + lane * 4 + i * 256) = v[i];
    if (writeU) {
      const float* sh = modp(p, ul, m, ks); const float* scl = modp(p, ul, m, ks + 1);
#pragma unroll
      for (int i = 0; i < 4; ++i) {
        float4 a = *(const float4*)(sh + lane * 4 + i * 256), c = *(const float4*)(scl + lane * 4 + i * 256);
        unsigned lo = f2bf(v[i].x * (1.f + c.x) + a.x) | ((unsigned)f2bf(v[i].y * (1.f + c.y) + a.y) << 16);
        unsigned hi = f2bf(v[i].z * (1.f + c.z) + a.z) | ((unsigned)f2bf(v[i].w * (1.f + c.w) + a.w) << 16);
        *(uint2*)(p.U + (size_t)m * 1024 + lane * 4 + i * 256) = make_uint2(lo, hi);
      }
    }
  }
}

__device__ __forceinline__ void ph_ffn_up(const P& p, int s, int Mt, char* lds) {
  EPI_VARS
  bf16_t* HM = (bf16_t*)p.R;
  const bf16_t* Wt = p.W + (s ? W_GU1 : W_GU0);
  const int ntile = Mt * 44;
  for (int it = 0;; ++it) {
    int tm, tn; if (!tile_map(it, Mt, 44, 4, tm, tn)) break; const int m0 = tm * 128, n0 = tn * 128;
    f32x4 acc[4][4]; ZERO_ACC(acc)
    gemm_main(p.U + (size_t)m0 * 1024, 1024, Wt + (size_t)n0 * 1024, 1024, 1024, acc, lds);
    const int hb = ((n0 + wc * 64) >> 6) * 32;
#pragma unroll
    for (int m = 0; m < 4; ++m)
#pragma unroll
      for (int n = 0; n < 2; ++n)
#pragma unroll
        for (int j = 0; j < 4; ++j) {
          const int row = m0 + wr * 64 + m * 16 + fq * 4 + j; const int hc = hb + n * 16 + fr;
          HM[(size_t)row * 2816 + hc] = f2bf(siluf_(acc[m][n][j]) * acc[m][n + 2][j]);
        }
  }
}
__device__ __forceinline__ void ph_ffn_down(const P& p, int l, int s, int Mt, char* lds) {
  EPI_VARS
  const bf16_t* HM = (const bf16_t*)p.R;
  const bf16_t* Wt = p.W + (s ? W_D1 : W_D0);
  const int gk = s ? 8 : 2;
  const int ntile = Mt * 8;
  for (int it = 0;; ++it) {
    int tm, tn; if (!tile_map(it, Mt, 8, 8, tm, tn)) break; const int m0 = tm * 128, n0 = tn * 128;
    f32x4 acc[4][4]; ZERO_ACC(acc)
    gemm_main(HM + (size_t)m0 * 2816, 2816, Wt + (size_t)n0 * 2816, 2816, 2816, acc, lds);
    EPI_ROW_BEGIN(m0)
      float* sp = srow(p, row) + n0 + wc * 64 + fr; const float* gp = modp(p, l, row, gk) + n0 + wc * 64 + fr;
#pragma unroll
      for (int n = 0; n < 4; ++n) sp[n * 16] = ALPHA * sp[n * 16] + 0.5f * gp[n * 16] * acc[m][n][j];
    EPI_ROW_END
  }
}

#define RW_ZRW(p) ((hf*)(p).R)
#define RW_RKV(p) (RW_ZRW(p) + (size_t)M_ALL * 1152)
#define RW_LA(p) ((bf16_t*)(RW_RKV(p) + (size_t)M_ALL * 1152))
#define RW_KK(p) ((hf*)(RW_LA(p) + (size_t)M_ALL * 256))
#define RW_KD(p) (RW_KK(p) + (size_t)M_ALL * 384)
#define RW_KA(p) (RW_KD(p) + (size_t)2 * M_ALL * 384)
#define RW_YR(p) (RW_KA(p) + (size_t)2 * M_ALL * 384)

#define S5_ZH(p) ((hf*)RW_LA(p))
#define S5_YG(p) ((p).W + W_GU0)
#define S5_E(p) ((float2*)((p).R + (size_t)M_ALL * 9728))
#define S5_X(p) S5_E(p)

#define ML_Z(p) ((hf*)(p).R)
#define ML_GL(p) ((float*)(ML_Z(p) + (size_t)M_ALL * 1536))
#define ML_QK(p) ((hf*)(ML_GL(p) + (size_t)M_ALL * 16))
#define ML_DC(p) ((float*)(ML_QK(p) + (size_t)M_ALL * 768))
#define ML_DN(p) (ML_DC(p) + (size_t)4224 * 9216)
#define ML_SC(p) (ML_DN(p) + (size_t)4224 * 96)
#define ML_MP(p) (ML_SC(p) + (size_t)4224 * 2)

__device__ __forceinline__ void ph_z_rw(const P& p, char* lds) {
  EPI_VARS
  hf* ZRW = RW_ZRW(p); bf16_t* LA = RW_LA(p);
  const int Mt = 264; const int ntile = Mt * 11;
  for (int it = 0;; ++it) {
    int tm, tn; if (!tile_map(it, Mt, 11, 11, tm, tn)) break; const int m0 = tm * 128;
    const int wrow = tn < 9 ? tn * 128 : 2960 + (tn - 9) * 128;
    f32x4 acc[4][4]; ZERO_ACC(acc)
    gemm_main(p.U + (size_t)m0 * 1024, 1024, p.W + W_IN + (size_t)wrow * 1024, 1024, 1024, acc, lds);
    if (tn < 9) {
      EPI_BEGIN(m0, tn * 128)
        ZRW[(size_t)row * 1152 + col] = (hf)val;
      EPI_END
    } else {
      EPI_BEGIN(m0, (tn - 9) * 128)
        float o = col < 64 ? tanhf_(val) : (col < 128 ? val : sigmoidf_(val));
        LA[(size_t)row * 256 + col] = f2bf(o);
      EPI_END
    }
  }
}
__device__ __forceinline__ void ph_z_s5(const P& p, char* lds, int vb, int nvb) {
  EPI_VARS
  hf* Z = S5_ZH(p);
  const int Mt = 264;
  for (int it = 0;; ++it) {
    int tm, tn; if (!tile_map_v(vb, nvb, it, Mt, 2, 2, tm, tn)) break; const int m0 = tm * 128;
    f32x4 acc[4][4]; ZERO_ACC(acc)
    gemm_main(p.U + (size_t)m0 * 1024, 1024, p.W + W_IN + (size_t)(2704 + tn * 128) * 1024, 1024, 1024, acc, lds);
    EPI_BEGIN(m0, tn * 128)
      Z[(size_t)row * 256 + col] = (hf)val;
    EPI_END
  }
}
__device__ __forceinline__ void ph_z_ml(const P& p, char* lds) {
  EPI_VARS
  hf* Z = ML_Z(p); float* GL = ML_GL(p);
  const int Mt = 264; const int ntile = Mt * 13;
  for (int it = 0;; ++it) {
    int tm, tn; if (!tile_map(it, Mt, 13, 13, tm, tn)) break; const int m0 = tm * 128;
    f32x4 acc[4][4]; ZERO_ACC(acc)
    gemm_main(p.U + (size_t)m0 * 1024, 1024, p.W + W_IN + (size_t)(1152 + tn * 128) * 1024, 1024, 1024, acc, lds);
    if (tn < 12) {
      EPI_BEGIN(m0, tn * 128)
        Z[(size_t)row * 1536 + col] = (hf)val;
      EPI_END
    } else {
      EPI_BEGIN(m0, 0)
        if (col < 16) GL[(size_t)row * 16 + col] = val;
      EPI_END
    }
  }
}

template <int which>
__device__ __forceinline__ void ph_conv(const P& p, int l) {
  constexpr int nch = which == 0 ? 144 : 96;
  constexpr int ldin = which == 0 ? 1152 : 1536;
  constexpr int cbase = which == 0 ? 0 : 1152;
  const hf* Zin = which == 0 ? RW_ZRW(p) : ML_Z(p);
  const float* cw = p.in[12] + (size_t)l * 9 * 1920;
  const unsigned total = (unsigned)(M_ALL / 4) * nch;
  for (unsigned idx = blockIdx.x * NTHR + get_tid(); idx < (total + 63u) / 64u * 64u; idx += gridDim.x * NTHR) {
    const bool act = idx < total;
    const int tg = act ? (int)(idx / (unsigned)nch) : 0; const int ch = act ? (int)(idx % (unsigned)nch) : 0; const int c0 = ch * 8;
    const int m0 = tg * 4;
    float o[4][8];
#pragma unroll
    for (int t = 0; t < 4; ++t)
#pragma unroll
      for (int i = 0; i < 8; ++i) o[t][i] = 0.f;
    const bool lat = m0 < M_LAT;
    const int bb = m0 >> 13, tt = lat ? (m0 & 8191) : ((m0 - M_LAT) & 255);
    const int gr = tt >> 6, gc0 = lat ? (tt & 63) : tt;
    const int ncol = lat ? 64 : 256;
#pragma unroll
    for (int dr = -1; dr <= 1; ++dr) {
      const int rr = gr + dr;
      const bool rowok = lat ? (rr >= 0 && rr < 128) : (dr == 0);
      if (!rowok) continue;
      const float* w = cw + ((dr + 1) * 3) * 1920 + cbase + c0;
      float wv[3][8];
#pragma unroll
      for (int k = 0; k < 3; ++k) { const float4 a = *(const float4*)(w + k * 1920), b = *(const float4*)(w + k * 1920 + 4);
        wv[k][0] = a.x; wv[k][1] = a.y; wv[k][2] = a.z; wv[k][3] = a.w; wv[k][4] = b.x; wv[k][5] = b.y; wv[k][6] = b.z; wv[k][7] = b.w; }
      const int mrow = lat ? ((bb << 13) + rr * 64) : (m0 - gc0);
#pragma unroll
      for (int cc = 0; cc < 6; ++cc) {
        const int col = gc0 - 1 + cc;
        if (col < 0 || col >= ncol) continue;
        const hf8 z = *(const hf8*)(Zin + (size_t)(mrow + col) * ldin + c0);
        float zf[8];
#pragma unroll
        for (int i = 0; i < 8; ++i) zf[i] = (float)z[i];
#pragma unroll
        for (int t = 0; t < 4; ++t) {
          const int k = cc - t;
          if (k >= 0 && k < 3) {
#pragma unroll
            for (int i = 0; i < 8; ++i) o[t][i] += zf[i] * wv[k][i];
          }
        }
      }
    }
#pragma unroll
    for (int t = 0; t < 4; ++t) {
      const int m = m0 + t;
      if (which == 0) {
        const bool isk = act && (c0 >= 384) && (c0 < 768);
        float kkv[8]; float ss = 0.f;
        if (isk) {
          const float* kkw = p.in[18] + (size_t)l * 384 + (c0 - 384);
#pragma unroll
          for (int i = 0; i < 8; ++i) { kkv[i] = o[t][i] * kkw[i]; ss += kkv[i] * kkv[i]; }
        } else {
#pragma unroll
          for (int i = 0; i < 8; ++i) kkv[i] = 0.f;
        }
        ss += __shfl_xor(ss, 1); ss += __shfl_xor(ss, 2); ss += __shfl_xor(ss, 4);
        if (act) {
          hf8 ov;
#pragma unroll
          for (int i = 0; i < 8; ++i) ov[i] = (hf)o[t][i];
          *(hf8*)(RW_RKV(p) + (size_t)m * 1152 + c0) = ov;
          if (isk) {
            const float rn = rsqrtf(fmaxf(ss, 1e-24f));
            hf8 kv;
#pragma unroll
            for (int i = 0; i < 8; ++i) kv[i] = (hf)(kkv[i] * rn);
            *(hf8*)(RW_KK(p) + (size_t)m * 384 + (c0 - 384)) = kv;
          }
        }
      } else if (act) {
        const float sc = c0 >= 384 ? 0.10206207261596575f : 1.f;
        hf8 ov;
#pragma unroll
        for (int i = 0; i < 8; ++i) ov[i] = (hf)(siluf_(o[t][i]) * sc);
        *(hf8*)(ML_QK(p) + (size_t)m * 768 + c0) = ov;
      }
    }
  }
}

__device__ __forceinline__ void ph_lora(const P& p, int l, char* lds) {
  EPI_VARS
  hf* ZRW = RW_ZRW(p); const hf* RKV = RW_RKV(p); const bf16_t* LA = RW_LA(p); const hf* KK = RW_KK(p);
  hf* KD = RW_KD(p); hf* KA = RW_KA(p);
  const int Mt = 264;
  for (int it = 0;; ++it) {
    int tm, q; if (!tile_map(it, Mt, 15, 15, tm, q)) break; const int job = q / 3, tn = q % 3; const int m0 = tm * 128, n0 = tn * 128;
    f32x4 acc[4][4]; ZERO_ACC(acc)
    if (job < 2) {
      const int d = job;
      gemm_small_t<1>(LA + (size_t)m0 * 256, 256, p.W + (d ? W_WUP1 : W_WUP0) + (size_t)n0 * 64, 64, acc, lds);
      const float* w0 = p.in[13] + (size_t)(l * 2 + d) * 384;
#pragma unroll
      for (int m = 0; m < 4; ++m) {
        const int row = m0 + wr * 64 + m * 16 + fr;
#pragma unroll
        for (int n = 0; n < 4; ++n) {
          const int cb = n0 + wc * 64 + n * 16 + fq * 4;
          const float4 wv = *(const float4*)(w0 + cb);
          const float wa[4] = {wv.x, wv.y, wv.z, wv.w};
          hf4 o;
#pragma unroll
          for (int j = 0; j < 4; ++j) { const float e = sigmoidf_(wa[j] + acc[m][n][j]) * 0.6065306597126334f; o[j] = (hf)(1.f - __expf(-e)); }
          *(hf4*)(ZRW + (size_t)row * 1152 + d * 384 + cb) = o;
        }
      }
    } else if (job < 4) {
      const int d = job - 2;
      gemm_small_t<1>(LA + (size_t)m0 * 256 + 64, 256, p.W + (d ? W_AUP1 : W_AUP0) + (size_t)n0 * 64, 64, acc, lds);
      const float* a0 = p.in[15] + (size_t)(l * 2 + d) * 384; const float* kaw = p.in[19] + (size_t)l * 384;
#pragma unroll
      for (int m = 0; m < 4; ++m) {
        const int row = m0 + wr * 64 + m * 16 + fr;
#pragma unroll
        for (int n = 0; n < 4; ++n) {
          const int cb = n0 + wc * 64 + n * 16 + fq * 4;
          const float4 av = *(const float4*)(a0 + cb), kv = *(const float4*)(kaw + cb);
          const float aa[4] = {av.x, av.y, av.z, av.w}, ka_[4] = {kv.x, kv.y, kv.z, kv.w};
          const hf4 k4 = *(const hf4*)(RKV + (size_t)row * 1152 + 384 + cb), kk4 = *(const hf4*)(KK + (size_t)row * 384 + cb);
          hf4 okd, oka;
#pragma unroll
          for (int j = 0; j < 4; ++j) { const float a = sigmoidf_(aa[j] + acc[m][n][j]); okd[j] = (hf)((float)k4[j] * (1.f + (a - 1.f) * ka_[j])); oka[j] = (hf)((float)kk4[j] * a); }
          *(hf4*)(KD + ((size_t)d * M_ALL + row) * 384 + cb) = okd;
          *(hf4*)(KA + ((size_t)d * M_ALL + row) * 384 + cb) = oka;
        }
      }
    } else {
      gemm_small_t<2>(LA + (size_t)m0 * 256 + 128, 256, p.W + W_GUP + (size_t)n0 * 128, 128, acc, lds);
#pragma unroll
      for (int m = 0; m < 4; ++m) {
        const int row = m0 + wr * 64 + m * 16 + fr;
#pragma unroll
        for (int n = 0; n < 4; ++n) {
          const int cb = n0 + wc * 64 + n * 16 + fq * 4;
          hf4 o; o[0] = (hf)acc[m][n][0]; o[1] = (hf)acc[m][n][1]; o[2] = (hf)acc[m][n][2]; o[3] = (hf)acc[m][n][3];
          *(hf4*)(ZRW + (size_t)row * 1152 + 768 + cb) = o;
        }
      }
    }
  }
}

typedef float f32x2 __attribute__((ext_vector_type(2)));
#define RW_CH 16
#define RW_BUF 21504
__device__ __forceinline__ void rw_cvt_store(char* dst, uint4 q) {
  const hf8 h = __builtin_bit_cast(hf8, q);
  f32x4 a, b;
  a[0] = (float)h[0]; a[1] = (float)h[1]; a[2] = (float)h[2]; a[3] = (float)h[3];
  b[0] = (float)h[4]; b[1] = (float)h[5]; b[2] = (float)h[6]; b[3] = (float)h[7];
  *(f32x4*)dst = a; *(f32x4*)(dst + 16) = b;
}
__device__ __forceinline__ void ph_rwscan(const P& p, char* lds) {
  const hf* ZRW = RW_ZRW(p); hf* RKV = RW_RKV(p); const hf* KK = RW_KK(p);
  const int tid = get_tid(), lane = tid & 63, wid = tid >> 6;
  char* pbuf = lds + 3 * RW_BUF + wid * 2048;
  char* ybuf = lds + 3 * RW_BUF + 8192;
  for (int t = blockIdx.x; t < 192; t += gridDim.x) {
    const int rqq = t & 3, h = (t >> 2) % 6, b = (t / 24) & 3, d = t / 96;
    const int rsub = lane >> 4, g = lane & 15; const int rl = wid * 4 + rsub;
    const int sgn = d ? -1 : 1;
    const bool grpA = tid < 128; const int t2 = tid & 127;
    const int sstep = t2 >> 3, sseg = t2 & 7;
    const hf* g0 = grpA ? (RKV + h * 64 + sseg * 8) : (RW_KD(p) + (size_t)d * M_ALL * 384 + h * 64 + sseg * 8);
    const size_t ld0 = grpA ? 1152 : 384;
    const hf* g1 = grpA ? (KK + h * 64 + sseg * 8) : (RW_KA(p) + (size_t)d * M_ALL * 384 + h * 64 + sseg * 8);
    const hf* g2 = grpA ? (ZRW + d * 384 + h * 64 + sseg * 8) : (RKV + 768 + h * 64 + rqq * 16 + (t2 & 1) * 8);
    const int s2 = grpA ? sstep : (t2 >> 1);
    const bool has2 = grpA || t2 < 32;
    const int o0 = (grpA ? 0 : 12288) + sstep * 256 + sseg * 32;
    const int o1 = (grpA ? 4096 : 16384) + sstep * 256 + sseg * 32;
    const int o2 = grpA ? (8192 + sstep * 256 + sseg * 32) : (20480 + (t2 >> 1) * 64 + (t2 & 1) * 32);
    hf* g_y = d == 0 ? (RKV + 384 + h * 64 + rqq * 16 + (tid & 1) * 8) : (RW_YR(p) + h * 64 + rqq * 16 + (tid & 1) * 8);
    const int ldy = d == 0 ? 1152 : 384;
    uint4 q0, q1, q2;
#define RW_M0(pp) ((pp) < 256 ? (M_LAT + b * 256 + (d ? 255 - (pp) : (pp))) : (b * 8192 + (d ? 8447 - (pp) : (pp) - 256)))
#define RW_GLOAD(c) { const int mb_ = RW_M0((c) * RW_CH); const size_t mm = (size_t)(mb_ + sgn * sstep); \
      q0 = *(const uint4*)(g0 + mm * ld0); q1 = *(const uint4*)(g1 + mm * 384); \
      if (has2) { const size_t m2 = (size_t)(mb_ + sgn * s2); q2 = *(const uint4*)(g2 + m2 * 1152); } }
#define RW_SSTORE(c) { char* bb_ = lds + ((c) % 3) * RW_BUF; rw_cvt_store(bb_ + o0, q0); rw_cvt_store(bb_ + o1, q1); if (has2) rw_cvt_store(bb_ + o2, q2); }
    f32x2 S01 = (f32x2){0.f, 0.f}, S23 = (f32x2){0.f, 0.f};
    RW_GLOAD(0) RW_SSTORE(0)
    RW_GLOAD(1) RW_SSTORE(1)
    __syncthreads();
    const int NCH = 8448 / RW_CH;
    for (int c = 0; c < NCH; ++c) {
      if (c + 2 < NCH) RW_GLOAD(c + 2)
      if (c > 0 && tid < 32) {
        const int mb_ = RW_M0((c - 1) * RW_CH); const size_t mv = (size_t)(mb_ + sgn * (tid >> 1));
        *(uint4*)(g_y + mv * ldy) = *(const uint4*)(ybuf + ((c - 1) & 1) * 512 + tid * 16);
      }
      const char* cb = lds + (c % 3) * RW_BUF + g * 16;
      const char* vb = lds + (c % 3) * RW_BUF + 20480 + rl * 4;
      f32x4 R4[RW_CH], K4[RW_CH], D4[RW_CH], KD4[RW_CH], KA4[RW_CH]; float VV[RW_CH];
#define RW_LDS(s_) { R4[s_] = *(const f32x4*)(cb + (s_) * 256); K4[s_] = *(const f32x4*)(cb + 4096 + (s_) * 256); D4[s_] = *(const f32x4*)(cb + 8192 + (s_) * 256); \
        KD4[s_] = *(const f32x4*)(cb + 12288 + (s_) * 256); KA4[s_] = *(const f32x4*)(cb + 16384 + (s_) * 256); VV[s_] = *(const float*)(vb + (s_) * 64); }
      RW_LDS(0) RW_LDS(1) RW_LDS(2)
#pragma unroll
      for (int s = 0; s < RW_CH; ++s) {
        if (s + 3 < RW_CH) RW_LDS(s + 3)
        const f32x4 r4 = R4[s], k4 = K4[s], d4 = D4[s], kd4 = KD4[s], ka4 = KA4[s]; const float vv = VV[s];
        const f32x2 k01 = {k4[0], k4[1]}, k23 = {k4[2], k4[3]}, d01 = {d4[0], d4[1]}, d23 = {d4[2], d4[3]};
        const f32x2 kd01 = {kd4[0], kd4[1]}, kd23 = {kd4[2], kd4[3]}, ka01 = {ka4[0], ka4[1]}, ka23 = {ka4[2], ka4[3]};
        const f32x2 r01 = {r4[0], r4[1]}, r23 = {r4[2], r4[3]};
        const f32x2 sa2 = __builtin_elementwise_fma(S23, k23, S01 * k01);
        float sa = sa2[0] + sa2[1];
        sa = rowsum16(sa);
        const f32x2 vv2 = {vv, vv}; const f32x2 nsa = {-sa, -sa};
        f32x2 T01 = __builtin_elementwise_fma(-S01, d01, S01), T23 = __builtin_elementwise_fma(-S23, d23, S23);
        T01 = __builtin_elementwise_fma(vv2, kd01, T01); T23 = __builtin_elementwise_fma(vv2, kd23, T23);
        S01 = __builtin_elementwise_fma(nsa, ka01, T01); S23 = __builtin_elementwise_fma(nsa, ka23, T23);
        const f32x2 y2 = __builtin_elementwise_fma(S23, r23, S01 * r01);
        *(float*)(pbuf + (((s & 7) * 4 + rsub) * 16 + g) * 4) = y2[0] + y2[1];
        if ((s & 7) == 7) {
          if (lane < 32) {
            const char* pr = pbuf + lane * 64;
            const f32x4 a0 = *(const f32x4*)(pr), a1 = *(const f32x4*)(pr + 16), a2 = *(const f32x4*)(pr + 32), a3 = *(const f32x4*)(pr + 48);
            const f32x4 sm = (a0 + a1) + (a2 + a3);
            const float y = (sm[0] + sm[1]) + (sm[2] + sm[3]);
            *(hf*)(ybuf + (c & 1) * 512 + (((s >> 3) * 8 + (lane >> 2)) * 16 + wid * 4 + (lane & 3)) * 2) = (hf)y;
          }
        }
      }
      if (c + 2 < NCH) RW_SSTORE(c + 2)
      __syncthreads();
    }
    if (tid < 32) {
      const int mb_ = RW_M0((NCH - 1) * RW_CH); const size_t mv = (size_t)(mb_ + sgn * (tid >> 1));
      *(uint4*)(g_y + mv * ldy) = *(const uint4*)(ybuf + ((NCH - 1) & 1) * 512 + tid * 16);
    }
    __syncthreads();
  }
}

__device__ __forceinline__ void ph_rwpost(const P& p, int l) {
  const hf* ZRW = RW_ZRW(p); const hf* RKV = RW_RKV(p); const hf* YR = RW_YR(p);
  const int lane = get_tid() & 63, wid = get_tid() >> 6;
  const int nw = gridDim.x * 4;
  for (int t = blockIdx.x * 4 + wid; t < M_ALL * 6; t += nw) {
    const int m = t / 6, h = t % 6; const int c = h * 64 + lane;
    const float ys = (float)RKV[(size_t)m * 1152 + 384 + c] + (float)YR[(size_t)m * 384 + c];
    const float mean = wavesum(ys) * (1.f / 64.f);
    const float xc = ys - mean;
    const float var = wavesum(xc * xc) * (1.f / 64.f);
    float y = xc * rsqrtf(var + 64e-5f) * p.in[21][(size_t)l * 384 + c] + p.in[22][(size_t)l * 384 + c];
    const float r = (float)RKV[(size_t)m * 1152 + c], v = (float)RKV[(size_t)m * 1152 + 768 + c];
    const float rk = p.in[20][(size_t)l * 384 + c];
    const float kd0 = (float)RW_KD(p)[(size_t)m * 384 + c], kd1 = (float)RW_KD(p)[((size_t)M_ALL + m) * 384 + c];
    const float bs = wavesum(r * (kd0 + kd1) * rk);
    y = (y + bs * v) * (float)ZRW[(size_t)m * 1152 + 768 + c];
    p.Y[(size_t)m * 1024 + c] = f2bf(y);
  }
}

struct S5C { float ar, ai; float br[16], bi[16]; };
__device__ __forceinline__ void s5_consts(const P& p, int l, int d, int g, int n, S5C& c) {
  const int ig = (l * 2 + d) * 16 + g;
  const float lr = fminf(p.in[23][(size_t)ig * 64 + n], -1e-4f), li = p.in[24][(size_t)ig * 64 + n];
  const float dt = expf(p.in[25][ig]);
  const float mag = expf(lr * dt);
  c.ar = mag * cosf(li * dt); c.ai = mag * sinf(li * dt);
  const float nr = c.ar - 1.f, ni = c.ai; const float den = 1.f / (lr * lr + li * li);
  const float cr = (nr * lr + ni * li) * den, ci = (ni * lr - nr * li) * den;
  const float* bre = p.in[26] + ((size_t)ig * 64 + n) * 16; const float* bim = p.in[27] + ((size_t)ig * 64 + n) * 16;
#pragma unroll
  for (int h = 0; h < 16; ++h) { const float xr = bre[h], xi = bim[h]; c.br[h] = cr * xr - ci * xi; c.bi[h] = cr * xi + ci * xr; }
}
__device__ __forceinline__ int s5_m0(int b, int tc) { return tc < 128 ? b * 8192 + tc * 64 : M_LAT + b * 256 + (tc - 128) * 64; }
__device__ __forceinline__ int chain_pos(int d, int tc) { return d == 0 ? (tc < 128 ? tc + 4 : tc - 128) : (tc < 128 ? 131 - tc : 131 - tc); }
__device__ __forceinline__ void ph_s5_pass(const P& p, int l, int pass, char* lds, int vb, int nvb) {
  const int tid = get_tid(), lane = tid & 63, wid = tid >> 6, fr = lane & 15, fq = lane >> 4;
  float* ub = (float*)(lds + wid * 8448);
  char* xs = lds + wid * 8448 + 4096;
  const hf* Z = S5_ZH(p); float2* E = S5_E(p); const float2* X = S5_X(p); bf16_t* YG = S5_YG(p);
  const int nw = nvb * 4;
  for (int t = vb * 4 + wid; t < 4 * 132 * 16; t += nw) {
    const int g = t & 15, tc = (t >> 4) % 132, b = t / (16 * 132);
    const int m0 = s5_m0(b, tc);
#pragma unroll
    for (int i = 0; i < 4; ++i) { const int e = lane + i * 64; const int tok = e >> 2, q = e & 3;
      const hf4 zv = *(const hf4*)(Z + (size_t)(m0 + tok) * 256 + g * 16 + q * 4);
      *(float4*)(ub + tok * 16 + q * 4) = make_float4((float)zv[0], (float)zv[1], (float)zv[2], (float)zv[3]); }
    f32x4 yacc[4];
#pragma unroll
    for (int i = 0; i < 4; ++i) yacc[i] = (f32x4){0.f, 0.f, 0.f, 0.f};
    for (int d = 0; d < 2; ++d) {
      S5C c; s5_consts(p, l, d, g, lane, c);
      const int cp = chain_pos(d, tc);
      const size_t sidx = (((size_t)(d * 4 + b) * 132 + cp) * 16 + g) * 64 + lane;
      float xr = 0.f, xi = 0.f;
      hf8 cf[4];
      if (pass == 3) {
        float2 x0 = X[sidx]; xr = x0.x; xi = x0.y;
        const int ig = (l * 2 + d) * 16 + g;
#pragma unroll
        for (int ks = 0; ks < 4; ++ks) {
          const int c0 = ks * 32 + fq * 8;
          const float* src_ = (c0 < 64 ? p.in[28] : p.in[29]) + ((size_t)ig * 16 + fr) * 64 + (c0 & 63);
          const float sg = c0 < 64 ? 1.f : -1.f;
          const float4 v0 = *(const float4*)src_, v1 = *(const float4*)(src_ + 4);
          cf[ks][0] = (hf)(sg * v0.x); cf[ks][1] = (hf)(sg * v0.y); cf[ks][2] = (hf)(sg * v0.z); cf[ks][3] = (hf)(sg * v0.w);
          cf[ks][4] = (hf)(sg * v1.x); cf[ks][5] = (hf)(sg * v1.y); cf[ks][6] = (hf)(sg * v1.z); cf[ks][7] = (hf)(sg * v1.w);
        }
      }
#pragma unroll 1
      for (int jb = 0; jb < 4; ++jb) {
        const int tb = d ? 3 - jb : jb;
#pragma unroll 4
        for (int jj = 0; jj < 16; ++jj) {
          const int t16 = d ? 15 - jj : jj;
          const float* u = ub + (tb * 16 + t16) * 16;
          float br = 0.f, bi = 0.f;
#pragma unroll
          for (int h = 0; h < 16; ++h) { const float uv = u[h]; br += c.br[h] * uv; bi += c.bi[h] * uv; }
          const float nr = c.ar * xr - c.ai * xi + br, ni = c.ar * xi + c.ai * xr + bi;
          xr = nr; xi = ni;
          if (pass == 3) { *(hf*)(xs + t16 * 272 + lane * 2) = (hf)xr; *(hf*)(xs + t16 * 272 + 128 + lane * 2) = (hf)xi; }
        }
        if (pass == 3) {
          f32x4 acc = (f32x4){0.f, 0.f, 0.f, 0.f};
#pragma unroll
          for (int ks = 0; ks < 4; ++ks) {
            const hf8 af = *(const hf8*)(xs + fr * 272 + ks * 64 + fq * 16);
            acc = __builtin_amdgcn_mfma_f32_16x16x32_f16(af, cf[ks], acc, 0, 0, 0);
          }
#pragma unroll
          for (int i = 0; i < 4; ++i) if (i == tb) yacc[i] += acc;
        }
      }
      if (pass == 1) E[sidx] = make_float2(xr, xi);
    }
    if (pass == 3) {
      const float dsk = p.in[30][(size_t)l * 256 + g * 16 + fr];
#pragma unroll
      for (int i = 0; i < 4; ++i)
#pragma unroll
        for (int j = 0; j < 4; ++j) {
          const int tok = i * 16 + fq * 4 + j;
          float y = yacc[i][j] + dsk * ub[tok * 16 + fr];
          const float inner = 0.7978845608028654f * (y + 0.044715f * y * y * y);
          y = 0.5f * y * (1.f + tanhf_(inner));
          YG[(size_t)(m0 + tok) * 256 + g * 16 + fr] = f2bf(y);
        }
    }
  }
}
__device__ __forceinline__ void ph_s5_carry(const P& p, int l, int vb, int nvb) {
  float2* E = S5_E(p); float2* X = S5_X(p);
  for (int t = vb * NTHR + get_tid(); t < 8192; t += nvb * NTHR) {
    const int n = t & 63, g = (t >> 6) & 15, b = (t >> 10) & 3, d = t >> 12;
    const int ig = (l * 2 + d) * 16 + g;
    const float lr = fminf(p.in[23][(size_t)ig * 64 + n], -1e-4f), li = p.in[24][(size_t)ig * 64 + n];
    const float dt = expf(p.in[25][ig]);
    const float mag = expf(lr * dt * 64.f);
    float ar = expf(lr * dt) * cosf(li * dt), ai = expf(lr * dt) * sinf(li * dt);
#pragma unroll
    for (int i = 0; i < 6; ++i) { const float r2 = ar * ar - ai * ai, i2 = 2.f * ar * ai; ar = r2; ai = i2; }
    (void)mag;
    float xr = 0.f, xi = 0.f;
    const size_t base = (((size_t)(d * 4 + b) * 132) * 16 + g) * 64 + n;
    for (int cp0 = 0; cp0 < 132; cp0 += 12) {
      float2 ev[12];
#pragma unroll
      for (int u = 0; u < 12; ++u) ev[u] = E[base + (size_t)(cp0 + u) * 1024];
#pragma unroll
      for (int u = 0; u < 12; ++u) {
        X[base + (size_t)(cp0 + u) * 1024] = make_float2(xr, xi);
        const float nr = ar * xr - ai * xi + ev[u].x, ni = ar * xi + ai * xr + ev[u].y;
        xr = nr; xi = ni;
      }
    }
  }
}
__device__ __forceinline__ void ph_glu(const P& p, int l, char* lds, int vb, int nvb) {
  EPI_VARS
  const bf16_t* YG = S5_YG(p);
  const int Mt = 264;
  const float* gb = p.in[32] + (size_t)l * 256;
  for (int it = 0;; ++it) {
    int tm, tn; if (!tile_map_v(vb, nvb, it, Mt, 2, 2, tm, tn)) break; const int m0 = tm * 128, n0 = tn * 128;
    f32x4 acc[4][4]; ZERO_ACC(acc)
    gemm_main(YG + (size_t)m0 * 256, 256, p.W + W_GLU + (size_t)n0 * 256, 256, 256, acc, lds);
    EPI_BEGIN(m0, n0)
      const float y = bf2f(YG[(size_t)row * 256 + col]);
      p.Y[(size_t)row * 1024 + 384 + col] = f2bf(y * sigmoidf_(val + gb[col]));
    EPI_END
  }
}

__device__ __forceinline__ void sub_barrier(unsigned* cnt, unsigned target) {
  asm volatile("s_waitcnt vmcnt(0)" ::: "memory");
  __syncthreads();
  if (__builtin_amdgcn_workitem_id_x() == 0) {
    __builtin_amdgcn_fence(__ATOMIC_RELEASE, "agent");
    asm volatile("s_waitcnt vmcnt(0)" ::: "memory");
    __hip_atomic_fetch_add(cnt, 1u, __ATOMIC_RELAXED, __HIP_MEMORY_SCOPE_AGENT);
    unsigned sp = 0;
    while (__hip_atomic_load(cnt, __ATOMIC_RELAXED, __HIP_MEMORY_SCOPE_AGENT) < target) { __builtin_amdgcn_s_sleep(2); if (++sp > (1u << 22)) break; }
    __builtin_amdgcn_fence(__ATOMIC_ACQUIRE, "agent");
    asm volatile("s_waitcnt vmcnt(0)" ::: "memory");
  }
  __syncthreads();
}
__device__ __forceinline__ void ph_s5_stage(const P& p, int l, char* lds, int vb, int nvb) {
  unsigned* cnt = p.bar + 3584;
  const unsigned base = (unsigned)(l * 4) * (unsigned)nvb;
  ph_z_s5(p, lds, vb, nvb);            sub_barrier(cnt, base + 1u * nvb);
  ph_s5_pass(p, l, 1, lds, vb, nvb);   sub_barrier(cnt, base + 2u * nvb);
  ph_s5_carry(p, l, vb, nvb);          sub_barrier(cnt, base + 3u * nvb);
  ph_s5_pass(p, l, 3, lds, vb, nvb);   sub_barrier(cnt, base + 4u * nvb);
  ph_glu(p, l, lds, vb, nvb);
}

__device__ __forceinline__ float logsigf_(float x) { return fminf(x, 0.f) - log1pf(__expf(-fabsf(x))); }
__device__ __forceinline__ void ml_gates(const P& p, int l, int d, int h, int m0, int lane, float& bcum, float& ic) {
  const int tok = d ? 63 - lane : lane;
  const float* gl = ML_GL(p) + (size_t)(m0 + tok) * 16;
  const float* gb = p.in[33] + (size_t)(l * 2 + d) * 8;
  ic = gl[d * 8 + h] + gb[h];
  float f = logsigf_(gl[d * 8 + 4 + h] + gb[4 + h]);
#pragma unroll
  for (int o = 1; o < 64; o <<= 1) { float v = __shfl_up(f, o); if (lane >= o) f += v; }
  bcum = f;
}
__device__ __forceinline__ void ml_gates2(const P& p, int l, int d, int h, int m0, int lane, float& bc, float& ic, float& tot) {
  const float* gl = ML_GL(p) + (size_t)(m0 + lane) * 16;
  const float* gb = p.in[33] + (size_t)(l * 2 + d) * 8;
  ic = gl[d * 8 + h] + gb[h];
  const float f0 = logsigf_(gl[d * 8 + 4 + h] + gb[4 + h]);
  float f = f0;
#pragma unroll
  for (int o = 1; o < 64; o <<= 1) { float v = __shfl_up(f, o); if (lane >= o) f += v; }
  tot = __shfl(f, 63);
  bc = d ? (tot - f + f0) : f;
}
#define MLQ 208
#define MLS 144
__device__ __forceinline__ void ph_ml_a(const P& p, int l, char* lds) {
  char* vt = lds; char* kt = lds + 13824; float* wg = (float*)(lds + 27648);
  const int tid = get_tid(), lane = tid & 63, wid = tid >> 6, fr = lane & 15, fq = lane >> 4;
  const hf* QK = ML_QK(p); const hf* Z = ML_Z(p);
  for (int t = blockIdx.x; t < 4224; t += gridDim.x) {
    const int tc = t % 132, h = (t / 132) & 3, b = (t / 528) & 3, d = t / 2112;
    const int m0 = s5_m0(b, tc); const int cp = chain_pos(d, tc);
    const size_t task = ((size_t)((d * 4 + b) * 4 + h)) * 132 + cp;
    if (wid == 0) {
      float bc, ic, tot; ml_gates2(p, l, d, h, m0, lane, bc, ic, tot);
      const float lw = tot - bc + ic;
      float mx = lw;
      for (int o = 32; o > 0; o >>= 1) mx = fmaxf(mx, __shfl_xor(mx, o));
      wg[lane] = __expf(lw - mx);
      if (lane == 0) { ML_SC(p)[task * 2] = mx; ML_SC(p)[task * 2 + 1] = tot; }
    }
    __syncthreads();
    for (int e = tid; e < 64 * 12; e += NTHR) {
      const int tok = e & 63, q = e >> 6;
      const hf8 kv = *(const hf8*)(QK + (size_t)(m0 + tok) * 768 + 384 + h * 96 + q * 8);
      const hf8 vv = *(const hf8*)(Z + (size_t)(m0 + tok) * 1536 + 768 + h * 96 + q * 8);
      const float w = wg[tok];
#pragma unroll
      for (int i = 0; i < 8; ++i) {
        *(hf*)(kt + (q * 8 + i) * MLS + tok * 2) = kv[i];
        *(hf*)(vt + (q * 8 + i) * MLS + tok * 2) = (hf)((float)vv[i] * w);
      }
    }
    __syncthreads();
    float* dc = ML_DC(p) + task * 9216;
#pragma unroll 1
    for (int bi = 0; bi < 9; ++bi) {
      const int idx = wid * 9 + bi; const int mb = idx / 6, nb = idx % 6;
      f32x4 acc = (f32x4){0.f, 0.f, 0.f, 0.f};
#pragma unroll
      for (int ks = 0; ks < 2; ++ks) {
        const hf8 af = *(const hf8*)(vt + (mb * 16 + fr) * MLS + ks * 64 + fq * 16);
        const hf8 bf = *(const hf8*)(kt + (nb * 16 + fr) * MLS + ks * 64 + fq * 16);
        acc = __builtin_amdgcn_mfma_f32_16x16x32_f16(af, bf, acc, 0, 0, 0);
      }
#pragma unroll
      for (int j = 0; j < 4; ++j) dc[(mb * 16 + fq * 4 + j) * 96 + nb * 16 + fr] = acc[j];
    }
    if (tid < 96) {
      float s = 0.f;
      for (int j = 0; j < 64; ++j) s += wg[j] * (float)*(const hf*)(kt + tid * MLS + j * 2);
      ML_DN(p)[task * 96 + tid] = s;
    }
    __syncthreads();
  }
}
__device__ __forceinline__ void ph_ml_b(const P& p) {
  float* DC = ML_DC(p); float* DN = ML_DN(p); const float* SC = ML_SC(p); float* MP = ML_MP(p);
  for (int t = blockIdx.x * NTHR + get_tid(); t < 32 * 9312; t += gridDim.x * NTHR) {
    const int chain = t / 9312, e = t % 9312;
    float cur = 0.f, mprev = 0.f;
    for (int cp0 = 0; cp0 < 132; cp0 += 12) {
      float dl[12], ml_[12], bl_[12];
#pragma unroll
      for (int u = 0; u < 12; ++u) {
        const size_t task = (size_t)chain * 132 + cp0 + u;
        dl[u] = e < 9216 ? DC[task * 9216 + e] : DN[task * 96 + (e - 9216)];
        ml_[u] = SC[task * 2]; bl_[u] = SC[task * 2 + 1];
      }
#pragma unroll
      for (int u = 0; u < 12; ++u) {
        const size_t task = (size_t)chain * 132 + cp0 + u;
        float* slot = e < 9216 ? DC + task * 9216 + e : DN + task * 96 + (e - 9216);
        *slot = cur;
        if (e == 0) MP[task] = mprev;
        const float mnew = fmaxf(bl_[u] + mprev, ml_[u]);
        cur = __expf(bl_[u] + mprev - mnew) * cur + __expf(ml_[u] - mnew) * dl[u];
        mprev = mnew;
      }
    }
  }
}
__device__ __forceinline__ void ph_ml_c(const P& p, int l, char* lds) {
  char* qs = lds; char* ks = lds + 13312; char* vt = lds + 26624; char* cs = lds + 40448; char* ps = lds + 60416;
  float* fl = (float*)(lds + 69632);
  float* bc = fl; float* icv = fl + 128; float* mr = fl + 256; float* inter = fl + 320; float* den = fl + 384; float* nq = fl + 448; float* nst = fl + 512;
  const int tid = get_tid(), lane = tid & 63, wid = tid >> 6, fr = lane & 15, fq = lane >> 4;
  const hf* QK = ML_QK(p); const hf* Z = ML_Z(p);
  for (int t = blockIdx.x; t < 2112; t += gridDim.x) {
    const int tc = t % 132, h = (t / 132) & 3, b = t / 528;
    const int m0 = s5_m0(b, tc);
    for (int e = tid; e < 64 * 12; e += NTHR) {
      const int tok = e & 63, q = e >> 6;
      *(hf8*)(qs + tok * MLQ + q * 16) = *(const hf8*)(QK + (size_t)(m0 + tok) * 768 + h * 96 + q * 8);
      *(hf8*)(ks + tok * MLQ + q * 16) = *(const hf8*)(QK + (size_t)(m0 + tok) * 768 + 384 + h * 96 + q * 8);
      const hf8 vv = *(const hf8*)(Z + (size_t)(m0 + tok) * 1536 + 768 + h * 96 + q * 8);
#pragma unroll
      for (int i = 0; i < 8; ++i) *(hf*)(vt + (q * 8 + i) * MLS + tok * 2) = vv[i];
    }
    if (wid < 2) { float bcv, ic, tot; ml_gates2(p, l, wid, h, m0, lane, bcv, ic, tot); bc[wid * 64 + lane] = bcv; icv[wid * 64 + lane] = ic; }
    f32x4 hs[6];
#pragma unroll
    for (int n = 0; n < 6; ++n) hs[n] = (f32x4){0.f, 0.f, 0.f, 0.f};
    for (int d = 0; d < 2; ++d) {
      const int cp = chain_pos(d, tc);
      const size_t task = ((size_t)((d * 4 + b) * 4 + h)) * 132 + cp;
      const float mprev = ML_MP(p)[task];
      __syncthreads();
      {
        const float* cg = ML_DC(p) + task * 9216;
        for (int e = tid; e < 96 * 24; e += NTHR) {
          const int v = e / 24, q = e % 24;
          const float4 c4 = *(const float4*)(cg + v * 96 + q * 4);
          hf4 o; o[0] = (hf)c4.x; o[1] = (hf)c4.y; o[2] = (hf)c4.z; o[3] = (hf)c4.w;
          *(hf4*)(cs + v * MLQ + q * 8) = o;
        }
        if (tid < 96) nst[tid] = ML_DN(p)[task * 96 + tid];
      }
      const float* bcd = bc + d * 64; const float* icd = icv + d * 64;
      if (tid < 64) {
        const int j = tid; const float bj = bcd[j];
        float mx = bj + mprev;
        if (d == 0) { for (int s = 0; s <= j; ++s) mx = fmaxf(mx, bj - bcd[s] + icd[s]); }
        else { for (int s = j; s < 64; ++s) mx = fmaxf(mx, bj - bcd[s] + icd[s]); }
        mr[j] = mx; inter[j] = __expf(bj + mprev - mx);
      }
      __syncthreads();
      if (tid < 64) {
        float s1 = 0.f;
        for (int k = 0; k < 96; ++k) s1 += nst[k] * (float)*(const hf*)(qs + tid * MLQ + k * 2);
        nq[tid] = s1;
      }
      {
        f32x4 sacc[4];
#pragma unroll
        for (int n = 0; n < 4; ++n) sacc[n] = (f32x4){0.f, 0.f, 0.f, 0.f};
#pragma unroll
        for (int kk = 0; kk < 3; ++kk) {
          const hf8 af = *(const hf8*)(qs + (wid * 16 + fr) * MLQ + kk * 64 + fq * 16);
#pragma unroll
          for (int n = 0; n < 4; ++n) {
            const hf8 bf = *(const hf8*)(ks + (n * 16 + fr) * MLQ + kk * 64 + fq * 16);
            sacc[n] = __builtin_amdgcn_mfma_f32_16x16x32_f16(af, bf, sacc[n], 0, 0, 0);
          }
        }
        float rs[4] = {0.f, 0.f, 0.f, 0.f};
#pragma unroll
        for (int n = 0; n < 4; ++n) {
          const int s = n * 16 + fr; const float bs = bcd[s] - icd[s];
#pragma unroll
          for (int jj = 0; jj < 4; ++jj) {
            const int j = wid * 16 + fq * 4 + jj;
            const bool valid = d == 0 ? (s <= j) : (s >= j);
            const float val = valid ? sacc[n][jj] * __expf(bcd[j] - bs - mr[j]) : 0.f;
            rs[jj] += val;
            *(hf*)(ps + j * MLS + s * 2) = (hf)val;
          }
        }
        __syncthreads();
#pragma unroll
        for (int jj = 0; jj < 4; ++jj) {
          const float r = rowsum16(rs[jj]);
          const int j = wid * 16 + fq * 4 + jj;
          if (fr == 0) den[j] = inter[j] * nq[j] + r;
        }
      }
      f32x4 acc[6];
#pragma unroll
      for (int n = 0; n < 6; ++n) acc[n] = (f32x4){0.f, 0.f, 0.f, 0.f};
#pragma unroll
      for (int kk = 0; kk < 3; ++kk) {
        const hf8 af = *(const hf8*)(qs + (wid * 16 + fr) * MLQ + kk * 64 + fq * 16);
#pragma unroll
        for (int n = 0; n < 6; ++n) {
          const hf8 bf = *(const hf8*)(cs + (n * 16 + fr) * MLQ + kk * 64 + fq * 16);
          acc[n] = __builtin_amdgcn_mfma_f32_16x16x32_f16(af, bf, acc[n], 0, 0, 0);
        }
      }
#pragma unroll
      for (int jj = 0; jj < 4; ++jj) { const float it = inter[wid * 16 + fq * 4 + jj];
#pragma unroll
        for (int n = 0; n < 6; ++n) acc[n][jj] *= it; }
#pragma unroll
      for (int kk = 0; kk < 2; ++kk) {
        const hf8 af = *(const hf8*)(ps + (wid * 16 + fr) * MLS + kk * 64 + fq * 16);
#pragma unroll
        for (int n = 0; n < 6; ++n) {
          const hf8 bf = *(const hf8*)(vt + (n * 16 + fr) * MLS + kk * 64 + fq * 16);
          acc[n] = __builtin_amdgcn_mfma_f32_16x16x32_f16(af, bf, acc[n], 0, 0, 0);
        }
      }
      __syncthreads();
#pragma unroll
      for (int jj = 0; jj < 4; ++jj) {
        const int j = wid * 16 + fq * 4 + jj;
        const float dn = 1.f / fmaxf(fabsf(den[j]), __expf(-mr[j]));
#pragma unroll
        for (int n = 0; n < 6; ++n) hs[n][jj] += acc[n][jj] * dn;
      }
    }
#pragma unroll
    for (int jj = 0; jj < 4; ++jj) {
      const int m = m0 + wid * 16 + fq * 4 + jj;
      const hf* op = Z + (size_t)m * 1536 + 1152 + h * 96 + fr;
      float x[6]; float s = 0.f;
#pragma unroll
      for (int n = 0; n < 6; ++n) { x[n] = sigmoidf_((float)op[n * 16]) * hs[n][jj]; s += x[n]; }
      s = rowsum16(s);
      const float mean = s * (1.f / 96.f);
      float q = 0.f;
#pragma unroll
      for (int n = 0; n < 6; ++n) { x[n] -= mean; q += x[n] * x[n]; }
      q = rowsum16(q);
      const float rsd = rsqrtf(q * (1.f / 96.f) + 1e-5f);
      const float* ng = p.in[34] + (size_t)l * 384 + h * 96 + fr;
      bf16_t* yp = p.Y + (size_t)m * 1024 + 640 + h * 96 + fr;
#pragma unroll
      for (int n = 0; n < 6; ++n) yp[n * 16] = f2bf(x[n] * rsd * ng[n * 16]);
    }
    __syncthreads();
  }
}

#define MG_YM(p) ((bf16_t*)(p).R)
#define MG_G3(p) (MG_YM(p) + (size_t)M_ALL * 1024)
__device__ __forceinline__ void ph_gates(const P& p, int l, int Mt, char* lds) {
  EPI_VARS
  bf16_t* G3 = MG_G3(p);
  const float* gbias = p.in[38] + (size_t)l * 3072;
  const int ntile = Mt * 24;
  for (int it = 0;; ++it) {
    int tm, tn; if (!tile_map(it, Mt, 24, 8, tm, tn)) break; const int m0 = tm * 128, n0 = tn * 128;
    f32x4 acc[4][4]; ZERO_ACC(acc)
    gemm_main(p.U + (size_t)m0 * 1024, 1024, p.W + W_IN + (size_t)(3216 + n0) * 1024, 1024, 1024, acc, lds);
    EPI_BEGIN(m0, n0)
      G3[(size_t)row * 3072 + col] = f2bf(sigmoidf_(val + gbias[col]));
    EPI_END
  }
}
__device__ __forceinline__ void ph_merge(const P& p, int l, int Mt, char* lds) {
  EPI_VARS
  bf16_t* YM = MG_YM(p); const bf16_t* G3 = MG_G3(p);
  const int ntile = Mt * 16;
  for (int it = 0;; ++it) {
    int tm, tn; if (!tile_map(it, Mt, 16, 8, tm, tn)) break; const int m0 = tm * 128, n0 = tn * 64;
    f32x4 yacc[4][2];
#pragma unroll
    for (int m = 0; m < 4; ++m) { yacc[m][0] = (f32x4){0.f, 0.f, 0.f, 0.f}; yacc[m][1] = (f32x4){0.f, 0.f, 0.f, 0.f}; }
#pragma unroll 1
    for (int br = 0; br < 3; ++br) {
      f32x4 acc[4][2];
#pragma unroll
      for (int m = 0; m < 4; ++m) { acc[m][0] = (f32x4){0.f, 0.f, 0.f, 0.f}; acc[m][1] = (f32x4){0.f, 0.f, 0.f, 0.f}; }
      const int kb = br == 1 ? 256 : 384; const int yoff = br == 0 ? 0 : (br == 1 ? 384 : 640);
      const int woff = br == 0 ? W_UPRW : (br == 1 ? W_UPS5 : W_UPML);
      gemm_main_t<2>(p.Y + (size_t)m0 * 1024 + yoff, 1024, p.W + woff + (size_t)n0 * kb, kb, kb, acc, lds);
      EPI_ROW_BEGIN(m0)
        const bf16_t* gp = G3 + (size_t)row * 3072 + br * 1024 + n0 + wc * 32 + fr;
#pragma unroll
        for (int n = 0; n < 2; ++n) yacc[m][n][j] += bf2f(gp[n * 16]) * acc[m][n][j];
      EPI_ROW_END
    }
    EPI_ROW_BEGIN(m0)
      bf16_t* yp = YM + (size_t)row * 1024 + n0 + wc * 32 + fr;
#pragma unroll
      for (int n = 0; n < 2; ++n) yp[n * 16] = f2bf(yacc[m][n][j]);
    EPI_ROW_END
  }
}
__device__ __forceinline__ void ph_wout(const P& p, int l, int Mt, char* lds) {
  EPI_VARS
  const bf16_t* YM = (const bf16_t*)p.R;
  const int ntile = Mt * 8;
  for (int it = 0;; ++it) {
    int tm, tn; if (!tile_map(it, Mt, 8, 8, tm, tn)) break; const int m0 = tm * 128, n0 = tn * 128;
    f32x4 acc[4][4]; ZERO_ACC(acc)
    gemm_main(YM + (size_t)m0 * 1024, 1024, p.W + W_OUT + (size_t)n0 * 1024, 1024, 1024, acc, lds);
    EPI_ROW_BEGIN(m0)
      float* sp = srow(p, row) + n0 + wc * 64 + fr; const float* gp = modp(p, l, row, 5) + n0 + wc * 64 + fr;
#pragma unroll
      for (int n = 0; n < 4; ++n) sp[n * 16] = ALPHA * sp[n * 16] + gp[n * 16] * acc[m][n][j];
    EPI_ROW_END
  }
}

#define XB_TMO      128
#define XB_XCNT(j)  (256  + 64 * (j))
#define XB_XSUB(j)  (1280 + 64 * (j))
#define XB_XGEN(j)  (2304 + 64 * (j))
#define XB_TOP      3328
#define XB_TOPGEN   3392
#define XCD_BAR_WORDS 3456
#define XB_SPIN_CAP (1u << 18)
#define LAS __attribute__((address_space(3)))

__device__ __forceinline__ unsigned xb_ld(unsigned* p)              { return __hip_atomic_load(p, __ATOMIC_RELAXED, __HIP_MEMORY_SCOPE_AGENT); }
__device__ __forceinline__ unsigned xb_add(unsigned* p, unsigned v) { return __hip_atomic_fetch_add(p, v, __ATOMIC_RELAXED, __HIP_MEMORY_SCOPE_AGENT); }
__device__ __forceinline__ unsigned xb_xcc_id() { return (unsigned)__builtin_amdgcn_s_getreg((3 << 11) | 20) & 0xFu; }
#define XB_SPIN(cond, bar) do { unsigned _sp = 0; while (cond) { __builtin_amdgcn_s_sleep(1); \
    if ((++_sp & 255u) == 0u) { if (xb_ld(&(bar)[XB_TMO])) break; if (_sp > XB_SPIN_CAP) { atomicAdd(&(bar)[XB_TMO], 1u); break; } } } } while (0)

struct XcdBarrier {
    unsigned* bar; unsigned x;
    volatile LAS unsigned* st;
};

__device__ __forceinline__ XcdBarrier xcd_barrier_post(unsigned* bar, volatile LAS unsigned* st) {
    XcdBarrier b; b.bar = bar; b.x = xb_xcc_id(); b.st = st;
    if (__builtin_amdgcn_workitem_id_x() == 0) (void)xb_add(&bar[XB_XCNT(b.x)], 1u);
    return b;
}
__device__ __forceinline__ void xcd_barrier_complete(unsigned* bar, unsigned x, unsigned& nloc, unsigned& nx) {
    const unsigned G = gridDim.x * gridDim.y * gridDim.z;
    unsigned sum, cnt, mine, sp = 0u;
    for (;;) {
        sum = 0u; cnt = 0u; mine = 0u;
#pragma unroll
        for (unsigned j = 0; j < 16; ++j) { const unsigned c = xb_ld(&bar[XB_XCNT(j)]); sum += c; cnt += (c > 0u) ? 1u : 0u; mine = (j == x) ? c : mine; }
        if (sum == G) break;
        __builtin_amdgcn_s_sleep(1);
        if ((++sp & 255u) == 0u) { if (xb_ld(&bar[XB_TMO])) break; if (sp > XB_SPIN_CAP) { atomicAdd(&bar[XB_TMO], 1u); break; } }
    }
    nloc = mine > 0u ? mine : 1u; nx = cnt > 0u ? cnt : 1u;
}

__device__ __forceinline__ void xcd_barrier(const XcdBarrier& b) {
    asm volatile("s_waitcnt vmcnt(0)" ::: "memory");
    __syncthreads();
    if (__builtin_amdgcn_workitem_id_x() == 0) {
        unsigned* bar = b.bar;
        __builtin_amdgcn_s_waitcnt(0);
        unsigned nloc = b.st[0], nx = b.st[1];
        if (nloc == 0u) { xcd_barrier_complete(bar, b.x, nloc, nx); b.st[0] = nloc; b.st[1] = nx; }
        const unsigned old = xb_add(&bar[XB_XSUB(b.x)], 1u);
        const unsigned gen = old / nloc;
        if (old + 1u == (gen + 1u) * nloc) {
            __builtin_amdgcn_fence(__ATOMIC_RELEASE, "agent");
            asm volatile("s_waitcnt vmcnt(0)" ::: "memory");
            const unsigned og = xb_add(&bar[XB_TOP], 1u);
            const unsigned tg = og / nx;
            if (og + 1u == (tg + 1u) * nx) xb_add(&bar[XB_TOPGEN], 1u);
            else XB_SPIN(xb_ld(&bar[XB_TOPGEN]) == tg, bar);
            __builtin_amdgcn_fence(__ATOMIC_ACQUIRE, "agent");
            xb_add(&bar[XB_XGEN(b.x)], 1u);
            asm volatile("s_waitcnt vmcnt(0)" ::: "memory");
        } else {
            XB_SPIN(xb_ld(&bar[XB_XGEN(b.x)]) == gen, bar);
            __builtin_amdgcn_fence(__ATOMIC_ACQUIRE, "agent");
            asm volatile("s_waitcnt vmcnt(0)" ::: "memory");
        }
    }
    __syncthreads();
}


#define SYNC xcd_barrier(xb); asm volatile("" : "+s"(l));
__global__ void __launch_bounds__(NTHR, 2) mega(P pv) {
#define p pv
  __shared__ __attribute__((aligned(16))) char lds[LDS_BYTES];
  __shared__ uint4 xb_words;
  cg::grid_group grid = cg::this_grid();
  {
    const int t0 = __builtin_amdgcn_workitem_id_x();
    if (blockIdx.x == 0) for (int i = t0; i < 4096; i += NTHR) pv.bar[i] = 0u;
    if (t0 == 0) xb_words = make_uint4(0u, 0u, 0u, 0u);
    __threadfence();
    grid.sync();
  }
  XcdBarrier xb = xcd_barrier_post(pv.bar, (volatile LAS unsigned*)&xb_words);
  for (int l = 0; l < 2; ++l) {
    const bool last = (l == 1);
    const int Mt2 = last ? 256 : 264;
    const int Mr2 = last ? M_LAT : M_ALL;
    ph_convert(p, l, l == 0, lds); SYNC
    if (l == 0) { ph_rows(p, 0, 0, 0, M_ALL, true, 0, 0); SYNC }
    ph_ffn_up(p, 0, 264, lds); SYNC
    ph_ffn_down(p, l, 0, 264, lds); SYNC
    ph_rows(p, 1, l, 0, M_ALL, true, l, 3); SYNC
    ph_z_rw(p, lds); SYNC
    ph_conv<0>(p, l); SYNC
    ph_lora(p, l, lds); SYNC
    {
      const int ns = gridDim.x >= 384 ? 192 : 0;
      if (ns == 0 || blockIdx.x < 192) ph_rwscan(p, lds);
      if (ns == 0) { SYNC }
      if ((int)blockIdx.x >= ns) ph_s5_stage(p, l, lds, (int)blockIdx.x - ns, (int)gridDim.x - ns);
      SYNC
    }
    ph_rwpost(p, l); SYNC
    ph_z_ml(p, lds); SYNC
    ph_conv<1>(p, l); SYNC
    ph_ml_a(p, l, lds); SYNC
    ph_ml_b(p); SYNC
    ph_ml_c(p, l, lds); SYNC
    ph_gates(p, l, Mt2, lds); SYNC
    ph_merge(p, l, Mt2, lds); SYNC
    ph_wout(p, l, Mt2, lds); SYNC
    ph_rows(p, 1, l, 1, Mr2, true, l, 6); SYNC
    ph_ffn_up(p, 1, Mt2, lds); SYNC
    ph_ffn_down(p, l, 1, Mt2, lds); SYNC
    ph_rows(p, 1, l, 2, Mr2, !last, l + 1, 0);
    if (!last) { SYNC }
  }
#undef p
}

extern "C" void kernel_launch(void* const* d_in, const int* in_sizes, int n_in, void* d_out, int out_size, void* d_ws, size_t ws_size,
                              hipStream_t stream) {
  static int grid_blocks = 0;
  if (!grid_blocks) {
    int dev = 0, cus = 0, per_cu = 0;
    hipGetDevice(&dev);
    hipDeviceGetAttribute(&cus, hipDeviceAttributeMultiprocessorCount, dev);
    hipOccupancyMaxActiveBlocksPerMultiprocessor(&per_cu, mega, NTHR, 0);
    if (per_cu > 2) per_cu = 2;
    grid_blocks = cus * per_cu;
  }
  P p{};
  for (int i = 0; i < 40; ++i) p.in[i] = (const float*)d_in[i];
  char* ws = (char*)d_ws;
  size_t off = 0;
  p.W = (bf16_t*)(ws + off); off += (size_t)W_TOTAL * 2;
  p.mod = (float*)(ws + off); off += (size_t)2 * 5 * 9216 * 4;
  p.sctx = (float*)(ws + off); off += (size_t)1024 * 1024 * 4;
  p.bar = (unsigned*)(ws + off); off += (size_t)16384;
  p.U = (bf16_t*)(ws + off); off += (size_t)M_ALL * 1024 * 2;
  p.Y = (bf16_t*)(ws + off); off += (size_t)M_ALL * 1024 * 2;
  p.R = ws + off;
  p.out = (float*)d_out;
  if (off + (size_t)M_ALL * 9728 > ws_size) fprintf(stderr, "workspace too small: need %zu have %zu\n", off + (size_t)M_ALL * 9728, ws_size);
  void* args[] = {&p};
  hipError_t e = hipLaunchCooperativeKernel((void*)mega, dim3(grid_blocks), dim3(NTHR), args, 0, stream);
  if (e != hipSuccess) fprintf(stderr, "cooperative launch failed: %s (grid %d)\n", hipGetErrorString(e), grid_blocks);
}
```

```cpp
#include <hip/hip_runtime.h>
#include <hip/hip_cooperative_groups.h>
#include <cstdio>
namespace cg = cooperative_groups;

typedef unsigned short bf16_t;
typedef _Float16 hf;
typedef hf hf4 __attribute__((ext_vector_type(4)));
typedef hf hf8 __attribute__((ext_vector_type(8)));
typedef __attribute__((ext_vector_type(8))) short bf16x8;
typedef __attribute__((ext_vector_type(4))) float f32x4;
typedef unsigned int u32x4 __attribute__((ext_vector_type(4)));

#define M_LAT 32768
#define M_ALL 33792
#define NTHR 256
#define LDS_BYTES 73728
#define ALPHA 1.41421356237f

#define W_GU0 0
#define W_D0 5767168
#define W_GU1 8650752
#define W_D1 14417920
#define W_IN 17301504
#define W_WUP0 23740416
#define W_WUP1 23764992
#define W_AUP0 23789568
#define W_AUP1 23814144
#define W_GUP 23838720
#define W_GLU 23887872
#define W_UPRW 23953408
#define W_UPS5 24346624
#define W_UPML 24608768
#define W_OUT 25001984
#define W_TOTAL 26050560

struct P {
  const float* in[40];
  float* out; float* sctx; float* mod;
  bf16_t* U; bf16_t* Y; bf16_t* W; char* R; unsigned* bar;
};

__device__ __forceinline__ int get_tid() { int t = __builtin_amdgcn_workitem_id_x(); asm volatile("" : "+v"(t)); return t; }
__device__ __forceinline__ bf16_t f2bf(float f) { return __builtin_bit_cast(unsigned short, (_Float16)f); }
__device__ __forceinline__ float bf2f(bf16_t h) { return (float)__builtin_bit_cast(_Float16, h); }
__device__ __forceinline__ float sigmoidf_(float x) { return __builtin_amdgcn_rcpf(1.f + __expf(-x)); }
__device__ __forceinline__ float tanhf_(float x) { return 1.f - 2.f * __builtin_amdgcn_rcpf(1.f + __expf(2.f * x)); }
__device__ __forceinline__ float siluf_(float x) { return x * __builtin_amdgcn_rcpf(1.f + __expf(-x)); }
__device__ __forceinline__ float* srow(const P& p, int m) { return m < M_LAT ? p.out + (size_t)m * 1024 : p.sctx + (size_t)(m - M_LAT) * 1024; }
__device__ __forceinline__ const float* modp(const P& p, int l, int m, int k) { int mv = m < M_LAT ? (m >> 13) : 4; return p.mod + (size_t)(l * 5 + mv) * 9216 + k * 1024; }
template <int C> __device__ __forceinline__ float dppf(float x) { return __int_as_float(__builtin_amdgcn_update_dpp(0, __float_as_int(x), C, 0xf, 0xf, false)); }
__device__ __forceinline__ float rowsum16(float x) { x += dppf<0x128>(x); x += dppf<0x124>(x); x += dppf<0x122>(x); x += dppf<0x121>(x); return x; }
__device__ __forceinline__ float wavesum(float x) { for (int o = 32; o > 0; o >>= 1) x += __shfl_xor(x, o); return x; }

template <int NB>
__device__ __forceinline__ void gemm_main_t(const bf16_t* __restrict__ A, int lda, const bf16_t* __restrict__ B, int ldb, int K,
                                          f32x4 (&acc)[4][NB], char* lds) {
  const int tid = get_tid(), lane = tid & 63, wid = tid >> 6, wr = wid >> 1, wc = wid & 1;
  const int fr = lane & 15, fq = lane >> 4;
  const int sr = tid >> 3, skc = tid & 7;
  const bf16_t* ga = A + (size_t)sr * lda + skc * 8;
  const bf16_t* gb = B + (size_t)sr * ldb + skc * 8;
  u32x4 ra0[4], rb0[NB], ra1[4], rb1[NB];
  const int soff = sr * 144 + skc * 16;
  const int nk = K >> 6;
  const int aoff = (wr * 64 + fr) * 144 + fq * 16;
  const int boff = 18432 + (wc * (NB * 16) + fr) * 144 + fq * 16;
#define G_LOAD(RA, RB, kt) { _Pragma("unroll") for (int i = 0; i < 4; ++i) { RA[i] = *(const u32x4*)(ga + (size_t)(i * 32) * lda + (kt) * 64); if (i < NB) RB[i] = *(const u32x4*)(gb + (size_t)(i * 32) * ldb + (kt) * 64); } }
#define G_STORE(RA, RB, buf) { char* d_ = lds + (buf) * 36864 + soff; _Pragma("unroll") for (int i = 0; i < 4; ++i) { *(u32x4*)(d_ + i * 32 * 144) = RA[i]; if (i < NB) *(u32x4*)(d_ + 18432 + i * 32 * 144) = RB[i]; } }
#define G_COMP(buf) { const char* cur = lds + (buf) * 36864; _Pragma("unroll") for (int ks = 0; ks < 2; ++ks) { hf8 af[4], bfr[NB]; \
    _Pragma("unroll") for (int m = 0; m < 4; ++m) af[m] = *(const hf8*)(cur + aoff + m * 16 * 144 + ks * 64); \
    _Pragma("unroll") for (int n = 0; n < NB; ++n) bfr[n] = *(const hf8*)(cur + boff + n * 16 * 144 + ks * 64); \
    _Pragma("unroll") for (int m = 0; m < 4; ++m) _Pragma("unroll") for (int n = 0; n < NB; ++n) acc[m][n] = __builtin_amdgcn_mfma_f32_16x16x32_f16(af[m], bfr[n], acc[m][n], 0, 0, 0); } }
  G_LOAD(ra0, rb0, 0)
  { const int k1 = nk > 1 ? 1 : 0; G_LOAD(ra1, rb1, k1) }
  G_STORE(ra0, rb0, 0)
  __syncthreads();
  for (int kt = 0; kt < nk; kt += 2) {
    { const int k2 = kt + 2 < nk ? kt + 2 : nk - 1; G_LOAD(ra0, rb0, k2) }
    G_COMP(0)
    G_STORE(ra1, rb1, 1)
    __syncthreads();
    { const int k3 = kt + 3 < nk ? kt + 3 : nk - 1; G_LOAD(ra1, rb1, k3) }
    if (kt + 1 < nk) G_COMP(1)
    G_STORE(ra0, rb0, 0)
    __syncthreads();
  }
}
__device__ __forceinline__ void gemm_stream(const bf16_t* __restrict__ A, int lda, const bf16_t* __restrict__ B, int ldb, int K,
                                            const bf16_t* __restrict__ An, const bf16_t* __restrict__ Bn, bool first,
                                            f32x4 (&acc)[4][4], char* lds, u32x4 (&ra1)[4], u32x4 (&rb1)[4]) {
  constexpr int NB = 4;
  const int tid = get_tid(), lane = tid & 63, wid = tid >> 6, wr = wid >> 1, wc = wid & 1;
  const int fr = lane & 15, fq = lane >> 4;
  const int sr = tid >> 3, skc = tid & 7;
  const bf16_t* ga = A + (size_t)sr * lda + skc * 8;
  const bf16_t* gb = B + (size_t)sr * ldb + skc * 8;
  const bf16_t* gan = An + (size_t)sr * lda + skc * 8;
  const bf16_t* gbn = Bn + (size_t)sr * ldb + skc * 8;
  u32x4 ra0[4], rb0[NB];
  const int soff = sr * 144 + skc * 16;
  const int nk = K >> 6;
  const int aoff = (wr * 64 + fr) * 144 + fq * 16;
  const int boff = 18432 + (wc * (NB * 16) + fr) * 144 + fq * 16;
#define GS_LOAD(RA, RB, pa, pb, kt) { _Pragma("unroll") for (int i = 0; i < 4; ++i) { RA[i] = *(const u32x4*)((pa) + (size_t)(i * 32) * lda + (kt) * 64); RB[i] = *(const u32x4*)((pb) + (size_t)(i * 32) * ldb + (kt) * 64); } }
  if (first) {
    GS_LOAD(ra0, rb0, ga, gb, 0)
    GS_LOAD(ra1, rb1, ga, gb, 1)
    G_STORE(ra0, rb0, 0)
    __syncthreads();
  }
  for (int kt = 0; kt < nk; kt += 2) {
    if (kt + 2 < nk) { GS_LOAD(ra0, rb0, ga, gb, kt + 2) } else { GS_LOAD(ra0, rb0, gan, gbn, 0) }
    G_COMP(0)
    G_STORE(ra1, rb1, 1)
    __syncthreads();
    if (kt + 3 < nk) { GS_LOAD(ra1, rb1, ga, gb, kt + 3) } else { GS_LOAD(ra1, rb1, gan, gbn, 1) }
    G_COMP(1)
    G_STORE(ra0, rb0, 0)
    __syncthreads();
  }
}
__device__ __forceinline__ void gemm_main(const bf16_t* __restrict__ A, int lda, const bf16_t* __restrict__ B, int ldb, int K, f32x4 (&acc)[4][4], char* lds) {
  gemm_main_t<4>(A, lda, B, ldb, K, acc, lds);
}
template <int KT>
__device__ __forceinline__ void gemm_small_t(const bf16_t* __restrict__ A, int lda, const bf16_t* __restrict__ B, int ldb, f32x4 (&acc)[4][4], char* lds) {
  const int tid = get_tid(), lane = tid & 63, wid = tid >> 6, wr = wid >> 1, wc = wid & 1;
  const int fr = lane & 15, fq = lane >> 4;
  const int sr = tid >> 3, skc = tid & 7;
  const bf16_t* ga = A + (size_t)sr * lda + skc * 8;
  const bf16_t* gb = B + (size_t)sr * ldb + skc * 8;
  const int soff = sr * 144 + skc * 16;
  const int aoff = (wr * 64 + fr) * 144 + fq * 16;
  const int boff = 18432 + (wc * 64 + fr) * 144 + fq * 16;
  u32x4 ra[KT][4], rb[KT][4];
#pragma unroll
  for (int kt = 0; kt < KT; ++kt)
#pragma unroll
    for (int i = 0; i < 4; ++i) { ra[kt][i] = *(const u32x4*)(ga + (size_t)(i * 32) * lda + kt * 64); rb[kt][i] = *(const u32x4*)(gb + (size_t)(i * 32) * ldb + kt * 64); }
#pragma unroll
  for (int kt = 0; kt < KT; ++kt)
#pragma unroll
    for (int i = 0; i < 4; ++i) { *(u32x4*)(lds + kt * 36864 + soff + i * 32 * 144) = ra[kt][i]; *(u32x4*)(lds + kt * 36864 + 18432 + soff + i * 32 * 144) = rb[kt][i]; }
  __syncthreads();
#pragma unroll
  for (int kt = 0; kt < KT; ++kt) {
    const char* cur = lds + kt * 36864;
#pragma unroll
    for (int ks = 0; ks < 2; ++ks) {
      hf8 af[4], bfr[4];
#pragma unroll
      for (int m = 0; m < 4; ++m) af[m] = *(const hf8*)(cur + aoff + m * 16 * 144 + ks * 64);
#pragma unroll
      for (int n = 0; n < 4; ++n) bfr[n] = *(const hf8*)(cur + boff + n * 16 * 144 + ks * 64);
#pragma unroll
      for (int m = 0; m < 4; ++m)
#pragma unroll
        for (int n = 0; n < 4; ++n) acc[m][n] = __builtin_amdgcn_mfma_f32_16x16x32_f16(bfr[n], af[m], acc[m][n], 0, 0, 0);
    }
  }
  __syncthreads();
}

template <int SM>
__device__ __forceinline__ bool tile_map_sm(int b, int nb, int it, int Mt, int Nt, int SN, int& tm, int& tn) {
  const int xcd = b & 7, li = b >> 3, nloc = nb >> 3;
  const int T = SM * SN; const int nsn = Nt / SN; const int nsuper = (Mt / SM) * nsn;
  const int o = li + it * nloc; const int k = o / T, w = o - k * T;
  const int s = xcd + 8 * k;
  if (s >= nsuper) return false;
  const int sm = s / nsn, sn = s - sm * nsn;
  tm = sm * SM + (w % SM); tn = sn * SN + (w / SM);
  return true;
}
__device__ __forceinline__ bool tile_map_v(int b, int nb, int it, int Mt, int Nt, int SN, int& tm, int& tn) {
  const int nsn = Nt / SN;
  if (nsn * (Mt >> 3) % 8 == 0 || nsn >= 8) return tile_map_sm<8>(b, nb, it, Mt, Nt, SN, tm, tn);
  return tile_map_sm<1>(b, nb, it, Mt, Nt, SN, tm, tn);
}
__device__ __forceinline__ bool tile_map(int it, int Mt, int Nt, int SN, int& tm, int& tn) { return tile_map_v(blockIdx.x, gridDim.x, it, Mt, Nt, SN, tm, tn); }
#define ZERO_ACC(a) _Pragma("unroll") for (int m_ = 0; m_ < 4; ++m_) _Pragma("unroll") for (int n_ = 0; n_ < 4; ++n_) a[m_][n_] = (f32x4){0.f, 0.f, 0.f, 0.f};
#define EPI_VARS const int tid = get_tid(), lane = tid & 63, wid = tid >> 6, wr = wid >> 1, wc = wid & 1, fr = lane & 15, fq = lane >> 4; (void)wr; (void)wc; (void)fr; (void)fq;
#define EPI_ROW_BEGIN(m0) _Pragma("unroll") for (int m = 0; m < 4; ++m) _Pragma("unroll") for (int j = 0; j < 4; ++j) { const int row = (m0) + wr * 64 + m * 16 + fq * 4 + j; (void)row;
#define EPI_COL_BEGIN(n0) _Pragma("unroll") for (int n = 0; n < 4; ++n) { const int col = (n0) + wc * 64 + n * 16 + fr; const float val = acc[m][n][j]; (void)col; (void)val;
#define EPI_COL_END }
#define EPI_ROW_END }
#define EPI_BEGIN(m0, n0) EPI_ROW_BEGIN(m0) EPI_COL_BEGIN(n0)
#define EPI_END } }

struct Job { const float* src; int K, N; int dst; int mode; };
__device__ __forceinline__ Job get_job(const P& p, int l, int j) {
  Job r; r.mode = 0;
  switch (j) {
    case 0: r.src = p.in[8] + (size_t)(l * 2 + 0) * 1024 * 2816; r.K = 1024; r.N = 2816; r.dst = W_GU0; r.mode = 1; break;
    case 1: r.src = p.in[9] + (size_t)(l * 2 + 0) * 1024 * 2816; r.K = 1024; r.N = 2816; r.dst = W_GU0; r.mode = 2; break;
    case 2: r.src = p.in[10] + (size_t)(l * 2 + 0) * 2816 * 1024; r.K = 2816; r.N = 1024; r.dst = W_D0; break;
    case 3: r.src = p.in[8] + (size_t)(l * 2 + 1) * 1024 * 2816; r.K = 1024; r.N = 2816; r.dst = W_GU1; r.mode = 1; break;
    case 4: r.src = p.in[9] + (size_t)(l * 2 + 1) * 1024 * 2816; r.K = 1024; r.N = 2816; r.dst = W_GU1; r.mode = 2; break;
    case 5: r.src = p.in[10] + (size_t)(l * 2 + 1) * 2816 * 1024; r.K = 2816; r.N = 1024; r.dst = W_D1; break;
    case 6: r.src = p.in[11] + (size_t)l * 1024 * 6288; r.K = 1024; r.N = 6288; r.dst = W_IN; break;
    case 7: r.src = p.in[14] + (size_t)(l * 2 + 0) * 64 * 384; r.K = 64; r.N = 384; r.dst = W_WUP0; break;
    case 8: r.src = p.in[14] + (size_t)(l * 2 + 1) * 64 * 384; r.K = 64; r.N = 384; r.dst = W_WUP1; break;
    case 9: r.src = p.in[16] + (size_t)(l * 2 + 0) * 64 * 384; r.K = 64; r.N = 384; r.dst = W_AUP0; break;
    case 10: r.src = p.in[16] + (size_t)(l * 2 + 1) * 64 * 384; r.K = 64; r.N = 384; r.dst = W_AUP1; break;
    case 11: r.src = p.in[17] + (size_t)l * 128 * 384; r.K = 128; r.N = 384; r.dst = W_GUP; break;
    case 12: r.src = p.in[31] + (size_t)l * 256 * 256; r.K = 256; r.N = 256; r.dst = W_GLU; break;
    case 13: r.src = p.in[35] + (size_t)l * 384 * 1024; r.K = 384; r.N = 1024; r.dst = W_UPRW; break;
    case 14: r.src = p.in[36] + (size_t)l * 256 * 1024; r.K = 256; r.N = 1024; r.dst = W_UPS5; break;
    case 15: r.src = p.in[37] + (size_t)l * 384 * 1024; r.K = 384; r.N = 1024; r.dst = W_UPML; break;
    default: r.src = p.in[39] + (size_t)l * 1024 * 1024; r.K = 1024; r.N = 1024; r.dst = W_OUT; break;
  }
  return r;
}
#define NJOBS 17
__device__ void mod_task(const P& p, int t, char* lds) {
  float* sc = (float*)lds;
  float* red = sc + 5 * 1024;
  const int tid = get_tid();
  for (int i = tid; i < 5 * 1024; i += NTHR) {
    int v = i >> 10, k = i & 1023;
    float c = v < 4 ? p.in[1][v * 1024 + k] : p.in[3][k];
    sc[i] = siluf_(c);
  }
  __syncthreads();
  const int c0 = t * 64; const int l = c0 / 9216; const int j0 = c0 % 9216;
  const int col = tid & 63, part = tid >> 6;
  const float* w = p.in[4] + ((size_t)l * 1024 + part * 256) * 9216 + j0 + col;
  float a0 = 0, a1 = 0, a2 = 0, a3 = 0, a4 = 0;
  const float* s = sc + part * 256;
#pragma unroll 8
  for (int i = 0; i < 256; ++i) {
    float wv = w[(size_t)i * 9216];
    a0 += s[i] * wv; a1 += s[1024 + i] * wv; a2 += s[2048 + i] * wv; a3 += s[3072 + i] * wv; a4 += s[4096 + i] * wv;
  }
  red[(part * 5 + 0) * 64 + col] = a0; red[(part * 5 + 1) * 64 + col] = a1; red[(part * 5 + 2) * 64 + col] = a2;
  red[(part * 5 + 3) * 64 + col] = a3; red[(part * 5 + 4) * 64 + col] = a4;
  __syncthreads();
  for (int i = tid; i < 320; i += NTHR) {
    int v = i >> 6, c = i & 63;
    float sum = red[(0 * 5 + v) * 64 + c] + red[(1 * 5 + v) * 64 + c] + red[(2 * 5 + v) * 64 + c] + red[(3 * 5 + v) * 64 + c];
    p.mod[(size_t)(l * 5 + v) * 9216 + j0 + c] = sum + p.in[5][(size_t)l * 9216 + j0 + c];
  }
  __syncthreads();
}
__device__ __forceinline__ void ph_convert(const P& p, int l, bool with_mod, char* lds) {
  const int tid = get_tid();
  int ntiles[NJOBS]; int total = 0;
#pragma unroll
  for (int j = 0; j < NJOBS; ++j) { Job jb = get_job(p, l, j); ntiles[j] = (jb.K >> 6) * ((jb.N + 63) >> 6); total += ntiles[j]; }
  const int nmod = with_mod ? 288 : 0;
  float* tile = (float*)lds;
  for (int t = blockIdx.x; t < total + nmod; t += gridDim.x) {
    if (t < nmod) { mod_task(p, t, lds); continue; }
    int tt = t - nmod; int j = 0;
#pragma unroll
    for (int q = 0; q < NJOBS; ++q) { if (j == q && tt >= ntiles[q]) { tt -= ntiles[q]; j = q + 1; } }
    Job jb = get_job(p, l, j);
    const int nkt = jb.K >> 6;
    const int k0 = (tt % nkt) * 64, n0 = (tt / nkt) * 64;
    {
      const int c = tid & 63, r0 = tid >> 6;
      const bool ok = (n0 + c) < jb.N;
#pragma unroll
      for (int i = 0; i < 16; ++i) { int r = r0 + i * 4; tile[r * 65 + c] = ok ? jb.src[(size_t)(k0 + r) * jb.N + n0 + c] : 0.f; }
    }
    __syncthreads();
    {
      const int nn = tid >> 2, q = tid & 3; const int n = n0 + nn;
      if (n < jb.N) {
        int drow = n;
        if (jb.mode == 1) drow = (n >> 5) * 64 + (n & 31);
        else if (jb.mode == 2) drow = (n >> 5) * 64 + 32 + (n & 31);
        bf16_t* d = p.W + jb.dst + (size_t)drow * jb.K + k0 + q * 16;
        unsigned pk[8];
#pragma unroll
        for (int i = 0; i < 8; ++i) { unsigned lo = f2bf(tile[(q * 16 + 2 * i) * 65 + nn]); unsigned hi = f2bf(tile[(q * 16 + 2 * i + 1) * 65 + nn]); pk[i] = lo | (hi << 16); }
        *(uint4*)d = make_uint4(pk[0], pk[1], pk[2], pk[3]);
        *(uint4*)(d + 8) = make_uint4(pk[4], pk[5], pk[6], pk[7]);
      }
    }
    __syncthreads();
  }
}

__device__ __forceinline__ void ph_rows(const P& p, int mode, int l, int ln_idx, int Mrows, bool writeU, int ul, int ks) {
  const int lane = get_tid() & 63, wid = get_tid() >> 6;
  const int nw = gridDim.x * 4;
  const float* g = p.in[6] + (size_t)(l * 3 + ln_idx) * 1024;
  const float* b = p.in[7] + (size_t)(l * 3 + ln_idx) * 1024;
  for (int m = blockIdx.x * 4 + wid; m < Mrows; m += nw) {
    float* s = srow(p, m);
    const float* src = s;
    if (mode == 0) src = m < M_LAT ? p.in[0] + (size_t)m * 1024 : p.in[2] + (size_t)(m - M_LAT) * 1024;
    float4 v[4];
#pragma unroll
    for (int i = 0; i < 4; ++i) v[i] = *(const float4*)(src + lane * 4 + i * 256);
    if (mode == 1) {
      float sum = 0;
#pragma unroll
      for (int i = 0; i < 4; ++i) sum += v[i].x + v[i].y + v[i].z + v[i].w;
      sum = wavesum(sum);
      const float mean = sum * (1.f / 1024.f);
      float sq = 0;
#pragma unroll
      for (int i = 0; i < 4; ++i) { v[i].x -= mean; v[i].y -= mean; v[i].z -= mean; v[i].w -= mean; sq += v[i].x * v[i].x + v[i].y * v[i].y + v[i].z * v[i].z + v[i].w * v[i].w; }
      sq = wavesum(sq);
      const float rstd = rsqrtf(sq * (1.f / 1024.f) + 1e-5f);
#pragma unroll
      for (int i = 0; i < 4; ++i) {
        float4 gg = *(const float4*)(g + lane * 4 + i * 256), bb = *(const float4*)(b + lane * 4 + i * 256);
        v[i].x = v[i].x * rstd * gg.x + bb.x; v[i].y = v[i].y * rstd * gg.y + bb.y; v[i].z = v[i].z * rstd * gg.z + bb.z; v[i].w = v[i].w * rstd * gg.w + bb.w;
      }
    }
#pragma unroll
    for (int i = 0; i < 4; ++i) *(float4*)(s + lane * 4 + i * 256) = v[i];
    if (writeU) {
      const float* sh = modp(p, ul, m, ks); const float* scl = modp(p, ul, m, ks + 1);
#pragma unroll
      for (int i = 0; i < 4; ++i) {
        float4 a = *(const float4*)(sh + lane * 4 + i * 256), c = *(const float4*)(scl + lane * 4 + i * 256);
        unsigned lo = f2bf(v[i].x * (1.f + c.x) + a.x) | ((unsigned)f2bf(v[i].y * (1.f + c.y) + a.y) << 16);
        unsigned hi = f2bf(v[i].z * (1.f + c.z) + a.z) | ((unsigned)f2bf(v[i].w * (1.f + c.w) + a.w) << 16);
        *(uint2*)(p.U + (size_t)m * 1024 + lane * 4 + i * 256) = make_uint2(lo, hi);
      }
    }
  }
}


#define STREAM_BEGIN(Mt_, Nt_, SN_, APTR, BPTR, LDA_, LDB_, K_) { \
    u32x4 pr_a[4], pr_b[4]; bool first_ = true; int tm, tn; bool have_ = tile_map(0, Mt_, Nt_, SN_, tm, tn); \
    for (int it = 0; have_; ++it) { int tm2, tn2; const bool have2_ = tile_map(it + 1, Mt_, Nt_, SN_, tm2, tn2); \
      const int tmn = have2_ ? tm2 : tm, tnn = have2_ ? tn2 : tn; \
      f32x4 acc[4][4]; ZERO_ACC(acc) \
      { const bf16_t* a_cur = APTR; const bf16_t* b_cur = BPTR; \
        const bf16_t* a_nxt; const bf16_t* b_nxt; { const int tm = tmn, tn = tnn; (void)tm; (void)tn; a_nxt = APTR; b_nxt = BPTR; } \
        gemm_stream(a_cur, LDA_, b_cur, LDB_, K_, a_nxt, b_nxt, first_, acc, lds, pr_a, pr_b); first_ = false; }
#define STREAM_END tm = tm2; tn = tn2; have_ = have2_; } }
__device__ __forceinline__ void ph_ffn_up(const P& p, int s, int Mt, char* lds) {
  EPI_VARS
  bf16_t* HM = (bf16_t*)p.R;
  const bf16_t* Wt = p.W + (s ? W_GU1 : W_GU0);
  STREAM_BEGIN(Mt, 44, 4, (p.U + (size_t)(tm * 128) * 1024), (Wt + (size_t)(tn * 128) * 1024), 1024, 1024, 1024)
    const int m0 = tm * 128, n0 = tn * 128;
    const int hb = ((n0 + wc * 64) >> 6) * 32;
#pragma unroll
    for (int m = 0; m < 4; ++m)
#pragma unroll
      for (int n = 0; n < 2; ++n)
#pragma unroll
        for (int j = 0; j < 4; ++j) {
          const int row = m0 + wr * 64 + m * 16 + fq * 4 + j; const int hc = hb + n * 16 + fr;
          HM[(size_t)row * 2816 + hc] = f2bf(siluf_(acc[m][n][j]) * acc[m][n + 2][j]);
        }
  STREAM_END
}
__device__ __forceinline__ void ph_ffn_down(const P& p, int l, int s, int Mt, char* lds) {
  EPI_VARS
  const bf16_t* HM = (const bf16_t*)p.R;
  const bf16_t* Wt = p.W + (s ? W_D1 : W_D0);
  const int gk = s ? 8 : 2;
  STREAM_BEGIN(Mt, 8, 8, (HM + (size_t)(tm * 128) * 2816), (Wt + (size_t)(tn * 128) * 2816), 2816, 2816, 2816)
    const int m0 = tm * 128, n0 = tn * 128;
    EPI_ROW_BEGIN(m0)
      float* sp = srow(p, row) + n0 + wc * 64 + fr; const float* gp = modp(p, l, row, gk) + n0 + wc * 64 + fr;
#pragma unroll
      for (int n = 0; n < 4; ++n) sp[n * 16] = ALPHA * sp[n * 16] + 0.5f * gp[n * 16] * acc[m][n][j];
    EPI_ROW_END
  STREAM_END
}

#define RW_ZRW(p) ((hf*)(p).R)
#define RW_RKV(p) (RW_ZRW(p) + (size_t)M_ALL * 1152)
#define RW_LA(p) ((bf16_t*)(RW_RKV(p) + (size_t)M_ALL * 1152))
#define RW_KK(p) ((hf*)(RW_LA(p) + (size_t)M_ALL * 256))
#define RW_KD(p) (RW_KK(p) + (size_t)M_ALL * 384)
#define RW_KA(p) (RW_KD(p) + (size_t)2 * M_ALL * 384)
#define RW_YR(p) (RW_KA(p) + (size_t)2 * M_ALL * 384)

#define S5_ZH(p) ((hf*)RW_LA(p))
#define S5_YG(p) ((p).W + W_GU0)
#define S5_E(p) ((float2*)((p).R + (size_t)M_ALL * 9728))
#define S5_X(p) S5_E(p)

#define ML_Z(p) ((hf*)(p).R)
#define ML_GL(p) ((float*)(ML_Z(p) + (size_t)M_ALL * 1536))
#define ML_QK(p) ((hf*)(ML_GL(p) + (size_t)M_ALL * 16))
#define ML_DC(p) ((float*)(ML_QK(p) + (size_t)M_ALL * 768))
#define ML_DN(p) (ML_DC(p) + (size_t)4224 * 9216)
#define ML_SC(p) (ML_DN(p) + (size_t)4224 * 96)
#define ML_MP(p) (ML_SC(p) + (size_t)4224 * 2)

__device__ __forceinline__ void ph_z_rw(const P& p, char* lds) {
  EPI_VARS
  hf* ZRW = RW_ZRW(p); bf16_t* LA = RW_LA(p);
  const int Mt = 264;
  STREAM_BEGIN(Mt, 11, 11, (p.U + (size_t)(tm * 128) * 1024), (p.W + W_IN + (size_t)(tn < 9 ? tn * 128 : 2960 + (tn - 9) * 128) * 1024), 1024, 1024, 1024)
    const int m0 = tm * 128;
    if (tn < 9) {
      EPI_BEGIN(m0, tn * 128)
        ZRW[(size_t)row * 1152 + col] = (hf)val;
      EPI_END
    } else {
      EPI_BEGIN(m0, (tn - 9) * 128)
        float o = col < 64 ? tanhf_(val) : (col < 128 ? val : sigmoidf_(val));
        LA[(size_t)row * 256 + col] = f2bf(o);
      EPI_END
    }
  STREAM_END
}
__device__ __forceinline__ void ph_z_s5(const P& p, char* lds, int vb, int nvb) {
  EPI_VARS
  hf* Z = S5_ZH(p);
  const int Mt = 264;
  for (int it = 0;; ++it) {
    int tm, tn; if (!tile_map_v(vb, nvb, it, Mt, 2, 2, tm, tn)) break; const int m0 = tm * 128;
    f32x4 acc[4][4]; ZERO_ACC(acc)
    gemm_main(p.U + (size_t)m0 * 1024, 1024, p.W + W_IN + (size_t)(2704 + tn * 128) * 1024, 1024, 1024, acc, lds);
    EPI_BEGIN(m0, tn * 128)
      Z[(size_t)row * 256 + col] = (hf)val;
    EPI_END
  }
}
__device__ __forceinline__ void ph_z_ml(const P& p, char* lds) {
  EPI_VARS
  hf* Z = ML_Z(p); float* GL = ML_GL(p);
  const int Mt = 264;
  STREAM_BEGIN(Mt, 13, 13, (p.U + (size_t)(tm * 128) * 1024), (p.W + W_IN + (size_t)(1152 + tn * 128) * 1024), 1024, 1024, 1024)
    const int m0 = tm * 128;
    if (tn < 12) {
      EPI_BEGIN(m0, tn * 128)
        Z[(size_t)row * 1536 + col] = (hf)val;
      EPI_END
    } else {
      EPI_BEGIN(m0, 0)
        if (col < 16) GL[(size_t)row * 16 + col] = val;
      EPI_END
    }
  STREAM_END
}

template <int which>
__device__ __forceinline__ void ph_conv(const P& p, int l) {
  constexpr int nch = which == 0 ? 144 : 96;
  constexpr int ldin = which == 0 ? 1152 : 1536;
  constexpr int cbase = which == 0 ? 0 : 1152;
  const hf* Zin = which == 0 ? RW_ZRW(p) : ML_Z(p);
  const float* cw = p.in[12] + (size_t)l * 9 * 1920;
  const unsigned total = (unsigned)(M_ALL / 4) * nch;
  for (unsigned idx = blockIdx.x * NTHR + get_tid(); idx < (total + 63u) / 64u * 64u; idx += gridDim.x * NTHR) {
    const bool act = idx < total;
    const int tg = act ? (int)(idx / (unsigned)nch) : 0; const int ch = act ? (int)(idx % (unsigned)nch) : 0; const int c0 = ch * 8;
    const int m0 = tg * 4;
    float o[4][8];
#pragma unroll
    for (int t = 0; t < 4; ++t)
#pragma unroll
      for (int i = 0; i < 8; ++i) o[t][i] = 0.f;
    const bool lat = m0 < M_LAT;
    const int bb = m0 >> 13, tt = lat ? (m0 & 8191) : ((m0 - M_LAT) & 255);
    const int gr = tt >> 6, gc0 = lat ? (tt & 63) : tt;
    const int ncol = lat ? 64 : 256;
#pragma unroll
    for (int dr = -1; dr <= 1; ++dr) {
      const int rr = gr + dr;
      const bool rowok = lat ? (rr >= 0 && rr < 128) : (dr == 0);
      if (!rowok) continue;
      const float* w = cw + ((dr + 1) * 3) * 1920 + cbase + c0;
      float wv[3][8];
#pragma unroll
      for (int k = 0; k < 3; ++k) { const float4 a = *(const float4*)(w + k * 1920), b = *(const float4*)(w + k * 1920 + 4);
        wv[k][0] = a.x; wv[k][1] = a.y; wv[k][2] = a.z; wv[k][3] = a.w; wv[k][4] = b.x; wv[k][5] = b.y; wv[k][6] = b.z; wv[k][7] = b.w; }
      const int mrow = lat ? ((bb << 13) + rr * 64) : (m0 - gc0);
#pragma unroll
      for (int cc = 0; cc < 6; ++cc) {
        const int col = gc0 - 1 + cc;
        if (col < 0 || col >= ncol) continue;
        const hf8 z = *(const hf8*)(Zin + (size_t)(mrow + col) * ldin + c0);
        float zf[8];
#pragma unroll
        for (int i = 0; i < 8; ++i) zf[i] = (float)z[i];
#pragma unroll
        for (int t = 0; t < 4; ++t) {
          const int k = cc - t;
          if (k >= 0 && k < 3) {
#pragma unroll
            for (int i = 0; i < 8; ++i) o[t][i] += zf[i] * wv[k][i];
          }
        }
      }
    }
#pragma unroll
    for (int t = 0; t < 4; ++t) {
      const int m = m0 + t;
      if (which == 0) {
        const bool isk = act && (c0 >= 384) && (c0 < 768);
        float kkv[8]; float ss = 0.f;
        if (isk) {
          const float* kkw = p.in[18] + (size_t)l * 384 + (c0 - 384);
#pragma unroll
          for (int i = 0; i < 8; ++i) { kkv[i] = o[t][i] * kkw[i]; ss += kkv[i] * kkv[i]; }
        } else {
#pragma unroll
          for (int i = 0; i < 8; ++i) kkv[i] = 0.f;
        }
        ss += __shfl_xor(ss, 1); ss += __shfl_xor(ss, 2); ss += __shfl_xor(ss, 4);
        if (act) {
          hf8 ov;
#pragma unroll
          for (int i = 0; i < 8; ++i) ov[i] = (hf)o[t][i];
          *(hf8*)(RW_RKV(p) + (size_t)m * 1152 + c0) = ov;
          if (isk) {
            const float rn = rsqrtf(fmaxf(ss, 1e-24f));
            hf8 kv;
#pragma unroll
            for (int i = 0; i < 8; ++i) kv[i] = (hf)(kkv[i] * rn);
            *(hf8*)(RW_KK(p) + (size_t)m * 384 + (c0 - 384)) = kv;
          }
        }
      } else if (act) {
        const float sc = c0 >= 384 ? 0.10206207261596575f : 1.f;
        hf8 ov;
#pragma unroll
        for (int i = 0; i < 8; ++i) ov[i] = (hf)(siluf_(o[t][i]) * sc);
        *(hf8*)(ML_QK(p) + (size_t)m * 768 + c0) = ov;
      }
    }
  }
}

__device__ __forceinline__ void ph_lora(const P& p, int l, char* lds) {
  EPI_VARS
  hf* ZRW = RW_ZRW(p); const hf* RKV = RW_RKV(p); const bf16_t* LA = RW_LA(p); const hf* KK = RW_KK(p);
  hf* KD = RW_KD(p); hf* KA = RW_KA(p);
  const int Mt = 264;
  for (int it = 0;; ++it) {
    int tm, q; if (!tile_map(it, Mt, 15, 15, tm, q)) break; const int job = q / 3, tn = q % 3; const int m0 = tm * 128, n0 = tn * 128;
    f32x4 acc[4][4]; ZERO_ACC(acc)
    if (job < 2) {
      const int d = job;
      gemm_small_t<1>(LA + (size_t)m0 * 256, 256, p.W + (d ? W_WUP1 : W_WUP0) + (size_t)n0 * 64, 64, acc, lds);
      const float* w0 = p.in[13] + (size_t)(l * 2 + d) * 384;
#pragma unroll
      for (int m = 0; m < 4; ++m) {
        const int row = m0 + wr * 64 + m * 16 + fr;
#pragma unroll
        for (int n = 0; n < 4; ++n) {
          const int cb = n0 + wc * 64 + n * 16 + fq * 4;
          const float4 wv = *(const float4*)(w0 + cb);
          const float wa[4] = {wv.x, wv.y, wv.z, wv.w};
          hf4 o;
#pragma unroll
          for (int j = 0; j < 4; ++j) { const float e = sigmoidf_(wa[j] + acc[m][n][j]) * 0.6065306597126334f; o[j] = (hf)(1.f - __expf(-e)); }
          *(hf4*)(ZRW + (size_t)row * 1152 + d * 384 + cb) = o;
        }
      }
    } else if (job < 4) {
      const int d = job - 2;
      gemm_small_t<1>(LA + (size_t)m0 * 256 + 64, 256, p.W + (d ? W_AUP1 : W_AUP0) + (size_t)n0 * 64, 64, acc, lds);
      const float* a0 = p.in[15] + (size_t)(l * 2 + d) * 384; const float* kaw = p.in[19] + (size_t)l * 384;
#pragma unroll
      for (int m = 0; m < 4; ++m) {
        const int row = m0 + wr * 64 + m * 16 + fr;
#pragma unroll
        for (int n = 0; n < 4; ++n) {
          const int cb = n0 + wc * 64 + n * 16 + fq * 4;
          const float4 av = *(const float4*)(a0 + cb), kv = *(const float4*)(kaw + cb);
          const float aa[4] = {av.x, av.y, av.z, av.w}, ka_[4] = {kv.x, kv.y, kv.z, kv.w};
          const hf4 k4 = *(const hf4*)(RKV + (size_t)row * 1152 + 384 + cb), kk4 = *(const hf4*)(KK + (size_t)row * 384 + cb);
          hf4 okd, oka;
#pragma unroll
          for (int j = 0; j < 4; ++j) { const float a = sigmoidf_(aa[j] + acc[m][n][j]); okd[j] = (hf)((float)k4[j] * (1.f + (a - 1.f) * ka_[j])); oka[j] = (hf)((float)kk4[j] * a); }
          *(hf4*)(KD + ((size_t)d * M_ALL + row) * 384 + cb) = okd;
          *(hf4*)(KA + ((size_t)d * M_ALL + row) * 384 + cb) = oka;
        }
      }
    } else {
      gemm_small_t<2>(LA + (size_t)m0 * 256 + 128, 256, p.W + W_GUP + (size_t)n0 * 128, 128, acc, lds);
#pragma unroll
      for (int m = 0; m < 4; ++m) {
        const int row = m0 + wr * 64 + m * 16 + fr;
#pragma unroll
        for (int n = 0; n < 4; ++n) {
          const int cb = n0 + wc * 64 + n * 16 + fq * 4;
          hf4 o; o[0] = (hf)acc[m][n][0]; o[1] = (hf)acc[m][n][1]; o[2] = (hf)acc[m][n][2]; o[3] = (hf)acc[m][n][3];
          *(hf4*)(ZRW + (size_t)row * 1152 + 768 + cb) = o;
        }
      }
    }
  }
}

typedef float f32x2 __attribute__((ext_vector_type(2)));
#define RW_CH 16
#define RW_BUF 21504
__device__ __forceinline__ void rw_cvt_store(char* dst, uint4 q) {
  const hf8 h = __builtin_bit_cast(hf8, q);
  f32x4 a, b;
  a[0] = (float)h[0]; a[1] = (float)h[1]; a[2] = (float)h[2]; a[3] = (float)h[3];
  b[0] = (float)h[4]; b[1] = (float)h[5]; b[2] = (float)h[6]; b[3] = (float)h[7];
  *(f32x4*)dst = a; *(f32x4*)(dst + 16) = b;
}
__device__ __forceinline__ void ph_rwscan(const P& p, char* lds) {
  const hf* ZRW = RW_ZRW(p); hf* RKV = RW_RKV(p); const hf* KK = RW_KK(p);
  const int tid = get_tid(), lane = tid & 63, wid = tid >> 6;
  char* pbuf = lds + 3 * RW_BUF + wid * 2048;
  char* ybuf = lds + 3 * RW_BUF + 8192;
  for (int t = blockIdx.x; t < 192; t += gridDim.x) {
    const int rqq = t & 3, h = (t >> 2) % 6, b = (t / 24) & 3, d = t / 96;
    const int rsub = lane >> 4, g = lane & 15; const int rl = wid * 4 + rsub;
    const int sgn = d ? -1 : 1;
    const bool grpA = tid < 128; const int t2 = tid & 127;
    const int sstep = t2 >> 3, sseg = t2 & 7;
    const hf* g0 = grpA ? (RKV + h * 64 + sseg * 8) : (RW_KD(p) + (size_t)d * M_ALL * 384 + h * 64 + sseg * 8);
    const size_t ld0 = grpA ? 1152 : 384;
    const hf* g1 = grpA ? (KK + h * 64 + sseg * 8) : (RW_KA(p) + (size_t)d * M_ALL * 384 + h * 64 + sseg * 8);
    const hf* g2 = grpA ? (ZRW + d * 384 + h * 64 + sseg * 8) : (RKV + 768 + h * 64 + rqq * 16 + (t2 & 1) * 8);
    const int s2 = grpA ? sstep : (t2 >> 1);
    const bool has2 = grpA || t2 < 32;
    const int o0 = (grpA ? 0 : 12288) + sstep * 256 + sseg * 32;
    const int o1 = (grpA ? 4096 : 16384) + sstep * 256 + sseg * 32;
    const int o2 = grpA ? (8192 + sstep * 256 + sseg * 32) : (20480 + (t2 >> 1) * 64 + (t2 & 1) * 32);
    hf* g_y = d == 0 ? (RKV + 384 + h * 64 + rqq * 16 + (tid & 1) * 8) : (RW_YR(p) + h * 64 + rqq * 16 + (tid & 1) * 8);
    const int ldy = d == 0 ? 1152 : 384;
    uint4 q0, q1, q2;
#define RW_M0(pp) ((pp) < 256 ? (M_LAT + b * 256 + (d ? 255 - (pp) : (pp))) : (b * 8192 + (d ? 8447 - (pp) : (pp) - 256)))
#define RW_GLOAD(c) { const int mb_ = RW_M0((c) * RW_CH); const size_t mm = (size_t)(mb_ + sgn * sstep); \
      q0 = *(const uint4*)(g0 + mm * ld0); q1 = *(const uint4*)(g1 + mm * 384); \
      if (has2) { const size_t m2 = (size_t)(mb_ + sgn * s2); q2 = *(const uint4*)(g2 + m2 * 1152); } }
#define RW_SSTORE(c) { char* bb_ = lds + ((c) % 3) * RW_BUF; rw_cvt_store(bb_ + o0, q0); rw_cvt_store(bb_ + o1, q1); if (has2) rw_cvt_store(bb_ + o2, q2); }
    f32x2 S01 = (f32x2){0.f, 0.f}, S23 = (f32x2){0.f, 0.f};
    RW_GLOAD(0) RW_SSTORE(0)
    RW_GLOAD(1) RW_SSTORE(1)
    __syncthreads();
    const int NCH = 8448 / RW_CH;
    for (int c = 0; c < NCH; ++c) {
      if (c + 2 < NCH) RW_GLOAD(c + 2)
      if (c > 0 && tid < 32) {
        const int mb_ = RW_M0((c - 1) * RW_CH); const size_t mv = (size_t)(mb_ + sgn * (tid >> 1));
        *(uint4*)(g_y + mv * ldy) = *(const uint4*)(ybuf + ((c - 1) & 1) * 512 + tid * 16);
      }
      const char* cb = lds + (c % 3) * RW_BUF + g * 16;
      const char* vb = lds + (c % 3) * RW_BUF + 20480 + rl * 4;
      f32x4 R4[RW_CH], K4[RW_CH], D4[RW_CH], KD4[RW_CH], KA4[RW_CH]; float VV[RW_CH];
#define RW_LDS(s_) { R4[s_] = *(const f32x4*)(cb + (s_) * 256); K4[s_] = *(const f32x4*)(cb + 4096 + (s_) * 256); D4[s_] = *(const f32x4*)(cb + 8192 + (s_) * 256); \
        KD4[s_] = *(const f32x4*)(cb + 12288 + (s_) * 256); KA4[s_] = *(const f32x4*)(cb + 16384 + (s_) * 256); VV[s_] = *(const float*)(vb + (s_) * 64); }
      RW_LDS(0) RW_LDS(1) RW_LDS(2)
#pragma unroll
      for (int s = 0; s < RW_CH; ++s) {
        if (s + 3 < RW_CH) RW_LDS(s + 3)
        const f32x4 r4 = R4[s], k4 = K4[s], d4 = D4[s], kd4 = KD4[s], ka4 = KA4[s]; const float vv = VV[s];
        const f32x2 k01 = {k4[0], k4[1]}, k23 = {k4[2], k4[3]}, d01 = {d4[0], d4[1]}, d23 = {d4[2], d4[3]};
        const f32x2 kd01 = {kd4[0], kd4[1]}, kd23 = {kd4[2], kd4[3]}, ka01 = {ka4[0], ka4[1]}, ka23 = {ka4[2], ka4[3]};
        const f32x2 r01 = {r4[0], r4[1]}, r23 = {r4[2], r4[3]};
        const f32x2 sa2 = __builtin_elementwise_fma(S23, k23, S01 * k01);
        float sa = sa2[0] + sa2[1];
        sa = rowsum16(sa);
        const f32x2 vv2 = {vv, vv}; const f32x2 nsa = {-sa, -sa};
        f32x2 T01 = __builtin_elementwise_fma(-S01, d01, S01), T23 = __builtin_elementwise_fma(-S23, d23, S23);
        T01 = __builtin_elementwise_fma(vv2, kd01, T01); T23 = __builtin_elementwise_fma(vv2, kd23, T23);
        S01 = __builtin_elementwise_fma(nsa, ka01, T01); S23 = __builtin_elementwise_fma(nsa, ka23, T23);
        const f32x2 y2 = __builtin_elementwise_fma(S23, r23, S01 * r01);
        *(float*)(pbuf + (((s & 7) * 4 + rsub) * 16 + g) * 4) = y2[0] + y2[1];
        if ((s & 7) == 7) {
          if (lane < 32) {
            const char* pr = pbuf + lane * 64;
            const f32x4 a0 = *(const f32x4*)(pr), a1 = *(const f32x4*)(pr + 16), a2 = *(const f32x4*)(pr + 32), a3 = *(const f32x4*)(pr + 48);
            const f32x4 sm = (a0 + a1) + (a2 + a3);
            const float y = (sm[0] + sm[1]) + (sm[2] + sm[3]);
            *(hf*)(ybuf + (c & 1) * 512 + (((s >> 3) * 8 + (lane >> 2)) * 16 + wid * 4 + (lane & 3)) * 2) = (hf)y;
          }
        }
      }
      if (c + 2 < NCH) RW_SSTORE(c + 2)
      __syncthreads();
    }
    if (tid < 32) {
      const int mb_ = RW_M0((NCH - 1) * RW_CH); const size_t mv = (size_t)(mb_ + sgn * (tid >> 1));
      *(uint4*)(g_y + mv * ldy) = *(const uint4*)(ybuf + ((NCH - 1) & 1) * 512 + tid * 16);
    }
    __syncthreads();
  }
}

__device__ __forceinline__ void ph_rwpost(const P& p, int l) {
  const hf* ZRW = RW_ZRW(p); const hf* RKV = RW_RKV(p); const hf* YR = RW_YR(p);
  const int lane = get_tid() & 63, wid = get_tid() >> 6;
  const int nw = gridDim.x * 4;
  for (int t = blockIdx.x * 4 + wid; t < M_ALL * 6; t += nw) {
    const int m = t / 6, h = t % 6; const int c = h * 64 + lane;
    const float ys = (float)RKV[(size_t)m * 1152 + 384 + c] + (float)YR[(size_t)m * 384 + c];
    const float mean = wavesum(ys) * (1.f / 64.f);
    const float xc = ys - mean;
    const float var = wavesum(xc * xc) * (1.f / 64.f);
    float y = xc * rsqrtf(var + 64e-5f) * p.in[21][(size_t)l * 384 + c] + p.in[22][(size_t)l * 384 + c];
    const float r = (float)RKV[(size_t)m * 1152 + c], v = (float)RKV[(size_t)m * 1152 + 768 + c];
    const float rk = p.in[20][(size_t)l * 384 + c];
    const float kd0 = (float)RW_KD(p)[(size_t)m * 384 + c], kd1 = (float)RW_KD(p)[((size_t)M_ALL + m) * 384 + c];
    const float bs = wavesum(r * (kd0 + kd1) * rk);
    y = (y + bs * v) * (float)ZRW[(size_t)m * 1152 + 768 + c];
    p.Y[(size_t)m * 1024 + c] = f2bf(y);
  }
}

struct S5C { float ar, ai; float br[16], bi[16]; };
__device__ __forceinline__ void s5_consts(const P& p, int l, int d, int g, int n, S5C& c) {
  const int ig = (l * 2 + d) * 16 + g;
  const float lr = fminf(p.in[23][(size_t)ig * 64 + n], -1e-4f), li = p.in[24][(size_t)ig * 64 + n];
  const float dt = expf(p.in[25][ig]);
  const float mag = expf(lr * dt);
  c.ar = mag * cosf(li * dt); c.ai = mag * sinf(li * dt);
  const float nr = c.ar - 1.f, ni = c.ai; const float den = 1.f / (lr * lr + li * li);
  const float cr = (nr * lr + ni * li) * den, ci = (ni * lr - nr * li) * den;
  const float* bre = p.in[26] + ((size_t)ig * 64 + n) * 16; const float* bim = p.in[27] + ((size_t)ig * 64 + n) * 16;
#pragma unroll
  for (int h = 0; h < 16; ++h) { const float xr = bre[h], xi = bim[h]; c.br[h] = cr * xr - ci * xi; c.bi[h] = cr * xi + ci * xr; }
}
__device__ __forceinline__ int s5_m0(int b, int tc) { return tc < 128 ? b * 8192 + tc * 64 : M_LAT + b * 256 + (tc - 128) * 64; }
__device__ __forceinline__ int chain_pos(int d, int tc) { return d == 0 ? (tc < 128 ? tc + 4 : tc - 128) : (tc < 128 ? 131 - tc : 131 - tc); }
__device__ __forceinline__ void ph_s5_pass(const P& p, int l, int pass, char* lds, int vb, int nvb) {
  const int tid = get_tid(), lane = tid & 63, wid = tid >> 6, fr = lane & 15, fq = lane >> 4;
  float* ub = (float*)(lds + wid * 8448);
  char* xs = lds + wid * 8448 + 4096;
  const hf* Z = S5_ZH(p); float2* E = S5_E(p); const float2* X = S5_X(p); bf16_t* YG = S5_YG(p);
  const int nw = nvb * 4;
  for (int t = vb * 4 + wid; t < 4 * 132 * 16; t += nw) {
    const int g = t & 15, tc = (t >> 4) % 132, b = t / (16 * 132);
    const int m0 = s5_m0(b, tc);
#pragma unroll
    for (int i = 0; i < 4; ++i) { const int e = lane + i * 64; const int tok = e >> 2, q = e & 3;
      const hf4 zv = *(const hf4*)(Z + (size_t)(m0 + tok) * 256 + g * 16 + q * 4);
      *(float4*)(ub + tok * 16 + q * 4) = make_float4((float)zv[0], (float)zv[1], (float)zv[2], (float)zv[3]); }
    f32x4 yacc[4];
#pragma unroll
    for (int i = 0; i < 4; ++i) yacc[i] = (f32x4){0.f, 0.f, 0.f, 0.f};
    for (int d = 0; d < 2; ++d) {
      S5C c; s5_consts(p, l, d, g, lane, c);
      const int cp = chain_pos(d, tc);
      const size_t sidx = (((size_t)(d * 4 + b) * 132 + cp) * 16 + g) * 64 + lane;
      float xr = 0.f, xi = 0.f;
      hf8 cf[4];
      if (pass == 3) {
        float2 x0 = X[sidx]; xr = x0.x; xi = x0.y;
        const int ig = (l * 2 + d) * 16 + g;
#pragma unroll
        for (int ks = 0; ks < 4; ++ks) {
          const int c0 = ks * 32 + fq * 8;
          const float* src_ = (c0 < 64 ? p.in[28] : p.in[29]) + ((size_t)ig * 16 + fr) * 64 + (c0 & 63);
          const float sg = c0 < 64 ? 1.f : -1.f;
          const float4 v0 = *(const float4*)src_, v1 = *(const float4*)(src_ + 4);
          cf[ks][0] = (hf)(sg * v0.x); cf[ks][1] = (hf)(sg * v0.y); cf[ks][2] = (hf)(sg * v0.z); cf[ks][3] = (hf)(sg * v0.w);
          cf[ks][4] = (hf)(sg * v1.x); cf[ks][5] = (hf)(sg * v1.y); cf[ks][6] = (hf)(sg * v1.z); cf[ks][7] = (hf)(sg * v1.w);
        }
      }
#pragma unroll 1
      for (int jb = 0; jb < 4; ++jb) {
        const int tb = d ? 3 - jb : jb;
#pragma unroll 4
        for (int jj = 0; jj < 16; ++jj) {
          const int t16 = d ? 15 - jj : jj;
          const float* u = ub + (tb * 16 + t16) * 16;
          float br = 0.f, bi = 0.f;
#pragma unroll
          for (int h = 0; h < 16; ++h) { const float uv = u[h]; br += c.br[h] * uv; bi += c.bi[h] * uv; }
          const float nr = c.ar * xr - c.ai * xi + br, ni = c.ar * xi + c.ai * xr + bi;
          xr = nr; xi = ni;
          if (pass == 3) { *(hf*)(xs + t16 * 272 + lane * 2) = (hf)xr; *(hf*)(xs + t16 * 272 + 128 + lane * 2) = (hf)xi; }
        }
        if (pass == 3) {
          f32x4 acc = (f32x4){0.f, 0.f, 0.f, 0.f};
#pragma unroll
          for (int ks = 0; ks < 4; ++ks) {
            const hf8 af = *(const hf8*)(xs + fr * 272 + ks * 64 + fq * 16);
            acc = __builtin_amdgcn_mfma_f32_16x16x32_f16(af, cf[ks], acc, 0, 0, 0);
          }
#pragma unroll
          for (int i = 0; i < 4; ++i) if (i == tb) yacc[i] += acc;
        }
      }
      if (pass == 1) E[sidx] = make_float2(xr, xi);
    }
    if (pass == 3) {
      const float dsk = p.in[30][(size_t)l * 256 + g * 16 + fr];
#pragma unroll
      for (int i = 0; i < 4; ++i)
#pragma unroll
        for (int j = 0; j < 4; ++j) {
          const int tok = i * 16 + fq * 4 + j;
          float y = yacc[i][j] + dsk * ub[tok * 16 + fr];
          const float inner = 0.7978845608028654f * (y + 0.044715f * y * y * y);
          y = 0.5f * y * (1.f + tanhf_(inner));
          YG[(size_t)(m0 + tok) * 256 + g * 16 + fr] = f2bf(y);
        }
    }
  }
}
__device__ __forceinline__ void ph_s5_carry(const P& p, int l, int vb, int nvb) {
  float2* E = S5_E(p); float2* X = S5_X(p);
  for (int t = vb * NTHR + get_tid(); t < 8192; t += nvb * NTHR) {
    const int n = t & 63, g = (t >> 6) & 15, b = (t >> 10) & 3, d = t >> 12;
    const int ig = (l * 2 + d) * 16 + g;
    const float lr = fminf(p.in[23][(size_t)ig * 64 + n], -1e-4f), li = p.in[24][(size_t)ig * 64 + n];
    const float dt = expf(p.in[25][ig]);
    const float mag = expf(lr * dt * 64.f);
    float ar = expf(lr * dt) * cosf(li * dt), ai = expf(lr * dt) * sinf(li * dt);
#pragma unroll
    for (int i = 0; i < 6; ++i) { const float r2 = ar * ar - ai * ai, i2 = 2.f * ar * ai; ar = r2; ai = i2; }
    (void)mag;
    float xr = 0.f, xi = 0.f;
    const size_t base = (((size_t)(d * 4 + b) * 132) * 16 + g) * 64 + n;
    for (int cp0 = 0; cp0 < 132; cp0 += 12) {
      float2 ev[12];
#pragma unroll
      for (int u = 0; u < 12; ++u) ev[u] = E[base + (size_t)(cp0 + u) * 1024];
#pragma unroll
      for (int u = 0; u < 12; ++u) {
        X[base + (size_t)(cp0 + u) * 1024] = make_float2(xr, xi);
        const float nr = ar * xr - ai * xi + ev[u].x, ni = ar * xi + ai * xr + ev[u].y;
        xr = nr; xi = ni;
      }
    }
  }
}
__device__ __forceinline__ void ph_glu(const P& p, int l, char* lds, int vb, int nvb) {
  EPI_VARS
  const bf16_t* YG = S5_YG(p);
  const int Mt = 264;
  const float* gb = p.in[32] + (size_t)l * 256;
  for (int it = 0;; ++it) {
    int tm, tn; if (!tile_map_v(vb, nvb, it, Mt, 2, 2, tm, tn)) break; const int m0 = tm * 128, n0 = tn * 128;
    f32x4 acc[4][4]; ZERO_ACC(acc)
    gemm_main(YG + (size_t)m0 * 256, 256, p.W + W_GLU + (size_t)n0 * 256, 256, 256, acc, lds);
    EPI_BEGIN(m0, n0)
      const float y = bf2f(YG[(size_t)row * 256 + col]);
      p.Y[(size_t)row * 1024 + 384 + col] = f2bf(y * sigmoidf_(val + gb[col]));
    EPI_END
  }
}

__device__ __forceinline__ void sub_barrier(unsigned* cnt, unsigned target) {
  asm volatile("s_waitcnt vmcnt(0)" ::: "memory");
  __syncthreads();
  if (__builtin_amdgcn_workitem_id_x() == 0) {
    __builtin_amdgcn_fence(__ATOMIC_RELEASE, "agent");
    asm volatile("s_waitcnt vmcnt(0)" ::: "memory");
    __hip_atomic_fetch_add(cnt, 1u, __ATOMIC_RELAXED, __HIP_MEMORY_SCOPE_AGENT);
    unsigned sp = 0;
    while (__hip_atomic_load(cnt, __ATOMIC_RELAXED, __HIP_MEMORY_SCOPE_AGENT) < target) { __builtin_amdgcn_s_sleep(2); if (++sp > (1u << 22)) break; }
    __builtin_amdgcn_fence(__ATOMIC_ACQUIRE, "agent");
    asm volatile("s_waitcnt vmcnt(0)" ::: "memory");
  }
  __syncthreads();
}
__device__ __forceinline__ void ph_s5_stage(const P& p, int l, char* lds, int vb, int nvb) {
  unsigned* cnt = p.bar + 3584;
  const unsigned base = (unsigned)(l * 4) * (unsigned)nvb;
  ph_z_s5(p, lds, vb, nvb);            sub_barrier(cnt, base + 1u * nvb);
  ph_s5_pass(p, l, 1, lds, vb, nvb);   sub_barrier(cnt, base + 2u * nvb);
  ph_s5_carry(p, l, vb, nvb);          sub_barrier(cnt, base + 3u * nvb);
  ph_s5_pass(p, l, 3, lds, vb, nvb);   sub_barrier(cnt, base + 4u * nvb);
  ph_glu(p, l, lds, vb, nvb);
}

__device__ __forceinline__ float logsigf_(float x) { return fminf(x, 0.f) - log1pf(__expf(-fabsf(x))); }
__device__ __forceinline__ void ml_gates(const P& p, int l, int d, int h, int m0, int lane, float& bcum, float& ic) {
  const int tok = d ? 63 - lane : lane;
  const float* gl = ML_GL(p) + (size_t)(m0 + tok) * 16;
  const float* gb = p.in[33] + (size_t)(l * 2 + d) * 8;
  ic = gl[d * 8 + h] + gb[h];
  float f = logsigf_(gl[d * 8 + 4 + h] + gb[4 + h]);
#pragma unroll
  for (int o = 1; o < 64; o <<= 1) { float v = __shfl_up(f, o); if (lane >= o) f += v; }
  bcum = f;
}
__device__ __forceinline__ void ml_gates2(const P& p, int l, int d, int h, int m0, int lane, float& bc, float& ic, float& tot) {
  const float* gl = ML_GL(p) + (size_t)(m0 + lane) * 16;
  const float* gb = p.in[33] + (size_t)(l * 2 + d) * 8;
  ic = gl[d * 8 + h] + gb[h];
  const float f0 = logsigf_(gl[d * 8 + 4 + h] + gb[4 + h]);
  float f = f0;
#pragma unroll
  for (int o = 1; o < 64; o <<= 1) { float v = __shfl_up(f, o); if (lane >= o) f += v; }
  tot = __shfl(f, 63);
  bc = d ? (tot - f + f0) : f;
}
#define MLQ 208
#define MLS 144
__device__ __forceinline__ void ph_ml_a(const P& p, int l, char* lds) {
  char* vt = lds; char* kt = lds + 13824; float* wg = (float*)(lds + 27648);
  const int tid = get_tid(), lane = tid & 63, wid = tid >> 6, fr = lane & 15, fq = lane >> 4;
  const hf* QK = ML_QK(p); const hf* Z = ML_Z(p);
  for (int t = blockIdx.x; t < 4224; t += gridDim.x) {
    const int tc = t % 132, h = (t / 132) & 3, b = (t / 528) & 3, d = t / 2112;
    const int m0 = s5_m0(b, tc); const int cp = chain_pos(d, tc);
    const size_t task = ((size_t)((d * 4 + b) * 4 + h)) * 132 + cp;
    if (wid == 0) {
      float bc, ic, tot; ml_gates2(p, l, d, h, m0, lane, bc, ic, tot);
      const float lw = tot - bc + ic;
      float mx = lw;
      for (int o = 32; o > 0; o >>= 1) mx = fmaxf(mx, __shfl_xor(mx, o));
      wg[lane] = __expf(lw - mx);
      if (lane == 0) { ML_SC(p)[task * 2] = mx; ML_SC(p)[task * 2 + 1] = tot; }
    }
    __syncthreads();
    for (int e = tid; e < 64 * 12; e += NTHR) {
      const int tok = e & 63, q = e >> 6;
      const hf8 kv = *(const hf8*)(QK + (size_t)(m0 + tok) * 768 + 384 + h * 96 + q * 8);
      const hf8 vv = *(const hf8*)(Z + (size_t)(m0 + tok) * 1536 + 768 + h * 96 + q * 8);
      const float w = wg[tok];
#pragma unroll
      for (int i = 0; i < 8; ++i) {
        *(hf*)(kt + (q * 8 + i) * MLS + tok * 2) = kv[i];
        *(hf*)(vt + (q * 8 + i) * MLS + tok * 2) = (hf)((float)vv[i] * w);
      }
    }
    __syncthreads();
    float* dc = ML_DC(p) + task * 9216;
#pragma unroll 1
    for (int bi = 0; bi < 9; ++bi) {
      const int idx = wid * 9 + bi; const int mb = idx / 6, nb = idx % 6;
      f32x4 acc = (f32x4){0.f, 0.f, 0.f, 0.f};
#pragma unroll
      for (int ks = 0; ks < 2; ++ks) {
        const hf8 af = *(const hf8*)(vt + (mb * 16 + fr) * MLS + ks * 64 + fq * 16);
        const hf8 bf = *(const hf8*)(kt + (nb * 16 + fr) * MLS + ks * 64 + fq * 16);
        acc = __builtin_amdgcn_mfma_f32_16x16x32_f16(af, bf, acc, 0, 0, 0);
      }
#pragma unroll
      for (int j = 0; j < 4; ++j) dc[(mb * 16 + fq * 4 + j) * 96 + nb * 16 + fr] = acc[j];
    }
    if (tid < 96) {
      float s = 0.f;
      for (int j = 0; j < 64; ++j) s += wg[j] * (float)*(const hf*)(kt + tid * MLS + j * 2);
      ML_DN(p)[task * 96 + tid] = s;
    }
    __syncthreads();
  }
}
__device__ __forceinline__ void ph_ml_b(const P& p) {
  float* DC = ML_DC(p); float* DN = ML_DN(p); const float* SC = ML_SC(p); float* MP = ML_MP(p);
  for (int t = blockIdx.x * NTHR + get_tid(); t < 32 * 9312; t += gridDim.x * NTHR) {
    const int chain = t / 9312, e = t % 9312;
    float cur = 0.f, mprev = 0.f;
    for (int cp0 = 0; cp0 < 132; cp0 += 12) {
      float dl[12], ml_[12], bl_[12];
#pragma unroll
      for (int u = 0; u < 12; ++u) {
        const size_t task = (size_t)chain * 132 + cp0 + u;
        dl[u] = e < 9216 ? DC[task * 9216 + e] : DN[task * 96 + (e - 9216)];
        ml_[u] = SC[task * 2]; bl_[u] = SC[task * 2 + 1];
      }
#pragma unroll
      for (int u = 0; u < 12; ++u) {
        const size_t task = (size_t)chain * 132 + cp0 + u;
        float* slot = e < 9216 ? DC + task * 9216 + e : DN + task * 96 + (e - 9216);
        *slot = cur;
        if (e == 0) MP[task] = mprev;
        const float mnew = fmaxf(bl_[u] + mprev, ml_[u]);
        cur = __expf(bl_[u] + mprev - mnew) * cur + __expf(ml_[u] - mnew) * dl[u];
        mprev = mnew;
      }
    }
  }
}
__device__ __forceinline__ void ph_ml_c(const P& p, int l, char* lds) {
  char* qs = lds; char* ks = lds + 13312; char* vt = lds + 26624; char* cs = lds + 40448; char* ps = lds + 60416;
  float* fl = (float*)(lds + 69632);
  float* bc = fl; float* icv = fl + 128; float* mr = fl + 256; float* inter = fl + 320; float* den = fl + 384; float* nq = fl + 448; float* nst = fl + 512;
  const int tid = get_tid(), lane = tid & 63, wid = tid >> 6, fr = lane & 15, fq = lane >> 4;
  const hf* QK = ML_QK(p); const hf* Z = ML_Z(p);
  for (int t = blockIdx.x; t < 2112; t += gridDim.x) {
    const int tc = t % 132, h = (t / 132) & 3, b = t / 528;
    const int m0 = s5_m0(b, tc);
    for (int e = tid; e < 64 * 12; e += NTHR) {
      const int tok = e & 63, q = e >> 6;
      *(hf8*)(qs + tok * MLQ + q * 16) = *(const hf8*)(QK + (size_t)(m0 + tok) * 768 + h * 96 + q * 8);
      *(hf8*)(ks + tok * MLQ + q * 16) = *(const hf8*)(QK + (size_t)(m0 + tok) * 768 + 384 + h * 96 + q * 8);
      const hf8 vv = *(const hf8*)(Z + (size_t)(m0 + tok) * 1536 + 768 + h * 96 + q * 8);
#pragma unroll
      for (int i = 0; i < 8; ++i) *(hf*)(vt + (q * 8 + i) * MLS + tok * 2) = vv[i];
    }
    if (wid < 2) { float bcv, ic, tot; ml_gates2(p, l, wid, h, m0, lane, bcv, ic, tot); bc[wid * 64 + lane] = bcv; icv[wid * 64 + lane] = ic; }
    f32x4 hs[6];
#pragma unroll
    for (int n = 0; n < 6; ++n) hs[n] = (f32x4){0.f, 0.f, 0.f, 0.f};
    for (int d = 0; d < 2; ++d) {
      const int cp = chain_pos(d, tc);
      const size_t task = ((size_t)((d * 4 + b) * 4 + h)) * 132 + cp;
      const float mprev = ML_MP(p)[task];
      __syncthreads();
      {
        const float* cg = ML_DC(p) + task * 9216;
        for (int e = tid; e < 96 * 24; e += NTHR) {
          const int v = e / 24, q = e % 24;
          const float4 c4 = *(const float4*)(cg + v * 96 + q * 4);
          hf4 o; o[0] = (hf)c4.x; o[1] = (hf)c4.y; o[2] = (hf)c4.z; o[3] = (hf)c4.w;
          *(hf4*)(cs + v * MLQ + q * 8) = o;
        }
        if (tid < 96) nst[tid] = ML_DN(p)[task * 96 + tid];
      }
      const float* bcd = bc + d * 64; const float* icd = icv + d * 64;
      if (tid < 64) {
        const int j = tid; const float bj = bcd[j];
        float mx = bj + mprev;
        if (d == 0) { for (int s = 0; s <= j; ++s) mx = fmaxf(mx, bj - bcd[s] + icd[s]); }
        else { for (int s = j; s < 64; ++s) mx = fmaxf(mx, bj - bcd[s] + icd[s]); }
        mr[j] = mx; inter[j] = __expf(bj + mprev - mx);
      }
      __syncthreads();
      if (tid < 64) {
        float s1 = 0.f;
        for (int k = 0; k < 96; ++k) s1 += nst[k] * (float)*(const hf*)(qs + tid * MLQ + k * 2);
        nq[tid] = s1;
      }
      {
        f32x4 sacc[4];
#pragma unroll
        for (int n = 0; n < 4; ++n) sacc[n] = (f32x4){0.f, 0.f, 0.f, 0.f};
#pragma unroll
        for (int kk = 0; kk < 3; ++kk) {
          const hf8 af = *(const hf8*)(qs + (wid * 16 + fr) * MLQ + kk * 64 + fq * 16);
#pragma unroll
          for (int n = 0; n < 4; ++n) {
            const hf8 bf = *(const hf8*)(ks + (n * 16 + fr) * MLQ + kk * 64 + fq * 16);
            sacc[n] = __builtin_amdgcn_mfma_f32_16x16x32_f16(af, bf, sacc[n], 0, 0, 0);
          }
        }
        float rs[4] = {0.f, 0.f, 0.f, 0.f};
#pragma unroll
        for (int n = 0; n < 4; ++n) {
          const int s = n * 16 + fr; const float bs = bcd[s] - icd[s];
#pragma unroll
          for (int jj = 0; jj < 4; ++jj) {
            const int j = wid * 16 + fq * 4 + jj;
            const bool valid = d == 0 ? (s <= j) : (s >= j);
            const float val = valid ? sacc[n][jj] * __expf(bcd[j] - bs - mr[j]) : 0.f;
            rs[jj] += val;
            *(hf*)(ps + j * MLS + s * 2) = (hf)val;
          }
        }
        __syncthreads();
#pragma unroll
        for (int jj = 0; jj < 4; ++jj) {
          const float r = rowsum16(rs[jj]);
          const int j = wid * 16 + fq * 4 + jj;
          if (fr == 0) den[j] = inter[j] * nq[j] + r;
        }
      }
      f32x4 acc[6];
#pragma unroll
      for (int n = 0; n < 6; ++n) acc[n] = (f32x4){0.f, 0.f, 0.f, 0.f};
#pragma unroll
      for (int kk = 0; kk < 3; ++kk) {
        const hf8 af = *(const hf8*)(qs + (wid * 16 + fr) * MLQ + kk * 64 + fq * 16);
#pragma unroll
        for (int n = 0; n < 6; ++n) {
          const hf8 bf = *(const hf8*)(cs + (n * 16 + fr) * MLQ + kk * 64 + fq * 16);
          acc[n] = __builtin_amdgcn_mfma_f32_16x16x32_f16(af, bf, acc[n], 0, 0, 0);
        }
      }
#pragma unroll
      for (int jj = 0; jj < 4; ++jj) { const float it = inter[wid * 16 + fq * 4 + jj];
#pragma unroll
        for (int n = 0; n < 6; ++n) acc[n][jj] *= it; }
#pragma unroll
      for (int kk = 0; kk < 2; ++kk) {
        const hf8 af = *(const hf8*)(ps + (wid * 16 + fr) * MLS + kk * 64 + fq * 16);
#pragma unroll
        for (int n = 0; n < 6; ++n) {
          const hf8 bf = *(const hf8*)(vt + (n * 16 + fr) * MLS + kk * 64 + fq * 16);
          acc[n] = __builtin_amdgcn_mfma_f32_16x16x32_f16(af, bf, acc[n], 0, 0, 0);
        }
      }
      __syncthreads();
#pragma unroll
      for (int jj = 0; jj < 4; ++jj) {
        const int j = wid * 16 + fq * 4 + jj;
        const float dn = 1.f / fmaxf(fabsf(den[j]), __expf(-mr[j]));
#pragma unroll
        for (int n = 0; n < 6; ++n) hs[n][jj] += acc[n][jj] * dn;
      }
    }
#pragma unroll
    for (int jj = 0; jj < 4; ++jj) {
      const int m = m0 + wid * 16 + fq * 4 + jj;
      const hf* op = Z + (size_t)m * 1536 + 1152 + h * 96 + fr;
      float x[6]; float s = 0.f;
#pragma unroll
      for (int n = 0; n < 6; ++n) { x[n] = sigmoidf_((float)op[n * 16]) * hs[n][jj]; s += x[n]; }
      s = rowsum16(s);
      const float mean = s * (1.f / 96.f);
      float q = 0.f;
#pragma unroll
      for (int n = 0; n < 6; ++n) { x[n] -= mean; q += x[n] * x[n]; }
      q = rowsum16(q);
      const float rsd = rsqrtf(q * (1.f / 96.f) + 1e-5f);
      const float* ng = p.in[34] + (size_t)l * 384 + h * 96 + fr;
      bf16_t* yp = p.Y + (size_t)m * 1024 + 640 + h * 96 + fr;
#pragma unroll
      for (int n = 0; n < 6; ++n) yp[n * 16] = f2bf(x[n] * rsd * ng[n * 16]);
    }
    __syncthreads();
  }
}

#define MG_YM(p) ((bf16_t*)(p).R)
#define MG_G3(p) (MG_YM(p) + (size_t)M_ALL * 1024)
__device__ __forceinline__ void ph_gates(const P& p, int l, int Mt, char* lds) {
  EPI_VARS
  bf16_t* G3 = MG_G3(p);
  const float* gbias = p.in[38] + (size_t)l * 3072;
  STREAM_BEGIN(Mt, 24, 8, (p.U + (size_t)(tm * 128) * 1024), (p.W + W_IN + (size_t)(3216 + tn * 128) * 1024), 1024, 1024, 1024)
    const int m0 = tm * 128, n0 = tn * 128;
    EPI_BEGIN(m0, n0)
      G3[(size_t)row * 3072 + col] = f2bf(sigmoidf_(val + gbias[col]));
    EPI_END
  STREAM_END
}
__device__ __forceinline__ void ph_merge(const P& p, int l, int Mt, char* lds) {
  EPI_VARS
  bf16_t* YM = MG_YM(p); const bf16_t* G3 = MG_G3(p);
  const int ntile = Mt * 16;
  for (int it = 0;; ++it) {
    int tm, tn; if (!tile_map(it, Mt, 16, 8, tm, tn)) break; const int m0 = tm * 128, n0 = tn * 64;
    f32x4 yacc[4][2];
#pragma unroll
    for (int m = 0; m < 4; ++m) { yacc[m][0] = (f32x4){0.f, 0.f, 0.f, 0.f}; yacc[m][1] = (f32x4){0.f, 0.f, 0.f, 0.f}; }
#pragma unroll 1
    for (int br = 0; br < 3; ++br) {
      f32x4 acc[4][2];
#pragma unroll
      for (int m = 0; m < 4; ++m) { acc[m][0] = (f32x4){0.f, 0.f, 0.f, 0.f}; acc[m][1] = (f32x4){0.f, 0.f, 0.f, 0.f}; }
      const int kb = br == 1 ? 256 : 384; const int yoff = br == 0 ? 0 : (br == 1 ? 384 : 640);
      const int woff = br == 0 ? W_UPRW : (br == 1 ? W_UPS5 : W_UPML);
      gemm_main_t<2>(p.Y + (size_t)m0 * 1024 + yoff, 1024, p.W + woff + (size_t)n0 * kb, kb, kb, acc, lds);
      EPI_ROW_BEGIN(m0)
        const bf16_t* gp = G3 + (size_t)row * 3072 + br * 1024 + n0 + wc * 32 + fr;
#pragma unroll
        for (int n = 0; n < 2; ++n) yacc[m][n][j] += bf2f(gp[n * 16]) * acc[m][n][j];
      EPI_ROW_END
    }
    EPI_ROW_BEGIN(m0)
      bf16_t* yp = YM + (size_t)row * 1024 + n0 + wc * 32 + fr;
#pragma unroll
      for (int n = 0; n < 2; ++n) yp[n * 16] = f2bf(yacc[m][n][j]);
    EPI_ROW_END
  }
}
__device__ __forceinline__ void ph_wout(const P& p, int l, int Mt, char* lds) {
  EPI_VARS
  const bf16_t* YM = (const bf16_t*)p.R;
  STREAM_BEGIN(Mt, 8, 8, (YM + (size_t)(tm * 128) * 1024), (p.W + W_OUT + (size_t)(tn * 128) * 1024), 1024, 1024, 1024)
    const int m0 = tm * 128, n0 = tn * 128;
    EPI_ROW_BEGIN(m0)
      float* sp = srow(p, row) + n0 + wc * 64 + fr; const float* gp = modp(p, l, row, 5) + n0 + wc * 64 + fr;
#pragma unroll
      for (int n = 0; n < 4; ++n) sp[n * 16] = ALPHA * sp[n * 16] + gp[n * 16] * acc[m][n][j];
    EPI_ROW_END
  STREAM_END
}

#define XB_TMO      128
#define XB_XCNT(j)  (256  + 64 * (j))
#define XB_XSUB(j)  (1280 + 64 * (j))
#define XB_XGEN(j)  (2304 + 64 * (j))
#define XB_TOP      3328
#define XB_TOPGEN   3392
#define XCD_BAR_WORDS 3456
#define XB_SPIN_CAP (1u << 18)
#define LAS __attribute__((address_space(3)))

__device__ __forceinline__ unsigned xb_ld(unsigned* p)              { return __hip_atomic_load(p, __ATOMIC_RELAXED, __HIP_MEMORY_SCOPE_AGENT); }
__device__ __forceinline__ unsigned xb_add(unsigned* p, unsigned v) { return __hip_atomic_fetch_add(p, v, __ATOMIC_RELAXED, __HIP_MEMORY_SCOPE_AGENT); }
__device__ __forceinline__ unsigned xb_xcc_id() { return (unsigned)__builtin_amdgcn_s_getreg((3 << 11) | 20) & 0xFu; }
#define XB_SPIN(cond, bar) do { unsigned _sp = 0; while (cond) { __builtin_amdgcn_s_sleep(1); \
    if ((++_sp & 255u) == 0u) { if (xb_ld(&(bar)[XB_TMO])) break; if (_sp > XB_SPIN_CAP) { atomicAdd(&(bar)[XB_TMO], 1u); break; } } } } while (0)

struct XcdBarrier {
    unsigned* bar; unsigned x;
    volatile LAS unsigned* st;
};

__device__ __forceinline__ XcdBarrier xcd_barrier_post(unsigned* bar, volatile LAS unsigned* st) {
    XcdBarrier b; b.bar = bar; b.x = xb_xcc_id(); b.st = st;
    if (__builtin_amdgcn_workitem_id_x() == 0) (void)xb_add(&bar[XB_XCNT(b.x)], 1u);
    return b;
}
__device__ __forceinline__ void xcd_barrier_complete(unsigned* bar, unsigned x, unsigned& nloc, unsigned& nx) {
    const unsigned G = gridDim.x * gridDim.y * gridDim.z;
    unsigned sum, cnt, mine, sp = 0u;
    for (;;) {
        sum = 0u; cnt = 0u; mine = 0u;
#pragma unroll
        for (unsigned j = 0; j < 16; ++j) { const unsigned c = xb_ld(&bar[XB_XCNT(j)]); sum += c; cnt += (c > 0u) ? 1u : 0u; mine = (j == x) ? c : mine; }
        if (sum == G) break;
        __builtin_amdgcn_s_sleep(1);
        if ((++sp & 255u) == 0u) { if (xb_ld(&bar[XB_TMO])) break; if (sp > XB_SPIN_CAP) { atomicAdd(&bar[XB_TMO], 1u); break; } }
    }
    nloc = mine > 0u ? mine : 1u; nx = cnt > 0u ? cnt : 1u;
}

__device__ __forceinline__ void xcd_barrier(const XcdBarrier& b) {
    asm volatile("s_waitcnt vmcnt(0)" ::: "memory");
    __syncthreads();
    if (__builtin_amdgcn_workitem_id_x() == 0) {
        unsigned* bar = b.bar;
        __builtin_amdgcn_s_waitcnt(0);
        unsigned nloc = b.st[0], nx = b.st[1];
        if (nloc == 0u) { xcd_barrier_complete(bar, b.x, nloc, nx); b.st[0] = nloc; b.st[1] = nx; }
        const unsigned old = xb_add(&bar[XB_XSUB(b.x)], 1u);
        const unsigned gen = old / nloc;
        if (old + 1u == (gen + 1u) * nloc) {
            __builtin_amdgcn_fence(__ATOMIC_RELEASE, "agent");
            asm volatile("s_waitcnt vmcnt(0)" ::: "memory");
            const unsigned og = xb_add(&bar[XB_TOP], 1u);
            const unsigned tg = og / nx;
            if (og + 1u == (tg + 1u) * nx) xb_add(&bar[XB_TOPGEN], 1u);
            else XB_SPIN(xb_ld(&bar[XB_TOPGEN]) == tg, bar);
            __builtin_amdgcn_fence(__ATOMIC_ACQUIRE, "agent");
            xb_add(&bar[XB_XGEN(b.x)], 1u);
            asm volatile("s_waitcnt vmcnt(0)" ::: "memory");
        } else {
            XB_SPIN(xb_ld(&bar[XB_XGEN(b.x)]) == gen, bar);
            __builtin_amdgcn_fence(__ATOMIC_ACQUIRE, "agent");
            asm volatile("s_waitcnt vmcnt(0)" ::: "memory");
        }
    }
    __syncthreads();
}


#define SYNC xcd_barrier(xb); asm volatile("" : "+s"(l));
__global__ void __launch_bounds__(NTHR, 2) mega(P pv) {
#define p pv
  __shared__ __attribute__((aligned(16))) char lds[LDS_BYTES];
  __shared__ uint4 xb_words;
  cg::grid_group grid = cg::this_grid();
  {
    const int t0 = __builtin_amdgcn_workitem_id_x();
    if (blockIdx.x == 0) for (int i = t0; i < 4096; i += NTHR) pv.bar[i] = 0u;
    if (t0 == 0) xb_words = make_uint4(0u, 0u, 0u, 0u);
    __threadfence();
    grid.sync();
  }
  XcdBarrier xb = xcd_barrier_post(pv.bar, (volatile LAS unsigned*)&xb_words);
  for (int l = 0; l < 2; ++l) {
    const bool last = (l == 1);
    const int Mt2 = last ? 256 : 264;
    const int Mr2 = last ? M_LAT : M_ALL;
    ph_convert(p, l, l == 0, lds); SYNC
    if (l == 0) { ph_rows(p, 0, 0, 0, M_ALL, true, 0, 0); SYNC }
    ph_ffn_up(p, 0, 264, lds); SYNC
    ph_ffn_down(p, l, 0, 264, lds); SYNC
    ph_rows(p, 1, l, 0, M_ALL, true, l, 3); SYNC
    ph_z_rw(p, lds); SYNC
    ph_conv<0>(p, l); SYNC
    ph_lora(p, l, lds); SYNC
    {
      const int ns = gridDim.x >= 384 ? 192 : 0;
      if (ns == 0 || blockIdx.x < 192) ph_rwscan(p, lds);
      if (ns == 0) { SYNC }
      if ((int)blockIdx.x >= ns) ph_s5_stage(p, l, lds, (int)blockIdx.x - ns, (int)gridDim.x - ns);
      SYNC
    }
    ph_rwpost(p, l); SYNC
    ph_z_ml(p, lds); SYNC
    ph_conv<1>(p, l); SYNC
    ph_ml_a(p, l, lds); SYNC
    ph_ml_b(p); SYNC
    ph_ml_c(p, l, lds); SYNC
    ph_gates(p, l, Mt2, lds); SYNC
    ph_merge(p, l, Mt2, lds); SYNC
    ph_wout(p, l, Mt2, lds); SYNC
    ph_rows(p, 1, l, 1, Mr2, true, l, 6); SYNC
    ph_ffn_up(p, 1, Mt2, lds); SYNC
    ph_ffn_down(p, l, 1, Mt2, lds); SYNC
    ph_rows(p, 1, l, 2, Mr2, !last, l + 1, 0);
    if (!last) { SYNC }
  }
#undef p
}

extern "C" void kernel_launch(void* const* d_in, const int* in_sizes, int n_in, void* d_out, int out_size, void* d_ws, size_t ws_size,
                              hipStream_t stream) {
  static int grid_blocks = 0;
  if (!grid_blocks) {
    int dev = 0, cus = 0, per_cu = 0;
    hipGetDevice(&dev);
    hipDeviceGetAttribute(&cus, hipDeviceAttributeMultiprocessorCount, dev);
    hipOccupancyMaxActiveBlocksPerMultiprocessor(&per_cu, mega, NTHR, 0);
    if (per_cu > 2) per_cu = 2;
    grid_blocks = cus * per_cu;
  }
  P p{};
  for (int i = 0; i < 40; ++i) p.in[i] = (const float*)d_in[i];
  char* ws = (char*)d_ws;
  size_t off = 0;
  p.W = (bf16_t*)(ws + off); off += (size_t)W_TOTAL * 2;
  p.mod = (float*)(ws + off); off += (size_t)2 * 5 * 9216 * 4;
  p.sctx = (float*)(ws + off); off += (size_t)1024 * 1024 * 4;
  p.bar = (unsigned*)(ws + off); off += (size_t)16384;
  p.U = (bf16_t*)(ws + off); off += (size_t)M_ALL * 1024 * 2;
  p.Y = (bf16_t*)(ws + off); off += (size_t)M_ALL * 1024 * 2;
  p.R = ws + off;
  p.out = (float*)d_out;
  if (off + (size_t)M_ALL * 9728 > ws_size) fprintf(stderr, "workspace too small: need %zu have %zu\n", off + (size_t)M_ALL * 9728, ws_size);
  void* args[] = {&p};
  hipError_t e = hipLaunchCooperativeKernel((void*)mega, dim3(grid_blocks), dim3(NTHR), args, 0, stream);
  if (e != hipSuccess) fprintf(stderr, "cooperative launch failed: %s (grid %d)\n", hipGetErrorString(e), grid_blocks);
}
```

```cpp
#include <hip/hip_runtime.h>
#include <hip/hip_cooperative_groups.h>
#include <cstdio>
namespace cg = cooperative_groups;

typedef unsigned short bf16_t;
typedef _Float16 hf;
typedef hf hf4 __attribute__((ext_vector_type(4)));
typedef hf hf8 __attribute__((ext_vector_type(8)));
typedef __attribute__((ext_vector_type(8))) short bf16x8;
typedef __attribute__((ext_vector_type(4))) float f32x4;
typedef unsigned int u32x4 __attribute__((ext_vector_type(4)));

#define M_LAT 32768
#define M_ALL 33792
#define NTHR 256
#define LDS_BYTES 73728
#define ALPHA 1.41421356237f

#define W_GU0 0
#define W_D0 5767168
#define W_GU1 8650752
#define W_D1 14417920
#define W_IN 17301504
#define W_WUP0 23740416
#define W_WUP1 23764992
#define W_AUP0 23789568
#define W_AUP1 23814144
#define W_GUP 23838720
#define W_GLU 23887872
#define W_UPRW 23953408
#define W_UPS5 24346624
#define W_UPML 24608768
#define W_OUT 25001984
#define W_TOTAL 26050560

struct P {
  const float* in[40];
  float* out; float* sctx; float* mod;
  bf16_t* U; bf16_t* Y; bf16_t* W; char* R; unsigned* bar;
};

__device__ __forceinline__ int get_tid() { int t = __builtin_amdgcn_workitem_id_x(); asm volatile("" : "+v"(t)); return t; }
__device__ __forceinline__ bf16_t f2bf(float f) { return __builtin_bit_cast(unsigned short, (_Float16)f); }
__device__ __forceinline__ float bf2f(bf16_t h) { return (float)__builtin_bit_cast(_Float16, h); }
__device__ __forceinline__ float sigmoidf_(float x) { return __builtin_amdgcn_rcpf(1.f + __expf(-x)); }
__device__ __forceinline__ float tanhf_(float x) { return 1.f - 2.f * __builtin_amdgcn_rcpf(1.f + __expf(2.f * x)); }
__device__ __forceinline__ float siluf_(float x) { return x * __builtin_amdgcn_rcpf(1.f + __expf(-x)); }
__device__ __forceinline__ float* srow(const P& p, int m) { return m < M_LAT ? p.out + (size_t)m * 1024 : p.sctx + (size_t)(m - M_LAT) * 1024; }
__device__ __forceinline__ const float* modp(const P& p, int l, int m, int k) { int mv = m < M_LAT ? (m >> 13) : 4; return p.mod + (size_t)(l * 5 + mv) * 9216 + k * 1024; }
template <int C> __device__ __forceinline__ float dppf(float x) { return __int_as_float(__builtin_amdgcn_update_dpp(0, __float_as_int(x), C, 0xf, 0xf, false)); }
__device__ __forceinline__ float rowsum16(float x) { x += dppf<0x128>(x); x += dppf<0x124>(x); x += dppf<0x122>(x); x += dppf<0x121>(x); return x; }
__device__ __forceinline__ float wavesum(float x) { for (int o = 32; o > 0; o >>= 1) x += __shfl_xor(x, o); return x; }

template <int NB>
__device__ __forceinline__ void gemm_main_t(const bf16_t* __restrict__ A, int lda, const bf16_t* __restrict__ B, int ldb, int K,
                                          f32x4 (&acc)[4][NB], char* lds) {
  const int tid = get_tid(), lane = tid & 63, wid = tid >> 6, wr = wid >> 1, wc = wid & 1;
  const int fr = lane & 15, fq = lane >> 4;
  const int sr = tid >> 3, skc = tid & 7;
  const bf16_t* ga = A + (size_t)sr * lda + skc * 8;
  const bf16_t* gb = B + (size_t)sr * ldb + skc * 8;
  u32x4 ra0[4], rb0[NB], ra1[4], rb1[NB];
  const int soff = sr * 144 + skc * 16;
  const int nk = K >> 6;
  const int aoff = (wr * 64 + fr) * 144 + fq * 16;
  const int boff = 18432 + (wc * (NB * 16) + fr) * 144 + fq * 16;
#define G_LOAD(RA, RB, kt) { _Pragma("unroll") for (int i = 0; i < 4; ++i) { RA[i] = *(const u32x4*)(ga + (size_t)(i * 32) * lda + (kt) * 64); if (i < NB) RB[i] = *(const u32x4*)(gb + (size_t)(i * 32) * ldb + (kt) * 64); } }
#define G_STORE(RA, RB, buf) { char* d_ = lds + (buf) * 36864 + soff; _Pragma("unroll") for (int i = 0; i < 4; ++i) { *(u32x4*)(d_ + i * 32 * 144) = RA[i]; if (i < NB) *(u32x4*)(d_ + 18432 + i * 32 * 144) = RB[i]; } }
#define G_COMP(buf) { const char* cur = lds + (buf) * 36864; _Pragma("unroll") for (int ks = 0; ks < 2; ++ks) { hf8 af[4], bfr[NB]; \
    _Pragma("unroll") for (int m = 0; m < 4; ++m) af[m] = *(const hf8*)(cur + aoff + m * 16 * 144 + ks * 64); \
    _Pragma("unroll") for (int n = 0; n < NB; ++n) bfr[n] = *(const hf8*)(cur + boff + n * 16 * 144 + ks * 64); \
    _Pragma("unroll") for (int m = 0; m < 4; ++m) _Pragma("unroll") for (int n = 0; n < NB; ++n) acc[m][n] = __builtin_amdgcn_mfma_f32_16x16x32_f16(af[m], bfr[n], acc[m][n], 0, 0, 0); } }
  G_LOAD(ra0, rb0, 0)
  { const int k1 = nk > 1 ? 1 : 0; G_LOAD(ra1, rb1, k1) }
  G_STORE(ra0, rb0, 0)
  __syncthreads();
  for (int kt = 0; kt < nk; kt += 2) {
    { const int k2 = kt + 2 < nk ? kt + 2 : nk - 1; G_LOAD(ra0, rb0, k2) }
    G_COMP(0)
    G_STORE(ra1, rb1, 1)
    __syncthreads();
    { const int k3 = kt + 3 < nk ? kt + 3 : nk - 1; G_LOAD(ra1, rb1, k3) }
    if (kt + 1 < nk) G_COMP(1)
    G_STORE(ra0, rb0, 0)
    __syncthreads();
  }
}
__device__ __forceinline__ void gemm_stream(const bf16_t* __restrict__ A, int lda, const bf16_t* __restrict__ B, int ldb, int K,
                                            const bf16_t* __restrict__ An, const bf16_t* __restrict__ Bn, bool first,
                                            f32x4 (&acc)[4][4], char* lds, u32x4 (&ra1)[4], u32x4 (&rb1)[4]) {
  constexpr int NB = 4;
  const int tid = get_tid(), lane = tid & 63, wid = tid >> 6, wr = wid >> 1, wc = wid & 1;
  const int fr = lane & 15, fq = lane >> 4;
  const int sr = tid >> 3, skc = tid & 7;
  const bf16_t* ga = A + (size_t)sr * lda + skc * 8;
  const bf16_t* gb = B + (size_t)sr * ldb + skc * 8;
  const bf16_t* gan = An + (size_t)sr * lda + skc * 8;
  const bf16_t* gbn = Bn + (size_t)sr * ldb + skc * 8;
  u32x4 ra0[4], rb0[NB];
  const int soff = sr * 144 + skc * 16;
  const int nk = K >> 6;
  const int aoff = (wr * 64 + fr) * 144 + fq * 16;
  const int boff = 18432 + (wc * (NB * 16) + fr) * 144 + fq * 16;
#define GS_LOAD(RA, RB, pa, pb, kt) { _Pragma("unroll") for (int i = 0; i < 4; ++i) { RA[i] = *(const u32x4*)((pa) + (size_t)(i * 32) * lda + (kt) * 64); RB[i] = *(const u32x4*)((pb) + (size_t)(i * 32) * ldb + (kt) * 64); } }
  if (first) {
    GS_LOAD(ra0, rb0, ga, gb, 0)
    GS_LOAD(ra1, rb1, ga, gb, 1)
    G_STORE(ra0, rb0, 0)
    __syncthreads();
  }
  for (int kt = 0; kt < nk; kt += 2) {
    if (kt + 2 < nk) { GS_LOAD(ra0, rb0, ga, gb, kt + 2) } else { GS_LOAD(ra0, rb0, gan, gbn, 0) }
    G_COMP(0)
    G_STORE(ra1, rb1, 1)
    __syncthreads();
    if (kt + 3 < nk) { GS_LOAD(ra1, rb1, ga, gb, kt + 3) } else { GS_LOAD(ra1, rb1, gan, gbn, 1) }
    G_COMP(1)
    G_STORE(ra0, rb0, 0)
    __syncthreads();
  }
}
__device__ __forceinline__ void gemm_main(const bf16_t* __restrict__ A, int lda, const bf16_t* __restrict__ B, int ldb, int K, f32x4 (&acc)[4][4], char* lds) {
  gemm_main_t<4>(A, lda, B, ldb, K, acc, lds);
}
template <int KT>
__device__ __forceinline__ void gemm_small_t(const bf16_t* __restrict__ A, int lda, const bf16_t* __restrict__ B, int ldb, f32x4 (&acc)[4][4], char* lds) {
  const int tid = get_tid(), lane = tid & 63, wid = tid >> 6, wr = wid >> 1, wc = wid & 1;
  const int fr = lane & 15, fq = lane >> 4;
  const int sr = tid >> 3, skc = tid & 7;
  const bf16_t* ga = A + (size_t)sr * lda + skc * 8;
  const bf16_t* gb = B + (size_t)sr * ldb + skc * 8;
  const int soff = sr * 144 + skc * 16;
  const int aoff = (wr * 64 + fr) * 144 + fq * 16;
  const int boff = 18432 + (wc * 64 + fr) * 144 + fq * 16;
  u32x4 ra[KT][4], rb[KT][4];
#pragma unroll
  for (int kt = 0; kt < KT; ++kt)
#pragma unroll
    for (int i = 0; i < 4; ++i) { ra[kt][i] = *(const u32x4*)(ga + (size_t)(i * 32) * lda + kt * 64); rb[kt][i] = *(const u32x4*)(gb + (size_t)(i * 32) * ldb + kt * 64); }
#pragma unroll
  for (int kt = 0; kt < KT; ++kt)
#pragma unroll
    for (int i = 0; i < 4; ++i) { *(u32x4*)(lds + kt * 36864 + soff + i * 32 * 144) = ra[kt][i]; *(u32x4*)(lds + kt * 36864 + 18432 + soff + i * 32 * 144) = rb[kt][i]; }
  __syncthreads();
#pragma unroll
  for (int kt = 0; kt < KT; ++kt) {
    const char* cur = lds + kt * 36864;
#pragma unroll
    for (int ks = 0; ks < 2; ++ks) {
      hf8 af[4], bfr[4];
#pragma unroll
      for (int m = 0; m < 4; ++m) af[m] = *(const hf8*)(cur + aoff + m * 16 * 144 + ks * 64);
#pragma unroll
      for (int n = 0; n < 4; ++n) bfr[n] = *(const hf8*)(cur + boff + n * 16 * 144 + ks * 64);
#pragma unroll
      for (int m = 0; m < 4; ++m)
#pragma unroll
        for (int n = 0; n < 4; ++n) acc[m][n] = __builtin_amdgcn_mfma_f32_16x16x32_f16(bfr[n], af[m], acc[m][n], 0, 0, 0);
    }
  }
  __syncthreads();
}

template <int SM>
__device__ __forceinline__ bool tile_map_sm(int b, int nb, int it, int Mt, int Nt, int SN, int& tm, int& tn) {
  const int xcd = b & 7, li = b >> 3, nloc = nb >> 3;
  const int T = SM * SN; const int nsn = Nt / SN; const int nsuper = (Mt / SM) * nsn;
  const int o = li + it * nloc; const int k = o / T, w = o - k * T;
  const int s = xcd + 8 * k;
  if (s >= nsuper) return false;
  const int sm = s / nsn, sn = s - sm * nsn;
  tm = sm * SM + (w % SM); tn = sn * SN + (w / SM);
  return true;
}
__device__ __forceinline__ bool tile_map_v(int b, int nb, int it, int Mt, int Nt, int SN, int& tm, int& tn) {
  const int nsn = Nt / SN;
  if (nsn * (Mt >> 3) % 8 == 0 || nsn >= 8) return tile_map_sm<8>(b, nb, it, Mt, Nt, SN, tm, tn);
  return tile_map_sm<1>(b, nb, it, Mt, Nt, SN, tm, tn);
}
__device__ __forceinline__ bool tile_map(int it, int Mt, int Nt, int SN, int& tm, int& tn) { return tile_map_v(blockIdx.x, gridDim.x, it, Mt, Nt, SN, tm, tn); }
#define ZERO_ACC(a) _Pragma("unroll") for (int m_ = 0; m_ < 4; ++m_) _Pragma("unroll") for (int n_ = 0; n_ < 4; ++n_) a[m_][n_] = (f32x4){0.f, 0.f, 0.f, 0.f};
#define EPI_VARS const int tid = get_tid(), lane = tid & 63, wid = tid >> 6, wr = wid >> 1, wc = wid & 1, fr = lane & 15, fq = lane >> 4; (void)wr; (void)wc; (void)fr; (void)fq;
#define EPI_ROW_BEGIN(m0) _Pragma("unroll") for (int m = 0; m < 4; ++m) _Pragma("unroll") for (int j = 0; j < 4; ++j) { const int row = (m0) + wr * 64 + m * 16 + fq * 4 + j; (void)row;
#define EPI_COL_BEGIN(n0) _Pragma("unroll") for (int n = 0; n < 4; ++n) { const int col = (n0) + wc * 64 + n * 16 + fr; const float val = acc[m][n][j]; (void)col; (void)val;
#define EPI_COL_END }
#define EPI_ROW_END }
#define EPI_BEGIN(m0, n0) EPI_ROW_BEGIN(m0) EPI_COL_BEGIN(n0)
#define EPI_END } }

struct Job { const float* src; int K, N; int dst; int mode; };
__device__ __forceinline__ Job get_job(const P& p, int l, int j) {
  Job r; r.mode = 0;
  switch (j) {
    case 0: r.src = p.in[8] + (size_t)(l * 2 + 0) * 1024 * 2816; r.K = 1024; r.N = 2816; r.dst = W_GU0; r.mode = 1; break;
    case 1: r.src = p.in[9] + (size_t)(l * 2 + 0) * 1024 * 2816; r.K = 1024; r.N = 2816; r.dst = W_GU0; r.mode = 2; break;
    case 2: r.src = p.in[10] + (size_t)(l * 2 + 0) * 2816 * 1024; r.K = 2816; r.N = 1024; r.dst = W_D0; break;
    case 3: r.src = p.in[8] + (size_t)(l * 2 + 1) * 1024 * 2816; r.K = 1024; r.N = 2816; r.dst = W_GU1; r.mode = 1; break;
    case 4: r.src = p.in[9] + (size_t)(l * 2 + 1) * 1024 * 2816; r.K = 1024; r.N = 2816; r.dst = W_GU1; r.mode = 2; break;
    case 5: r.src = p.in[10] + (size_t)(l * 2 + 1) * 2816 * 1024; r.K = 2816; r.N = 1024; r.dst = W_D1; break;
    case 6: r.src = p.in[11] + (size_t)l * 1024 * 6288; r.K = 1024; r.N = 6288; r.dst = W_IN; break;
    case 7: r.src = p.in[14] + (size_t)(l * 2 + 0) * 64 * 384; r.K = 64; r.N = 384; r.dst = W_WUP0; break;
    case 8: r.src = p.in[14] + (size_t)(l * 2 + 1) * 64 * 384; r.K = 64; r.N = 384; r.dst = W_WUP1; break;
    case 9: r.src = p.in[16] + (size_t)(l * 2 + 0) * 64 * 384; r.K = 64; r.N = 384; r.dst = W_AUP0; break;
    case 10: r.src = p.in[16] + (size_t)(l * 2 + 1) * 64 * 384; r.K = 64; r.N = 384; r.dst = W_AUP1; break;
    case 11: r.src = p.in[17] + (size_t)l * 128 * 384; r.K = 128; r.N = 384; r.dst = W_GUP; break;
    case 12: r.src = p.in[31] + (size_t)l * 256 * 256; r.K = 256; r.N = 256; r.dst = W_GLU; break;
    case 13: r.src = p.in[35] + (size_t)l * 384 * 1024; r.K = 384; r.N = 1024; r.dst = W_UPRW; break;
    case 14: r.src = p.in[36] + (size_t)l * 256 * 1024; r.K = 256; r.N = 1024; r.dst = W_UPS5; break;
    case 15: r.src = p.in[37] + (size_t)l * 384 * 1024; r.K = 384; r.N = 1024; r.dst = W_UPML; break;
    default: r.src = p.in[39] + (size_t)l * 1024 * 1024; r.K = 1024; r.N = 1024; r.dst = W_OUT; break;
  }
  return r;
}
#define NJOBS 17
__device__ void mod_task(const P& p, int t, char* lds) {
  float* sc = (float*)lds;
  float* red = sc + 5 * 1024;
  const int tid = get_tid();
  for (int i = tid; i < 5 * 1024; i += NTHR) {
    int v = i >> 10, k = i & 1023;
    float c = v < 4 ? p.in[1][v * 1024 + k] : p.in[3][k];
    sc[i] = siluf_(c);
  }
  __syncthreads();
  const int c0 = t * 64; const int l = c0 / 9216; const int j0 = c0 % 9216;
  const int col = tid & 63, part = tid >> 6;
  const float* w = p.in[4] + ((size_t)l * 1024 + part * 256) * 9216 + j0 + col;
  float a0 = 0, a1 = 0, a2 = 0, a3 = 0, a4 = 0;
  const float* s = sc + part * 256;
#pragma unroll 8
  for (int i = 0; i < 256; ++i) {
    float wv = w[(size_t)i * 9216];
    a0 += s[i] * wv; a1 += s[1024 + i] * wv; a2 += s[2048 + i] * wv; a3 += s[3072 + i] * wv; a4 += s[4096 + i] * wv;
  }
  red[(part * 5 + 0) * 64 + col] = a0; red[(part * 5 + 1) * 64 + col] = a1; red[(part * 5 + 2) * 64 + col] = a2;
  red[(part * 5 + 3) * 64 + col] = a3; red[(part * 5 + 4) * 64 + col] = a4;
  __syncthreads();
  for (int i = tid; i < 320; i += NTHR) {
    int v = i >> 6, c = i & 63;
    float sum = red[(0 * 5 + v) * 64 + c] + red[(1 * 5 + v) * 64 + c] + red[(2 * 5 + v) * 64 + c] + red[(3 * 5 + v) * 64 + c];
    p.mod[(size_t)(l * 5 + v) * 9216 + j0 + c] = sum + p.in[5][(size_t)l * 9216 + j0 + c];
  }
  __syncthreads();
}
__device__ __forceinline__ void ph_convert(const P& p, int l, bool with_mod, char* lds) {
  const int tid = get_tid();
  int ntiles[NJOBS]; int total = 0;
#pragma unroll
  for (int j = 0; j < NJOBS; ++j) { Job jb = get_job(p, l, j); ntiles[j] = (jb.K >> 6) * ((jb.N + 63) >> 6); total += ntiles[j]; }
  const int nmod = with_mod ? 288 : 0;
  float* tile = (float*)lds;
  for (int t = blockIdx.x; t < total + nmod; t += gridDim.x) {
    if (t < nmod) { mod_task(p, t, lds); continue; }
    int tt = t - nmod; int j = 0;
#pragma unroll
    for (int q = 0; q < NJOBS; ++q) { if (j == q && tt >= ntiles[q]) { tt -= ntiles[q]; j = q + 1; } }
    Job jb = get_job(p, l, j);
    const int nkt = jb.K >> 6;
    const int k0 = (tt % nkt) * 64, n0 = (tt / nkt) * 64;
    {
      const int c = tid & 63, r0 = tid >> 6;
      const bool ok = (n0 + c) < jb.N;
#pragma unroll
      for (int i = 0; i < 16; ++i) { int r = r0 + i * 4; tile[r * 65 + c] = ok ? jb.src[(size_t)(k0 + r) * jb.N + n0 + c] : 0.f; }
    }
    __syncthreads();
    {
      const int nn = tid >> 2, q = tid & 3; const int n = n0 + nn;
      if (n < jb.N) {
        int drow = n;
        if (jb.mode == 1) drow = (n >> 5) * 64 + (n & 31);
        else if (jb.mode == 2) drow = (n >> 5) * 64 + 32 + (n & 31);
        bf16_t* d = p.W + jb.dst + (size_t)drow * jb.K + k0 + q * 16;
        unsigned pk[8];
#pragma unroll
        for (int i = 0; i < 8; ++i) { unsigned lo = f2bf(tile[(q * 16 + 2 * i) * 65 + nn]); unsigned hi = f2bf(tile[(q * 16 + 2 * i + 1) * 65 + nn]); pk[i] = lo | (hi << 16); }
        *(uint4*)d = make_uint4(pk[0], pk[1], pk[2], pk[3]);
        *(uint4*)(d + 8) = make_uint4(pk[4], pk[5], pk[6], pk[7]);
      }
    }
    __syncthreads();
  }
}

__device__ __forceinline__ void ph_rows(const P& p, int mode, int l, int ln_idx, int Mrows, bool writeU, int ul, int ks) {
  const int lane = get_tid() & 63, wid = get_tid() >> 6;
  const int nw = gridDim.x * 4;
  const float* g = p.in[6] + (size_t)(l * 3 + ln_idx) * 1024;
  const float* b = p.in[7] + (size_t)(l * 3 + ln_idx) * 1024;
  for (int m = blockIdx.x * 4 + wid; m < Mrows; m += nw) {
    float* s = srow(p, m);
    const float* src = s;
    if (mode == 0) src = m < M_LAT ? p.in[0] + (size_t)m * 1024 : p.in[2] + (size_t)(m - M_LAT) * 1024;
    float4 v[4];
#pragma unroll
    for (int i = 0; i < 4; ++i) v[i] = *(const float4*)(src + lane * 4 + i * 256);
    if (mode == 1) {
      float sum = 0;
#pragma unroll
      for (int i = 0; i < 4; ++i) sum += v[i].x + v[i].y + v[i].z + v[i].w;
      sum = wavesum(sum);
      const float mean = sum * (1.f / 1024.f);
      float sq = 0;
#pragma unroll
      for (int i = 0; i < 4; ++i) { v[i].x -= mean; v[i].y -= mean; v[i].z -= mean; v[i].w -= mean; sq += v[i].x * v[i].x + v[i].y * v[i].y + v[i].z * v[i].z + v[i].w * v[i].w; }
      sq = wavesum(sq);
      const float rstd = rsqrtf(sq * (1.f / 1024.f) + 1e-5f);
#pragma unroll
      for (int i = 0; i < 4; ++i) {
        float4 gg = *(const float4*)(g + lane * 4 + i * 256), bb = *(const float4*)(b + lane * 4 + i * 256);
        v[i].x = v[i].x * rstd * gg.x + bb.x; v[i].y = v[i].y * rstd * gg.y + bb.y; v[i].z = v[i].z * rstd * gg.z + bb.z; v[i].w = v[i].w * rstd * gg.w + bb.w;
      }
    }
#pragma unroll
    for (int i = 0; i < 4; ++i) *(float4*)(s + lane * 4 + i * 256) = v[i];
    if (writeU) {
      const float* sh = modp(p, ul, m, ks); const float* scl = modp(p, ul, m, ks + 1);
#pragma unroll
      for (int i = 0; i < 4; ++i) {
        float4 a = *(const float4*)(sh + lane * 4 + i * 256), c = *(const float4*)(scl + lane * 4 + i * 256);
        unsigned lo = f2bf(v[i].x * (1.f + c.x) + a.x) | ((unsigned)f2bf(v[i].y * (1.f + c.y) + a.y) << 16);
        unsigned hi = f2bf(v[i].z * (1.f + c.z) + a.z) | ((unsigned)f2bf(v[i].w * (1.f + c.w) + a.w) << 16);
        *(uint2*)(p.U + (size_t)m * 1024 + lane * 4 + i * 256) = make_uint2(lo, hi);
      }
    }
  }
}


#define STREAM_BEGIN(Mt_, Nt_, SN_, APTR, BPTR, LDA_, LDB_, K_) { \
    u32x4 pr_a[4], pr_b[4]; bool first_ = true; int tm, tn; bool have_ = tile_map(0, Mt_, Nt_, SN_, tm, tn); \
    for (int it = 0; have_; ++it) { int tm2, tn2; const bool have2_ = tile_map(it + 1, Mt_, Nt_, SN_, tm2, tn2); \
      const int tmn = have2_ ? tm2 : tm, tnn = have2_ ? tn2 : tn; \
      f32x4 acc[4][4]; ZERO_ACC(acc) \
      { const bf16_t* a_cur = APTR; const bf16_t* b_cur = BPTR; \
        const bf16_t* a_nxt; const bf16_t* b_nxt; { const int tm = tmn, tn = tnn; (void)tm; (void)tn; a_nxt = APTR; b_nxt = BPTR; } \
        gemm_stream(a_cur, LDA_, b_cur, LDB_, K_, a_nxt, b_nxt, first_, acc, lds, pr_a, pr_b); first_ = false; }
#define STREAM_END tm = tm2; tn = tn2; have_ = have2_; } }
__device__ __forceinline__ void ph_ffn_up(const P& p, int s, int Mt, char* lds) {
  EPI_VARS
  bf16_t* HM = (bf16_t*)p.R;
  const bf16_t* Wt = p.W + (s ? W_GU1 : W_GU0);
  STREAM_BEGIN(Mt, 44, 4, (p.U + (size_t)(tm * 128) * 1024), (Wt + (size_t)(tn * 128) * 1024), 1024, 1024, 1024)
    const int m0 = tm * 128, n0 = tn * 128;
    const int hb = ((n0 + wc * 64) >> 6) * 32;
#pragma unroll
    for (int m = 0; m < 4; ++m)
#pragma unroll
      for (int n = 0; n < 2; ++n)
#pragma unroll
        for (int j = 0; j < 4; ++j) {
          const int row = m0 + wr * 64 + m * 16 + fq * 4 + j; const int hc = hb + n * 16 + fr;
          HM[(size_t)row * 2816 + hc] = f2bf(siluf_(acc[m][n][j]) * acc[m][n + 2][j]);
        }
  STREAM_END
}
__device__ __forceinline__ void ph_ffn_down(const P& p, int l, int s, int Mt, char* lds) {
  EPI_VARS
  const bf16_t* HM = (const bf16_t*)p.R;
  const bf16_t* Wt = p.W + (s ? W_D1 : W_D0);
  const int gk = s ? 8 : 2;
  STREAM_BEGIN(Mt, 8, 8, (HM + (size_t)(tm * 128) * 2816), (Wt + (size_t)(tn * 128) * 2816), 2816, 2816, 2816)
    const int m0 = tm * 128, n0 = tn * 128;
    EPI_ROW_BEGIN(m0)
      float* sp = srow(p, row) + n0 + wc * 64 + fr; const float* gp = modp(p, l, row, gk) + n0 + wc * 64 + fr;
#pragma unroll
      for (int n = 0; n < 4; ++n) sp[n * 16] = ALPHA * sp[n * 16] + 0.5f * gp[n * 16] * acc[m][n][j];
    EPI_ROW_END
  STREAM_END
}

#define RW_ZRW(p) ((hf*)(p).R)
#define RW_RKV(p) (RW_ZRW(p) + (size_t)M_ALL * 1152)
#define RW_LA(p) ((bf16_t*)(RW_RKV(p) + (size_t)M_ALL * 1152))
#define RW_KK(p) ((hf*)(RW_LA(p) + (size_t)M_ALL * 256))
#define RW_KD(p) (RW_KK(p) + (size_t)M_ALL * 384)
#define RW_KA(p) (RW_KD(p) + (size_t)2 * M_ALL * 384)
#define RW_YR(p) (RW_KA(p) + (size_t)2 * M_ALL * 384)

#define S5_ZH(p) ((hf*)RW_LA(p))
#define S5_YG(p) ((p).W + W_GU0)
#define S5_E(p) ((float2*)((p).R + (size_t)M_ALL * 9728))
#define S5_X(p) S5_E(p)

#define ML_Z(p) ((hf*)(p).R)
#define ML_GL(p) ((float*)(ML_Z(p) + (size_t)M_ALL * 1536))
#define ML_QK(p) ((hf*)(ML_GL(p) + (size_t)M_ALL * 16))
#define ML_DC(p) ((float*)(ML_QK(p) + (size_t)M_ALL * 768))
#define ML_DN(p) (ML_DC(p) + (size_t)4224 * 9216)
#define ML_SC(p) (ML_DN(p) + (size_t)4224 * 96)
#define ML_MP(p) (ML_SC(p) + (size_t)4224 * 2)

__device__ __forceinline__ void ph_z_rw(const P& p, char* lds) {
  EPI_VARS
  hf* ZRW = RW_ZRW(p); bf16_t* LA = RW_LA(p);
  const int Mt = 264;
  STREAM_BEGIN(Mt, 11, 11, (p.U + (size_t)(tm * 128) * 1024), (p.W + W_IN + (size_t)(tn < 9 ? tn * 128 : 2960 + (tn - 9) * 128) * 1024), 1024, 1024, 1024)
    const int m0 = tm * 128;
    if (tn < 9) {
      EPI_BEGIN(m0, tn * 128)
        ZRW[(size_t)row * 1152 + col] = (hf)val;
      EPI_END
    } else {
      EPI_BEGIN(m0, (tn - 9) * 128)
        float o = col < 64 ? tanhf_(val) : (col < 128 ? val : sigmoidf_(val));
        LA[(size_t)row * 256 + col] = f2bf(o);
      EPI_END
    }
  STREAM_END
}
__device__ __forceinline__ void ph_z_s5(const P& p, char* lds, int vb, int nvb) {
  EPI_VARS
  hf* Z = S5_ZH(p);
  const int Mt = 264;
  for (int it = 0;; ++it) {
    int tm, tn; if (!tile_map_v(vb, nvb, it, Mt, 2, 2, tm, tn)) break; const int m0 = tm * 128;
    f32x4 acc[4][4]; ZERO_ACC(acc)
    gemm_main(p.U + (size_t)m0 * 1024, 1024, p.W + W_IN + (size_t)(2704 + tn * 128) * 1024, 1024, 1024, acc, lds);
    EPI_BEGIN(m0, tn * 128)
      Z[(size_t)row * 256 + col] = (hf)val;
    EPI_END
  }
}
__device__ __forceinline__ void ph_z_ml(const P& p, char* lds) {
  EPI_VARS
  hf* Z = ML_Z(p); float* GL = ML_GL(p);
  const int Mt = 264;
  STREAM_BEGIN(Mt, 13, 13, (p.U + (size_t)(tm * 128) * 1024), (p.W + W_IN + (size_t)(1152 + tn * 128) * 1024), 1024, 1024, 1024)
    const int m0 = tm * 128;
    if (tn < 12) {
      EPI_BEGIN(m0, tn * 128)
        Z[(size_t)row * 1536 + col] = (hf)val;
      EPI_END
    } else {
      EPI_BEGIN(m0, 0)
        if (col < 16) GL[(size_t)row * 16 + col] = val;
      EPI_END
    }
  STREAM_END
}

template <int which>
__device__ __forceinline__ void ph_conv(const P& p, int l) {
  constexpr int nch = which == 0 ? 144 : 96;
  constexpr int ldin = which == 0 ? 1152 : 1536;
  constexpr int cbase = which == 0 ? 0 : 1152;
  const hf* Zin = which == 0 ? RW_ZRW(p) : ML_Z(p);
  const float* cw = p.in[12] + (size_t)l * 9 * 1920;
  const unsigned total = (unsigned)(M_ALL / 4) * nch;
  for (unsigned idx = blockIdx.x * NTHR + get_tid(); idx < (total + 63u) / 64u * 64u; idx += gridDim.x * NTHR) {
    const bool act = idx < total;
    const int tg = act ? (int)(idx / (unsigned)nch) : 0; const int ch = act ? (int)(idx % (unsigned)nch) : 0; const int c0 = ch * 8;
    const int m0 = tg * 4;
    float o[4][8];
#pragma unroll
    for (int t = 0; t < 4; ++t)
#pragma unroll
      for (int i = 0; i < 8; ++i) o[t][i] = 0.f;
    const bool lat = m0 < M_LAT;
    const int bb = m0 >> 13, tt = lat ? (m0 & 8191) : ((m0 - M_LAT) & 255);
    const int gr = tt >> 6, gc0 = lat ? (tt & 63) : tt;
    const int ncol = lat ? 64 : 256;
#pragma unroll
    for (int dr = -1; dr <= 1; ++dr) {
      const int rr = gr + dr;
      const bool rowok = lat ? (rr >= 0 && rr < 128) : (dr == 0);
      if (!rowok) continue;
      const float* w = cw + ((dr + 1) * 3) * 1920 + cbase + c0;
      float wv[3][8];
#pragma unroll
      for (int k = 0; k < 3; ++k) { const float4 a = *(const float4*)(w + k * 1920), b = *(const float4*)(w + k * 1920 + 4);
        wv[k][0] = a.x; wv[k][1] = a.y; wv[k][2] = a.z; wv[k][3] = a.w; wv[k][4] = b.x; wv[k][5] = b.y; wv[k][6] = b.z; wv[k][7] = b.w; }
      const int mrow = lat ? ((bb << 13) + rr * 64) : (m0 - gc0);
#pragma unroll
      for (int cc = 0; cc < 6; ++cc) {
        const int col = gc0 - 1 + cc;
        if (col < 0 || col >= ncol) continue;
        const hf8 z = *(const hf8*)(Zin + (size_t)(mrow + col) * ldin + c0);
        float zf[8];
#pragma unroll
        for (int i = 0; i < 8; ++i) zf[i] = (float)z[i];
#pragma unroll
        for (int t = 0; t < 4; ++t) {
          const int k = cc - t;
          if (k >= 0 && k < 3) {
#pragma unroll
            for (int i = 0; i < 8; ++i) o[t][i] += zf[i] * wv[k][i];
          }
        }
      }
    }
#pragma unroll
    for (int t = 0; t < 4; ++t) {
      const int m = m0 + t;
      if (which == 0) {
        const bool isk = act && (c0 >= 384) && (c0 < 768);
        float kkv[8]; float ss = 0.f;
        if (isk) {
          const float* kkw = p.in[18] + (size_t)l * 384 + (c0 - 384);
#pragma unroll
          for (int i = 0; i < 8; ++i) { kkv[i] = o[t][i] * kkw[i]; ss += kkv[i] * kkv[i]; }
        } else {
#pragma unroll
          for (int i = 0; i < 8; ++i) kkv[i] = 0.f;
        }
        ss += __shfl_xor(ss, 1); ss += __shfl_xor(ss, 2); ss += __shfl_xor(ss, 4);
        if (act) {
          hf8 ov;
#pragma unroll
          for (int i = 0; i < 8; ++i) ov[i] = (hf)o[t][i];
          *(hf8*)(RW_RKV(p) + (size_t)m * 1152 + c0) = ov;
          if (isk) {
            const float rn = rsqrtf(fmaxf(ss, 1e-24f));
            hf8 kv;
#pragma unroll
            for (int i = 0; i < 8; ++i) kv[i] = (hf)(kkv[i] * rn);
            *(hf8*)(RW_KK(p) + (size_t)m * 384 + (c0 - 384)) = kv;
          }
        }
      } else if (act) {
        const float sc = c0 >= 384 ? 0.10206207261596575f : 1.f;
        hf8 ov;
#pragma unroll
        for (int i = 0; i < 8; ++i) ov[i] = (hf)(siluf_(o[t][i]) * sc);
        *(hf8*)(ML_QK(p) + (size_t)m * 768 + c0) = ov;
      }
    }
  }
}

__device__ __forceinline__ void ph_lora(const P& p, int l, char* lds) {
  EPI_VARS
  hf* ZRW = RW_ZRW(p); const hf* RKV = RW_RKV(p); const bf16_t* LA = RW_LA(p); const hf* KK = RW_KK(p);
  hf* KD = RW_KD(p); hf* KA = RW_KA(p);
  const int Mt = 264;
  for (int it = 0;; ++it) {
    int tm, q; if (!tile_map(it, Mt, 15, 15, tm, q)) break; const int job = q / 3, tn = q % 3; const int m0 = tm * 128, n0 = tn * 128;
    f32x4 acc[4][4]; ZERO_ACC(acc)
    if (job < 2) {
      const int d = job;
      gemm_small_t<1>(LA + (size_t)m0 * 256, 256, p.W + (d ? W_WUP1 : W_WUP0) + (size_t)n0 * 64, 64, acc, lds);
      const float* w0 = p.in[13] + (size_t)(l * 2 + d) * 384;
#pragma unroll
      for (int m = 0; m < 4; ++m) {
        const int row = m0 + wr * 64 + m * 16 + fr;
#pragma unroll
        for (int n = 0; n < 4; ++n) {
          const int cb = n0 + wc * 64 + n * 16 + fq * 4;
          const float4 wv = *(const float4*)(w0 + cb);
          const float wa[4] = {wv.x, wv.y, wv.z, wv.w};
          hf4 o;
#pragma unroll
          for (int j = 0; j < 4; ++j) { const float e = sigmoidf_(wa[j] + acc[m][n][j]) * 0.6065306597126334f; o[j] = (hf)(1.f - __expf(-e)); }
          *(hf4*)(ZRW + (size_t)row * 1152 + d * 384 + cb) = o;
        }
      }
    } else if (job < 4) {
      const int d = job - 2;
      gemm_small_t<1>(LA + (size_t)m0 * 256 + 64, 256, p.W + (d ? W_AUP1 : W_AUP0) + (size_t)n0 * 64, 64, acc, lds);
      const float* a0 = p.in[15] + (size_t)(l * 2 + d) * 384; const float* kaw = p.in[19] + (size_t)l * 384;
#pragma unroll
      for (int m = 0; m < 4; ++m) {
        const int row = m0 + wr * 64 + m * 16 + fr;
#pragma unroll
        for (int n = 0; n < 4; ++n) {
          const int cb = n0 + wc * 64 + n * 16 + fq * 4;
          const float4 av = *(const float4*)(a0 + cb), kv = *(const float4*)(kaw + cb);
          const float aa[4] = {av.x, av.y, av.z, av.w}, ka_[4] = {kv.x, kv.y, kv.z, kv.w};
          const hf4 k4 = *(const hf4*)(RKV + (size_t)row * 1152 + 384 + cb), kk4 = *(const hf4*)(KK + (size_t)row * 384 + cb);
          hf4 okd, oka;
#pragma unroll
          for (int j = 0; j < 4; ++j) { const float a = sigmoidf_(aa[j] + acc[m][n][j]); okd[j] = (hf)((float)k4[j] * (1.f + (a - 1.f) * ka_[j])); oka[j] = (hf)((float)kk4[j] * a); }
          *(hf4*)(KD + ((size_t)d * M_ALL + row) * 384 + cb) = okd;
          *(hf4*)(KA + ((size_t)d * M_ALL + row) * 384 + cb) = oka;
        }
      }
    } else {
      gemm_small_t<2>(LA + (size_t)m0 * 256 + 128, 256, p.W + W_GUP + (size_t)n0 * 128, 128, acc, lds);
#pragma unroll
      for (int m = 0; m < 4; ++m) {
        const int row = m0 + wr * 64 + m * 16 + fr;
#pragma unroll
        for (int n = 0; n < 4; ++n) {
          const int cb = n0 + wc * 64 + n * 16 + fq * 4;
          hf4 o; o[0] = (hf)acc[m][n][0]; o[1] = (hf)acc[m][n][1]; o[2] = (hf)acc[m][n][2]; o[3] = (hf)acc[m][n][3];
          *(hf4*)(ZRW + (size_t)row * 1152 + 768 + cb) = o;
        }
      }
    }
  }
}

typedef float f32x2 __attribute__((ext_vector_type(2)));
#define RW_CH 16
#define RW_BUF 21504
__device__ __forceinline__ void rw_cvt_store(char* dst, uint4 q) {
  const hf8 h = __builtin_bit_cast(hf8, q);
  f32x4 a, b;
  a[0] = (float)h[0]; a[1] = (float)h[1]; a[2] = (float)h[2]; a[3] = (float)h[3];
  b[0] = (float)h[4]; b[1] = (float)h[5]; b[2] = (float)h[6]; b[3] = (float)h[7];
  *(f32x4*)dst = a; *(f32x4*)(dst + 16) = b;
}
__device__ __forceinline__ void ph_rwscan(const P& p, char* lds) {
  const hf* ZRW = RW_ZRW(p); hf* RKV = RW_RKV(p); const hf* KK = RW_KK(p);
  const int tid = get_tid(), lane = tid & 63, wid = tid >> 6;
  char* pbuf = lds + 3 * RW_BUF + wid * 2048;
  char* ybuf = lds + 3 * RW_BUF + 8192;
  for (int t = blockIdx.x; t < 192; t += gridDim.x) {
    const int rqq = t & 3, h = (t >> 2) % 6, b = (t / 24) & 3, d = t / 96;
    const int rsub = lane >> 4, g = lane & 15; const int rl = wid * 4 + rsub;
    const int sgn = d ? -1 : 1;
    const bool grpA = tid < 128; const int t2 = tid & 127;
    const int sstep = t2 >> 3, sseg = t2 & 7;
    const hf* g0 = grpA ? (RKV + h * 64 + sseg * 8) : (RW_KD(p) + (size_t)d * M_ALL * 384 + h * 64 + sseg * 8);
    const size_t ld0 = grpA ? 1152 : 384;
    const hf* g1 = grpA ? (KK + h * 64 + sseg * 8) : (RW_KA(p) + (size_t)d * M_ALL * 384 + h * 64 + sseg * 8);
    const hf* g2 = grpA ? (ZRW + d * 384 + h * 64 + sseg * 8) : (RKV + 768 + h * 64 + rqq * 16 + (t2 & 1) * 8);
    const int s2 = grpA ? sstep : (t2 >> 1);
    const bool has2 = grpA || t2 < 32;
    const int o0 = (grpA ? 0 : 12288) + sstep * 256 + sseg * 32;
    const int o1 = (grpA ? 4096 : 16384) + sstep * 256 + sseg * 32;
    const int o2 = grpA ? (8192 + sstep * 256 + sseg * 32) : (20480 + (t2 >> 1) * 64 + (t2 & 1) * 32);
    hf* g_y = d == 0 ? (RKV + 384 + h * 64 + rqq * 16 + (tid & 1) * 8) : (RW_YR(p) + h * 64 + rqq * 16 + (tid & 1) * 8);
    const int ldy = d == 0 ? 1152 : 384;
    uint4 q0, q1, q2;
#define RW_M0(pp) ((pp) < 256 ? (M_LAT + b * 256 + (d ? 255 - (pp) : (pp))) : (b * 8192 + (d ? 8447 - (pp) : (pp) - 256)))
#define RW_GLOAD(c) { const int mb_ = RW_M0((c) * RW_CH); const size_t mm = (size_t)(mb_ + sgn * sstep); \
      q0 = *(const uint4*)(g0 + mm * ld0); q1 = *(const uint4*)(g1 + mm * 384); \
      if (has2) { const size_t m2 = (size_t)(mb_ + sgn * s2); q2 = *(const uint4*)(g2 + m2 * 1152); } }
#define RW_SSTORE(c) { char* bb_ = lds + ((c) % 3) * RW_BUF; rw_cvt_store(bb_ + o0, q0); rw_cvt_store(bb_ + o1, q1); if (has2) rw_cvt_store(bb_ + o2, q2); }
    f32x2 S01 = (f32x2){0.f, 0.f}, S23 = (f32x2){0.f, 0.f};
    RW_GLOAD(0) RW_SSTORE(0)
    RW_GLOAD(1) RW_SSTORE(1)
    __syncthreads();
    const int NCH = 8448 / RW_CH;
    for (int c = 0; c < NCH; ++c) {
      if (c + 2 < NCH) RW_GLOAD(c + 2)
      if (c > 0 && tid < 32) {
        const int mb_ = RW_M0((c - 1) * RW_CH); const size_t mv = (size_t)(mb_ + sgn * (tid >> 1));
        *(uint4*)(g_y + mv * ldy) = *(const uint4*)(ybuf + ((c - 1) & 1) * 512 + tid * 16);
      }
      const char* cb = lds + (c % 3) * RW_BUF + g * 16;
      const char* vb = lds + (c % 3) * RW_BUF + 20480 + rl * 4;
      f32x4 R4[RW_CH], K4[RW_CH], D4[RW_CH], KD4[RW_CH], KA4[RW_CH]; float VV[RW_CH];
#define RW_LDS(s_) { R4[s_] = *(const f32x4*)(cb + (s_) * 256); K4[s_] = *(const f32x4*)(cb + 4096 + (s_) * 256); D4[s_] = *(const f32x4*)(cb + 8192 + (s_) * 256); \
        KD4[s_] = *(const f32x4*)(cb + 12288 + (s_) * 256); KA4[s_] = *(const f32x4*)(cb + 16384 + (s_) * 256); VV[s_] = *(const float*)(vb + (s_) * 64); }
      RW_LDS(0) RW_LDS(1) RW_LDS(2)
#pragma unroll
      for (int s = 0; s < RW_CH; ++s) {
        if (s + 3 < RW_CH) RW_LDS(s + 3)
        const f32x4 r4 = R4[s], k4 = K4[s], d4 = D4[s], kd4 = KD4[s], ka4 = KA4[s]; const float vv = VV[s];
        const f32x2 k01 = {k4[0], k4[1]}, k23 = {k4[2], k4[3]}, d01 = {d4[0], d4[1]}, d23 = {d4[2], d4[3]};
        const f32x2 kd01 = {kd4[0], kd4[1]}, kd23 = {kd4[2], kd4[3]}, ka01 = {ka4[0], ka4[1]}, ka23 = {ka4[2], ka4[3]};
        const f32x2 r01 = {r4[0], r4[1]}, r23 = {r4[2], r4[3]};
        const f32x2 sa2 = __builtin_elementwise_fma(S23, k23, S01 * k01);
        float sa = sa2[0] + sa2[1];
        sa = rowsum16(sa);
        const f32x2 vv2 = {vv, vv}; const f32x2 nsa = {-sa, -sa};
        f32x2 T01 = __builtin_elementwise_fma(-S01, d01, S01), T23 = __builtin_elementwise_fma(-S23, d23, S23);
        T01 = __builtin_elementwise_fma(vv2, kd01, T01); T23 = __builtin_elementwise_fma(vv2, kd23, T23);
        S01 = __builtin_elementwise_fma(nsa, ka01, T01); S23 = __builtin_elementwise_fma(nsa, ka23, T23);
        const f32x2 y2 = __builtin_elementwise_fma(S23, r23, S01 * r01);
        *(float*)(pbuf + (((s & 7) * 4 + rsub) * 16 + g) * 4) = y2[0] + y2[1];
        if ((s & 7) == 7) {
          if (lane < 32) {
            const char* pr = pbuf + lane * 64;
            const f32x4 a0 = *(const f32x4*)(pr), a1 = *(const f32x4*)(pr + 16), a2 = *(const f32x4*)(pr + 32), a3 = *(const f32x4*)(pr + 48);
            const f32x4 sm = (a0 + a1) + (a2 + a3);
            const float y = (sm[0] + sm[1]) + (sm[2] + sm[3]);
            *(hf*)(ybuf + (c & 1) * 512 + (((s >> 3) * 8 + (lane >> 2)) * 16 + wid * 4 + (lane & 3)) * 2) = (hf)y;
          }
        }
      }
      if (c + 2 < NCH) RW_SSTORE(c + 2)
      __syncthreads();
    }
    if (tid < 32) {
      const int mb_ = RW_M0((NCH - 1) * RW_CH); const size_t mv = (size_t)(mb_ + sgn * (tid >> 1));
      *(uint4*)(g_y + mv * ldy) = *(const uint4*)(ybuf + ((NCH - 1) & 1) * 512 + tid * 16);
    }
    __syncthreads();
  }
}

__device__ __forceinline__ void ph_rwpost(const P& p, int l) {
  const hf* ZRW = RW_ZRW(p); const hf* RKV = RW_RKV(p); const hf* YR = RW_YR(p);
  const int lane = get_tid() & 63, wid = get_tid() >> 6;
  const int nw = gridDim.x * 4;
  for (int t = blockIdx.x * 4 + wid; t < M_ALL * 6; t += nw) {
    const int m = t / 6, h = t % 6; const int c = h * 64 + lane;
    const float ys = (float)RKV[(size_t)m * 1152 + 384 + c] + (float)YR[(size_t)m * 384 + c];
    const float mean = wavesum(ys) * (1.f / 64.f);
    const float xc = ys - mean;
    const float var = wavesum(xc * xc) * (1.f / 64.f);
    float y = xc * rsqrtf(var + 64e-5f) * p.in[21][(size_t)l * 384 + c] + p.in[22][(size_t)l * 384 + c];
    const float r = (float)RKV[(size_t)m * 1152 + c], v = (float)RKV[(size_t)m * 1152 + 768 + c];
    const float rk = p.in[20][(size_t)l * 384 + c];
    const float kd0 = (float)RW_KD(p)[(size_t)m * 384 + c], kd1 = (float)RW_KD(p)[((size_t)M_ALL + m) * 384 + c];
    const float bs = wavesum(r * (kd0 + kd1) * rk);
    y = (y + bs * v) * (float)ZRW[(size_t)m * 1152 + 768 + c];
    p.Y[(size_t)m * 1024 + c] = f2bf(y);
  }
}

struct S5C { float ar, ai; float br[16], bi[16]; };
__device__ __forceinline__ void s5_consts(const P& p, int l, int d, int g, int n, S5C& c) {
  const int ig = (l * 2 + d) * 16 + g;
  const float lr = fminf(p.in[23][(size_t)ig * 64 + n], -1e-4f), li = p.in[24][(size_t)ig * 64 + n];
  const float dt = expf(p.in[25][ig]);
  const float mag = expf(lr * dt);
  c.ar = mag * cosf(li * dt); c.ai = mag * sinf(li * dt);
  const float nr = c.ar - 1.f, ni = c.ai; const float den = 1.f / (lr * lr + li * li);
  const float cr = (nr * lr + ni * li) * den, ci = (ni * lr - nr * li) * den;
  const float* bre = p.in[26] + ((size_t)ig * 64 + n) * 16; const float* bim = p.in[27] + ((size_t)ig * 64 + n) * 16;
#pragma unroll
  for (int h = 0; h < 16; ++h) { const float xr = bre[h], xi = bim[h]; c.br[h] = cr * xr - ci * xi; c.bi[h] = cr * xi + ci * xr; }
}
__device__ __forceinline__ int s5_m0(int b, int tc) { return tc < 128 ? b * 8192 + tc * 64 : M_LAT + b * 256 + (tc - 128) * 64; }
__device__ __forceinline__ int chain_pos(int d, int tc) { return d == 0 ? (tc < 128 ? tc + 4 : tc - 128) : (tc < 128 ? 131 - tc : 131 - tc); }
__device__ __forceinline__ void ph_s5_pass(const P& p, int l, int pass, char* lds, int vb, int nvb) {
  const int tid = get_tid(), lane = tid & 63, wid = tid >> 6, fr = lane & 15, fq = lane >> 4;
  float* ub = (float*)(lds + wid * 8448);
  char* xs = lds + wid * 8448 + 4096;
  const hf* Z = S5_ZH(p); float2* E = S5_E(p); const float2* X = S5_X(p); bf16_t* YG = S5_YG(p);
  const int nw = nvb * 4;
  for (int t = vb * 4 + wid; t < 4 * 132 * 16; t += nw) {
    const int g = t & 15, tc = (t >> 4) % 132, b = t / (16 * 132);
    const int m0 = s5_m0(b, tc);
#pragma unroll
    for (int i = 0; i < 4; ++i) { const int e = lane + i * 64; const int tok = e >> 2, q = e & 3;
      const hf4 zv = *(const hf4*)(Z + (size_t)(m0 + tok) * 256 + g * 16 + q * 4);
      *(float4*)(ub + tok * 16 + q * 4) = make_float4((float)zv[0], (float)zv[1], (float)zv[2], (float)zv[3]); }
    f32x4 yacc[4];
#pragma unroll
    for (int i = 0; i < 4; ++i) yacc[i] = (f32x4){0.f, 0.f, 0.f, 0.f};
    for (int d = 0; d < 2; ++d) {
      S5C c; s5_consts(p, l, d, g, lane, c);
      const int cp = chain_pos(d, tc);
      const size_t sidx = (((size_t)(d * 4 + b) * 132 + cp) * 16 + g) * 64 + lane;
      float xr = 0.f, xi = 0.f;
      hf8 cf[4];
      if (pass == 3) {
        float2 x0 = X[sidx]; xr = x0.x; xi = x0.y;
        const int ig = (l * 2 + d) * 16 + g;
#pragma unroll
        for (int ks = 0; ks < 4; ++ks) {
          const int c0 = ks * 32 + fq * 8;
          const float* src_ = (c0 < 64 ? p.in[28] : p.in[29]) + ((size_t)ig * 16 + fr) * 64 + (c0 & 63);
          const float sg = c0 < 64 ? 1.f : -1.f;
          const float4 v0 = *(const float4*)src_, v1 = *(const float4*)(src_ + 4);
          cf[ks][0] = (hf)(sg * v0.x); cf[ks][1] = (hf)(sg * v0.y); cf[ks][2] = (hf)(sg * v0.z); cf[ks][3] = (hf)(sg * v0.w);
          cf[ks][4] = (hf)(sg * v1.x); cf[ks][5] = (hf)(sg * v1.y); cf[ks][6] = (hf)(sg * v1.z); cf[ks][7] = (hf)(sg * v1.w);
        }
      }
#pragma unroll 1
      for (int jb = 0; jb < 4; ++jb) {
        const int tb = d ? 3 - jb : jb;
#pragma unroll 4
        for (int jj = 0; jj < 16; ++jj) {
          const int t16 = d ? 15 - jj : jj;
          const float* u = ub + (tb * 16 + t16) * 16;
          float br = 0.f, bi = 0.f;
#pragma unroll
          for (int h = 0; h < 16; ++h) { const float uv = u[h]; br += c.br[h] * uv; bi += c.bi[h] * uv; }
          const float nr = c.ar * xr - c.ai * xi + br, ni = c.ar * xi + c.ai * xr + bi;
          xr = nr; xi = ni;
          if (pass == 3) { *(hf*)(xs + t16 * 272 + lane * 2) = (hf)xr; *(hf*)(xs + t16 * 272 + 128 + lane * 2) = (hf)xi; }
        }
        if (pass == 3) {
          f32x4 acc = (f32x4){0.f, 0.f, 0.f, 0.f};
#pragma unroll
          for (int ks = 0; ks < 4; ++ks) {
            const hf8 af = *(const hf8*)(xs + fr * 272 + ks * 64 + fq * 16);
            acc = __builtin_amdgcn_mfma_f32_16x16x32_f16(af, cf[ks], acc, 0, 0, 0);
          }
#pragma unroll
          for (int i = 0; i < 4; ++i) if (i == tb) yacc[i] += acc;
        }
      }
      if (pass == 1) E[sidx] = make_float2(xr, xi);
    }
    if (pass == 3) {
      const float dsk = p.in[30][(size_t)l * 256 + g * 16 + fr];
#pragma unroll
      for (int i = 0; i < 4; ++i)
#pragma unroll
        for (int j = 0; j < 4; ++j) {
          const int tok = i * 16 + fq * 4 + j;
          float y = yacc[i][j] + dsk * ub[tok * 16 + fr];
          const float inner = 0.7978845608028654f * (y + 0.044715f * y * y * y);
          y = 0.5f * y * (1.f + tanhf_(inner));
          YG[(size_t)(m0 + tok) * 256 + g * 16 + fr] = f2bf(y);
        }
    }
  }
}
__device__ __forceinline__ void ph_s5_carry(const P& p, int l, int vb, int nvb) {
  float2* E = S5_E(p); float2* X = S5_X(p);
  for (int t = vb * NTHR + get_tid(); t < 8192; t += nvb * NTHR) {
    const int n = t & 63, g = (t >> 6) & 15, b = (t >> 10) & 3, d = t >> 12;
    const int ig = (l * 2 + d) * 16 + g;
    const float lr = fminf(p.in[23][(size_t)ig * 64 + n], -1e-4f), li = p.in[24][(size_t)ig * 64 + n];
    const float dt = expf(p.in[25][ig]);
    const float mag = expf(lr * dt * 64.f);
    float ar = expf(lr * dt) * cosf(li * dt), ai = expf(lr * dt) * sinf(li * dt);
#pragma unroll
    for (int i = 0; i < 6; ++i) { const float r2 = ar * ar - ai * ai, i2 = 2.f * ar * ai; ar = r2; ai = i2; }
    (void)mag;
    float xr = 0.f, xi = 0.f;
    const size_t base = (((size_t)(d * 4 + b) * 132) * 16 + g) * 64 + n;
    for (int cp0 = 0; cp0 < 132; cp0 += 12) {
      float2 ev[12];
#pragma unroll
      for (int u = 0; u < 12; ++u) ev[u] = E[base + (size_t)(cp0 + u) * 1024];
#pragma unroll
      for (int u = 0; u < 12; ++u) {
        X[base + (size_t)(cp0 + u) * 1024] = make_float2(xr, xi);
        const float nr = ar * xr - ai * xi + ev[u].x, ni = ar * xi + ai * xr + ev[u].y;
        xr = nr; xi = ni;
      }
    }
  }
}
__device__ __forceinline__ void ph_glu(const P& p, int l, char* lds, int vb, int nvb) {
  EPI_VARS
  const bf16_t* YG = S5_YG(p);
  const int Mt = 264;
  const float* gb = p.in[32] + (size_t)l * 256;
  for (int it = 0;; ++it) {
    int tm, tn; if (!tile_map_v(vb, nvb, it, Mt, 2, 2, tm, tn)) break; const int m0 = tm * 128, n0 = tn * 128;
    f32x4 acc[4][4]; ZERO_ACC(acc)
    gemm_main(YG + (size_t)m0 * 256, 256, p.W + W_GLU + (size_t)n0 * 256, 256, 256, acc, lds);
    EPI_BEGIN(m0, n0)
      const float y = bf2f(YG[(size_t)row * 256 + col]);
      p.Y[(size_t)row * 1024 + 384 + col] = f2bf(y * sigmoidf_(val + gb[col]));
    EPI_END
  }
}

__device__ __forceinline__ void sub_barrier(unsigned* cnt, unsigned target) {
  asm volatile("s_waitcnt vmcnt(0)" ::: "memory");
  __syncthreads();
  if (__builtin_amdgcn_workitem_id_x() == 0) {
    __builtin_amdgcn_fence(__ATOMIC_RELEASE, "agent");
    asm volatile("s_waitcnt vmcnt(0)" ::: "memory");
    __hip_atomic_fetch_add(cnt, 1u, __ATOMIC_RELAXED, __HIP_MEMORY_SCOPE_AGENT);
    unsigned sp = 0;
    while (__hip_atomic_load(cnt, __ATOMIC_RELAXED, __HIP_MEMORY_SCOPE_AGENT) < target) { __builtin_amdgcn_s_sleep(2); if (++sp > (1u << 22)) break; }
    __builtin_amdgcn_fence(__ATOMIC_ACQUIRE, "agent");
    asm volatile("s_waitcnt vmcnt(0)" ::: "memory");
  }
  __syncthreads();
}
__device__ __forceinline__ void ph_s5_stage(const P& p, int l, char* lds, int vb, int nvb) {
  unsigned* cnt = p.bar + 3584;
  const unsigned base = (unsigned)(l * 4) * (unsigned)nvb;
  ph_z_s5(p, lds, vb, nvb);            sub_barrier(cnt, base + 1u * nvb);
  ph_s5_pass(p, l, 1, lds, vb, nvb);   sub_barrier(cnt, base + 2u * nvb);
  ph_s5_carry(p, l, vb, nvb);          sub_barrier(cnt, base + 3u * nvb);
  ph_s5_pass(p, l, 3, lds, vb, nvb);   sub_barrier(cnt, base + 4u * nvb);
  ph_glu(p, l, lds, vb, nvb);
}

__device__ __forceinline__ float logsigf_(float x) { return fminf(x, 0.f) - log1pf(__expf(-fabsf(x))); }
__device__ __forceinline__ void ml_gates(const P& p, int l, int d, int h, int m0, int lane, float& bcum, float& ic) {
  const int tok = d ? 63 - lane : lane;
  const float* gl = ML_GL(p) + (size_t)(m0 + tok) * 16;
  const float* gb = p.in[33] + (size_t)(l * 2 + d) * 8;
  ic = gl[d * 8 + h] + gb[h];
  float f = logsigf_(gl[d * 8 + 4 + h] + gb[4 + h]);
#pragma unroll
  for (int o = 1; o < 64; o <<= 1) { float v = __shfl_up(f, o); if (lane >= o) f += v; }
  bcum = f;
}
__device__ __forceinline__ void ml_gates2(const P& p, int l, int d, int h, int m0, int lane, float& bc, float& ic, float& tot) {
  const float* gl = ML_GL(p) + (size_t)(m0 + lane) * 16;
  const float* gb = p.in[33] + (size_t)(l * 2 + d) * 8;
  ic = gl[d * 8 + h] + gb[h];
  const float f0 = logsigf_(gl[d * 8 + 4 + h] + gb[4 + h]);
  float f = f0;
#pragma unroll
  for (int o = 1; o < 64; o <<= 1) { float v = __shfl_up(f, o); if (lane >= o) f += v; }
  tot = __shfl(f, 63);
  bc = d ? (tot - f + f0) : f;
}
#define MLQ 208
#define MLS 144
__device__ __forceinline__ void ph_ml_a(const P& p, int l, char* lds) {
  char* vt = lds; char* kt = lds + 13824; float* wg = (float*)(lds + 27648);
  const int tid = get_tid(), lane = tid & 63, wid = tid >> 6, fr = lane & 15, fq = lane >> 4;
  const hf* QK = ML_QK(p); const hf* Z = ML_Z(p);
  for (int t = blockIdx.x; t < 4224; t += gridDim.x) {
    const int tc = t % 132, h = (t / 132) & 3, b = (t / 528) & 3, d = t / 2112;
    const int m0 = s5_m0(b, tc); const int cp = chain_pos(d, tc);
    const size_t task = ((size_t)((d * 4 + b) * 4 + h)) * 132 + cp;
    if (wid == 0) {
      float bc, ic, tot; ml_gates2(p, l, d, h, m0, lane, bc, ic, tot);
      const float lw = tot - bc + ic;
      float mx = lw;
      for (int o = 32; o > 0; o >>= 1) mx = fmaxf(mx, __shfl_xor(mx, o));
      wg[lane] = __expf(lw - mx);
      if (lane == 0) { ML_SC(p)[task * 2] = mx; ML_SC(p)[task * 2 + 1] = tot; }
    }
    __syncthreads();
    for (int e = tid; e < 64 * 12; e += NTHR) {
      const int tok = e & 63, q = e >> 6;
      const hf8 kv = *(const hf8*)(QK + (size_t)(m0 + tok) * 768 + 384 + h * 96 + q * 8);
      const hf8 vv = *(const hf8*)(Z + (size_t)(m0 + tok) * 1536 + 768 + h * 96 + q * 8);
      const float w = wg[tok];
#pragma unroll
      for (int i = 0; i < 8; ++i) {
        *(hf*)(kt + (q * 8 + i) * MLS + tok * 2) = kv[i];
        *(hf*)(vt + (q * 8 + i) * MLS + tok * 2) = (hf)((float)vv[i] * w);
      }
    }
    __syncthreads();
    float* dc = ML_DC(p) + task * 9216;
#pragma unroll 1
    for (int bi = 0; bi < 9; ++bi) {
      const int idx = wid * 9 + bi; const int mb = idx / 6, nb = idx % 6;
      f32x4 acc = (f32x4){0.f, 0.f, 0.f, 0.f};
#pragma unroll
      for (int ks = 0; ks < 2; ++ks) {
        const hf8 af = *(const hf8*)(vt + (mb * 16 + fr) * MLS + ks * 64 + fq * 16);
        const hf8 bf = *(const hf8*)(kt + (nb * 16 + fr) * MLS + ks * 64 + fq * 16);
        acc = __builtin_amdgcn_mfma_f32_16x16x32_f16(af, bf, acc, 0, 0, 0);
      }
#pragma unroll
      for (int j = 0; j < 4; ++j) dc[(mb * 16 + fq * 4 + j) * 96 + nb * 16 + fr] = acc[j];
    }
    if (tid < 96) {
      float s = 0.f;
      for (int j = 0; j < 64; ++j) s += wg[j] * (float)*(const hf*)(kt + tid * MLS + j * 2);
      ML_DN(p)[task * 96 + tid] = s;
    }
    __syncthreads();
  }
}
__device__ __forceinline__ void ph_ml_b(const P& p) {
  float* DC = ML_DC(p); float* DN = ML_DN(p); const float* SC = ML_SC(p); float* MP = ML_MP(p);
  for (int t = blockIdx.x * NTHR + get_tid(); t < 32 * 9312; t += gridDim.x * NTHR) {
    const int chain = t / 9312, e = t % 9312;
    float cur = 0.f, mprev = 0.f;
    for (int cp0 = 0; cp0 < 132; cp0 += 12) {
      float dl[12], ml_[12], bl_[12];
#pragma unroll
      for (int u = 0; u < 12; ++u) {
        const size_t task = (size_t)chain * 132 + cp0 + u;
        dl[u] = e < 9216 ? DC[task * 9216 + e] : DN[task * 96 + (e - 9216)];
        ml_[u] = SC[task * 2]; bl_[u] = SC[task * 2 + 1];
      }
#pragma unroll
      for (int u = 0; u < 12; ++u) {
        const size_t task = (size_t)chain * 132 + cp0 + u;
        float* slot = e < 9216 ? DC + task * 9216 + e : DN + task * 96 + (e - 9216);
        *slot = cur;
        if (e == 0) MP[task] = mprev;
        const float mnew = fmaxf(bl_[u] + mprev, ml_[u]);
        cur = __expf(bl_[u] + mprev - mnew) * cur + __expf(ml_[u] - mnew) * dl[u];
        mprev = mnew;
      }
    }
  }
}
__device__ __forceinline__ void ph_ml_c(const P& p, int l, char* lds) {
  char* qs = lds; char* ks = lds + 13312; char* vt = lds + 26624; char* cs = lds + 40448; char* ps = lds + 60416;
  float* fl = (float*)(lds + 69632);
  float* bc = fl; float* icv = fl + 128; float* mr = fl + 256; float* inter = fl + 320; float* den = fl + 384; float* nq = fl + 448; float* nst = fl + 512;
  const int tid = get_tid(), lane = tid & 63, wid = tid >> 6, fr = lane & 15, fq = lane >> 4;
  const hf* QK = ML_QK(p); const hf* Z = ML_Z(p);
  const int ntc = (l == 1) ? 128 : 132;
  for (int t = blockIdx.x; t < 16 * ntc; t += gridDim.x) {
    const int tc = t % ntc, h = (t / ntc) & 3, b = t / (4 * ntc);
    const int m0 = s5_m0(b, tc);
    for (int e = tid; e < 64 * 12; e += NTHR) {
      const int tok = e & 63, q = e >> 6;
      *(hf8*)(qs + tok * MLQ + q * 16) = *(const hf8*)(QK + (size_t)(m0 + tok) * 768 + h * 96 + q * 8);
      *(hf8*)(ks + tok * MLQ + q * 16) = *(const hf8*)(QK + (size_t)(m0 + tok) * 768 + 384 + h * 96 + q * 8);
      const hf8 vv = *(const hf8*)(Z + (size_t)(m0 + tok) * 1536 + 768 + h * 96 + q * 8);
#pragma unroll
      for (int i = 0; i < 8; ++i) *(hf*)(vt + (q * 8 + i) * MLS + tok * 2) = vv[i];
    }
    if (wid < 2) { float bcv, ic, tot; ml_gates2(p, l, wid, h, m0, lane, bcv, ic, tot); bc[wid * 64 + lane] = bcv; icv[wid * 64 + lane] = ic; }
    f32x4 hs[6];
#pragma unroll
    for (int n = 0; n < 6; ++n) hs[n] = (f32x4){0.f, 0.f, 0.f, 0.f};
    for (int d = 0; d < 2; ++d) {
      const int cp = chain_pos(d, tc);
      const size_t task = ((size_t)((d * 4 + b) * 4 + h)) * 132 + cp;
      const float mprev = ML_MP(p)[task];
      __syncthreads();
      {
        const float* cg = ML_DC(p) + task * 9216;
        for (int e = tid; e < 96 * 24; e += NTHR) {
          const int v = e / 24, q = e % 24;
          const float4 c4 = *(const float4*)(cg + v * 96 + q * 4);
          hf4 o; o[0] = (hf)c4.x; o[1] = (hf)c4.y; o[2] = (hf)c4.z; o[3] = (hf)c4.w;
          *(hf4*)(cs + v * MLQ + q * 8) = o;
        }
        if (tid < 96) nst[tid] = ML_DN(p)[task * 96 + tid];
      }
      const float* bcd = bc + d * 64; const float* icd = icv + d * 64;
      if (tid < 64) {
        const int j = tid; const float bj = bcd[j];
        float mx = bj + mprev;
        if (d == 0) { for (int s = 0; s <= j; ++s) mx = fmaxf(mx, bj - bcd[s] + icd[s]); }
        else { for (int s = j; s < 64; ++s) mx = fmaxf(mx, bj - bcd[s] + icd[s]); }
        mr[j] = mx; inter[j] = __expf(bj + mprev - mx);
      }
      __syncthreads();
      if (tid < 64) {
        float s1 = 0.f;
        for (int k = 0; k < 96; ++k) s1 += nst[k] * (float)*(const hf*)(qs + tid * MLQ + k * 2);
        nq[tid] = s1;
      }
      {
        f32x4 sacc[4];
#pragma unroll
        for (int n = 0; n < 4; ++n) sacc[n] = (f32x4){0.f, 0.f, 0.f, 0.f};
#pragma unroll
        for (int kk = 0; kk < 3; ++kk) {
          const hf8 af = *(const hf8*)(qs + (wid * 16 + fr) * MLQ + kk * 64 + fq * 16);
#pragma unroll
          for (int n = 0; n < 4; ++n) {
            const hf8 bf = *(const hf8*)(ks + (n * 16 + fr) * MLQ + kk * 64 + fq * 16);
            sacc[n] = __builtin_amdgcn_mfma_f32_16x16x32_f16(af, bf, sacc[n], 0, 0, 0);
          }
        }
        float rs[4] = {0.f, 0.f, 0.f, 0.f};
#pragma unroll
        for (int n = 0; n < 4; ++n) {
          const int s = n * 16 + fr; const float bs = bcd[s] - icd[s];
#pragma unroll
          for (int jj = 0; jj < 4; ++jj) {
            const int j = wid * 16 + fq * 4 + jj;
            const bool valid = d == 0 ? (s <= j) : (s >= j);
            const float val = valid ? sacc[n][jj] * __expf(bcd[j] - bs - mr[j]) : 0.f;
            rs[jj] += val;
            *(hf*)(ps + j * MLS + s * 2) = (hf)val;
          }
        }
        __syncthreads();
#pragma unroll
        for (int jj = 0; jj < 4; ++jj) {
          const float r = rowsum16(rs[jj]);
          const int j = wid * 16 + fq * 4 + jj;
          if (fr == 0) den[j] = inter[j] * nq[j] + r;
        }
      }
      f32x4 acc[6];
#pragma unroll
      for (int n = 0; n < 6; ++n) acc[n] = (f32x4){0.f, 0.f, 0.f, 0.f};
#pragma unroll
      for (int kk = 0; kk < 3; ++kk) {
        const hf8 af = *(const hf8*)(qs + (wid * 16 + fr) * MLQ + kk * 64 + fq * 16);
#pragma unroll
        for (int n = 0; n < 6; ++n) {
          const hf8 bf = *(const hf8*)(cs + (n * 16 + fr) * MLQ + kk * 64 + fq * 16);
          acc[n] = __builtin_amdgcn_mfma_f32_16x16x32_f16(af, bf, acc[n], 0, 0, 0);
        }
      }
#pragma unroll
      for (int jj = 0; jj < 4; ++jj) { const float it = inter[wid * 16 + fq * 4 + jj];
#pragma unroll
        for (int n = 0; n < 6; ++n) acc[n][jj] *= it; }
#pragma unroll
      for (int kk = 0; kk < 2; ++kk) {
        const hf8 af = *(const hf8*)(ps + (wid * 16 + fr) * MLS + kk * 64 + fq * 16);
#pragma unroll
        for (int n = 0; n < 6; ++n) {
          const hf8 bf = *(const hf8*)(vt + (n * 16 + fr) * MLS + kk * 64 + fq * 16);
          acc[n] = __builtin_amdgcn_mfma_f32_16x16x32_f16(af, bf, acc[n], 0, 0, 0);
        }
      }
      __syncthreads();
#pragma unroll
      for (int jj = 0; jj < 4; ++jj) {
        const int j = wid * 16 + fq * 4 + jj;
        const float dn = 1.f / fmaxf(fabsf(den[j]), __expf(-mr[j]));
#pragma unroll
        for (int n = 0; n < 6; ++n) hs[n][jj] += acc[n][jj] * dn;
      }
    }
#pragma unroll
    for (int jj = 0; jj < 4; ++jj) {
      const int m = m0 + wid * 16 + fq * 4 + jj;
      const hf* op = Z + (size_t)m * 1536 + 1152 + h * 96 + fr;
      float x[6]; float s = 0.f;
#pragma unroll
      for (int n = 0; n < 6; ++n) { x[n] = sigmoidf_((float)op[n * 16]) * hs[n][jj]; s += x[n]; }
      s = rowsum16(s);
      const float mean = s * (1.f / 96.f);
      float q = 0.f;
#pragma unroll
      for (int n = 0; n < 6; ++n) { x[n] -= mean; q += x[n] * x[n]; }
      q = rowsum16(q);
      const float rsd = rsqrtf(q * (1.f / 96.f) + 1e-5f);
      const float* ng = p.in[34] + (size_t)l * 384 + h * 96 + fr;
      bf16_t* yp = p.Y + (size_t)m * 1024 + 640 + h * 96 + fr;
#pragma unroll
      for (int n = 0; n < 6; ++n) yp[n * 16] = f2bf(x[n] * rsd * ng[n * 16]);
    }
    __syncthreads();
  }
}

#define MG_YM(p) ((bf16_t*)(p).R)
#define MG_G3(p) (MG_YM(p) + (size_t)M_ALL * 1024)
__device__ __forceinline__ void ph_gates(const P& p, int l, int Mt, char* lds) {
  EPI_VARS
  bf16_t* G3 = MG_G3(p);
  const float* gbias = p.in[38] + (size_t)l * 3072;
  STREAM_BEGIN(Mt, 24, 8, (p.U + (size_t)(tm * 128) * 1024), (p.W + W_IN + (size_t)(3216 + tn * 128) * 1024), 1024, 1024, 1024)
    const int m0 = tm * 128, n0 = tn * 128;
    EPI_BEGIN(m0, n0)
      G3[(size_t)row * 3072 + col] = f2bf(sigmoidf_(val + gbias[col]));
    EPI_END
  STREAM_END
}
__device__ __forceinline__ void ph_merge(const P& p, int l, int Mt, char* lds) {
  EPI_VARS
  bf16_t* YM = MG_YM(p); const bf16_t* G3 = MG_G3(p);
  const int ntile = Mt * 16;
  for (int it = 0;; ++it) {
    int tm, tn; if (!tile_map(it, Mt, 16, 8, tm, tn)) break; const int m0 = tm * 128, n0 = tn * 64;
    f32x4 yacc[4][2];
#pragma unroll
    for (int m = 0; m < 4; ++m) { yacc[m][0] = (f32x4){0.f, 0.f, 0.f, 0.f}; yacc[m][1] = (f32x4){0.f, 0.f, 0.f, 0.f}; }
#pragma unroll 1
    for (int br = 0; br < 3; ++br) {
      f32x4 acc[4][2];
#pragma unroll
      for (int m = 0; m < 4; ++m) { acc[m][0] = (f32x4){0.f, 0.f, 0.f, 0.f}; acc[m][1] = (f32x4){0.f, 0.f, 0.f, 0.f}; }
      const int kb = br == 1 ? 256 : 384; const int yoff = br == 0 ? 0 : (br == 1 ? 384 : 640);
      const int woff = br == 0 ? W_UPRW : (br == 1 ? W_UPS5 : W_UPML);
      gemm_main_t<2>(p.Y + (size_t)m0 * 1024 + yoff, 1024, p.W + woff + (size_t)n0 * kb, kb, kb, acc, lds);
      EPI_ROW_BEGIN(m0)
        const bf16_t* gp = G3 + (size_t)row * 3072 + br * 1024 + n0 + wc * 32 + fr;
#pragma unroll
        for (int n = 0; n < 2; ++n) yacc[m][n][j] += bf2f(gp[n * 16]) * acc[m][n][j];
      EPI_ROW_END
    }
    EPI_ROW_BEGIN(m0)
      bf16_t* yp = YM + (size_t)row * 1024 + n0 + wc * 32 + fr;
#pragma unroll
      for (int n = 0; n < 2; ++n) yp[n * 16] = f2bf(yacc[m][n][j]);
    EPI_ROW_END
  }
}
__device__ __forceinline__ void ph_wout(const P& p, int l, int Mt, char* lds) {
  EPI_VARS
  const bf16_t* YM = (const bf16_t*)p.R;
  STREAM_BEGIN(Mt, 8, 8, (YM + (size_t)(tm * 128) * 1024), (p.W + W_OUT + (size_t)(tn * 128) * 1024), 1024, 1024, 1024)
    const int m0 = tm * 128, n0 = tn * 128;
    EPI_ROW_BEGIN(m0)
      float* sp = srow(p, row) + n0 + wc * 64 + fr; const float* gp = modp(p, l, row, 5) + n0 + wc * 64 + fr;
#pragma unroll
      for (int n = 0; n < 4; ++n) sp[n * 16] = ALPHA * sp[n * 16] + gp[n * 16] * acc[m][n][j];
    EPI_ROW_END
  STREAM_END
}

#define XB_TMO      128
#define XB_XCNT(j)  (256  + 64 * (j))
#define XB_XSUB(j)  (1280 + 64 * (j))
#define XB_XGEN(j)  (2304 + 64 * (j))
#define XB_TOP      3328
#define XB_TOPGEN   3392
#define XCD_BAR_WORDS 3456
#define XB_SPIN_CAP (1u << 18)
#define LAS __attribute__((address_space(3)))

__device__ __forceinline__ unsigned xb_ld(unsigned* p)              { return __hip_atomic_load(p, __ATOMIC_RELAXED, __HIP_MEMORY_SCOPE_AGENT); }
__device__ __forceinline__ unsigned xb_add(unsigned* p, unsigned v) { return __hip_atomic_fetch_add(p, v, __ATOMIC_RELAXED, __HIP_MEMORY_SCOPE_AGENT); }
__device__ __forceinline__ unsigned xb_xcc_id() { return (unsigned)__builtin_amdgcn_s_getreg((3 << 11) | 20) & 0xFu; }
#define XB_SPIN(cond, bar) do { unsigned _sp = 0; while (cond) { __builtin_amdgcn_s_sleep(1); \
    if ((++_sp & 255u) == 0u) { if (xb_ld(&(bar)[XB_TMO])) break; if (_sp > XB_SPIN_CAP) { atomicAdd(&(bar)[XB_TMO], 1u); break; } } } } while (0)

struct XcdBarrier {
    unsigned* bar; unsigned x;
    volatile LAS unsigned* st;
};

__device__ __forceinline__ XcdBarrier xcd_barrier_post(unsigned* bar, volatile LAS unsigned* st) {
    XcdBarrier b; b.bar = bar; b.x = xb_xcc_id(); b.st = st;
    if (__builtin_amdgcn_workitem_id_x() == 0) (void)xb_add(&bar[XB_XCNT(b.x)], 1u);
    return b;
}
__device__ __forceinline__ void xcd_barrier_complete(unsigned* bar, unsigned x, unsigned& nloc, unsigned& nx) {
    const unsigned G = gridDim.x * gridDim.y * gridDim.z;
    unsigned sum, cnt, mine, sp = 0u;
    for (;;) {
        sum = 0u; cnt = 0u; mine = 0u;
#pragma unroll
        for (unsigned j = 0; j < 16; ++j) { const unsigned c = xb_ld(&bar[XB_XCNT(j)]); sum += c; cnt += (c > 0u) ? 1u : 0u; mine = (j == x) ? c : mine; }
        if (sum == G) break;
        __builtin_amdgcn_s_sleep(1);
        if ((++sp & 255u) == 0u) { if (xb_ld(&bar[XB_TMO])) break; if (sp > XB_SPIN_CAP) { atomicAdd(&bar[XB_TMO], 1u); break; } }
    }
    nloc = mine > 0u ? mine : 1u; nx = cnt > 0u ? cnt : 1u;
}

__device__ __forceinline__ void xcd_barrier(const XcdBarrier& b) {
    asm volatile("s_waitcnt vmcnt(0)" ::: "memory");
    __syncthreads();
    if (__builtin_amdgcn_workitem_id_x() == 0) {
        unsigned* bar = b.bar;
        __builtin_amdgcn_s_waitcnt(0);
        unsigned nloc = b.st[0], nx = b.st[1];
        if (nloc == 0u) { xcd_barrier_complete(bar, b.x, nloc, nx); b.st[0] = nloc; b.st[1] = nx; }
        const unsigned old = xb_add(&bar[XB_XSUB(b.x)], 1u);
        const unsigned gen = old / nloc;
        if (old + 1u == (gen + 1u) * nloc) {
            __builtin_amdgcn_fence(__ATOMIC_RELEASE, "agent");
            asm volatile("s_waitcnt vmcnt(0)" ::: "memory");
            const unsigned og = xb_add(&bar[XB_TOP], 1u);
            const unsigned tg = og / nx;
            if (og + 1u == (tg + 1u) * nx) xb_add(&bar[XB_TOPGEN], 1u);
            else XB_SPIN(xb_ld(&bar[XB_TOPGEN]) == tg, bar);
            __builtin_amdgcn_fence(__ATOMIC_ACQUIRE, "agent");
            xb_add(&bar[XB_XGEN(b.x)], 1u);
            asm volatile("s_waitcnt vmcnt(0)" ::: "memory");
        } else {
            XB_SPIN(xb_ld(&bar[XB_XGEN(b.x)]) == gen, bar);
            __builtin_amdgcn_fence(__ATOMIC_ACQUIRE, "agent");
            asm volatile("s_waitcnt vmcnt(0)" ::: "memory");
        }
    }
    __syncthreads();
}


#define SYNC xcd_barrier(xb); asm volatile("" : "+s"(l));
__global__ void __launch_bounds__(NTHR, 2) mega(P pv) {
#define p pv
  __shared__ __attribute__((aligned(16))) char lds[LDS_BYTES];
  __shared__ uint4 xb_words;
  cg::grid_group grid = cg::this_grid();
  {
    const int t0 = __builtin_amdgcn_workitem_id_x();
    if (blockIdx.x == 0) for (int i = t0; i < 4096; i += NTHR) pv.bar[i] = 0u;
    if (t0 == 0) xb_words = make_uint4(0u, 0u, 0u, 0u);
    __threadfence();
    grid.sync();
  }
  XcdBarrier xb = xcd_barrier_post(pv.bar, (volatile LAS unsigned*)&xb_words);
  for (int l = 0; l < 2; ++l) {
    const bool last = (l == 1);
    const int Mt2 = last ? 256 : 264;
    const int Mr2 = last ? M_LAT : M_ALL;
    ph_convert(p, l, l == 0, lds); SYNC
    if (l == 0) { ph_rows(p, 0, 0, 0, M_ALL, true, 0, 0); SYNC }
    ph_ffn_up(p, 0, 264, lds); SYNC
    ph_ffn_down(p, l, 0, 264, lds); SYNC
    ph_rows(p, 1, l, 0, M_ALL, true, l, 3); SYNC
    ph_z_rw(p, lds); SYNC
    ph_conv<0>(p, l); SYNC
    ph_lora(p, l, lds); SYNC
    {
      const int ns = gridDim.x >= 384 ? 192 : 0;
      if (ns == 0 || blockIdx.x < 192) ph_rwscan(p, lds);
      if (ns == 0) { SYNC }
      if ((int)blockIdx.x >= ns) ph_s5_stage(p, l, lds, (int)blockIdx.x - ns, (int)gridDim.x - ns);
      SYNC
    }
    ph_rwpost(p, l); SYNC
    ph_z_ml(p, lds); SYNC
    ph_conv<1>(p, l); SYNC
    ph_ml_a(p, l, lds); SYNC
    ph_ml_b(p); SYNC
    ph_ml_c(p, l, lds); SYNC
    ph_gates(p, l, Mt2, lds); SYNC
    ph_merge(p, l, Mt2, lds); SYNC
    ph_wout(p, l, Mt2, lds); SYNC
    ph_rows(p, 1, l, 1, Mr2, true, l, 6); SYNC
    ph_ffn_up(p, 1, Mt2, lds); SYNC
    ph_ffn_down(p, l, 1, Mt2, lds); SYNC
    ph_rows(p, 1, l, 2, Mr2, !last, l + 1, 0);
    if (!last) { SYNC }
  }
#undef p
}

extern "C" void kernel_launch(void* const* d_in, const int* in_sizes, int n_in, void* d_out, int out_size, void* d_ws, size_t ws_size,
                              hipStream_t stream) {
  static int grid_blocks = 0;
  if (!grid_blocks) {
    int dev = 0, cus = 0, per_cu = 0;
    hipGetDevice(&dev);
    hipDeviceGetAttribute(&cus, hipDeviceAttributeMultiprocessorCount, dev);
    hipOccupancyMaxActiveBlocksPerMultiprocessor(&per_cu, mega, NTHR, 0);
    if (per_cu > 2) per_cu = 2;
    grid_blocks = cus * per_cu;
  }
  P p{};
  for (int i = 0; i < 40; ++i) p.in[i] = (const float*)d_in[i];
  char* ws = (char*)d_ws;
  size_t off = 0;
  p.W = (bf16_t*)(ws + off); off += (size_t)W_TOTAL * 2;
  p.mod = (float*)(ws + off); off += (size_t)2 * 5 * 9216 * 4;
  p.sctx = (float*)(ws + off); off += (size_t)1024 * 1024 * 4;
  p.bar = (unsigned*)(ws + off); off += (size_t)16384;
  p.U = (bf16_t*)(ws + off); off += (size_t)M_ALL * 1024 * 2;
  p.Y = (bf16_t*)(ws + off); off += (size_t)M_ALL * 1024 * 2;
  p.R = ws + off;
  p.out = (float*)d_out;
  if (off + (size_t)M_ALL * 9728 > ws_size) fprintf(stderr, "workspace too small: need %zu have %zu\n", off + (size_t)M_ALL * 9728, ws_size);
  void* args[] = {&p};
  hipError_t e = hipLaunchCooperativeKernel((void*)mega, dim3(grid_blocks), dim3(NTHR), args, 0, stream);
  if (e != hipSuccess) fprintf(stderr, "cooperative launch failed: %s (grid %d)\n", hipGetErrorString(e), grid_blocks);
}
```

```cpp
#include <hip/hip_runtime.h>
#include <hip/hip_cooperative_groups.h>
#include <cstdio>
namespace cg = cooperative_groups;

typedef unsigned short bf16_t;
typedef _Float16 hf;
typedef hf hf4 __attribute__((ext_vector_type(4)));
typedef hf hf8 __attribute__((ext_vector_type(8)));
typedef __attribute__((ext_vector_type(8))) short bf16x8;
typedef __attribute__((ext_vector_type(4))) float f32x4;
typedef unsigned int u32x4 __attribute__((ext_vector_type(4)));

#define M_LAT 32768
#define M_ALL 33792
#define NTHR 256
#define LDS_BYTES 73728
#define ALPHA 1.41421356237f

#define W_GU0 0
#define W_D0 5767168
#define W_GU1 8650752
#define W_D1 14417920
#define W_IN 17301504
#define W_WUP0 23740416
#define W_WUP1 23764992
#define W_AUP0 23789568
#define W_AUP1 23814144
#define W_GUP 23838720
#define W_GLU 23887872
#define W_UPRW 23953408
#define W_UPS5 24346624
#define W_UPML 24608768
#define W_OUT 25001984
#define W_TOTAL 26050560

struct P {
  const float* in[40];
  float* out; float* sctx; float* mod;
  bf16_t* U; bf16_t* Y; bf16_t* W; char* R; unsigned* bar;
};

__device__ __forceinline__ int get_tid() { int t = __builtin_amdgcn_workitem_id_x(); asm volatile("" : "+v"(t)); return t; }
__device__ __forceinline__ bf16_t f2bf(float f) { return __builtin_bit_cast(unsigned short, (_Float16)f); }
__device__ __forceinline__ float bf2f(bf16_t h) { return (float)__builtin_bit_cast(_Float16, h); }
__device__ __forceinline__ float sigmoidf_(float x) { return __builtin_amdgcn_rcpf(1.f + __expf(-x)); }
__device__ __forceinline__ float tanhf_(float x) { return 1.f - 2.f * __builtin_amdgcn_rcpf(1.f + __expf(2.f * x)); }
__device__ __forceinline__ float siluf_(float x) { return x * __builtin_amdgcn_rcpf(1.f + __expf(-x)); }
__device__ __forceinline__ float* srow(const P& p, int m) { return m < M_LAT ? p.out + (size_t)m * 1024 : p.sctx + (size_t)(m - M_LAT) * 1024; }
__device__ __forceinline__ const float* modp(const P& p, int l, int m, int k) { int mv = m < M_LAT ? (m >> 13) : 4; return p.mod + (size_t)(l * 5 + mv) * 9216 + k * 1024; }
template <int C> __device__ __forceinline__ float dppf(float x) { return __int_as_float(__builtin_amdgcn_update_dpp(0, __float_as_int(x), C, 0xf, 0xf, false)); }
__device__ __forceinline__ float rowsum16(float x) { x += dppf<0x128>(x); x += dppf<0x124>(x); x += dppf<0x122>(x); x += dppf<0x121>(x); return x; }
__device__ __forceinline__ float wavesum(float x) { for (int o = 32; o > 0; o >>= 1) x += __shfl_xor(x, o); return x; }

template <int NB>
__device__ __forceinline__ void gemm_main_t(const bf16_t* __restrict__ A, int lda, const bf16_t* __restrict__ B, int ldb, int K,
                                          f32x4 (&acc)[4][NB], char* lds) {
  const int tid = get_tid(), lane = tid & 63, wid = tid >> 6, wr = wid >> 1, wc = wid & 1;
  const int fr = lane & 15, fq = lane >> 4;
  const int sr = tid >> 3, skc = tid & 7;
  const bf16_t* ga = A + (size_t)sr * lda + skc * 8;
  const bf16_t* gb = B + (size_t)sr * ldb + skc * 8;
  u32x4 ra0[4], rb0[NB], ra1[4], rb1[NB];
  const int soff = sr * 144 + skc * 16;
  const int nk = K >> 6;
  const int aoff = (wr * 64 + fr) * 144 + fq * 16;
  const int boff = 18432 + (wc * (NB * 16) + fr) * 144 + fq * 16;
#define G_LOAD(RA, RB, kt) { _Pragma("unroll") for (int i = 0; i < 4; ++i) { RA[i] = *(const u32x4*)(ga + (size_t)(i * 32) * lda + (kt) * 64); if (i < NB) RB[i] = *(const u32x4*)(gb + (size_t)(i * 32) * ldb + (kt) * 64); } }
#define G_STORE(RA, RB, buf) { char* d_ = lds + (buf) * 36864 + soff; _Pragma("unroll") for (int i = 0; i < 4; ++i) { *(u32x4*)(d_ + i * 32 * 144) = RA[i]; if (i < NB) *(u32x4*)(d_ + 18432 + i * 32 * 144) = RB[i]; } }
#define G_COMP(buf) { const char* cur = lds + (buf) * 36864; _Pragma("unroll") for (int ks = 0; ks < 2; ++ks) { hf8 af[4], bfr[NB]; \
    _Pragma("unroll") for (int m = 0; m < 4; ++m) af[m] = *(const hf8*)(cur + aoff + m * 16 * 144 + ks * 64); \
    _Pragma("unroll") for (int n = 0; n < NB; ++n) bfr[n] = *(const hf8*)(cur + boff + n * 16 * 144 + ks * 64); \
    _Pragma("unroll") for (int m = 0; m < 4; ++m) _Pragma("unroll") for (int n = 0; n < NB; ++n) acc[m][n] = __builtin_amdgcn_mfma_f32_16x16x32_f16(af[m], bfr[n], acc[m][n], 0, 0, 0); } }
  G_LOAD(ra0, rb0, 0)
  { const int k1 = nk > 1 ? 1 : 0; G_LOAD(ra1, rb1, k1) }
  G_STORE(ra0, rb0, 0)
  __syncthreads();
  for (int kt = 0; kt < nk; kt += 2) {
    { const int k2 = kt + 2 < nk ? kt + 2 : nk - 1; G_LOAD(ra0, rb0, k2) }
    G_COMP(0)
    G_STORE(ra1, rb1, 1)
    __syncthreads();
    { const int k3 = kt + 3 < nk ? kt + 3 : nk - 1; G_LOAD(ra1, rb1, k3) }
    if (kt + 1 < nk) G_COMP(1)
    G_STORE(ra0, rb0, 0)
    __syncthreads();
  }
}
__device__ __forceinline__ void gemm_stream(const bf16_t* __restrict__ A, int lda, const bf16_t* __restrict__ B, int ldb, int K,
                                            const bf16_t* __restrict__ An, const bf16_t* __restrict__ Bn, bool first,
                                            f32x4 (&acc)[4][4], char* lds, u32x4 (&ra1)[4], u32x4 (&rb1)[4]) {
  constexpr int NB = 4;
  const int tid = get_tid(), lane = tid & 63, wid = tid >> 6, wr = wid >> 1, wc = wid & 1;
  const int fr = lane & 15, fq = lane >> 4;
  const int sr = tid >> 3, skc = tid & 7;
  const bf16_t* ga = A + (size_t)sr * lda + skc * 8;
  const bf16_t* gb = B + (size_t)sr * ldb + skc * 8;
  const bf16_t* gan = An + (size_t)sr * lda + skc * 8;
  const bf16_t* gbn = Bn + (size_t)sr * ldb + skc * 8;
  u32x4 ra0[4], rb0[NB];
  const int soff = sr * 144 + skc * 16;
  const int nk = K >> 6;
  const int aoff = (wr * 64 + fr) * 144 + fq * 16;
  const int boff = 18432 + (wc * (NB * 16) + fr) * 144 + fq * 16;
#define GS_LOAD(RA, RB, pa, pb, kt) { _Pragma("unroll") for (int i = 0; i < 4; ++i) { RA[i] = *(const u32x4*)((pa) + (size_t)(i * 32) * lda + (kt) * 64); RB[i] = *(const u32x4*)((pb) + (size_t)(i * 32) * ldb + (kt) * 64); } }
  if (first) {
    GS_LOAD(ra0, rb0, ga, gb, 0)
    GS_LOAD(ra1, rb1, ga, gb, 1)
    G_STORE(ra0, rb0, 0)
    __syncthreads();
  }
  for (int kt = 0; kt < nk; kt += 2) {
    if (kt + 2 < nk) { GS_LOAD(ra0, rb0, ga, gb, kt + 2) } else { GS_LOAD(ra0, rb0, gan, gbn, 0) }
    G_COMP(0)
    G_STORE(ra1, rb1, 1)
    __syncthreads();
    if (kt + 3 < nk) { GS_LOAD(ra1, rb1, ga, gb, kt + 3) } else { GS_LOAD(ra1, rb1, gan, gbn, 1) }
    G_COMP(1)
    G_STORE(ra0, rb0, 0)
    __syncthreads();
  }
}
__device__ __forceinline__ void gemm_main(const bf16_t* __restrict__ A, int lda, const bf16_t* __restrict__ B, int ldb, int K, f32x4 (&acc)[4][4], char* lds) {
  gemm_main_t<4>(A, lda, B, ldb, K, acc, lds);
}
template <int KT>
__device__ __forceinline__ void gemm_small_t(const bf16_t* __restrict__ A, int lda, const bf16_t* __restrict__ B, int ldb, f32x4 (&acc)[4][4], char* lds) {
  const int tid = get_tid(), lane = tid & 63, wid = tid >> 6, wr = wid >> 1, wc = wid & 1;
  const int fr = lane & 15, fq = lane >> 4;
  const int sr = tid >> 3, skc = tid & 7;
  const bf16_t* ga = A + (size_t)sr * lda + skc * 8;
  const bf16_t* gb = B + (size_t)sr * ldb + skc * 8;
  const int soff = sr * 144 + skc * 16;
  const int aoff = (wr * 64 + fr) * 144 + fq * 16;
  const int boff = 18432 + (wc * 64 + fr) * 144 + fq * 16;
  u32x4 ra[KT][4], rb[KT][4];
#pragma unroll
  for (int kt = 0; kt < KT; ++kt)
#pragma unroll
    for (int i = 0; i < 4; ++i) { ra[kt][i] = *(const u32x4*)(ga + (size_t)(i * 32) * lda + kt * 64); rb[kt][i] = *(const u32x4*)(gb + (size_t)(i * 32) * ldb + kt * 64); }
#pragma unroll
  for (int kt = 0; kt < KT; ++kt)
#pragma unroll
    for (int i = 0; i < 4; ++i) { *(u32x4*)(lds + kt * 36864 + soff + i * 32 * 144) = ra[kt][i]; *(u32x4*)(lds + kt * 36864 + 18432 + soff + i * 32 * 144) = rb[kt][i]; }
  __syncthreads();
#pragma unroll
  for (int kt = 0; kt < KT; ++kt) {
    const char* cur = lds + kt * 36864;
#pragma unroll
    for (int ks = 0; ks < 2; ++ks) {
      hf8 af[4], bfr[4];
#pragma unroll
      for (int m = 0; m < 4; ++m) af[m] = *(const hf8*)(cur + aoff + m * 16 * 144 + ks * 64);
#pragma unroll
      for (int n = 0; n < 4; ++n) bfr[n] = *(const hf8*)(cur + boff + n * 16 * 144 + ks * 64);
#pragma unroll
      for (int m = 0; m < 4; ++m)
#pragma unroll
        for (int n = 0; n < 4; ++n) acc[m][n] = __builtin_amdgcn_mfma_f32_16x16x32_f16(bfr[n], af[m], acc[m][n], 0, 0, 0);
    }
  }
  __syncthreads();
}

template <int SM>
__device__ __forceinline__ bool tile_map_sm(int b, int nb, int it, int Mt, int Nt, int SN, int& tm, int& tn) {
  const int xcd = b & 7, li = b >> 3, nloc = nb >> 3;
  const int T = SM * SN; const int nsn = Nt / SN; const int nsuper = (Mt / SM) * nsn;
  const int o = li + it * nloc; const int k = o / T, w = o - k * T;
  const int s = xcd + 8 * k;
  if (s >= nsuper) return false;
  const int sm = s / nsn, sn = s - sm * nsn;
  tm = sm * SM + (w % SM); tn = sn * SN + (w / SM);
  return true;
}
__device__ __forceinline__ bool tile_map_v(int b, int nb, int it, int Mt, int Nt, int SN, int& tm, int& tn) {
  const int nsn = Nt / SN;
  if (nsn * (Mt >> 3) % 8 == 0 || nsn >= 8) return tile_map_sm<8>(b, nb, it, Mt, Nt, SN, tm, tn);
  return tile_map_sm<1>(b, nb, it, Mt, Nt, SN, tm, tn);
}
__device__ __forceinline__ bool tile_map(int it, int Mt, int Nt, int SN, int& tm, int& tn) { return tile_map_v(blockIdx.x, gridDim.x, it, Mt, Nt, SN, tm, tn); }
#define ZERO_ACC(a) _Pragma("unroll") for (int m_ = 0; m_ < 4; ++m_) _Pragma("unroll") for (int n_ = 0; n_ < 4; ++n_) a[m_][n_] = (f32x4){0.f, 0.f, 0.f, 0.f};
#define EPI_VARS const int tid = get_tid(), lane = tid & 63, wid = tid >> 6, wr = wid >> 1, wc = wid & 1, fr = lane & 15, fq = lane >> 4; (void)wr; (void)wc; (void)fr; (void)fq;
#define EPI_ROW_BEGIN(m0) _Pragma("unroll") for (int m = 0; m < 4; ++m) _Pragma("unroll") for (int j = 0; j < 4; ++j) { const int row = (m0) + wr * 64 + m * 16 + fq * 4 + j; (void)row;
#define EPI_COL_BEGIN(n0) _Pragma("unroll") for (int n = 0; n < 4; ++n) { const int col = (n0) + wc * 64 + n * 16 + fr; const float val = acc[m][n][j]; (void)col; (void)val;
#define EPI_COL_END }
#define EPI_ROW_END }
#define EPI_BEGIN(m0, n0) EPI_ROW_BEGIN(m0) EPI_COL_BEGIN(n0)
#define EPI_END } }

struct Job { const float* src; int K, N; int dst; int mode; };
__device__ __forceinline__ Job get_job(const P& p, int l, int j) {
  Job r; r.mode = 0;
  switch (j) {
    case 0: r.src = p.in[8] + (size_t)(l * 2 + 0) * 1024 * 2816; r.K = 1024; r.N = 2816; r.dst = W_GU0; r.mode = 1; break;
    case 1: r.src = p.in[9] + (size_t)(l * 2 + 0) * 1024 * 2816; r.K = 1024; r.N = 2816; r.dst = W_GU0; r.mode = 2; break;
    case 2: r.src = p.in[10] + (size_t)(l * 2 + 0) * 2816 * 1024; r.K = 2816; r.N = 1024; r.dst = W_D0; break;
    case 3: r.src = p.in[8] + (size_t)(l * 2 + 1) * 1024 * 2816; r.K = 1024; r.N = 2816; r.dst = W_GU1; r.mode = 1; break;
    case 4: r.src = p.in[9] + (size_t)(l * 2 + 1) * 1024 * 2816; r.K = 1024; r.N = 2816; r.dst = W_GU1; r.mode = 2; break;
    case 5: r.src = p.in[10] + (size_t)(l * 2 + 1) * 2816 * 1024; r.K = 2816; r.N = 1024; r.dst = W_D1; break;
    case 6: r.src = p.in[11] + (size_t)l * 1024 * 6288; r.K = 1024; r.N = 6288; r.dst = W_IN; break;
    case 7: r.src = p.in[14] + (size_t)(l * 2 + 0) * 64 * 384; r.K = 64; r.N = 384; r.dst = W_WUP0; break;
    case 8: r.src = p.in[14] + (size_t)(l * 2 + 1) * 64 * 384; r.K = 64; r.N = 384; r.dst = W_WUP1; break;
    case 9: r.src = p.in[16] + (size_t)(l * 2 + 0) * 64 * 384; r.K = 64; r.N = 384; r.dst = W_AUP0; break;
    case 10: r.src = p.in[16] + (size_t)(l * 2 + 1) * 64 * 384; r.K = 64; r.N = 384; r.dst = W_AUP1; break;
    case 11: r.src = p.in[17] + (size_t)l * 128 * 384; r.K = 128; r.N = 384; r.dst = W_GUP; break;
    case 12: r.src = p.in[31] + (size_t)l * 256 * 256; r.K = 256; r.N = 256; r.dst = W_GLU; break;
    case 13: r.src = p.in[35] + (size_t)l * 384 * 1024; r.K = 384; r.N = 1024; r.dst = W_UPRW; break;
    case 14: r.src = p.in[36] + (size_t)l * 256 * 1024; r.K = 256; r.N = 1024; r.dst = W_UPS5; break;
    case 15: r.src = p.in[37] + (size_t)l * 384 * 1024; r.K = 384; r.N = 1024; r.dst = W_UPML; break;
    default: r.src = p.in[39] + (size_t)l * 1024 * 1024; r.K = 1024; r.N = 1024; r.dst = W_OUT; break;
  }
  return r;
}
#define NJOBS 17
__device__ void mod_task(const P& p, int t, char* lds) {
  float* sc = (float*)lds;
  float* red = sc + 5 * 1024;
  const int tid = get_tid();
  for (int i = tid; i < 5 * 1024; i += NTHR) {
    int v = i >> 10, k = i & 1023;
    float c = v < 4 ? p.in[1][v * 1024 + k] : p.in[3][k];
    sc[i] = siluf_(c);
  }
  __syncthreads();
  const int c0 = t * 64; const int l = c0 / 9216; const int j0 = c0 % 9216;
  const int col = tid & 63, part = tid >> 6;
  const float* w = p.in[4] + ((size_t)l * 1024 + part * 256) * 9216 + j0 + col;
  float a0 = 0, a1 = 0, a2 = 0, a3 = 0, a4 = 0;
  const float* s = sc + part * 256;
#pragma unroll 8
  for (int i = 0; i < 256; ++i) {
    float wv = w[(size_t)i * 9216];
    a0 += s[i] * wv; a1 += s[1024 + i] * wv; a2 += s[2048 + i] * wv; a3 += s[3072 + i] * wv; a4 += s[4096 + i] * wv;
  }
  red[(part * 5 + 0) * 64 + col] = a0; red[(part * 5 + 1) * 64 + col] = a1; red[(part * 5 + 2) * 64 + col] = a2;
  red[(part * 5 + 3) * 64 + col] = a3; red[(part * 5 + 4) * 64 + col] = a4;
  __syncthreads();
  for (int i = tid; i < 320; i += NTHR) {
    int v = i >> 6, c = i & 63;
    float sum = red[(0 * 5 + v) * 64 + c] + red[(1 * 5 + v) * 64 + c] + red[(2 * 5 + v) * 64 + c] + red[(3 * 5 + v) * 64 + c];
    p.mod[(size_t)(l * 5 + v) * 9216 + j0 + c] = sum + p.in[5][(size_t)l * 9216 + j0 + c];
  }
  __syncthreads();
}
__device__ __forceinline__ void ph_convert(const P& p, int l, bool with_mod, char* lds) {
  const int tid = get_tid();
  int ntiles[NJOBS]; int total = 0;
#pragma unroll
  for (int j = 0; j < NJOBS; ++j) { Job jb = get_job(p, l, j); ntiles[j] = (jb.K >> 6) * ((jb.N + 63) >> 6); total += ntiles[j]; }
  const int nmod = with_mod ? 288 : 0;
  float* tile = (float*)lds;
  for (int t = blockIdx.x; t < total + nmod; t += gridDim.x) {
    if (t < nmod) { mod_task(p, t, lds); continue; }
    int tt = t - nmod; int j = 0;
#pragma unroll
    for (int q = 0; q < NJOBS; ++q) { if (j == q && tt >= ntiles[q]) { tt -= ntiles[q]; j = q + 1; } }
    Job jb = get_job(p, l, j);
    const int nkt = jb.K >> 6;
    const int k0 = (tt % nkt) * 64, n0 = (tt / nkt) * 64;
    {
      const int c = tid & 63, r0 = tid >> 6;
      const bool ok = (n0 + c) < jb.N;
#pragma unroll
      for (int i = 0; i < 16; ++i) { int r = r0 + i * 4; tile[r * 65 + c] = ok ? jb.src[(size_t)(k0 + r) * jb.N + n0 + c] : 0.f; }
    }
    __syncthreads();
    {
      const int nn = tid >> 2, q = tid & 3; const int n = n0 + nn;
      if (n < jb.N) {
        int drow = n;
        if (jb.mode == 1) drow = (n >> 5) * 64 + (n & 31);
        else if (jb.mode == 2) drow = (n >> 5) * 64 + 32 + (n & 31);
        bf16_t* d = p.W + jb.dst + (size_t)drow * jb.K + k0 + q * 16;
        unsigned pk[8];
#pragma unroll
        for (int i = 0; i < 8; ++i) { unsigned lo = f2bf(tile[(q * 16 + 2 * i) * 65 + nn]); unsigned hi = f2bf(tile[(q * 16 + 2 * i + 1) * 65 + nn]); pk[i] = lo | (hi << 16); }
        *(uint4*)d = make_uint4(pk[0], pk[1], pk[2], pk[3]);
        *(uint4*)(d + 8) = make_uint4(pk[4], pk[5], pk[6], pk[7]);
      }
    }
    __syncthreads();
  }
}

__device__ __forceinline__ void ph_rows(const P& p, int mode, int l, int ln_idx, int Mrows, bool writeU, int ul, int ks) {
  const int lane = get_tid() & 63, wid = get_tid() >> 6;
  const int nw = gridDim.x * 4;
  const float* g = p.in[6] + (size_t)(l * 3 + ln_idx) * 1024;
  const float* b = p.in[7] + (size_t)(l * 3 + ln_idx) * 1024;
  for (int m = blockIdx.x * 4 + wid; m < Mrows; m += nw) {
    float* s = srow(p, m);
    const float* src = s;
    if (mode == 0) src = m < M_LAT ? p.in[0] + (size_t)m * 1024 : p.in[2] + (size_t)(m - M_LAT) * 1024;
    float4 v[4];
#pragma unroll
    for (int i = 0; i < 4; ++i) v[i] = *(const float4*)(src + lane * 4 + i * 256);
    if (mode == 1) {
      float sum = 0;
#pragma unroll
      for (int i = 0; i < 4; ++i) sum += v[i].x + v[i].y + v[i].z + v[i].w;
      sum = wavesum(sum);
      const float mean = sum * (1.f / 1024.f);
      float sq = 0;
#pragma unroll
      for (int i = 0; i < 4; ++i) { v[i].x -= mean; v[i].y -= mean; v[i].z -= mean; v[i].w -= mean; sq += v[i].x * v[i].x + v[i].y * v[i].y + v[i].z * v[i].z + v[i].w * v[i].w; }
      sq = wavesum(sq);
      const float rstd = rsqrtf(sq * (1.f / 1024.f) + 1e-5f);
#pragma unroll
      for (int i = 0; i < 4; ++i) {
        float4 gg = *(const float4*)(g + lane * 4 + i * 256), bb = *(const float4*)(b + lane * 4 + i * 256);
        v[i].x = v[i].x * rstd * gg.x + bb.x; v[i].y = v[i].y * rstd * gg.y + bb.y; v[i].z = v[i].z * rstd * gg.z + bb.z; v[i].w = v[i].w * rstd * gg.w + bb.w;
      }
    }
#pragma unroll
    for (int i = 0; i < 4; ++i) *(float4*)(s + lane * 4 + i * 256) = v[i];
    if (writeU) {
      const float* sh = modp(p, ul, m, ks); const float* scl = modp(p, ul, m, ks + 1);
#pragma unroll
      for (int i = 0; i < 4; ++i) {
        float4 a = *(const float4*)(sh + lane * 4 + i * 256), c = *(const float4*)(scl + lane * 4 + i * 256);
        unsigned lo = f2bf(v[i].x * (1.f + c.x) + a.x) | ((unsigned)f2bf(v[i].y * (1.f + c.y) + a.y) << 16);
        unsigned hi = f2bf(v[i].z * (1.f + c.z) + a.z) | ((unsigned)f2bf(v[i].w * (1.f + c.w) + a.w) << 16);
        *(uint2*)(p.U + (size_t)m * 1024 + lane * 4 + i * 256) = make_uint2(lo, hi);
      }
    }
  }
}


#define STREAM_BEGIN(Mt_, Nt_, SN_, APTR, BPTR, LDA_, LDB_, K_) { \
    u32x4 pr_a[4], pr_b[4]; bool first_ = true; int tm, tn; bool have_ = tile_map(0, Mt_, Nt_, SN_, tm, tn); \
    for (int it = 0; have_; ++it) { int tm2, tn2; const bool have2_ = tile_map(it + 1, Mt_, Nt_, SN_, tm2, tn2); \
      const int tmn = have2_ ? tm2 : tm, tnn = have2_ ? tn2 : tn; \
      f32x4 acc[4][4]; ZERO_ACC(acc) \
      { const bf16_t* a_cur = APTR; const bf16_t* b_cur = BPTR; \
        const bf16_t* a_nxt; const bf16_t* b_nxt; { const int tm = tmn, tn = tnn; (void)tm; (void)tn; a_nxt = APTR; b_nxt = BPTR; } \
        gemm_stream(a_cur, LDA_, b_cur, LDB_, K_, a_nxt, b_nxt, first_, acc, lds, pr_a, pr_b); first_ = false; }
#define STREAM_END tm = tm2; tn = tn2; have_ = have2_; } }
__device__ __forceinline__ void ph_ffn_up(const P& p, int s, int Mt, char* lds) {
  EPI_VARS
  bf16_t* HM = (bf16_t*)p.R;
  const bf16_t* Wt = p.W + (s ? W_GU1 : W_GU0);
  STREAM_BEGIN(Mt, 44, 4, (p.U + (size_t)(tm * 128) * 1024), (Wt + (size_t)(tn * 128) * 1024), 1024, 1024, 1024)
    const int m0 = tm * 128, n0 = tn * 128;
    const int hb = ((n0 + wc * 64) >> 6) * 32;
#pragma unroll
    for (int m = 0; m < 4; ++m)
#pragma unroll
      for (int n = 0; n < 2; ++n)
#pragma unroll
        for (int j = 0; j < 4; ++j) {
          const int row = m0 + wr * 64 + m * 16 + fq * 4 + j; const int hc = hb + n * 16 + fr;
          HM[(size_t)row * 2816 + hc] = f2bf(siluf_(acc[m][n][j]) * acc[m][n + 2][j]);
        }
  STREAM_END
}
__device__ __forceinline__ void ph_ffn_down(const P& p, int l, int s, int Mt, char* lds) {
  EPI_VARS
  const bf16_t* HM = (const bf16_t*)p.R;
  const bf16_t* Wt = p.W + (s ? W_D1 : W_D0);
  const int gk = s ? 8 : 2;
  STREAM_BEGIN(Mt, 8, 8, (HM + (size_t)(tm * 128) * 2816), (Wt + (size_t)(tn * 128) * 2816), 2816, 2816, 2816)
    const int m0 = tm * 128, n0 = tn * 128;
    EPI_ROW_BEGIN(m0)
      float* sp = srow(p, row) + n0 + wc * 64 + fr; const float* gp = modp(p, l, row, gk) + n0 + wc * 64 + fr;
#pragma unroll
      for (int n = 0; n < 4; ++n) sp[n * 16] = ALPHA * sp[n * 16] + 0.5f * gp[n * 16] * acc[m][n][j];
    EPI_ROW_END
  STREAM_END
}

#define RW_ZRW(p) ((hf*)(p).R)
#define RW_RKV(p) (RW_ZRW(p) + (size_t)M_ALL * 1152)
#define RW_LA(p) ((bf16_t*)(RW_RKV(p) + (size_t)M_ALL * 1152))
#define RW_KK(p) ((hf*)(RW_LA(p) + (size_t)M_ALL * 256))
#define RW_KD(p) (RW_KK(p) + (size_t)M_ALL * 384)
#define RW_KA(p) (RW_KD(p) + (size_t)2 * M_ALL * 384)
#define RW_YR(p) (RW_KA(p) + (size_t)2 * M_ALL * 384)

#define S5_ZH(p) ((hf*)RW_LA(p))
#define S5_YG(p) ((p).W + W_GU0)
#define S5_E(p) ((float2*)((p).R + (size_t)M_ALL * 9728))
#define S5_X(p) S5_E(p)

#define ML_Z(p) ((hf*)(p).R)
#define ML_GL(p) ((float*)(ML_Z(p) + (size_t)M_ALL * 1536))
#define ML_QK(p) ((hf*)(ML_GL(p) + (size_t)M_ALL * 16))
#define ML_DC(p) ((float*)(ML_QK(p) + (size_t)M_ALL * 768))
#define ML_DN(p) (ML_DC(p) + (size_t)4224 * 9216)
#define ML_SC(p) (ML_DN(p) + (size_t)4224 * 96)
#define ML_MP(p) (ML_SC(p) + (size_t)4224 * 2)

__device__ __forceinline__ void ph_z_rw(const P& p, char* lds) {
  EPI_VARS
  hf* ZRW = RW_ZRW(p); bf16_t* LA = RW_LA(p);
  const int Mt = 264;
  STREAM_BEGIN(Mt, 11, 11, (p.U + (size_t)(tm * 128) * 1024), (p.W + W_IN + (size_t)(tn < 9 ? tn * 128 : 2960 + (tn - 9) * 128) * 1024), 1024, 1024, 1024)
    const int m0 = tm * 128;
    if (tn < 9) {
      EPI_BEGIN(m0, tn * 128)
        ZRW[(size_t)row * 1152 + col] = (hf)val;
      EPI_END
    } else {
      EPI_BEGIN(m0, (tn - 9) * 128)
        float o = col < 64 ? tanhf_(val) : (col < 128 ? val : sigmoidf_(val));
        LA[(size_t)row * 256 + col] = f2bf(o);
      EPI_END
    }
  STREAM_END
}
__device__ __forceinline__ void ph_z_s5(const P& p, char* lds, int vb, int nvb) {
  EPI_VARS
  hf* Z = S5_ZH(p);
  const int Mt = 264;
  for (int it = 0;; ++it) {
    int tm, tn; if (!tile_map_v(vb, nvb, it, Mt, 2, 2, tm, tn)) break; const int m0 = tm * 128;
    f32x4 acc[4][4]; ZERO_ACC(acc)
    gemm_main(p.U + (size_t)m0 * 1024, 1024, p.W + W_IN + (size_t)(2704 + tn * 128) * 1024, 1024, 1024, acc, lds);
    EPI_BEGIN(m0, tn * 128)
      Z[(size_t)row * 256 + col] = (hf)val;
    EPI_END
  }
}
__device__ __forceinline__ void ph_z_ml(const P& p, char* lds) {
  EPI_VARS
  hf* Z = ML_Z(p); float* GL = ML_GL(p);
  const int Mt = 264;
  STREAM_BEGIN(Mt, 13, 13, (p.U + (size_t)(tm * 128) * 1024), (p.W + W_IN + (size_t)(1152 + tn * 128) * 1024), 1024, 1024, 1024)
    const int m0 = tm * 128;
    if (tn < 12) {
      EPI_BEGIN(m0, tn * 128)
        Z[(size_t)row * 1536 + col] = (hf)val;
      EPI_END
    } else {
      EPI_BEGIN(m0, 0)
        if (col < 16) GL[(size_t)row * 16 + col] = val;
      EPI_END
    }
  STREAM_END
}

template <int which>
__device__ __forceinline__ void ph_conv(const P& p, int l) {
  constexpr int nch = which == 0 ? 144 : 96;
  constexpr int ldin = which == 0 ? 1152 : 1536;
  constexpr int cbase = which == 0 ? 0 : 1152;
  const hf* Zin = which == 0 ? RW_ZRW(p) : ML_Z(p);
  const float* cw = p.in[12] + (size_t)l * 9 * 1920;
  const unsigned total = (unsigned)(M_ALL / 4) * nch;
  for (unsigned idx = blockIdx.x * NTHR + get_tid(); idx < (total + 63u) / 64u * 64u; idx += gridDim.x * NTHR) {
    const bool act = idx < total;
    const int tg = act ? (int)(idx / (unsigned)nch) : 0; const int ch = act ? (int)(idx % (unsigned)nch) : 0; const int c0 = ch * 8;
    const int m0 = tg * 4;
    float o[4][8];
#pragma unroll
    for (int t = 0; t < 4; ++t)
#pragma unroll
      for (int i = 0; i < 8; ++i) o[t][i] = 0.f;
    const bool lat = m0 < M_LAT;
    const int bb = m0 >> 13, tt = lat ? (m0 & 8191) : ((m0 - M_LAT) & 255);
    const int gr = tt >> 6, gc0 = lat ? (tt & 63) : tt;
    const int ncol = lat ? 64 : 256;
#pragma unroll
    for (int dr = -1; dr <= 1; ++dr) {
      const int rr = gr + dr;
      const bool rowok = lat ? (rr >= 0 && rr < 128) : (dr == 0);
      if (!rowok) continue;
      const float* w = cw + ((dr + 1) * 3) * 1920 + cbase + c0;
      float wv[3][8];
#pragma unroll
      for (int k = 0; k < 3; ++k) { const float4 a = *(const float4*)(w + k * 1920), b = *(const float4*)(w + k * 1920 + 4);
        wv[k][0] = a.x; wv[k][1] = a.y; wv[k][2] = a.z; wv[k][3] = a.w; wv[k][4] = b.x; wv[k][5] = b.y; wv[k][6] = b.z; wv[k][7] = b.w; }
      const int mrow = lat ? ((bb << 13) + rr * 64) : (m0 - gc0);
#pragma unroll
      for (int cc = 0; cc < 6; ++cc) {
        const int col = gc0 - 1 + cc;
        if (col < 0 || col >= ncol) continue;
        const hf8 z = *(const hf8*)(Zin + (size_t)(mrow + col) * ldin + c0);
        float zf[8];
#pragma unroll
        for (int i = 0; i < 8; ++i) zf[i] = (float)z[i];
#pragma unroll
        for (int t = 0; t < 4; ++t) {
          const int k = cc - t;
          if (k >= 0 && k < 3) {
#pragma unroll
            for (int i = 0; i < 8; ++i) o[t][i] += zf[i] * wv[k][i];
          }
        }
      }
    }
#pragma unroll
    for (int t = 0; t < 4; ++t) {
      const int m = m0 + t;
      if (which == 0) {
        const bool isk = act && (c0 >= 384) && (c0 < 768);
        float kkv[8]; float ss = 0.f;
        if (isk) {
          const float* kkw = p.in[18] + (size_t)l * 384 + (c0 - 384);
#pragma unroll
          for (int i = 0; i < 8; ++i) { kkv[i] = o[t][i] * kkw[i]; ss += kkv[i] * kkv[i]; }
        } else {
#pragma unroll
          for (int i = 0; i < 8; ++i) kkv[i] = 0.f;
        }
        ss += __shfl_xor(ss, 1); ss += __shfl_xor(ss, 2); ss += __shfl_xor(ss, 4);
        if (act) {
          hf8 ov;
#pragma unroll
          for (int i = 0; i < 8; ++i) ov[i] = (hf)o[t][i];
          *(hf8*)(RW_RKV(p) + (size_t)m * 1152 + c0) = ov;
          if (isk) {
            const float rn = rsqrtf(fmaxf(ss, 1e-24f));
            hf8 kv;
#pragma unroll
            for (int i = 0; i < 8; ++i) kv[i] = (hf)(kkv[i] * rn);
            *(hf8*)(RW_KK(p) + (size_t)m * 384 + (c0 - 384)) = kv;
          }
        }
      } else if (act) {
        const float sc = c0 >= 384 ? 0.10206207261596575f : 1.f;
        hf8 ov;
#pragma unroll
        for (int i = 0; i < 8; ++i) ov[i] = (hf)(siluf_(o[t][i]) * sc);
        *(hf8*)(ML_QK(p) + (size_t)m * 768 + c0) = ov;
      }
    }
  }
}

__device__ __forceinline__ void ph_lora(const P& p, int l, char* lds) {
  EPI_VARS
  hf* ZRW = RW_ZRW(p); const hf* RKV = RW_RKV(p); const bf16_t* LA = RW_LA(p); const hf* KK = RW_KK(p);
  hf* KD = RW_KD(p); hf* KA = RW_KA(p);
  const int Mt = 264;
  for (int it = 0;; ++it) {
    int tm, q; if (!tile_map(it, Mt, 15, 15, tm, q)) break; const int job = q / 3, tn = q % 3; const int m0 = tm * 128, n0 = tn * 128;
    f32x4 acc[4][4]; ZERO_ACC(acc)
    if (job < 2) {
      const int d = job;
      gemm_small_t<1>(LA + (size_t)m0 * 256, 256, p.W + (d ? W_WUP1 : W_WUP0) + (size_t)n0 * 64, 64, acc, lds);
      const float* w0 = p.in[13] + (size_t)(l * 2 + d) * 384;
#pragma unroll
      for (int m = 0; m < 4; ++m) {
        const int row = m0 + wr * 64 + m * 16 + fr;
#pragma unroll
        for (int n = 0; n < 4; ++n) {
          const int cb = n0 + wc * 64 + n * 16 + fq * 4;
          const float4 wv = *(const float4*)(w0 + cb);
          const float wa[4] = {wv.x, wv.y, wv.z, wv.w};
          hf4 o;
#pragma unroll
          for (int j = 0; j < 4; ++j) { const float e = sigmoidf_(wa[j] + acc[m][n][j]) * 0.6065306597126334f; o[j] = (hf)(1.f - __expf(-e)); }
          *(hf4*)(ZRW + (size_t)row * 1152 + d * 384 + cb) = o;
        }
      }
    } else if (job < 4) {
      const int d = job - 2;
      gemm_small_t<1>(LA + (size_t)m0 * 256 + 64, 256, p.W + (d ? W_AUP1 : W_AUP0) + (size_t)n0 * 64, 64, acc, lds);
      const float* a0 = p.in[15] + (size_t)(l * 2 + d) * 384; const float* kaw = p.in[19] + (size_t)l * 384;
#pragma unroll
      for (int m = 0; m < 4; ++m) {
        const int row = m0 + wr * 64 + m * 16 + fr;
#pragma unroll
        for (int n = 0; n < 4; ++n) {
          const int cb = n0 + wc * 64 + n * 16 + fq * 4;
          const float4 av = *(const float4*)(a0 + cb), kv = *(const float4*)(kaw + cb);
          const float aa[4] = {av.x, av.y, av.z, av.w}, ka_[4] = {kv.x, kv.y, kv.z, kv.w};
          const hf4 k4 = *(const hf4*)(RKV + (size_t)row * 1152 + 384 + cb), kk4 = *(const hf4*)(KK + (size_t)row * 384 + cb);
          hf4 okd, oka;
#pragma unroll
          for (int j = 0; j < 4; ++j) { const float a = sigmoidf_(aa[j] + acc[m][n][j]); okd[j] = (hf)((float)k4[j] * (1.f + (a - 1.f) * ka_[j])); oka[j] = (hf)((float)kk4[j] * a); }
          *(hf4*)(KD + ((size_t)d * M_ALL + row) * 384 + cb) = okd;
          *(hf4*)(KA + ((size_t)d * M_ALL + row) * 384 + cb) = oka;
        }
      }
    } else {
      gemm_small_t<2>(LA + (size_t)m0 * 256 + 128, 256, p.W + W_GUP + (size_t)n0 * 128, 128, acc, lds);
#pragma unroll
      for (int m = 0; m < 4; ++m) {
        const int row = m0 + wr * 64 + m * 16 + fr;
#pragma unroll
        for (int n = 0; n < 4; ++n) {
          const int cb = n0 + wc * 64 + n * 16 + fq * 4;
          hf4 o; o[0] = (hf)acc[m][n][0]; o[1] = (hf)acc[m][n][1]; o[2] = (hf)acc[m][n][2]; o[3] = (hf)acc[m][n][3];
          *(hf4*)(ZRW + (size_t)row * 1152 + 768 + cb) = o;
        }
      }
    }
  }
}

typedef float f32x2 __attribute__((ext_vector_type(2)));
#define RW_CH 16
#define RW_BUF 21504
__device__ __forceinline__ void rw_cvt_store(char* dst, uint4 q) {
  const hf8 h = __builtin_bit_cast(hf8, q);
  f32x4 a, b;
  a[0] = (float)h[0]; a[1] = (float)h[1]; a[2] = (float)h[2]; a[3] = (float)h[3];
  b[0] = (float)h[4]; b[1] = (float)h[5]; b[2] = (float)h[6]; b[3] = (float)h[7];
  *(f32x4*)dst = a; *(f32x4*)(dst + 16) = b;
}
__device__ __forceinline__ void ph_rwscan(const P& p, char* lds) {
  const hf* ZRW = RW_ZRW(p); hf* RKV = RW_RKV(p); const hf* KK = RW_KK(p);
  const int tid = get_tid(), lane = tid & 63, wid = tid >> 6;
  char* pbuf = lds + 3 * RW_BUF + wid * 2048;
  char* ybuf = lds + 3 * RW_BUF + 8192;
  for (int t = blockIdx.x; t < 192; t += gridDim.x) {
    const int rqq = t & 3, h = (t >> 2) % 6, b = (t / 24) & 3, d = t / 96;
    const int rsub = lane >> 4, g = lane & 15; const int rl = wid * 4 + rsub;
    const int sgn = d ? -1 : 1;
    const bool grpA = tid < 128; const int t2 = tid & 127;
    const int sstep = t2 >> 3, sseg = t2 & 7;
    const hf* g0 = grpA ? (RKV + h * 64 + sseg * 8) : (RW_KD(p) + (size_t)d * M_ALL * 384 + h * 64 + sseg * 8);
    const size_t ld0 = grpA ? 1152 : 384;
    const hf* g1 = grpA ? (KK + h * 64 + sseg * 8) : (RW_KA(p) + (size_t)d * M_ALL * 384 + h * 64 + sseg * 8);
    const hf* g2 = grpA ? (ZRW + d * 384 + h * 64 + sseg * 8) : (RKV + 768 + h * 64 + rqq * 16 + (t2 & 1) * 8);
    const int s2 = grpA ? sstep : (t2 >> 1);
    const bool has2 = grpA || t2 < 32;
    const int o0 = (grpA ? 0 : 12288) + sstep * 256 + sseg * 32;
    const int o1 = (grpA ? 4096 : 16384) + sstep * 256 + sseg * 32;
    const int o2 = grpA ? (8192 + sstep * 256 + sseg * 32) : (20480 + (t2 >> 1) * 64 + (t2 & 1) * 32);
    hf* g_y = d == 0 ? (RKV + 384 + h * 64 + rqq * 16 + (tid & 1) * 8) : (RW_YR(p) + h * 64 + rqq * 16 + (tid & 1) * 8);
    const int ldy = d == 0 ? 1152 : 384;
    uint4 q0, q1, q2;
#define RW_M0(pp) ((pp) < 256 ? (M_LAT + b * 256 + (d ? 255 - (pp) : (pp))) : (b * 8192 + (d ? 8447 - (pp) : (pp) - 256)))
#define RW_GLOAD(c) { const int mb_ = RW_M0((c) * RW_CH); const size_t mm = (size_t)(mb_ + sgn * sstep); \
      q0 = *(const uint4*)(g0 + mm * ld0); q1 = *(const uint4*)(g1 + mm * 384); \
      if (has2) { const size_t m2 = (size_t)(mb_ + sgn * s2); q2 = *(const uint4*)(g2 + m2 * 1152); } }
#define RW_SSTORE(c) { char* bb_ = lds + ((c) % 3) * RW_BUF; rw_cvt_store(bb_ + o0, q0); rw_cvt_store(bb_ + o1, q1); if (has2) rw_cvt_store(bb_ + o2, q2); }
    f32x2 S01 = (f32x2){0.f, 0.f}, S23 = (f32x2){0.f, 0.f};
    RW_GLOAD(0) RW_SSTORE(0)
    RW_GLOAD(1) RW_SSTORE(1)
    __syncthreads();
    const int NCH = 8448 / RW_CH;
    for (int c = 0; c < NCH; ++c) {
      if (c + 2 < NCH) RW_GLOAD(c + 2)
      if (c > 0 && tid < 32) {
        const int mb_ = RW_M0((c - 1) * RW_CH); const size_t mv = (size_t)(mb_ + sgn * (tid >> 1));
        *(uint4*)(g_y + mv * ldy) = *(const uint4*)(ybuf + ((c - 1) & 1) * 512 + tid * 16);
      }
      const char* cb = lds + (c % 3) * RW_BUF + g * 16;
      const char* vb = lds + (c % 3) * RW_BUF + 20480 + rl * 4;
      f32x4 R4[RW_CH], K4[RW_CH], D4[RW_CH], KD4[RW_CH], KA4[RW_CH]; float VV[RW_CH];
#define RW_LDS(s_) { R4[s_] = *(const f32x4*)(cb + (s_) * 256); K4[s_] = *(const f32x4*)(cb + 4096 + (s_) * 256); D4[s_] = *(const f32x4*)(cb + 8192 + (s_) * 256); \
        KD4[s_] = *(const f32x4*)(cb + 12288 + (s_) * 256); KA4[s_] = *(const f32x4*)(cb + 16384 + (s_) * 256); VV[s_] = *(const float*)(vb + (s_) * 64); }
      RW_LDS(0) RW_LDS(1) RW_LDS(2)
#pragma unroll
      for (int s = 0; s < RW_CH; ++s) {
        if (s + 3 < RW_CH) RW_LDS(s + 3)
        const f32x4 r4 = R4[s], k4 = K4[s], d4 = D4[s], kd4 = KD4[s], ka4 = KA4[s]; const float vv = VV[s];
        const f32x2 k01 = {k4[0], k4[1]}, k23 = {k4[2], k4[3]}, d01 = {d4[0], d4[1]}, d23 = {d4[2], d4[3]};
        const f32x2 kd01 = {kd4[0], kd4[1]}, kd23 = {kd4[2], kd4[3]}, ka01 = {ka4[0], ka4[1]}, ka23 = {ka4[2], ka4[3]};
        const f32x2 r01 = {r4[0], r4[1]}, r23 = {r4[2], r4[3]};
        const f32x2 sa2 = __builtin_elementwise_fma(S23, k23, S01 * k01);
        float sa = sa2[0] + sa2[1];
        sa = rowsum16(sa);
        const f32x2 vv2 = {vv, vv}; const f32x2 nsa = {-sa, -sa};
        f32x2 T01 = __builtin_elementwise_fma(-S01, d01, S01), T23 = __builtin_elementwise_fma(-S23, d23, S23);
        T01 = __builtin_elementwise_fma(vv2, kd01, T01); T23 = __builtin_elementwise_fma(vv2, kd23, T23);
        S01 = __builtin_elementwise_fma(nsa, ka01, T01); S23 = __builtin_elementwise_fma(nsa, ka23, T23);
        const f32x2 y2 = __builtin_elementwise_fma(S23, r23, S01 * r01);
        *(float*)(pbuf + (((s & 7) * 4 + rsub) * 16 + g) * 4) = y2[0] + y2[1];
        if ((s & 7) == 7) {
          if (lane < 32) {
            const char* pr = pbuf + lane * 64;
            const f32x4 a0 = *(const f32x4*)(pr), a1 = *(const f32x4*)(pr + 16), a2 = *(const f32x4*)(pr + 32), a3 = *(const f32x4*)(pr + 48);
            const f32x4 sm = (a0 + a1) + (a2 + a3);
            const float y = (sm[0] + sm[1]) + (sm[2] + sm[3]);
            *(hf*)(ybuf + (c & 1) * 512 + (((s >> 3) * 8 + (lane >> 2)) * 16 + wid * 4 + (lane & 3)) * 2) = (hf)y;
          }
        }
      }
      if (c + 2 < NCH) RW_SSTORE(c + 2)
      __syncthreads();
    }
    if (tid < 32) {
      const int mb_ = RW_M0((NCH - 1) * RW_CH); const size_t mv = (size_t)(mb_ + sgn * (tid >> 1));
      *(uint4*)(g_y + mv * ldy) = *(const uint4*)(ybuf + ((NCH - 1) & 1) * 512 + tid * 16);
    }
    __syncthreads();
  }
}

__device__ __forceinline__ void ph_rwpost(const P& p, int l) {
  const hf* ZRW = RW_ZRW(p); const hf* RKV = RW_RKV(p); const hf* YR = RW_YR(p);
  const int lane = get_tid() & 63, wid = get_tid() >> 6;
  const int nw = gridDim.x * 4;
  for (int t = blockIdx.x * 4 + wid; t < M_ALL * 6; t += nw) {
    const int m = t / 6, h = t % 6; const int c = h * 64 + lane;
    const float ys = (float)RKV[(size_t)m * 1152 + 384 + c] + (float)YR[(size_t)m * 384 + c];
    const float mean = wavesum(ys) * (1.f / 64.f);
    const float xc = ys - mean;
    const float var = wavesum(xc * xc) * (1.f / 64.f);
    float y = xc * rsqrtf(var + 64e-5f) * p.in[21][(size_t)l * 384 + c] + p.in[22][(size_t)l * 384 + c];
    const float r = (float)RKV[(size_t)m * 1152 + c], v = (float)RKV[(size_t)m * 1152 + 768 + c];
    const float rk = p.in[20][(size_t)l * 384 + c];
    const float kd0 = (float)RW_KD(p)[(size_t)m * 384 + c], kd1 = (float)RW_KD(p)[((size_t)M_ALL + m) * 384 + c];
    const float bs = wavesum(r * (kd0 + kd1) * rk);
    y = (y + bs * v) * (float)ZRW[(size_t)m * 1152 + 768 + c];
    p.Y[(size_t)m * 1024 + c] = f2bf(y);
  }
}

struct S5C { float ar, ai; float br[16], bi[16]; };
__device__ __forceinline__ void s5_consts(const P& p, int l, int d, int g, int n, S5C& c) {
  const int ig = (l * 2 + d) * 16 + g;
  const float lr = fminf(p.in[23][(size_t)ig * 64 + n], -1e-4f), li = p.in[24][(size_t)ig * 64 + n];
  const float dt = expf(p.in[25][ig]);
  const float mag = expf(lr * dt);
  c.ar = mag * cosf(li * dt); c.ai = mag * sinf(li * dt);
  const float nr = c.ar - 1.f, ni = c.ai; const float den = 1.f / (lr * lr + li * li);
  const float cr = (nr * lr + ni * li) * den, ci = (ni * lr - nr * li) * den;
  const float* bre = p.in[26] + ((size_t)ig * 64 + n) * 16; const float* bim = p.in[27] + ((size_t)ig * 64 + n) * 16;
#pragma unroll
  for (int h = 0; h < 16; ++h) { const float xr = bre[h], xi = bim[h]; c.br[h] = cr * xr - ci * xi; c.bi[h] = cr * xi + ci * xr; }
}
__device__ __forceinline__ int s5_m0(int b, int tc) { return tc < 128 ? b * 8192 + tc * 64 : M_LAT + b * 256 + (tc - 128) * 64; }
__device__ __forceinline__ int chain_pos(int d, int tc) { return d == 0 ? (tc < 128 ? tc + 4 : tc - 128) : (tc < 128 ? 131 - tc : 131 - tc); }
__device__ __forceinline__ void s5_cf(const P& p, int ig, int n, float dt, float& ar, float& ai, float& cr, float& ci) {
  const float lr = fminf(p.in[23][(size_t)ig * 64 + n], -1e-4f), li = p.in[24][(size_t)ig * 64 + n];
  const float mag = expf(lr * dt);
  ar = mag * cosf(li * dt); ai = mag * sinf(li * dt);
  const float nr = ar - 1.f, ni = ai; const float den = 1.f / (lr * lr + li * li);
  cr = (nr * lr + ni * li) * den; ci = (ni * lr - nr * li) * den;
}
__device__ __forceinline__ void ph_s5_pass(const P& p, int l, int pass, char* lds, int vb, int nvb) {
  const int tid = get_tid(), lane = tid & 63, wid = tid >> 6, fr = lane & 15, fq = lane >> 4;
  float* ub = (float*)(lds + wid * 16896);
  char* xs = lds + wid * 16896 + 4096;
  float* bu = (float*)(lds + wid * 16896 + 8448);
  const hf* Z = S5_ZH(p); float2* E = S5_E(p); const float2* X = S5_X(p); bf16_t* YG = S5_YG(p);
  const int nw = nvb * 4;
  for (int t = vb * 4 + wid; t < 4 * 132 * 16; t += nw) {
    const int g = t & 15, tc = (t >> 4) % 132, b = t / (16 * 132);
    const int m0 = s5_m0(b, tc);
#pragma unroll
    for (int i = 0; i < 4; ++i) { const int e = lane + i * 64; const int tok = e >> 2, q = e & 3;
      const hf4 zv = *(const hf4*)(Z + (size_t)(m0 + tok) * 256 + g * 16 + q * 4);
      *(float4*)(ub + tok * 16 + q * 4) = make_float4((float)zv[0], (float)zv[1], (float)zv[2], (float)zv[3]); }
    f32x4 yacc[4];
#pragma unroll
    for (int i = 0; i < 4; ++i) yacc[i] = (f32x4){0.f, 0.f, 0.f, 0.f};
    for (int d = 0; d < 2; ++d) {
      const int ig = (l * 2 + d) * 16 + g;
      const float dt = expf(p.in[25][ig]);
      float ar, ai, crn, cin_;
      s5_cf(p, ig, lane, dt, ar, ai, crn, cin_);
      hf8 bfB[8];
#pragma unroll
      for (int q4 = 0; q4 < 4; ++q4) {
        const int n = q4 * 16 + fr;
        float a_r, a_i, cr, ci; s5_cf(p, ig, n, dt, a_r, a_i, cr, ci);
        hf8 re, im;
        if (fq < 2) {
          const float* bre = p.in[26] + ((size_t)ig * 64 + n) * 16 + fq * 8; const float* bim = p.in[27] + ((size_t)ig * 64 + n) * 16 + fq * 8;
          const float4 r0 = *(const float4*)bre, r1 = *(const float4*)(bre + 4), i0 = *(const float4*)bim, i1 = *(const float4*)(bim + 4);
          const float xr[8] = {r0.x, r0.y, r0.z, r0.w, r1.x, r1.y, r1.z, r1.w}, xi[8] = {i0.x, i0.y, i0.z, i0.w, i1.x, i1.y, i1.z, i1.w};
#pragma unroll
          for (int k = 0; k < 8; ++k) { re[k] = (hf)(1024.f * (cr * xr[k] - ci * xi[k])); im[k] = (hf)(1024.f * (cr * xi[k] + ci * xr[k])); }
        } else {
#pragma unroll
          for (int k = 0; k < 8; ++k) { re[k] = (hf)0.f; im[k] = (hf)0.f; }
        }
        bfB[q4] = re; bfB[q4 + 4] = im;
      }
      const int cp = chain_pos(d, tc);
      const size_t sidx = (((size_t)(d * 4 + b) * 132 + cp) * 16 + g) * 64 + lane;
      float xr = 0.f, xi = 0.f;
      hf8 cf[4];
      if (pass == 3) {
        float2 x0 = X[sidx]; xr = x0.x; xi = x0.y;
#pragma unroll
        for (int ks = 0; ks < 4; ++ks) {
          const int c0 = ks * 32 + fq * 8;
          const float* src_ = (c0 < 64 ? p.in[28] : p.in[29]) + ((size_t)ig * 16 + fr) * 64 + (c0 & 63);
          const float sg = c0 < 64 ? 1.f : -1.f;
          const float4 v0 = *(const float4*)src_, v1 = *(const float4*)(src_ + 4);
          cf[ks][0] = (hf)(sg * v0.x); cf[ks][1] = (hf)(sg * v0.y); cf[ks][2] = (hf)(sg * v0.z); cf[ks][3] = (hf)(sg * v0.w);
          cf[ks][4] = (hf)(sg * v1.x); cf[ks][5] = (hf)(sg * v1.y); cf[ks][6] = (hf)(sg * v1.z); cf[ks][7] = (hf)(sg * v1.w);
        }
      }
#pragma unroll 1
      for (int jb = 0; jb < 4; ++jb) {
        const int tb = d ? 3 - jb : jb;
        {
          hf8 au;
          if (fq < 2) {
            const float* up = ub + (tb * 16 + fr) * 16 + fq * 8;
            const float4 u0 = *(const float4*)up, u1 = *(const float4*)(up + 4);
            au[0] = (hf)u0.x; au[1] = (hf)u0.y; au[2] = (hf)u0.z; au[3] = (hf)u0.w; au[4] = (hf)u1.x; au[5] = (hf)u1.y; au[6] = (hf)u1.z; au[7] = (hf)u1.w;
          } else {
#pragma unroll
            for (int k = 0; k < 8; ++k) au[k] = (hf)0.f;
          }
#pragma unroll
          for (int nb = 0; nb < 8; ++nb) {
            f32x4 ab = (f32x4){0.f, 0.f, 0.f, 0.f};
            ab = __builtin_amdgcn_mfma_f32_16x16x32_f16(au, bfB[nb], ab, 0, 0, 0);
#pragma unroll
            for (int j = 0; j < 4; ++j) bu[(fq * 4 + j) * 132 + nb * 16 + fr] = ab[j];
          }
        }
#pragma unroll 4
        for (int jj = 0; jj < 16; ++jj) {
          const int t16 = d ? 15 - jj : jj;
          const float br = bu[t16 * 132 + lane] * 0.0009765625f, bi = bu[t16 * 132 + 64 + lane] * 0.0009765625f;
          const float nr = ar * xr - ai * xi + br, ni = ar * xi + ai * xr + bi;
          xr = nr; xi = ni;
          if (pass == 3) { *(hf*)(xs + t16 * 272 + lane * 2) = (hf)xr; *(hf*)(xs + t16 * 272 + 128 + lane * 2) = (hf)xi; }
        }
        if (pass == 3) {
          f32x4 acc = (f32x4){0.f, 0.f, 0.f, 0.f};
#pragma unroll
          for (int ks = 0; ks < 4; ++ks) {
            const hf8 af = *(const hf8*)(xs + fr * 272 + ks * 64 + fq * 16);
            acc = __builtin_amdgcn_mfma_f32_16x16x32_f16(af, cf[ks], acc, 0, 0, 0);
          }
#pragma unroll
          for (int i = 0; i < 4; ++i) if (i == tb) yacc[i] += acc;
        }
      }
      if (pass == 1) E[sidx] = make_float2(xr, xi);
    }
    if (pass == 3) {
      const float dsk = p.in[30][(size_t)l * 256 + g * 16 + fr];
#pragma unroll
      for (int i = 0; i < 4; ++i)
#pragma unroll
        for (int j = 0; j < 4; ++j) {
          const int tok = i * 16 + fq * 4 + j;
          float y = yacc[i][j] + dsk * ub[tok * 16 + fr];
          const float inner = 0.7978845608028654f * (y + 0.044715f * y * y * y);
          y = 0.5f * y * (1.f + tanhf_(inner));
          YG[(size_t)(m0 + tok) * 256 + g * 16 + fr] = f2bf(y);
        }
    }
  }
}
__device__ __forceinline__ void ph_s5_carry(const P& p, int l, int vb, int nvb) {
  float2* E = S5_E(p); float2* X = S5_X(p);
  for (int t = vb * NTHR + get_tid(); t < 8192; t += nvb * NTHR) {
    const int n = t & 63, g = (t >> 6) & 15, b = (t >> 10) & 3, d = t >> 12;
    const int ig = (l * 2 + d) * 16 + g;
    const float lr = fminf(p.in[23][(size_t)ig * 64 + n], -1e-4f), li = p.in[24][(size_t)ig * 64 + n];
    const float dt = expf(p.in[25][ig]);
    const float mag = expf(lr * dt * 64.f);
    float ar = expf(lr * dt) * cosf(li * dt), ai = expf(lr * dt) * sinf(li * dt);
#pragma unroll
    for (int i = 0; i < 6; ++i) { const float r2 = ar * ar - ai * ai, i2 = 2.f * ar * ai; ar = r2; ai = i2; }
    (void)mag;
    float xr = 0.f, xi = 0.f;
    const size_t base = (((size_t)(d * 4 + b) * 132) * 16 + g) * 64 + n;
    for (int cp0 = 0; cp0 < 132; cp0 += 12) {
      float2 ev[12];
#pragma unroll
      for (int u = 0; u < 12; ++u) ev[u] = E[base + (size_t)(cp0 + u) * 1024];
#pragma unroll
      for (int u = 0; u < 12; ++u) {
        X[base + (size_t)(cp0 + u) * 1024] = make_float2(xr, xi);
        const float nr = ar * xr - ai * xi + ev[u].x, ni = ar * xi + ai * xr + ev[u].y;
        xr = nr; xi = ni;
      }
    }
  }
}
__device__ __forceinline__ void ph_glu(const P& p, int l, char* lds, int vb, int nvb) {
  EPI_VARS
  const bf16_t* YG = S5_YG(p);
  const int Mt = 264;
  const float* gb = p.in[32] + (size_t)l * 256;
  for (int it = 0;; ++it) {
    int tm, tn; if (!tile_map_v(vb, nvb, it, Mt, 2, 2, tm, tn)) break; const int m0 = tm * 128, n0 = tn * 128;
    f32x4 acc[4][4]; ZERO_ACC(acc)
    gemm_main(YG + (size_t)m0 * 256, 256, p.W + W_GLU + (size_t)n0 * 256, 256, 256, acc, lds);
    EPI_BEGIN(m0, n0)
      const float y = bf2f(YG[(size_t)row * 256 + col]);
      p.Y[(size_t)row * 1024 + 384 + col] = f2bf(y * sigmoidf_(val + gb[col]));
    EPI_END
  }
}

__device__ __forceinline__ void sub_barrier(unsigned* cnt, unsigned target) {
  asm volatile("s_waitcnt vmcnt(0)" ::: "memory");
  __syncthreads();
  if (__builtin_amdgcn_workitem_id_x() == 0) {
    __builtin_amdgcn_fence(__ATOMIC_RELEASE, "agent");
    asm volatile("s_waitcnt vmcnt(0)" ::: "memory");
    __hip_atomic_fetch_add(cnt, 1u, __ATOMIC_RELAXED, __HIP_MEMORY_SCOPE_AGENT);
    unsigned sp = 0;
    while (__hip_atomic_load(cnt, __ATOMIC_RELAXED, __HIP_MEMORY_SCOPE_AGENT) < target) { __builtin_amdgcn_s_sleep(2); if (++sp > (1u << 22)) break; }
    __builtin_amdgcn_fence(__ATOMIC_ACQUIRE, "agent");
    asm volatile("s_waitcnt vmcnt(0)" ::: "memory");
  }
  __syncthreads();
}
__device__ __forceinline__ void ph_s5_stage(const P& p, int l, char* lds, int vb, int nvb) {
  unsigned* cnt = p.bar + 3584;
  const unsigned base = (unsigned)(l * 4) * (unsigned)nvb;
  ph_z_s5(p, lds, vb, nvb);            sub_barrier(cnt, base + 1u * nvb);
  ph_s5_pass(p, l, 1, lds, vb, nvb);   sub_barrier(cnt, base + 2u * nvb);
  ph_s5_carry(p, l, vb, nvb);          sub_barrier(cnt, base + 3u * nvb);
  ph_s5_pass(p, l, 3, lds, vb, nvb);   sub_barrier(cnt, base + 4u * nvb);
  ph_glu(p, l, lds, vb, nvb);
}

__device__ __forceinline__ float logsigf_(float x) { return fminf(x, 0.f) - log1pf(__expf(-fabsf(x))); }
__device__ __forceinline__ void ml_gates(const P& p, int l, int d, int h, int m0, int lane, float& bcum, float& ic) {
  const int tok = d ? 63 - lane : lane;
  const float* gl = ML_GL(p) + (size_t)(m0 + tok) * 16;
  const float* gb = p.in[33] + (size_t)(l * 2 + d) * 8;
  ic = gl[d * 8 + h] + gb[h];
  float f = logsigf_(gl[d * 8 + 4 + h] + gb[4 + h]);
#pragma unroll
  for (int o = 1; o < 64; o <<= 1) { float v = __shfl_up(f, o); if (lane >= o) f += v; }
  bcum = f;
}
__device__ __forceinline__ void ml_gates2(const P& p, int l, int d, int h, int m0, int lane, float& bc, float& ic, float& tot) {
  const float* gl = ML_GL(p) + (size_t)(m0 + lane) * 16;
  const float* gb = p.in[33] + (size_t)(l * 2 + d) * 8;
  ic = gl[d * 8 + h] + gb[h];
  const float f0 = logsigf_(gl[d * 8 + 4 + h] + gb[4 + h]);
  float f = f0;
#pragma unroll
  for (int o = 1; o < 64; o <<= 1) { float v = __shfl_up(f, o); if (lane >= o) f += v; }
  tot = __shfl(f, 63);
  bc = d ? (tot - f + f0) : f;
}
#define MLQ 208
#define MLS 144
__device__ __forceinline__ void ph_ml_a(const P& p, int l, char* lds) {
  char* vt = lds; char* kt = lds + 13824; float* wg = (float*)(lds + 27648);
  const int tid = get_tid(), lane = tid & 63, wid = tid >> 6, fr = lane & 15, fq = lane >> 4;
  const hf* QK = ML_QK(p); const hf* Z = ML_Z(p);
  for (int t = blockIdx.x; t < 4224; t += gridDim.x) {
    const int tc = t % 132, h = (t / 132) & 3, b = (t / 528) & 3, d = t / 2112;
    const int m0 = s5_m0(b, tc); const int cp = chain_pos(d, tc);
    const size_t task = ((size_t)((d * 4 + b) * 4 + h)) * 132 + cp;
    if (wid == 0) {
      float bc, ic, tot; ml_gates2(p, l, d, h, m0, lane, bc, ic, tot);
      const float lw = tot - bc + ic;
      float mx = lw;
      for (int o = 32; o > 0; o >>= 1) mx = fmaxf(mx, __shfl_xor(mx, o));
      wg[lane] = __expf(lw - mx);
      if (lane == 0) { ML_SC(p)[task * 2] = mx; ML_SC(p)[task * 2 + 1] = tot; }
    }
    __syncthreads();
    for (int e = tid; e < 64 * 12; e += NTHR) {
      const int tok = e & 63, q = e >> 6;
      const hf8 kv = *(const hf8*)(QK + (size_t)(m0 + tok) * 768 + 384 + h * 96 + q * 8);
      const hf8 vv = *(const hf8*)(Z + (size_t)(m0 + tok) * 1536 + 768 + h * 96 + q * 8);
      const float w = wg[tok];
#pragma unroll
      for (int i = 0; i < 8; ++i) {
        *(hf*)(kt + (q * 8 + i) * MLS + tok * 2) = kv[i];
        *(hf*)(vt + (q * 8 + i) * MLS + tok * 2) = (hf)((float)vv[i] * w);
      }
    }
    __syncthreads();
    float* dc = ML_DC(p) + task * 9216;
#pragma unroll 1
    for (int bi = 0; bi < 9; ++bi) {
      const int idx = wid * 9 + bi; const int mb = idx / 6, nb = idx % 6;
      f32x4 acc = (f32x4){0.f, 0.f, 0.f, 0.f};
#pragma unroll
      for (int ks = 0; ks < 2; ++ks) {
        const hf8 af = *(const hf8*)(vt + (mb * 16 + fr) * MLS + ks * 64 + fq * 16);
        const hf8 bf = *(const hf8*)(kt + (nb * 16 + fr) * MLS + ks * 64 + fq * 16);
        acc = __builtin_amdgcn_mfma_f32_16x16x32_f16(af, bf, acc, 0, 0, 0);
      }
#pragma unroll
      for (int j = 0; j < 4; ++j) dc[(mb * 16 + fq * 4 + j) * 96 + nb * 16 + fr] = acc[j];
    }
    if (tid < 96) {
      float s = 0.f;
      for (int j = 0; j < 64; ++j) s += wg[j] * (float)*(const hf*)(kt + tid * MLS + j * 2);
      ML_DN(p)[task * 96 + tid] = s;
    }
    __syncthreads();
  }
}
__device__ __forceinline__ void ph_ml_b(const P& p) {
  float* DC = ML_DC(p); float* DN = ML_DN(p); const float* SC = ML_SC(p); float* MP = ML_MP(p);
  for (int t = blockIdx.x * NTHR + get_tid(); t < 32 * 9312; t += gridDim.x * NTHR) {
    const int chain = t / 9312, e = t % 9312;
    float cur = 0.f, mprev = 0.f;
    for (int cp0 = 0; cp0 < 132; cp0 += 12) {
      float dl[12], ml_[12], bl_[12];
#pragma unroll
      for (int u = 0; u < 12; ++u) {
        const size_t task = (size_t)chain * 132 + cp0 + u;
        dl[u] = e < 9216 ? DC[task * 9216 + e] : DN[task * 96 + (e - 9216)];
        ml_[u] = SC[task * 2]; bl_[u] = SC[task * 2 + 1];
      }
#pragma unroll
      for (int u = 0; u < 12; ++u) {
        const size_t task = (size_t)chain * 132 + cp0 + u;
        float* slot = e < 9216 ? DC + task * 9216 + e : DN + task * 96 + (e - 9216);
        *slot = cur;
        if (e == 0) MP[task] = mprev;
        const float mnew = fmaxf(bl_[u] + mprev, ml_[u]);
        cur = __expf(bl_[u] + mprev - mnew) * cur + __expf(ml_[u] - mnew) * dl[u];
        mprev = mnew;
      }
    }
  }
}
__device__ __forceinline__ void ph_ml_c(const P& p, int l, char* lds) {
  char* qs = lds; char* ks = lds + 13312; char* vt = lds + 26624; char* cs = lds + 40448; char* ps = lds + 60416;
  float* fl = (float*)(lds + 69632);
  float* bc = fl; float* icv = fl + 128; float* mr = fl + 256; float* inter = fl + 320; float* den = fl + 384; float* nq = fl + 448; float* nst = fl + 512;
  const int tid = get_tid(), lane = tid & 63, wid = tid >> 6, fr = lane & 15, fq = lane >> 4;
  const hf* QK = ML_QK(p); const hf* Z = ML_Z(p);
  const int ntc = (l == 1) ? 128 : 132;
  for (int t = blockIdx.x; t < 16 * ntc; t += gridDim.x) {
    const int tc = t % ntc, h = (t / ntc) & 3, b = t / (4 * ntc);
    const int m0 = s5_m0(b, tc);
    for (int e = tid; e < 64 * 12; e += NTHR) {
      const int tok = e & 63, q = e >> 6;
      *(hf8*)(qs + tok * MLQ + q * 16) = *(const hf8*)(QK + (size_t)(m0 + tok) * 768 + h * 96 + q * 8);
      *(hf8*)(ks + tok * MLQ + q * 16) = *(const hf8*)(QK + (size_t)(m0 + tok) * 768 + 384 + h * 96 + q * 8);
      const hf8 vv = *(const hf8*)(Z + (size_t)(m0 + tok) * 1536 + 768 + h * 96 + q * 8);
#pragma unroll
      for (int i = 0; i < 8; ++i) *(hf*)(vt + (q * 8 + i) * MLS + tok * 2) = vv[i];
    }
    if (wid < 2) { float bcv, ic, tot; ml_gates2(p, l, wid, h, m0, lane, bcv, ic, tot); bc[wid * 64 + lane] = bcv; icv[wid * 64 + lane] = ic; }
    f32x4 hs[6];
#pragma unroll
    for (int n = 0; n < 6; ++n) hs[n] = (f32x4){0.f, 0.f, 0.f, 0.f};
    for (int d = 0; d < 2; ++d) {
      const int cp = chain_pos(d, tc);
      const size_t task = ((size_t)((d * 4 + b) * 4 + h)) * 132 + cp;
      const float mprev = ML_MP(p)[task];
      __syncthreads();
      {
        const float* cg = ML_DC(p) + task * 9216;
        for (int e = tid; e < 96 * 24; e += NTHR) {
          const int v = e / 24, q = e % 24;
          const float4 c4 = *(const float4*)(cg + v * 96 + q * 4);
          hf4 o; o[0] = (hf)c4.x; o[1] = (hf)c4.y; o[2] = (hf)c4.z; o[3] = (hf)c4.w;
          *(hf4*)(cs + v * MLQ + q * 8) = o;
        }
        if (tid < 96) nst[tid] = ML_DN(p)[task * 96 + tid];
      }
      const float* bcd = bc + d * 64; const float* icd = icv + d * 64;
      if (tid < 64) {
        const int j = tid; const float bj = bcd[j];
        float mx = bj + mprev;
        if (d == 0) { for (int s = 0; s <= j; ++s) mx = fmaxf(mx, bj - bcd[s] + icd[s]); }
        else { for (int s = j; s < 64; ++s) mx = fmaxf(mx, bj - bcd[s] + icd[s]); }
        mr[j] = mx; inter[j] = __expf(bj + mprev - mx);
      }
      __syncthreads();
      if (tid < 64) {
        float s1 = 0.f;
        for (int k = 0; k < 96; ++k) s1 += nst[k] * (float)*(const hf*)(qs + tid * MLQ + k * 2);
        nq[tid] = s1;
      }
      {
        f32x4 sacc[4];
#pragma unroll
        for (int n = 0; n < 4; ++n) sacc[n] = (f32x4){0.f, 0.f, 0.f, 0.f};
#pragma unroll
        for (int kk = 0; kk < 3; ++kk) {
          const hf8 af = *(const hf8*)(qs + (wid * 16 + fr) * MLQ + kk * 64 + fq * 16);
#pragma unroll
          for (int n = 0; n < 4; ++n) {
            const hf8 bf = *(const hf8*)(ks + (n * 16 + fr) * MLQ + kk * 64 + fq * 16);
            sacc[n] = __builtin_amdgcn_mfma_f32_16x16x32_f16(af, bf, sacc[n], 0, 0, 0);
          }
        }
        float rs[4] = {0.f, 0.f, 0.f, 0.f};
#pragma unroll
        for (int n = 0; n < 4; ++n) {
          const int s = n * 16 + fr; const float bs = bcd[s] - icd[s];
#pragma unroll
          for (int jj = 0; jj < 4; ++jj) {
            const int j = wid * 16 + fq * 4 + jj;
            const bool valid = d == 0 ? (s <= j) : (s >= j);
            const float val = valid ? sacc[n][jj] * __expf(bcd[j] - bs - mr[j]) : 0.f;
            rs[jj] += val;
            *(hf*)(ps + j * MLS + s * 2) = (hf)val;
          }
        }
        __syncthreads();
#pragma unroll
        for (int jj = 0; jj < 4; ++jj) {
          const float r = rowsum16(rs[jj]);
          const int j = wid * 16 + fq * 4 + jj;
          if (fr == 0) den[j] = inter[j] * nq[j] + r;
        }
      }
      f32x4 acc[6];
#pragma unroll
      for (int n = 0; n < 6; ++n) acc[n] = (f32x4){0.f, 0.f, 0.f, 0.f};
#pragma unroll
      for (int kk = 0; kk < 3; ++kk) {
        const hf8 af = *(const hf8*)(qs + (wid * 16 + fr) * MLQ + kk * 64 + fq * 16);
#pragma unroll
        for (int n = 0; n < 6; ++n) {
          const hf8 bf = *(const hf8*)(cs + (n * 16 + fr) * MLQ + kk * 64 + fq * 16);
          acc[n] = __builtin_amdgcn_mfma_f32_16x16x32_f16(af, bf, acc[n], 0, 0, 0);
        }
      }
#pragma unroll
      for (int jj = 0; jj < 4; ++jj) { const float it = inter[wid * 16 + fq * 4 + jj];
#pragma unroll
        for (int n = 0; n < 6; ++n) acc[n][jj] *= it; }
#pragma unroll
      for (int kk = 0; kk < 2; ++kk) {
        const hf8 af = *(const hf8*)(ps + (wid * 16 + fr) * MLS + kk * 64 + fq * 16);
#pragma unroll
        for (int n = 0; n < 6; ++n) {
          const hf8 bf = *(const hf8*)(vt + (n * 16 + fr) * MLS + kk * 64 + fq * 16);
          acc[n] = __builtin_amdgcn_mfma_f32_16x16x32_f16(af, bf, acc[n], 0, 0, 0);
        }
      }
      __syncthreads();
#pragma unroll
      for (int jj = 0; jj < 4; ++jj) {
        const int j = wid * 16 + fq * 4 + jj;
        const float dn = 1.f / fmaxf(fabsf(den[j]), __expf(-mr[j]));
#pragma unroll
        for (int n = 0; n < 6; ++n) hs[n][jj] += acc[n][jj] * dn;
      }
    }
#pragma unroll
    for (int jj = 0; jj < 4; ++jj) {
      const int m = m0 + wid * 16 + fq * 4 + jj;
      const hf* op = Z + (size_t)m * 1536 + 1152 + h * 96 + fr;
      float x[6]; float s = 0.f;
#pragma unroll
      for (int n = 0; n < 6; ++n) { x[n] = sigmoidf_((float)op[n * 16]) * hs[n][jj]; s += x[n]; }
      s = rowsum16(s);
      const float mean = s * (1.f / 96.f);
      float q = 0.f;
#pragma unroll
      for (int n = 0; n < 6; ++n) { x[n] -= mean; q += x[n] * x[n]; }
      q = rowsum16(q);
      const float rsd = rsqrtf(q * (1.f / 96.f) + 1e-5f);
      const float* ng = p.in[34] + (size_t)l * 384 + h * 96 + fr;
      bf16_t* yp = p.Y + (size_t)m * 1024 + 640 + h * 96 + fr;
#pragma unroll
      for (int n = 0; n < 6; ++n) yp[n * 16] = f2bf(x[n] * rsd * ng[n * 16]);
    }
    __syncthreads();
  }
}

#define MG_YM(p) ((bf16_t*)(p).R)
#define MG_G3(p) (MG_YM(p) + (size_t)M_ALL * 1024)
__device__ __forceinline__ void ph_gates(const P& p, int l, int Mt, char* lds) {
  EPI_VARS
  bf16_t* G3 = MG_G3(p);
  const float* gbias = p.in[38] + (size_t)l * 3072;
  STREAM_BEGIN(Mt, 24, 8, (p.U + (size_t)(tm * 128) * 1024), (p.W + W_IN + (size_t)(3216 + tn * 128) * 1024), 1024, 1024, 1024)
    const int m0 = tm * 128, n0 = tn * 128;
    EPI_BEGIN(m0, n0)
      G3[(size_t)row * 3072 + col] = f2bf(sigmoidf_(val + gbias[col]));
    EPI_END
  STREAM_END
}
__device__ __forceinline__ void ph_merge(const P& p, int l, int Mt, char* lds) {
  EPI_VARS
  bf16_t* YM = MG_YM(p); const bf16_t* G3 = MG_G3(p);
  const int ntile = Mt * 16;
  for (int it = 0;; ++it) {
    int tm, tn; if (!tile_map(it, Mt, 16, 8, tm, tn)) break; const int m0 = tm * 128, n0 = tn * 64;
    f32x4 yacc[4][2];
#pragma unroll
    for (int m = 0; m < 4; ++m) { yacc[m][0] = (f32x4){0.f, 0.f, 0.f, 0.f}; yacc[m][1] = (f32x4){0.f, 0.f, 0.f, 0.f}; }
#pragma unroll 1
    for (int br = 0; br < 3; ++br) {
      f32x4 acc[4][2];
#pragma unroll
      for (int m = 0; m < 4; ++m) { acc[m][0] = (f32x4){0.f, 0.f, 0.f, 0.f}; acc[m][1] = (f32x4){0.f, 0.f, 0.f, 0.f}; }
      const int kb = br == 1 ? 256 : 384; const int yoff = br == 0 ? 0 : (br == 1 ? 384 : 640);
      const int woff = br == 0 ? W_UPRW : (br == 1 ? W_UPS5 : W_UPML);
      gemm_main_t<2>(p.Y + (size_t)m0 * 1024 + yoff, 1024, p.W + woff + (size_t)n0 * kb, kb, kb, acc, lds);
      EPI_ROW_BEGIN(m0)
        const bf16_t* gp = G3 + (size_t)row * 3072 + br * 1024 + n0 + wc * 32 + fr;
#pragma unroll
        for (int n = 0; n < 2; ++n) yacc[m][n][j] += bf2f(gp[n * 16]) * acc[m][n][j];
      EPI_ROW_END
    }
    EPI_ROW_BEGIN(m0)
      bf16_t* yp = YM + (size_t)row * 1024 + n0 + wc * 32 + fr;
#pragma unroll
      for (int n = 0; n < 2; ++n) yp[n * 16] = f2bf(yacc[m][n][j]);
    EPI_ROW_END
  }
}
__device__ __forceinline__ void ph_wout(const P& p, int l, int Mt, char* lds) {
  EPI_VARS
  const bf16_t* YM = (const bf16_t*)p.R;
  STREAM_BEGIN(Mt, 8, 8, (YM + (size_t)(tm * 128) * 1024), (p.W + W_OUT + (size_t)(tn * 128) * 1024), 1024, 1024, 1024)
    const int m0 = tm * 128, n0 = tn * 128;
    EPI_ROW_BEGIN(m0)
      float* sp = srow(p, row) + n0 + wc * 64 + fr; const float* gp = modp(p, l, row, 5) + n0 + wc * 64 + fr;
#pragma unroll
      for (int n = 0; n < 4; ++n) sp[n * 16] = ALPHA * sp[n * 16] + gp[n * 16] * acc[m][n][j];
    EPI_ROW_END
  STREAM_END
}

#define XB_TMO      128
#define XB_XCNT(j)  (256  + 64 * (j))
#define XB_XSUB(j)  (1280 + 64 * (j))
#define XB_XGEN(j)  (2304 + 64 * (j))
#define XB_TOP      3328
#define XB_TOPGEN   3392
#define XCD_BAR_WORDS 3456
#define XB_SPIN_CAP (1u << 18)
#define LAS __attribute__((address_space(3)))

__device__ __forceinline__ unsigned xb_ld(unsigned* p)              { return __hip_atomic_load(p, __ATOMIC_RELAXED, __HIP_MEMORY_SCOPE_AGENT); }
__device__ __forceinline__ unsigned xb_add(unsigned* p, unsigned v) { return __hip_atomic_fetch_add(p, v, __ATOMIC_RELAXED, __HIP_MEMORY_SCOPE_AGENT); }
__device__ __forceinline__ unsigned xb_xcc_id() { return (unsigned)__builtin_amdgcn_s_getreg((3 << 11) | 20) & 0xFu; }
#define XB_SPIN(cond, bar) do { unsigned _sp = 0; while (cond) { __builtin_amdgcn_s_sleep(1); \
    if ((++_sp & 255u) == 0u) { if (xb_ld(&(bar)[XB_TMO])) break; if (_sp > XB_SPIN_CAP) { atomicAdd(&(bar)[XB_TMO], 1u); break; } } } } while (0)

struct XcdBarrier {
    unsigned* bar; unsigned x;
    volatile LAS unsigned* st;
};

__device__ __forceinline__ XcdBarrier xcd_barrier_post(unsigned* bar, volatile LAS unsigned* st) {
    XcdBarrier b; b.bar = bar; b.x = xb_xcc_id(); b.st = st;
    if (__builtin_amdgcn_workitem_id_x() == 0) (void)xb_add(&bar[XB_XCNT(b.x)], 1u);
    return b;
}
__device__ __forceinline__ void xcd_barrier_complete(unsigned* bar, unsigned x, unsigned& nloc, unsigned& nx) {
    const unsigned G = gridDim.x * gridDim.y * gridDim.z;
    unsigned sum, cnt, mine, sp = 0u;
    for (;;) {
        sum = 0u; cnt = 0u; mine = 0u;
#pragma unroll
        for (unsigned j = 0; j < 16; ++j) { const unsigned c = xb_ld(&bar[XB_XCNT(j)]); sum += c; cnt += (c > 0u) ? 1u : 0u; mine = (j == x) ? c : mine; }
        if (sum == G) break;
        __builtin_amdgcn_s_sleep(1);
        if ((++sp & 255u) == 0u) { if (xb_ld(&bar[XB_TMO])) break; if (sp > XB_SPIN_CAP) { atomicAdd(&bar[XB_TMO], 1u); break; } }
    }
    nloc = mine > 0u ? mine : 1u; nx = cnt > 0u ? cnt : 1u;
}

__device__ __forceinline__ void xcd_barrier(const XcdBarrier& b) {
    asm volatile("s_waitcnt vmcnt(0)" ::: "memory");
    __syncthreads();
    if (__builtin_amdgcn_workitem_id_x() == 0) {
        unsigned* bar = b.bar;
        __builtin_amdgcn_s_waitcnt(0);
        unsigned nloc = b.st[0], nx = b.st[1];
        if (nloc == 0u) { xcd_barrier_complete(bar, b.x, nloc, nx); b.st[0] = nloc; b.st[1] = nx; }
        const unsigned old = xb_add(&bar[XB_XSUB(b.x)], 1u);
        const unsigned gen = old / nloc;
        if (old + 1u == (gen + 1u) * nloc) {
            __builtin_amdgcn_fence(__ATOMIC_RELEASE, "agent");
            asm volatile("s_waitcnt vmcnt(0)" ::: "memory");
            const unsigned og = xb_add(&bar[XB_TOP], 1u);
            const unsigned tg = og / nx;
            if (og + 1u == (tg + 1u) * nx) xb_add(&bar[XB_TOPGEN], 1u);
            else XB_SPIN(xb_ld(&bar[XB_TOPGEN]) == tg, bar);
            __builtin_amdgcn_fence(__ATOMIC_ACQUIRE, "agent");
            xb_add(&bar[XB_XGEN(b.x)], 1u);
            asm volatile("s_waitcnt vmcnt(0)" ::: "memory");
        } else {
            XB_SPIN(xb_ld(&bar[XB_XGEN(b.x)]) == gen, bar);
            __builtin_amdgcn_fence(__ATOMIC_ACQUIRE, "agent");
            asm volatile("s_waitcnt vmcnt(0)" ::: "memory");
        }
    }
    __syncthreads();
}


#define SYNC xcd_barrier(xb); asm volatile("" : "+s"(l));
__global__ void __launch_bounds__(NTHR, 2) mega(P pv) {
#define p pv
  __shared__ __attribute__((aligned(16))) char lds[LDS_BYTES];
  __shared__ uint4 xb_words;
  cg::grid_group grid = cg::this_grid();
  {
    const int t0 = __builtin_amdgcn_workitem_id_x();
    if (blockIdx.x == 0) for (int i = t0; i < 4096; i += NTHR) pv.bar[i] = 0u;
    if (t0 == 0) xb_words = make_uint4(0u, 0u, 0u, 0u);
    __threadfence();
    grid.sync();
  }
  XcdBarrier xb = xcd_barrier_post(pv.bar, (volatile LAS unsigned*)&xb_words);
  for (int l = 0; l < 2; ++l) {
    const bool last = (l == 1);
    const int Mt2 = last ? 256 : 264;
    const int Mr2 = last ? M_LAT : M_ALL;
    ph_convert(p, l, l == 0, lds); SYNC
    if (l == 0) { ph_rows(p, 0, 0, 0, M_ALL, true, 0, 0); SYNC }
    ph_ffn_up(p, 0, 264, lds); SYNC
    ph_ffn_down(p, l, 0, 264, lds); SYNC
    ph_rows(p, 1, l, 0, M_ALL, true, l, 3); SYNC
    ph_z_rw(p, lds); SYNC
    ph_conv<0>(p, l); SYNC
    ph_lora(p, l, lds); SYNC
    {
      const int ns = gridDim.x >= 384 ? 192 : 0;
      if (ns == 0 || blockIdx.x < 192) ph_rwscan(p, lds);
      if (ns == 0) { SYNC }
      if ((int)blockIdx.x >= ns) ph_s5_stage(p, l, lds, (int)blockIdx.x - ns, (int)gridDim.x - ns);
      SYNC
    }
    ph_rwpost(p, l); SYNC
    ph_z_ml(p, lds); SYNC
    ph_conv<1>(p, l); SYNC
    ph_ml_a(p, l, lds); SYNC
    ph_ml_b(p); SYNC
    ph_ml_c(p, l, lds); SYNC
    ph_gates(p, l, Mt2, lds); SYNC
    ph_merge(p, l, Mt2, lds); SYNC
    ph_wout(p, l, Mt2, lds); SYNC
    ph_rows(p, 1, l, 1, Mr2, true, l, 6); SYNC
    ph_ffn_up(p, 1, Mt2, lds); SYNC
    ph_ffn_down(p, l, 1, Mt2, lds); SYNC
    ph_rows(p, 1, l, 2, Mr2, !last, l + 1, 0);
    if (!last) { SYNC }
  }
#undef p
}

extern "C" void kernel_launch(void* const* d_in, const int* in_sizes, int n_in, void* d_out, int out_size, void* d_ws, size_t ws_size,
                              hipStream_t stream) {
  static int grid_blocks = 0;
  if (!grid_blocks) {
    int dev = 0, cus = 0, per_cu = 0;
    hipGetDevice(&dev);
    hipDeviceGetAttribute(&cus, hipDeviceAttributeMultiprocessorCount, dev);
    hipOccupancyMaxActiveBlocksPerMultiprocessor(&per_cu, mega, NTHR, 0);
    if (per_cu > 2) per_cu = 2;
    grid_blocks = cus * per_cu;
  }
  P p{};
  for (int i = 0; i < 40; ++i) p.in[i] = (const float*)d_in[i];
  char* ws = (char*)d_ws;
  size_t off = 0;
  p.W = (bf16_t*)(ws + off); off += (size_t)W_TOTAL * 2;
  p.mod = (float*)(ws + off); off += (size_t)2 * 5 * 9216 * 4;
  p.sctx = (float*)(ws + off); off += (size_t)1024 * 1024 * 4;
  p.bar = (unsigned*)(ws + off); off += (size_t)16384;
  p.U = (bf16_t*)(ws + off); off += (size_t)M_ALL * 1024 * 2;
  p.Y = (bf16_t*)(ws + off); off += (size_t)M_ALL * 1024 * 2;
  p.R = ws + off;
  p.out = (float*)d_out;
  if (off + (size_t)M_ALL * 9728 > ws_size) fprintf(stderr, "workspace too small: need %zu have %zu\n", off + (size_t)M_ALL * 9728, ws_size);
  void* args[] = {&p};
  hipError_t e = hipLaunchCooperativeKernel((void*)mega, dim3(grid_blocks), dim3(NTHR), args, 0, stream);
  if (e != hipSuccess) fprintf(stderr, "cooperative launch failed: %s (grid %d)\n", hipGetErrorString(e), grid_blocks);
}
```

```cpp
#include <hip/hip_runtime.h>
#include <hip/hip_cooperative_groups.h>
#include <cstdio>
namespace cg = cooperative_groups;

typedef unsigned short bf16_t;
typedef _Float16 hf;
typedef hf hf4 __attribute__((ext_vector_type(4)));
typedef hf hf8 __attribute__((ext_vector_type(8)));
typedef __attribute__((ext_vector_type(8))) short bf16x8;
typedef __attribute__((ext_vector_type(4))) float f32x4;
typedef unsigned int u32x4 __attribute__((ext_vector_type(4)));

#define M_LAT 32768
#define M_ALL 33792
#define NTHR 256
#define LDS_BYTES 73728
#define ALPHA 1.41421356237f

#define W_GU0 0
#define W_D0 5767168
#define W_GU1 8650752
#define W_D1 14417920
#define W_IN 17301504
#define W_WUP0 23740416
#define W_WUP1 23764992
#define W_AUP0 23789568
#define W_AUP1 23814144
#define W_GUP 23838720
#define W_GLU 23887872
#define W_UPRW 23953408
#define W_UPS5 24346624
#define W_UPML 24608768
#define W_OUT 25001984
#define W_TOTAL 26050560

struct P {
  const float* in[40];
  float* out; float* sctx; float* mod;
  bf16_t* U; bf16_t* Y; bf16_t* W; char* R; unsigned* bar;
};

__device__ __forceinline__ int get_tid() { int t = __builtin_amdgcn_workitem_id_x(); asm volatile("" : "+v"(t)); return t; }
__device__ __forceinline__ bf16_t f2bf(float f) { return __builtin_bit_cast(unsigned short, (_Float16)f); }
__device__ __forceinline__ float bf2f(bf16_t h) { return (float)__builtin_bit_cast(_Float16, h); }
__device__ __forceinline__ float sigmoidf_(float x) { return __builtin_amdgcn_rcpf(1.f + __expf(-x)); }
__device__ __forceinline__ float tanhf_(float x) { return 1.f - 2.f * __builtin_amdgcn_rcpf(1.f + __expf(2.f * x)); }
__device__ __forceinline__ float siluf_(float x) { return x * __builtin_amdgcn_rcpf(1.f + __expf(-x)); }
__device__ __forceinline__ float* srow(const P& p, int m) { return m < M_LAT ? p.out + (size_t)m * 1024 : p.sctx + (size_t)(m - M_LAT) * 1024; }
__device__ __forceinline__ const float* modp(const P& p, int l, int m, int k) { int mv = m < M_LAT ? (m >> 13) : 4; return p.mod + (size_t)(l * 5 + mv) * 9216 + k * 1024; }
template <int C> __device__ __forceinline__ float dppf(float x) { return __int_as_float(__builtin_amdgcn_update_dpp(0, __float_as_int(x), C, 0xf, 0xf, false)); }
__device__ __forceinline__ float rowsum16(float x) { x += dppf<0x128>(x); x += dppf<0x124>(x); x += dppf<0x122>(x); x += dppf<0x121>(x); return x; }
__device__ __forceinline__ float wavesum(float x) { for (int o = 32; o > 0; o >>= 1) x += __shfl_xor(x, o); return x; }

template <int NB>
__device__ __forceinline__ void gemm_main_t(const bf16_t* __restrict__ A, int lda, const bf16_t* __restrict__ B, int ldb, int K,
                                          f32x4 (&acc)[4][NB], char* lds) {
  const int tid = get_tid(), lane = tid & 63, wid = tid >> 6, wr = wid >> 1, wc = wid & 1;
  const int fr = lane & 15, fq = lane >> 4;
  const int sr = tid >> 3, skc = tid & 7;
  const bf16_t* ga = A + (size_t)sr * lda + skc * 8;
  const bf16_t* gb = B + (size_t)sr * ldb + skc * 8;
  u32x4 ra0[4], rb0[NB], ra1[4], rb1[NB];
  const int soff = sr * 144 + skc * 16;
  const int nk = K >> 6;
  const int aoff = (wr * 64 + fr) * 144 + fq * 16;
  const int boff = 18432 + (wc * (NB * 16) + fr) * 144 + fq * 16;
#define G_LOAD(RA, RB, kt) { _Pragma("unroll") for (int i = 0; i < 4; ++i) { RA[i] = *(const u32x4*)(ga + (size_t)(i * 32) * lda + (kt) * 64); if (i < NB) RB[i] = *(const u32x4*)(gb + (size_t)(i * 32) * ldb + (kt) * 64); } }
#define G_STORE(RA, RB, buf) { char* d_ = lds + (buf) * 36864 + soff; _Pragma("unroll") for (int i = 0; i < 4; ++i) { *(u32x4*)(d_ + i * 32 * 144) = RA[i]; if (i < NB) *(u32x4*)(d_ + 18432 + i * 32 * 144) = RB[i]; } }
#define G_COMP(buf) { const char* cur = lds + (buf) * 36864; _Pragma("unroll") for (int ks = 0; ks < 2; ++ks) { hf8 af[4], bfr[NB]; \
    _Pragma("unroll") for (int m = 0; m < 4; ++m) af[m] = *(const hf8*)(cur + aoff + m * 16 * 144 + ks * 64); \
    _Pragma("unroll") for (int n = 0; n < NB; ++n) bfr[n] = *(const hf8*)(cur + boff + n * 16 * 144 + ks * 64); \
    _Pragma("unroll") for (int m = 0; m < 4; ++m) _Pragma("unroll") for (int n = 0; n < NB; ++n) acc[m][n] = __builtin_amdgcn_mfma_f32_16x16x32_f16(af[m], bfr[n], acc[m][n], 0, 0, 0); } }
  G_LOAD(ra0, rb0, 0)
  { const int k1 = nk > 1 ? 1 : 0; G_LOAD(ra1, rb1, k1) }
  G_STORE(ra0, rb0, 0)
  __syncthreads();
  for (int kt = 0; kt < nk; kt += 2) {
    { const int k2 = kt + 2 < nk ? kt + 2 : nk - 1; G_LOAD(ra0, rb0, k2) }
    G_COMP(0)
    G_STORE(ra1, rb1, 1)
    __syncthreads();
    { const int k3 = kt + 3 < nk ? kt + 3 : nk - 1; G_LOAD(ra1, rb1, k3) }
    if (kt + 1 < nk) G_COMP(1)
    G_STORE(ra0, rb0, 0)
    __syncthreads();
  }
}
#define G_COMPS(buf) { const char* cur = lds + (buf) * 36864; _Pragma("unroll") for (int ks = 0; ks < 2; ++ks) { hf8 af[4], bfr[4]; \
    _Pragma("unroll") for (int m = 0; m < 4; ++m) af[m] = *(const hf8*)(cur + aoff + m * 16 * 144 + ks * 64); \
    _Pragma("unroll") for (int n = 0; n < 4; ++n) bfr[n] = *(const hf8*)(cur + boff + n * 16 * 144 + ks * 64); \
    _Pragma("unroll") for (int m = 0; m < 4; ++m) _Pragma("unroll") for (int n = 0; n < 4; ++n) \
      acc[m][n] = SW ? __builtin_amdgcn_mfma_f32_16x16x32_f16(bfr[n], af[m], acc[m][n], 0, 0, 0) : __builtin_amdgcn_mfma_f32_16x16x32_f16(af[m], bfr[n], acc[m][n], 0, 0, 0); } }
template <bool SW>
__device__ __forceinline__ void gemm_stream(const bf16_t* __restrict__ A, int lda, const bf16_t* __restrict__ B, int ldb, int K,
                                            const bf16_t* __restrict__ An, const bf16_t* __restrict__ Bn, bool first,
                                            f32x4 (&acc)[4][4], char* lds, u32x4 (&ra1)[4], u32x4 (&rb1)[4]) {
  constexpr int NB = 4;
  const int tid = get_tid(), lane = tid & 63, wid = tid >> 6, wr = wid >> 1, wc = wid & 1;
  const int fr = lane & 15, fq = lane >> 4;
  const int sr = tid >> 3, skc = tid & 7;
  const bf16_t* ga = A + (size_t)sr * lda + skc * 8;
  const bf16_t* gb = B + (size_t)sr * ldb + skc * 8;
  const bf16_t* gan = An + (size_t)sr * lda + skc * 8;
  const bf16_t* gbn = Bn + (size_t)sr * ldb + skc * 8;
  u32x4 ra0[4], rb0[NB];
  const int soff = sr * 144 + skc * 16;
  const int nk = K >> 6;
  const int aoff = (wr * 64 + fr) * 144 + fq * 16;
  const int boff = 18432 + (wc * (NB * 16) + fr) * 144 + fq * 16;
#define GS_LOAD(RA, RB, pa, pb, kt) { _Pragma("unroll") for (int i = 0; i < 4; ++i) { RA[i] = *(const u32x4*)((pa) + (size_t)(i * 32) * lda + (kt) * 64); RB[i] = *(const u32x4*)((pb) + (size_t)(i * 32) * ldb + (kt) * 64); } }
  if (first) {
    GS_LOAD(ra0, rb0, ga, gb, 0)
    GS_LOAD(ra1, rb1, ga, gb, 1)
    G_STORE(ra0, rb0, 0)
    __syncthreads();
  }
  for (int kt = 0; kt < nk; kt += 2) {
    if (kt + 2 < nk) { GS_LOAD(ra0, rb0, ga, gb, kt + 2) } else { GS_LOAD(ra0, rb0, gan, gbn, 0) }
    G_COMPS(0)
    G_STORE(ra1, rb1, 1)
    __syncthreads();
    if (kt + 3 < nk) { GS_LOAD(ra1, rb1, ga, gb, kt + 3) } else { GS_LOAD(ra1, rb1, gan, gbn, 1) }
    G_COMPS(1)
    G_STORE(ra0, rb0, 0)
    __syncthreads();
  }
}
__device__ __forceinline__ void gemm_main(const bf16_t* __restrict__ A, int lda, const bf16_t* __restrict__ B, int ldb, int K, f32x4 (&acc)[4][4], char* lds) {
  gemm_main_t<4>(A, lda, B, ldb, K, acc, lds);
}
template <int KT>
__device__ __forceinline__ void gemm_small_t(const bf16_t* __restrict__ A, int lda, const bf16_t* __restrict__ B, int ldb, f32x4 (&acc)[4][4], char* lds) {
  const int tid = get_tid(), lane = tid & 63, wid = tid >> 6, wr = wid >> 1, wc = wid & 1;
  const int fr = lane & 15, fq = lane >> 4;
  const int sr = tid >> 3, skc = tid & 7;
  const bf16_t* ga = A + (size_t)sr * lda + skc * 8;
  const bf16_t* gb = B + (size_t)sr * ldb + skc * 8;
  const int soff = sr * 144 + skc * 16;
  const int aoff = (wr * 64 + fr) * 144 + fq * 16;
  const int boff = 18432 + (wc * 64 + fr) * 144 + fq * 16;
  u32x4 ra[KT][4], rb[KT][4];
#pragma unroll
  for (int kt = 0; kt < KT; ++kt)
#pragma unroll
    for (int i = 0; i < 4; ++i) { ra[kt][i] = *(const u32x4*)(ga + (size_t)(i * 32) * lda + kt * 64); rb[kt][i] = *(const u32x4*)(gb + (size_t)(i * 32) * ldb + kt * 64); }
#pragma unroll
  for (int kt = 0; kt < KT; ++kt)
#pragma unroll
    for (int i = 0; i < 4; ++i) { *(u32x4*)(lds + kt * 36864 + soff + i * 32 * 144) = ra[kt][i]; *(u32x4*)(lds + kt * 36864 + 18432 + soff + i * 32 * 144) = rb[kt][i]; }
  __syncthreads();
#pragma unroll
  for (int kt = 0; kt < KT; ++kt) {
    const char* cur = lds + kt * 36864;
#pragma unroll
    for (int ks = 0; ks < 2; ++ks) {
      hf8 af[4], bfr[4];
#pragma unroll
      for (int m = 0; m < 4; ++m) af[m] = *(const hf8*)(cur + aoff + m * 16 * 144 + ks * 64);
#pragma unroll
      for (int n = 0; n < 4; ++n) bfr[n] = *(const hf8*)(cur + boff + n * 16 * 144 + ks * 64);
#pragma unroll
      for (int m = 0; m < 4; ++m)
#pragma unroll
        for (int n = 0; n < 4; ++n) acc[m][n] = __builtin_amdgcn_mfma_f32_16x16x32_f16(bfr[n], af[m], acc[m][n], 0, 0, 0);
    }
  }
  __syncthreads();
}

template <int SM>
__device__ __forceinline__ bool tile_map_sm(int b, int nb, int it, int Mt, int Nt, int SN, int& tm, int& tn) {
  const int xcd = b & 7, li = b >> 3, nloc = nb >> 3;
  const int T = SM * SN; const int nsn = Nt / SN; const int nsuper = (Mt / SM) * nsn;
  const int o = li + it * nloc; const int k = o / T, w = o - k * T;
  const int s = xcd + 8 * k;
  if (s >= nsuper) return false;
  const int sm = s / nsn, sn = s - sm * nsn;
  tm = sm * SM + (w % SM); tn = sn * SN + (w / SM);
  return true;
}
__device__ __forceinline__ bool tile_map_v(int b, int nb, int it, int Mt, int Nt, int SN, int& tm, int& tn) {
  const int nsn = Nt / SN;
  if (nsn * (Mt >> 3) % 8 == 0 || nsn >= 8) return tile_map_sm<8>(b, nb, it, Mt, Nt, SN, tm, tn);
  return tile_map_sm<1>(b, nb, it, Mt, Nt, SN, tm, tn);
}
__device__ __forceinline__ bool tile_map(int it, int Mt, int Nt, int SN, int& tm, int& tn) { return tile_map_v(blockIdx.x, gridDim.x, it, Mt, Nt, SN, tm, tn); }
#define ZERO_ACC(a) _Pragma("unroll") for (int m_ = 0; m_ < 4; ++m_) _Pragma("unroll") for (int n_ = 0; n_ < 4; ++n_) a[m_][n_] = (f32x4){0.f, 0.f, 0.f, 0.f};
#define EPI_VARS const int tid = get_tid(), lane = tid & 63, wid = tid >> 6, wr = wid >> 1, wc = wid & 1, fr = lane & 15, fq = lane >> 4; (void)wr; (void)wc; (void)fr; (void)fq;
#define EPI_ROW_BEGIN(m0) _Pragma("unroll") for (int m = 0; m < 4; ++m) _Pragma("unroll") for (int j = 0; j < 4; ++j) { const int row = (m0) + wr * 64 + m * 16 + fq * 4 + j; (void)row;
#define EPI_COL_BEGIN(n0) _Pragma("unroll") for (int n = 0; n < 4; ++n) { const int col = (n0) + wc * 64 + n * 16 + fr; const float val = acc[m][n][j]; (void)col; (void)val;
#define EPI_COL_END }
#define EPI_ROW_END }
#define EPI_BEGIN(m0, n0) EPI_ROW_BEGIN(m0) EPI_COL_BEGIN(n0)
#define EPI_END } }

struct Job { const float* src; int K, N; int dst; int mode; };
__device__ __forceinline__ Job get_job(const P& p, int l, int j) {
  Job r; r.mode = 0;
  switch (j) {
    case 0: r.src = p.in[8] + (size_t)(l * 2 + 0) * 1024 * 2816; r.K = 1024; r.N = 2816; r.dst = W_GU0; r.mode = 1; break;
    case 1: r.src = p.in[9] + (size_t)(l * 2 + 0) * 1024 * 2816; r.K = 1024; r.N = 2816; r.dst = W_GU0; r.mode = 2; break;
    case 2: r.src = p.in[10] + (size_t)(l * 2 + 0) * 2816 * 1024; r.K = 2816; r.N = 1024; r.dst = W_D0; break;
    case 3: r.src = p.in[8] + (size_t)(l * 2 + 1) * 1024 * 2816; r.K = 1024; r.N = 2816; r.dst = W_GU1; r.mode = 1; break;
    case 4: r.src = p.in[9] + (size_t)(l * 2 + 1) * 1024 * 2816; r.K = 1024; r.N = 2816; r.dst = W_GU1; r.mode = 2; break;
    case 5: r.src = p.in[10] + (size_t)(l * 2 + 1) * 2816 * 1024; r.K = 2816; r.N = 1024; r.dst = W_D1; break;
    case 6: r.src = p.in[11] + (size_t)l * 1024 * 6288; r.K = 1024; r.N = 6288; r.dst = W_IN; break;
    case 7: r.src = p.in[14] + (size_t)(l * 2 + 0) * 64 * 384; r.K = 64; r.N = 384; r.dst = W_WUP0; break;
    case 8: r.src = p.in[14] + (size_t)(l * 2 + 1) * 64 * 384; r.K = 64; r.N = 384; r.dst = W_WUP1; break;
    case 9: r.src = p.in[16] + (size_t)(l * 2 + 0) * 64 * 384; r.K = 64; r.N = 384; r.dst = W_AUP0; break;
    case 10: r.src = p.in[16] + (size_t)(l * 2 + 1) * 64 * 384; r.K = 64; r.N = 384; r.dst = W_AUP1; break;
    case 11: r.src = p.in[17] + (size_t)l * 128 * 384; r.K = 128; r.N = 384; r.dst = W_GUP; break;
    case 12: r.src = p.in[31] + (size_t)l * 256 * 256; r.K = 256; r.N = 256; r.dst = W_GLU; break;
    case 13: r.src = p.in[35] + (size_t)l * 384 * 1024; r.K = 384; r.N = 1024; r.dst = W_UPRW; break;
    case 14: r.src = p.in[36] + (size_t)l * 256 * 1024; r.K = 256; r.N = 1024; r.dst = W_UPS5; break;
    case 15: r.src = p.in[37] + (size_t)l * 384 * 1024; r.K = 384; r.N = 1024; r.dst = W_UPML; break;
    default: r.src = p.in[39] + (size_t)l * 1024 * 1024; r.K = 1024; r.N = 1024; r.dst = W_OUT; break;
  }
  return r;
}
#define NJOBS 17
__device__ void mod_task(const P& p, int t, char* lds) {
  float* sc = (float*)lds;
  float* red = sc + 5 * 1024;
  const int tid = get_tid();
  for (int i = tid; i < 5 * 1024; i += NTHR) {
    int v = i >> 10, k = i & 1023;
    float c = v < 4 ? p.in[1][v * 1024 + k] : p.in[3][k];
    sc[i] = siluf_(c);
  }
  __syncthreads();
  const int c0 = t * 64; const int l = c0 / 9216; const int j0 = c0 % 9216;
  const int col = tid & 63, part = tid >> 6;
  const float* w = p.in[4] + ((size_t)l * 1024 + part * 256) * 9216 + j0 + col;
  float a0 = 0, a1 = 0, a2 = 0, a3 = 0, a4 = 0;
  const float* s = sc + part * 256;
#pragma unroll 8
  for (int i = 0; i < 256; ++i) {
    float wv = w[(size_t)i * 9216];
    a0 += s[i] * wv; a1 += s[1024 + i] * wv; a2 += s[2048 + i] * wv; a3 += s[3072 + i] * wv; a4 += s[4096 + i] * wv;
  }
  red[(part * 5 + 0) * 64 + col] = a0; red[(part * 5 + 1) * 64 + col] = a1; red[(part * 5 + 2) * 64 + col] = a2;
  red[(part * 5 + 3) * 64 + col] = a3; red[(part * 5 + 4) * 64 + col] = a4;
  __syncthreads();
  for (int i = tid; i < 320; i += NTHR) {
    int v = i >> 6, c = i & 63;
    float sum = red[(0 * 5 + v) * 64 + c] + red[(1 * 5 + v) * 64 + c] + red[(2 * 5 + v) * 64 + c] + red[(3 * 5 + v) * 64 + c];
    p.mod[(size_t)(l * 5 + v) * 9216 + j0 + c] = sum + p.in[5][(size_t)l * 9216 + j0 + c];
  }
  __syncthreads();
}
__device__ __forceinline__ void ph_convert(const P& p, int l, bool with_mod, char* lds) {
  const int tid = get_tid();
  int ntiles[NJOBS]; int total = 0;
#pragma unroll
  for (int j = 0; j < NJOBS; ++j) { Job jb = get_job(p, l, j); ntiles[j] = (jb.K >> 6) * ((jb.N + 63) >> 6); total += ntiles[j]; }
  const int nmod = with_mod ? 288 : 0;
  float* tile = (float*)lds;
  for (int t = blockIdx.x; t < total + nmod; t += gridDim.x) {
    if (t < nmod) { mod_task(p, t, lds); continue; }
    int tt = t - nmod; int j = 0;
#pragma unroll
    for (int q = 0; q < NJOBS; ++q) { if (j == q && tt >= ntiles[q]) { tt -= ntiles[q]; j = q + 1; } }
    Job jb = get_job(p, l, j);
    const int nkt = jb.K >> 6;
    const int k0 = (tt % nkt) * 64, n0 = (tt / nkt) * 64;
    {
      const int c = tid & 63, r0 = tid >> 6;
      const bool ok = (n0 + c) < jb.N;
#pragma unroll
      for (int i = 0; i < 16; ++i) { int r = r0 + i * 4; tile[r * 65 + c] = ok ? jb.src[(size_t)(k0 + r) * jb.N + n0 + c] : 0.f; }
    }
    __syncthreads();
    {
      const int nn = tid >> 2, q = tid & 3; const int n = n0 + nn;
      if (n < jb.N) {
        int drow = n;
        if (jb.mode == 1) drow = (n >> 5) * 64 + (n & 31);
        else if (jb.mode == 2) drow = (n >> 5) * 64 + 32 + (n & 31);
        bf16_t* d = p.W + jb.dst + (size_t)drow * jb.K + k0 + q * 16;
        unsigned pk[8];
#pragma unroll
        for (int i = 0; i < 8; ++i) { unsigned lo = f2bf(tile[(q * 16 + 2 * i) * 65 + nn]); unsigned hi = f2bf(tile[(q * 16 + 2 * i + 1) * 65 + nn]); pk[i] = lo | (hi << 16); }
        *(uint4*)d = make_uint4(pk[0], pk[1], pk[2], pk[3]);
        *(uint4*)(d + 8) = make_uint4(pk[4], pk[5], pk[6], pk[7]);
      }
    }
    __syncthreads();
  }
}

__device__ __forceinline__ void ph_rows(const P& p, int mode, int l, int ln_idx, int Mrows, bool writeU, int ul, int ks) {
  const int lane = get_tid() & 63, wid = get_tid() >> 6;
  const int nw = gridDim.x * 4;
  const float* g = p.in[6] + (size_t)(l * 3 + ln_idx) * 1024;
  const float* b = p.in[7] + (size_t)(l * 3 + ln_idx) * 1024;
  for (int m = blockIdx.x * 4 + wid; m < Mrows; m += nw) {
    float* s = srow(p, m);
    const float* src = s;
    if (mode == 0) src = m < M_LAT ? p.in[0] + (size_t)m * 1024 : p.in[2] + (size_t)(m - M_LAT) * 1024;
    float4 v[4];
#pragma unroll
    for (int i = 0; i < 4; ++i) v[i] = *(const float4*)(src + lane * 4 + i * 256);
    if (mode == 1) {
      float sum = 0;
#pragma unroll
      for (int i = 0; i < 4; ++i) sum += v[i].x + v[i].y + v[i].z + v[i].w;
      sum = wavesum(sum);
      const float mean = sum * (1.f / 1024.f);
      float sq = 0;
#pragma unroll
      for (int i = 0; i < 4; ++i) { v[i].x -= mean; v[i].y -= mean; v[i].z -= mean; v[i].w -= mean; sq += v[i].x * v[i].x + v[i].y * v[i].y + v[i].z * v[i].z + v[i].w * v[i].w; }
      sq = wavesum(sq);
      const float rstd = rsqrtf(sq * (1.f / 1024.f) + 1e-5f);
#pragma unroll
      for (int i = 0; i < 4; ++i) {
        float4 gg = *(const float4*)(g + lane * 4 + i * 256), bb = *(const float4*)(b + lane * 4 + i * 256);
        v[i].x = v[i].x * rstd * gg.x + bb.x; v[i].y = v[i].y * rstd * gg.y + bb.y; v[i].z = v[i].z * rstd * gg.z + bb.z; v[i].w = v[i].w * rstd * gg.w + bb.w;
      }
    }
#pragma unroll
    for (int i = 0; i < 4; ++i) *(float4*)(s + lane * 4 + i * 256) = v[i];
    if (writeU) {
      const float* sh = modp(p, ul, m, ks); const float* scl = modp(p, ul, m, ks + 1);
#pragma unroll
      for (int i = 0; i < 4; ++i) {
        float4 a = *(const float4*)(sh + lane * 4 + i * 256), c = *(const float4*)(scl + lane * 4 + i * 256);
        unsigned lo = f2bf(v[i].x * (1.f + c.x) + a.x) | ((unsigned)f2bf(v[i].y * (1.f + c.y) + a.y) << 16);
        unsigned hi = f2bf(v[i].z * (1.f + c.z) + a.z) | ((unsigned)f2bf(v[i].w * (1.f + c.w) + a.w) << 16);
        *(uint2*)(p.U + (size_t)m * 1024 + lane * 4 + i * 256) = make_uint2(lo, hi);
      }
    }
  }
}


#define STREAM_BEGIN_X(SWAPPED_, Mt_, Nt_, SN_, APTR, BPTR, LDA_, LDB_, K_) { \
    u32x4 pr_a[4], pr_b[4]; bool first_ = true; int tm, tn; bool have_ = tile_map(0, Mt_, Nt_, SN_, tm, tn); \
    for (int it = 0; have_; ++it) { int tm2, tn2; const bool have2_ = tile_map(it + 1, Mt_, Nt_, SN_, tm2, tn2); \
      const int tmn = have2_ ? tm2 : tm, tnn = have2_ ? tn2 : tn; \
      f32x4 acc[4][4]; ZERO_ACC(acc) \
      { const bf16_t* a_cur = APTR; const bf16_t* b_cur = BPTR; \
        const bf16_t* a_nxt; const bf16_t* b_nxt; { const int tm = tmn, tn = tnn; (void)tm; (void)tn; a_nxt = APTR; b_nxt = BPTR; } \
        gemm_stream<SWAPPED_>(a_cur, LDA_, b_cur, LDB_, K_, a_nxt, b_nxt, first_, acc, lds, pr_a, pr_b); first_ = false; }
#define STREAM_BEGIN(Mt_, Nt_, SN_, APTR, BPTR, LDA_, LDB_, K_) STREAM_BEGIN_X(false, Mt_, Nt_, SN_, APTR, BPTR, LDA_, LDB_, K_)
#define STREAM_BEGIN_T(Mt_, Nt_, SN_, APTR, BPTR, LDA_, LDB_, K_) STREAM_BEGIN_X(true, Mt_, Nt_, SN_, APTR, BPTR, LDA_, LDB_, K_)
#define STREAM_END tm = tm2; tn = tn2; have_ = have2_; } }
__device__ __forceinline__ void ph_ffn_up(const P& p, int s, int Mt, char* lds) {
  EPI_VARS
  bf16_t* HM = (bf16_t*)p.R;
  const bf16_t* Wt = p.W + (s ? W_GU1 : W_GU0);
  STREAM_BEGIN_T(Mt, 44, 4, (p.U + (size_t)(tm * 128) * 1024), (Wt + (size_t)(tn * 128) * 1024), 1024, 1024, 1024)
    const int m0 = tm * 128, n0 = tn * 128;
    const int hb = ((n0 + wc * 64) >> 6) * 32 + fq * 4;
#pragma unroll
    for (int m = 0; m < 4; ++m) {
      bf16_t* hp = HM + (size_t)(m0 + wr * 64 + m * 16 + fr) * 2816 + hb;
#pragma unroll
      for (int n = 0; n < 2; ++n) {
        const unsigned lo = (unsigned)f2bf(siluf_(acc[m][n][0]) * acc[m][n + 2][0]) | ((unsigned)f2bf(siluf_(acc[m][n][1]) * acc[m][n + 2][1]) << 16);
        const unsigned hi = (unsigned)f2bf(siluf_(acc[m][n][2]) * acc[m][n + 2][2]) | ((unsigned)f2bf(siluf_(acc[m][n][3]) * acc[m][n + 2][3]) << 16);
        *(uint2*)(hp + n * 16) = make_uint2(lo, hi);
      }
    }
  STREAM_END
}
__device__ __forceinline__ void ph_ffn_down(const P& p, int l, int s, int Mt, char* lds) {
  EPI_VARS
  const bf16_t* HM = (const bf16_t*)p.R;
  const bf16_t* Wt = p.W + (s ? W_D1 : W_D0);
  const int gk = s ? 8 : 2;
  STREAM_BEGIN_T(Mt, 8, 8, (HM + (size_t)(tm * 128) * 2816), (Wt + (size_t)(tn * 128) * 2816), 2816, 2816, 2816)
    const int m0 = tm * 128, n0 = tn * 128;
#pragma unroll
    for (int m = 0; m < 4; ++m) {
      const int row = m0 + wr * 64 + m * 16 + fr;
      float* sp = srow(p, row) + n0 + wc * 64 + fq * 4; const float* gp = modp(p, l, row, gk) + n0 + wc * 64 + fq * 4;
#pragma unroll
      for (int n = 0; n < 4; ++n) {
        float4 s4 = *(const float4*)(sp + n * 16); const float4 g4 = *(const float4*)(gp + n * 16);
        s4.x = ALPHA * s4.x + 0.5f * g4.x * acc[m][n][0]; s4.y = ALPHA * s4.y + 0.5f * g4.y * acc[m][n][1];
        s4.z = ALPHA * s4.z + 0.5f * g4.z * acc[m][n][2]; s4.w = ALPHA * s4.w + 0.5f * g4.w * acc[m][n][3];
        *(float4*)(sp + n * 16) = s4;
      }
    }
  STREAM_END
}

#define RW_ZRW(p) ((hf*)(p).R)
#define RW_RKV(p) (RW_ZRW(p) + (size_t)M_ALL * 1152)
#define RW_LA(p) ((bf16_t*)(RW_RKV(p) + (size_t)M_ALL * 1152))
#define RW_KK(p) ((hf*)(RW_LA(p) + (size_t)M_ALL * 256))
#define RW_KD(p) (RW_KK(p) + (size_t)M_ALL * 384)
#define RW_KA(p) (RW_KD(p) + (size_t)2 * M_ALL * 384)
#define RW_YR(p) (RW_KA(p) + (size_t)2 * M_ALL * 384)

#define S5_ZH(p) ((hf*)RW_LA(p))
#define S5_YG(p) ((p).W + W_GU0)
#define S5_E(p) ((float2*)((p).R + (size_t)M_ALL * 9728))
#define S5_X(p) S5_E(p)

#define ML_Z(p) ((hf*)(p).R)
#define ML_GL(p) ((float*)(ML_Z(p) + (size_t)M_ALL * 1536))
#define ML_QK(p) ((hf*)(ML_GL(p) + (size_t)M_ALL * 16))
#define ML_DC(p) ((float*)(ML_QK(p) + (size_t)M_ALL * 768))
#define ML_DN(p) (ML_DC(p) + (size_t)4224 * 9216)
#define ML_SC(p) (ML_DN(p) + (size_t)4224 * 96)
#define ML_MP(p) (ML_SC(p) + (size_t)4224 * 2)

__device__ __forceinline__ void ph_z_rw(const P& p, char* lds) {
  EPI_VARS
  hf* ZRW = RW_ZRW(p); bf16_t* LA = RW_LA(p);
  const int Mt = 264;
  STREAM_BEGIN(Mt, 11, 11, (p.U + (size_t)(tm * 128) * 1024), (p.W + W_IN + (size_t)(tn < 9 ? tn * 128 : 2960 + (tn - 9) * 128) * 1024), 1024, 1024, 1024)
    const int m0 = tm * 128;
    if (tn < 9) {
      EPI_BEGIN(m0, tn * 128)
        ZRW[(size_t)row * 1152 + col] = (hf)val;
      EPI_END
    } else {
      EPI_BEGIN(m0, (tn - 9) * 128)
        float o = col < 64 ? tanhf_(val) : (col < 128 ? val : sigmoidf_(val));
        LA[(size_t)row * 256 + col] = f2bf(o);
      EPI_END
    }
  STREAM_END
}
__device__ __forceinline__ void ph_z_s5(const P& p, char* lds, int vb, int nvb) {
  EPI_VARS
  hf* Z = S5_ZH(p);
  const int Mt = 264;
  for (int it = 0;; ++it) {
    int tm, tn; if (!tile_map_v(vb, nvb, it, Mt, 2, 2, tm, tn)) break; const int m0 = tm * 128;
    f32x4 acc[4][4]; ZERO_ACC(acc)
    gemm_main(p.U + (size_t)m0 * 1024, 1024, p.W + W_IN + (size_t)(2704 + tn * 128) * 1024, 1024, 1024, acc, lds);
    EPI_BEGIN(m0, tn * 128)
      Z[(size_t)row * 256 + col] = (hf)val;
    EPI_END
  }
}
__device__ __forceinline__ void ph_z_ml(const P& p, char* lds) {
  EPI_VARS
  hf* Z = ML_Z(p); float* GL = ML_GL(p);
  const int Mt = 264;
  STREAM_BEGIN(Mt, 13, 13, (p.U + (size_t)(tm * 128) * 1024), (p.W + W_IN + (size_t)(1152 + tn * 128) * 1024), 1024, 1024, 1024)
    const int m0 = tm * 128;
    if (tn < 12) {
      EPI_BEGIN(m0, tn * 128)
        Z[(size_t)row * 1536 + col] = (hf)val;
      EPI_END
    } else {
      EPI_BEGIN(m0, 0)
        if (col < 16) GL[(size_t)row * 16 + col] = val;
      EPI_END
    }
  STREAM_END
}

template <int which>
__device__ __forceinline__ void ph_conv(const P& p, int l) {
  constexpr int nch = which == 0 ? 144 : 96;
  constexpr int ldin = which == 0 ? 1152 : 1536;
  constexpr int cbase = which == 0 ? 0 : 1152;
  const hf* Zin = which == 0 ? RW_ZRW(p) : ML_Z(p);
  const float* cw = p.in[12] + (size_t)l * 9 * 1920;
  const unsigned total = (unsigned)(M_ALL / 4) * nch;
  for (unsigned idx = blockIdx.x * NTHR + get_tid(); idx < (total + 63u) / 64u * 64u; idx += gridDim.x * NTHR) {
    const bool act = idx < total;
    const int tg = act ? (int)(idx / (unsigned)nch) : 0; const int ch = act ? (int)(idx % (unsigned)nch) : 0; const int c0 = ch * 8;
    const int m0 = tg * 4;
    float o[4][8];
#pragma unroll
    for (int t = 0; t < 4; ++t)
#pragma unroll
      for (int i = 0; i < 8; ++i) o[t][i] = 0.f;
    const bool lat = m0 < M_LAT;
    const int bb = m0 >> 13, tt = lat ? (m0 & 8191) : ((m0 - M_LAT) & 255);
    const int gr = tt >> 6, gc0 = lat ? (tt & 63) : tt;
    const int ncol = lat ? 64 : 256;
#pragma unroll
    for (int dr = -1; dr <= 1; ++dr) {
      const int rr = gr + dr;
      const bool rowok = lat ? (rr >= 0 && rr < 128) : (dr == 0);
      if (!rowok) continue;
      const float* w = cw + ((dr + 1) * 3) * 1920 + cbase + c0;
      float wv[3][8];
#pragma unroll
      for (int k = 0; k < 3; ++k) { const float4 a = *(const float4*)(w + k * 1920), b = *(const float4*)(w + k * 1920 + 4);
        wv[k][0] = a.x; wv[k][1] = a.y; wv[k][2] = a.z; wv[k][3] = a.w; wv[k][4] = b.x; wv[k][5] = b.y; wv[k][6] = b.z; wv[k][7] = b.w; }
      const int mrow = lat ? ((bb << 13) + rr * 64) : (m0 - gc0);
#pragma unroll
      for (int cc = 0; cc < 6; ++cc) {
        const int col = gc0 - 1 + cc;
        if (col < 0 || col >= ncol) continue;
        const hf8 z = *(const hf8*)(Zin + (size_t)(mrow + col) * ldin + c0);
        float zf[8];
#pragma unroll
        for (int i = 0; i < 8; ++i) zf[i] = (float)z[i];
#pragma unroll
        for (int t = 0; t < 4; ++t) {
          const int k = cc - t;
          if (k >= 0 && k < 3) {
#pragma unroll
            for (int i = 0; i < 8; ++i) o[t][i] += zf[i] * wv[k][i];
          }
        }
      }
    }
#pragma unroll
    for (int t = 0; t < 4; ++t) {
      const int m = m0 + t;
      if (which == 0) {
        const bool isk = act && (c0 >= 384) && (c0 < 768);
        float kkv[8]; float ss = 0.f;
        if (isk) {
          const float* kkw = p.in[18] + (size_t)l * 384 + (c0 - 384);
#pragma unroll
          for (int i = 0; i < 8; ++i) { kkv[i] = o[t][i] * kkw[i]; ss += kkv[i] * kkv[i]; }
        } else {
#pragma unroll
          for (int i = 0; i < 8; ++i) kkv[i] = 0.f;
        }
        ss += __shfl_xor(ss, 1); ss += __shfl_xor(ss, 2); ss += __shfl_xor(ss, 4);
        if (act) {
          hf8 ov;
#pragma unroll
          for (int i = 0; i < 8; ++i) ov[i] = (hf)o[t][i];
          *(hf8*)(RW_RKV(p) + (size_t)m * 1152 + c0) = ov;
          if (isk) {
            const float rn = rsqrtf(fmaxf(ss, 1e-24f));
            hf8 kv;
#pragma unroll
            for (int i = 0; i < 8; ++i) kv[i] = (hf)(kkv[i] * rn);
            *(hf8*)(RW_KK(p) + (size_t)m * 384 + (c0 - 384)) = kv;
          }
        }
      } else if (act) {
        const float sc = c0 >= 384 ? 0.10206207261596575f : 1.f;
        hf8 ov;
#pragma unroll
        for (int i = 0; i < 8; ++i) ov[i] = (hf)(siluf_(o[t][i]) * sc);
        *(hf8*)(ML_QK(p) + (size_t)m * 768 + c0) = ov;
      }
    }
  }
}

__device__ __forceinline__ void ph_lora(const P& p, int l, char* lds) {
  EPI_VARS
  hf* ZRW = RW_ZRW(p); const hf* RKV = RW_RKV(p); const bf16_t* LA = RW_LA(p); const hf* KK = RW_KK(p);
  hf* KD = RW_KD(p); hf* KA = RW_KA(p);
  const int Mt = 264;
  for (int it = 0;; ++it) {
    int tm, q; if (!tile_map(it, Mt, 15, 15, tm, q)) break; const int job = q / 3, tn = q % 3; const int m0 = tm * 128, n0 = tn * 128;
    f32x4 acc[4][4]; ZERO_ACC(acc)
    if (job < 2) {
      const int d = job;
      gemm_small_t<1>(LA + (size_t)m0 * 256, 256, p.W + (d ? W_WUP1 : W_WUP0) + (size_t)n0 * 64, 64, acc, lds);
      const float* w0 = p.in[13] + (size_t)(l * 2 + d) * 384;
#pragma unroll
      for (int m = 0; m < 4; ++m) {
        const int row = m0 + wr * 64 + m * 16 + fr;
#pragma unroll
        for (int n = 0; n < 4; ++n) {
          const int cb = n0 + wc * 64 + n * 16 + fq * 4;
          const float4 wv = *(const float4*)(w0 + cb);
          const float wa[4] = {wv.x, wv.y, wv.z, wv.w};
          hf4 o;
#pragma unroll
          for (int j = 0; j < 4; ++j) { const float e = sigmoidf_(wa[j] + acc[m][n][j]) * 0.6065306597126334f; o[j] = (hf)(1.f - __expf(-e)); }
          *(hf4*)(ZRW + (size_t)row * 1152 + d * 384 + cb) = o;
        }
      }
    } else if (job < 4) {
      const int d = job - 2;
      gemm_small_t<1>(LA + (size_t)m0 * 256 + 64, 256, p.W + (d ? W_AUP1 : W_AUP0) + (size_t)n0 * 64, 64, acc, lds);
      const float* a0 = p.in[15] + (size_t)(l * 2 + d) * 384; const float* kaw = p.in[19] + (size_t)l * 384;
#pragma unroll
      for (int m = 0; m < 4; ++m) {
        const int row = m0 + wr * 64 + m * 16 + fr;
#pragma unroll
        for (int n = 0; n < 4; ++n) {
          const int cb = n0 + wc * 64 + n * 16 + fq * 4;
          const float4 av = *(const float4*)(a0 + cb), kv = *(const float4*)(kaw + cb);
          const float aa[4] = {av.x, av.y, av.z, av.w}, ka_[4] = {kv.x, kv.y, kv.z, kv.w};
          const hf4 k4 = *(const hf4*)(RKV + (size_t)row * 1152 + 384 + cb), kk4 = *(const hf4*)(KK + (size_t)row * 384 + cb);
          hf4 okd, oka;
#pragma unroll
          for (int j = 0; j < 4; ++j) { const float a = sigmoidf_(aa[j] + acc[m][n][j]); okd[j] = (hf)((float)k4[j] * (1.f + (a - 1.f) * ka_[j])); oka[j] = (hf)((float)kk4[j] * a); }
          *(hf4*)(KD + ((size_t)d * M_ALL + row) * 384 + cb) = okd;
          *(hf4*)(KA + ((size_t)d * M_ALL + row) * 384 + cb) = oka;
        }
      }
    } else {
      gemm_small_t<2>(LA + (size_t)m0 * 256 + 128, 256, p.W + W_GUP + (size_t)n0 * 128, 128, acc, lds);
#pragma unroll
      for (int m = 0; m < 4; ++m) {
        const int row = m0 + wr * 64 + m * 16 + fr;
#pragma unroll
        for (int n = 0; n < 4; ++n) {
          const int cb = n0 + wc * 64 + n * 16 + fq * 4;
          hf4 o; o[0] = (hf)acc[m][n][0]; o[1] = (hf)acc[m][n][1]; o[2] = (hf)acc[m][n][2]; o[3] = (hf)acc[m][n][3];
          *(hf4*)(ZRW + (size_t)row * 1152 + 768 + cb) = o;
        }
      }
    }
  }
}

typedef float f32x2 __attribute__((ext_vector_type(2)));
#define RW_CH 16
#define RW_BUF 21504
__device__ __forceinline__ void rw_cvt_store(char* dst, uint4 q) {
  const hf8 h = __builtin_bit_cast(hf8, q);
  f32x4 a, b;
  a[0] = (float)h[0]; a[1] = (float)h[1]; a[2] = (float)h[2]; a[3] = (float)h[3];
  b[0] = (float)h[4]; b[1] = (float)h[5]; b[2] = (float)h[6]; b[3] = (float)h[7];
  *(f32x4*)dst = a; *(f32x4*)(dst + 16) = b;
}
__device__ __forceinline__ void ph_rwscan(const P& p, char* lds) {
  const hf* ZRW = RW_ZRW(p); hf* RKV = RW_RKV(p); const hf* KK = RW_KK(p);
  const int tid = get_tid(), lane = tid & 63, wid = tid >> 6;
  char* pbuf = lds + 3 * RW_BUF + wid * 2048;
  char* ybuf = lds + 3 * RW_BUF + 8192;
  for (int t = blockIdx.x; t < 192; t += gridDim.x) {
    const int rqq = t & 3, h = (t >> 2) % 6, b = (t / 24) & 3, d = t / 96;
    const int rsub = lane >> 4, g = lane & 15; const int rl = wid * 4 + rsub;
    const int sgn = d ? -1 : 1;
    const bool grpA = tid < 128; const int t2 = tid & 127;
    const int sstep = t2 >> 3, sseg = t2 & 7;
    const hf* g0 = grpA ? (RKV + h * 64 + sseg * 8) : (RW_KD(p) + (size_t)d * M_ALL * 384 + h * 64 + sseg * 8);
    const size_t ld0 = grpA ? 1152 : 384;
    const hf* g1 = grpA ? (KK + h * 64 + sseg * 8) : (RW_KA(p) + (size_t)d * M_ALL * 384 + h * 64 + sseg * 8);
    const hf* g2 = grpA ? (ZRW + d * 384 + h * 64 + sseg * 8) : (RKV + 768 + h * 64 + rqq * 16 + (t2 & 1) * 8);
    const int s2 = grpA ? sstep : (t2 >> 1);
    const bool has2 = grpA || t2 < 32;
    const int o0 = (grpA ? 0 : 12288) + sstep * 256 + sseg * 32;
    const int o1 = (grpA ? 4096 : 16384) + sstep * 256 + sseg * 32;
    const int o2 = grpA ? (8192 + sstep * 256 + sseg * 32) : (20480 + (t2 >> 1) * 64 + (t2 & 1) * 32);
    hf* g_y = d == 0 ? (RKV + 384 + h * 64 + rqq * 16 + (tid & 1) * 8) : (RW_YR(p) + h * 64 + rqq * 16 + (tid & 1) * 8);
    const int ldy = d == 0 ? 1152 : 384;
    uint4 q0, q1, q2;
#define RW_M0(pp) ((pp) < 256 ? (M_LAT + b * 256 + (d ? 255 - (pp) : (pp))) : (b * 8192 + (d ? 8447 - (pp) : (pp) - 256)))
#define RW_GLOAD(c) { const int mb_ = RW_M0((c) * RW_CH); const size_t mm = (size_t)(mb_ + sgn * sstep); \
      q0 = *(const uint4*)(g0 + mm * ld0); q1 = *(const uint4*)(g1 + mm * 384); \
      if (has2) { const size_t m2 = (size_t)(mb_ + sgn * s2); q2 = *(const uint4*)(g2 + m2 * 1152); } }
#define RW_SSTORE(c) { char* bb_ = lds + ((c) % 3) * RW_BUF; rw_cvt_store(bb_ + o0, q0); rw_cvt_store(bb_ + o1, q1); if (has2) rw_cvt_store(bb_ + o2, q2); }
    f32x2 S01 = (f32x2){0.f, 0.f}, S23 = (f32x2){0.f, 0.f};
    RW_GLOAD(0) RW_SSTORE(0)
    RW_GLOAD(1) RW_SSTORE(1)
    __syncthreads();
    const int NCH = 8448 / RW_CH;
    for (int c = 0; c < NCH; ++c) {
      if (c + 2 < NCH) RW_GLOAD(c + 2)
      if (c > 0 && tid < 32) {
        const int mb_ = RW_M0((c - 1) * RW_CH); const size_t mv = (size_t)(mb_ + sgn * (tid >> 1));
        *(uint4*)(g_y + mv * ldy) = *(const uint4*)(ybuf + ((c - 1) & 1) * 512 + tid * 16);
      }
      const char* cb = lds + (c % 3) * RW_BUF + g * 16;
      const char* vb = lds + (c % 3) * RW_BUF + 20480 + rl * 4;
      f32x4 R4[RW_CH], K4[RW_CH], D4[RW_CH], KD4[RW_CH], KA4[RW_CH]; float VV[RW_CH];
#define RW_LDS(s_) { R4[s_] = *(const f32x4*)(cb + (s_) * 256); K4[s_] = *(const f32x4*)(cb + 4096 + (s_) * 256); D4[s_] = *(const f32x4*)(cb + 8192 + (s_) * 256); \
        KD4[s_] = *(const f32x4*)(cb + 12288 + (s_) * 256); KA4[s_] = *(const f32x4*)(cb + 16384 + (s_) * 256); VV[s_] = *(const float*)(vb + (s_) * 64); }
      RW_LDS(0) RW_LDS(1) RW_LDS(2)
#pragma unroll
      for (int s = 0; s < RW_CH; ++s) {
        if (s + 3 < RW_CH) RW_LDS(s + 3)
        const f32x4 r4 = R4[s], k4 = K4[s], d4 = D4[s], kd4 = KD4[s], ka4 = KA4[s]; const float vv = VV[s];
        const f32x2 k01 = {k4[0], k4[1]}, k23 = {k4[2], k4[3]}, d01 = {d4[0], d4[1]}, d23 = {d4[2], d4[3]};
        const f32x2 kd01 = {kd4[0], kd4[1]}, kd23 = {kd4[2], kd4[3]}, ka01 = {ka4[0], ka4[1]}, ka23 = {ka4[2], ka4[3]};
        const f32x2 r01 = {r4[0], r4[1]}, r23 = {r4[2], r4[3]};
        const f32x2 sa2 = __builtin_elementwise_fma(S23, k23, S01 * k01);
        float sa = sa2[0] + sa2[1];
        sa = rowsum16(sa);
        const f32x2 vv2 = {vv, vv}; const f32x2 nsa = {-sa, -sa};
        f32x2 T01 = __builtin_elementwise_fma(-S01, d01, S01), T23 = __builtin_elementwise_fma(-S23, d23, S23);
        T01 = __builtin_elementwise_fma(vv2, kd01, T01); T23 = __builtin_elementwise_fma(vv2, kd23, T23);
        S01 = __builtin_elementwise_fma(nsa, ka01, T01); S23 = __builtin_elementwise_fma(nsa, ka23, T23);
        const f32x2 y2 = __builtin_elementwise_fma(S23, r23, S01 * r01);
        *(float*)(pbuf + (((s & 7) * 4 + rsub) * 16 + g) * 4) = y2[0] + y2[1];
        if ((s & 7) == 7) {
          if (lane < 32) {
            const char* pr = pbuf + lane * 64;
            const f32x4 a0 = *(const f32x4*)(pr), a1 = *(const f32x4*)(pr + 16), a2 = *(const f32x4*)(pr + 32), a3 = *(const f32x4*)(pr + 48);
            const f32x4 sm = (a0 + a1) + (a2 + a3);
            const float y = (sm[0] + sm[1]) + (sm[2] + sm[3]);
            *(hf*)(ybuf + (c & 1) * 512 + (((s >> 3) * 8 + (lane >> 2)) * 16 + wid * 4 + (lane & 3)) * 2) = (hf)y;
          }
        }
      }
      if (c + 2 < NCH) RW_SSTORE(c + 2)
      __syncthreads();
    }
    if (tid < 32) {
      const int mb_ = RW_M0((NCH - 1) * RW_CH); const size_t mv = (size_t)(mb_ + sgn * (tid >> 1));
      *(uint4*)(g_y + mv * ldy) = *(const uint4*)(ybuf + ((NCH - 1) & 1) * 512 + tid * 16);
    }
    __syncthreads();
  }
}

__device__ __forceinline__ void ph_rwpost(const P& p, int l) {
  const hf* ZRW = RW_ZRW(p); const hf* RKV = RW_RKV(p); const hf* YR = RW_YR(p);
  const int lane = get_tid() & 63, wid = get_tid() >> 6;
  const int nw = gridDim.x * 4;
  for (int t = blockIdx.x * 4 + wid; t < M_ALL * 6; t += nw) {
    const int m = t / 6, h = t % 6; const int c = h * 64 + lane;
    const float ys = (float)RKV[(size_t)m * 1152 + 384 + c] + (float)YR[(size_t)m * 384 + c];
    const float mean = wavesum(ys) * (1.f / 64.f);
    const float xc = ys - mean;
    const float var = wavesum(xc * xc) * (1.f / 64.f);
    float y = xc * rsqrtf(var + 64e-5f) * p.in[21][(size_t)l * 384 + c] + p.in[22][(size_t)l * 384 + c];
    const float r = (float)RKV[(size_t)m * 1152 + c], v = (float)RKV[(size_t)m * 1152 + 768 + c];
    const float rk = p.in[20][(size_t)l * 384 + c];
    const float kd0 = (float)RW_KD(p)[(size_t)m * 384 + c], kd1 = (float)RW_KD(p)[((size_t)M_ALL + m) * 384 + c];
    const float bs = wavesum(r * (kd0 + kd1) * rk);
    y = (y + bs * v) * (float)ZRW[(size_t)m * 1152 + 768 + c];
    p.Y[(size_t)m * 1024 + c] = f2bf(y);
  }
}

struct S5C { float ar, ai; float br[16], bi[16]; };
__device__ __forceinline__ void s5_consts(const P& p, int l, int d, int g, int n, S5C& c) {
  const int ig = (l * 2 + d) * 16 + g;
  const float lr = fminf(p.in[23][(size_t)ig * 64 + n], -1e-4f), li = p.in[24][(size_t)ig * 64 + n];
  const float dt = expf(p.in[25][ig]);
  const float mag = expf(lr * dt);
  c.ar = mag * cosf(li * dt); c.ai = mag * sinf(li * dt);
  const float nr = c.ar - 1.f, ni = c.ai; const float den = 1.f / (lr * lr + li * li);
  const float cr = (nr * lr + ni * li) * den, ci = (ni * lr - nr * li) * den;
  const float* bre = p.in[26] + ((size_t)ig * 64 + n) * 16; const float* bim = p.in[27] + ((size_t)ig * 64 + n) * 16;
#pragma unroll
  for (int h = 0; h < 16; ++h) { const float xr = bre[h], xi = bim[h]; c.br[h] = cr * xr - ci * xi; c.bi[h] = cr * xi + ci * xr; }
}
__device__ __forceinline__ int s5_m0(int b, int tc) { return tc < 128 ? b * 8192 + tc * 64 : M_LAT + b * 256 + (tc - 128) * 64; }
__device__ __forceinline__ int chain_pos(int d, int tc) { return d == 0 ? (tc < 128 ? tc + 4 : tc - 128) : (tc < 128 ? 131 - tc : 131 - tc); }
__device__ __forceinline__ void s5_cf(const P& p, int ig, int n, float dt, float& ar, float& ai, float& cr, float& ci) {
  const float lr = fminf(p.in[23][(size_t)ig * 64 + n], -1e-4f), li = p.in[24][(size_t)ig * 64 + n];
  const float mag = expf(lr * dt);
  ar = mag * cosf(li * dt); ai = mag * sinf(li * dt);
  const float nr = ar - 1.f, ni = ai; const float den = 1.f / (lr * lr + li * li);
  cr = (nr * lr + ni * li) * den; ci = (ni * lr - nr * li) * den;
}
__device__ __forceinline__ void ph_s5_pass(const P& p, int l, int pass, char* lds, int vb, int nvb) {
  const int tid = get_tid(), lane = tid & 63, wid = tid >> 6, fr = lane & 15, fq = lane >> 4;
  float* ub = (float*)(lds + wid * 16896);
  char* xs = lds + wid * 16896 + 4096;
  float* bu = (float*)(lds + wid * 16896 + 8448);
  const hf* Z = S5_ZH(p); float2* E = S5_E(p); const float2* X = S5_X(p); bf16_t* YG = S5_YG(p);
  const int nw = nvb * 4;
  for (int t = vb * 4 + wid; t < 4 * 132 * 16; t += nw) {
    const int g = t & 15, tc = (t >> 4) % 132, b = t / (16 * 132);
    const int m0 = s5_m0(b, tc);
#pragma unroll
    for (int i = 0; i < 4; ++i) { const int e = lane + i * 64; const int tok = e >> 2, q = e & 3;
      const hf4 zv = *(const hf4*)(Z + (size_t)(m0 + tok) * 256 + g * 16 + q * 4);
      *(float4*)(ub + tok * 16 + q * 4) = make_float4((float)zv[0], (float)zv[1], (float)zv[2], (float)zv[3]); }
    f32x4 yacc[4];
#pragma unroll
    for (int i = 0; i < 4; ++i) yacc[i] = (f32x4){0.f, 0.f, 0.f, 0.f};
    for (int d = 0; d < 2; ++d) {
      const int ig = (l * 2 + d) * 16 + g;
      const float dt = expf(p.in[25][ig]);
      float ar, ai, crn, cin_;
      s5_cf(p, ig, lane, dt, ar, ai, crn, cin_);
      hf8 bfB[8];
#pragma unroll
      for (int q4 = 0; q4 < 4; ++q4) {
        const int n = q4 * 16 + fr;
        float a_r, a_i, cr, ci; s5_cf(p, ig, n, dt, a_r, a_i, cr, ci);
        hf8 re, im;
        if (fq < 2) {
          const float* bre = p.in[26] + ((size_t)ig * 64 + n) * 16 + fq * 8; const float* bim = p.in[27] + ((size_t)ig * 64 + n) * 16 + fq * 8;
          const float4 r0 = *(const float4*)bre, r1 = *(const float4*)(bre + 4), i0 = *(const float4*)bim, i1 = *(const float4*)(bim + 4);
          const float xr[8] = {r0.x, r0.y, r0.z, r0.w, r1.x, r1.y, r1.z, r1.w}, xi[8] = {i0.x, i0.y, i0.z, i0.w, i1.x, i1.y, i1.z, i1.w};
#pragma unroll
          for (int k = 0; k < 8; ++k) { re[k] = (hf)(1024.f * (cr * xr[k] - ci * xi[k])); im[k] = (hf)(1024.f * (cr * xi[k] + ci * xr[k])); }
        } else {
#pragma unroll
          for (int k = 0; k < 8; ++k) { re[k] = (hf)0.f; im[k] = (hf)0.f; }
        }
        bfB[q4] = re; bfB[q4 + 4] = im;
      }
      const int cp = chain_pos(d, tc);
      const size_t sidx = (((size_t)(d * 4 + b) * 132 + cp) * 16 + g) * 64 + lane;
      float xr = 0.f, xi = 0.f;
      hf8 cf[4];
      if (pass == 3) {
        float2 x0 = X[sidx]; xr = x0.x; xi = x0.y;
#pragma unroll
        for (int ks = 0; ks < 4; ++ks) {
          const int c0 = ks * 32 + fq * 8;
          const float* src_ = (c0 < 64 ? p.in[28] : p.in[29]) + ((size_t)ig * 16 + fr) * 64 + (c0 & 63);
          const float sg = c0 < 64 ? 1.f : -1.f;
          const float4 v0 = *(const float4*)src_, v1 = *(const float4*)(src_ + 4);
          cf[ks][0] = (hf)(sg * v0.x); cf[ks][1] = (hf)(sg * v0.y); cf[ks][2] = (hf)(sg * v0.z); cf[ks][3] = (hf)(sg * v0.w);
          cf[ks][4] = (hf)(sg * v1.x); cf[ks][5] = (hf)(sg * v1.y); cf[ks][6] = (hf)(sg * v1.z); cf[ks][7] = (hf)(sg * v1.w);
        }
      }
#pragma unroll 1
      for (int jb = 0; jb < 4; ++jb) {
        const int tb = d ? 3 - jb : jb;
        {
          hf8 au;
          if (fq < 2) {
            const float* up = ub + (tb * 16 + fr) * 16 + fq * 8;
            const float4 u0 = *(const float4*)up, u1 = *(const float4*)(up + 4);
            au[0] = (hf)u0.x; au[1] = (hf)u0.y; au[2] = (hf)u0.z; au[3] = (hf)u0.w; au[4] = (hf)u1.x; au[5] = (hf)u1.y; au[6] = (hf)u1.z; au[7] = (hf)u1.w;
          } else {
#pragma unroll
            for (int k = 0; k < 8; ++k) au[k] = (hf)0.f;
          }
#pragma unroll
          for (int nb = 0; nb < 8; ++nb) {
            f32x4 ab = (f32x4){0.f, 0.f, 0.f, 0.f};
            ab = __builtin_amdgcn_mfma_f32_16x16x32_f16(au, bfB[nb], ab, 0, 0, 0);
#pragma unroll
            for (int j = 0; j < 4; ++j) bu[(fq * 4 + j) * 132 + nb * 16 + fr] = ab[j];
          }
        }
#pragma unroll 4
        for (int jj = 0; jj < 16; ++jj) {
          const int t16 = d ? 15 - jj : jj;
          const float br = bu[t16 * 132 + lane] * 0.0009765625f, bi = bu[t16 * 132 + 64 + lane] * 0.0009765625f;
          const float nr = ar * xr - ai * xi + br, ni = ar * xi + ai * xr + bi;
          xr = nr; xi = ni;
          if (pass == 3) { *(hf*)(xs + t16 * 272 + lane * 2) = (hf)xr; *(hf*)(xs + t16 * 272 + 128 + lane * 2) = (hf)xi; }
        }
        if (pass == 3) {
          f32x4 acc = (f32x4){0.f, 0.f, 0.f, 0.f};
#pragma unroll
          for (int ks = 0; ks < 4; ++ks) {
            const hf8 af = *(const hf8*)(xs + fr * 272 + ks * 64 + fq * 16);
            acc = __builtin_amdgcn_mfma_f32_16x16x32_f16(af, cf[ks], acc, 0, 0, 0);
          }
#pragma unroll
          for (int i = 0; i < 4; ++i) if (i == tb) yacc[i] += acc;
        }
      }
      if (pass == 1) E[sidx] = make_float2(xr, xi);
    }
    if (pass == 3) {
      const float dsk = p.in[30][(size_t)l * 256 + g * 16 + fr];
#pragma unroll
      for (int i = 0; i < 4; ++i)
#pragma unroll
        for (int j = 0; j < 4; ++j) {
          const int tok = i * 16 + fq * 4 + j;
          float y = yacc[i][j] + dsk * ub[tok * 16 + fr];
          const float inner = 0.7978845608028654f * (y + 0.044715f * y * y * y);
          y = 0.5f * y * (1.f + tanhf_(inner));
          YG[(size_t)(m0 + tok) * 256 + g * 16 + fr] = f2bf(y);
        }
    }
  }
}
__device__ __forceinline__ void ph_s5_carry(const P& p, int l, int vb, int nvb) {
  float2* E = S5_E(p); float2* X = S5_X(p);
  for (int t = vb * NTHR + get_tid(); t < 8192; t += nvb * NTHR) {
    const int n = t & 63, g = (t >> 6) & 15, b = (t >> 10) & 3, d = t >> 12;
    const int ig = (l * 2 + d) * 16 + g;
    const float lr = fminf(p.in[23][(size_t)ig * 64 + n], -1e-4f), li = p.in[24][(size_t)ig * 64 + n];
    const float dt = expf(p.in[25][ig]);
    const float mag = expf(lr * dt * 64.f);
    float ar = expf(lr * dt) * cosf(li * dt), ai = expf(lr * dt) * sinf(li * dt);
#pragma unroll
    for (int i = 0; i < 6; ++i) { const float r2 = ar * ar - ai * ai, i2 = 2.f * ar * ai; ar = r2; ai = i2; }
    (void)mag;
    float xr = 0.f, xi = 0.f;
    const size_t base = (((size_t)(d * 4 + b) * 132) * 16 + g) * 64 + n;
    for (int cp0 = 0; cp0 < 132; cp0 += 12) {
      float2 ev[12];
#pragma unroll
      for (int u = 0; u < 12; ++u) ev[u] = E[base + (size_t)(cp0 + u) * 1024];
#pragma unroll
      for (int u = 0; u < 12; ++u) {
        X[base + (size_t)(cp0 + u) * 1024] = make_float2(xr, xi);
        const float nr = ar * xr - ai * xi + ev[u].x, ni = ar * xi + ai * xr + ev[u].y;
        xr = nr; xi = ni;
      }
    }
  }
}
__device__ __forceinline__ void ph_glu(const P& p, int l, char* lds, int vb, int nvb) {
  EPI_VARS
  const bf16_t* YG = S5_YG(p);
  const int Mt = 264;
  const float* gb = p.in[32] + (size_t)l * 256;
  for (int it = 0;; ++it) {
    int tm, tn; if (!tile_map_v(vb, nvb, it, Mt, 2, 2, tm, tn)) break; const int m0 = tm * 128, n0 = tn * 128;
    f32x4 acc[4][4]; ZERO_ACC(acc)
    gemm_main(YG + (size_t)m0 * 256, 256, p.W + W_GLU + (size_t)n0 * 256, 256, 256, acc, lds);
    EPI_BEGIN(m0, n0)
      const float y = bf2f(YG[(size_t)row * 256 + col]);
      p.Y[(size_t)row * 1024 + 384 + col] = f2bf(y * sigmoidf_(val + gb[col]));
    EPI_END
  }
}

__device__ __forceinline__ void sub_barrier(unsigned* cnt, unsigned target) {
  asm volatile("s_waitcnt vmcnt(0)" ::: "memory");
  __syncthreads();
  if (__builtin_amdgcn_workitem_id_x() == 0) {
    __builtin_amdgcn_fence(__ATOMIC_RELEASE, "agent");
    asm volatile("s_waitcnt vmcnt(0)" ::: "memory");
    __hip_atomic_fetch_add(cnt, 1u, __ATOMIC_RELAXED, __HIP_MEMORY_SCOPE_AGENT);
    unsigned sp = 0;
    while (__hip_atomic_load(cnt, __ATOMIC_RELAXED, __HIP_MEMORY_SCOPE_AGENT) < target) { __builtin_amdgcn_s_sleep(2); if (++sp > (1u << 22)) break; }
    __builtin_amdgcn_fence(__ATOMIC_ACQUIRE, "agent");
    asm volatile("s_waitcnt vmcnt(0)" ::: "memory");
  }
  __syncthreads();
}
__device__ __forceinline__ void ph_s5_stage(const P& p, int l, char* lds, int vb, int nvb) {
  unsigned* cnt = p.bar + 3584;
  const unsigned base = (unsigned)(l * 4) * (unsigned)nvb;
  ph_z_s5(p, lds, vb, nvb);            sub_barrier(cnt, base + 1u * nvb);
  ph_s5_pass(p, l, 1, lds, vb, nvb);   sub_barrier(cnt, base + 2u * nvb);
  ph_s5_carry(p, l, vb, nvb);          sub_barrier(cnt, base + 3u * nvb);
  ph_s5_pass(p, l, 3, lds, vb, nvb);   sub_barrier(cnt, base + 4u * nvb);
  ph_glu(p, l, lds, vb, nvb);
}

__device__ __forceinline__ float logsigf_(float x) { return fminf(x, 0.f) - log1pf(__expf(-fabsf(x))); }
__device__ __forceinline__ void ml_gates(const P& p, int l, int d, int h, int m0, int lane, float& bcum, float& ic) {
  const int tok = d ? 63 - lane : lane;
  const float* gl = ML_GL(p) + (size_t)(m0 + tok) * 16;
  const float* gb = p.in[33] + (size_t)(l * 2 + d) * 8;
  ic = gl[d * 8 + h] + gb[h];
  float f = logsigf_(gl[d * 8 + 4 + h] + gb[4 + h]);
#pragma unroll
  for (int o = 1; o < 64; o <<= 1) { float v = __shfl_up(f, o); if (lane >= o) f += v; }
  bcum = f;
}
__device__ __forceinline__ void ml_gates2(const P& p, int l, int d, int h, int m0, int lane, float& bc, float& ic, float& tot) {
  const float* gl = ML_GL(p) + (size_t)(m0 + lane) * 16;
  const float* gb = p.in[33] + (size_t)(l * 2 + d) * 8;
  ic = gl[d * 8 + h] + gb[h];
  const float f0 = logsigf_(gl[d * 8 + 4 + h] + gb[4 + h]);
  float f = f0;
#pragma unroll
  for (int o = 1; o < 64; o <<= 1) { float v = __shfl_up(f, o); if (lane >= o) f += v; }
  tot = __shfl(f, 63);
  bc = d ? (tot - f + f0) : f;
}
#define MLQ 208
#define MLS 144
__device__ __forceinline__ void ph_ml_a(const P& p, int l, char* lds) {
  char* vt = lds; char* kt = lds + 13824; float* wg = (float*)(lds + 27648);
  const int tid = get_tid(), lane = tid & 63, wid = tid >> 6, fr = lane & 15, fq = lane >> 4;
  const hf* QK = ML_QK(p); const hf* Z = ML_Z(p);
  for (int t = blockIdx.x; t < 4224; t += gridDim.x) {
    const int tc = t % 132, h = (t / 132) & 3, b = (t / 528) & 3, d = t / 2112;
    const int m0 = s5_m0(b, tc); const int cp = chain_pos(d, tc);
    const size_t task = ((size_t)((d * 4 + b) * 4 + h)) * 132 + cp;
    if (wid == 0) {
      float bc, ic, tot; ml_gates2(p, l, d, h, m0, lane, bc, ic, tot);
      const float lw = tot - bc + ic;
      float mx = lw;
      for (int o = 32; o > 0; o >>= 1) mx = fmaxf(mx, __shfl_xor(mx, o));
      wg[lane] = __expf(lw - mx);
      if (lane == 0) { ML_SC(p)[task * 2] = mx; ML_SC(p)[task * 2 + 1] = tot; }
    }
    __syncthreads();
    for (int e = tid; e < 64 * 12; e += NTHR) {
      const int tok = e & 63, q = e >> 6;
      const hf8 kv = *(const hf8*)(QK + (size_t)(m0 + tok) * 768 + 384 + h * 96 + q * 8);
      const hf8 vv = *(const hf8*)(Z + (size_t)(m0 + tok) * 1536 + 768 + h * 96 + q * 8);
      const float w = wg[tok];
#pragma unroll
      for (int i = 0; i < 8; ++i) {
        *(hf*)(kt + (q * 8 + i) * MLS + tok * 2) = kv[i];
        *(hf*)(vt + (q * 8 + i) * MLS + tok * 2) = (hf)((float)vv[i] * w);
      }
    }
    __syncthreads();
    float* dc = ML_DC(p) + task * 9216;
#pragma unroll 1
    for (int bi = 0; bi < 9; ++bi) {
      const int idx = wid * 9 + bi; const int mb = idx / 6, nb = idx % 6;
      f32x4 acc = (f32x4){0.f, 0.f, 0.f, 0.f};
#pragma unroll
      for (int ks = 0; ks < 2; ++ks) {
        const hf8 af = *(const hf8*)(vt + (mb * 16 + fr) * MLS + ks * 64 + fq * 16);
        const hf8 bf = *(const hf8*)(kt + (nb * 16 + fr) * MLS + ks * 64 + fq * 16);
        acc = __builtin_amdgcn_mfma_f32_16x16x32_f16(af, bf, acc, 0, 0, 0);
      }
#pragma unroll
      for (int j = 0; j < 4; ++j) dc[(mb * 16 + fq * 4 + j) * 96 + nb * 16 + fr] = acc[j];
    }
    if (tid < 96) {
      float s = 0.f;
      for (int j = 0; j < 64; ++j) s += wg[j] * (float)*(const hf*)(kt + tid * MLS + j * 2);
      ML_DN(p)[task * 96 + tid] = s;
    }
    __syncthreads();
  }
}
__device__ __forceinline__ void ph_ml_b(const P& p) {
  float* DC = ML_DC(p); float* DN = ML_DN(p); const float* SC = ML_SC(p); float* MP = ML_MP(p);
  for (int t = blockIdx.x * NTHR + get_tid(); t < 32 * 9312; t += gridDim.x * NTHR) {
    const int chain = t / 9312, e = t % 9312;
    float cur = 0.f, mprev = 0.f;
    for (int cp0 = 0; cp0 < 132; cp0 += 12) {
      float dl[12], ml_[12], bl_[12];
#pragma unroll
      for (int u = 0; u < 12; ++u) {
        const size_t task = (size_t)chain * 132 + cp0 + u;
        dl[u] = e < 9216 ? DC[task * 9216 + e] : DN[task * 96 + (e - 9216)];
        ml_[u] = SC[task * 2]; bl_[u] = SC[task * 2 + 1];
      }
#pragma unroll
      for (int u = 0; u < 12; ++u) {
        const size_t task = (size_t)chain * 132 + cp0 + u;
        float* slot = e < 9216 ? DC + task * 9216 + e : DN + task * 96 + (e - 9216);
        *slot = cur;
        if (e == 0) MP[task] = mprev;
        const float mnew = fmaxf(bl_[u] + mprev, ml_[u]);
        cur = __expf(bl_[u] + mprev - mnew) * cur + __expf(ml_[u] - mnew) * dl[u];
        mprev = mnew;
      }
    }
  }
}
__device__ __forceinline__ void ph_ml_c(const P& p, int l, char* lds) {
  char* qs = lds; char* ks = lds + 13312; char* vt = lds + 26624; char* cs = lds + 40448; char* ps = lds + 60416;
  float* fl = (float*)(lds + 69632);
  float* bc = fl; float* icv = fl + 128; float* mr = fl + 256; float* inter = fl + 320; float* den = fl + 384; float* nq = fl + 448; float* nst = fl + 512;
  const int tid = get_tid(), lane = tid & 63, wid = tid >> 6, fr = lane & 15, fq = lane >> 4;
  const hf* QK = ML_QK(p); const hf* Z = ML_Z(p);
  const int ntc = (l == 1) ? 128 : 132;
  for (int t = blockIdx.x; t < 16 * ntc; t += gridDim.x) {
    const int tc = t % ntc, h = (t / ntc) & 3, b = t / (4 * ntc);
    const int m0 = s5_m0(b, tc);
    for (int e = tid; e < 64 * 12; e += NTHR) {
      const int tok = e & 63, q = e >> 6;
      *(hf8*)(qs + tok * MLQ + q * 16) = *(const hf8*)(QK + (size_t)(m0 + tok) * 768 + h * 96 + q * 8);
      *(hf8*)(ks + tok * MLQ + q * 16) = *(const hf8*)(QK + (size_t)(m0 + tok) * 768 + 384 + h * 96 + q * 8);
      const hf8 vv = *(const hf8*)(Z + (size_t)(m0 + tok) * 1536 + 768 + h * 96 + q * 8);
#pragma unroll
      for (int i = 0; i < 8; ++i) *(hf*)(vt + (q * 8 + i) * MLS + tok * 2) = vv[i];
    }
    if (wid < 2) { float bcv, ic, tot; ml_gates2(p, l, wid, h, m0, lane, bcv, ic, tot); bc[wid * 64 + lane] = bcv; icv[wid * 64 + lane] = ic; }
    f32x4 hs[6];
#pragma unroll
    for (int n = 0; n < 6; ++n) hs[n] = (f32x4){0.f, 0.f, 0.f, 0.f};
    for (int d = 0; d < 2; ++d) {
      const int cp = chain_pos(d, tc);
      const size_t task = ((size_t)((d * 4 + b) * 4 + h)) * 132 + cp;
      const float mprev = ML_MP(p)[task];
      __syncthreads();
      {
        const float* cg = ML_DC(p) + task * 9216;
        for (int e = tid; e < 96 * 24; e += NTHR) {
          const int v = e / 24, q = e % 24;
          const float4 c4 = *(const float4*)(cg + v * 96 + q * 4);
          hf4 o; o[0] = (hf)c4.x; o[1] = (hf)c4.y; o[2] = (hf)c4.z; o[3] = (hf)c4.w;
          *(hf4*)(cs + v * MLQ + q * 8) = o;
        }
        if (tid < 96) nst[tid] = ML_DN(p)[task * 96 + tid];
      }
      const float* bcd = bc + d * 64; const float* icd = icv + d * 64;
      if (tid < 64) {
        const int j = tid; const float bj = bcd[j];
        float mx = bj + mprev;
        if (d == 0) { for (int s = 0; s <= j; ++s) mx = fmaxf(mx, bj - bcd[s] + icd[s]); }
        else { for (int s = j; s < 64; ++s) mx = fmaxf(mx, bj - bcd[s] + icd[s]); }
        mr[j] = mx; inter[j] = __expf(bj + mprev - mx);
      }
      __syncthreads();
      if (tid < 64) {
        float s1 = 0.f;
        for (int k = 0; k < 96; ++k) s1 += nst[k] * (float)*(const hf*)(qs + tid * MLQ + k * 2);
        nq[tid] = s1;
      }
      {
        f32x4 sacc[4];
#pragma unroll
        for (int n = 0; n < 4; ++n) sacc[n] = (f32x4){0.f, 0.f, 0.f, 0.f};
#pragma unroll
        for (int kk = 0; kk < 3; ++kk) {
          const hf8 af = *(const hf8*)(qs + (wid * 16 + fr) * MLQ + kk * 64 + fq * 16);
#pragma unroll
          for (int n = 0; n < 4; ++n) {
            const hf8 bf = *(const hf8*)(ks + (n * 16 + fr) * MLQ + kk * 64 + fq * 16);
            sacc[n] = __builtin_amdgcn_mfma_f32_16x16x32_f16(af, bf, sacc[n], 0, 0, 0);
          }
        }
        float rs[4] = {0.f, 0.f, 0.f, 0.f};
#pragma unroll
        for (int n = 0; n < 4; ++n) {
          const int s = n * 16 + fr; const float bs = bcd[s] - icd[s];
#pragma unroll
          for (int jj = 0; jj < 4; ++jj) {
            const int j = wid * 16 + fq * 4 + jj;
            const bool valid = d == 0 ? (s <= j) : (s >= j);
            const float val = valid ? sacc[n][jj] * __expf(bcd[j] - bs - mr[j]) : 0.f;
            rs[jj] += val;
            *(hf*)(ps + j * MLS + s * 2) = (hf)val;
          }
        }
        __syncthreads();
#pragma unroll
        for (int jj = 0; jj < 4; ++jj) {
          const float r = rowsum16(rs[jj]);
          const int j = wid * 16 + fq * 4 + jj;
          if (fr == 0) den[j] = inter[j] * nq[j] + r;
        }
      }
      f32x4 acc[6];
#pragma unroll
      for (int n = 0; n < 6; ++n) acc[n] = (f32x4){0.f, 0.f, 0.f, 0.f};
#pragma unroll
      for (int kk = 0; kk < 3; ++kk) {
        const hf8 af = *(const hf8*)(qs + (wid * 16 + fr) * MLQ + kk * 64 + fq * 16);
#pragma unroll
        for (int n = 0; n < 6; ++n) {
          const hf8 bf = *(const hf8*)(cs + (n * 16 + fr) * MLQ + kk * 64 + fq * 16);
          acc[n] = __builtin_amdgcn_mfma_f32_16x16x32_f16(af, bf, acc[n], 0, 0, 0);
        }
      }
#pragma unroll
      for (int jj = 0; jj < 4; ++jj) { const float it = inter[wid * 16 + fq * 4 + jj];
#pragma unroll
        for (int n = 0; n < 6; ++n) acc[n][jj] *= it; }
#pragma unroll
      for (int kk = 0; kk < 2; ++kk) {
        const hf8 af = *(const hf8*)(ps + (wid * 16 + fr) * MLS + kk * 64 + fq * 16);
#pragma unroll
        for (int n = 0; n < 6; ++n) {
          const hf8 bf = *(const hf8*)(vt + (n * 16 + fr) * MLS + kk * 64 + fq * 16);
          acc[n] = __builtin_amdgcn_mfma_f32_16x16x32_f16(af, bf, acc[n], 0, 0, 0);
        }
      }
      __syncthreads();
#pragma unroll
      for (int jj = 0; jj < 4; ++jj) {
        const int j = wid * 16 + fq * 4 + jj;
        const float dn = 1.f / fmaxf(fabsf(den[j]), __expf(-mr[j]));
#pragma unroll
        for (int n = 0; n < 6; ++n) hs[n][jj] += acc[n][jj] * dn;
      }
    }
#pragma unroll
    for (int jj = 0; jj < 4; ++jj) {
      const int m = m0 + wid * 16 + fq * 4 + jj;
      const hf* op = Z + (size_t)m * 1536 + 1152 + h * 96 + fr;
      float x[6]; float s = 0.f;
#pragma unroll
      for (int n = 0; n < 6; ++n) { x[n] = sigmoidf_((float)op[n * 16]) * hs[n][jj]; s += x[n]; }
      s = rowsum16(s);
      const float mean = s * (1.f / 96.f);
      float q = 0.f;
#pragma unroll
      for (int n = 0; n < 6; ++n) { x[n] -= mean; q += x[n] * x[n]; }
      q = rowsum16(q);
      const float rsd = rsqrtf(q * (1.f / 96.f) + 1e-5f);
      const float* ng = p.in[34] + (size_t)l * 384 + h * 96 + fr;
      bf16_t* yp = p.Y + (size_t)m * 1024 + 640 + h * 96 + fr;
#pragma unroll
      for (int n = 0; n < 6; ++n) yp[n * 16] = f2bf(x[n] * rsd * ng[n * 16]);
    }
    __syncthreads();
  }
}

#define MG_YM(p) ((bf16_t*)(p).R)
#define MG_G3(p) (MG_YM(p) + (size_t)M_ALL * 1024)
__device__ __forceinline__ void ph_gates(const P& p, int l, int Mt, char* lds) {
  EPI_VARS
  bf16_t* G3 = MG_G3(p);
  const float* gbias = p.in[38] + (size_t)l * 3072;
  STREAM_BEGIN_T(Mt, 24, 8, (p.U + (size_t)(tm * 128) * 1024), (p.W + W_IN + (size_t)(3216 + tn * 128) * 1024), 1024, 1024, 1024)
    const int m0 = tm * 128, n0 = tn * 128;
#pragma unroll
    for (int m = 0; m < 4; ++m) {
      bf16_t* gp3 = G3 + (size_t)(m0 + wr * 64 + m * 16 + fr) * 3072 + n0 + wc * 64 + fq * 4;
#pragma unroll
      for (int n = 0; n < 4; ++n) {
        const float4 b4 = *(const float4*)(gbias + n0 + wc * 64 + n * 16 + fq * 4);
        const unsigned lo = (unsigned)f2bf(sigmoidf_(acc[m][n][0] + b4.x)) | ((unsigned)f2bf(sigmoidf_(acc[m][n][1] + b4.y)) << 16);
        const unsigned hi = (unsigned)f2bf(sigmoidf_(acc[m][n][2] + b4.z)) | ((unsigned)f2bf(sigmoidf_(acc[m][n][3] + b4.w)) << 16);
        *(uint2*)(gp3 + n * 16) = make_uint2(lo, hi);
      }
    }
  STREAM_END
}
__device__ __forceinline__ void ph_merge(const P& p, int l, int Mt, char* lds) {
  EPI_VARS
  bf16_t* YM = MG_YM(p); const bf16_t* G3 = MG_G3(p);
  const int ntile = Mt * 16;
  for (int it = 0;; ++it) {
    int tm, tn; if (!tile_map(it, Mt, 16, 8, tm, tn)) break; const int m0 = tm * 128, n0 = tn * 64;
    f32x4 yacc[4][2];
#pragma unroll
    for (int m = 0; m < 4; ++m) { yacc[m][0] = (f32x4){0.f, 0.f, 0.f, 0.f}; yacc[m][1] = (f32x4){0.f, 0.f, 0.f, 0.f}; }
#pragma unroll 1
    for (int br = 0; br < 3; ++br) {
      f32x4 acc[4][2];
#pragma unroll
      for (int m = 0; m < 4; ++m) { acc[m][0] = (f32x4){0.f, 0.f, 0.f, 0.f}; acc[m][1] = (f32x4){0.f, 0.f, 0.f, 0.f}; }
      const int kb = br == 1 ? 256 : 384; const int yoff = br == 0 ? 0 : (br == 1 ? 384 : 640);
      const int woff = br == 0 ? W_UPRW : (br == 1 ? W_UPS5 : W_UPML);
      gemm_main_t<2>(p.Y + (size_t)m0 * 1024 + yoff, 1024, p.W + woff + (size_t)n0 * kb, kb, kb, acc, lds);
      EPI_ROW_BEGIN(m0)
        const bf16_t* gp = G3 + (size_t)row * 3072 + br * 1024 + n0 + wc * 32 + fr;
#pragma unroll
        for (int n = 0; n < 2; ++n) yacc[m][n][j] += bf2f(gp[n * 16]) * acc[m][n][j];
      EPI_ROW_END
    }
    EPI_ROW_BEGIN(m0)
      bf16_t* yp = YM + (size_t)row * 1024 + n0 + wc * 32 + fr;
#pragma unroll
      for (int n = 0; n < 2; ++n) yp[n * 16] = f2bf(yacc[m][n][j]);
    EPI_ROW_END
  }
}
__device__ __forceinline__ void ph_wout(const P& p, int l, int Mt, char* lds) {
  EPI_VARS
  const bf16_t* YM = (const bf16_t*)p.R;
  STREAM_BEGIN_T(Mt, 8, 8, (YM + (size_t)(tm * 128) * 1024), (p.W + W_OUT + (size_t)(tn * 128) * 1024), 1024, 1024, 1024)
    const int m0 = tm * 128, n0 = tn * 128;
#pragma unroll
    for (int m = 0; m < 4; ++m) {
      const int row = m0 + wr * 64 + m * 16 + fr;
      float* sp = srow(p, row) + n0 + wc * 64 + fq * 4; const float* gp = modp(p, l, row, 5) + n0 + wc * 64 + fq * 4;
#pragma unroll
      for (int n = 0; n < 4; ++n) {
        float4 s4 = *(const float4*)(sp + n * 16); const float4 g4 = *(const float4*)(gp + n * 16);
        s4.x = ALPHA * s4.x + g4.x * acc[m][n][0]; s4.y = ALPHA * s4.y + g4.y * acc[m][n][1];
        s4.z = ALPHA * s4.z + g4.z * acc[m][n][2]; s4.w = ALPHA * s4.w + g4.w * acc[m][n][3];
        *(float4*)(sp + n * 16) = s4;
      }
    }
  STREAM_END
}

#define XB_TMO      128
#define XB_XCNT(j)  (256  + 64 * (j))
#define XB_XSUB(j)  (1280 + 64 * (j))
#define XB_XGEN(j)  (2304 + 64 * (j))
#define XB_TOP      3328
#define XB_TOPGEN   3392
#define XCD_BAR_WORDS 3456
#define XB_SPIN_CAP (1u << 18)
#define LAS __attribute__((address_space(3)))

__device__ __forceinline__ unsigned xb_ld(unsigned* p)              { return __hip_atomic_load(p, __ATOMIC_RELAXED, __HIP_MEMORY_SCOPE_AGENT); }
__device__ __forceinline__ unsigned xb_add(unsigned* p, unsigned v) { return __hip_atomic_fetch_add(p, v, __ATOMIC_RELAXED, __HIP_MEMORY_SCOPE_AGENT); }
__device__ __forceinline__ unsigned xb_xcc_id() { return (unsigned)__builtin_amdgcn_s_getreg((3 << 11) | 20) & 0xFu; }
#define XB_SPIN(cond, bar) do { unsigned _sp = 0; while (cond) { __builtin_amdgcn_s_sleep(1); \
    if ((++_sp & 255u) == 0u) { if (xb_ld(&(bar)[XB_TMO])) break; if (_sp > XB_SPIN_CAP) { atomicAdd(&(bar)[XB_TMO], 1u); break; } } } } while (0)

struct XcdBarrier {
    unsigned* bar; unsigned x;
    volatile LAS unsigned* st;
};

__device__ __forceinline__ XcdBarrier xcd_barrier_post(unsigned* bar, volatile LAS unsigned* st) {
    XcdBarrier b; b.bar = bar; b.x = xb_xcc_id(); b.st = st;
    if (__builtin_amdgcn_workitem_id_x() == 0) (void)xb_add(&bar[XB_XCNT(b.x)], 1u);
    return b;
}
__device__ __forceinline__ void xcd_barrier_complete(unsigned* bar, unsigned x, unsigned& nloc, unsigned& nx) {
    const unsigned G = gridDim.x * gridDim.y * gridDim.z;
    unsigned sum, cnt, mine, sp = 0u;
    for (;;) {
        sum = 0u; cnt = 0u; mine = 0u;
#pragma unroll
        for (unsigned j = 0; j < 16; ++j) { const unsigned c = xb_ld(&bar[XB_XCNT(j)]); sum += c; cnt += (c > 0u) ? 1u : 0u; mine = (j == x) ? c : mine; }
        if (sum == G) break;
        __builtin_amdgcn_s_sleep(1);
        if ((++sp & 255u) == 0u) { if (xb_ld(&bar[XB_TMO])) break; if (sp > XB_SPIN_CAP) { atomicAdd(&bar[XB_TMO], 1u); break; } }
    }
    nloc = mine > 0u ? mine : 1u; nx = cnt > 0u ? cnt : 1u;
}

__device__ __forceinline__ void xcd_barrier(const XcdBarrier& b) {
    asm volatile("s_waitcnt vmcnt(0)" ::: "memory");
    __syncthreads();
    if (__builtin_amdgcn_workitem_id_x() == 0) {
        unsigned* bar = b.bar;
        __builtin_amdgcn_s_waitcnt(0);
        unsigned nloc = b.st[0], nx = b.st[1];
        if (nloc == 0u) { xcd_barrier_complete(bar, b.x, nloc, nx); b.st[0] = nloc; b.st[1] = nx; }
        const unsigned old = xb_add(&bar[XB_XSUB(b.x)], 1u);
        const unsigned gen = old / nloc;
        if (old + 1u == (gen + 1u) * nloc) {
            __builtin_amdgcn_fence(__ATOMIC_RELEASE, "agent");
            asm volatile("s_waitcnt vmcnt(0)" ::: "memory");
            const unsigned og = xb_add(&bar[XB_TOP], 1u);
            const unsigned tg = og / nx;
            if (og + 1u == (tg + 1u) * nx) xb_add(&bar[XB_TOPGEN], 1u);
            else XB_SPIN(xb_ld(&bar[XB_TOPGEN]) == tg, bar);
            __builtin_amdgcn_fence(__ATOMIC_ACQUIRE, "agent");
            xb_add(&bar[XB_XGEN(b.x)], 1u);
            asm volatile("s_waitcnt vmcnt(0)" ::: "memory");
        } else {
            XB_SPIN(xb_ld(&bar[XB_XGEN(b.x)]) == gen, bar);
            __builtin_amdgcn_fence(__ATOMIC_ACQUIRE, "agent");
            asm volatile("s_waitcnt vmcnt(0)" ::: "memory");
        }
    }
    __syncthreads();
}


#define SYNC xcd_barrier(xb); asm volatile("" : "+s"(l));
__global__ void __launch_bounds__(NTHR, 2) mega(P pv) {
#define p pv
  __shared__ __attribute__((aligned(16))) char lds[LDS_BYTES];
  __shared__ uint4 xb_words;
  cg::grid_group grid = cg::this_grid();
  {
    const int t0 = __builtin_amdgcn_workitem_id_x();
    if (blockIdx.x == 0) for (int i = t0; i < 4096; i += NTHR) pv.bar[i] = 0u;
    if (t0 == 0) xb_words = make_uint4(0u, 0u, 0u, 0u);
    __threadfence();
    grid.sync();
  }
  XcdBarrier xb = xcd_barrier_post(pv.bar, (volatile LAS unsigned*)&xb_words);
  for (int l = 0; l < 2; ++l) {
    const bool last = (l == 1);
    const int Mt2 = last ? 256 : 264;
    const int Mr2 = last ? M_LAT : M_ALL;
    ph_convert(p, l, l == 0, lds); SYNC
    if (l == 0) { ph_rows(p, 0, 0, 0, M_ALL, true, 0, 0); SYNC }
    ph_ffn_up(p, 0, 264, lds); SYNC
    ph_ffn_down(p, l, 0, 264, lds); SYNC
    ph_rows(p, 1, l, 0, M_ALL, true, l, 3); SYNC
    ph_z_rw(p, lds); SYNC
    ph_conv<0>(p, l); SYNC
    ph_lora(p, l, lds); SYNC
    {
      const int ns = gridDim.x >= 384 ? 192 : 0;
      if (ns == 0 || blockIdx.x < 192) ph_rwscan(p, lds);
      if (ns == 0) { SYNC }
      if ((int)blockIdx.x >= ns) ph_s5_stage(p, l, lds, (int)blockIdx.x - ns, (int)gridDim.x - ns);
      SYNC
    }
    ph_rwpost(p, l); SYNC
    ph_z_ml(p, lds); SYNC
    ph_conv<1>(p, l); SYNC
    ph_ml_a(p, l, lds); SYNC
    ph_ml_b(p); SYNC
    ph_ml_c(p, l, lds); SYNC
    ph_gates(p, l, Mt2, lds); SYNC
    ph_merge(p, l, Mt2, lds); SYNC
    ph_wout(p, l, Mt2, lds); SYNC
    ph_rows(p, 1, l, 1, Mr2, true, l, 6); SYNC
    ph_ffn_up(p, 1, Mt2, lds); SYNC
    ph_ffn_down(p, l, 1, Mt2, lds); SYNC
    ph_rows(p, 1, l, 2, Mr2, !last, l + 1, 0);
    if (!last) { SYNC }
  }
#undef p
}

extern "C" void kernel_launch(void* const* d_in, const int* in_sizes, int n_in, void* d_out, int out_size, void* d_ws, size_t ws_size,
                              hipStream_t stream) {
  static int grid_blocks = 0;
  if (!grid_blocks) {
    int dev = 0, cus = 0, per_cu = 0;
    hipGetDevice(&dev);
    hipDeviceGetAttribute(&cus, hipDeviceAttributeMultiprocessorCount, dev);
    hipOccupancyMaxActiveBlocksPerMultiprocessor(&per_cu, mega, NTHR, 0);
    if (per_cu > 2) per_cu = 2;
    grid_blocks = cus * per_cu;
  }
  P p{};
  for (int i = 0; i < 40; ++i) p.in[i] = (const float*)d_in[i];
  char* ws = (char*)d_ws;
  size_t off = 0;
  p.W = (bf16_t*)(ws + off); off += (size_t)W_TOTAL * 2;
  p.mod = (float*)(ws + off); off += (size_t)2 * 5 * 9216 * 4;
  p.sctx = (float*)(ws + off); off += (size_t)1024 * 1024 * 4;
  p.bar = (unsigned*)(ws + off); off += (size_t)16384;
  p.U = (bf16_t*)(ws + off); off += (size_t)M_ALL * 1024 * 2;
  p.Y = (bf16_t*)(ws + off); off += (size_t)M_ALL * 1024 * 2;
  p.R = ws + off;
  p.out = (float*)d_out;
  if (off + (size_t)M_ALL * 9728 > ws_size) fprintf(stderr, "workspace too small: need %zu have %zu\n", off + (size_t)M_ALL * 9728, ws_size);
  void* args[] = {&p};
  hipError_t e = hipLaunchCooperativeKernel((void*)mega, dim3(grid_blocks), dim3(NTHR), args, 0, stream);
  if (e != hipSuccess) fprintf(stderr, "cooperative launch failed: %s (grid %d)\n", hipGetErrorString(e), grid_blocks);
}
```

```cpp
#include <hip/hip_runtime.h>
#include <hip/hip_cooperative_groups.h>
#include <cstdio>
namespace cg = cooperative_groups;

typedef unsigned short bf16_t;
typedef _Float16 hf;
typedef hf hf4 __attribute__((ext_vector_type(4)));
typedef hf hf8 __attribute__((ext_vector_type(8)));
typedef __attribute__((ext_vector_type(8))) short bf16x8;
typedef __attribute__((ext_vector_type(4))) float f32x4;
typedef unsigned int u32x4 __attribute__((ext_vector_type(4)));

#define M_LAT 32768
#define M_ALL 33792
#define NTHR 256
#define LDS_BYTES 73728
#define ALPHA 1.41421356237f

#define W_GU0 0
#define W_D0 5767168
#define W_GU1 8650752
#define W_D1 14417920
#define W_IN 17301504
#define W_WUP0 23740416
#define W_WUP1 23764992
#define W_AUP0 23789568
#define W_AUP1 23814144
#define W_GUP 23838720
#define W_GLU 23887872
#define W_UPRW 23953408
#define W_UPS5 24346624
#define W_UPML 24608768
#define W_OUT 25001984
#define W_TOTAL 26050560

struct P {
  const float* in[40];
  float* out; float* sctx; float* mod;
  bf16_t* U; bf16_t* Y; bf16_t* W; char* R; unsigned* bar;
};

__device__ __forceinline__ int get_tid() { int t = __builtin_amdgcn_workitem_id_x(); asm volatile("" : "+v"(t)); return t; }
__device__ __forceinline__ bf16_t f2bf(float f) { return __builtin_bit_cast(unsigned short, (_Float16)f); }
__device__ __forceinline__ float bf2f(bf16_t h) { return (float)__builtin_bit_cast(_Float16, h); }
__device__ __forceinline__ float sigmoidf_(float x) { return __builtin_amdgcn_rcpf(1.f + __expf(-x)); }
__device__ __forceinline__ float tanhf_(float x) { return 1.f - 2.f * __builtin_amdgcn_rcpf(1.f + __expf(2.f * x)); }
__device__ __forceinline__ float siluf_(float x) { return x * __builtin_amdgcn_rcpf(1.f + __expf(-x)); }
__device__ __forceinline__ float* srow(const P& p, int m) { return m < M_LAT ? p.out + (size_t)m * 1024 : p.sctx + (size_t)(m - M_LAT) * 1024; }
__device__ __forceinline__ const float* modp(const P& p, int l, int m, int k) { int mv = m < M_LAT ? (m >> 13) : 4; return p.mod + (size_t)(l * 5 + mv) * 9216 + k * 1024; }
template <int C> __device__ __forceinline__ float dppf(float x) { return __int_as_float(__builtin_amdgcn_update_dpp(0, __float_as_int(x), C, 0xf, 0xf, false)); }
__device__ __forceinline__ float rowsum16(float x) { x += dppf<0x128>(x); x += dppf<0x124>(x); x += dppf<0x122>(x); x += dppf<0x121>(x); return x; }
__device__ __forceinline__ float wavesum(float x) { for (int o = 32; o > 0; o >>= 1) x += __shfl_xor(x, o); return x; }

template <int NB>
__device__ __forceinline__ void gemm_main_t(const bf16_t* __restrict__ A, int lda, const bf16_t* __restrict__ B, int ldb, int K,
                                          f32x4 (&acc)[4][NB], char* lds) {
  const int tid = get_tid(), lane = tid & 63, wid = tid >> 6, wr = wid >> 1, wc = wid & 1;
  const int fr = lane & 15, fq = lane >> 4;
  const int sr = tid >> 3, skc = tid & 7;
  const bf16_t* ga = A + (size_t)sr * lda + skc * 8;
  const bf16_t* gb = B + (size_t)sr * ldb + skc * 8;
  u32x4 ra0[4], rb0[NB], ra1[4], rb1[NB];
  const int soff = sr * 144 + skc * 16;
  const int nk = K >> 6;
  const int aoff = (wr * 64 + fr) * 144 + fq * 16;
  const int boff = 18432 + (wc * (NB * 16) + fr) * 144 + fq * 16;
#define G_LOAD(RA, RB, kt) { _Pragma("unroll") for (int i = 0; i < 4; ++i) { RA[i] = *(const u32x4*)(ga + (size_t)(i * 32) * lda + (kt) * 64); if (i < NB) RB[i] = *(const u32x4*)(gb + (size_t)(i * 32) * ldb + (kt) * 64); } }
#define G_STORE(RA, RB, buf) { char* d_ = lds + (buf) * 36864 + soff; _Pragma("unroll") for (int i = 0; i < 4; ++i) { *(u32x4*)(d_ + i * 32 * 144) = RA[i]; if (i < NB) *(u32x4*)(d_ + 18432 + i * 32 * 144) = RB[i]; } }
#define G_COMP(buf) { const char* cur = lds + (buf) * 36864; _Pragma("unroll") for (int ks = 0; ks < 2; ++ks) { hf8 af[4], bfr[NB]; \
    _Pragma("unroll") for (int m = 0; m < 4; ++m) af[m] = *(const hf8*)(cur + aoff + m * 16 * 144 + ks * 64); \
    _Pragma("unroll") for (int n = 0; n < NB; ++n) bfr[n] = *(const hf8*)(cur + boff + n * 16 * 144 + ks * 64); \
    _Pragma("unroll") for (int m = 0; m < 4; ++m) _Pragma("unroll") for (int n = 0; n < NB; ++n) acc[m][n] = __builtin_amdgcn_mfma_f32_16x16x32_f16(af[m], bfr[n], acc[m][n], 0, 0, 0); } }
  G_LOAD(ra0, rb0, 0)
  { const int k1 = nk > 1 ? 1 : 0; G_LOAD(ra1, rb1, k1) }
  G_STORE(ra0, rb0, 0)
  __syncthreads();
  for (int kt = 0; kt < nk; kt += 2) {
    { const int k2 = kt + 2 < nk ? kt + 2 : nk - 1; G_LOAD(ra0, rb0, k2) }
    G_COMP(0)
    G_STORE(ra1, rb1, 1)
    __syncthreads();
    { const int k3 = kt + 3 < nk ? kt + 3 : nk - 1; G_LOAD(ra1, rb1, k3) }
    if (kt + 1 < nk) G_COMP(1)
    G_STORE(ra0, rb0, 0)
    __syncthreads();
  }
}
#define G_COMPS(buf) { const char* cur = lds + (buf) * 36864; _Pragma("unroll") for (int ks = 0; ks < 2; ++ks) { hf8 af[4], bfr[4]; \
    _Pragma("unroll") for (int m = 0; m < 4; ++m) af[m] = *(const hf8*)(cur + aoff + m * 16 * 144 + ks * 64); \
    _Pragma("unroll") for (int n = 0; n < 4; ++n) bfr[n] = *(const hf8*)(cur + boff + n * 16 * 144 + ks * 64); \
    _Pragma("unroll") for (int m = 0; m < 4; ++m) _Pragma("unroll") for (int n = 0; n < 4; ++n) \
      acc[m][n] = SW ? __builtin_amdgcn_mfma_f32_16x16x32_f16(bfr[n], af[m], acc[m][n], 0, 0, 0) : __builtin_amdgcn_mfma_f32_16x16x32_f16(af[m], bfr[n], acc[m][n], 0, 0, 0); } }
template <bool SW>
__device__ __forceinline__ void gemm_stream(const bf16_t* __restrict__ A, int lda, const bf16_t* __restrict__ B, int ldb, int K,
                                            const bf16_t* __restrict__ An, const bf16_t* __restrict__ Bn, bool first,
                                            f32x4 (&acc)[4][4], char* lds, u32x4 (&ra1)[4], u32x4 (&rb1)[4]) {
  constexpr int NB = 4;
  const int tid = get_tid(), lane = tid & 63, wid = tid >> 6, wr = wid >> 1, wc = wid & 1;
  const int fr = lane & 15, fq = lane >> 4;
  const int sr = tid >> 3, skc = tid & 7;
  const bf16_t* ga = A + (size_t)sr * lda + skc * 8;
  const bf16_t* gb = B + (size_t)sr * ldb + skc * 8;
  const bf16_t* gan = An + (size_t)sr * lda + skc * 8;
  const bf16_t* gbn = Bn + (size_t)sr * ldb + skc * 8;
  u32x4 ra0[4], rb0[NB];
  const int soff = sr * 144 + skc * 16;
  const int nk = K >> 6;
  const int aoff = (wr * 64 + fr) * 144 + fq * 16;
  const int boff = 18432 + (wc * (NB * 16) + fr) * 144 + fq * 16;
#define GS_LOAD(RA, RB, pa, pb, kt) { _Pragma("unroll") for (int i = 0; i < 4; ++i) { RA[i] = *(const u32x4*)((pa) + (size_t)(i * 32) * lda + (kt) * 64); RB[i] = *(const u32x4*)((pb) + (size_t)(i * 32) * ldb + (kt) * 64); } }
  if (first) {
    GS_LOAD(ra0, rb0, ga, gb, 0)
    GS_LOAD(ra1, rb1, ga, gb, 1)
    G_STORE(ra0, rb0, 0)
    __syncthreads();
  }
  for (int kt = 0; kt < nk; kt += 2) {
    if (kt + 2 < nk) { GS_LOAD(ra0, rb0, ga, gb, kt + 2) } else { GS_LOAD(ra0, rb0, gan, gbn, 0) }
    G_COMPS(0)
    G_STORE(ra1, rb1, 1)
    __syncthreads();
    if (kt + 3 < nk) { GS_LOAD(ra1, rb1, ga, gb, kt + 3) } else { GS_LOAD(ra1, rb1, gan, gbn, 1) }
    G_COMPS(1)
    G_STORE(ra0, rb0, 0)
    __syncthreads();
  }
}
__device__ __forceinline__ void gemm_main(const bf16_t* __restrict__ A, int lda, const bf16_t* __restrict__ B, int ldb, int K, f32x4 (&acc)[4][4], char* lds) {
  gemm_main_t<4>(A, lda, B, ldb, K, acc, lds);
}
template <int KT>
__device__ __forceinline__ void gemm_small_t(const bf16_t* __restrict__ A, int lda, const bf16_t* __restrict__ B, int ldb, f32x4 (&acc)[4][4], char* lds) {
  const int tid = get_tid(), lane = tid & 63, wid = tid >> 6, wr = wid >> 1, wc = wid & 1;
  const int fr = lane & 15, fq = lane >> 4;
  const int sr = tid >> 3, skc = tid & 7;
  const bf16_t* ga = A + (size_t)sr * lda + skc * 8;
  const bf16_t* gb = B + (size_t)sr * ldb + skc * 8;
  const int soff = sr * 144 + skc * 16;
  const int aoff = (wr * 64 + fr) * 144 + fq * 16;
  const int boff = 18432 + (wc * 64 + fr) * 144 + fq * 16;
  u32x4 ra[KT][4], rb[KT][4];
#pragma unroll
  for (int kt = 0; kt < KT; ++kt)
#pragma unroll
    for (int i = 0; i < 4; ++i) { ra[kt][i] = *(const u32x4*)(ga + (size_t)(i * 32) * lda + kt * 64); rb[kt][i] = *(const u32x4*)(gb + (size_t)(i * 32) * ldb + kt * 64); }
#pragma unroll
  for (int kt = 0; kt < KT; ++kt)
#pragma unroll
    for (int i = 0; i < 4; ++i) { *(u32x4*)(lds + kt * 36864 + soff + i * 32 * 144) = ra[kt][i]; *(u32x4*)(lds + kt * 36864 + 18432 + soff + i * 32 * 144) = rb[kt][i]; }
  __syncthreads();
#pragma unroll
  for (int kt = 0; kt < KT; ++kt) {
    const char* cur = lds + kt * 36864;
#pragma unroll
    for (int ks = 0; ks < 2; ++ks) {
      hf8 af[4], bfr[4];
#pragma unroll
      for (int m = 0; m < 4; ++m) af[m] = *(const hf8*)(cur + aoff + m * 16 * 144 + ks * 64);
#pragma unroll
      for (int n = 0; n < 4; ++n) bfr[n] = *(const hf8*)(cur + boff + n * 16 * 144 + ks * 64);
#pragma unroll
      for (int m = 0; m < 4; ++m)
#pragma unroll
        for (int n = 0; n < 4; ++n) acc[m][n] = __builtin_amdgcn_mfma_f32_16x16x32_f16(bfr[n], af[m], acc[m][n], 0, 0, 0);
    }
  }
  __syncthreads();
}

template <int SM>
__device__ __forceinline__ bool tile_map_sm(int b, int nb, int it, int Mt, int Nt, int SN, int& tm, int& tn) {
  const int xcd = b & 7, li = b >> 3, nloc = nb >> 3;
  const int T = SM * SN; const int nsn = Nt / SN; const int nsuper = (Mt / SM) * nsn;
  const int o = li + it * nloc; const int k = o / T, w = o - k * T;
  const int s = xcd + 8 * k;
  if (s >= nsuper) return false;
  const int sm = s / nsn, sn = s - sm * nsn;
  tm = sm * SM + (w % SM); tn = sn * SN + (w / SM);
  return true;
}
__device__ __forceinline__ bool tile_map_v(int b, int nb, int it, int Mt, int Nt, int SN, int& tm, int& tn) {
  const int nsn = Nt / SN;
  if (nsn * (Mt >> 3) % 8 == 0 || nsn >= 8) return tile_map_sm<8>(b, nb, it, Mt, Nt, SN, tm, tn);
  return tile_map_sm<1>(b, nb, it, Mt, Nt, SN, tm, tn);
}
__device__ __forceinline__ bool tile_map(int it, int Mt, int Nt, int SN, int& tm, int& tn) { return tile_map_v(blockIdx.x, gridDim.x, it, Mt, Nt, SN, tm, tn); }
#define ZERO_ACC(a) _Pragma("unroll") for (int m_ = 0; m_ < 4; ++m_) _Pragma("unroll") for (int n_ = 0; n_ < 4; ++n_) a[m_][n_] = (f32x4){0.f, 0.f, 0.f, 0.f};
#define EPI_VARS const int tid = get_tid(), lane = tid & 63, wid = tid >> 6, wr = wid >> 1, wc = wid & 1, fr = lane & 15, fq = lane >> 4; (void)wr; (void)wc; (void)fr; (void)fq;
#define EPI_ROW_BEGIN(m0) _Pragma("unroll") for (int m = 0; m < 4; ++m) _Pragma("unroll") for (int j = 0; j < 4; ++j) { const int row = (m0) + wr * 64 + m * 16 + fq * 4 + j; (void)row;
#define EPI_COL_BEGIN(n0) _Pragma("unroll") for (int n = 0; n < 4; ++n) { const int col = (n0) + wc * 64 + n * 16 + fr; const float val = acc[m][n][j]; (void)col; (void)val;
#define EPI_COL_END }
#define EPI_ROW_END }
#define EPI_BEGIN(m0, n0) EPI_ROW_BEGIN(m0) EPI_COL_BEGIN(n0)
#define EPI_END } }

struct Job { const float* src; int K, N; int dst; int mode; };
__device__ __forceinline__ Job get_job(const P& p, int l, int j) {
  Job r; r.mode = 0;
  switch (j) {
    case 0: r.src = p.in[8] + (size_t)(l * 2 + 0) * 1024 * 2816; r.K = 1024; r.N = 2816; r.dst = W_GU0; r.mode = 1; break;
    case 1: r.src = p.in[9] + (size_t)(l * 2 + 0) * 1024 * 2816; r.K = 1024; r.N = 2816; r.dst = W_GU0; r.mode = 2; break;
    case 2: r.src = p.in[10] + (size_t)(l * 2 + 0) * 2816 * 1024; r.K = 2816; r.N = 1024; r.dst = W_D0; break;
    case 3: r.src = p.in[8] + (size_t)(l * 2 + 1) * 1024 * 2816; r.K = 1024; r.N = 2816; r.dst = W_GU1; r.mode = 1; break;
    case 4: r.src = p.in[9] + (size_t)(l * 2 + 1) * 1024 * 2816; r.K = 1024; r.N = 2816; r.dst = W_GU1; r.mode = 2; break;
    case 5: r.src = p.in[10] + (size_t)(l * 2 + 1) * 2816 * 1024; r.K = 2816; r.N = 1024; r.dst = W_D1; break;
    case 6: r.src = p.in[11] + (size_t)l * 1024 * 6288; r.K = 1024; r.N = 6288; r.dst = W_IN; break;
    case 7: r.src = p.in[14] + (size_t)(l * 2 + 0) * 64 * 384; r.K = 64; r.N = 384; r.dst = W_WUP0; break;
    case 8: r.src = p.in[14] + (size_t)(l * 2 + 1) * 64 * 384; r.K = 64; r.N = 384; r.dst = W_WUP1; break;
    case 9: r.src = p.in[16] + (size_t)(l * 2 + 0) * 64 * 384; r.K = 64; r.N = 384; r.dst = W_AUP0; break;
    case 10: r.src = p.in[16] + (size_t)(l * 2 + 1) * 64 * 384; r.K = 64; r.N = 384; r.dst = W_AUP1; break;
    case 11: r.src = p.in[17] + (size_t)l * 128 * 384; r.K = 128; r.N = 384; r.dst = W_GUP; break;
    case 12: r.src = p.in[31] + (size_t)l * 256 * 256; r.K = 256; r.N = 256; r.dst = W_GLU; break;
    case 13: r.src = p.in[35] + (size_t)l * 384 * 1024; r.K = 384; r.N = 1024; r.dst = W_UPRW; break;
    case 14: r.src = p.in[36] + (size_t)l * 256 * 1024; r.K = 256; r.N = 1024; r.dst = W_UPS5; break;
    case 15: r.src = p.in[37] + (size_t)l * 384 * 1024; r.K = 384; r.N = 1024; r.dst = W_UPML; break;
    default: r.src = p.in[39] + (size_t)l * 1024 * 1024; r.K = 1024; r.N = 1024; r.dst = W_OUT; break;
  }
  return r;
}
#define NJOBS 17
__device__ void mod_task(const P& p, int t, char* lds) {
  float* sc = (float*)lds;
  float* red = sc + 5 * 1024;
  const int tid = get_tid();
  for (int i = tid; i < 5 * 1024; i += NTHR) {
    int v = i >> 10, k = i & 1023;
    float c = v < 4 ? p.in[1][v * 1024 + k] : p.in[3][k];
    sc[i] = siluf_(c);
  }
  __syncthreads();
  const int c0 = t * 64; const int l = c0 / 9216; const int j0 = c0 % 9216;
  const int col = tid & 63, part = tid >> 6;
  const float* w = p.in[4] + ((size_t)l * 1024 + part * 256) * 9216 + j0 + col;
  float a0 = 0, a1 = 0, a2 = 0, a3 = 0, a4 = 0;
  const float* s = sc + part * 256;
#pragma unroll 8
  for (int i = 0; i < 256; ++i) {
    float wv = w[(size_t)i * 9216];
    a0 += s[i] * wv; a1 += s[1024 + i] * wv; a2 += s[2048 + i] * wv; a3 += s[3072 + i] * wv; a4 += s[4096 + i] * wv;
  }
  red[(part * 5 + 0) * 64 + col] = a0; red[(part * 5 + 1) * 64 + col] = a1; red[(part * 5 + 2) * 64 + col] = a2;
  red[(part * 5 + 3) * 64 + col] = a3; red[(part * 5 + 4) * 64 + col] = a4;
  __syncthreads();
  for (int i = tid; i < 320; i += NTHR) {
    int v = i >> 6, c = i & 63;
    float sum = red[(0 * 5 + v) * 64 + c] + red[(1 * 5 + v) * 64 + c] + red[(2 * 5 + v) * 64 + c] + red[(3 * 5 + v) * 64 + c];
    p.mod[(size_t)(l * 5 + v) * 9216 + j0 + c] = sum + p.in[5][(size_t)l * 9216 + j0 + c];
  }
  __syncthreads();
}
__device__ __forceinline__ void ph_convert(const P& p, int l, bool with_mod, char* lds) {
  const int tid = get_tid();
  int ntiles[NJOBS]; int total = 0;
#pragma unroll
  for (int j = 0; j < NJOBS; ++j) { Job jb = get_job(p, l, j); ntiles[j] = (jb.K >> 6) * ((jb.N + 63) >> 6); total += ntiles[j]; }
  const int nmod = with_mod ? 288 : 0;
  float* tile = (float*)lds;
  for (int t = blockIdx.x; t < total + nmod; t += gridDim.x) {
    if (t < nmod) { mod_task(p, t, lds); continue; }
    int tt = t - nmod; int j = 0;
#pragma unroll
    for (int q = 0; q < NJOBS; ++q) { if (j == q && tt >= ntiles[q]) { tt -= ntiles[q]; j = q + 1; } }
    Job jb = get_job(p, l, j);
    const int nkt = jb.K >> 6;
    const int k0 = (tt % nkt) * 64, n0 = (tt / nkt) * 64;
    {
      const int c = tid & 63, r0 = tid >> 6;
      const bool ok = (n0 + c) < jb.N;
#pragma unroll
      for (int i = 0; i < 16; ++i) { int r = r0 + i * 4; tile[r * 65 + c] = ok ? jb.src[(size_t)(k0 + r) * jb.N + n0 + c] : 0.f; }
    }
    __syncthreads();
    {
      const int nn = tid >> 2, q = tid & 3; const int n = n0 + nn;
      if (n < jb.N) {
        int drow = n;
        if (jb.mode == 1) drow = (n >> 5) * 64 + (n & 31);
        else if (jb.mode == 2) drow = (n >> 5) * 64 + 32 + (n & 31);
        bf16_t* d = p.W + jb.dst + (size_t)drow * jb.K + k0 + q * 16;
        unsigned pk[8];
#pragma unroll
        for (int i = 0; i < 8; ++i) { unsigned lo = f2bf(tile[(q * 16 + 2 * i) * 65 + nn]); unsigned hi = f2bf(tile[(q * 16 + 2 * i + 1) * 65 + nn]); pk[i] = lo | (hi << 16); }
        *(uint4*)d = make_uint4(pk[0], pk[1], pk[2], pk[3]);
        *(uint4*)(d + 8) = make_uint4(pk[4], pk[5], pk[6], pk[7]);
      }
    }
    __syncthreads();
  }
}

__device__ __forceinline__ void ph_rows(const P& p, int mode, int l, int ln_idx, int Mrows, bool writeU, int ul, int ks) {
  const int lane = get_tid() & 63, wid = get_tid() >> 6;
  const int nw = gridDim.x * 4;
  const float* g = p.in[6] + (size_t)(l * 3 + ln_idx) * 1024;
  const float* b = p.in[7] + (size_t)(l * 3 + ln_idx) * 1024;
  for (int m = blockIdx.x * 4 + wid; m < Mrows; m += nw) {
    float* s = srow(p, m);
    const float* src = s;
    if (mode == 0) src = m < M_LAT ? p.in[0] + (size_t)m * 1024 : p.in[2] + (size_t)(m - M_LAT) * 1024;
    float4 v[4];
#pragma unroll
    for (int i = 0; i < 4; ++i) v[i] = *(const float4*)(src + lane * 4 + i * 256);
    if (mode == 1) {
      float sum = 0;
#pragma unroll
      for (int i = 0; i < 4; ++i) sum += v[i].x + v[i].y + v[i].z + v[i].w;
      sum = wavesum(sum);
      const float mean = sum * (1.f / 1024.f);
      float sq = 0;
#pragma unroll
      for (int i = 0; i < 4; ++i) { v[i].x -= mean; v[i].y -= mean; v[i].z -= mean; v[i].w -= mean; sq += v[i].x * v[i].x + v[i].y * v[i].y + v[i].z * v[i].z + v[i].w * v[i].w; }
      sq = wavesum(sq);
      const float rstd = rsqrtf(sq * (1.f / 1024.f) + 1e-5f);
#pragma unroll
      for (int i = 0; i < 4; ++i) {
        float4 gg = *(const float4*)(g + lane * 4 + i * 256), bb = *(const float4*)(b + lane * 4 + i * 256);
        v[i].x = v[i].x * rstd * gg.x + bb.x; v[i].y = v[i].y * rstd * gg.y + bb.y; v[i].z = v[i].z * rstd * gg.z + bb.z; v[i].w = v[i].w * rstd * gg.w + bb.w;
      }
    }
    if (mode == 1) {
#pragma unroll
      for (int i = 0; i < 4; ++i) *(float4*)(s + lane * 4 + i * 256) = v[i];
    }
    if (writeU) {
      const float* sh = modp(p, ul, m, ks); const float* scl = modp(p, ul, m, ks + 1);
#pragma unroll
      for (int i = 0; i < 4; ++i) {
        float4 a = *(const float4*)(sh + lane * 4 + i * 256), c = *(const float4*)(scl + lane * 4 + i * 256);
        unsigned lo = f2bf(v[i].x * (1.f + c.x) + a.x) | ((unsigned)f2bf(v[i].y * (1.f + c.y) + a.y) << 16);
        unsigned hi = f2bf(v[i].z * (1.f + c.z) + a.z) | ((unsigned)f2bf(v[i].w * (1.f + c.w) + a.w) << 16);
        *(uint2*)(p.U + (size_t)m * 1024 + lane * 4 + i * 256) = make_uint2(lo, hi);
      }
    }
  }
}


#define STREAM_BEGIN_X(SWAPPED_, Mt_, Nt_, SN_, APTR, BPTR, LDA_, LDB_, K_) { \
    u32x4 pr_a[4], pr_b[4]; bool first_ = true; int tm, tn; bool have_ = tile_map(0, Mt_, Nt_, SN_, tm, tn); \
    for (int it = 0; have_; ++it) { int tm2, tn2; const bool have2_ = tile_map(it + 1, Mt_, Nt_, SN_, tm2, tn2); \
      const int tmn = have2_ ? tm2 : tm, tnn = have2_ ? tn2 : tn; \
      f32x4 acc[4][4]; ZERO_ACC(acc) \
      { const bf16_t* a_cur = APTR; const bf16_t* b_cur = BPTR; \
        const bf16_t* a_nxt; const bf16_t* b_nxt; { const int tm = tmn, tn = tnn; (void)tm; (void)tn; a_nxt = APTR; b_nxt = BPTR; } \
        gemm_stream<SWAPPED_>(a_cur, LDA_, b_cur, LDB_, K_, a_nxt, b_nxt, first_, acc, lds, pr_a, pr_b); first_ = false; }
#define STREAM_BEGIN(Mt_, Nt_, SN_, APTR, BPTR, LDA_, LDB_, K_) STREAM_BEGIN_X(false, Mt_, Nt_, SN_, APTR, BPTR, LDA_, LDB_, K_)
#define STREAM_BEGIN_T(Mt_, Nt_, SN_, APTR, BPTR, LDA_, LDB_, K_) STREAM_BEGIN_X(true, Mt_, Nt_, SN_, APTR, BPTR, LDA_, LDB_, K_)
#define STREAM_END tm = tm2; tn = tn2; have_ = have2_; } }
__device__ __forceinline__ void ph_ffn_up(const P& p, int s, int Mt, char* lds) {
  EPI_VARS
  bf16_t* HM = (bf16_t*)p.R;
  const bf16_t* Wt = p.W + (s ? W_GU1 : W_GU0);
  STREAM_BEGIN_T(Mt, 44, 4, (p.U + (size_t)(tm * 128) * 1024), (Wt + (size_t)(tn * 128) * 1024), 1024, 1024, 1024)
    const int m0 = tm * 128, n0 = tn * 128;
    const int hb = ((n0 + wc * 64) >> 6) * 32 + fq * 4;
#pragma unroll
    for (int m = 0; m < 4; ++m) {
      bf16_t* hp = HM + (size_t)(m0 + wr * 64 + m * 16 + fr) * 2816 + hb;
#pragma unroll
      for (int n = 0; n < 2; ++n) {
        const unsigned lo = (unsigned)f2bf(siluf_(acc[m][n][0]) * acc[m][n + 2][0]) | ((unsigned)f2bf(siluf_(acc[m][n][1]) * acc[m][n + 2][1]) << 16);
        const unsigned hi = (unsigned)f2bf(siluf_(acc[m][n][2]) * acc[m][n + 2][2]) | ((unsigned)f2bf(siluf_(acc[m][n][3]) * acc[m][n + 2][3]) << 16);
        *(uint2*)(hp + n * 16) = make_uint2(lo, hi);
      }
    }
  STREAM_END
}
__device__ __forceinline__ void ph_ffn_down(const P& p, int l, int s, int Mt, char* lds) {
  EPI_VARS
  const bf16_t* HM = (const bf16_t*)p.R;
  const bf16_t* Wt = p.W + (s ? W_D1 : W_D0);
  const int gk = s ? 8 : 2;
  STREAM_BEGIN_T(Mt, 8, 8, (HM + (size_t)(tm * 128) * 2816), (Wt + (size_t)(tn * 128) * 2816), 2816, 2816, 2816)
    const int m0 = tm * 128, n0 = tn * 128;
#pragma unroll
    for (int m = 0; m < 4; ++m) {
      const int row = m0 + wr * 64 + m * 16 + fr;
      float* sp = srow(p, row) + n0 + wc * 64 + fq * 4; const float* gp = modp(p, l, row, gk) + n0 + wc * 64 + fq * 4;
      const float* rp = (l == 0 && s == 0) ? (row < M_LAT ? p.in[0] + (size_t)row * 1024 : p.in[2] + (size_t)(row - M_LAT) * 1024) + n0 + wc * 64 + fq * 4 : sp;
#pragma unroll
      for (int n = 0; n < 4; ++n) {
        float4 s4 = *(const float4*)(rp + n * 16); const float4 g4 = *(const float4*)(gp + n * 16);
        s4.x = ALPHA * s4.x + 0.5f * g4.x * acc[m][n][0]; s4.y = ALPHA * s4.y + 0.5f * g4.y * acc[m][n][1];
        s4.z = ALPHA * s4.z + 0.5f * g4.z * acc[m][n][2]; s4.w = ALPHA * s4.w + 0.5f * g4.w * acc[m][n][3];
        *(float4*)(sp + n * 16) = s4;
      }
    }
  STREAM_END
}

#define RW_ZRW(p) ((hf*)(p).R)
#define RW_RKV(p) (RW_ZRW(p) + (size_t)M_ALL * 1152)
#define RW_LA(p) ((bf16_t*)(RW_RKV(p) + (size_t)M_ALL * 1152))
#define RW_KK(p) ((hf*)(RW_LA(p) + (size_t)M_ALL * 256))
#define RW_KD(p) (RW_KK(p) + (size_t)M_ALL * 384)
#define RW_KA(p) (RW_KD(p) + (size_t)2 * M_ALL * 384)
#define RW_YR(p) (RW_KA(p) + (size_t)2 * M_ALL * 384)

#define S5_ZH(p) ((hf*)RW_LA(p))
#define S5_YG(p) ((p).W + W_GU0)
#define S5_E(p) ((float2*)((p).R + (size_t)M_ALL * 9728))
#define S5_X(p) S5_E(p)

#define ML_Z(p) ((hf*)(p).R)
#define ML_GL(p) ((float*)(ML_Z(p) + (size_t)M_ALL * 1536))
#define ML_QK(p) ((hf*)(ML_GL(p) + (size_t)M_ALL * 16))
#define ML_DC(p) ((float*)(ML_QK(p) + (size_t)M_ALL * 768))
#define ML_DN(p) (ML_DC(p) + (size_t)4224 * 9216)
#define ML_SC(p) (ML_DN(p) + (size_t)4224 * 96)
#define ML_MP(p) (ML_SC(p) + (size_t)4224 * 2)

__device__ __forceinline__ void ph_z_rw(const P& p, char* lds) {
  EPI_VARS
  hf* ZRW = RW_ZRW(p); bf16_t* LA = RW_LA(p);
  const int Mt = 264;
  STREAM_BEGIN(Mt, 11, 11, (p.U + (size_t)(tm * 128) * 1024), (p.W + W_IN + (size_t)(tn < 9 ? tn * 128 : 2960 + (tn - 9) * 128) * 1024), 1024, 1024, 1024)
    const int m0 = tm * 128;
    if (tn < 9) {
      EPI_BEGIN(m0, tn * 128)
        ZRW[(size_t)row * 1152 + col] = (hf)val;
      EPI_END
    } else {
      EPI_BEGIN(m0, (tn - 9) * 128)
        float o = col < 64 ? tanhf_(val) : (col < 128 ? val : sigmoidf_(val));
        LA[(size_t)row * 256 + col] = f2bf(o);
      EPI_END
    }
  STREAM_END
}
__device__ __forceinline__ void ph_z_s5(const P& p, char* lds, int vb, int nvb) {
  EPI_VARS
  hf* Z = S5_ZH(p);
  const int Mt = 264;
  for (int it = 0;; ++it) {
    int tm, tn; if (!tile_map_v(vb, nvb, it, Mt, 2, 2, tm, tn)) break; const int m0 = tm * 128;
    f32x4 acc[4][4]; ZERO_ACC(acc)
    gemm_main(p.U + (size_t)m0 * 1024, 1024, p.W + W_IN + (size_t)(2704 + tn * 128) * 1024, 1024, 1024, acc, lds);
    EPI_BEGIN(m0, tn * 128)
      Z[(size_t)row * 256 + col] = (hf)val;
    EPI_END
  }
}
__device__ __forceinline__ void ph_z_ml(const P& p, char* lds) {
  EPI_VARS
  hf* Z = ML_Z(p); float* GL = ML_GL(p);
  const int Mt = 264;
  STREAM_BEGIN(Mt, 13, 13, (p.U + (size_t)(tm * 128) * 1024), (p.W + W_IN + (size_t)(1152 + tn * 128) * 1024), 1024, 1024, 1024)
    const int m0 = tm * 128;
    if (tn < 12) {
      EPI_BEGIN(m0, tn * 128)
        Z[(size_t)row * 1536 + col] = (hf)val;
      EPI_END
    } else {
      EPI_BEGIN(m0, 0)
        if (col < 16) GL[(size_t)row * 16 + col] = val;
      EPI_END
    }
  STREAM_END
}

template <int which>
__device__ __forceinline__ void ph_conv(const P& p, int l) {
  constexpr int nch = which == 0 ? 144 : 96;
  constexpr int ldin = which == 0 ? 1152 : 1536;
  constexpr int cbase = which == 0 ? 0 : 1152;
  const hf* Zin = which == 0 ? RW_ZRW(p) : ML_Z(p);
  const float* cw = p.in[12] + (size_t)l * 9 * 1920;
  const unsigned total = (unsigned)(M_ALL / 4) * nch;
  for (unsigned idx = blockIdx.x * NTHR + get_tid(); idx < (total + 63u) / 64u * 64u; idx += gridDim.x * NTHR) {
    const bool act = idx < total;
    const int tg = act ? (int)(idx / (unsigned)nch) : 0; const int ch = act ? (int)(idx % (unsigned)nch) : 0; const int c0 = ch * 8;
    const int m0 = tg * 4;
    float o[4][8];
#pragma unroll
    for (int t = 0; t < 4; ++t)
#pragma unroll
      for (int i = 0; i < 8; ++i) o[t][i] = 0.f;
    const bool lat = m0 < M_LAT;
    const int bb = m0 >> 13, tt = lat ? (m0 & 8191) : ((m0 - M_LAT) & 255);
    const int gr = tt >> 6, gc0 = lat ? (tt & 63) : tt;
    const int ncol = lat ? 64 : 256;
#pragma unroll
    for (int dr = -1; dr <= 1; ++dr) {
      const int rr = gr + dr;
      const bool rowok = lat ? (rr >= 0 && rr < 128) : (dr == 0);
      if (!rowok) continue;
      const float* w = cw + ((dr + 1) * 3) * 1920 + cbase + c0;
      float wv[3][8];
#pragma unroll
      for (int k = 0; k < 3; ++k) { const float4 a = *(const float4*)(w + k * 1920), b = *(const float4*)(w + k * 1920 + 4);
        wv[k][0] = a.x; wv[k][1] = a.y; wv[k][2] = a.z; wv[k][3] = a.w; wv[k][4] = b.x; wv[k][5] = b.y; wv[k][6] = b.z; wv[k][7] = b.w; }
      const int mrow = lat ? ((bb << 13) + rr * 64) : (m0 - gc0);
#pragma unroll
      for (int cc = 0; cc < 6; ++cc) {
        const int col = gc0 - 1 + cc;
        if (col < 0 || col >= ncol) continue;
        const hf8 z = *(const hf8*)(Zin + (size_t)(mrow + col) * ldin + c0);
        float zf[8];
#pragma unroll
        for (int i = 0; i < 8; ++i) zf[i] = (float)z[i];
#pragma unroll
        for (int t = 0; t < 4; ++t) {
          const int k = cc - t;
          if (k >= 0 && k < 3) {
#pragma unroll
            for (int i = 0; i < 8; ++i) o[t][i] += zf[i] * wv[k][i];
          }
        }
      }
    }
#pragma unroll
    for (int t = 0; t < 4; ++t) {
      const int m = m0 + t;
      if (which == 0) {
        const bool isk = act && (c0 >= 384) && (c0 < 768);
        float kkv[8]; float ss = 0.f;
        if (isk) {
          const float* kkw = p.in[18] + (size_t)l * 384 + (c0 - 384);
#pragma unroll
          for (int i = 0; i < 8; ++i) { kkv[i] = o[t][i] * kkw[i]; ss += kkv[i] * kkv[i]; }
        } else {
#pragma unroll
          for (int i = 0; i < 8; ++i) kkv[i] = 0.f;
        }
        ss += __shfl_xor(ss, 1); ss += __shfl_xor(ss, 2); ss += __shfl_xor(ss, 4);
        if (act) {
          hf8 ov;
#pragma unroll
          for (int i = 0; i < 8; ++i) ov[i] = (hf)o[t][i];
          *(hf8*)(RW_RKV(p) + (size_t)m * 1152 + c0) = ov;
          if (isk) {
            const float rn = rsqrtf(fmaxf(ss, 1e-24f));
            hf8 kv;
#pragma unroll
            for (int i = 0; i < 8; ++i) kv[i] = (hf)(kkv[i] * rn);
            *(hf8*)(RW_KK(p) + (size_t)m * 384 + (c0 - 384)) = kv;
          }
        }
      } else if (act) {
        const float sc = c0 >= 384 ? 0.10206207261596575f : 1.f;
        hf8 ov;
#pragma unroll
        for (int i = 0; i < 8; ++i) ov[i] = (hf)(siluf_(o[t][i]) * sc);
        *(hf8*)(ML_QK(p) + (size_t)m * 768 + c0) = ov;
      }
    }
  }
}

__device__ __forceinline__ void ph_lora(const P& p, int l, char* lds) {
  EPI_VARS
  hf* ZRW = RW_ZRW(p); const hf* RKV = RW_RKV(p); const bf16_t* LA = RW_LA(p); const hf* KK = RW_KK(p);
  hf* KD = RW_KD(p); hf* KA = RW_KA(p);
  const int Mt = 264;
  for (int it = 0;; ++it) {
    int tm, q; if (!tile_map(it, Mt, 15, 15, tm, q)) break; const int job = q / 3, tn = q % 3; const int m0 = tm * 128, n0 = tn * 128;
    f32x4 acc[4][4]; ZERO_ACC(acc)
    if (job < 2) {
      const int d = job;
      gemm_small_t<1>(LA + (size_t)m0 * 256, 256, p.W + (d ? W_WUP1 : W_WUP0) + (size_t)n0 * 64, 64, acc, lds);
      const float* w0 = p.in[13] + (size_t)(l * 2 + d) * 384;
#pragma unroll
      for (int m = 0; m < 4; ++m) {
        const int row = m0 + wr * 64 + m * 16 + fr;
#pragma unroll
        for (int n = 0; n < 4; ++n) {
          const int cb = n0 + wc * 64 + n * 16 + fq * 4;
          const float4 wv = *(const float4*)(w0 + cb);
          const float wa[4] = {wv.x, wv.y, wv.z, wv.w};
          hf4 o;
#pragma unroll
          for (int j = 0; j < 4; ++j) { const float e = sigmoidf_(wa[j] + acc[m][n][j]) * 0.6065306597126334f; o[j] = (hf)(1.f - __expf(-e)); }
          *(hf4*)(ZRW + (size_t)row * 1152 + d * 384 + cb) = o;
        }
      }
    } else if (job < 4) {
      const int d = job - 2;
      gemm_small_t<1>(LA + (size_t)m0 * 256 + 64, 256, p.W + (d ? W_AUP1 : W_AUP0) + (size_t)n0 * 64, 64, acc, lds);
      const float* a0 = p.in[15] + (size_t)(l * 2 + d) * 384; const float* kaw = p.in[19] + (size_t)l * 384;
#pragma unroll
      for (int m = 0; m < 4; ++m) {
        const int row = m0 + wr * 64 + m * 16 + fr;
#pragma unroll
        for (int n = 0; n < 4; ++n) {
          const int cb = n0 + wc * 64 + n * 16 + fq * 4;
          const float4 av = *(const float4*)(a0 + cb), kv = *(const float4*)(kaw + cb);
          const float aa[4] = {av.x, av.y, av.z, av.w}, ka_[4] = {kv.x, kv.y, kv.z, kv.w};
          const hf4 k4 = *(const hf4*)(RKV + (size_t)row * 1152 + 384 + cb), kk4 = *(const hf4*)(KK + (size_t)row * 384 + cb);
          hf4 okd, oka;
#pragma unroll
          for (int j = 0; j < 4; ++j) { const float a = sigmoidf_(aa[j] + acc[m][n][j]); okd[j] = (hf)((float)k4[j] * (1.f + (a - 1.f) * ka_[j])); oka[j] = (hf)((float)kk4[j] * a); }
          *(hf4*)(KD + ((size_t)d * M_ALL + row) * 384 + cb) = okd;
          *(hf4*)(KA + ((size_t)d * M_ALL + row) * 384 + cb) = oka;
        }
      }
    } else {
      gemm_small_t<2>(LA + (size_t)m0 * 256 + 128, 256, p.W + W_GUP + (size_t)n0 * 128, 128, acc, lds);
#pragma unroll
      for (int m = 0; m < 4; ++m) {
        const int row = m0 + wr * 64 + m * 16 + fr;
#pragma unroll
        for (int n = 0; n < 4; ++n) {
          const int cb = n0 + wc * 64 + n * 16 + fq * 4;
          hf4 o; o[0] = (hf)acc[m][n][0]; o[1] = (hf)acc[m][n][1]; o[2] = (hf)acc[m][n][2]; o[3] = (hf)acc[m][n][3];
          *(hf4*)(ZRW + (size_t)row * 1152 + 768 + cb) = o;
        }
      }
    }
  }
}

typedef float f32x2 __attribute__((ext_vector_type(2)));
#define RW_CH 16
#define RW_BUF 21504
__device__ __forceinline__ void rw_cvt_store(char* dst, uint4 q) {
  const hf8 h = __builtin_bit_cast(hf8, q);
  f32x4 a, b;
  a[0] = (float)h[0]; a[1] = (float)h[1]; a[2] = (float)h[2]; a[3] = (float)h[3];
  b[0] = (float)h[4]; b[1] = (float)h[5]; b[2] = (float)h[6]; b[3] = (float)h[7];
  *(f32x4*)dst = a; *(f32x4*)(dst + 16) = b;
}
__device__ __forceinline__ void ph_rwscan(const P& p, char* lds) {
  const hf* ZRW = RW_ZRW(p); hf* RKV = RW_RKV(p); const hf* KK = RW_KK(p);
  const int tid = get_tid(), lane = tid & 63, wid = tid >> 6;
  char* pbuf = lds + 3 * RW_BUF + wid * 2048;
  char* ybuf = lds + 3 * RW_BUF + 8192;
  for (int t = blockIdx.x; t < 192; t += gridDim.x) {
    const int rqq = t & 3, h = (t >> 2) % 6, b = (t / 24) & 3, d = t / 96;
    const int rsub = lane >> 4, g = lane & 15; const int rl = wid * 4 + rsub;
    const int sgn = d ? -1 : 1;
    const bool grpA = tid < 128; const int t2 = tid & 127;
    const int sstep = t2 >> 3, sseg = t2 & 7;
    const hf* g0 = grpA ? (RKV + h * 64 + sseg * 8) : (RW_KD(p) + (size_t)d * M_ALL * 384 + h * 64 + sseg * 8);
    const size_t ld0 = grpA ? 1152 : 384;
    const hf* g1 = grpA ? (KK + h * 64 + sseg * 8) : (RW_KA(p) + (size_t)d * M_ALL * 384 + h * 64 + sseg * 8);
    const hf* g2 = grpA ? (ZRW + d * 384 + h * 64 + sseg * 8) : (RKV + 768 + h * 64 + rqq * 16 + (t2 & 1) * 8);
    const int s2 = grpA ? sstep : (t2 >> 1);
    const bool has2 = grpA || t2 < 32;
    const int o0 = (grpA ? 0 : 12288) + sstep * 256 + sseg * 32;
    const int o1 = (grpA ? 4096 : 16384) + sstep * 256 + sseg * 32;
    const int o2 = grpA ? (8192 + sstep * 256 + sseg * 32) : (20480 + (t2 >> 1) * 64 + (t2 & 1) * 32);
    hf* g_y = d == 0 ? (RKV + 384 + h * 64 + rqq * 16 + (tid & 1) * 8) : (RW_YR(p) + h * 64 + rqq * 16 + (tid & 1) * 8);
    const int ldy = d == 0 ? 1152 : 384;
    uint4 q0, q1, q2;
#define RW_M0(pp) ((pp) < 256 ? (M_LAT + b * 256 + (d ? 255 - (pp) : (pp))) : (b * 8192 + (d ? 8447 - (pp) : (pp) - 256)))
#define RW_GLOAD(c) { const int mb_ = RW_M0((c) * RW_CH); const size_t mm = (size_t)(mb_ + sgn * sstep); \
      q0 = *(const uint4*)(g0 + mm * ld0); q1 = *(const uint4*)(g1 + mm * 384); \
      if (has2) { const size_t m2 = (size_t)(mb_ + sgn * s2); q2 = *(const uint4*)(g2 + m2 * 1152); } }
#define RW_SSTORE(c) { char* bb_ = lds + ((c) % 3) * RW_BUF; rw_cvt_store(bb_ + o0, q0); rw_cvt_store(bb_ + o1, q1); if (has2) rw_cvt_store(bb_ + o2, q2); }
    f32x2 S01 = (f32x2){0.f, 0.f}, S23 = (f32x2){0.f, 0.f};
    RW_GLOAD(0) RW_SSTORE(0)
    RW_GLOAD(1) RW_SSTORE(1)
    __syncthreads();
    const int NCH = 8448 / RW_CH;
    for (int c = 0; c < NCH; ++c) {
      if (c + 2 < NCH) RW_GLOAD(c + 2)
      if (c > 0 && tid < 32) {
        const int mb_ = RW_M0((c - 1) * RW_CH); const size_t mv = (size_t)(mb_ + sgn * (tid >> 1));
        *(uint4*)(g_y + mv * ldy) = *(const uint4*)(ybuf + ((c - 1) & 1) * 512 + tid * 16);
      }
      const char* cb = lds + (c % 3) * RW_BUF + g * 16;
      const char* vb = lds + (c % 3) * RW_BUF + 20480 + rl * 4;
      f32x4 R4[RW_CH], K4[RW_CH], D4[RW_CH], KD4[RW_CH], KA4[RW_CH]; float VV[RW_CH];
#define RW_LDS(s_) { R4[s_] = *(const f32x4*)(cb + (s_) * 256); K4[s_] = *(const f32x4*)(cb + 4096 + (s_) * 256); D4[s_] = *(const f32x4*)(cb + 8192 + (s_) * 256); \
        KD4[s_] = *(const f32x4*)(cb + 12288 + (s_) * 256); KA4[s_] = *(const f32x4*)(cb + 16384 + (s_) * 256); VV[s_] = *(const float*)(vb + (s_) * 64); }
      RW_LDS(0) RW_LDS(1) RW_LDS(2)
#pragma unroll
      for (int s = 0; s < RW_CH; ++s) {
        if (s + 3 < RW_CH) RW_LDS(s + 3)
        const f32x4 r4 = R4[s], k4 = K4[s], d4 = D4[s], kd4 = KD4[s], ka4 = KA4[s]; const float vv = VV[s];
        const f32x2 k01 = {k4[0], k4[1]}, k23 = {k4[2], k4[3]}, d01 = {d4[0], d4[1]}, d23 = {d4[2], d4[3]};
        const f32x2 kd01 = {kd4[0], kd4[1]}, kd23 = {kd4[2], kd4[3]}, ka01 = {ka4[0], ka4[1]}, ka23 = {ka4[2], ka4[3]};
        const f32x2 r01 = {r4[0], r4[1]}, r23 = {r4[2], r4[3]};
        const f32x2 sa2 = __builtin_elementwise_fma(S23, k23, S01 * k01);
        float sa = sa2[0] + sa2[1];
        sa = rowsum16(sa);
        const f32x2 vv2 = {vv, vv}; const f32x2 nsa = {-sa, -sa};
        f32x2 T01 = __builtin_elementwise_fma(-S01, d01, S01), T23 = __builtin_elementwise_fma(-S23, d23, S23);
        T01 = __builtin_elementwise_fma(vv2, kd01, T01); T23 = __builtin_elementwise_fma(vv2, kd23, T23);
        S01 = __builtin_elementwise_fma(nsa, ka01, T01); S23 = __builtin_elementwise_fma(nsa, ka23, T23);
        const f32x2 y2 = __builtin_elementwise_fma(S23, r23, S01 * r01);
        *(float*)(pbuf + (((s & 7) * 4 + rsub) * 16 + g) * 4) = y2[0] + y2[1];
        if ((s & 7) == 7) {
          if (lane < 32) {
            const char* pr = pbuf + lane * 64;
            const f32x4 a0 = *(const f32x4*)(pr), a1 = *(const f32x4*)(pr + 16), a2 = *(const f32x4*)(pr + 32), a3 = *(const f32x4*)(pr + 48);
            const f32x4 sm = (a0 + a1) + (a2 + a3);
            const float y = (sm[0] + sm[1]) + (sm[2] + sm[3]);
            *(hf*)(ybuf + (c & 1) * 512 + (((s >> 3) * 8 + (lane >> 2)) * 16 + wid * 4 + (lane & 3)) * 2) = (hf)y;
          }
        }
      }
      if (c + 2 < NCH) RW_SSTORE(c + 2)
      __syncthreads();
    }
    if (tid < 32) {
      const int mb_ = RW_M0((NCH - 1) * RW_CH); const size_t mv = (size_t)(mb_ + sgn * (tid >> 1));
      *(uint4*)(g_y + mv * ldy) = *(const uint4*)(ybuf + ((NCH - 1) & 1) * 512 + tid * 16);
    }
    __syncthreads();
  }
}

__device__ __forceinline__ void ph_rwpost(const P& p, int l) {
  const hf* ZRW = RW_ZRW(p); const hf* RKV = RW_RKV(p); const hf* YR = RW_YR(p);
  const int lane = get_tid() & 63, wid = get_tid() >> 6;
  const int nw = gridDim.x * 4;
  for (int t = blockIdx.x * 4 + wid; t < M_ALL * 6; t += nw) {
    const int m = t / 6, h = t % 6; const int c = h * 64 + lane;
    const float ys = (float)RKV[(size_t)m * 1152 + 384 + c] + (float)YR[(size_t)m * 384 + c];
    const float mean = wavesum(ys) * (1.f / 64.f);
    const float xc = ys - mean;
    const float var = wavesum(xc * xc) * (1.f / 64.f);
    float y = xc * rsqrtf(var + 64e-5f) * p.in[21][(size_t)l * 384 + c] + p.in[22][(size_t)l * 384 + c];
    const float r = (float)RKV[(size_t)m * 1152 + c], v = (float)RKV[(size_t)m * 1152 + 768 + c];
    const float rk = p.in[20][(size_t)l * 384 + c];
    const float kd0 = (float)RW_KD(p)[(size_t)m * 384 + c], kd1 = (float)RW_KD(p)[((size_t)M_ALL + m) * 384 + c];
    const float bs = wavesum(r * (kd0 + kd1) * rk);
    y = (y + bs * v) * (float)ZRW[(size_t)m * 1152 + 768 + c];
    p.Y[(size_t)m * 1024 + c] = f2bf(y);
  }
}

struct S5C { float ar, ai; float br[16], bi[16]; };
__device__ __forceinline__ void s5_consts(const P& p, int l, int d, int g, int n, S5C& c) {
  const int ig = (l * 2 + d) * 16 + g;
  const float lr = fminf(p.in[23][(size_t)ig * 64 + n], -1e-4f), li = p.in[24][(size_t)ig * 64 + n];
  const float dt = expf(p.in[25][ig]);
  const float mag = expf(lr * dt);
  c.ar = mag * cosf(li * dt); c.ai = mag * sinf(li * dt);
  const float nr = c.ar - 1.f, ni = c.ai; const float den = 1.f / (lr * lr + li * li);
  const float cr = (nr * lr + ni * li) * den, ci = (ni * lr - nr * li) * den;
  const float* bre = p.in[26] + ((size_t)ig * 64 + n) * 16; const float* bim = p.in[27] + ((size_t)ig * 64 + n) * 16;
#pragma unroll
  for (int h = 0; h < 16; ++h) { const float xr = bre[h], xi = bim[h]; c.br[h] = cr * xr - ci * xi; c.bi[h] = cr * xi + ci * xr; }
}
__device__ __forceinline__ int s5_m0(int b, int tc) { return tc < 128 ? b * 8192 + tc * 64 : M_LAT + b * 256 + (tc - 128) * 64; }
__device__ __forceinline__ int chain_pos(int d, int tc) { return d == 0 ? (tc < 128 ? tc + 4 : tc - 128) : (tc < 128 ? 131 - tc : 131 - tc); }
__device__ __forceinline__ void s5_cf(const P& p, int ig, int n, float dt, float& ar, float& ai, float& cr, float& ci) {
  const float lr = fminf(p.in[23][(size_t)ig * 64 + n], -1e-4f), li = p.in[24][(size_t)ig * 64 + n];
  const float mag = expf(lr * dt);
  ar = mag * cosf(li * dt); ai = mag * sinf(li * dt);
  const float nr = ar - 1.f, ni = ai; const float den = 1.f / (lr * lr + li * li);
  cr = (nr * lr + ni * li) * den; ci = (ni * lr - nr * li) * den;
}
__device__ __forceinline__ void ph_s5_pass(const P& p, int l, int pass, char* lds, int vb, int nvb) {
  const int tid = get_tid(), lane = tid & 63, wid = tid >> 6, fr = lane & 15, fq = lane >> 4;
  float* ub = (float*)(lds + wid * 16896);
  char* xs = lds + wid * 16896 + 4096;
  float* bu = (float*)(lds + wid * 16896 + 8448);
  const hf* Z = S5_ZH(p); float2* E = S5_E(p); const float2* X = S5_X(p); bf16_t* YG = S5_YG(p);
  const int nw = nvb * 4;
  for (int t = vb * 4 + wid; t < 4 * 132 * 16; t += nw) {
    const int g = t & 15, tc = (t >> 4) % 132, b = t / (16 * 132);
    const int m0 = s5_m0(b, tc);
#pragma unroll
    for (int i = 0; i < 4; ++i) { const int e = lane + i * 64; const int tok = e >> 2, q = e & 3;
      const hf4 zv = *(const hf4*)(Z + (size_t)(m0 + tok) * 256 + g * 16 + q * 4);
      *(float4*)(ub + tok * 16 + q * 4) = make_float4((float)zv[0], (float)zv[1], (float)zv[2], (float)zv[3]); }
    f32x4 yacc[4];
#pragma unroll
    for (int i = 0; i < 4; ++i) yacc[i] = (f32x4){0.f, 0.f, 0.f, 0.f};
    for (int d = 0; d < 2; ++d) {
      const int ig = (l * 2 + d) * 16 + g;
      const float dt = expf(p.in[25][ig]);
      float ar, ai, crn, cin_;
      s5_cf(p, ig, lane, dt, ar, ai, crn, cin_);
      hf8 bfB[8];
#pragma unroll
      for (int q4 = 0; q4 < 4; ++q4) {
        const int n = q4 * 16 + fr;
        float a_r, a_i, cr, ci; s5_cf(p, ig, n, dt, a_r, a_i, cr, ci);
        hf8 re, im;
        if (fq < 2) {
          const float* bre = p.in[26] + ((size_t)ig * 64 + n) * 16 + fq * 8; const float* bim = p.in[27] + ((size_t)ig * 64 + n) * 16 + fq * 8;
          const float4 r0 = *(const float4*)bre, r1 = *(const float4*)(bre + 4), i0 = *(const float4*)bim, i1 = *(const float4*)(bim + 4);
          const float xr[8] = {r0.x, r0.y, r0.z, r0.w, r1.x, r1.y, r1.z, r1.w}, xi[8] = {i0.x, i0.y, i0.z, i0.w, i1.x, i1.y, i1.z, i1.w};
#pragma unroll
          for (int k = 0; k < 8; ++k) { re[k] = (hf)(1024.f * (cr * xr[k] - ci * xi[k])); im[k] = (hf)(1024.f * (cr * xi[k] + ci * xr[k])); }
        } else {
#pragma unroll
          for (int k = 0; k < 8; ++k) { re[k] = (hf)0.f; im[k] = (hf)0.f; }
        }
        bfB[q4] = re; bfB[q4 + 4] = im;
      }
      const int cp = chain_pos(d, tc);
      const size_t sidx = (((size_t)(d * 4 + b) * 132 + cp) * 16 + g) * 64 + lane;
      float xr = 0.f, xi = 0.f;
      hf8 cf[4];
      if (pass == 3) {
        float2 x0 = X[sidx]; xr = x0.x; xi = x0.y;
#pragma unroll
        for (int ks = 0; ks < 4; ++ks) {
          const int c0 = ks * 32 + fq * 8;
          const float* src_ = (c0 < 64 ? p.in[28] : p.in[29]) + ((size_t)ig * 16 + fr) * 64 + (c0 & 63);
          const float sg = c0 < 64 ? 1.f : -1.f;
          const float4 v0 = *(const float4*)src_, v1 = *(const float4*)(src_ + 4);
          cf[ks][0] = (hf)(sg * v0.x); cf[ks][1] = (hf)(sg * v0.y); cf[ks][2] = (hf)(sg * v0.z); cf[ks][3] = (hf)(sg * v0.w);
          cf[ks][4] = (hf)(sg * v1.x); cf[ks][5] = (hf)(sg * v1.y); cf[ks][6] = (hf)(sg * v1.z); cf[ks][7] = (hf)(sg * v1.w);
        }
      }
#pragma unroll 1
      for (int jb = 0; jb < 4; ++jb) {
        const int tb = d ? 3 - jb : jb;
        {
          hf8 au;
          if (fq < 2) {
            const float* up = ub + (tb * 16 + fr) * 16 + fq * 8;
            const float4 u0 = *(const float4*)up, u1 = *(const float4*)(up + 4);
            au[0] = (hf)u0.x; au[1] = (hf)u0.y; au[2] = (hf)u0.z; au[3] = (hf)u0.w; au[4] = (hf)u1.x; au[5] = (hf)u1.y; au[6] = (hf)u1.z; au[7] = (hf)u1.w;
          } else {
#pragma unroll
            for (int k = 0; k < 8; ++k) au[k] = (hf)0.f;
          }
#pragma unroll
          for (int nb = 0; nb < 8; ++nb) {
            f32x4 ab = (f32x4){0.f, 0.f, 0.f, 0.f};
            ab = __builtin_amdgcn_mfma_f32_16x16x32_f16(au, bfB[nb], ab, 0, 0, 0);
#pragma unroll
            for (int j = 0; j < 4; ++j) bu[(fq * 4 + j) * 132 + nb * 16 + fr] = ab[j];
          }
        }
#pragma unroll 4
        for (int jj = 0; jj < 16; ++jj) {
          const int t16 = d ? 15 - jj : jj;
          const float br = bu[t16 * 132 + lane] * 0.0009765625f, bi = bu[t16 * 132 + 64 + lane] * 0.0009765625f;
          const float nr = ar * xr - ai * xi + br, ni = ar * xi + ai * xr + bi;
          xr = nr; xi = ni;
          if (pass == 3) { *(hf*)(xs + t16 * 272 + lane * 2) = (hf)xr; *(hf*)(xs + t16 * 272 + 128 + lane * 2) = (hf)xi; }
        }
        if (pass == 3) {
          f32x4 acc = (f32x4){0.f, 0.f, 0.f, 0.f};
#pragma unroll
          for (int ks = 0; ks < 4; ++ks) {
            const hf8 af = *(const hf8*)(xs + fr * 272 + ks * 64 + fq * 16);
            acc = __builtin_amdgcn_mfma_f32_16x16x32_f16(af, cf[ks], acc, 0, 0, 0);
          }
#pragma unroll
          for (int i = 0; i < 4; ++i) if (i == tb) yacc[i] += acc;
        }
      }
      if (pass == 1) E[sidx] = make_float2(xr, xi);
    }
    if (pass == 3) {
      const float dsk = p.in[30][(size_t)l * 256 + g * 16 + fr];
#pragma unroll
      for (int i = 0; i < 4; ++i)
#pragma unroll
        for (int j = 0; j < 4; ++j) {
          const int tok = i * 16 + fq * 4 + j;
          float y = yacc[i][j] + dsk * ub[tok * 16 + fr];
          const float inner = 0.7978845608028654f * (y + 0.044715f * y * y * y);
          y = 0.5f * y * (1.f + tanhf_(inner));
          YG[(size_t)(m0 + tok) * 256 + g * 16 + fr] = f2bf(y);
        }
    }
  }
}
__device__ __forceinline__ void ph_s5_carry(const P& p, int l, int vb, int nvb) {
  float2* E = S5_E(p); float2* X = S5_X(p);
  for (int t = vb * NTHR + get_tid(); t < 8192; t += nvb * NTHR) {
    const int n = t & 63, g = (t >> 6) & 15, b = (t >> 10) & 3, d = t >> 12;
    const int ig = (l * 2 + d) * 16 + g;
    const float lr = fminf(p.in[23][(size_t)ig * 64 + n], -1e-4f), li = p.in[24][(size_t)ig * 64 + n];
    const float dt = expf(p.in[25][ig]);
    const float mag = expf(lr * dt * 64.f);
    float ar = expf(lr * dt) * cosf(li * dt), ai = expf(lr * dt) * sinf(li * dt);
#pragma unroll
    for (int i = 0; i < 6; ++i) { const float r2 = ar * ar - ai * ai, i2 = 2.f * ar * ai; ar = r2; ai = i2; }
    (void)mag;
    float xr = 0.f, xi = 0.f;
    const size_t base = (((size_t)(d * 4 + b) * 132) * 16 + g) * 64 + n;
    for (int cp0 = 0; cp0 < 132; cp0 += 12) {
      float2 ev[12];
#pragma unroll
      for (int u = 0; u < 12; ++u) ev[u] = E[base + (size_t)(cp0 + u) * 1024];
#pragma unroll
      for (int u = 0; u < 12; ++u) {
        X[base + (size_t)(cp0 + u) * 1024] = make_float2(xr, xi);
        const float nr = ar * xr - ai * xi + ev[u].x, ni = ar * xi + ai * xr + ev[u].y;
        xr = nr; xi = ni;
      }
    }
  }
}
__device__ __forceinline__ void ph_glu(const P& p, int l, char* lds, int vb, int nvb) {
  EPI_VARS
  const bf16_t* YG = S5_YG(p);
  const int Mt = 264;
  const float* gb = p.in[32] + (size_t)l * 256;
  for (int it = 0;; ++it) {
    int tm, tn; if (!tile_map_v(vb, nvb, it, Mt, 2, 2, tm, tn)) break; const int m0 = tm * 128, n0 = tn * 128;
    f32x4 acc[4][4]; ZERO_ACC(acc)
    gemm_main(YG + (size_t)m0 * 256, 256, p.W + W_GLU + (size_t)n0 * 256, 256, 256, acc, lds);
    EPI_BEGIN(m0, n0)
      const float y = bf2f(YG[(size_t)row * 256 + col]);
      p.Y[(size_t)row * 1024 + 384 + col] = f2bf(y * sigmoidf_(val + gb[col]));
    EPI_END
  }
}

__device__ __forceinline__ void sub_barrier(unsigned* cnt, unsigned target) {
  asm volatile("s_waitcnt vmcnt(0)" ::: "memory");
  __syncthreads();
  if (__builtin_amdgcn_workitem_id_x() == 0) {
    __builtin_amdgcn_fence(__ATOMIC_RELEASE, "agent");
    asm volatile("s_waitcnt vmcnt(0)" ::: "memory");
    __hip_atomic_fetch_add(cnt, 1u, __ATOMIC_RELAXED, __HIP_MEMORY_SCOPE_AGENT);
    unsigned sp = 0;
    while (__hip_atomic_load(cnt, __ATOMIC_RELAXED, __HIP_MEMORY_SCOPE_AGENT) < target) { __builtin_amdgcn_s_sleep(2); if (++sp > (1u << 22)) break; }
    __builtin_amdgcn_fence(__ATOMIC_ACQUIRE, "agent");
    asm volatile("s_waitcnt vmcnt(0)" ::: "memory");
  }
  __syncthreads();
}
__device__ __forceinline__ void ph_s5_stage(const P& p, int l, char* lds, int vb, int nvb) {
  unsigned* cnt = p.bar + 3584;
  const unsigned base = (unsigned)(l * 4) * (unsigned)nvb;
  ph_z_s5(p, lds, vb, nvb);            sub_barrier(cnt, base + 1u * nvb);
  ph_s5_pass(p, l, 1, lds, vb, nvb);   sub_barrier(cnt, base + 2u * nvb);
  ph_s5_carry(p, l, vb, nvb);          sub_barrier(cnt, base + 3u * nvb);
  ph_s5_pass(p, l, 3, lds, vb, nvb);   sub_barrier(cnt, base + 4u * nvb);
  ph_glu(p, l, lds, vb, nvb);
}

__device__ __forceinline__ float logsigf_(float x) { return fminf(x, 0.f) - log1pf(__expf(-fabsf(x))); }
__device__ __forceinline__ void ml_gates(const P& p, int l, int d, int h, int m0, int lane, float& bcum, float& ic) {
  const int tok = d ? 63 - lane : lane;
  const float* gl = ML_GL(p) + (size_t)(m0 + tok) * 16;
  const float* gb = p.in[33] + (size_t)(l * 2 + d) * 8;
  ic = gl[d * 8 + h] + gb[h];
  float f = logsigf_(gl[d * 8 + 4 + h] + gb[4 + h]);
#pragma unroll
  for (int o = 1; o < 64; o <<= 1) { float v = __shfl_up(f, o); if (lane >= o) f += v; }
  bcum = f;
}
__device__ __forceinline__ void ml_gates2(const P& p, int l, int d, int h, int m0, int lane, float& bc, float& ic, float& tot) {
  const float* gl = ML_GL(p) + (size_t)(m0 + lane) * 16;
  const float* gb = p.in[33] + (size_t)(l * 2 + d) * 8;
  ic = gl[d * 8 + h] + gb[h];
  const float f0 = logsigf_(gl[d * 8 + 4 + h] + gb[4 + h]);
  float f = f0;
#pragma unroll
  for (int o = 1; o < 64; o <<= 1) { float v = __shfl_up(f, o); if (lane >= o) f += v; }
  tot = __shfl(f, 63);
  bc = d ? (tot - f + f0) : f;
}
#define MLQ 208
#define MLS 144
__device__ __forceinline__ void ph_ml_a(const P& p, int l, char* lds) {
  char* vt = lds; char* kt = lds + 13824; float* wg = (float*)(lds + 27648);
  const int tid = get_tid(), lane = tid & 63, wid = tid >> 6, fr = lane & 15, fq = lane >> 4;
  const hf* QK = ML_QK(p); const hf* Z = ML_Z(p);
  for (int t = blockIdx.x; t < 4224; t += gridDim.x) {
    const int tc = t % 132, h = (t / 132) & 3, b = (t / 528) & 3, d = t / 2112;
    const int m0 = s5_m0(b, tc); const int cp = chain_pos(d, tc);
    const size_t task = ((size_t)((d * 4 + b) * 4 + h)) * 132 + cp;
    if (wid == 0) {
      float bc, ic, tot; ml_gates2(p, l, d, h, m0, lane, bc, ic, tot);
      const float lw = tot - bc + ic;
      float mx = lw;
      for (int o = 32; o > 0; o >>= 1) mx = fmaxf(mx, __shfl_xor(mx, o));
      wg[lane] = __expf(lw - mx);
      if (lane == 0) { ML_SC(p)[task * 2] = mx; ML_SC(p)[task * 2 + 1] = tot; }
    }
    __syncthreads();
    for (int e = tid; e < 64 * 12; e += NTHR) {
      const int tok = e & 63, q = e >> 6;
      const hf8 kv = *(const hf8*)(QK + (size_t)(m0 + tok) * 768 + 384 + h * 96 + q * 8);
      const hf8 vv = *(const hf8*)(Z + (size_t)(m0 + tok) * 1536 + 768 + h * 96 + q * 8);
      const float w = wg[tok];
#pragma unroll
      for (int i = 0; i < 8; ++i) {
        *(hf*)(kt + (q * 8 + i) * MLS + tok * 2) = kv[i];
        *(hf*)(vt + (q * 8 + i) * MLS + tok * 2) = (hf)((float)vv[i] * w);
      }
    }
    __syncthreads();
    float* dc = ML_DC(p) + task * 9216;
#pragma unroll 1
    for (int bi = 0; bi < 9; ++bi) {
      const int idx = wid * 9 + bi; const int mb = idx / 6, nb = idx % 6;
      f32x4 acc = (f32x4){0.f, 0.f, 0.f, 0.f};
#pragma unroll
      for (int ks = 0; ks < 2; ++ks) {
        const hf8 af = *(const hf8*)(vt + (mb * 16 + fr) * MLS + ks * 64 + fq * 16);
        const hf8 bf = *(const hf8*)(kt + (nb * 16 + fr) * MLS + ks * 64 + fq * 16);
        acc = __builtin_amdgcn_mfma_f32_16x16x32_f16(af, bf, acc, 0, 0, 0);
      }
#pragma unroll
      for (int j = 0; j < 4; ++j) dc[(mb * 16 + fq * 4 + j) * 96 + nb * 16 + fr] = acc[j];
    }
    if (tid < 96) {
      float s = 0.f;
      for (int j = 0; j < 64; ++j) s += wg[j] * (float)*(const hf*)(kt + tid * MLS + j * 2);
      ML_DN(p)[task * 96 + tid] = s;
    }
    __syncthreads();
  }
}
__device__ __forceinline__ void ph_ml_b(const P& p) {
  float* DC = ML_DC(p); float* DN = ML_DN(p); const float* SC = ML_SC(p); float* MP = ML_MP(p);
  for (int t = blockIdx.x * NTHR + get_tid(); t < 32 * 9312; t += gridDim.x * NTHR) {
    const int chain = t / 9312, e = t % 9312;
    float cur = 0.f, mprev = 0.f;
    for (int cp0 = 0; cp0 < 132; cp0 += 12) {
      float dl[12], ml_[12], bl_[12];
#pragma unroll
      for (int u = 0; u < 12; ++u) {
        const size_t task = (size_t)chain * 132 + cp0 + u;
        dl[u] = e < 9216 ? DC[task * 9216 + e] : DN[task * 96 + (e - 9216)];
        ml_[u] = SC[task * 2]; bl_[u] = SC[task * 2 + 1];
      }
#pragma unroll
      for (int u = 0; u < 12; ++u) {
        const size_t task = (size_t)chain * 132 + cp0 + u;
        float* slot = e < 9216 ? DC + task * 9216 + e : DN + task * 96 + (e - 9216);
        *slot = cur;
        if (e == 0) MP[task] = mprev;
        const float mnew = fmaxf(bl_[u] + mprev, ml_[u]);
        cur = __expf(bl_[u] + mprev - mnew) * cur + __expf(ml_[u] - mnew) * dl[u];
        mprev = mnew;
      }
    }
  }
}
__device__ __forceinline__ void ph_ml_c(const P& p, int l, char* lds) {
  char* qs = lds; char* ks = lds + 13312; char* vt = lds + 26624; char* cs = lds + 40448; char* ps = lds + 60416;
  float* fl = (float*)(lds + 69632);
  float* bc = fl; float* icv = fl + 128; float* mr = fl + 256; float* inter = fl + 320; float* den = fl + 384; float* nq = fl + 448; float* nst = fl + 512;
  const int tid = get_tid(), lane = tid & 63, wid = tid >> 6, fr = lane & 15, fq = lane >> 4;
  const hf* QK = ML_QK(p); const hf* Z = ML_Z(p);
  const int ntc = (l == 1) ? 128 : 132;
  for (int t = blockIdx.x; t < 16 * ntc; t += gridDim.x) {
    const int tc = t % ntc, h = (t / ntc) & 3, b = t / (4 * ntc);
    const int m0 = s5_m0(b, tc);
    for (int e = tid; e < 64 * 12; e += NTHR) {
      const int tok = e & 63, q = e >> 6;
      *(hf8*)(qs + tok * MLQ + q * 16) = *(const hf8*)(QK + (size_t)(m0 + tok) * 768 + h * 96 + q * 8);
      *(hf8*)(ks + tok * MLQ + q * 16) = *(const hf8*)(QK + (size_t)(m0 + tok) * 768 + 384 + h * 96 + q * 8);
      const hf8 vv = *(const hf8*)(Z + (size_t)(m0 + tok) * 1536 + 768 + h * 96 + q * 8);
#pragma unroll
      for (int i = 0; i < 8; ++i) *(hf*)(vt + (q * 8 + i) * MLS + tok * 2) = vv[i];
    }
    if (wid < 2) { float bcv, ic, tot; ml_gates2(p, l, wid, h, m0, lane, bcv, ic, tot); bc[wid * 64 + lane] = bcv; icv[wid * 64 + lane] = ic; }
    f32x4 hs[6];
#pragma unroll
    for (int n = 0; n < 6; ++n) hs[n] = (f32x4){0.f, 0.f, 0.f, 0.f};
    for (int d = 0; d < 2; ++d) {
      const int cp = chain_pos(d, tc);
      const size_t task = ((size_t)((d * 4 + b) * 4 + h)) * 132 + cp;
      const float mprev = ML_MP(p)[task];
      __syncthreads();
      {
        const float* cg = ML_DC(p) + task * 9216;
        for (int e = tid; e < 96 * 24; e += NTHR) {
          const int v = e / 24, q = e % 24;
          const float4 c4 = *(const float4*)(cg + v * 96 + q * 4);
          hf4 o; o[0] = (hf)c4.x; o[1] = (hf)c4.y; o[2] = (hf)c4.z; o[3] = (hf)c4.w;
          *(hf4*)(cs + v * MLQ + q * 8) = o;
        }
        if (tid < 96) nst[tid] = ML_DN(p)[task * 96 + tid];
      }
      const float* bcd = bc + d * 64; const float* icd = icv + d * 64;
      if (tid < 64) {
        const int j = tid; const float bj = bcd[j];
        float mx = bj + mprev;
        if (d == 0) { for (int s = 0; s <= j; ++s) mx = fmaxf(mx, bj - bcd[s] + icd[s]); }
        else { for (int s = j; s < 64; ++s) mx = fmaxf(mx, bj - bcd[s] + icd[s]); }
        mr[j] = mx; inter[j] = __expf(bj + mprev - mx);
      }
      __syncthreads();
      if (tid < 64) {
        float s1 = 0.f;
        for (int k = 0; k < 96; ++k) s1 += nst[k] * (float)*(const hf*)(qs + tid * MLQ + k * 2);
        nq[tid] = s1;
      }
      {
        f32x4 sacc[4];
#pragma unroll
        for (int n = 0; n < 4; ++n) sacc[n] = (f32x4){0.f, 0.f, 0.f, 0.f};
#pragma unroll
        for (int kk = 0; kk < 3; ++kk) {
          const hf8 af = *(const hf8*)(qs + (wid * 16 + fr) * MLQ + kk * 64 + fq * 16);
#pragma unroll
          for (int n = 0; n < 4; ++n) {
            const hf8 bf = *(const hf8*)(ks + (n * 16 + fr) * MLQ + kk * 64 + fq * 16);
            sacc[n] = __builtin_amdgcn_mfma_f32_16x16x32_f16(af, bf, sacc[n], 0, 0, 0);
          }
        }
        float rs[4] = {0.f, 0.f, 0.f, 0.f};
#pragma unroll
        for (int n = 0; n < 4; ++n) {
          const int s = n * 16 + fr; const float bs = bcd[s] - icd[s];
#pragma unroll
          for (int jj = 0; jj < 4; ++jj) {
            const int j = wid * 16 + fq * 4 + jj;
            const bool valid = d == 0 ? (s <= j) : (s >= j);
            const float val = valid ? sacc[n][jj] * __expf(bcd[j] - bs - mr[j]) : 0.f;
            rs[jj] += val;
            *(hf*)(ps + j * MLS + s * 2) = (hf)val;
          }
        }
        __syncthreads();
#pragma unroll
        for (int jj = 0; jj < 4; ++jj) {
          const float r = rowsum16(rs[jj]);
          const int j = wid * 16 + fq * 4 + jj;
          if (fr == 0) den[j] = inter[j] * nq[j] + r;
        }
      }
      f32x4 acc[6];
#pragma unroll
      for (int n = 0; n < 6; ++n) acc[n] = (f32x4){0.f, 0.f, 0.f, 0.f};
#pragma unroll
      for (int kk = 0; kk < 3; ++kk) {
        const hf8 af = *(const hf8*)(qs + (wid * 16 + fr) * MLQ + kk * 64 + fq * 16);
#pragma unroll
        for (int n = 0; n < 6; ++n) {
          const hf8 bf = *(const hf8*)(cs + (n * 16 + fr) * MLQ + kk * 64 + fq * 16);
          acc[n] = __builtin_amdgcn_mfma_f32_16x16x32_f16(af, bf, acc[n], 0, 0, 0);
        }
      }
#pragma unroll
      for (int jj = 0; jj < 4; ++jj) { const float it = inter[wid * 16 + fq * 4 + jj];
#pragma unroll
        for (int n = 0; n < 6; ++n) acc[n][jj] *= it; }
#pragma unroll
      for (int kk = 0; kk < 2; ++kk) {
        const hf8 af = *(const hf8*)(ps + (wid * 16 + fr) * MLS + kk * 64 + fq * 16);
#pragma unroll
        for (int n = 0; n < 6; ++n) {
          const hf8 bf = *(const hf8*)(vt + (n * 16 + fr) * MLS + kk * 64 + fq * 16);
          acc[n] = __builtin_amdgcn_mfma_f32_16x16x32_f16(af, bf, acc[n], 0, 0, 0);
        }
      }
      __syncthreads();
#pragma unroll
      for (int jj = 0; jj < 4; ++jj) {
        const int j = wid * 16 + fq * 4 + jj;
        const float dn = 1.f / fmaxf(fabsf(den[j]), __expf(-mr[j]));
#pragma unroll
        for (int n = 0; n < 6; ++n) hs[n][jj] += acc[n][jj] * dn;
      }
    }
#pragma unroll
    for (int jj = 0; jj < 4; ++jj) {
      const int m = m0 + wid * 16 + fq * 4 + jj;
      const hf* op = Z + (size_t)m * 1536 + 1152 + h * 96 + fr;
      float x[6]; float s = 0.f;
#pragma unroll
      for (int n = 0; n < 6; ++n) { x[n] = sigmoidf_((float)op[n * 16]) * hs[n][jj]; s += x[n]; }
      s = rowsum16(s);
      const float mean = s * (1.f / 96.f);
      float q = 0.f;
#pragma unroll
      for (int n = 0; n < 6; ++n) { x[n] -= mean; q += x[n] * x[n]; }
      q = rowsum16(q);
      const float rsd = rsqrtf(q * (1.f / 96.f) + 1e-5f);
      const float* ng = p.in[34] + (size_t)l * 384 + h * 96 + fr;
      bf16_t* yp = p.Y + (size_t)m * 1024 + 640 + h * 96 + fr;
#pragma unroll
      for (int n = 0; n < 6; ++n) yp[n * 16] = f2bf(x[n] * rsd * ng[n * 16]);
    }
    __syncthreads();
  }
}

#define MG_YM(p) ((bf16_t*)(p).R)
#define MG_G3(p) (MG_YM(p) + (size_t)M_ALL * 1024)
__device__ __forceinline__ void ph_gates(const P& p, int l, int Mt, char* lds) {
  EPI_VARS
  bf16_t* G3 = MG_G3(p);
  const float* gbias = p.in[38] + (size_t)l * 3072;
  STREAM_BEGIN_T(Mt, 24, 8, (p.U + (size_t)(tm * 128) * 1024), (p.W + W_IN + (size_t)(3216 + tn * 128) * 1024), 1024, 1024, 1024)
    const int m0 = tm * 128, n0 = tn * 128;
#pragma unroll
    for (int m = 0; m < 4; ++m) {
      bf16_t* gp3 = G3 + (size_t)(m0 + wr * 64 + m * 16 + fr) * 3072 + n0 + wc * 64 + fq * 4;
#pragma unroll
      for (int n = 0; n < 4; ++n) {
        const float4 b4 = *(const float4*)(gbias + n0 + wc * 64 + n * 16 + fq * 4);
        const unsigned lo = (unsigned)f2bf(sigmoidf_(acc[m][n][0] + b4.x)) | ((unsigned)f2bf(sigmoidf_(acc[m][n][1] + b4.y)) << 16);
        const unsigned hi = (unsigned)f2bf(sigmoidf_(acc[m][n][2] + b4.z)) | ((unsigned)f2bf(sigmoidf_(acc[m][n][3] + b4.w)) << 16);
        *(uint2*)(gp3 + n * 16) = make_uint2(lo, hi);
      }
    }
  STREAM_END
}
__device__ __forceinline__ void ph_merge(const P& p, int l, int Mt, char* lds) {
  EPI_VARS
  bf16_t* YM = MG_YM(p); const bf16_t* G3 = MG_G3(p);
  const int ntile = Mt * 16;
  for (int it = 0;; ++it) {
    int tm, tn; if (!tile_map(it, Mt, 16, 8, tm, tn)) break; const int m0 = tm * 128, n0 = tn * 64;
    f32x4 yacc[4][2];
#pragma unroll
    for (int m = 0; m < 4; ++m) { yacc[m][0] = (f32x4){0.f, 0.f, 0.f, 0.f}; yacc[m][1] = (f32x4){0.f, 0.f, 0.f, 0.f}; }
#pragma unroll 1
    for (int br = 0; br < 3; ++br) {
      f32x4 acc[4][2];
#pragma unroll
      for (int m = 0; m < 4; ++m) { acc[m][0] = (f32x4){0.f, 0.f, 0.f, 0.f}; acc[m][1] = (f32x4){0.f, 0.f, 0.f, 0.f}; }
      const int kb = br == 1 ? 256 : 384; const int yoff = br == 0 ? 0 : (br == 1 ? 384 : 640);
      const int woff = br == 0 ? W_UPRW : (br == 1 ? W_UPS5 : W_UPML);
      gemm_main_t<2>(p.Y + (size_t)m0 * 1024 + yoff, 1024, p.W + woff + (size_t)n0 * kb, kb, kb, acc, lds);
      EPI_ROW_BEGIN(m0)
        const bf16_t* gp = G3 + (size_t)row * 3072 + br * 1024 + n0 + wc * 32 + fr;
#pragma unroll
        for (int n = 0; n < 2; ++n) yacc[m][n][j] += bf2f(gp[n * 16]) * acc[m][n][j];
      EPI_ROW_END
    }
    EPI_ROW_BEGIN(m0)
      bf16_t* yp = YM + (size_t)row * 1024 + n0 + wc * 32 + fr;
#pragma unroll
      for (int n = 0; n < 2; ++n) yp[n * 16] = f2bf(yacc[m][n][j]);
    EPI_ROW_END
  }
}
__device__ __forceinline__ void ph_wout(const P& p, int l, int Mt, char* lds) {
  EPI_VARS
  const bf16_t* YM = (const bf16_t*)p.R;
  STREAM_BEGIN_T(Mt, 8, 8, (YM + (size_t)(tm * 128) * 1024), (p.W + W_OUT + (size_t)(tn * 128) * 1024), 1024, 1024, 1024)
    const int m0 = tm * 128, n0 = tn * 128;
#pragma unroll
    for (int m = 0; m < 4; ++m) {
      const int row = m0 + wr * 64 + m * 16 + fr;
      float* sp = srow(p, row) + n0 + wc * 64 + fq * 4; const float* gp = modp(p, l, row, 5) + n0 + wc * 64 + fq * 4;
#pragma unroll
      for (int n = 0; n < 4; ++n) {
        float4 s4 = *(const float4*)(sp + n * 16); const float4 g4 = *(const float4*)(gp + n * 16);
        s4.x = ALPHA * s4.x + g4.x * acc[m][n][0]; s4.y = ALPHA * s4.y + g4.y * acc[m][n][1];
        s4.z = ALPHA * s4.z + g4.z * acc[m][n][2]; s4.w = ALPHA * s4.w + g4.w * acc[m][n][3];
        *(float4*)(sp + n * 16) = s4;
      }
    }
  STREAM_END
}

#define XB_TMO      128
#define XB_XCNT(j)  (256  + 64 * (j))
#define XB_XSUB(j)  (1280 + 64 * (j))
#define XB_XGEN(j)  (2304 + 64 * (j))
#define XB_TOP      3328
#define XB_TOPGEN   3392
#define XCD_BAR_WORDS 3456
#define XB_SPIN_CAP (1u << 18)
#define LAS __attribute__((address_space(3)))

__device__ __forceinline__ unsigned xb_ld(unsigned* p)              { return __hip_atomic_load(p, __ATOMIC_RELAXED, __HIP_MEMORY_SCOPE_AGENT); }
__device__ __forceinline__ unsigned xb_add(unsigned* p, unsigned v) { return __hip_atomic_fetch_add(p, v, __ATOMIC_RELAXED, __HIP_MEMORY_SCOPE_AGENT); }
__device__ __forceinline__ unsigned xb_xcc_id() { return (unsigned)__builtin_amdgcn_s_getreg((3 << 11) | 20) & 0xFu; }
#define XB_SPIN(cond, bar) do { unsigned _sp = 0; while (cond) { __builtin_amdgcn_s_sleep(1); \
    if ((++_sp & 255u) == 0u) { if (xb_ld(&(bar)[XB_TMO])) break; if (_sp > XB_SPIN_CAP) { atomicAdd(&(bar)[XB_TMO], 1u); break; } } } } while (0)

struct XcdBarrier {
    unsigned* bar; unsigned x;
    volatile LAS unsigned* st;
};

__device__ __forceinline__ XcdBarrier xcd_barrier_post(unsigned* bar, volatile LAS unsigned* st) {
    XcdBarrier b; b.bar = bar; b.x = xb_xcc_id(); b.st = st;
    if (__builtin_amdgcn_workitem_id_x() == 0) (void)xb_add(&bar[XB_XCNT(b.x)], 1u);
    return b;
}
__device__ __forceinline__ void xcd_barrier_complete(unsigned* bar, unsigned x, unsigned& nloc, unsigned& nx) {
    const unsigned G = gridDim.x * gridDim.y * gridDim.z;
    unsigned sum, cnt, mine, sp = 0u;
    for (;;) {
        sum = 0u; cnt = 0u; mine = 0u;
#pragma unroll
        for (unsigned j = 0; j < 16; ++j) { const unsigned c = xb_ld(&bar[XB_XCNT(j)]); sum += c; cnt += (c > 0u) ? 1u : 0u; mine = (j == x) ? c : mine; }
        if (sum == G) break;
        __builtin_amdgcn_s_sleep(1);
        if ((++sp & 255u) == 0u) { if (xb_ld(&bar[XB_TMO])) break; if (sp > XB_SPIN_CAP) { atomicAdd(&bar[XB_TMO], 1u); break; } }
    }
    nloc = mine > 0u ? mine : 1u; nx = cnt > 0u ? cnt : 1u;
}

__device__ __forceinline__ void xcd_barrier(const XcdBarrier& b) {
    asm volatile("s_waitcnt vmcnt(0)" ::: "memory");
    __syncthreads();
    if (__builtin_amdgcn_workitem_id_x() == 0) {
        unsigned* bar = b.bar;
        __builtin_amdgcn_s_waitcnt(0);
        unsigned nloc = b.st[0], nx = b.st[1];
        if (nloc == 0u) { xcd_barrier_complete(bar, b.x, nloc, nx); b.st[0] = nloc; b.st[1] = nx; }
        const unsigned old = xb_add(&bar[XB_XSUB(b.x)], 1u);
        const unsigned gen = old / nloc;
        if (old + 1u == (gen + 1u) * nloc) {
            __builtin_amdgcn_fence(__ATOMIC_RELEASE, "agent");
            asm volatile("s_waitcnt vmcnt(0)" ::: "memory");
            const unsigned og = xb_add(&bar[XB_TOP], 1u);
            const unsigned tg = og / nx;
            if (og + 1u == (tg + 1u) * nx) xb_add(&bar[XB_TOPGEN], 1u);
            else XB_SPIN(xb_ld(&bar[XB_TOPGEN]) == tg, bar);
            __builtin_amdgcn_fence(__ATOMIC_ACQUIRE, "agent");
            xb_add(&bar[XB_XGEN(b.x)], 1u);
            asm volatile("s_waitcnt vmcnt(0)" ::: "memory");
        } else {
            XB_SPIN(xb_ld(&bar[XB_XGEN(b.x)]) == gen, bar);
            __builtin_amdgcn_fence(__ATOMIC_ACQUIRE, "agent");
            asm volatile("s_waitcnt vmcnt(0)" ::: "memory");
        }
    }
    __syncthreads();
}


#define SYNC xcd_barrier(xb); asm volatile("" : "+s"(l));
__global__ void __launch_bounds__(NTHR, 2) mega(P pv) {
#define p pv
  __shared__ __attribute__((aligned(16))) char lds[LDS_BYTES];
  __shared__ uint4 xb_words;
  cg::grid_group grid = cg::this_grid();
  {
    const int t0 = __builtin_amdgcn_workitem_id_x();
    if (blockIdx.x == 0) for (int i = t0; i < 4096; i += NTHR) pv.bar[i] = 0u;
    if (t0 == 0) xb_words = make_uint4(0u, 0u, 0u, 0u);
    __threadfence();
    grid.sync();
  }
  XcdBarrier xb = xcd_barrier_post(pv.bar, (volatile LAS unsigned*)&xb_words);
  for (int l = 0; l < 2; ++l) {
    const bool last = (l == 1);
    const int Mt2 = last ? 256 : 264;
    const int Mr2 = last ? M_LAT : M_ALL;
    ph_convert(p, l, l == 0, lds); SYNC
    if (l == 0) { ph_rows(p, 0, 0, 0, M_ALL, true, 0, 0); SYNC }
    ph_ffn_up(p, 0, 264, lds); SYNC
    ph_ffn_down(p, l, 0, 264, lds); SYNC
    ph_rows(p, 1, l, 0, M_ALL, true, l, 3); SYNC
    ph_z_rw(p, lds); SYNC
    ph_conv<0>(p, l); SYNC
    ph_lora(p, l, lds); SYNC
    {
      const int ns = gridDim.x >= 384 ? 192 : 0;
      if (ns == 0 || blockIdx.x < 192) ph_rwscan(p, lds);
      if (ns == 0) { SYNC }
      if ((int)blockIdx.x >= ns) ph_s5_stage(p, l, lds, (int)blockIdx.x - ns, (int)gridDim.x - ns);
      SYNC
    }
    ph_rwpost(p, l); SYNC
    ph_z_ml(p, lds); SYNC
    ph_conv<1>(p, l); SYNC
    ph_ml_a(p, l, lds); SYNC
    ph_ml_b(p); SYNC
    ph_ml_c(p, l, lds); SYNC
    ph_gates(p, l, Mt2, lds); SYNC
    ph_merge(p, l, Mt2, lds); SYNC
    ph_wout(p, l, Mt2, lds); SYNC
    ph_rows(p, 1, l, 1, Mr2, true, l, 6); SYNC
    ph_ffn_up(p, 1, Mt2, lds); SYNC
    ph_ffn_down(p, l, 1, Mt2, lds); SYNC
    ph_rows(p, 1, l, 2, Mr2, !last, l + 1, 0);
  }
#undef p
}

extern "C" void kernel_launch(void* const* d_in, const int* in_sizes, int n_in, void* d_out, int out_size, void* d_ws, size_t ws_size,
                              hipStream_t stream) {
  static int grid_blocks = 0;
  if (!grid_blocks) {
    int dev = 0, cus = 0, per_cu = 0;
    hipGetDevice(&dev);
    hipDeviceGetAttribute(&cus, hipDeviceAttributeMultiprocessorCount, dev);
    hipOccupancyMaxActiveBlocksPerMultiprocessor(&per_cu, mega, NTHR, 0);
    if (per_cu > 2) per_cu = 2;
    grid_blocks = cus * per_cu;
  }
  P p{};
  for (int i = 0; i < 40; ++i) p.in[i] = (const float*)d_in[i];
  char* ws = (char*)d_ws;
  size_t off = 0;
  p.W = (bf16_t*)(ws + off); off += (size_t)W_TOTAL * 2;
  p.mod = (float*)(ws + off); off += (size_t)2 * 5 * 9216 * 4;
  p.sctx = (float*)(ws + off); off += (size_t)1024 * 1024 * 4;
  p.bar = (unsigned*)(ws + off); off += (size_t)16384;
  p.U = (bf16_t*)(ws + off); off += (size_t)M_ALL * 1024 * 2;
  p.Y = (bf16_t*)(ws + off); off += (size_t)M_ALL * 1024 * 2;
  p.R = ws + off;
  p.out = (float*)d_out;
  if (off + (size_t)M_ALL * 9728 > ws_size) fprintf(stderr, "workspace too small: need %zu have %zu\n", off + (size_t)M_ALL * 9728, ws_size);
  void* args[] = {&p};
  hipError_t e = hipLaunchCooperativeKernel((void*)mega, dim3(grid_blocks), dim3(NTHR), args, 0, stream);
  if (e != hipSuccess) fprintf(stderr, "cooperative launch failed: %s (grid %d)\n", hipGetErrorString(e), grid_blocks);
}
```

```cpp
#include <hip/hip_runtime.h>
#include <hip/hip_cooperative_groups.h>
#include <cstdio>
namespace cg = cooperative_groups;

typedef unsigned short bf16_t;
typedef _Float16 hf;
typedef hf hf4 __attribute__((ext_vector_type(4)));
typedef hf hf8 __attribute__((ext_vector_type(8)));
typedef __attribute__((ext_vector_type(8))) short bf16x8;
typedef __attribute__((ext_vector_type(4))) float f32x4;
typedef unsigned int u32x4 __attribute__((ext_vector_type(4)));

#define M_LAT 32768
#define M_ALL 33792
#define NTHR 256
#define LDS_BYTES 73728
#define ALPHA 1.41421356237f

#define W_GU0 0
#define W_D0 5767168
#define W_GU1 8650752
#define W_D1 14417920
#define W_IN 17301504
#define W_WUP0 23740416
#define W_WUP1 23764992
#define W_AUP0 23789568
#define W_AUP1 23814144
#define W_GUP 23838720
#define W_GLU 23887872
#define W_UPRW 23953408
#define W_UPS5 24346624
#define W_UPML 24608768
#define W_OUT 25001984
#define W_TOTAL 26050560

struct P {
  const float* in[40];
  float* out; float* sctx; float* mod;
  bf16_t* U; bf16_t* Y; bf16_t* W; char* R; unsigned* bar;
};

__device__ __forceinline__ int get_tid() { int t = __builtin_amdgcn_workitem_id_x(); asm volatile("" : "+v"(t)); return t; }
__device__ __forceinline__ bf16_t f2bf(float f) { return __builtin_bit_cast(unsigned short, (_Float16)f); }
__device__ __forceinline__ float bf2f(bf16_t h) { return (float)__builtin_bit_cast(_Float16, h); }
__device__ __forceinline__ float sigmoidf_(float x) { return __builtin_amdgcn_rcpf(1.f + __expf(-x)); }
__device__ __forceinline__ float tanhf_(float x) { return 1.f - 2.f * __builtin_amdgcn_rcpf(1.f + __expf(2.f * x)); }
__device__ __forceinline__ float siluf_(float x) { return x * __builtin_amdgcn_rcpf(1.f + __expf(-x)); }
__device__ __forceinline__ float* srow(const P& p, int m) { return m < M_LAT ? p.out + (size_t)m * 1024 : p.sctx + (size_t)(m - M_LAT) * 1024; }
__device__ __forceinline__ const float* modp(const P& p, int l, int m, int k) { int mv = m < M_LAT ? (m >> 13) : 4; return p.mod + (size_t)(l * 5 + mv) * 9216 + k * 1024; }
template <int C> __device__ __forceinline__ float dppf(float x) { return __int_as_float(__builtin_amdgcn_update_dpp(0, __float_as_int(x), C, 0xf, 0xf, false)); }
__device__ __forceinline__ float rowsum16(float x) { x += dppf<0x128>(x); x += dppf<0x124>(x); x += dppf<0x122>(x); x += dppf<0x121>(x); return x; }
__device__ __forceinline__ float wavesum(float x) { for (int o = 32; o > 0; o >>= 1) x += __shfl_xor(x, o); return x; }

template <int NB>
__device__ __forceinline__ void gemm_main_t(const bf16_t* __restrict__ A, int lda, const bf16_t* __restrict__ B, int ldb, int K,
                                          f32x4 (&acc)[4][NB], char* lds) {
  const int tid = get_tid(), lane = tid & 63, wid = tid >> 6, wr = wid >> 1, wc = wid & 1;
  const int fr = lane & 15, fq = lane >> 4;
  const int sr = tid >> 3, skc = tid & 7;
  const bf16_t* ga = A + (size_t)sr * lda + skc * 8;
  const bf16_t* gb = B + (size_t)sr * ldb + skc * 8;
  u32x4 ra0[4], rb0[NB], ra1[4], rb1[NB];
  const int soff = sr * 144 + skc * 16;
  const int nk = K >> 6;
  const int aoff = (wr * 64 + fr) * 144 + fq * 16;
  const int boff = 18432 + (wc * (NB * 16) + fr) * 144 + fq * 16;
#define G_LOAD(RA, RB, kt) { _Pragma("unroll") for (int i = 0; i < 4; ++i) { RA[i] = *(const u32x4*)(ga + (size_t)(i * 32) * lda + (kt) * 64); if (i < NB) RB[i] = *(const u32x4*)(gb + (size_t)(i * 32) * ldb + (kt) * 64); } }
#define G_STORE(RA, RB, buf) { char* d_ = lds + (buf) * 36864 + soff; _Pragma("unroll") for (int i = 0; i < 4; ++i) { *(u32x4*)(d_ + i * 32 * 144) = RA[i]; if (i < NB) *(u32x4*)(d_ + 18432 + i * 32 * 144) = RB[i]; } }
#define G_COMP(buf) { const char* cur = lds + (buf) * 36864; _Pragma("unroll") for (int ks = 0; ks < 2; ++ks) { hf8 af[4], bfr[NB]; \
    _Pragma("unroll") for (int m = 0; m < 4; ++m) af[m] = *(const hf8*)(cur + aoff + m * 16 * 144 + ks * 64); \
    _Pragma("unroll") for (int n = 0; n < NB; ++n) bfr[n] = *(const hf8*)(cur + boff + n * 16 * 144 + ks * 64); \
    _Pragma("unroll") for (int m = 0; m < 4; ++m) _Pragma("unroll") for (int n = 0; n < NB; ++n) acc[m][n] = __builtin_amdgcn_mfma_f32_16x16x32_f16(af[m], bfr[n], acc[m][n], 0, 0, 0); } }
  G_LOAD(ra0, rb0, 0)
  { const int k1 = nk > 1 ? 1 : 0; G_LOAD(ra1, rb1, k1) }
  G_STORE(ra0, rb0, 0)
  __syncthreads();
  for (int kt = 0; kt < nk; kt += 2) {
    { const int k2 = kt + 2 < nk ? kt + 2 : nk - 1; G_LOAD(ra0, rb0, k2) }
    G_COMP(0)
    G_STORE(ra1, rb1, 1)
    __syncthreads();
    { const int k3 = kt + 3 < nk ? kt + 3 : nk - 1; G_LOAD(ra1, rb1, k3) }
    if (kt + 1 < nk) G_COMP(1)
    G_STORE(ra0, rb0, 0)
    __syncthreads();
  }
}
#define G_COMPS(buf) { const char* cur = lds + (buf) * 36864; _Pragma("unroll") for (int ks = 0; ks < 2; ++ks) { hf8 af[4], bfr[4]; \
    _Pragma("unroll") for (int m = 0; m < 4; ++m) af[m] = *(const hf8*)(cur + aoff + m * 16 * 144 + ks * 64); \
    _Pragma("unroll") for (int n = 0; n < 4; ++n) bfr[n] = *(const hf8*)(cur + boff + n * 16 * 144 + ks * 64); \
    _Pragma("unroll") for (int m = 0; m < 4; ++m) _Pragma("unroll") for (int n = 0; n < 4; ++n) \
      acc[m][n] = SW ? __builtin_amdgcn_mfma_f32_16x16x32_f16(bfr[n], af[m], acc[m][n], 0, 0, 0) : __builtin_amdgcn_mfma_f32_16x16x32_f16(af[m], bfr[n], acc[m][n], 0, 0, 0); } }
template <bool SW>
__device__ __forceinline__ void gemm_stream(const bf16_t* __restrict__ A, int lda, const bf16_t* __restrict__ B, int ldb, int K,
                                            const bf16_t* __restrict__ An, const bf16_t* __restrict__ Bn, bool first,
                                            f32x4 (&acc)[4][4], char* lds, u32x4 (&ra1)[4], u32x4 (&rb1)[4]) {
  constexpr int NB = 4;
  const int tid = get_tid(), lane = tid & 63, wid = tid >> 6, wr = wid >> 1, wc = wid & 1;
  const int fr = lane & 15, fq = lane >> 4;
  const int sr = tid >> 3, skc = tid & 7;
  const bf16_t* ga = A + (size_t)sr * lda + skc * 8;
  const bf16_t* gb = B + (size_t)sr * ldb + skc * 8;
  const bf16_t* gan = An + (size_t)sr * lda + skc * 8;
  const bf16_t* gbn = Bn + (size_t)sr * ldb + skc * 8;
  u32x4 ra0[4], rb0[NB];
  const int soff = sr * 144 + skc * 16;
  const int nk = K >> 6;
  const int aoff = (wr * 64 + fr) * 144 + fq * 16;
  const int boff = 18432 + (wc * (NB * 16) + fr) * 144 + fq * 16;
#define GS_LOAD(RA, RB, pa, pb, kt) { _Pragma("unroll") for (int i = 0; i < 4; ++i) { RA[i] = *(const u32x4*)((pa) + (size_t)(i * 32) * lda + (kt) * 64); RB[i] = *(const u32x4*)((pb) + (size_t)(i * 32) * ldb + (kt) * 64); } }
  if (first) {
    GS_LOAD(ra0, rb0, ga, gb, 0)
    GS_LOAD(ra1, rb1, ga, gb, 1)
    G_STORE(ra0, rb0, 0)
    __syncthreads();
  }
  for (int kt = 0; kt < nk; kt += 2) {
    if (kt + 2 < nk) { GS_LOAD(ra0, rb0, ga, gb, kt + 2) } else { GS_LOAD(ra0, rb0, gan, gbn, 0) }
    G_COMPS(0)
    G_STORE(ra1, rb1, 1)
    __syncthreads();
    if (kt + 3 < nk) { GS_LOAD(ra1, rb1, ga, gb, kt + 3) } else { GS_LOAD(ra1, rb1, gan, gbn, 1) }
    G_COMPS(1)
    G_STORE(ra0, rb0, 0)
    __syncthreads();
  }
}
__device__ __forceinline__ void gemm_main(const bf16_t* __restrict__ A, int lda, const bf16_t* __restrict__ B, int ldb, int K, f32x4 (&acc)[4][4], char* lds) {
  gemm_main_t<4>(A, lda, B, ldb, K, acc, lds);
}
template <int KT>
__device__ __forceinline__ void gemm_small_t(const bf16_t* __restrict__ A, int lda, const bf16_t* __restrict__ B, int ldb, f32x4 (&acc)[4][4], char* lds) {
  const int tid = get_tid(), lane = tid & 63, wid = tid >> 6, wr = wid >> 1, wc = wid & 1;
  const int fr = lane & 15, fq = lane >> 4;
  const int sr = tid >> 3, skc = tid & 7;
  const bf16_t* ga = A + (size_t)sr * lda + skc * 8;
  const bf16_t* gb = B + (size_t)sr * ldb + skc * 8;
  const int soff = sr * 144 + skc * 16;
  const int aoff = (wr * 64 + fr) * 144 + fq * 16;
  const int boff = 18432 + (wc * 64 + fr) * 144 + fq * 16;
  u32x4 ra[KT][4], rb[KT][4];
#pragma unroll
  for (int kt = 0; kt < KT; ++kt)
#pragma unroll
    for (int i = 0; i < 4; ++i) { ra[kt][i] = *(const u32x4*)(ga + (size_t)(i * 32) * lda + kt * 64); rb[kt][i] = *(const u32x4*)(gb + (size_t)(i * 32) * ldb + kt * 64); }
#pragma unroll
  for (int kt = 0; kt < KT; ++kt)
#pragma unroll
    for (int i = 0; i < 4; ++i) { *(u32x4*)(lds + kt * 36864 + soff + i * 32 * 144) = ra[kt][i]; *(u32x4*)(lds + kt * 36864 + 18432 + soff + i * 32 * 144) = rb[kt][i]; }
  __syncthreads();
#pragma unroll
  for (int kt = 0; kt < KT; ++kt) {
    const char* cur = lds + kt * 36864;
#pragma unroll
    for (int ks = 0; ks < 2; ++ks) {
      hf8 af[4], bfr[4];
#pragma unroll
      for (int m = 0; m < 4; ++m) af[m] = *(const hf8*)(cur + aoff + m * 16 * 144 + ks * 64);
#pragma unroll
      for (int n = 0; n < 4; ++n) bfr[n] = *(const hf8*)(cur + boff + n * 16 * 144 + ks * 64);
#pragma unroll
      for (int m = 0; m < 4; ++m)
#pragma unroll
        for (int n = 0; n < 4; ++n) acc[m][n] = __builtin_amdgcn_mfma_f32_16x16x32_f16(bfr[n], af[m], acc[m][n], 0, 0, 0);
    }
  }
  __syncthreads();
}

template <int SM>
__device__ __forceinline__ bool tile_map_sm(int b, int nb, int it, int Mt, int Nt, int SN, int& tm, int& tn) {
  const int xcd = b & 7, li = b >> 3, nloc = nb >> 3;
  const int T = SM * SN; const int nsn = Nt / SN; const int nsuper = (Mt / SM) * nsn;
  const int o = li + it * nloc; const int k = o / T, w = o - k * T;
  const int s = xcd + 8 * k;
  if (s >= nsuper) return false;
  const int sm = s / nsn, sn = s - sm * nsn;
  tm = sm * SM + (w % SM); tn = sn * SN + (w / SM);
  return true;
}
__device__ __forceinline__ bool tile_map_v(int b, int nb, int it, int Mt, int Nt, int SN, int& tm, int& tn) {
  const int nsn = Nt / SN;
  if (nsn * (Mt >> 3) % 8 == 0 || nsn >= 8) return tile_map_sm<8>(b, nb, it, Mt, Nt, SN, tm, tn);
  return tile_map_sm<1>(b, nb, it, Mt, Nt, SN, tm, tn);
}
__device__ __forceinline__ bool tile_map(int it, int Mt, int Nt, int SN, int& tm, int& tn) { return tile_map_v(blockIdx.x, gridDim.x, it, Mt, Nt, SN, tm, tn); }
#define ZERO_ACC(a) _Pragma("unroll") for (int m_ = 0; m_ < 4; ++m_) _Pragma("unroll") for (int n_ = 0; n_ < 4; ++n_) a[m_][n_] = (f32x4){0.f, 0.f, 0.f, 0.f};
#define EPI_VARS const int tid = get_tid(), lane = tid & 63, wid = tid >> 6, wr = wid >> 1, wc = wid & 1, fr = lane & 15, fq = lane >> 4; (void)wr; (void)wc; (void)fr; (void)fq;
#define EPI_ROW_BEGIN(m0) _Pragma("unroll") for (int m = 0; m < 4; ++m) _Pragma("unroll") for (int j = 0; j < 4; ++j) { const int row = (m0) + wr * 64 + m * 16 + fq * 4 + j; (void)row;
#define EPI_COL_BEGIN(n0) _Pragma("unroll") for (int n = 0; n < 4; ++n) { const int col = (n0) + wc * 64 + n * 16 + fr; const float val = acc[m][n][j]; (void)col; (void)val;
#define EPI_COL_END }
#define EPI_ROW_END }
#define EPI_BEGIN(m0, n0) EPI_ROW_BEGIN(m0) EPI_COL_BEGIN(n0)
#define EPI_END } }

struct Job { const float* src; int K, N; int dst; int mode; };
__device__ __forceinline__ Job get_job(const P& p, int l, int j) {
  Job r; r.mode = 0;
  switch (j) {
    case 0: r.src = p.in[8] + (size_t)(l * 2 + 0) * 1024 * 2816; r.K = 1024; r.N = 2816; r.dst = W_GU0; r.mode = 1; break;
    case 1: r.src = p.in[9] + (size_t)(l * 2 + 0) * 1024 * 2816; r.K = 1024; r.N = 2816; r.dst = W_GU0; r.mode = 2; break;
    case 2: r.src = p.in[10] + (size_t)(l * 2 + 0) * 2816 * 1024; r.K = 2816; r.N = 1024; r.dst = W_D0; break;
    case 3: r.src = p.in[8] + (size_t)(l * 2 + 1) * 1024 * 2816; r.K = 1024; r.N = 2816; r.dst = W_GU1; r.mode = 1; break;
    case 4: r.src = p.in[9] + (size_t)(l * 2 + 1) * 1024 * 2816; r.K = 1024; r.N = 2816; r.dst = W_GU1; r.mode = 2; break;
    case 5: r.src = p.in[10] + (size_t)(l * 2 + 1) * 2816 * 1024; r.K = 2816; r.N = 1024; r.dst = W_D1; break;
    case 6: r.src = p.in[11] + (size_t)l * 1024 * 6288; r.K = 1024; r.N = 6288; r.dst = W_IN; break;
    case 7: r.src = p.in[14] + (size_t)(l * 2 + 0) * 64 * 384; r.K = 64; r.N = 384; r.dst = W_WUP0; break;
    case 8: r.src = p.in[14] + (size_t)(l * 2 + 1) * 64 * 384; r.K = 64; r.N = 384; r.dst = W_WUP1; break;
    case 9: r.src = p.in[16] + (size_t)(l * 2 + 0) * 64 * 384; r.K = 64; r.N = 384; r.dst = W_AUP0; break;
    case 10: r.src = p.in[16] + (size_t)(l * 2 + 1) * 64 * 384; r.K = 64; r.N = 384; r.dst = W_AUP1; break;
    case 11: r.src = p.in[17] + (size_t)l * 128 * 384; r.K = 128; r.N = 384; r.dst = W_GUP; break;
    case 12: r.src = p.in[31] + (size_t)l * 256 * 256; r.K = 256; r.N = 256; r.dst = W_GLU; break;
    case 13: r.src = p.in[35] + (size_t)l * 384 * 1024; r.K = 384; r.N = 1024; r.dst = W_UPRW; break;
    case 14: r.src = p.in[36] + (size_t)l * 256 * 1024; r.K = 256; r.N = 1024; r.dst = W_UPS5; break;
    case 15: r.src = p.in[37] + (size_t)l * 384 * 1024; r.K = 384; r.N = 1024; r.dst = W_UPML; break;
    default: r.src = p.in[39] + (size_t)l * 1024 * 1024; r.K = 1024; r.N = 1024; r.dst = W_OUT; break;
  }
  return r;
}
#define NJOBS 17
__device__ void mod_task(const P& p, int t, char* lds) {
  float* sc = (float*)lds;
  float* red = sc + 5 * 1024;
  const int tid = get_tid();
  for (int i = tid; i < 5 * 1024; i += NTHR) {
    int v = i >> 10, k = i & 1023;
    float c = v < 4 ? p.in[1][v * 1024 + k] : p.in[3][k];
    sc[i] = siluf_(c);
  }
  __syncthreads();
  const int c0 = t * 64; const int l = c0 / 9216; const int j0 = c0 % 9216;
  const int col = tid & 63, part = tid >> 6;
  const float* w = p.in[4] + ((size_t)l * 1024 + part * 256) * 9216 + j0 + col;
  float a0 = 0, a1 = 0, a2 = 0, a3 = 0, a4 = 0;
  const float* s = sc + part * 256;
#pragma unroll 8
  for (int i = 0; i < 256; ++i) {
    float wv = w[(size_t)i * 9216];
    a0 += s[i] * wv; a1 += s[1024 + i] * wv; a2 += s[2048 + i] * wv; a3 += s[3072 + i] * wv; a4 += s[4096 + i] * wv;
  }
  red[(part * 5 + 0) * 64 + col] = a0; red[(part * 5 + 1) * 64 + col] = a1; red[(part * 5 + 2) * 64 + col] = a2;
  red[(part * 5 + 3) * 64 + col] = a3; red[(part * 5 + 4) * 64 + col] = a4;
  __syncthreads();
  for (int i = tid; i < 320; i += NTHR) {
    int v = i >> 6, c = i & 63;
    float sum = red[(0 * 5 + v) * 64 + c] + red[(1 * 5 + v) * 64 + c] + red[(2 * 5 + v) * 64 + c] + red[(3 * 5 + v) * 64 + c];
    p.mod[(size_t)(l * 5 + v) * 9216 + j0 + c] = sum + p.in[5][(size_t)l * 9216 + j0 + c];
  }
  __syncthreads();
}
__device__ __forceinline__ void ph_convert(const P& p, int l, bool with_mod, char* lds) {
  const int tid = get_tid();
  int ntiles[NJOBS]; int total = 0;
#pragma unroll
  for (int j = 0; j < NJOBS; ++j) { Job jb = get_job(p, l, j); ntiles[j] = (jb.K >> 6) * ((jb.N + 63) >> 6); total += ntiles[j]; }
  const int nmod = with_mod ? 288 : 0;
  float* tile = (float*)lds;
  for (int t = blockIdx.x; t < total + nmod; t += gridDim.x) {
    if (t < nmod) { mod_task(p, t, lds); continue; }
    int tt = t - nmod; int j = 0;
#pragma unroll
    for (int q = 0; q < NJOBS; ++q) { if (j == q && tt >= ntiles[q]) { tt -= ntiles[q]; j = q + 1; } }
    Job jb = get_job(p, l, j);
    const int nkt = jb.K >> 6;
    const int k0 = (tt % nkt) * 64, n0 = (tt / nkt) * 64;
    {
      const int c = tid & 63, r0 = tid >> 6;
      const bool ok = (n0 + c) < jb.N;
#pragma unroll
      for (int i = 0; i < 16; ++i) { int r = r0 + i * 4; tile[r * 65 + c] = ok ? jb.src[(size_t)(k0 + r) * jb.N + n0 + c] : 0.f; }
    }
    __syncthreads();
    {
      const int nn = tid >> 2, q = tid & 3; const int n = n0 + nn;
      if (n < jb.N) {
        int drow = n;
        if (jb.mode == 1) drow = (n >> 5) * 64 + (n & 31);
        else if (jb.mode == 2) drow = (n >> 5) * 64 + 32 + (n & 31);
        bf16_t* d = p.W + jb.dst + (size_t)drow * jb.K + k0 + q * 16;
        unsigned pk[8];
#pragma unroll
        for (int i = 0; i < 8; ++i) { unsigned lo = f2bf(tile[(q * 16 + 2 * i) * 65 + nn]); unsigned hi = f2bf(tile[(q * 16 + 2 * i + 1) * 65 + nn]); pk[i] = lo | (hi << 16); }
        *(uint4*)d = make_uint4(pk[0], pk[1], pk[2], pk[3]);
        *(uint4*)(d + 8) = make_uint4(pk[4], pk[5], pk[6], pk[7]);
      }
    }
    __syncthreads();
  }
}

__device__ __forceinline__ void ph_rows(const P& p, int mode, int l, int ln_idx, int Mrows, bool writeU, int ul, int ks) {
  const int lane = get_tid() & 63, wid = get_tid() >> 6;
  const int nw = gridDim.x * 4;
  const float* g = p.in[6] + (size_t)(l * 3 + ln_idx) * 1024;
  const float* b = p.in[7] + (size_t)(l * 3 + ln_idx) * 1024;
  for (int m = blockIdx.x * 4 + wid; m < Mrows; m += nw) {
    float* s = srow(p, m);
    const float* src = s;
    if (mode == 0) src = m < M_LAT ? p.in[0] + (size_t)m * 1024 : p.in[2] + (size_t)(m - M_LAT) * 1024;
    float4 v[4];
#pragma unroll
    for (int i = 0; i < 4; ++i) v[i] = *(const float4*)(src + lane * 4 + i * 256);
    if (mode == 1) {
      float sum = 0;
#pragma unroll
      for (int i = 0; i < 4; ++i) sum += v[i].x + v[i].y + v[i].z + v[i].w;
      sum = wavesum(sum);
      const float mean = sum * (1.f / 1024.f);
      float sq = 0;
#pragma unroll
      for (int i = 0; i < 4; ++i) { v[i].x -= mean; v[i].y -= mean; v[i].z -= mean; v[i].w -= mean; sq += v[i].x * v[i].x + v[i].y * v[i].y + v[i].z * v[i].z + v[i].w * v[i].w; }
      sq = wavesum(sq);
      const float rstd = rsqrtf(sq * (1.f / 1024.f) + 1e-5f);
#pragma unroll
      for (int i = 0; i < 4; ++i) {
        float4 gg = *(const float4*)(g + lane * 4 + i * 256), bb = *(const float4*)(b + lane * 4 + i * 256);
        v[i].x = v[i].x * rstd * gg.x + bb.x; v[i].y = v[i].y * rstd * gg.y + bb.y; v[i].z = v[i].z * rstd * gg.z + bb.z; v[i].w = v[i].w * rstd * gg.w + bb.w;
      }
    }
    if (mode == 1) {
#pragma unroll
      for (int i = 0; i < 4; ++i) *(float4*)(s + lane * 4 + i * 256) = v[i];
    }
    if (writeU) {
      const float* sh = modp(p, ul, m, ks); const float* scl = modp(p, ul, m, ks + 1);
#pragma unroll
      for (int i = 0; i < 4; ++i) {
        float4 a = *(const float4*)(sh + lane * 4 + i * 256), c = *(const float4*)(scl + lane * 4 + i * 256);
        unsigned lo = f2bf(v[i].x * (1.f + c.x) + a.x) | ((unsigned)f2bf(v[i].y * (1.f + c.y) + a.y) << 16);
        unsigned hi = f2bf(v[i].z * (1.f + c.z) + a.z) | ((unsigned)f2bf(v[i].w * (1.f + c.w) + a.w) << 16);
        *(uint2*)(p.U + (size_t)m * 1024 + lane * 4 + i * 256) = make_uint2(lo, hi);
      }
    }
  }
}


#define STREAM_BEGIN_X(SWAPPED_, Mt_, Nt_, SN_, APTR, BPTR, LDA_, LDB_, K_) { \
    u32x4 pr_a[4], pr_b[4]; bool first_ = true; int tm, tn; bool have_ = tile_map(0, Mt_, Nt_, SN_, tm, tn); \
    for (int it = 0; have_; ++it) { int tm2, tn2; const bool have2_ = tile_map(it + 1, Mt_, Nt_, SN_, tm2, tn2); \
      const int tmn = have2_ ? tm2 : tm, tnn = have2_ ? tn2 : tn; \
      f32x4 acc[4][4]; ZERO_ACC(acc) \
      { const bf16_t* a_cur = APTR; const bf16_t* b_cur = BPTR; \
        const bf16_t* a_nxt; const bf16_t* b_nxt; { const int tm = tmn, tn = tnn; (void)tm; (void)tn; a_nxt = APTR; b_nxt = BPTR; } \
        gemm_stream<SWAPPED_>(a_cur, LDA_, b_cur, LDB_, K_, a_nxt, b_nxt, first_, acc, lds, pr_a, pr_b); first_ = false; }
#define STREAM_BEGIN(Mt_, Nt_, SN_, APTR, BPTR, LDA_, LDB_, K_) STREAM_BEGIN_X(false, Mt_, Nt_, SN_, APTR, BPTR, LDA_, LDB_, K_)
#define STREAM_BEGIN_T(Mt_, Nt_, SN_, APTR, BPTR, LDA_, LDB_, K_) STREAM_BEGIN_X(true, Mt_, Nt_, SN_, APTR, BPTR, LDA_, LDB_, K_)
#define STREAM_END tm = tm2; tn = tn2; have_ = have2_; } }
__device__ __forceinline__ void ph_ffn_up(const P& p, int s, int Mt, char* lds) {
  EPI_VARS
  bf16_t* HM = (bf16_t*)p.R;
  const bf16_t* Wt = p.W + (s ? W_GU1 : W_GU0);
  STREAM_BEGIN_T(Mt, 44, 4, (p.U + (size_t)(tm * 128) * 1024), (Wt + (size_t)(tn * 128) * 1024), 1024, 1024, 1024)
    const int m0 = tm * 128, n0 = tn * 128;
    const int hb = ((n0 + wc * 64) >> 6) * 32 + fq * 4;
#pragma unroll
    for (int m = 0; m < 4; ++m) {
      bf16_t* hp = HM + (size_t)(m0 + wr * 64 + m * 16 + fr) * 2816 + hb;
#pragma unroll
      for (int n = 0; n < 2; ++n) {
        const unsigned lo = (unsigned)f2bf(siluf_(acc[m][n][0]) * acc[m][n + 2][0]) | ((unsigned)f2bf(siluf_(acc[m][n][1]) * acc[m][n + 2][1]) << 16);
        const unsigned hi = (unsigned)f2bf(siluf_(acc[m][n][2]) * acc[m][n + 2][2]) | ((unsigned)f2bf(siluf_(acc[m][n][3]) * acc[m][n + 2][3]) << 16);
        *(uint2*)(hp + n * 16) = make_uint2(lo, hi);
      }
    }
  STREAM_END
}
__device__ __forceinline__ void ph_ffn_down(const P& p, int l, int s, int Mt, char* lds) {
  EPI_VARS
  const bf16_t* HM = (const bf16_t*)p.R;
  const bf16_t* Wt = p.W + (s ? W_D1 : W_D0);
  const int gk = s ? 8 : 2;
  STREAM_BEGIN_T(Mt, 8, 8, (HM + (size_t)((Mt - 1 - tm) * 128) * 2816), (Wt + (size_t)(tn * 128) * 2816), 2816, 2816, 2816)
    const int m0 = (Mt - 1 - tm) * 128, n0 = tn * 128;
#pragma unroll
    for (int m = 0; m < 4; ++m) {
      const int row = m0 + wr * 64 + m * 16 + fr;
      float* sp = srow(p, row) + n0 + wc * 64 + fq * 4; const float* gp = modp(p, l, row, gk) + n0 + wc * 64 + fq * 4;
      const float* rp = (l == 0 && s == 0) ? (row < M_LAT ? p.in[0] + (size_t)row * 1024 : p.in[2] + (size_t)(row - M_LAT) * 1024) + n0 + wc * 64 + fq * 4 : sp;
#pragma unroll
      for (int n = 0; n < 4; ++n) {
        float4 s4 = *(const float4*)(rp + n * 16); const float4 g4 = *(const float4*)(gp + n * 16);
        s4.x = ALPHA * s4.x + 0.5f * g4.x * acc[m][n][0]; s4.y = ALPHA * s4.y + 0.5f * g4.y * acc[m][n][1];
        s4.z = ALPHA * s4.z + 0.5f * g4.z * acc[m][n][2]; s4.w = ALPHA * s4.w + 0.5f * g4.w * acc[m][n][3];
        *(float4*)(sp + n * 16) = s4;
      }
    }
  STREAM_END
}

#define RW_ZRW(p) ((hf*)(p).R)
#define RW_RKV(p) (RW_ZRW(p) + (size_t)M_ALL * 1152)
#define RW_LA(p) ((bf16_t*)(RW_RKV(p) + (size_t)M_ALL * 1152))
#define RW_KK(p) ((hf*)(RW_LA(p) + (size_t)M_ALL * 256))
#define RW_KD(p) (RW_KK(p) + (size_t)M_ALL * 384)
#define RW_KA(p) (RW_KD(p) + (size_t)2 * M_ALL * 384)
#define RW_YR(p) (RW_KA(p) + (size_t)2 * M_ALL * 384)

#define S5_ZH(p) ((hf*)RW_LA(p))
#define S5_YG(p) ((p).W + W_GU0)
#define S5_E(p) ((float2*)((p).R + (size_t)M_ALL * 9728))
#define S5_X(p) S5_E(p)

#define ML_Z(p) ((hf*)(p).R)
#define ML_GL(p) ((float*)(ML_Z(p) + (size_t)M_ALL * 1536))
#define ML_QK(p) ((hf*)(ML_GL(p) + (size_t)M_ALL * 16))
#define ML_DC(p) ((float*)(ML_QK(p) + (size_t)M_ALL * 768))
#define ML_DN(p) (ML_DC(p) + (size_t)4224 * 9216)
#define ML_SC(p) (ML_DN(p) + (size_t)4224 * 96)
#define ML_MP(p) (ML_SC(p) + (size_t)4224 * 2)

__device__ __forceinline__ void ph_z_rw(const P& p, char* lds) {
  EPI_VARS
  hf* ZRW = RW_ZRW(p); bf16_t* LA = RW_LA(p);
  const int Mt = 264;
  STREAM_BEGIN(Mt, 11, 11, (p.U + (size_t)(tm * 128) * 1024), (p.W + W_IN + (size_t)(tn < 9 ? tn * 128 : 2960 + (tn - 9) * 128) * 1024), 1024, 1024, 1024)
    const int m0 = tm * 128;
    if (tn < 9) {
      EPI_BEGIN(m0, tn * 128)
        ZRW[(size_t)row * 1152 + col] = (hf)val;
      EPI_END
    } else {
      EPI_BEGIN(m0, (tn - 9) * 128)
        float o = col < 64 ? tanhf_(val) : (col < 128 ? val : sigmoidf_(val));
        LA[(size_t)row * 256 + col] = f2bf(o);
      EPI_END
    }
  STREAM_END
}
__device__ __forceinline__ void ph_z_s5(const P& p, char* lds, int vb, int nvb) {
  EPI_VARS
  hf* Z = S5_ZH(p);
  const int Mt = 264;
  for (int it = 0;; ++it) {
    int tm, tn; if (!tile_map_v(vb, nvb, it, Mt, 2, 2, tm, tn)) break; const int m0 = tm * 128;
    f32x4 acc[4][4]; ZERO_ACC(acc)
    gemm_main(p.U + (size_t)m0 * 1024, 1024, p.W + W_IN + (size_t)(2704 + tn * 128) * 1024, 1024, 1024, acc, lds);
    EPI_BEGIN(m0, tn * 128)
      Z[(size_t)row * 256 + col] = (hf)val;
    EPI_END
  }
}
__device__ __forceinline__ void ph_z_ml(const P& p, char* lds) {
  EPI_VARS
  hf* Z = ML_Z(p); float* GL = ML_GL(p);
  const int Mt = 264;
  STREAM_BEGIN(Mt, 13, 13, (p.U + (size_t)(tm * 128) * 1024), (p.W + W_IN + (size_t)(1152 + tn * 128) * 1024), 1024, 1024, 1024)
    const int m0 = tm * 128;
    if (tn < 12) {
      EPI_BEGIN(m0, tn * 128)
        Z[(size_t)row * 1536 + col] = (hf)val;
      EPI_END
    } else {
      EPI_BEGIN(m0, 0)
        if (col < 16) GL[(size_t)row * 16 + col] = val;
      EPI_END
    }
  STREAM_END
}

template <int which>
__device__ __forceinline__ void ph_conv(const P& p, int l) {
  constexpr int nch = which == 0 ? 144 : 96;
  constexpr int ldin = which == 0 ? 1152 : 1536;
  constexpr int cbase = which == 0 ? 0 : 1152;
  const hf* Zin = which == 0 ? RW_ZRW(p) : ML_Z(p);
  const float* cw = p.in[12] + (size_t)l * 9 * 1920;
  const unsigned total = (unsigned)(M_ALL / 4) * nch;
  for (unsigned idx = blockIdx.x * NTHR + get_tid(); idx < (total + 63u) / 64u * 64u; idx += gridDim.x * NTHR) {
    const bool act = idx < total;
    const int tg = act ? (int)(idx / (unsigned)nch) : 0; const int ch = act ? (int)(idx % (unsigned)nch) : 0; const int c0 = ch * 8;
    const int m0 = tg * 4;
    float o[4][8];
#pragma unroll
    for (int t = 0; t < 4; ++t)
#pragma unroll
      for (int i = 0; i < 8; ++i) o[t][i] = 0.f;
    const bool lat = m0 < M_LAT;
    const int bb = m0 >> 13, tt = lat ? (m0 & 8191) : ((m0 - M_LAT) & 255);
    const int gr = tt >> 6, gc0 = lat ? (tt & 63) : tt;
    const int ncol = lat ? 64 : 256;
#pragma unroll
    for (int dr = -1; dr <= 1; ++dr) {
      const int rr = gr + dr;
      const bool rowok = lat ? (rr >= 0 && rr < 128) : (dr == 0);
      if (!rowok) continue;
      const float* w = cw + ((dr + 1) * 3) * 1920 + cbase + c0;
      float wv[3][8];
#pragma unroll
      for (int k = 0; k < 3; ++k) { const float4 a = *(const float4*)(w + k * 1920), b = *(const float4*)(w + k * 1920 + 4);
        wv[k][0] = a.x; wv[k][1] = a.y; wv[k][2] = a.z; wv[k][3] = a.w; wv[k][4] = b.x; wv[k][5] = b.y; wv[k][6] = b.z; wv[k][7] = b.w; }
      const int mrow = lat ? ((bb << 13) + rr * 64) : (m0 - gc0);
#pragma unroll
      for (int cc = 0; cc < 6; ++cc) {
        const int col = gc0 - 1 + cc;
        if (col < 0 || col >= ncol) continue;
        const hf8 z = *(const hf8*)(Zin + (size_t)(mrow + col) * ldin + c0);
        float zf[8];
#pragma unroll
        for (int i = 0; i < 8; ++i) zf[i] = (float)z[i];
#pragma unroll
        for (int t = 0; t < 4; ++t) {
          const int k = cc - t;
          if (k >= 0 && k < 3) {
#pragma unroll
            for (int i = 0; i < 8; ++i) o[t][i] += zf[i] * wv[k][i];
          }
        }
      }
    }
#pragma unroll
    for (int t = 0; t < 4; ++t) {
      const int m = m0 + t;
      if (which == 0) {
        const bool isk = act && (c0 >= 384) && (c0 < 768);
        float kkv[8]; float ss = 0.f;
        if (isk) {
          const float* kkw = p.in[18] + (size_t)l * 384 + (c0 - 384);
#pragma unroll
          for (int i = 0; i < 8; ++i) { kkv[i] = o[t][i] * kkw[i]; ss += kkv[i] * kkv[i]; }
        } else {
#pragma unroll
          for (int i = 0; i < 8; ++i) kkv[i] = 0.f;
        }
        ss += __shfl_xor(ss, 1); ss += __shfl_xor(ss, 2); ss += __shfl_xor(ss, 4);
        if (act) {
          hf8 ov;
#pragma unroll
          for (int i = 0; i < 8; ++i) ov[i] = (hf)o[t][i];
          *(hf8*)(RW_RKV(p) + (size_t)m * 1152 + c0) = ov;
          if (isk) {
            const float rn = rsqrtf(fmaxf(ss, 1e-24f));
            hf8 kv;
#pragma unroll
            for (int i = 0; i < 8; ++i) kv[i] = (hf)(kkv[i] * rn);
            *(hf8*)(RW_KK(p) + (size_t)m * 384 + (c0 - 384)) = kv;
          }
        }
      } else if (act) {
        const float sc = c0 >= 384 ? 0.10206207261596575f : 1.f;
        hf8 ov;
#pragma unroll
        for (int i = 0; i < 8; ++i) ov[i] = (hf)(siluf_(o[t][i]) * sc);
        *(hf8*)(ML_QK(p) + (size_t)m * 768 + c0) = ov;
      }
    }
  }
}

__device__ __forceinline__ void ph_lora(const P& p, int l, char* lds) {
  EPI_VARS
  hf* ZRW = RW_ZRW(p); const hf* RKV = RW_RKV(p); const bf16_t* LA = RW_LA(p); const hf* KK = RW_KK(p);
  hf* KD = RW_KD(p); hf* KA = RW_KA(p);
  const int Mt = 264;
  for (int it = 0;; ++it) {
    int tm, q; if (!tile_map(it, Mt, 15, 15, tm, q)) break; const int job = q / 3, tn = q % 3; const int m0 = tm * 128, n0 = tn * 128;
    f32x4 acc[4][4]; ZERO_ACC(acc)
    if (job < 2) {
      const int d = job;
      gemm_small_t<1>(LA + (size_t)m0 * 256, 256, p.W + (d ? W_WUP1 : W_WUP0) + (size_t)n0 * 64, 64, acc, lds);
      const float* w0 = p.in[13] + (size_t)(l * 2 + d) * 384;
#pragma unroll
      for (int m = 0; m < 4; ++m) {
        const int row = m0 + wr * 64 + m * 16 + fr;
#pragma unroll
        for (int n = 0; n < 4; ++n) {
          const int cb = n0 + wc * 64 + n * 16 + fq * 4;
          const float4 wv = *(const float4*)(w0 + cb);
          const float wa[4] = {wv.x, wv.y, wv.z, wv.w};
          hf4 o;
#pragma unroll
          for (int j = 0; j < 4; ++j) { const float e = sigmoidf_(wa[j] + acc[m][n][j]) * 0.6065306597126334f; o[j] = (hf)(1.f - __expf(-e)); }
          *(hf4*)(ZRW + (size_t)row * 1152 + d * 384 + cb) = o;
        }
      }
    } else if (job < 4) {
      const int d = job - 2;
      gemm_small_t<1>(LA + (size_t)m0 * 256 + 64, 256, p.W + (d ? W_AUP1 : W_AUP0) + (size_t)n0 * 64, 64, acc, lds);
      const float* a0 = p.in[15] + (size_t)(l * 2 + d) * 384; const float* kaw = p.in[19] + (size_t)l * 384;
#pragma unroll
      for (int m = 0; m < 4; ++m) {
        const int row = m0 + wr * 64 + m * 16 + fr;
#pragma unroll
        for (int n = 0; n < 4; ++n) {
          const int cb = n0 + wc * 64 + n * 16 + fq * 4;
          const float4 av = *(const float4*)(a0 + cb), kv = *(const float4*)(kaw + cb);
          const float aa[4] = {av.x, av.y, av.z, av.w}, ka_[4] = {kv.x, kv.y, kv.z, kv.w};
          const hf4 k4 = *(const hf4*)(RKV + (size_t)row * 1152 + 384 + cb), kk4 = *(const hf4*)(KK + (size_t)row * 384 + cb);
          hf4 okd, oka;
#pragma unroll
          for (int j = 0; j < 4; ++j) { const float a = sigmoidf_(aa[j] + acc[m][n][j]); okd[j] = (hf)((float)k4[j] * (1.f + (a - 1.f) * ka_[j])); oka[j] = (hf)((float)kk4[j] * a); }
          *(hf4*)(KD + ((size_t)d * M_ALL + row) * 384 + cb) = okd;
          *(hf4*)(KA + ((size_t)d * M_ALL + row) * 384 + cb) = oka;
        }
      }
    } else {
      gemm_small_t<2>(LA + (size_t)m0 * 256 + 128, 256, p.W + W_GUP + (size_t)n0 * 128, 128, acc, lds);
#pragma unroll
      for (int m = 0; m < 4; ++m) {
        const int row = m0 + wr * 64 + m * 16 + fr;
#pragma unroll
        for (int n = 0; n < 4; ++n) {
          const int cb = n0 + wc * 64 + n * 16 + fq * 4;
          hf4 o; o[0] = (hf)acc[m][n][0]; o[1] = (hf)acc[m][n][1]; o[2] = (hf)acc[m][n][2]; o[3] = (hf)acc[m][n][3];
          *(hf4*)(ZRW + (size_t)row * 1152 + 768 + cb) = o;
        }
      }
    }
  }
}

typedef float f32x2 __attribute__((ext_vector_type(2)));
#define RW_CH 16
#define RW_BUF 21504
__device__ __forceinline__ void rw_cvt_store(char* dst, uint4 q) {
  const hf8 h = __builtin_bit_cast(hf8, q);
  f32x4 a, b;
  a[0] = (float)h[0]; a[1] = (float)h[1]; a[2] = (float)h[2]; a[3] = (float)h[3];
  b[0] = (float)h[4]; b[1] = (float)h[5]; b[2] = (float)h[6]; b[3] = (float)h[7];
  *(f32x4*)dst = a; *(f32x4*)(dst + 16) = b;
}
__device__ __forceinline__ void ph_rwscan(const P& p, char* lds) {
  const hf* ZRW = RW_ZRW(p); hf* RKV = RW_RKV(p); const hf* KK = RW_KK(p);
  const int tid = get_tid(), lane = tid & 63, wid = tid >> 6;
  char* pbuf = lds + 3 * RW_BUF + wid * 2048;
  char* ybuf = lds + 3 * RW_BUF + 8192;
  for (int t = blockIdx.x; t < 192; t += gridDim.x) {
    const int rqq = t & 3, h = (t >> 2) % 6, b = (t / 24) & 3, d = t / 96;
    const int rsub = lane >> 4, g = lane & 15; const int rl = wid * 4 + rsub;
    const int sgn = d ? -1 : 1;
    const bool grpA = tid < 128; const int t2 = tid & 127;
    const int sstep = t2 >> 3, sseg = t2 & 7;
    const hf* g0 = grpA ? (RKV + h * 64 + sseg * 8) : (RW_KD(p) + (size_t)d * M_ALL * 384 + h * 64 + sseg * 8);
    const size_t ld0 = grpA ? 1152 : 384;
    const hf* g1 = grpA ? (KK + h * 64 + sseg * 8) : (RW_KA(p) + (size_t)d * M_ALL * 384 + h * 64 + sseg * 8);
    const hf* g2 = grpA ? (ZRW + d * 384 + h * 64 + sseg * 8) : (RKV + 768 + h * 64 + rqq * 16 + (t2 & 1) * 8);
    const int s2 = grpA ? sstep : (t2 >> 1);
    const bool has2 = grpA || t2 < 32;
    const int o0 = (grpA ? 0 : 12288) + sstep * 256 + sseg * 32;
    const int o1 = (grpA ? 4096 : 16384) + sstep * 256 + sseg * 32;
    const int o2 = grpA ? (8192 + sstep * 256 + sseg * 32) : (20480 + (t2 >> 1) * 64 + (t2 & 1) * 32);
    hf* g_y = d == 0 ? (RKV + 384 + h * 64 + rqq * 16 + (tid & 1) * 8) : (RW_YR(p) + h * 64 + rqq * 16 + (tid & 1) * 8);
    const int ldy = d == 0 ? 1152 : 384;
    uint4 q0, q1, q2;
#define RW_M0(pp) ((pp) < 256 ? (M_LAT + b * 256 + (d ? 255 - (pp) : (pp))) : (b * 8192 + (d ? 8447 - (pp) : (pp) - 256)))
#define RW_GLOAD(c) { const int mb_ = RW_M0((c) * RW_CH); const size_t mm = (size_t)(mb_ + sgn * sstep); \
      q0 = *(const uint4*)(g0 + mm * ld0); q1 = *(const uint4*)(g1 + mm * 384); \
      if (has2) { const size_t m2 = (size_t)(mb_ + sgn * s2); q2 = *(const uint4*)(g2 + m2 * 1152); } }
#define RW_SSTORE(c) { char* bb_ = lds + ((c) % 3) * RW_BUF; rw_cvt_store(bb_ + o0, q0); rw_cvt_store(bb_ + o1, q1); if (has2) rw_cvt_store(bb_ + o2, q2); }
    f32x2 S01 = (f32x2){0.f, 0.f}, S23 = (f32x2){0.f, 0.f};
    RW_GLOAD(0) RW_SSTORE(0)
    RW_GLOAD(1) RW_SSTORE(1)
    __syncthreads();
    const int NCH = 8448 / RW_CH;
    for (int c = 0; c < NCH; ++c) {
      if (c + 2 < NCH) RW_GLOAD(c + 2)
      if (c > 0 && tid < 32) {
        const int mb_ = RW_M0((c - 1) * RW_CH); const size_t mv = (size_t)(mb_ + sgn * (tid >> 1));
        *(uint4*)(g_y + mv * ldy) = *(const uint4*)(ybuf + ((c - 1) & 1) * 512 + tid * 16);
      }
      const char* cb = lds + (c % 3) * RW_BUF + g * 16;
      const char* vb = lds + (c % 3) * RW_BUF + 20480 + rl * 4;
      f32x4 R4[RW_CH], K4[RW_CH], D4[RW_CH], KD4[RW_CH], KA4[RW_CH]; float VV[RW_CH];
#define RW_LDS(s_) { R4[s_] = *(const f32x4*)(cb + (s_) * 256); K4[s_] = *(const f32x4*)(cb + 4096 + (s_) * 256); D4[s_] = *(const f32x4*)(cb + 8192 + (s_) * 256); \
        KD4[s_] = *(const f32x4*)(cb + 12288 + (s_) * 256); KA4[s_] = *(const f32x4*)(cb + 16384 + (s_) * 256); VV[s_] = *(const float*)(vb + (s_) * 64); }
      RW_LDS(0) RW_LDS(1) RW_LDS(2)
#pragma unroll
      for (int s = 0; s < RW_CH; ++s) {
        if (s + 3 < RW_CH) RW_LDS(s + 3)
        const f32x4 r4 = R4[s], k4 = K4[s], d4 = D4[s], kd4 = KD4[s], ka4 = KA4[s]; const float vv = VV[s];
        const f32x2 k01 = {k4[0], k4[1]}, k23 = {k4[2], k4[3]}, d01 = {d4[0], d4[1]}, d23 = {d4[2], d4[3]};
        const f32x2 kd01 = {kd4[0], kd4[1]}, kd23 = {kd4[2], kd4[3]}, ka01 = {ka4[0], ka4[1]}, ka23 = {ka4[2], ka4[3]};
        const f32x2 r01 = {r4[0], r4[1]}, r23 = {r4[2], r4[3]};
        const f32x2 sa2 = __builtin_elementwise_fma(S23, k23, S01 * k01);
        float sa = sa2[0] + sa2[1];
        sa = rowsum16(sa);
        const f32x2 vv2 = {vv, vv}; const f32x2 nsa = {-sa, -sa};
        f32x2 T01 = __builtin_elementwise_fma(-S01, d01, S01), T23 = __builtin_elementwise_fma(-S23, d23, S23);
        T01 = __builtin_elementwise_fma(vv2, kd01, T01); T23 = __builtin_elementwise_fma(vv2, kd23, T23);
        S01 = __builtin_elementwise_fma(nsa, ka01, T01); S23 = __builtin_elementwise_fma(nsa, ka23, T23);
        const f32x2 y2 = __builtin_elementwise_fma(S23, r23, S01 * r01);
        *(float*)(pbuf + (((s & 7) * 4 + rsub) * 16 + g) * 4) = y2[0] + y2[1];
        if ((s & 7) == 7) {
          if (lane < 32) {
            const char* pr = pbuf + lane * 64;
            const f32x4 a0 = *(const f32x4*)(pr), a1 = *(const f32x4*)(pr + 16), a2 = *(const f32x4*)(pr + 32), a3 = *(const f32x4*)(pr + 48);
            const f32x4 sm = (a0 + a1) + (a2 + a3);
            const float y = (sm[0] + sm[1]) + (sm[2] + sm[3]);
            *(hf*)(ybuf + (c & 1) * 512 + (((s >> 3) * 8 + (lane >> 2)) * 16 + wid * 4 + (lane & 3)) * 2) = (hf)y;
          }
        }
      }
      if (c + 2 < NCH) RW_SSTORE(c + 2)
      __syncthreads();
    }
    if (tid < 32) {
      const int mb_ = RW_M0((NCH - 1) * RW_CH); const size_t mv = (size_t)(mb_ + sgn * (tid >> 1));
      *(uint4*)(g_y + mv * ldy) = *(const uint4*)(ybuf + ((NCH - 1) & 1) * 512 + tid * 16);
    }
    __syncthreads();
  }
}

__device__ __forceinline__ void ph_rwpost(const P& p, int l) {
  const hf* ZRW = RW_ZRW(p); const hf* RKV = RW_RKV(p); const hf* YR = RW_YR(p);
  const int lane = get_tid() & 63, wid = get_tid() >> 6;
  const int nw = gridDim.x * 4;
  for (int t = blockIdx.x * 4 + wid; t < M_ALL * 6; t += nw) {
    const int m = t / 6, h = t % 6; const int c = h * 64 + lane;
    const float ys = (float)RKV[(size_t)m * 1152 + 384 + c] + (float)YR[(size_t)m * 384 + c];
    const float mean = wavesum(ys) * (1.f / 64.f);
    const float xc = ys - mean;
    const float var = wavesum(xc * xc) * (1.f / 64.f);
    float y = xc * rsqrtf(var + 64e-5f) * p.in[21][(size_t)l * 384 + c] + p.in[22][(size_t)l * 384 + c];
    const float r = (float)RKV[(size_t)m * 1152 + c], v = (float)RKV[(size_t)m * 1152 + 768 + c];
    const float rk = p.in[20][(size_t)l * 384 + c];
    const float kd0 = (float)RW_KD(p)[(size_t)m * 384 + c], kd1 = (float)RW_KD(p)[((size_t)M_ALL + m) * 384 + c];
    const float bs = wavesum(r * (kd0 + kd1) * rk);
    y = (y + bs * v) * (float)ZRW[(size_t)m * 1152 + 768 + c];
    p.Y[(size_t)m * 1024 + c] = f2bf(y);
  }
}

struct S5C { float ar, ai; float br[16], bi[16]; };
__device__ __forceinline__ void s5_consts(const P& p, int l, int d, int g, int n, S5C& c) {
  const int ig = (l * 2 + d) * 16 + g;
  const float lr = fminf(p.in[23][(size_t)ig * 64 + n], -1e-4f), li = p.in[24][(size_t)ig * 64 + n];
  const float dt = expf(p.in[25][ig]);
  const float mag = expf(lr * dt);
  c.ar = mag * cosf(li * dt); c.ai = mag * sinf(li * dt);
  const float nr = c.ar - 1.f, ni = c.ai; const float den = 1.f / (lr * lr + li * li);
  const float cr = (nr * lr + ni * li) * den, ci = (ni * lr - nr * li) * den;
  const float* bre = p.in[26] + ((size_t)ig * 64 + n) * 16; const float* bim = p.in[27] + ((size_t)ig * 64 + n) * 16;
#pragma unroll
  for (int h = 0; h < 16; ++h) { const float xr = bre[h], xi = bim[h]; c.br[h] = cr * xr - ci * xi; c.bi[h] = cr * xi + ci * xr; }
}
__device__ __forceinline__ int s5_m0(int b, int tc) { return tc < 128 ? b * 8192 + tc * 64 : M_LAT + b * 256 + (tc - 128) * 64; }
__device__ __forceinline__ int chain_pos(int d, int tc) { return d == 0 ? (tc < 128 ? tc + 4 : tc - 128) : (tc < 128 ? 131 - tc : 131 - tc); }
__device__ __forceinline__ void s5_cf(const P& p, int ig, int n, float dt, float& ar, float& ai, float& cr, float& ci) {
  const float lr = fminf(p.in[23][(size_t)ig * 64 + n], -1e-4f), li = p.in[24][(size_t)ig * 64 + n];
  const float mag = expf(lr * dt);
  ar = mag * cosf(li * dt); ai = mag * sinf(li * dt);
  const float nr = ar - 1.f, ni = ai; const float den = 1.f / (lr * lr + li * li);
  cr = (nr * lr + ni * li) * den; ci = (ni * lr - nr * li) * den;
}
__device__ __forceinline__ void ph_s5_pass(const P& p, int l, int pass, char* lds, int vb, int nvb) {
  const int tid = get_tid(), lane = tid & 63, wid = tid >> 6, fr = lane & 15, fq = lane >> 4;
  float* ub = (float*)(lds + wid * 16896);
  char* xs = lds + wid * 16896 + 4096;
  float* bu = (float*)(lds + wid * 16896 + 8448);
  const hf* Z = S5_ZH(p); float2* E = S5_E(p); const float2* X = S5_X(p); bf16_t* YG = S5_YG(p);
  const int nw = nvb * 4;
  for (int t = vb * 4 + wid; t < 4 * 132 * 16; t += nw) {
    const int g = t & 15, tc = (t >> 4) % 132, b = t / (16 * 132);
    const int m0 = s5_m0(b, tc);
#pragma unroll
    for (int i = 0; i < 4; ++i) { const int e = lane + i * 64; const int tok = e >> 2, q = e & 3;
      const hf4 zv = *(const hf4*)(Z + (size_t)(m0 + tok) * 256 + g * 16 + q * 4);
      *(float4*)(ub + tok * 16 + q * 4) = make_float4((float)zv[0], (float)zv[1], (float)zv[2], (float)zv[3]); }
    f32x4 yacc[4];
#pragma unroll
    for (int i = 0; i < 4; ++i) yacc[i] = (f32x4){0.f, 0.f, 0.f, 0.f};
    for (int d = 0; d < 2; ++d) {
      const int ig = (l * 2 + d) * 16 + g;
      const float dt = expf(p.in[25][ig]);
      float ar, ai, crn, cin_;
      s5_cf(p, ig, lane, dt, ar, ai, crn, cin_);
      hf8 bfB[8];
#pragma unroll
      for (int q4 = 0; q4 < 4; ++q4) {
        const int n = q4 * 16 + fr;
        float a_r, a_i, cr, ci; s5_cf(p, ig, n, dt, a_r, a_i, cr, ci);
        hf8 re, im;
        if (fq < 2) {
          const float* bre = p.in[26] + ((size_t)ig * 64 + n) * 16 + fq * 8; const float* bim = p.in[27] + ((size_t)ig * 64 + n) * 16 + fq * 8;
          const float4 r0 = *(const float4*)bre, r1 = *(const float4*)(bre + 4), i0 = *(const float4*)bim, i1 = *(const float4*)(bim + 4);
          const float xr[8] = {r0.x, r0.y, r0.z, r0.w, r1.x, r1.y, r1.z, r1.w}, xi[8] = {i0.x, i0.y, i0.z, i0.w, i1.x, i1.y, i1.z, i1.w};
#pragma unroll
          for (int k = 0; k < 8; ++k) { re[k] = (hf)(1024.f * (cr * xr[k] - ci * xi[k])); im[k] = (hf)(1024.f * (cr * xi[k] + ci * xr[k])); }
        } else {
#pragma unroll
          for (int k = 0; k < 8; ++k) { re[k] = (hf)0.f; im[k] = (hf)0.f; }
        }
        bfB[q4] = re; bfB[q4 + 4] = im;
      }
      const int cp = chain_pos(d, tc);
      const size_t sidx = (((size_t)(d * 4 + b) * 132 + cp) * 16 + g) * 64 + lane;
      float xr = 0.f, xi = 0.f;
      hf8 cf[4];
      if (pass == 3) {
        float2 x0 = X[sidx]; xr = x0.x; xi = x0.y;
#pragma unroll
        for (int ks = 0; ks < 4; ++ks) {
          const int c0 = ks * 32 + fq * 8;
          const float* src_ = (c0 < 64 ? p.in[28] : p.in[29]) + ((size_t)ig * 16 + fr) * 64 + (c0 & 63);
          const float sg = c0 < 64 ? 1.f : -1.f;
          const float4 v0 = *(const float4*)src_, v1 = *(const float4*)(src_ + 4);
          cf[ks][0] = (hf)(sg * v0.x); cf[ks][1] = (hf)(sg * v0.y); cf[ks][2] = (hf)(sg * v0.z); cf[ks][3] = (hf)(sg * v0.w);
          cf[ks][4] = (hf)(sg * v1.x); cf[ks][5] = (hf)(sg * v1.y); cf[ks][6] = (hf)(sg * v1.z); cf[ks][7] = (hf)(sg * v1.w);
        }
      }
#pragma unroll 1
      for (int jb = 0; jb < 4; ++jb) {
        const int tb = d ? 3 - jb : jb;
        {
          hf8 au;
          if (fq < 2) {
            const float* up = ub + (tb * 16 + fr) * 16 + fq * 8;
            const float4 u0 = *(const float4*)up, u1 = *(const float4*)(up + 4);
            au[0] = (hf)u0.x; au[1] = (hf)u0.y; au[2] = (hf)u0.z; au[3] = (hf)u0.w; au[4] = (hf)u1.x; au[5] = (hf)u1.y; au[6] = (hf)u1.z; au[7] = (hf)u1.w;
          } else {
#pragma unroll
            for (int k = 0; k < 8; ++k) au[k] = (hf)0.f;
          }
#pragma unroll
          for (int nb = 0; nb < 8; ++nb) {
            f32x4 ab = (f32x4){0.f, 0.f, 0.f, 0.f};
            ab = __builtin_amdgcn_mfma_f32_16x16x32_f16(au, bfB[nb], ab, 0, 0, 0);
#pragma unroll
            for (int j = 0; j < 4; ++j) bu[(fq * 4 + j) * 132 + nb * 16 + fr] = ab[j];
          }
        }
#pragma unroll 4
        for (int jj = 0; jj < 16; ++jj) {
          const int t16 = d ? 15 - jj : jj;
          const float br = bu[t16 * 132 + lane] * 0.0009765625f, bi = bu[t16 * 132 + 64 + lane] * 0.0009765625f;
          const float nr = ar * xr - ai * xi + br, ni = ar * xi + ai * xr + bi;
          xr = nr; xi = ni;
          if (pass == 3) { *(hf*)(xs + t16 * 272 + lane * 2) = (hf)xr; *(hf*)(xs + t16 * 272 + 128 + lane * 2) = (hf)xi; }
        }
        if (pass == 3) {
          f32x4 acc = (f32x4){0.f, 0.f, 0.f, 0.f};
#pragma unroll
          for (int ks = 0; ks < 4; ++ks) {
            const hf8 af = *(const hf8*)(xs + fr * 272 + ks * 64 + fq * 16);
            acc = __builtin_amdgcn_mfma_f32_16x16x32_f16(af, cf[ks], acc, 0, 0, 0);
          }
#pragma unroll
          for (int i = 0; i < 4; ++i) if (i == tb) yacc[i] += acc;
        }
      }
      if (pass == 1) E[sidx] = make_float2(xr, xi);
    }
    if (pass == 3) {
      const float dsk = p.in[30][(size_t)l * 256 + g * 16 + fr];
#pragma unroll
      for (int i = 0; i < 4; ++i)
#pragma unroll
        for (int j = 0; j < 4; ++j) {
          const int tok = i * 16 + fq * 4 + j;
          float y = yacc[i][j] + dsk * ub[tok * 16 + fr];
          const float inner = 0.7978845608028654f * (y + 0.044715f * y * y * y);
          y = 0.5f * y * (1.f + tanhf_(inner));
          YG[(size_t)(m0 + tok) * 256 + g * 16 + fr] = f2bf(y);
        }
    }
  }
}
__device__ __forceinline__ void ph_s5_carry(const P& p, int l, int vb, int nvb) {
  float2* E = S5_E(p); float2* X = S5_X(p);
  for (int t = vb * NTHR + get_tid(); t < 8192; t += nvb * NTHR) {
    const int n = t & 63, g = (t >> 6) & 15, b = (t >> 10) & 3, d = t >> 12;
    const int ig = (l * 2 + d) * 16 + g;
    const float lr = fminf(p.in[23][(size_t)ig * 64 + n], -1e-4f), li = p.in[24][(size_t)ig * 64 + n];
    const float dt = expf(p.in[25][ig]);
    const float mag = expf(lr * dt * 64.f);
    float ar = expf(lr * dt) * cosf(li * dt), ai = expf(lr * dt) * sinf(li * dt);
#pragma unroll
    for (int i = 0; i < 6; ++i) { const float r2 = ar * ar - ai * ai, i2 = 2.f * ar * ai; ar = r2; ai = i2; }
    (void)mag;
    float xr = 0.f, xi = 0.f;
    const size_t base = (((size_t)(d * 4 + b) * 132) * 16 + g) * 64 + n;
    for (int cp0 = 0; cp0 < 132; cp0 += 12) {
      float2 ev[12];
#pragma unroll
      for (int u = 0; u < 12; ++u) ev[u] = E[base + (size_t)(cp0 + u) * 1024];
#pragma unroll
      for (int u = 0; u < 12; ++u) {
        X[base + (size_t)(cp0 + u) * 1024] = make_float2(xr, xi);
        const float nr = ar * xr - ai * xi + ev[u].x, ni = ar * xi + ai * xr + ev[u].y;
        xr = nr; xi = ni;
      }
    }
  }
}
__device__ __forceinline__ void ph_glu(const P& p, int l, char* lds, int vb, int nvb) {
  EPI_VARS
  const bf16_t* YG = S5_YG(p);
  const int Mt = 264;
  const float* gb = p.in[32] + (size_t)l * 256;
  for (int it = 0;; ++it) {
    int tm, tn; if (!tile_map_v(vb, nvb, it, Mt, 2, 2, tm, tn)) break; const int m0 = tm * 128, n0 = tn * 128;
    f32x4 acc[4][4]; ZERO_ACC(acc)
    gemm_main(YG + (size_t)m0 * 256, 256, p.W + W_GLU + (size_t)n0 * 256, 256, 256, acc, lds);
    EPI_BEGIN(m0, n0)
      const float y = bf2f(YG[(size_t)row * 256 + col]);
      p.Y[(size_t)row * 1024 + 384 + col] = f2bf(y * sigmoidf_(val + gb[col]));
    EPI_END
  }
}

__device__ __forceinline__ void sub_barrier(unsigned* cnt, unsigned target) {
  asm volatile("s_waitcnt vmcnt(0)" ::: "memory");
  __syncthreads();
  if (__builtin_amdgcn_workitem_id_x() == 0) {
    __builtin_amdgcn_fence(__ATOMIC_RELEASE, "agent");
    asm volatile("s_waitcnt vmcnt(0)" ::: "memory");
    __hip_atomic_fetch_add(cnt, 1u, __ATOMIC_RELAXED, __HIP_MEMORY_SCOPE_AGENT);
    unsigned sp = 0;
    while (__hip_atomic_load(cnt, __ATOMIC_RELAXED, __HIP_MEMORY_SCOPE_AGENT) < target) { __builtin_amdgcn_s_sleep(2); if (++sp > (1u << 22)) break; }
    __builtin_amdgcn_fence(__ATOMIC_ACQUIRE, "agent");
    asm volatile("s_waitcnt vmcnt(0)" ::: "memory");
  }
  __syncthreads();
}
__device__ __forceinline__ void ph_s5_stage(const P& p, int l, char* lds, int vb, int nvb) {
  unsigned* cnt = p.bar + 3584;
  const unsigned base = (unsigned)(l * 4) * (unsigned)nvb;
  ph_z_s5(p, lds, vb, nvb);            sub_barrier(cnt, base + 1u * nvb);
  ph_s5_pass(p, l, 1, lds, vb, nvb);   sub_barrier(cnt, base + 2u * nvb);
  ph_s5_carry(p, l, vb, nvb);          sub_barrier(cnt, base + 3u * nvb);
  ph_s5_pass(p, l, 3, lds, vb, nvb);   sub_barrier(cnt, base + 4u * nvb);
  ph_glu(p, l, lds, vb, nvb);
}

__device__ __forceinline__ float logsigf_(float x) { return fminf(x, 0.f) - log1pf(__expf(-fabsf(x))); }
__device__ __forceinline__ void ml_gates(const P& p, int l, int d, int h, int m0, int lane, float& bcum, float& ic) {
  const int tok = d ? 63 - lane : lane;
  const float* gl = ML_GL(p) + (size_t)(m0 + tok) * 16;
  const float* gb = p.in[33] + (size_t)(l * 2 + d) * 8;
  ic = gl[d * 8 + h] + gb[h];
  float f = logsigf_(gl[d * 8 + 4 + h] + gb[4 + h]);
#pragma unroll
  for (int o = 1; o < 64; o <<= 1) { float v = __shfl_up(f, o); if (lane >= o) f += v; }
  bcum = f;
}
__device__ __forceinline__ void ml_gates2(const P& p, int l, int d, int h, int m0, int lane, float& bc, float& ic, float& tot) {
  const float* gl = ML_GL(p) + (size_t)(m0 + lane) * 16;
  const float* gb = p.in[33] + (size_t)(l * 2 + d) * 8;
  ic = gl[d * 8 + h] + gb[h];
  const float f0 = logsigf_(gl[d * 8 + 4 + h] + gb[4 + h]);
  float f = f0;
#pragma unroll
  for (int o = 1; o < 64; o <<= 1) { float v = __shfl_up(f, o); if (lane >= o) f += v; }
  tot = __shfl(f, 63);
  bc = d ? (tot - f + f0) : f;
}
#define MLQ 208
#define MLS 144
__device__ __forceinline__ void ph_ml_a(const P& p, int l, char* lds) {
  char* vt = lds; char* kt = lds + 13824; float* wg = (float*)(lds + 27648);
  const int tid = get_tid(), lane = tid & 63, wid = tid >> 6, fr = lane & 15, fq = lane >> 4;
  const hf* QK = ML_QK(p); const hf* Z = ML_Z(p);
  for (int t = blockIdx.x; t < 4224; t += gridDim.x) {
    const int tc = t % 132, h = (t / 132) & 3, b = (t / 528) & 3, d = t / 2112;
    const int m0 = s5_m0(b, tc); const int cp = chain_pos(d, tc);
    const size_t task = ((size_t)((d * 4 + b) * 4 + h)) * 132 + cp;
    if (wid == 0) {
      float bc, ic, tot; ml_gates2(p, l, d, h, m0, lane, bc, ic, tot);
      const float lw = tot - bc + ic;
      float mx = lw;
      for (int o = 32; o > 0; o >>= 1) mx = fmaxf(mx, __shfl_xor(mx, o));
      wg[lane] = __expf(lw - mx);
      if (lane == 0) { ML_SC(p)[task * 2] = mx; ML_SC(p)[task * 2 + 1] = tot; }
    }
    __syncthreads();
    for (int e = tid; e < 64 * 12; e += NTHR) {
      const int tok = e & 63, q = e >> 6;
      const hf8 kv = *(const hf8*)(QK + (size_t)(m0 + tok) * 768 + 384 + h * 96 + q * 8);
      const hf8 vv = *(const hf8*)(Z + (size_t)(m0 + tok) * 1536 + 768 + h * 96 + q * 8);
      const float w = wg[tok];
#pragma unroll
      for (int i = 0; i < 8; ++i) {
        *(hf*)(kt + (q * 8 + i) * MLS + tok * 2) = kv[i];
        *(hf*)(vt + (q * 8 + i) * MLS + tok * 2) = (hf)((float)vv[i] * w);
      }
    }
    __syncthreads();
    float* dc = ML_DC(p) + task * 9216;
#pragma unroll 1
    for (int bi = 0; bi < 9; ++bi) {
      const int idx = wid * 9 + bi; const int mb = idx / 6, nb = idx % 6;
      f32x4 acc = (f32x4){0.f, 0.f, 0.f, 0.f};
#pragma unroll
      for (int ks = 0; ks < 2; ++ks) {
        const hf8 af = *(const hf8*)(vt + (mb * 16 + fr) * MLS + ks * 64 + fq * 16);
        const hf8 bf = *(const hf8*)(kt + (nb * 16 + fr) * MLS + ks * 64 + fq * 16);
        acc = __builtin_amdgcn_mfma_f32_16x16x32_f16(af, bf, acc, 0, 0, 0);
      }
#pragma unroll
      for (int j = 0; j < 4; ++j) dc[(mb * 16 + fq * 4 + j) * 96 + nb * 16 + fr] = acc[j];
    }
    if (tid < 96) {
      float s = 0.f;
      for (int j = 0; j < 64; ++j) s += wg[j] * (float)*(const hf*)(kt + tid * MLS + j * 2);
      ML_DN(p)[task * 96 + tid] = s;
    }
    __syncthreads();
  }
}
__device__ __forceinline__ void ph_ml_b(const P& p) {
  float* DC = ML_DC(p); float* DN = ML_DN(p); const float* SC = ML_SC(p); float* MP = ML_MP(p);
  for (int t = blockIdx.x * NTHR + get_tid(); t < 32 * 9312; t += gridDim.x * NTHR) {
    const int chain = t / 9312, e = t % 9312;
    float cur = 0.f, mprev = 0.f;
    for (int cp0 = 0; cp0 < 132; cp0 += 12) {
      float dl[12], ml_[12], bl_[12];
#pragma unroll
      for (int u = 0; u < 12; ++u) {
        const size_t task = (size_t)chain * 132 + cp0 + u;
        dl[u] = e < 9216 ? DC[task * 9216 + e] : DN[task * 96 + (e - 9216)];
        ml_[u] = SC[task * 2]; bl_[u] = SC[task * 2 + 1];
      }
#pragma unroll
      for (int u = 0; u < 12; ++u) {
        const size_t task = (size_t)chain * 132 + cp0 + u;
        float* slot = e < 9216 ? DC + task * 9216 + e : DN + task * 96 + (e - 9216);
        *slot = cur;
        if (e == 0) MP[task] = mprev;
        const float mnew = fmaxf(bl_[u] + mprev, ml_[u]);
        cur = __expf(bl_[u] + mprev - mnew) * cur + __expf(ml_[u] - mnew) * dl[u];
        mprev = mnew;
      }
    }
  }
}
__device__ __forceinline__ void ph_ml_c(const P& p, int l, char* lds) {
  char* qs = lds; char* ks = lds + 13312; char* vt = lds + 26624; char* cs = lds + 40448; char* ps = lds + 60416;
  float* fl = (float*)(lds + 69632);
  float* bc = fl; float* icv = fl + 128; float* mr = fl + 256; float* inter = fl + 320; float* den = fl + 384; float* nq = fl + 448; float* nst = fl + 512;
  const int tid = get_tid(), lane = tid & 63, wid = tid >> 6, fr = lane & 15, fq = lane >> 4;
  const hf* QK = ML_QK(p); const hf* Z = ML_Z(p);
  const int ntc = (l == 1) ? 128 : 132;
  for (int t = blockIdx.x; t < 16 * ntc; t += gridDim.x) {
    const int tc = t % ntc, h = (t / ntc) & 3, b = t / (4 * ntc);
    const int m0 = s5_m0(b, tc);
    for (int e = tid; e < 64 * 12; e += NTHR) {
      const int tok = e & 63, q = e >> 6;
      *(hf8*)(qs + tok * MLQ + q * 16) = *(const hf8*)(QK + (size_t)(m0 + tok) * 768 + h * 96 + q * 8);
      *(hf8*)(ks + tok * MLQ + q * 16) = *(const hf8*)(QK + (size_t)(m0 + tok) * 768 + 384 + h * 96 + q * 8);
      const hf8 vv = *(const hf8*)(Z + (size_t)(m0 + tok) * 1536 + 768 + h * 96 + q * 8);
#pragma unroll
      for (int i = 0; i < 8; ++i) *(hf*)(vt + (q * 8 + i) * MLS + tok * 2) = vv[i];
    }
    if (wid < 2) { float bcv, ic, tot; ml_gates2(p, l, wid, h, m0, lane, bcv, ic, tot); bc[wid * 64 + lane] = bcv; icv[wid * 64 + lane] = ic; }
    f32x4 hs[6];
#pragma unroll
    for (int n = 0; n < 6; ++n) hs[n] = (f32x4){0.f, 0.f, 0.f, 0.f};
    for (int d = 0; d < 2; ++d) {
      const int cp = chain_pos(d, tc);
      const size_t task = ((size_t)((d * 4 + b) * 4 + h)) * 132 + cp;
      const float mprev = ML_MP(p)[task];
      __syncthreads();
      {
        const float* cg = ML_DC(p) + task * 9216;
        for (int e = tid; e < 96 * 24; e += NTHR) {
          const int v = e / 24, q = e % 24;
          const float4 c4 = *(const float4*)(cg + v * 96 + q * 4);
          hf4 o; o[0] = (hf)c4.x; o[1] = (hf)c4.y; o[2] = (hf)c4.z; o[3] = (hf)c4.w;
          *(hf4*)(cs + v * MLQ + q * 8) = o;
        }
        if (tid < 96) nst[tid] = ML_DN(p)[task * 96 + tid];
      }
      const float* bcd = bc + d * 64; const float* icd = icv + d * 64;
      if (tid < 64) {
        const int j = tid; const float bj = bcd[j];
        float mx = bj + mprev;
        if (d == 0) { for (int s = 0; s <= j; ++s) mx = fmaxf(mx, bj - bcd[s] + icd[s]); }
        else { for (int s = j; s < 64; ++s) mx = fmaxf(mx, bj - bcd[s] + icd[s]); }
        mr[j] = mx; inter[j] = __expf(bj + mprev - mx);
      }
      __syncthreads();
      if (tid < 64) {
        float s1 = 0.f;
        for (int k = 0; k < 96; ++k) s1 += nst[k] * (float)*(const hf*)(qs + tid * MLQ + k * 2);
        nq[tid] = s1;
      }
      {
        f32x4 sacc[4];
#pragma unroll
        for (int n = 0; n < 4; ++n) sacc[n] = (f32x4){0.f, 0.f, 0.f, 0.f};
#pragma unroll
        for (int kk = 0; kk < 3; ++kk) {
          const hf8 af = *(const hf8*)(qs + (wid * 16 + fr) * MLQ + kk * 64 + fq * 16);
#pragma unroll
          for (int n = 0; n < 4; ++n) {
            const hf8 bf = *(const hf8*)(ks + (n * 16 + fr) * MLQ + kk * 64 + fq * 16);
            sacc[n] = __builtin_amdgcn_mfma_f32_16x16x32_f16(af, bf, sacc[n], 0, 0, 0);
          }
        }
        float rs[4] = {0.f, 0.f, 0.f, 0.f};
#pragma unroll
        for (int n = 0; n < 4; ++n) {
          const int s = n * 16 + fr; const float bs = bcd[s] - icd[s];
#pragma unroll
          for (int jj = 0; jj < 4; ++jj) {
            const int j = wid * 16 + fq * 4 + jj;
            const bool valid = d == 0 ? (s <= j) : (s >= j);
            const float val = valid ? sacc[n][jj] * __expf(bcd[j] - bs - mr[j]) : 0.f;
            rs[jj] += val;
            *(hf*)(ps + j * MLS + s * 2) = (hf)val;
          }
        }
        __syncthreads();
#pragma unroll
        for (int jj = 0; jj < 4; ++jj) {
          const float r = rowsum16(rs[jj]);
          const int j = wid * 16 + fq * 4 + jj;
          if (fr == 0) den[j] = inter[j] * nq[j] + r;
        }
      }
      f32x4 acc[6];
#pragma unroll
      for (int n = 0; n < 6; ++n) acc[n] = (f32x4){0.f, 0.f, 0.f, 0.f};
#pragma unroll
      for (int kk = 0; kk < 3; ++kk) {
        const hf8 af = *(const hf8*)(qs + (wid * 16 + fr) * MLQ + kk * 64 + fq * 16);
#pragma unroll
        for (int n = 0; n < 6; ++n) {
          const hf8 bf = *(const hf8*)(cs + (n * 16 + fr) * MLQ + kk * 64 + fq * 16);
          acc[n] = __builtin_amdgcn_mfma_f32_16x16x32_f16(af, bf, acc[n], 0, 0, 0);
        }
      }
#pragma unroll
      for (int jj = 0; jj < 4; ++jj) { const float it = inter[wid * 16 + fq * 4 + jj];
#pragma unroll
        for (int n = 0; n < 6; ++n) acc[n][jj] *= it; }
#pragma unroll
      for (int kk = 0; kk < 2; ++kk) {
        const hf8 af = *(const hf8*)(ps + (wid * 16 + fr) * MLS + kk * 64 + fq * 16);
#pragma unroll
        for (int n = 0; n < 6; ++n) {
          const hf8 bf = *(const hf8*)(vt + (n * 16 + fr) * MLS + kk * 64 + fq * 16);
          acc[n] = __builtin_amdgcn_mfma_f32_16x16x32_f16(af, bf, acc[n], 0, 0, 0);
        }
      }
      __syncthreads();
#pragma unroll
      for (int jj = 0; jj < 4; ++jj) {
        const int j = wid * 16 + fq * 4 + jj;
        const float dn = 1.f / fmaxf(fabsf(den[j]), __expf(-mr[j]));
#pragma unroll
        for (int n = 0; n < 6; ++n) hs[n][jj] += acc[n][jj] * dn;
      }
    }
#pragma unroll
    for (int jj = 0; jj < 4; ++jj) {
      const int m = m0 + wid * 16 + fq * 4 + jj;
      const hf* op = Z + (size_t)m * 1536 + 1152 + h * 96 + fr;
      float x[6]; float s = 0.f;
#pragma unroll
      for (int n = 0; n < 6; ++n) { x[n] = sigmoidf_((float)op[n * 16]) * hs[n][jj]; s += x[n]; }
      s = rowsum16(s);
      const float mean = s * (1.f / 96.f);
      float q = 0.f;
#pragma unroll
      for (int n = 0; n < 6; ++n) { x[n] -= mean; q += x[n] * x[n]; }
      q = rowsum16(q);
      const float rsd = rsqrtf(q * (1.f / 96.f) + 1e-5f);
      const float* ng = p.in[34] + (size_t)l * 384 + h * 96 + fr;
      bf16_t* yp = p.Y + (size_t)m * 1024 + 640 + h * 96 + fr;
#pragma unroll
      for (int n = 0; n < 6; ++n) yp[n * 16] = f2bf(x[n] * rsd * ng[n * 16]);
    }
    __syncthreads();
  }
}

#define MG_YM(p) ((bf16_t*)(p).R)
#define MG_G3(p) (MG_YM(p) + (size_t)M_ALL * 1024)
__device__ __forceinline__ void ph_gates(const P& p, int l, int Mt, char* lds) {
  EPI_VARS
  bf16_t* G3 = MG_G3(p);
  const float* gbias = p.in[38] + (size_t)l * 3072;
  STREAM_BEGIN_T(Mt, 24, 8, (p.U + (size_t)(tm * 128) * 1024), (p.W + W_IN + (size_t)(3216 + tn * 128) * 1024), 1024, 1024, 1024)
    const int m0 = tm * 128, n0 = tn * 128;
#pragma unroll
    for (int m = 0; m < 4; ++m) {
      bf16_t* gp3 = G3 + (size_t)(m0 + wr * 64 + m * 16 + fr) * 3072 + n0 + wc * 64 + fq * 4;
#pragma unroll
      for (int n = 0; n < 4; ++n) {
        const float4 b4 = *(const float4*)(gbias + n0 + wc * 64 + n * 16 + fq * 4);
        const unsigned lo = (unsigned)f2bf(sigmoidf_(acc[m][n][0] + b4.x)) | ((unsigned)f2bf(sigmoidf_(acc[m][n][1] + b4.y)) << 16);
        const unsigned hi = (unsigned)f2bf(sigmoidf_(acc[m][n][2] + b4.z)) | ((unsigned)f2bf(sigmoidf_(acc[m][n][3] + b4.w)) << 16);
        *(uint2*)(gp3 + n * 16) = make_uint2(lo, hi);
      }
    }
  STREAM_END
}
__device__ __forceinline__ void ph_merge(const P& p, int l, int Mt, char* lds) {
  EPI_VARS
  bf16_t* YM = MG_YM(p); const bf16_t* G3 = MG_G3(p);
  const int ntile = Mt * 16;
  for (int it = 0;; ++it) {
    int tm, tn; if (!tile_map(it, Mt, 16, 8, tm, tn)) break; const int m0 = tm * 128, n0 = tn * 64;
    f32x4 yacc[4][2];
#pragma unroll
    for (int m = 0; m < 4; ++m) { yacc[m][0] = (f32x4){0.f, 0.f, 0.f, 0.f}; yacc[m][1] = (f32x4){0.f, 0.f, 0.f, 0.f}; }
#pragma unroll 1
    for (int br = 0; br < 3; ++br) {
      f32x4 acc[4][2];
#pragma unroll
      for (int m = 0; m < 4; ++m) { acc[m][0] = (f32x4){0.f, 0.f, 0.f, 0.f}; acc[m][1] = (f32x4){0.f, 0.f, 0.f, 0.f}; }
      const int kb = br == 1 ? 256 : 384; const int yoff = br == 0 ? 0 : (br == 1 ? 384 : 640);
      const int woff = br == 0 ? W_UPRW : (br == 1 ? W_UPS5 : W_UPML);
      gemm_main_t<2>(p.Y + (size_t)m0 * 1024 + yoff, 1024, p.W + woff + (size_t)n0 * kb, kb, kb, acc, lds);
      EPI_ROW_BEGIN(m0)
        const bf16_t* gp = G3 + (size_t)row * 3072 + br * 1024 + n0 + wc * 32 + fr;
#pragma unroll
        for (int n = 0; n < 2; ++n) yacc[m][n][j] += bf2f(gp[n * 16]) * acc[m][n][j];
      EPI_ROW_END
    }
    EPI_ROW_BEGIN(m0)
      bf16_t* yp = YM + (size_t)row * 1024 + n0 + wc * 32 + fr;
#pragma unroll
      for (int n = 0; n < 2; ++n) yp[n * 16] = f2bf(yacc[m][n][j]);
    EPI_ROW_END
  }
}
__device__ __forceinline__ void ph_wout(const P& p, int l, int Mt, char* lds) {
  EPI_VARS
  const bf16_t* YM = (const bf16_t*)p.R;
  STREAM_BEGIN_T(Mt, 8, 8, (YM + (size_t)(tm * 128) * 1024), (p.W + W_OUT + (size_t)(tn * 128) * 1024), 1024, 1024, 1024)
    const int m0 = tm * 128, n0 = tn * 128;
#pragma unroll
    for (int m = 0; m < 4; ++m) {
      const int row = m0 + wr * 64 + m * 16 + fr;
      float* sp = srow(p, row) + n0 + wc * 64 + fq * 4; const float* gp = modp(p, l, row, 5) + n0 + wc * 64 + fq * 4;
#pragma unroll
      for (int n = 0; n < 4; ++n) {
        float4 s4 = *(const float4*)(sp + n * 16); const float4 g4 = *(const float4*)(gp + n * 16);
        s4.x = ALPHA * s4.x + g4.x * acc[m][n][0]; s4.y = ALPHA * s4.y + g4.y * acc[m][n][1];
        s4.z = ALPHA * s4.z + g4.z * acc[m][n][2]; s4.w = ALPHA * s4.w + g4.w * acc[m][n][3];
        *(float4*)(sp + n * 16) = s4;
      }
    }
  STREAM_END
}

#define XB_TMO      128
#define XB_XCNT(j)  (256  + 64 * (j))
#define XB_XSUB(j)  (1280 + 64 * (j))
#define XB_XGEN(j)  (2304 + 64 * (j))
#define XB_TOP      3328
#define XB_TOPGEN   3392
#define XCD_BAR_WORDS 3456
#define XB_SPIN_CAP (1u << 18)
#define LAS __attribute__((address_space(3)))

__device__ __forceinline__ unsigned xb_ld(unsigned* p)              { return __hip_atomic_load(p, __ATOMIC_RELAXED, __HIP_MEMORY_SCOPE_AGENT); }
__device__ __forceinline__ unsigned xb_add(unsigned* p, unsigned v) { return __hip_atomic_fetch_add(p, v, __ATOMIC_RELAXED, __HIP_MEMORY_SCOPE_AGENT); }
__device__ __forceinline__ unsigned xb_xcc_id() { return (unsigned)__builtin_amdgcn_s_getreg((3 << 11) | 20) & 0xFu; }
#define XB_SPIN(cond, bar) do { unsigned _sp = 0; while (cond) { __builtin_amdgcn_s_sleep(1); \
    if ((++_sp & 255u) == 0u) { if (xb_ld(&(bar)[XB_TMO])) break; if (_sp > XB_SPIN_CAP) { atomicAdd(&(bar)[XB_TMO], 1u); break; } } } } while (0)

struct XcdBarrier {
    unsigned* bar; unsigned x;
    volatile LAS unsigned* st;
};

__device__ __forceinline__ XcdBarrier xcd_barrier_post(unsigned* bar, volatile LAS unsigned* st) {
    XcdBarrier b; b.bar = bar; b.x = xb_xcc_id(); b.st = st;
    if (__builtin_amdgcn_workitem_id_x() == 0) (void)xb_add(&bar[XB_XCNT(b.x)], 1u);
    return b;
}
__device__ __forceinline__ void xcd_barrier_complete(unsigned* bar, unsigned x, unsigned& nloc, unsigned& nx) {
    const unsigned G = gridDim.x * gridDim.y * gridDim.z;
    unsigned sum, cnt, mine, sp = 0u;
    for (;;) {
        sum = 0u; cnt = 0u; mine = 0u;
#pragma unroll
        for (unsigned j = 0; j < 16; ++j) { const unsigned c = xb_ld(&bar[XB_XCNT(j)]); sum += c; cnt += (c > 0u) ? 1u : 0u; mine = (j == x) ? c : mine; }
        if (sum == G) break;
        __builtin_amdgcn_s_sleep(1);
        if ((++sp & 255u) == 0u) { if (xb_ld(&bar[XB_TMO])) break; if (sp > XB_SPIN_CAP) { atomicAdd(&bar[XB_TMO], 1u); break; } }
    }
    nloc = mine > 0u ? mine : 1u; nx = cnt > 0u ? cnt : 1u;
}

__device__ __forceinline__ void xcd_barrier(const XcdBarrier& b) {
    asm volatile("s_waitcnt vmcnt(0)" ::: "memory");
    __syncthreads();
    if (__builtin_amdgcn_workitem_id_x() == 0) {
        unsigned* bar = b.bar;
        __builtin_amdgcn_s_waitcnt(0);
        unsigned nloc = b.st[0], nx = b.st[1];
        if (nloc == 0u) { xcd_barrier_complete(bar, b.x, nloc, nx); b.st[0] = nloc; b.st[1] = nx; }
        const unsigned old = xb_add(&bar[XB_XSUB(b.x)], 1u);
        const unsigned gen = old / nloc;
        if (old + 1u == (gen + 1u) * nloc) {
            __builtin_amdgcn_fence(__ATOMIC_RELEASE, "agent");
            asm volatile("s_waitcnt vmcnt(0)" ::: "memory");
            const unsigned og = xb_add(&bar[XB_TOP], 1u);
            const unsigned tg = og / nx;
            if (og + 1u == (tg + 1u) * nx) xb_add(&bar[XB_TOPGEN], 1u);
            else XB_SPIN(xb_ld(&bar[XB_TOPGEN]) == tg, bar);
            __builtin_amdgcn_fence(__ATOMIC_ACQUIRE, "agent");
            xb_add(&bar[XB_XGEN(b.x)], 1u);
            asm volatile("s_waitcnt vmcnt(0)" ::: "memory");
        } else {
            XB_SPIN(xb_ld(&bar[XB_XGEN(b.x)]) == gen, bar);
            __builtin_amdgcn_fence(__ATOMIC_ACQUIRE, "agent");
            asm volatile("s_waitcnt vmcnt(0)" ::: "memory");
        }
    }
    __syncthreads();
}


#define SYNC xcd_barrier(xb); asm volatile("" : "+s"(l));
__global__ void __launch_bounds__(NTHR, 2) mega(P pv) {
#define p pv
  __shared__ __attribute__((aligned(16))) char lds[LDS_BYTES];
  __shared__ uint4 xb_words;
  cg::grid_group grid = cg::this_grid();
  {
    const int t0 = __builtin_amdgcn_workitem_id_x();
    if (blockIdx.x == 0) for (int i = t0; i < 4096; i += NTHR) pv.bar[i] = 0u;
    if (t0 == 0) xb_words = make_uint4(0u, 0u, 0u, 0u);
    __threadfence();
    grid.sync();
  }
  XcdBarrier xb = xcd_barrier_post(pv.bar, (volatile LAS unsigned*)&xb_words);
  for (int l = 0; l < 2; ++l) {
    const bool last = (l == 1);
    const int Mt2 = last ? 256 : 264;
    const int Mr2 = last ? M_LAT : M_ALL;
    ph_convert(p, l, l == 0, lds); SYNC
    if (l == 0) { ph_rows(p, 0, 0, 0, M_ALL, true, 0, 0); SYNC }
    ph_ffn_up(p, 0, 264, lds); SYNC
    ph_ffn_down(p, l, 0, 264, lds); SYNC
    ph_rows(p, 1, l, 0, M_ALL, true, l, 3); SYNC
    ph_z_rw(p, lds); SYNC
    ph_conv<0>(p, l); SYNC
    ph_lora(p, l, lds); SYNC
    {
      const int ns = gridDim.x >= 384 ? 192 : 0;
      if (ns == 0 || blockIdx.x < 192) ph_rwscan(p, lds);
      if (ns == 0) { SYNC }
      if ((int)blockIdx.x >= ns) ph_s5_stage(p, l, lds, (int)blockIdx.x - ns, (int)gridDim.x - ns);
      SYNC
    }
    ph_rwpost(p, l); SYNC
    ph_z_ml(p, lds); SYNC
    ph_conv<1>(p, l); SYNC
    ph_ml_a(p, l, lds); SYNC
    ph_ml_b(p); SYNC
    ph_ml_c(p, l, lds); SYNC
    ph_gates(p, l, Mt2, lds); SYNC
    ph_merge(p, l, Mt2, lds); SYNC
    ph_wout(p, l, Mt2, lds); SYNC
    ph_rows(p, 1, l, 1, Mr2, true, l, 6); SYNC
    ph_ffn_up(p, 1, Mt2, lds); SYNC
    ph_ffn_down(p, l, 1, Mt2, lds); SYNC
    ph_rows(p, 1, l, 2, Mr2, !last, l + 1, 0);
  }
#undef p
}

extern "C" void kernel_launch(void* const* d_in, const int* in_sizes, int n_in, void* d_out, int out_size, void* d_ws, size_t ws_size,
                              hipStream_t stream) {
  static int grid_blocks = 0;
  if (!grid_blocks) {
    int dev = 0, cus = 0, per_cu = 0;
    hipGetDevice(&dev);
    hipDeviceGetAttribute(&cus, hipDeviceAttributeMultiprocessorCount, dev);
    hipOccupancyMaxActiveBlocksPerMultiprocessor(&per_cu, mega, NTHR, 0);
    if (per_cu > 2) per_cu = 2;
    grid_blocks = cus * per_cu;
  }
  P p{};
  for (int i = 0; i < 40; ++i) p.in[i] = (const float*)d_in[i];
  char* ws = (char*)d_ws;
  size_t off = 0;
  p.W = (bf16_t*)(ws + off); off += (size_t)W_TOTAL * 2;
  p.mod = (float*)(ws + off); off += (size_t)2 * 5 * 9216 * 4;
  p.sctx = (float*)(ws + off); off += (size_t)1024 * 1024 * 4;
  p.bar = (unsigned*)(ws + off); off += (size_t)16384;
  p.U = (bf16_t*)(ws + off); off += (size_t)M_ALL * 1024 * 2;
  p.Y = (bf16_t*)(ws + off); off += (size_t)M_ALL * 1024 * 2;
  p.R = ws + off;
  p.out = (float*)d_out;
  if (off + (size_t)M_ALL * 9728 > ws_size) fprintf(stderr, "workspace too small: need %zu have %zu\n", off + (size_t)M_ALL * 9728, ws_size);
  void* args[] = {&p};
  hipError_t e = hipLaunchCooperativeKernel((void*)mega, dim3(grid_blocks), dim3(NTHR), args, 0, stream);
  if (e != hipSuccess) fprintf(stderr, "cooperative launch failed: %s (grid %d)\n", hipGetErrorString(e), grid_blocks);
}
```
